# Optimizing an MI355X kernel written in HIP

```python
import jax
import jax.numpy as jnp
from jax import lax
import numpy as np

D_MODEL = 1024
BATCH = 4
SEQ = 8192
DEPTH = 4

N_A_LAYERS = DEPTH // 2
N_B_LAYERS = DEPTH - N_A_LAYERS
N_HEADS = 8
HEAD_DIM = D_MODEL // N_HEADS
N_KV_HEADS = 2
HEAD_GROUP = N_HEADS // N_KV_HEADS
KV_DIM = N_KV_HEADS * HEAD_DIM
IDX_HEADS = 4
IDX_DIM = 64
IDX_TOPK_MAX = 256
DSA_Q_BLOCK = 128
MOBA_BLOCK = 256
MOBA_TOPK = 3
MOBA_Q_CHUNK = 16
N_GROUPS = 4
EXPERTS_PER_GROUP = 8
N_EXPERTS = N_GROUPS * EXPERTS_PER_GROUP
TOP_EXPERTS = 2
D_EXPERT = 512
MOE_ROW_BLOCK = 128
PLE_DIM = 256
ALPHA = (2.0 * DEPTH) ** 0.25
BETA = (8.0 * DEPTH) ** -0.25
LN_EPS = 1e-5
A_SPLITS = (D_MODEL, D_MODEL + KV_DIM, D_MODEL + 2 * KV_DIM,
            D_MODEL + 2 * KV_DIM + IDX_HEADS * IDX_DIM,
            D_MODEL + 2 * KV_DIM + IDX_HEADS * IDX_DIM + IDX_DIM)
A_COLS = A_SPLITS[-1] + IDX_HEADS

kernel_name = 'yoco_dsa_moba_hmoe_trunk'


def alibi_slopes(n):
    return 2.0 ** (-8.0 * jnp.arange(1, n + 1, dtype=jnp.float32) / n)


def layer_norm(x, g, b):
    xf = x.astype(jnp.float32)
    mu = jnp.mean(xf, axis=-1, keepdims=True)
    var = jnp.mean(jnp.square(xf - mu), axis=-1, keepdims=True)
    y = (xf - mu) * lax.rsqrt(var + LN_EPS) * g.astype(jnp.float32) + b.astype(jnp.float32)
    return y.astype(x.dtype)


def dsa_attention(h, w_in, w_o, slopes):
    bsz, seq, _ = h.shape
    q, k, v, iq, ik, iw = jnp.split(h @ w_in, A_SPLITS, axis=-1)
    q = q.reshape(bsz, seq, N_KV_HEADS, HEAD_GROUP, HEAD_DIM)
    k = k.reshape(bsz, seq, N_KV_HEADS, HEAD_DIM)
    v = v.reshape(bsz, seq, N_KV_HEADS, HEAD_DIM)
    iq = iq.reshape(bsz, seq, IDX_HEADS, IDX_DIM)
    iw = iw * (IDX_HEADS ** -0.5)
    topk = min(IDX_TOPK_MAX, seq // 4)
    n_blk = seq // DSA_Q_BLOCK
    key_pos = jnp.arange(seq)
    b_ix = jnp.arange(bsz)[:, None, None]
    slope = slopes.reshape(N_KV_HEADS, HEAD_GROUP)[None, None, :, :, None]

    def block(i):
        start = i * DSA_Q_BLOCK
        qb = lax.dynamic_slice_in_dim(q, start, DSA_Q_BLOCK, axis=1)
        iqb = lax.dynamic_slice_in_dim(iq, start, DSA_Q_BLOCK, axis=1)
        iwb = lax.dynamic_slice_in_dim(iw, start, DSA_Q_BLOCK, axis=1)
        qpos = start + jnp.arange(DSA_Q_BLOCK)
        rel = jax.nn.relu(jnp.einsum('bqhd,bsd->bqhs', iqb, ik) * (IDX_DIM ** -0.5))
        score = jnp.einsum('bqhs,bqh->bqs', rel, iwb).astype(jnp.float32)
        score = jnp.where(key_pos[None, None, :] <= qpos[None, :, None], score, -jnp.inf)
        _, idx = lax.top_k(score, topk)
        kg = k[b_ix, idx]
        vg = v[b_ix, idx]
        logits = jnp.einsum('bqgrd,bqkgd->bqgrk', qb, kg).astype(jnp.float32) * (HEAD_DIM ** -0.5)
        dist = (qpos[None, :, None] - idx).astype(jnp.float32)[:, :, None, None, :]
        logits = logits - slope * dist
        valid = (idx <= qpos[None, :, None])[:, :, None, None, :]
        probs = jax.nn.softmax(jnp.where(valid, logits, -jnp.inf), axis=-1).astype(v.dtype)
        out = jnp.einsum('bqgrk,bqkgd->bqgrd', probs, vg)
        return out.reshape(bsz, DSA_Q_BLOCK, D_MODEL)

    out = lax.map(block, jnp.arange(n_blk))
    out = out.transpose(1, 0, 2, 3).reshape(bsz, seq, D_MODEL)
    return out @ w_o


def shared_block_kv(h, w_kv):
    bsz, seq, _ = h.shape
    k, v = jnp.split(h @ w_kv, 2, axis=-1)
    n_blocks = -(-seq // MOBA_BLOCK)
    pad = n_blocks * MOBA_BLOCK - seq

    def to_blocks(t):
        t = jnp.pad(t, ((0, 0), (0, pad), (0, 0)))
        return t.reshape(bsz, n_blocks, MOBA_BLOCK, N_KV_HEADS, HEAD_DIM).transpose(0, 3, 1, 2, 4)

    k_blocks = to_blocks(k)
    v_blocks = to_blocks(v)
    k_means = jnp.mean(k_blocks.astype(jnp.float32), axis=3).astype(h.dtype)
    return k_blocks, v_blocks, k_means


def moba_attention(h, w_q, w_o, k_blocks, v_blocks, k_means, slopes):
    bsz, seq, _ = h.shape
    n_blocks = k_blocks.shape[2]
    n_sel = max(1, min(MOBA_TOPK, n_blocks - 1))
    n_past_cols = n_sel * MOBA_BLOCK
    q = (h @ w_q).reshape(bsz, seq, N_KV_HEADS, HEAD_GROUP, HEAD_DIM)
    blk_ids = jnp.arange(n_blocks)
    in_blk = jnp.arange(MOBA_BLOCK)
    b_ix = jnp.arange(bsz)[:, None, None, None, None]
    g_ix = jnp.arange(N_KV_HEADS)[None, None, :, None, None]
    slope = slopes.reshape(N_KV_HEADS, HEAD_GROUP)[None, None, :, :, None]
    scale = HEAD_DIM ** -0.5

    def chunk(c):
        start = c * MOBA_Q_CHUNK
        qc = lax.dynamic_slice_in_dim(q, start, MOBA_Q_CHUNK, axis=1)
        qpos = start + jnp.arange(MOBA_Q_CHUNK)
        own = start // MOBA_BLOCK
        gate = jnp.einsum('bqgrd,bgnd->bqgrn', qc, k_means).astype(jnp.float32)
        gate = jnp.where(blk_ids < own, gate, -jnp.inf)
        _, sel = lax.top_k(gate, n_sel)
        ks = k_blocks[b_ix, g_ix, sel]
        vs = v_blocks[b_ix, g_ix, sel]
        ko = lax.dynamic_index_in_dim(k_blocks, own, axis=2, keepdims=False)
        vo = lax.dynamic_index_in_dim(v_blocks, own, axis=2, keepdims=False)
        past = jnp.einsum('bqgrd,bqgrjpd->bqgrjp', qc, ks).astype(jnp.float32) * scale
        kpos = sel[..., None] * MOBA_BLOCK + in_blk
        past_dist = (qpos[None, :, None, None, None, None] - kpos).astype(jnp.float32)
        past = past - slope[..., None] * past_dist
        past = jnp.where((sel < own)[..., None], past, -jnp.inf)
        past = past.reshape(bsz, MOBA_Q_CHUNK, N_KV_HEADS, HEAD_GROUP, n_past_cols)
        selfb = jnp.einsum('bqgrd,bgpd->bqgrp', qc, ko).astype(jnp.float32) * scale
        own_dist = (qpos[:, None] - (own * MOBA_BLOCK + in_blk)[None, :]).astype(jnp.float32)
        selfb = selfb - slope * own_dist[None, :, None, None, :]
        selfb = jnp.where((own_dist >= 0)[None, :, None, None, :], selfb, -jnp.inf)
        probs = jax.nn.softmax(jnp.concatenate([past, selfb], axis=-1), axis=-1).astype(v_blocks.dtype)
        p_past = probs[..., :n_past_cols].reshape(bsz, MOBA_Q_CHUNK, N_KV_HEADS, HEAD_GROUP, n_sel, MOBA_BLOCK)
        p_own = probs[..., n_past_cols:]
        out = (jnp.einsum('bqgrjp,bqgrjpd->bqgrd', p_past, vs)
               + jnp.einsum('bqgrp,bgpd->bqgrd', p_own, vo))
        return out.reshape(bsz, MOBA_Q_CHUNK, D_MODEL)

    out = lax.map(chunk, jnp.arange(seq // MOBA_Q_CHUNK))
    out = out.transpose(1, 0, 2, 3).reshape(bsz, seq, D_MODEL)
    return out @ w_o


def hier_moe(h, w_rg, b_rg, w_re, b_re, w_gate, w_up, w_down):
    bsz, seq, _ = h.shape
    n_tok = bsz * seq
    n_assign = n_tok * TOP_EXPERTS
    xt = h.reshape(n_tok, D_MODEL)
    g_logits = (xt @ w_rg + b_rg).astype(jnp.float32)
    g_prob = jax.nn.softmax(g_logits, axis=-1)
    g_sel = jnp.argmax(g_logits, axis=-1)
    g_w = jnp.take_along_axis(g_prob, g_sel[:, None], axis=-1)
    e_logits = (xt @ w_re + b_re).astype(jnp.float32).reshape(n_tok, N_GROUPS, EXPERTS_PER_GROUP)
    e_logits = jnp.take_along_axis(e_logits, g_sel[:, None, None], axis=1)[:, 0]
    e_val, e_loc = lax.top_k(e_logits, TOP_EXPERTS)
    e_w = jax.nn.softmax(e_val, axis=-1) * g_w
    e_id = g_sel[:, None] * EXPERTS_PER_GROUP + e_loc
    flat_e = e_id.reshape(-1)
    flat_tok = jnp.repeat(jnp.arange(n_tok), TOP_EXPERTS)
    flat_w = e_w.reshape(-1)
    order = jnp.argsort(flat_e)
    se, stok, sw = flat_e[order], flat_tok[order], flat_w[order]
    counts = jnp.bincount(flat_e, length=N_EXPERTS)
    padded = (counts + MOE_ROW_BLOCK - 1) // MOE_ROW_BLOCK * MOE_ROW_BLOCK
    pad_end = jnp.cumsum(padded)
    pad_start = pad_end - padded
    raw_start = jnp.cumsum(counts) - counts
    dest = pad_start[se] + (jnp.arange(n_assign) - raw_start[se])
    n_rows = (n_assign + N_EXPERTS * (MOE_ROW_BLOCK - 1) + MOE_ROW_BLOCK - 1) // MOE_ROW_BLOCK * MOE_ROW_BLOCK
    n_row_blocks = n_rows // MOE_ROW_BLOCK
    rows = jnp.zeros((n_rows, D_MODEL), h.dtype).at[dest].set(xt[stok])
    blk_expert = jnp.minimum(
        jnp.searchsorted(pad_end, jnp.arange(n_row_blocks) * MOE_ROW_BLOCK, side='right'),
        N_EXPERTS - 1)

    def expert_block(args):
        xb, e = args
        return (jax.nn.silu(xb @ w_gate[e]) * (xb @ w_up[e])) @ w_down[e]

    yb = lax.map(expert_block, (rows.reshape(n_row_blocks, MOE_ROW_BLOCK, D_MODEL), blk_expert))
    y = yb.reshape(n_rows, D_MODEL)[dest] * sw[:, None].astype(h.dtype)
    out = jax.ops.segment_sum(y, stok, num_segments=n_tok)
    return out.reshape(bsz, seq, D_MODEL)


def setup_inputs(seed: int = 0) -> dict:
    key = jax.random.key(seed)
    ks = jax.random.split(key, 18)
    f32 = jnp.float32

    def nrm(k, shape, scale):
        return jax.random.normal(k, shape, f32) * scale

    a_col_scale = jnp.concatenate([
        jnp.ones((D_MODEL + KV_DIM,), f32),
        jnp.full((KV_DIM,), BETA, f32),
        jnp.ones((A_COLS - D_MODEL - 2 * KV_DIM,), f32)])
    kv_col_scale = jnp.concatenate([jnp.ones((KV_DIM,), f32), jnp.full((KV_DIM,), BETA, f32)])
    return {
        'x': nrm(ks[0], (BATCH, SEQ, D_MODEL), 1.0),
        'p': nrm(ks[1], (DEPTH, BATCH, SEQ, PLE_DIM), 1.0),
        'w_in_a': nrm(ks[2], (N_A_LAYERS, D_MODEL, A_COLS), D_MODEL ** -0.5) * a_col_scale,
        'w_o_a': nrm(ks[3], (N_A_LAYERS, D_MODEL, D_MODEL), BETA * D_MODEL ** -0.5),
        'w_kv_shared': nrm(ks[4], (D_MODEL, 2 * KV_DIM), D_MODEL ** -0.5) * kv_col_scale,
        'w_q_b': nrm(ks[5], (N_B_LAYERS, D_MODEL, D_MODEL), D_MODEL ** -0.5),
        'w_o_b': nrm(ks[6], (N_B_LAYERS, D_MODEL, D_MODEL), BETA * D_MODEL ** -0.5),
        'w_router_group': nrm(ks[7], (DEPTH, D_MODEL, N_GROUPS), D_MODEL ** -0.5),
        'b_router_group': nrm(ks[8], (DEPTH, N_GROUPS), 0.01),
        'w_router_expert': nrm(ks[9], (DEPTH, D_MODEL, N_EXPERTS), D_MODEL ** -0.5),
        'b_router_expert': nrm(ks[10], (DEPTH, N_EXPERTS), 0.01),
        'w_gate': nrm(ks[11], (DEPTH, N_EXPERTS, D_MODEL, D_EXPERT), D_MODEL ** -0.5),
        'w_up': nrm(ks[12], (DEPTH, N_EXPERTS, D_MODEL, D_EXPERT), D_MODEL ** -0.5),
        'w_down': nrm(ks[13], (DEPTH, N_EXPERTS, D_EXPERT, D_MODEL), BETA * D_EXPERT ** -0.5),
        'w_ple': nrm(ks[14], (DEPTH, PLE_DIM, D_MODEL), BETA * PLE_DIM ** -0.5),
        'w_ple_gate': nrm(ks[15], (DEPTH, D_MODEL, D_MODEL), D_MODEL ** -0.5),
        'ln_g': 1.0 + nrm(ks[16], (DEPTH, 3, D_MODEL), 0.02),
        'ln_b': nrm(ks[17], (DEPTH, 3, D_MODEL), 0.02),
    }


def reference(x, p, w_in_a, w_o_a, w_kv_shared, w_q_b, w_o_b, w_router_group, b_router_group,
              w_router_expert, b_router_expert, w_gate, w_up, w_down, w_ple, w_ple_gate, ln_g, ln_b):
    slopes = alibi_slopes(N_HEADS)
    h = x
    for i in range(DEPTH):
        if i < N_A_LAYERS:
            mix = dsa_attention(h, w_in_a[i], w_o_a[i], slopes)
        else:
            if i == N_A_LAYERS:
                k_blocks, v_blocks, k_means = shared_block_kv(h, w_kv_shared)
            j = i - N_A_LAYERS
            mix = moba_attention(h, w_q_b[j], w_o_b[j], k_blocks, v_blocks, k_means, slopes)
        h = layer_norm(ALPHA * h + mix, ln_g[i, 0], ln_b[i, 0])
        ffn = hier_moe(h, w_router_group[i], b_router_group[i], w_router_expert[i],
                       b_router_expert[i], w_gate[i], w_up[i], w_down[i])
        h = layer_norm(ALPHA * h + ffn, ln_g[i, 1], ln_b[i, 1])
        ple = (p[i] @ w_ple[i]) * jax.nn.sigmoid(h @ w_ple_gate[i])
        h = layer_norm(ALPHA * h + ple, ln_g[i, 2], ln_b[i, 2])
    return h
```

```cpp
#include <hip/hip_runtime.h>
#include <stdint.h>

#define D_MODEL 1024
#define BATCH 4
#define SEQ 8192
#define NTOK (BATCH * SEQ)
#define DEPTH 4
#define N_A 2
#define N_HEADS 8
#define HEAD_DIM 128
#define N_KV 2
#define HEAD_GROUP 4
#define KV_DIM 256
#define IDX_HEADS 4
#define IDX_DIM 64
#define TOPK 256
#define MOBA_BLOCK 256
#define N_BLOCKS 32
#define N_GROUPS 4
#define EPG 8
#define N_EXPERTS 32
#define D_EXPERT 512
#define PLE_DIM 256
#define A_COLS 1860
#define QLD 2048
#define COL_K 1024
#define COL_V 1280
#define COL_IQ 1536
#define COL_IK 1792
#define COL_IW 1856
#define ALPHA_F 1.6817928305074290f
#define LN_EPS 1e-5f
#define MAX_SLOTS (65536 + 8192)
#define MAX_MTILES (MAX_SLOTS / 256)

#define LAS __attribute__((address_space(3)))
#define GAS __attribute__((address_space(1)))
typedef unsigned short bf16;
typedef short bf16x8 __attribute__((ext_vector_type(8)));
typedef float f32x4 __attribute__((ext_vector_type(4)));
typedef float f32x2 __attribute__((ext_vector_type(2)));
typedef unsigned u32x4 __attribute__((ext_vector_type(4)));
typedef unsigned u32x2 __attribute__((ext_vector_type(2)));

__device__ __forceinline__ unsigned cvt_pk_bf16(float lo, float hi) { unsigned r; asm("v_cvt_pk_bf16_f32 %0, %1, %2" : "=v"(r) : "v"(lo), "v"(hi)); return r; }
__device__ __forceinline__ float bf2f(bf16 b) { return __uint_as_float(((unsigned)b) << 16); }
__device__ __forceinline__ float bflo(unsigned u) { return __uint_as_float(u << 16); }
__device__ __forceinline__ float bfhi(unsigned u) { return __uint_as_float(u & 0xffff0000u); }
template <int CTRL> __device__ __forceinline__ float dpp_add(float v) { return v + __int_as_float(__builtin_amdgcn_update_dpp(0, __float_as_int(v), CTRL, 0xF, 0xF, false)); }
__device__ __forceinline__ float row16_sum(float v) {
    v = dpp_add<0xB1>(v); v = dpp_add<0x4E>(v); v = dpp_add<0x141>(v); v = dpp_add<0x140>(v); return v;
}
__device__ __forceinline__ float wave_sum(float v) { v = row16_sum(v); v += __shfl_xor(v, 16); v += __shfl_xor(v, 32); return v; }

constexpr size_t MiB = 1u << 20;
constexpr size_t WS_CTL = 0, CTL_ZERO_BYTES = 1 * MiB;
constexpr size_t WS_WMIX = 2 * MiB;
constexpr size_t WS_WPG = 10 * MiB;
constexpr size_t WS_WPLE = 12 * MiB;
constexpr size_t WS_WGU = 16 * MiB;
constexpr size_t WS_WD = 80 * MiB;
constexpr size_t WS_PB = 112 * MiB;
constexpr size_t WS_H = 128 * MiB;
constexpr size_t WS_HB = 256 * MiB;
constexpr size_t WS_T = 320 * MiB;
constexpr size_t WS_KV = 448 * MiB;
constexpr size_t WS_PL = 480 * MiB;
constexpr size_t WS_QKVI = 544 * MiB;
constexpr size_t WS_ATTN = 672 * MiB;
constexpr size_t WS_SEL = 736 * MiB;
constexpr size_t WS_ACT = 544 * MiB;
constexpr size_t WS_Y = 616 * MiB;
constexpr size_t WS_MOE = 768 * MiB;
constexpr size_t WS_IW = 770 * MiB;
constexpr size_t WS_KM = 771 * MiB;
constexpr size_t WS_SCORES = 772 * MiB;
constexpr int MO_TOK_E = 0, MO_TOK_POS = NTOK * 2, MO_TOK_SLOT = NTOK * 4, MO_TOK_W = NTOK * 6, MO_SLOT_TOK = NTOK * 8, MO_TILE_E = MO_SLOT_TOK + MAX_SLOTS, MO_TILE_ROW0 = MO_TILE_E + 512, MO_TILE_NV = MO_TILE_ROW0 + 512;
constexpr int CW_BAR = 65536;
constexpr int CW_CNT = 16384;
constexpr int CW_NTILES = 16384 + 256;

constexpr int LDS_BYTES = 163840;
constexpr int LDS_MISC = 163840 - 256;
constexpr int NWAVES = 8;

#define XB_TMO      128
#define XB_XCNT(j)  (256  + 64 * (j))
#define XB_XSUB(j)  (1280 + 64 * (j))
#define XB_XGEN(j)  (2304 + 64 * (j))
#define XB_TOP      3328
#define XB_TOPGEN   3392
#define XCD_BAR_WORDS 3456
#define XB_SPIN_CAP (1u << 22)
__device__ __forceinline__ unsigned xb_ld(unsigned* p)              { return __hip_atomic_load(p, __ATOMIC_RELAXED, __HIP_MEMORY_SCOPE_AGENT); }
__device__ __forceinline__ unsigned xb_add(unsigned* p, unsigned v) { return __hip_atomic_fetch_add(p, v, __ATOMIC_RELAXED, __HIP_MEMORY_SCOPE_AGENT); }
__device__ __forceinline__ unsigned xb_xcc_id() { return (unsigned)__builtin_amdgcn_s_getreg((3 << 11) | 20) & 0xFu; }
#define XB_SPIN(cond, bar) do { unsigned _sp = 0; while (cond) { __builtin_amdgcn_s_sleep(1); \
    if ((++_sp & 255u) == 0u) { if (xb_ld(&(bar)[XB_TMO])) break; if (_sp > XB_SPIN_CAP) { atomicAdd(&(bar)[XB_TMO], 1u); break; } } } } while (0)
struct XcdBarrier { unsigned* bar; unsigned x; volatile LAS unsigned* st; };
__device__ __forceinline__ XcdBarrier xcd_barrier_post(unsigned* bar, volatile LAS unsigned* st) {
    XcdBarrier b; b.bar = bar; b.x = xb_xcc_id(); b.st = st;
    if (threadIdx.x == 0) (void)xb_add(&bar[XB_XCNT(b.x)], 1u);
    return b;
}
__device__ __forceinline__ void xcd_barrier_complete(unsigned* bar, unsigned x, unsigned& nloc, unsigned& nx) {
    const unsigned G = gridDim.x * gridDim.y * gridDim.z;
    unsigned sum, cnt, mine, sp = 0u;
    for (;;) {
        sum = 0u; cnt = 0u; mine = 0u;
#pragma unroll
        for (unsigned j = 0; j < 16; ++j) { const unsigned c = xb_ld(&bar[XB_XCNT(j)]); sum += c; cnt += (c > 0u) ? 1u : 0u; mine = (j == x) ? c : mine; }
        if (sum == G) break;
        __builtin_amdgcn_s_sleep(1);
        if ((++sp & 255u) == 0u) { if (xb_ld(&bar[XB_TMO])) break; if (sp > XB_SPIN_CAP) { atomicAdd(&bar[XB_TMO], 1u); break; } }
    }
    nloc = mine > 0u ? mine : 1u; nx = cnt > 0u ? cnt : 1u;
}
__device__ __forceinline__ void xcd_barrier(const XcdBarrier& b) {
    asm volatile("s_waitcnt vmcnt(0)" ::: "memory");
    __syncthreads();
    if (threadIdx.x == 0) {
        unsigned* bar = b.bar;
        __builtin_amdgcn_s_waitcnt(0);
        unsigned nloc = b.st[0], nx = b.st[1];
        if (nloc == 0u) { xcd_barrier_complete(bar, b.x, nloc, nx); b.st[0] = nloc; b.st[1] = nx; }
        const unsigned old = xb_add(&bar[XB_XSUB(b.x)], 1u);
        const unsigned gen = old / nloc;
        if (old + 1u == (gen + 1u) * nloc) {
            __builtin_amdgcn_fence(__ATOMIC_RELEASE, "agent");
            asm volatile("s_waitcnt vmcnt(0)" ::: "memory");
            const unsigned og = xb_add(&bar[XB_TOP], 1u);
            const unsigned tg = og / nx;
            if (og + 1u == (tg + 1u) * nx) xb_add(&bar[XB_TOPGEN], 1u);
            else XB_SPIN(xb_ld(&bar[XB_TOPGEN]) == tg, bar);
            __builtin_amdgcn_fence(__ATOMIC_ACQUIRE, "agent");
            xb_add(&bar[XB_XGEN(b.x)], 1u);
            asm volatile("s_waitcnt vmcnt(0)" ::: "memory");
        } else {
            XB_SPIN(xb_ld(&bar[XB_XGEN(b.x)]) == gen, bar);
            __builtin_amdgcn_fence(__ATOMIC_ACQUIRE, "agent");
            asm volatile("s_waitcnt vmcnt(0)" ::: "memory");
        }
    }
    __syncthreads();
}

namespace gm {
constexpr int BM = 256, BK = 64, HALF = 128, HTB = HALF * BK * 2, STAGE_BYTES = 8 * HTB, NXCD = 8, WGM = 8;
__host__ __device__ __forceinline__ int lds_byte(int r, int c) { const int st = (r >> 4) * 2 + (c >> 5), rr = r & 15, cc = c & 31, ob = rr * 64 + cc * 2; return st * 1024 + (ob ^ (((ob >> 9) & 1) << 5)); }
__host__ __device__ __forceinline__ void stage_rc(int b, int& R, int& C) { const int st = b / 1024, sb = b % 1024, swz = sb ^ (((sb >> 9) & 1) << 5); R = (st >> 1) * 16 + swz / 64; C = (st & 1) * 32 + (swz % 64) / 2; }
__host__ __device__ __forceinline__ int perm32(int rho) { const int n = rho >> 4, i = rho & 15; return 8 * (i >> 2) + 4 * n + (i & 3); }

struct Unit { const char* a; const char* b; int row0, col0, aux; };

struct DenseOrder {
    int nM, nN, nwg, G, c; const char* A; const char* B; size_t tA, tB;
    __device__ void init(const void* A_, const void* Bt_, int M, int N, int K, int G_, int c_) { nM = M / BM; nN = N / BM; nwg = nM * nN; G = G_; c = c_; A = (const char*)A_; B = (const char*)Bt_; tA = (size_t)BM * K * 2; tB = tA; }
    __device__ bool next(int i, Unit& u) const {
        const long L = (long)i * G + c; if (L >= nwg) return false;
        int wgid = (int)L; { const int q = nwg / NXCD, r = nwg % NXCD, xcd = wgid % NXCD, off = wgid / NXCD; wgid = (xcd < r ? xcd * (q + 1) : r * (q + 1) + (xcd - r) * q) + off; }
        const int nig = WGM * nN, gid = wgid / nig, fm = gid * WGM, gsz = (nM - fm) < WGM ? (nM - fm) : WGM;
        const int pm = fm + ((wgid % nig) % gsz), pn = (wgid % nig) / gsz;
        u.a = A + (size_t)pm * tA; u.b = B + (size_t)pn * tB; u.row0 = pm * BM; u.col0 = pn * BM; u.aux = 0; return true;
    }
    __device__ __forceinline__ void gather(const Unit&, unsigned (&)[2][2], const int (&)[2], const int (&)[2], int) const {}
};
struct MoeOrder {
    const int* tile_e; const int* tile_row0; const int* tile_nv; const int* slot_tok; int n_units, G, c, K; const char* A; const char* W; size_t wstride, tB; bool gath;
    __device__ bool next(int i, Unit& u) const {
        const int L = i * G + c; if (L >= n_units) return false;
        const int T = L >> 2, pn = L & 3;
        const int e = __builtin_amdgcn_readfirstlane(tile_e[T]), r0 = __builtin_amdgcn_readfirstlane(tile_row0[T]), nv = __builtin_amdgcn_readfirstlane(tile_nv[T]);
        u.a = gath ? A : A + (size_t)r0 * K * 2; u.b = W + (size_t)e * wstride + (size_t)pn * tB; u.row0 = r0; u.col0 = pn; u.aux = nv; return true;
    }
    __device__ __forceinline__ void gather(const Unit& u, unsigned (&vo)[2][2], const int (&sR)[2], const int (&sC)[2], int K_) const {
#pragma unroll
        for (int h = 0; h < 2; ++h)
#pragma unroll
            for (int i = 0; i < 2; ++i) { const int r = h * HALF + sR[i]; const int tok = (r < u.aux) ? slot_tok[u.row0 + r] : 0; vo[h][i] = (unsigned)(tok * K_ + sC[i]) * 2u; }
    }
};

template <class Epi, class Sched, bool GATHER>
__device__ __forceinline__ void gemm_phase(LAS unsigned char* lds, const int K, const Sched& S, const Epi& E) {
    int tz = threadIdx.x; asm volatile("" : "+v"(tz));
    const int tid = tz, wid = __builtin_amdgcn_readfirstlane(tid >> 6), lane = tid & 63, wr = wid >> 2, wc = wid & 3, fr = lane & 15, fq = lane >> 4;
    const int nt = K / BK;
    unsigned voffB[2], vA[2][2], vAn[2][2]; int sR[2], sC[2];
#pragma unroll
    for (int i = 0; i < 2; ++i) { int R, C; stage_rc(tid * 16 + i * 8192, R, C); const int Rb = Epi::PERM ? ((R & ~31) + perm32(R & 31)) : R;
        sR[i] = R; sC[i] = C; voffB[i] = (unsigned)(Rb * K + C) * 2u;
        vA[0][i] = (unsigned)(R * K + C) * 2u; vA[1][i] = (unsigned)((R + HALF) * K + C) * 2u; vAn[0][i] = vA[0][i]; vAn[1][i] = vA[1][i]; }
    const size_t kstep = (size_t)(BK * 2);
    const size_t hstep = (size_t)HALF * K * 2;
    const unsigned ldsw = (unsigned)wid * 1024u;
    const int aoff = lds_byte(wr * 64 + fr, fq * 8), boff = lds_byte(wc * 32 + fr, fq * 8);
#define PG8_SA(b, h) (((b) * 2 + (h)) * HTB)
#define PG8_SB(b, h) ((4 + (b) * 2 + (h)) * HTB)
#define PG8_STAGE(bufoff, gbase, voff) do { _Pragma("unroll") for (int _i = 0; _i < 2; ++_i) \
        __builtin_amdgcn_global_load_lds((const unsigned*)((const char*)(gbase) + (voff)[_i]), (LAS unsigned*)(lds + (bufoff) + ldsw + _i * 8192), 16, 0, 0); } while (0)
#define PG8_LDA(dst, b, h) do { _Pragma("unroll") for (int m = 0; m < 4; ++m) _Pragma("unroll") for (int k = 0; k < 2; ++k) dst[m][k] = *(const LAS bf16x8*)(lds + PG8_SA(b, h) + aoff + m * 2048 + k * 1024); } while (0)
#define PG8_LDB(dst, b, h) do { _Pragma("unroll") for (int n = 0; n < 2; ++n) _Pragma("unroll") for (int k = 0; k < 2; ++k) dst[n][k] = *(const LAS bf16x8*)(lds + PG8_SB(b, h) + boff + n * 2048 + k * 1024); } while (0)
#define PG8_MMA(ai, bj, At, Bt) do { __builtin_amdgcn_s_setprio(1); _Pragma("unroll") for (int m = 0; m < 4; ++m) _Pragma("unroll") for (int n = 0; n < 2; ++n) _Pragma("unroll") for (int k = 0; k < 2; ++k) \
        acc[ai][bj][m][n] = __builtin_amdgcn_mfma_f32_16x16x32_bf16(Bt[n][k], At[m][k], acc[ai][bj][m][n], 0, 0, 0); __builtin_amdgcn_s_setprio(0); } while (0)
#define PG8_WAIT_V(n) asm volatile("s_waitcnt vmcnt(" #n ")" ::: "memory")
#define PG8_WAIT_L(n) asm volatile("s_waitcnt lgkmcnt(" #n ")" ::: "memory")
#define PG8_BAR __builtin_amdgcn_s_barrier()
#define PG8_SCHED __builtin_amdgcn_sched_barrier(0)
    Unit cur, nxt; int ui = 0;
    if (!S.next(0, cur)) return;
    f32x4 acc[2][2][4][2];
#pragma unroll
    for (int a = 0; a < 2; ++a)
#pragma unroll
        for (int b = 0; b < 2; ++b)
#pragma unroll
            for (int m = 0; m < 4; ++m)
#pragma unroll
                for (int n = 0; n < 2; ++n) acc[a][b][m][n] = (f32x4){0.f, 0.f, 0.f, 0.f};
    bf16x8 At[4][2], B0[2][2], B1[2][2];
    const char* cA = cur.a; const char* cB = cur.b;
    if constexpr (GATHER) S.gather(cur, vA, sR, sC, K);
    PG8_STAGE(PG8_SB(0, 0), cB, voffB); PG8_STAGE(PG8_SB(0, 1), cB + hstep, voffB); PG8_STAGE(PG8_SA(0, 0), cA, vA[0]); PG8_STAGE(PG8_SA(0, 1), cA, vA[1]);
    if (wr == 1) PG8_BAR;
    PG8_WAIT_V(2); PG8_BAR;
    PG8_STAGE(PG8_SB(1, 0), cB + kstep, voffB); PG8_STAGE(PG8_SA(1, 0), cA + kstep, vA[0]); PG8_STAGE(PG8_SB(1, 1), cB + hstep + kstep, voffB);
    PG8_WAIT_V(6); PG8_BAR;
    for (;;) {
        const bool has_next = S.next(ui + 1, nxt);
        const char* nA = has_next ? nxt.a : cA; const char* nB = has_next ? nxt.b : cB;
        if constexpr (GATHER) {
            if (has_next) S.gather(nxt, vAn, sR, sC, K);
            else { vAn[0][0] = vA[0][0]; vAn[0][1] = vA[0][1]; vAn[1][0] = vA[1][0]; vAn[1][1] = vA[1][1]; }
        }
        for (int t = 0; t < nt; t += 2) {
            const bool last = (t == nt - 2);
            const char* a1 = cA + (size_t)(t + 1) * kstep;
            const char* a2 = last ? nA : cA + (size_t)(t + 2) * kstep; const char* b2 = last ? nB : cB + (size_t)(t + 2) * kstep;
            const char* a3 = a2 + kstep; const char* b3 = b2 + kstep;
            unsigned w0[2], w1[2];
            if constexpr (GATHER) { w0[0] = last ? vAn[0][0] : vA[0][0]; w0[1] = last ? vAn[0][1] : vA[0][1]; w1[0] = last ? vAn[1][0] : vA[1][0]; w1[1] = last ? vAn[1][1] : vA[1][1]; }
            else { w0[0] = vA[0][0]; w0[1] = vA[0][1]; w1[0] = vA[1][0]; w1[1] = vA[1][1]; }
            PG8_LDB(B0, 0, 0); PG8_LDB(B1, 0, 1); PG8_SCHED; PG8_LDA(At, 0, 0); PG8_STAGE(PG8_SA(1, 1), a1, vA[1]);
            PG8_WAIT_V(8); PG8_WAIT_L(0); PG8_BAR; PG8_MMA(0, 0, At, B0); PG8_MMA(0, 1, At, B1); PG8_BAR; PG8_SCHED;
            PG8_LDA(At, 0, 1); PG8_STAGE(PG8_SB(0, 0), b2, voffB); PG8_STAGE(PG8_SB(0, 1), b2 + hstep, voffB); PG8_STAGE(PG8_SA(0, 0), a2, w0);
            PG8_WAIT_V(8); PG8_WAIT_L(0); PG8_BAR; PG8_MMA(1, 0, At, B0); PG8_MMA(1, 1, At, B1); PG8_BAR; PG8_SCHED;
            PG8_LDB(B0, 1, 0); PG8_LDB(B1, 1, 1); PG8_SCHED; PG8_LDA(At, 1, 0); PG8_STAGE(PG8_SA(0, 1), a2, w1);
            PG8_WAIT_V(8); PG8_WAIT_L(0); PG8_BAR; PG8_MMA(0, 0, At, B0); PG8_MMA(0, 1, At, B1); PG8_BAR; PG8_SCHED;
            PG8_LDA(At, 1, 1); PG8_STAGE(PG8_SB(1, 0), b3, voffB); PG8_STAGE(PG8_SB(1, 1), b3 + hstep, voffB); PG8_STAGE(PG8_SA(1, 0), a3, w0);
            PG8_WAIT_V(8); PG8_WAIT_L(0); PG8_BAR; PG8_MMA(1, 0, At, B0); PG8_MMA(1, 1, At, B1); PG8_BAR; PG8_SCHED;
        }
        if (wr == 0) PG8_BAR;
        E(acc, cur, wr, wc, fr, fq);
        if (!has_next) break;
#pragma unroll
        for (int a = 0; a < 2; ++a)
#pragma unroll
            for (int b = 0; b < 2; ++b)
#pragma unroll
                for (int m = 0; m < 4; ++m)
#pragma unroll
                    for (int n = 0; n < 2; ++n) acc[a][b][m][n] = (f32x4){0.f, 0.f, 0.f, 0.f};
        cur = nxt; cA = nA; cB = nB; ++ui;
        if constexpr (GATHER) { vA[0][0] = vAn[0][0]; vA[0][1] = vAn[0][1]; vA[1][0] = vAn[1][0]; vA[1][1] = vAn[1][1]; }
        if (wr == 1) PG8_BAR;
    }
    PG8_WAIT_V(0);
    PG8_BAR;
#undef PG8_SA
#undef PG8_SB
#undef PG8_STAGE
#undef PG8_LDA
#undef PG8_LDB
#undef PG8_MMA
#undef PG8_WAIT_V
#undef PG8_WAIT_L
#undef PG8_BAR
#undef PG8_SCHED
}

#define EPI_ROWS(u, ai, m) ((u).row0 + (ai) * HALF + wr * 64 + (m) * 16 + fr)
struct EpiBf16 {
    static constexpr bool PERM = true;
    bf16* O; int ldc; float* iw;
    __device__ __forceinline__ void operator()(const f32x4 (&acc)[2][2][4][2], const Unit& u, int wr, int wc, int fr, int fq) const {
#pragma unroll
        for (int ai = 0; ai < 2; ++ai)
#pragma unroll
            for (int m = 0; m < 4; ++m) { const int row = EPI_ROWS(u, ai, m); bf16* rowp = O + (size_t)row * ldc + u.col0 + wc * 32 + 8 * fq;
#pragma unroll
                for (int bj = 0; bj < 2; ++bj) { const f32x4 v0 = acc[ai][bj][m][0], v1 = acc[ai][bj][m][1];
                    u32x4 w; w.x = cvt_pk_bf16(v0[0], v0[1]); w.y = cvt_pk_bf16(v0[2], v0[3]); w.z = cvt_pk_bf16(v1[0], v1[1]); w.w = cvt_pk_bf16(v1[2], v1[3]);
                    *(u32x4*)(rowp + bj * HALF) = w; }
                if (iw != nullptr && u.col0 == 1792 && wc == 2 && fq == 0) *(f32x4*)(iw + (size_t)row * 4) = acc[ai][0][m][0] * 0.0625f; }
    }
};
struct EpiResid {
    static constexpr bool PERM = false;
    const float* h; float* t;
    __device__ __forceinline__ void operator()(const f32x4 (&acc)[2][2][4][2], const Unit& u, int wr, int wc, int fr, int fq) const {
#pragma unroll
        for (int ai = 0; ai < 2; ++ai)
#pragma unroll
            for (int m = 0; m < 4; ++m) { const size_t o = (size_t)EPI_ROWS(u, ai, m) * D_MODEL + u.col0 + wc * 32 + 4 * fq;
#pragma unroll
                for (int bj = 0; bj < 2; ++bj)
#pragma unroll
                    for (int n = 0; n < 2; ++n) { const size_t oo = o + bj * HALF + n * 16; const f32x4 hv = *(const f32x4*)(h + oo); *(f32x4*)(t + oo) = hv * ALPHA_F + acc[ai][bj][m][n]; } }
    }
};
struct EpiPle {
    static constexpr bool PERM = false;
    const float* h; const bf16* pl; float* t;
    __device__ __forceinline__ void operator()(const f32x4 (&acc)[2][2][4][2], const Unit& u, int wr, int wc, int fr, int fq) const {
#pragma unroll
        for (int ai = 0; ai < 2; ++ai)
#pragma unroll
            for (int m = 0; m < 4; ++m) { const size_t o = (size_t)EPI_ROWS(u, ai, m) * D_MODEL + u.col0 + wc * 32 + 4 * fq;
#pragma unroll
                for (int bj = 0; bj < 2; ++bj)
#pragma unroll
                    for (int n = 0; n < 2; ++n) { const size_t oo = o + bj * HALF + n * 16; const f32x4 hv = *(const f32x4*)(h + oo); const u32x2 pv = *(const u32x2*)(pl + oo);
                        const f32x4 a = acc[ai][bj][m][n]; f32x4 r;
                        r[0] = fmaf(hv[0], ALPHA_F, bflo(pv.x) * __builtin_amdgcn_rcpf(1.f + __builtin_amdgcn_exp2f(a[0] * -1.4426950408889634f))); r[1] = fmaf(hv[1], ALPHA_F, bfhi(pv.x) * __builtin_amdgcn_rcpf(1.f + __builtin_amdgcn_exp2f(a[1] * -1.4426950408889634f)));
                        r[2] = fmaf(hv[2], ALPHA_F, bflo(pv.y) * __builtin_amdgcn_rcpf(1.f + __builtin_amdgcn_exp2f(a[2] * -1.4426950408889634f))); r[3] = fmaf(hv[3], ALPHA_F, bfhi(pv.y) * __builtin_amdgcn_rcpf(1.f + __builtin_amdgcn_exp2f(a[3] * -1.4426950408889634f)));
                        *(f32x4*)(t + oo) = r; } }
    }
};
struct EpiSwiglu {
    static constexpr bool PERM = true;
    bf16* act;
    __device__ __forceinline__ void operator()(const f32x4 (&acc)[2][2][4][2], const Unit& u, int wr, int wc, int fr, int fq) const {
#pragma unroll
        for (int ai = 0; ai < 2; ++ai)
#pragma unroll
            for (int m = 0; m < 4; ++m) { const int row = EPI_ROWS(u, ai, m); float r[8];
#pragma unroll
                for (int n = 0; n < 2; ++n)
#pragma unroll
                    for (int j = 0; j < 4; ++j) { const float g = acc[ai][0][m][n][j], uu = acc[ai][1][m][n][j]; r[n * 4 + j] = g * __builtin_amdgcn_rcpf(1.f + __builtin_amdgcn_exp2f(g * -1.4426950408889634f)) * uu; }
                u32x4 w; w.x = cvt_pk_bf16(r[0], r[1]); w.y = cvt_pk_bf16(r[2], r[3]); w.z = cvt_pk_bf16(r[4], r[5]); w.w = cvt_pk_bf16(r[6], r[7]);
                *(u32x4*)(act + (size_t)row * D_EXPERT + u.col0 * 128 + wc * 32 + 8 * fq) = w; }
    }
};
struct EpiMoeDown {
    static constexpr bool PERM = true;
    bf16* Y;
    __device__ __forceinline__ void operator()(const f32x4 (&acc)[2][2][4][2], const Unit& u, int wr, int wc, int fr, int fq) const {
#pragma unroll
        for (int ai = 0; ai < 2; ++ai)
#pragma unroll
            for (int m = 0; m < 4; ++m) { const int row = EPI_ROWS(u, ai, m); bf16* rowp = Y + (size_t)row * D_MODEL + u.col0 * 256 + wc * 32 + 8 * fq;
#pragma unroll
                for (int bj = 0; bj < 2; ++bj) { const f32x4 v0 = acc[ai][bj][m][0], v1 = acc[ai][bj][m][1];
                    u32x4 w; w.x = cvt_pk_bf16(v0[0], v0[1]); w.y = cvt_pk_bf16(v0[2], v0[3]); w.z = cvt_pk_bf16(v1[0], v1[1]); w.w = cvt_pk_bf16(v1[2], v1[3]);
                    *(u32x4*)(rowp + bj * HALF) = w; } }
    }
};
}

struct Params { const float* in[18]; float* out; unsigned char* ws; int ph_lo, ph_hi, bar_idx, pad; };
typedef const Params __attribute__((address_space(4)))* KP;
__device__ __forceinline__ KP fresh_params() { KP p = (KP)__builtin_amdgcn_kernarg_segment_ptr(); asm volatile("" : "+s"(p)); return p; }

__device__ __forceinline__ void tr_item(const float* W, int K, int N, bf16* WT, int row_off, LAS float* scr, int kb, int nb, int lane) {
    const int k0 = 64 * kb, n0 = 32 * nb;
    const bool ok = (n0 + (lane & 31)) < N;
    if (n0 + 32 <= N) {
        const int kr = lane >> 3, c4 = (lane & 7) * 4;
#pragma unroll
        for (int i = 0; i < 8; ++i) { const int kk = 8 * i + kr; const f32x4 v = *(const f32x4*)(W + (size_t)(k0 + kk) * N + n0 + c4);
            LAS float* d = scr + kk * 33 + c4; d[0] = v[0]; d[1] = v[1]; d[2] = v[2]; d[3] = v[3]; }
    } else {
#pragma unroll 8
        for (int i = 0; i < 32; ++i) { const int kk = 2 * i + (lane >> 5); scr[kk * 33 + (lane & 31)] = ok ? W[(size_t)(k0 + kk) * N + n0 + (lane & 31)] : 0.f; }
    }
    asm volatile("s_waitcnt lgkmcnt(0)" ::: "memory");
    const int c = lane & 7;
#pragma unroll
    for (int j = 0; j < 4; ++j) { const int n = (lane >> 3) + 8 * j; const LAS float* s = scr + (8 * c) * 33 + n;
        u32x4 o; o.x = cvt_pk_bf16(s[0 * 33], s[1 * 33]); o.y = cvt_pk_bf16(s[2 * 33], s[3 * 33]); o.z = cvt_pk_bf16(s[4 * 33], s[5 * 33]); o.w = cvt_pk_bf16(s[6 * 33], s[7 * 33]);
        *(u32x4*)(WT + (size_t)(row_off + n0 + n) * K + k0 + 8 * c) = o; }
    asm volatile("s_waitcnt lgkmcnt(0)" ::: "memory");
}
__device__ __forceinline__ void cvt_rows(const float* src, bf16* dst, size_t n4, int gtid, int gthreads) {
    for (size_t i = gtid; i < n4; i += gthreads) { const f32x4 v = *(const f32x4*)(src + i * 4); u32x2 o; o.x = cvt_pk_bf16(v[0], v[1]); o.y = cvt_pk_bf16(v[2], v[3]); *(u32x2*)(dst + i * 4) = o; }
}
__device__ __forceinline__ void phase_convert(KP P, int L, LAS unsigned char* lds) {
    int tz = threadIdx.x; asm volatile("" : "+v"(tz));
    const int tid = tz, lane = tid & 63, wave = tid >> 6;
    LAS float* scr = (LAS float*)(lds + wave * 16384);
    const int gw = blockIdx.x * NWAVES + wave, NGW = gridDim.x * NWAVES;
    unsigned char* ws = P->ws;
    bf16* wmix = (bf16*)(ws + WS_WMIX); bf16* wo_t = (bf16*)(ws + WS_WMIX + 4 * MiB); bf16* wkv_t = (bf16*)(ws + WS_WMIX + 6 * MiB);
    bf16* wpg_t = (bf16*)(ws + WS_WPG); bf16* wple_t = (bf16*)(ws + WS_WPLE); bf16* wgu_t = (bf16*)(ws + WS_WGU); bf16* wd_t = (bf16*)(ws + WS_WD);
    const bool isA = L < N_A; const int j = L - N_A;
    const float* w_first = isA ? P->in[2] + (size_t)L * D_MODEL * A_COLS : P->in[5] + (size_t)j * D_MODEL * D_MODEL;
    const int n_first = isA ? A_COLS : D_MODEL, nb_first = isA ? 64 : 32;
    const float* w_o = isA ? P->in[3] + (size_t)L * D_MODEL * D_MODEL : P->in[6] + (size_t)j * D_MODEL * D_MODEL;
    const int I_FIRST = 16 * nb_first, I_O = 16 * 32, I_KV = (L == N_A) ? 16 * 16 : 0, I_PG = 16 * 32, I_PLE = 4 * 32, I_G = 32 * 256, I_U = 32 * 256, I_D = 32 * 256;
    const int NITEMS = I_FIRST + I_O + I_KV + I_PG + I_PLE + I_G + I_U + I_D;
    const size_t wsz = (size_t)D_MODEL * D_EXPERT;
    for (int it = gw; it < NITEMS; it += NGW) {
        int r = it;
        if (r < I_FIRST) { tr_item(w_first, D_MODEL, n_first, wmix, 0, scr, r / nb_first, r % nb_first, lane); continue; } r -= I_FIRST;
        if (r < I_O) { tr_item(w_o, D_MODEL, D_MODEL, wo_t, 0, scr, r / 32, r % 32, lane); continue; } r -= I_O;
        if (r < I_KV) { tr_item(P->in[4], D_MODEL, 512, wkv_t, 0, scr, r / 16, r % 16, lane); continue; } r -= I_KV;
        if (r < I_PG) { tr_item(P->in[15] + (size_t)L * D_MODEL * D_MODEL, D_MODEL, D_MODEL, wpg_t, 0, scr, r / 32, r % 32, lane); continue; } r -= I_PG;
        if (r < I_PLE) { tr_item(P->in[14] + (size_t)L * PLE_DIM * D_MODEL, PLE_DIM, D_MODEL, wple_t, 0, scr, r / 32, r % 32, lane); continue; } r -= I_PLE;
        if (r < I_G + I_U) {
            const bool up = r >= I_G; if (up) r -= I_G;
            const int e = r >> 8, rem = r & 255, kb = rem >> 4, nb = rem & 15, n0 = nb * 32;
            const float* W = (up ? P->in[12] : P->in[11]) + ((size_t)L * N_EXPERTS + e) * wsz;
            const int row_off = (n0 >> 7) * 256 + (up ? 128 : 0) + (n0 & 127) - n0;
            tr_item(W, D_MODEL, D_EXPERT, wgu_t + (size_t)e * D_MODEL * D_MODEL, row_off, scr, kb, nb, lane); continue; }
        r -= I_G + I_U;
        { const int e = r >> 8, rem = r & 255, kb = rem >> 5, nb = rem & 31;
          tr_item(P->in[13] + ((size_t)L * N_EXPERTS + e) * wsz, D_EXPERT, D_MODEL, wd_t + (size_t)e * wsz, 0, scr, kb, nb, lane); }
    }
    const int gtid = blockIdx.x * 512 + tid, gthreads = gridDim.x * 512;
    cvt_rows(P->in[1] + (size_t)L * NTOK * PLE_DIM, (bf16*)(ws + WS_PB), (size_t)NTOK * PLE_DIM / 4, gtid, gthreads);
    if (L == 0) cvt_rows(P->in[0], (bf16*)(ws + WS_HB), (size_t)NTOK * D_MODEL / 4, gtid, gthreads);
}

template <int SRC, bool ROUTER>
__device__ __forceinline__ void phase_ln(KP P, int L, int which, LAS unsigned char* lds, float* dst_f32, bool write_hb, int cidx = -1) {
    int tz = threadIdx.x; asm volatile("" : "+v"(tz));
    const int tid = tz, lane = tid & 63, wave = tid >> 6;
    unsigned char* ws = P->ws;
    const float* t = (const float*)(ws + WS_T); const float* h = (const float*)(ws + WS_H); bf16* hb = (bf16*)(ws + WS_HB);
    const bf16* Y = (const bf16*)(ws + WS_Y);
    int* moe = (int*)(ws + WS_MOE);
    const float* g = P->in[16] + (size_t)(L * 3 + which) * D_MODEL; const float* bt = P->in[17] + (size_t)(L * 3 + which) * D_MODEL;
    LAS float* Wl = (LAS float*)lds;
    LAS float* lgs = (LAS float*)(lds + 147456) + wave * 40;
    if (ROUTER) {
        const float* wrg = P->in[7] + (size_t)L * D_MODEL * N_GROUPS; const float* wre = P->in[9] + (size_t)L * D_MODEL * N_EXPERTS;
        for (int i = tid; i < D_MODEL * 36; i += 512) { const int k = i / 36, c = i % 36; Wl[c * D_MODEL + k] = (c < 4) ? wrg[k * 4 + c] : wre[k * 32 + (c - 4)]; }
        __syncthreads();
    }
    f32x4 gv[4], bv[4];
#pragma unroll
    for (int j = 0; j < 4; ++j) { gv[j] = *(const f32x4*)(g + 4 * lane + 256 * j); bv[j] = *(const f32x4*)(bt + 4 * lane + 256 * j); }
    const int gw = blockIdx.x * NWAVES + wave, NGW = gridDim.x * NWAVES;
    for (int row = gw; row < NTOK; row += NGW) {
        f32x4 v[4];
        if (SRC == 0) {
#pragma unroll
            for (int j = 0; j < 4; ++j) v[j] = *(const f32x4*)(t + (size_t)row * D_MODEL + 4 * lane + 256 * j);
        } else {
            const int s0 = moe[MO_TOK_SLOT + row * 2], s1 = moe[MO_TOK_SLOT + row * 2 + 1];
            const float w0 = ((const float*)moe)[MO_TOK_W + row * 2], w1 = ((const float*)moe)[MO_TOK_W + row * 2 + 1];
#pragma unroll
            for (int j = 0; j < 4; ++j) {
                const f32x4 hv = *(const f32x4*)(h + (size_t)row * D_MODEL + 4 * lane + 256 * j);
                const u32x2 y0 = *(const u32x2*)(Y + (size_t)s0 * D_MODEL + 4 * lane + 256 * j), y1 = *(const u32x2*)(Y + (size_t)s1 * D_MODEL + 4 * lane + 256 * j);
                v[j][0] = hv[0] * ALPHA_F + (w0 * bflo(y0.x) + w1 * bflo(y1.x)); v[j][1] = hv[1] * ALPHA_F + (w0 * bfhi(y0.x) + w1 * bfhi(y1.x));
                v[j][2] = hv[2] * ALPHA_F + (w0 * bflo(y0.y) + w1 * bflo(y1.y)); v[j][3] = hv[3] * ALPHA_F + (w0 * bfhi(y0.y) + w1 * bfhi(y1.y));
            }
        }
        float s = 0.f;
#pragma unroll
        for (int j = 0; j < 4; ++j) s += (v[j][0] + v[j][1]) + (v[j][2] + v[j][3]);
        const float mean = wave_sum(s) * (1.f / D_MODEL);
        float q = 0.f;
#pragma unroll
        for (int j = 0; j < 4; ++j) { v[j] = v[j] - mean; q += (v[j][0] * v[j][0] + v[j][1] * v[j][1]) + (v[j][2] * v[j][2] + v[j][3] * v[j][3]); }
        const float rstd = rsqrtf(wave_sum(q) * (1.f / D_MODEL) + LN_EPS);
#pragma unroll
        for (int j = 0; j < 4; ++j) { v[j] = v[j] * rstd * gv[j] + bv[j]; *(f32x4*)(dst_f32 + (size_t)row * D_MODEL + 4 * lane + 256 * j) = v[j]; }
        if (write_hb) {
#pragma unroll
            for (int j = 0; j < 4; ++j) { u32x2 o; o.x = cvt_pk_bf16(v[j][0], v[j][1]); o.y = cvt_pk_bf16(v[j][2], v[j][3]); *(u32x2*)(hb + (size_t)row * D_MODEL + 4 * lane + 256 * j) = o; }
        }
        if (ROUTER) {
            float lg[36];
#pragma unroll
            for (int c = 0; c < 36; ++c) {
                float a = 0.f;
#pragma unroll
                for (int j = 0; j < 4; ++j) { const f32x4 w = *(const LAS f32x4*)(Wl + c * D_MODEL + 4 * lane + 256 * j); a += (v[j][0] * w[0] + v[j][1] * w[1]) + (v[j][2] * w[2] + v[j][3] * w[3]); }
                lg[c] = wave_sum(a);
            }
            if (lane == 0) {
                const float* brg = P->in[8] + L * N_GROUPS; const float* bre = P->in[10] + L * N_EXPERTS;
                float gl[4];
#pragma unroll
                for (int jj = 0; jj < 4; ++jj) gl[jj] = lg[jj] + brg[jj];
                int gs = 0; float gmax = gl[0];
#pragma unroll
                for (int jj = 1; jj < 4; ++jj) if (gl[jj] > gmax) { gmax = gl[jj]; gs = jj; }
                float den = 0.f;
#pragma unroll
                for (int jj = 0; jj < 4; ++jj) den += expf(gl[jj] - gmax);
                const float gwt = 1.f / den;
                float el[8];
#pragma unroll
                for (int jj = 0; jj < 8; ++jj) el[jj] = 0.f;
#pragma unroll
                for (int c = 0; c < 32; ++c) { if ((c >> 3) == gs) el[c & 7] = lg[4 + c] + bre[c]; }
                int i0 = 0; float v0 = el[0];
#pragma unroll
                for (int jj = 1; jj < 8; ++jj) if (el[jj] > v0) { v0 = el[jj]; i0 = jj; }
                int i1 = -1; float v1 = 0.f;
#pragma unroll
                for (int jj = 0; jj < 8; ++jj) if (jj != i0 && (i1 < 0 || el[jj] > v1)) { v1 = el[jj]; i1 = jj; }
                const float e1 = expf(v1 - v0);
                const float w0 = gwt / (1.f + e1), w1 = gwt * e1 / (1.f + e1);
                const int ea = gs * 8 + i0, eb = gs * 8 + i1;
                unsigned* cnt = (unsigned*)(ws + WS_CTL) + CW_CNT + (cidx < 0 ? L : cidx) * 32;
                const int pa = (int)atomicAdd(&cnt[ea], 1u), pb = (int)atomicAdd(&cnt[eb], 1u);
                moe[MO_TOK_E + row * 2] = ea; moe[MO_TOK_E + row * 2 + 1] = eb; moe[MO_TOK_POS + row * 2] = pa; moe[MO_TOK_POS + row * 2 + 1] = pb;
                ((float*)moe)[MO_TOK_W + row * 2] = w0; ((float*)moe)[MO_TOK_W + row * 2 + 1] = w1;
            }
        }
    }
    (void)lgs;
}


__device__ __forceinline__ void phase_ln_router(KP P, int L, LAS unsigned char* lds, int cidx) {
    int tz = threadIdx.x; asm volatile("" : "+v"(tz)); const int tid = tz, lane = tid & 63, wave = tid >> 6;
    unsigned char* ws = P->ws;
    const float* t = (const float*)(ws + WS_T); float* h = (float*)(ws + WS_H); bf16* hb = (bf16*)(ws + WS_HB);
    int* moe = (int*)(ws + WS_MOE);
    const float* g = P->in[16] + (size_t)(L * 3) * D_MODEL; const float* bt = P->in[17] + (size_t)(L * 3) * D_MODEL;
    LAS float* Wl = (LAS float*)lds;
    LAS float* lgs = (LAS float*)(lds + 147456) + wave * 80;
    LAS int* lcnt = (LAS int*)(lds + 150016);
    LAS int* rinfo = (LAS int*)(lds + 150272);
    { const float* wrg = P->in[7] + (size_t)L * D_MODEL * N_GROUPS; const float* wre = P->in[9] + (size_t)L * D_MODEL * N_EXPERTS;
      for (int i = tid; i < D_MODEL * 36; i += 512) { const int k = i / 36, c = i - k * 36; Wl[c * D_MODEL + k] = (c < 4) ? wrg[k * 4 + c] : wre[k * 32 + (c - 4)]; }
      if (tid < 64) lcnt[tid] = 0; }
    __syncthreads();
    f32x4 gv[4], bv[4];
#pragma unroll
    for (int j = 0; j < 4; ++j) { gv[j] = *(const f32x4*)(g + 4 * lane + 256 * j); bv[j] = *(const f32x4*)(bt + 4 * lane + 256 * j); }
    const float* brg = P->in[8] + L * N_GROUPS; const float* bre = P->in[10] + L * N_EXPERTS;
    const int gw = blockIdx.x * NWAVES + wave, NGW = gridDim.x * NWAVES;
    int it = 0;
    for (int pi = gw; pi < NTOK / 2; pi += NGW, ++it) {
        const int row0 = pi * 2;
        f32x4 va[4], vb[4];
#pragma unroll
        for (int j = 0; j < 4; ++j) { va[j] = *(const f32x4*)(t + (size_t)row0 * D_MODEL + 4 * lane + 256 * j); vb[j] = *(const f32x4*)(t + (size_t)(row0 + 1) * D_MODEL + 4 * lane + 256 * j); }
        float sa = 0.f, sb = 0.f;
#pragma unroll
        for (int j = 0; j < 4; ++j) { sa += (va[j][0] + va[j][1]) + (va[j][2] + va[j][3]); sb += (vb[j][0] + vb[j][1]) + (vb[j][2] + vb[j][3]); }
        const float ma = wave_sum(sa) * (1.f / D_MODEL), mb_ = wave_sum(sb) * (1.f / D_MODEL);
        float qa = 0.f, qb = 0.f;
#pragma unroll
        for (int j = 0; j < 4; ++j) { va[j] = va[j] - ma; vb[j] = vb[j] - mb_;
            qa += (va[j][0] * va[j][0] + va[j][1] * va[j][1]) + (va[j][2] * va[j][2] + va[j][3] * va[j][3]);
            qb += (vb[j][0] * vb[j][0] + vb[j][1] * vb[j][1]) + (vb[j][2] * vb[j][2] + vb[j][3] * vb[j][3]); }
        const float ra = rsqrtf(wave_sum(qa) * (1.f / D_MODEL) + LN_EPS), rb = rsqrtf(wave_sum(qb) * (1.f / D_MODEL) + LN_EPS);
#pragma unroll
        for (int j = 0; j < 4; ++j) { va[j] = va[j] * ra * gv[j] + bv[j]; vb[j] = vb[j] * rb * gv[j] + bv[j];
            *(f32x4*)(h + (size_t)row0 * D_MODEL + 4 * lane + 256 * j) = va[j]; *(f32x4*)(h + (size_t)(row0 + 1) * D_MODEL + 4 * lane + 256 * j) = vb[j];
            u32x2 oa, ob; oa.x = cvt_pk_bf16(va[j][0], va[j][1]); oa.y = cvt_pk_bf16(va[j][2], va[j][3]); ob.x = cvt_pk_bf16(vb[j][0], vb[j][1]); ob.y = cvt_pk_bf16(vb[j][2], vb[j][3]);
            *(u32x2*)(hb + (size_t)row0 * D_MODEL + 4 * lane + 256 * j) = oa; *(u32x2*)(hb + (size_t)(row0 + 1) * D_MODEL + 4 * lane + 256 * j) = ob; }
#pragma unroll
        for (int p = 0; p < 18; ++p) {
            f32x2 a0 = {0.f, 0.f}, a1 = {0.f, 0.f};
#pragma unroll
            for (int j = 0; j < 4; ++j) { const f32x4 w0 = *(const LAS f32x4*)(Wl + (2 * p) * D_MODEL + 4 * lane + 256 * j), w1 = *(const LAS f32x4*)(Wl + (2 * p + 1) * D_MODEL + 4 * lane + 256 * j);
#pragma unroll
                for (int i = 0; i < 4; ++i) { const f32x2 y = {va[j][i], vb[j][i]}; a0 = a0 + y * w0[i]; a1 = a1 + y * w1[i]; } }
            float ra2[2];
#pragma unroll
            for (int rr = 0; rr < 2; ++rr) {
                auto sw = __builtin_amdgcn_permlane32_swap(__float_as_uint(rr ? a0.y : a0.x), __float_as_uint(rr ? a1.y : a1.x), false, false);
                float v = __uint_as_float(sw[0]) + __uint_as_float(sw[1]);
                v = row16_sum(v); v += __shfl_xor(v, 16); ra2[rr] = v; }
            if ((lane & 31) == 0) { const int ci = 2 * p + (lane >> 5); lgs[ci] = ra2[0]; lgs[40 + ci] = ra2[1]; }
            __builtin_amdgcn_sched_barrier(0);
        }
        asm volatile("s_waitcnt lgkmcnt(0)" ::: "memory");
        if (lane == 0 || lane == 32) {
            const int rr = lane >> 5; LAS float* lg = lgs + rr * 40;
            float gl[4];
#pragma unroll
            for (int jj = 0; jj < 4; ++jj) gl[jj] = lg[jj] + brg[jj];
            int gs = 0; float gmax = gl[0];
#pragma unroll
            for (int jj = 1; jj < 4; ++jj) if (gl[jj] > gmax) { gmax = gl[jj]; gs = jj; }
            float den = 0.f;
#pragma unroll
            for (int jj = 0; jj < 4; ++jj) den += expf(gl[jj] - gmax);
            const float gwt = 1.f / den;
            float el[8];
#pragma unroll
            for (int jj = 0; jj < 8; ++jj) el[jj] = lg[4 + gs * 8 + jj] + bre[gs * 8 + jj];
            int i0 = 0; float v0 = el[0];
#pragma unroll
            for (int jj = 1; jj < 8; ++jj) if (el[jj] > v0) { v0 = el[jj]; i0 = jj; }
            int i1 = -1; float v1 = 0.f;
#pragma unroll
            for (int jj = 0; jj < 8; ++jj) if (jj != i0 && (i1 < 0 || el[jj] > v1)) { v1 = el[jj]; i1 = jj; }
            const float e1 = expf(v1 - v0);
            const float w0 = gwt / (1.f + e1), w1 = gwt * e1 / (1.f + e1);
            const int ea = gs * 8 + i0, eb = gs * 8 + i1;
            const int pa = __hip_atomic_fetch_add(lcnt + ea, 1, __ATOMIC_RELAXED, __HIP_MEMORY_SCOPE_WORKGROUP), pb2 = __hip_atomic_fetch_add(lcnt + eb, 1, __ATOMIC_RELAXED, __HIP_MEMORY_SCOPE_WORKGROUP);
            LAS int* ri = rinfo + ((it * NWAVES + wave) * 2 + rr) * 5;
            ri[0] = ea | (eb << 8); ri[1] = pa; ri[2] = pb2; ri[3] = __float_as_int(w0); ri[4] = __float_as_int(w1);
        }
    }
    __syncthreads();
    if (tid < 32) { const int n = lcnt[tid]; unsigned* cnt = (unsigned*)(ws + WS_CTL) + CW_CNT + cidx * 32; lcnt[32 + tid] = n ? (int)atomicAdd(&cnt[tid], (unsigned)n) : 0; }
    __syncthreads();
    for (int sl = tid; sl < it * NWAVES * 2; sl += 512) {
        const int i2 = sl / (NWAVES * 2), w2 = (sl >> 1) & (NWAVES - 1), rr = sl & 1;
        const int row = ((blockIdx.x * NWAVES + w2) + i2 * NGW) * 2 + rr;
        if (row < NTOK) { const LAS int* ri = rinfo + sl * 5; const int ea = ri[0] & 255, eb = ri[0] >> 8;
            moe[MO_TOK_E + row * 2] = ea; moe[MO_TOK_E + row * 2 + 1] = eb; moe[MO_TOK_POS + row * 2] = lcnt[32 + ea] + ri[1]; moe[MO_TOK_POS + row * 2 + 1] = lcnt[32 + eb] + ri[2];
            moe[MO_TOK_W + row * 2] = ri[3]; moe[MO_TOK_W + row * 2 + 1] = ri[4]; }
    }
}

__device__ __forceinline__ void phase_moe_prep(KP P, int L, LAS unsigned char* lds) {
    int tz = threadIdx.x; asm volatile("" : "+v"(tz));
    const int tid = tz;
    unsigned char* ws = P->ws; int* moe = (int*)(ws + WS_MOE);
    const unsigned* cnt = (const unsigned*)(ws + WS_CTL) + CW_CNT + L * 32;
    LAS int* sb = (LAS int*)lds;
    LAS int* sc = (LAS int*)lds + 64;
    if (tid < 32) sc[tid] = (int)cnt[tid];
    __syncthreads();
    if (tid == 0) { int s = 0; for (int e = 0; e < N_EXPERTS; ++e) { sb[e] = s; s += (sc[e] + 255) / 256 * 256; } sb[N_EXPERTS] = s; }
    __syncthreads();
    const int ntiles = sb[N_EXPERTS] / 256;
    if (blockIdx.x == 0) {
        if (tid == 0) *((unsigned*)(ws + WS_CTL) + CW_NTILES + L) = (unsigned)ntiles;
        for (int T = tid; T < ntiles; T += 512) {
            const int r = T * 256; int e = 0;
            for (int x = 0; x < N_EXPERTS; ++x) if (r >= sb[x] && r < sb[x + 1]) e = x;
            const int nv = sc[e] - (r - sb[e]);
            moe[MO_TILE_E + T] = e; moe[MO_TILE_ROW0 + T] = r; moe[MO_TILE_NV + T] = nv < 256 ? nv : 256;
        }
    }
    for (int a = blockIdx.x * 512 + tid; a < NTOK * 2; a += gridDim.x * 512) {
        const int slot = sb[moe[MO_TOK_E + a]] + moe[MO_TOK_POS + a];
        moe[MO_SLOT_TOK + slot] = a >> 1; moe[MO_TOK_SLOT + a] = slot;
    }
}


namespace mb {
typedef short s16x4 __attribute__((ext_vector_type(4)));
typedef float f32x16 __attribute__((ext_vector_type(16)));
constexpr int SHM_V = 64 * 128 * 2, SHM_K = 64 * 128 * 2, V_OFF = 0, K_OFF = 2 * SHM_V, PRE_OFF = 65536;
constexpr float SCALE = 0.08838834764831845f, LOG2E = 1.4426950408889634f, CC = SCALE * LOG2E, THRX = 8.f * LOG2E;
#define MB_KSWZ(row, colB) ((row) * 256 + ((colB) ^ (((row) & 7) << 4)))
__device__ __forceinline__ int v_st(int k, int c) { const int kk = (k & ~0xC) | ((k & 4) << 1) | ((k & 8) >> 1); return ((kk >> 3) * 4 + (c >> 5)) * 512 + ((kk & 7) * 32 + (c & 31)) * 2; }
__device__ __forceinline__ int v_rd_base(int lane) { return ((lane & 3) << 3) | (((lane >> 2) & 3) << 6) | (((lane >> 4) & 1) << 5) | (((lane >> 5) & 1) << 8); }
constexpr int v_rd_off(int d0, int ks, int half) { return d0 * 512 + ks * 4096 + half * 2048; }
template <int OFF> __device__ __forceinline__ s16x4 tr_read(int vb) { s16x4 r; asm volatile("ds_read_b64_tr_b16 %0, %1 offset:%2" : "=&v"(r) : "v"(vb), "i"(OFF) : "memory"); return r; }
#define MB_SBAR() __builtin_amdgcn_sched_barrier(0)

__device__ __forceinline__ void qkt(f32x16& p0, f32x16& p1, LAS unsigned char* Ks, const bf16x8 (&qr)[8], int r32, int hi) {
    p0 = f32x16{}; p1 = f32x16{};
#pragma unroll
    for (int d0 = 0; d0 < 8; ++d0) { const int cb = (d0 * 16 + hi * 8) * 2;
        const bf16x8 b0 = *(const LAS bf16x8*)(Ks + MB_KSWZ(r32, cb));
        const bf16x8 b1 = *(const LAS bf16x8*)(Ks + MB_KSWZ(32 + r32, cb));
        p0 = __builtin_amdgcn_mfma_f32_32x32x16_bf16(b0, qr[d0], p0, 0, 0, 0);
        p1 = __builtin_amdgcn_mfma_f32_32x32x16_bf16(b1, qr[d0], p1, 0, 0, 0); }
}
__device__ __forceinline__ void partialSM(f32x16& p0, f32x16& p1, float& m_reg, float& mn, float& alpha, float bias2, float tb4, bool own, int lim) {
#pragma unroll
    for (int r = 0; r < 16; ++r) { const float kc = (float)((r & 3) + 8 * (r >> 2));
        p0[r] = fmaf(p0[r], CC, fmaf(bias2, kc, tb4)); p1[r] = fmaf(p1[r], CC, fmaf(bias2, kc + 32.f, tb4)); }
    if (own) {
#pragma unroll
        for (int r = 0; r < 16; ++r) { const int kc = (r & 3) + 8 * (r >> 2); if (kc > lim) p0[r] = -INFINITY; if (kc + 32 > lim) p1[r] = -INFINITY; }
    }
    float pmax = p0[0];
#pragma unroll
    for (int r = 1; r < 16; ++r) pmax = fmaxf(pmax, p0[r]);
#pragma unroll
    for (int r = 0; r < 16; ++r) pmax = fmaxf(pmax, p1[r]);
    { auto rr = __builtin_amdgcn_permlane32_swap(__float_as_uint(pmax), __float_as_uint(pmax), false, false); pmax = fmaxf(__uint_as_float(rr[0]), __uint_as_float(rr[1])); }
    if (__builtin_expect(__all(pmax - m_reg <= THRX), 1)) { mn = m_reg; alpha = 1.f; }
    else { mn = fmaxf(m_reg, pmax); alpha = __builtin_amdgcn_exp2f(m_reg - mn); m_reg = mn; }
#pragma unroll
    for (int r = 0; r < 16; ++r) { p0[r] = p0[r] - mn; p1[r] = p1[r] - mn; }
#pragma unroll
    for (int r = 0; r < 16; ++r) p0[r] = __builtin_amdgcn_exp2f(p0[r]);
}
__device__ __forceinline__ void finishSM(f32x16& p0, f32x16& p1, float alpha, float& l_reg, bf16x8& pa0, bf16x8& pa1, bf16x8& pa2, bf16x8& pa3) {
#pragma unroll
    for (int r = 0; r < 16; ++r) p1[r] = __builtin_amdgcn_exp2f(p1[r]);
    float ps = 0.f;
#pragma unroll
    for (int r = 0; r < 16; ++r) ps += p0[r];
#pragma unroll
    for (int r = 0; r < 16; ++r) ps += p1[r];
    { auto rr = __builtin_amdgcn_permlane32_swap(__float_as_uint(ps), __float_as_uint(ps), false, false); ps = __uint_as_float(rr[0]) + __uint_as_float(rr[1]); }
    l_reg = l_reg * alpha + ps;
#define MB_PK4(P, BASE, OUT) do { unsigned a0 = cvt_pk_bf16(P[BASE + 0], P[BASE + 1]), a1 = cvt_pk_bf16(P[BASE + 2], P[BASE + 3]); \
    unsigned b0 = cvt_pk_bf16(P[BASE + 4], P[BASE + 5]), b1 = cvt_pk_bf16(P[BASE + 6], P[BASE + 7]); \
    auto r0 = __builtin_amdgcn_permlane32_swap(a0, b0, false, false); auto r1 = __builtin_amdgcn_permlane32_swap(a1, b1, false, false); \
    u32x4 w = {r0[0], r1[0], r0[1], r1[1]}; OUT = *reinterpret_cast<bf16x8*>(&w); } while (0)
    MB_PK4(p0, 0, pa0); MB_PK4(p0, 8, pa1); MB_PK4(p1, 0, pa2); MB_PK4(p1, 8, pa3);
#undef MB_PK4
}
template <int D0> __device__ __forceinline__ void pv_one(f32x16& od, int vb, bf16x8 pa0, bf16x8 pa1, bf16x8 pa2, bf16x8 pa3) {
    const s16x4 l0 = tr_read<v_rd_off(D0, 0, 0)>(vb), h0 = tr_read<v_rd_off(D0, 0, 1)>(vb), l1 = tr_read<v_rd_off(D0, 1, 0)>(vb), h1 = tr_read<v_rd_off(D0, 1, 1)>(vb);
    const s16x4 l2 = tr_read<v_rd_off(D0, 2, 0)>(vb), h2 = tr_read<v_rd_off(D0, 2, 1)>(vb), l3 = tr_read<v_rd_off(D0, 3, 0)>(vb), h3 = tr_read<v_rd_off(D0, 3, 1)>(vb);
    asm volatile("s_waitcnt lgkmcnt(0)" ::: "memory"); MB_SBAR();
#define MB_PK(L, H) (bf16x8){L[0], L[1], L[2], L[3], H[0], H[1], H[2], H[3]}
    od = __builtin_amdgcn_mfma_f32_32x32x16_bf16(MB_PK(l0, h0), pa0, od, 0, 0, 0);
    od = __builtin_amdgcn_mfma_f32_32x32x16_bf16(MB_PK(l1, h1), pa1, od, 0, 0, 0);
    od = __builtin_amdgcn_mfma_f32_32x32x16_bf16(MB_PK(l2, h2), pa2, od, 0, 0, 0);
    od = __builtin_amdgcn_mfma_f32_32x32x16_bf16(MB_PK(l3, h3), pa3, od, 0, 0, 0);
#undef MB_PK
}
__device__ __forceinline__ void pv_d0(f32x16 (&o)[4], int vb, bf16x8 pa0, bf16x8 pa1, bf16x8 pa2, bf16x8 pa3) {
    pv_one<0>(o[0], vb, pa0, pa1, pa2, pa3); pv_one<1>(o[1], vb, pa0, pa1, pa2, pa3); pv_one<2>(o[2], vb, pa0, pa1, pa2, pa3); pv_one<3>(o[3], vb, pa0, pa1, pa2, pa3);
}

__device__ __forceinline__ void item(const bf16* __restrict__ q, const bf16* __restrict__ kv, bf16* __restrict__ part_o, float* __restrict__ part_ml, LAS unsigned char* lds,
                                     int tid, int b, int g, int kblk, int NT, bool own, int t, int rh, int slot, bool valid) {
    const int lane = tid & 63, r32 = lane & 31, hi = lane >> 5;
    const int h = g * 4 + rh;
    const bf16* Kh = kv + (size_t)(b * SEQ + kblk * MOBA_BLOCK) * 512 + g * HEAD_DIM;
    float m_reg = -1e30f, l_reg = 0.f; f32x16 o[4] = {}; bf16x8 qr[8];
    { const bf16* Qw = q + (size_t)(b * SEQ + t) * D_MODEL + h * HEAD_DIM + hi * 8;
#pragma unroll
      for (int d0 = 0; d0 < 8; ++d0) qr[d0] = *(const bf16x8*)(Qw + d0 * 16); }
    const float bias2 = __builtin_amdgcn_exp2f(-(float)(h + 1)) * LOG2E;
    const int trel = t - kblk * MOBA_BLOCK;
    const float tb4 = bias2 * (float)(4 * hi - trel);
    const int lim0 = trel - 4 * hi;
    const int sr = tid >> 4, sc = (tid & 15) * 8, vst0 = v_st(sr, sc), vst1 = v_st(32 + sr, sc);
    const int vb0 = (int)(unsigned)(uintptr_t)(lds + V_OFF) + v_rd_base(lane);
    bf16x8 vsA0, vsA1, ksA0, ksA1, vsB0, vsB1, ksB0, ksB1;
    const unsigned vo0 = (unsigned)(sr * 512 + sc) * 2u, vo1 = vo0 + 32u * 1024u;
    const char* KhB = (const char*)Kh;
#define MB_SLOAD_A(k0) do { const char* kt_ = KhB + (size_t)(k0) * 1024; vsA0 = *(const bf16x8*)(kt_ + 512 + vo0); vsA1 = *(const bf16x8*)(kt_ + 512 + vo1); \
        ksA0 = *(const bf16x8*)(kt_ + vo0); ksA1 = *(const bf16x8*)(kt_ + vo1); } while (0)
#define MB_SLOAD_B(k0) do { const char* kt_ = KhB + (size_t)(k0) * 1024; vsB0 = *(const bf16x8*)(kt_ + 512 + vo0); vsB1 = *(const bf16x8*)(kt_ + 512 + vo1); \
        ksB0 = *(const bf16x8*)(kt_ + vo0); ksB1 = *(const bf16x8*)(kt_ + vo1); } while (0)
#define MB_SWRITE(bb, V0, V1, K0, K1) do { *(LAS bf16x8*)(lds + V_OFF + (bb) * SHM_V + vst0) = V0; *(LAS bf16x8*)(lds + V_OFF + (bb) * SHM_V + vst1) = V1; \
        *(LAS bf16x8*)(lds + K_OFF + (bb) * SHM_K + MB_KSWZ(sr, sc * 2)) = K0; *(LAS bf16x8*)(lds + K_OFF + (bb) * SHM_K + MB_KSWZ(32 + sr, sc * 2)) = K1; } while (0)
#define MB_SWAIT() asm volatile("s_waitcnt vmcnt(4)" ::: "memory")
#define MB_RESC(a) do { if (__any((a) < 1.f)) { _Pragma("unroll") for (int d = 0; d < 4; ++d) _Pragma("unroll") for (int r = 0; r < 16; ++r) o[d][r] *= (a); } } while (0)
#define MB_PSM(P0, P1, MN, AL, tile) partialSM(P0, P1, m_reg, MN, AL, bias2, tb4 + bias2 * (float)((tile) * 64), own, lim0 - (tile) * 64)
    f32x16 pA0, pA1, pB0, pB1; float mnA, mnB, alA, alB; bf16x8 pa0, pa1, pa2, pa3;
    MB_SLOAD_A(0); asm volatile("s_waitcnt vmcnt(0)" ::: "memory"); MB_SWRITE(0, vsA0, vsA1, ksA0, ksA1); __syncthreads();
    qkt(pA0, pA1, lds + K_OFF, qr, r32, hi); MB_PSM(pA0, pA1, mnA, alA, 0);
    MB_SLOAD_B(64); if (2 < NT) MB_SLOAD_A(128);
    MB_SWAIT(); MB_SWRITE(1, vsB0, vsB1, ksB0, ksB1); __syncthreads();
    for (int j = 1; j + 1 < NT; j += 2) {
        MB_SBAR(); qkt(pB0, pB1, lds + K_OFF + SHM_K, qr, r32, hi);
        finishSM(pA0, pA1, alA, l_reg, pa0, pa1, pa2, pa3); MB_SBAR();
        MB_SLOAD_B((j + 2) * 64); MB_SBAR();
        pv_d0(o, vb0, pa0, pa1, pa2, pa3); MB_PSM(pB0, pB1, mnB, alB, j);
        __syncthreads(); MB_SWAIT(); MB_SWRITE(0, vsA0, vsA1, ksA0, ksA1);
        MB_RESC(alB); __syncthreads();
        MB_SBAR(); qkt(pA0, pA1, lds + K_OFF, qr, r32, hi);
        finishSM(pB0, pB1, alB, l_reg, pa0, pa1, pa2, pa3); MB_SBAR();
        if (j + 3 < NT) MB_SLOAD_A((j + 3) * 64); MB_SBAR();
        pv_d0(o, vb0 + SHM_V, pa0, pa1, pa2, pa3); MB_PSM(pA0, pA1, mnA, alA, j + 1);
        __syncthreads(); MB_SWAIT(); MB_SWRITE(1, vsB0, vsB1, ksB0, ksB1);
        MB_RESC(alA); __syncthreads();
    }
    MB_SBAR(); qkt(pB0, pB1, lds + K_OFF + SHM_K, qr, r32, hi);
    finishSM(pA0, pA1, alA, l_reg, pa0, pa1, pa2, pa3); MB_SBAR();
    pv_d0(o, vb0, pa0, pa1, pa2, pa3); MB_PSM(pB0, pB1, mnB, alB, NT - 1);
    __syncthreads(); MB_RESC(alB);
    finishSM(pB0, pB1, alB, l_reg, pa0, pa1, pa2, pa3); MB_SBAR();
    pv_d0(o, vb0 + SHM_V, pa0, pa1, pa2, pa3);
    if (valid) {
        const float inv = 1.f / l_reg;
        const size_t rg = ((size_t)(b * SEQ + t) * N_HEADS + h) * 4 + slot;
        bf16* po = part_o + rg * HEAD_DIM + 4 * hi;
#pragma unroll
        for (int d0 = 0; d0 < 4; ++d0)
#pragma unroll
            for (int rq = 0; rq < 4; ++rq) { u32x2 w; w.x = cvt_pk_bf16(o[d0][rq * 4 + 0] * inv, o[d0][rq * 4 + 1] * inv); w.y = cvt_pk_bf16(o[d0][rq * 4 + 2] * inv, o[d0][rq * 4 + 3] * inv);
                *(u32x2*)(po + d0 * 32 + rq * 8) = w; }
        if (hi == 0) { f32x2 ml; ml.x = m_reg; ml.y = l_reg; *(f32x2*)(part_ml + rg * 2) = ml; }
    }
    __syncthreads();
#undef MB_SLOAD_A
#undef MB_SLOAD_B
#undef MB_SWRITE
#undef MB_SWAIT
#undef MB_RESC
#undef MB_PSM
}
}

constexpr size_t WS_SELB = WS_T;
constexpr size_t WS_PML = WS_T + 2 * MiB;
constexpr size_t WS_LISTS = WS_T + 16 * MiB;
constexpr size_t WS_PARTO = WS_SCORES;
constexpr int CW_LCNT = 16384 + 512;

__device__ __forceinline__ void phase_kmeans(KP P) {
    int tz = threadIdx.x; asm volatile("" : "+v"(tz)); const int tid = tz;
    const bf16* kv = (const bf16*)(P->ws + WS_KV); float* km = (float*)(P->ws + WS_KM);
    for (int it = blockIdx.x; it < BATCH * N_KV * N_BLOCKS; it += gridDim.x) {
        const int blk = it % N_BLOCKS, g = (it / N_BLOCKS) % N_KV, b = it / (N_BLOCKS * N_KV);
        if (tid < HEAD_DIM) { float s = 0.f;
            for (int i = 0; i < MOBA_BLOCK; ++i) s += bf2f(kv[(size_t)(b * SEQ + blk * MOBA_BLOCK + i) * 512 + g * HEAD_DIM + tid]);
            const float mval = s * (1.f / MOBA_BLOCK); km[(size_t)it * HEAD_DIM + tid] = mval;
            const unsigned hi16 = cvt_pk_bf16(mval, 0.f) & 0xffffu; const float rem = mval - bflo(hi16);
            bf16* kmh = (bf16*)(km + 65536); kmh[(size_t)it * HEAD_DIM + tid] = (bf16)hi16; kmh[(size_t)(BATCH * N_KV * N_BLOCKS + it) * HEAD_DIM + tid] = (bf16)(cvt_pk_bf16(rem, 0.f) & 0xffffu); }
    }
}
__device__ __forceinline__ void phase_moba_gate(KP P, LAS unsigned char* lds) {
    int tz = threadIdx.x; asm volatile("" : "+v"(tz)); const int tid = tz, lane = tid & 63, wave = tid >> 6;
    const bf16* q = (const bf16*)(P->ws + WS_QKVI); const float* km = (const float*)(P->ws + WS_KM); unsigned char* selb = (unsigned char*)(P->ws + WS_SELB);
    LAS float* qs = (LAS float*)(lds + wave * 2048);
    const int blk = lane & 31, half = lane >> 5;
    for (int it = blockIdx.x * NWAVES + wave; it < NTOK * 2; it += gridDim.x * NWAVES) {
        const int tok = it >> 1, g = it & 1, b = tok / SEQ, t = tok % SEQ, own = t >> 8;
        unsigned char* sb = selb + ((size_t)tok * 8 + g * 4) * 4;
        if (own < 3) { if (lane < 4) { for (int s2 = own; s2 < 3; ++s2) sb[lane * 4 + s2] = 0xFF; } }
        if (own == 0) continue;
        { const u32x4 w = *(const u32x4*)(q + (size_t)tok * D_MODEL + g * 512 + lane * 8);
          LAS float* d = qs + lane * 8;
          d[0] = bflo(w.x); d[1] = bfhi(w.x); d[2] = bflo(w.y); d[3] = bfhi(w.y); d[4] = bflo(w.z); d[5] = bfhi(w.z); d[6] = bflo(w.w); d[7] = bfhi(w.w); }
        asm volatile("s_waitcnt lgkmcnt(0)" ::: "memory");
        float acc[4] = {0.f, 0.f, 0.f, 0.f};
        const float* kp = km + ((size_t)(b * N_KV + g) * N_BLOCKS + blk) * HEAD_DIM + half * 64;
#pragma unroll 4
        for (int i = 0; i < 16; ++i) { const f32x4 kk = *(const f32x4*)(kp + 4 * i);
#pragma unroll
            for (int r = 0; r < 4; ++r) { const f32x4 qq = *(const LAS f32x4*)(qs + r * 128 + half * 64 + 4 * i); acc[r] += (kk[0] * qq[0] + kk[1] * qq[1]) + (kk[2] * qq[2] + kk[3] * qq[3]); } }
#pragma unroll
        for (int r = 0; r < 4; ++r) { acc[r] += __shfl_xor(acc[r], 32); if (blk >= own) acc[r] = -INFINITY; }
        int rank[4] = {0, 0, 0, 0};
#pragma unroll
        for (int j = 0; j < 32; ++j) {
#pragma unroll
            for (int r = 0; r < 4; ++r) { const float vj = __uint_as_float(__builtin_amdgcn_readlane(__float_as_uint(acc[r]), j)); rank[r] += (vj > acc[r] || (vj == acc[r] && j < blk)) ? 1 : 0; }
        }
        if (half == 0 && blk < own) {
#pragma unroll
            for (int r = 0; r < 4; ++r) if (rank[r] < 3) sb[r * 4 + rank[r]] = (unsigned char)blk;
        }
    }
}

__device__ __forceinline__ void phase_moba_gate2(KP P) {
    typedef float f32x16 __attribute__((ext_vector_type(16)));
    int tz = threadIdx.x; asm volatile("" : "+v"(tz)); const int tid = tz, lane = tid & 63, wave = tid >> 6, r32 = lane & 31, hi = lane >> 5;
    const bf16* q = (const bf16*)(P->ws + WS_QKVI); const bf16* kmh = (const bf16*)((const float*)(P->ws + WS_KM) + 65536); unsigned char* selb = (unsigned char*)(P->ws + WS_SELB);
    const int gw = blockIdx.x * NWAVES + wave, NGW = gridDim.x * NWAVES;
    int cur_bg = -1; bf16x8 ah[8], al[8];
    for (int tile = gw * 4; tile < 8192; tile += NGW * 4) {
#pragma unroll 1
        for (int sub = 0; sub < 4; ++sub) {
            const int tl = tile + sub, bg = tl >> 10, b = bg >> 1, g = bg & 1, rt = tl & 1023;
            if (bg != cur_bg) { cur_bg = bg;
                const bf16* kp = kmh + ((size_t)(b * N_KV + g) * N_BLOCKS + r32) * HEAD_DIM + 8 * hi;
#pragma unroll
                for (int ks = 0; ks < 8; ++ks) { ah[ks] = *(const bf16x8*)(kp + 16 * ks); al[ks] = *(const bf16x8*)(kp + (size_t)BATCH * N_KV * N_BLOCKS * HEAD_DIM + 16 * ks); } }
            const int row = rt * 32 + r32, t = row >> 2, rh = row & 3, own = t >> 8, tok = b * SEQ + t;
            const bf16* qp = q + (size_t)tok * D_MODEL + (g * 4 + rh) * HEAD_DIM + 8 * hi;
            f32x16 acc = {};
#pragma unroll
            for (int ks = 0; ks < 8; ++ks) { const bf16x8 qv = *(const bf16x8*)(qp + 16 * ks);
                acc = __builtin_amdgcn_mfma_f32_32x32x16_bf16(ah[ks], qv, acc, 0, 0, 0); acc = __builtin_amdgcn_mfma_f32_32x32x16_bf16(al[ks], qv, acc, 0, 0, 0); }
            float v[16];
#pragma unroll
            for (int r = 0; r < 16; ++r) { const int blk = (r & 3) + 8 * (r >> 2) + 4 * hi; v[r] = (blk < own) ? acc[r] : -INFINITY; }
            float bv[3]; int bi[3];
#pragma unroll
            for (int p = 0; p < 3; ++p) { float best = -INFINITY; int br = -1;
#pragma unroll
                for (int r = 0; r < 16; ++r) { if (v[r] > best) { best = v[r]; br = r; } }
                bv[p] = best; bi[p] = (br < 0) ? 255 : ((br & 3) + 8 * (br >> 2) + 4 * hi);
#pragma unroll
                for (int r = 0; r < 16; ++r) { if (r == br) v[r] = -INFINITY; } }
            float ov[3]; int oi[3];
#pragma unroll
            for (int p = 0; p < 3; ++p) { ov[p] = __shfl_xor(bv[p], 32); oi[p] = __shfl_xor(bi[p], 32); }
            int ia = 0, ib = 0; int res[3];
#pragma unroll
            for (int p = 0; p < 3; ++p) {
                const float va = (ia == 0) ? bv[0] : (ia == 1) ? bv[1] : (ia == 2) ? bv[2] : -INFINITY; const int xa = (ia == 0) ? bi[0] : (ia == 1) ? bi[1] : (ia == 2) ? bi[2] : 255;
                const float vb = (ib == 0) ? ov[0] : (ib == 1) ? ov[1] : (ib == 2) ? ov[2] : -INFINITY; const int xb = (ib == 0) ? oi[0] : (ib == 1) ? oi[1] : (ib == 2) ? oi[2] : 255;
                const bool takeA = (va > vb) || (va == vb && xa < xb);
                const float vv = takeA ? va : vb; const int xx = takeA ? xa : xb;
                res[p] = (vv > -INFINITY) ? xx : 255; if (takeA) ++ia; else ++ib; }
            if (hi == 0) { const unsigned w = (unsigned)res[0] | ((unsigned)res[1] << 8) | ((unsigned)res[2] << 16) | 0xFF000000u;
                *(unsigned*)(selb + ((size_t)tok * 8 + g * 4 + rh) * 4) = w; }
        }
    }
}

__device__ __forceinline__ void phase_moba_lists(KP P, LAS unsigned char* lds) {
    int tz = threadIdx.x; asm volatile("" : "+v"(tz)); const int tid = tz, lane = tid & 63, wave = tid >> 6;
    const u32x4* selb = (const u32x4*)(P->ws + WS_SELB); unsigned* lists = (unsigned*)(P->ws + WS_LISTS); unsigned* lcnt = (unsigned*)(P->ws + WS_CTL) + CW_LCNT;
    LAS int* wtot = (LAS int*)lds;
    for (int li = blockIdx.x; li < 256; li += gridDim.x) {
        const int j = li & 31, g = (li >> 5) & 1, b = li >> 6, base_t = (j + 1) * MOBA_BLOCK, n_t = SEQ - base_t;
        unsigned* out = lists + (size_t)li * 32768;
        int running = 0;
        for (int i0 = 0; i0 < n_t; i0 += 512) {
            const int ti = i0 + tid; const bool ok = ti < n_t; const int t = base_t + ti;
            u32x4 w = {0xFFFFFFFFu, 0xFFFFFFFFu, 0xFFFFFFFFu, 0xFFFFFFFFu};
            if (ok) w = selb[((size_t)(b * SEQ + t) * 8 + g * 4) / 4];
            int ms[4];
#pragma unroll
            for (int r = 0; r < 4; ++r) { const unsigned x = w[r]; ms[r] = ((x & 0xFFu) == (unsigned)j) ? 0 : (((x >> 8) & 0xFFu) == (unsigned)j) ? 1 : (((x >> 16) & 0xFFu) == (unsigned)j) ? 2 : -1; }
            const int c = (ms[0] >= 0) + (ms[1] >= 0) + (ms[2] >= 0) + (ms[3] >= 0);
            int inc = c;
#pragma unroll
            for (int o = 1; o < 64; o <<= 1) { const int v = __shfl_up(inc, o); if (lane >= o) inc += v; }
            __syncthreads();
            if (lane == 63) wtot[wave] = inc;
            __syncthreads();
            int woff = 0, tot = 0;
#pragma unroll
            for (int x = 0; x < NWAVES; ++x) { const int v = wtot[x]; if (x < wave) woff += v; tot += v; }
            int pos = running + woff + inc - c;
#pragma unroll
            for (int r = 0; r < 4; ++r) if (ms[r] >= 0) out[pos++] = (unsigned)t | ((unsigned)r << 13) | ((unsigned)ms[r] << 15);
            running += tot;
        }
        if (tid == 0) lcnt[li] = (unsigned)running;
        __syncthreads();
    }
}
__device__ __forceinline__ void phase_moba_attn(KP P, LAS unsigned char* lds) {
    int tz = threadIdx.x; asm volatile("" : "+v"(tz)); const int tid = tz, lane = tid & 63, wave = tid >> 6;
    const bf16* q = (const bf16*)(P->ws + WS_QKVI); const bf16* kv = (const bf16*)(P->ws + WS_KV);
    bf16* part_o = (bf16*)(P->ws + WS_PARTO); float* part_ml = (float*)(P->ws + WS_PML);
    const unsigned* lists = (const unsigned*)(P->ws + WS_LISTS); const unsigned* lcnt = (const unsigned*)(P->ws + WS_CTL) + CW_LCNT;
    LAS int* pre = (LAS int*)(lds + mb::PRE_OFF);
    LAS int* cn = pre + 260;
    if (tid < 256) cn[tid] = (int)lcnt[tid];
    __syncthreads();
    if (tid == 0) { int s = 0; for (int i = 0; i < 256; ++i) { pre[i] = s; s += (cn[i] + 255) >> 8; } pre[256] = s; }
    __syncthreads();
    const int npast = pre[256], total = npast + 1024;
    for (int it = blockIdx.x; it < total; it += gridDim.x) {
        int b, g, kblk, NT, t, rh, slot; bool own, valid;
        const int ri = wave * 32 + (lane & 31);
        if (it < npast) {
            int lo = 0, hi = 256;
            while (hi - lo > 1) { const int mid = (lo + hi) >> 1; if (pre[mid] <= it) lo = mid; else hi = mid; }
            const int li = lo, chunk = it - pre[li], n = cn[li];
            kblk = li & 31; g = (li >> 5) & 1; b = li >> 6; NT = 4; own = false;
            int idx = chunk * 256 + ri; valid = idx < n; if (!valid) idx = chunk * 256;
            const unsigned e = lists[(size_t)li * 32768 + idx];
            t = (int)(e & 0x1FFFu); rh = (int)((e >> 13) & 3u); slot = (int)((e >> 15) & 3u);
        } else {
            const int oi = it - npast, chunk = oi & 3, bi = oi >> 2;
            kblk = bi & 31; g = (bi >> 5) & 1; b = bi >> 6; NT = chunk < 2 ? 2 : 4; own = true; valid = true;
            t = kblk * MOBA_BLOCK + chunk * 64 + (ri >> 2); rh = ri & 3; slot = 3;
        }
        mb::item(q, kv, part_o, part_ml, lds, tid, b, g, kblk, NT, own, t, rh, slot, valid);
    }
}

namespace mb {
constexpr int SEG_K = 0, SEG_V = 65536, SEG_PRE = 131072, SEGC = 8;
__device__ __forceinline__ void stage_block(const bf16* __restrict__ kv, LAS unsigned char* lds, int tid, int b, int g, int kblk) {
    const char* KhB = (const char*)(kv + (size_t)(b * SEQ + kblk * MOBA_BLOCK) * 512 + g * HEAD_DIM);
    const int sr = tid >> 4, sc = (tid & 15) * 8, vst0 = v_st(sr, sc), vst1 = v_st(32 + sr, sc);
    const unsigned vo0 = (unsigned)(sr * 512 + sc) * 2u, vo1 = vo0 + 32u * 1024u;
#pragma unroll
    for (int h2 = 0; h2 < 2; ++h2) {
        bf16x8 kx[2][2], vx[2][2];
#pragma unroll
        for (int tt = 0; tt < 2; ++tt) { const char* kt_ = KhB + (size_t)((h2 * 2 + tt) * 64) * 1024;
            kx[tt][0] = *(const bf16x8*)(kt_ + vo0); kx[tt][1] = *(const bf16x8*)(kt_ + vo1); vx[tt][0] = *(const bf16x8*)(kt_ + 512 + vo0); vx[tt][1] = *(const bf16x8*)(kt_ + 512 + vo1); }
#pragma unroll
        for (int tt = 0; tt < 2; ++tt) { const int tile = h2 * 2 + tt;
            *(LAS bf16x8*)(lds + SEG_K + tile * SHM_K + MB_KSWZ(sr, sc * 2)) = kx[tt][0]; *(LAS bf16x8*)(lds + SEG_K + tile * SHM_K + MB_KSWZ(32 + sr, sc * 2)) = kx[tt][1];
            *(LAS bf16x8*)(lds + SEG_V + tile * SHM_V + vst0) = vx[tt][0]; *(LAS bf16x8*)(lds + SEG_V + tile * SHM_V + vst1) = vx[tt][1]; }
    }
}
__device__ __forceinline__ void chunk_rows(const bf16* __restrict__ q, bf16* __restrict__ part_o, float* __restrict__ part_ml, LAS unsigned char* lds, int lane,
                                           int b, int g, int kblk, int NT, bool own, int t, int rh, int slot, bool valid) {
    const int r32 = lane & 31, hi = lane >> 5, h = g * 4 + rh;
    float m_reg = -1e30f, l_reg = 0.f; f32x16 o[4] = {}; bf16x8 qr[8];
    { const bf16* Qw = q + (size_t)(b * SEQ + t) * D_MODEL + h * HEAD_DIM + hi * 8;
#pragma unroll
      for (int d0 = 0; d0 < 8; ++d0) qr[d0] = *(const bf16x8*)(Qw + d0 * 16); }
    const float bias2 = __builtin_amdgcn_exp2f(-(float)(h + 1)) * LOG2E;
    const int trel = t - kblk * MOBA_BLOCK;
    const float tb4 = bias2 * (float)(4 * hi - trel);
    const int lim0 = trel - 4 * hi;
    const int vb0 = (int)(unsigned)(uintptr_t)(lds + SEG_V) + v_rd_base(lane);
    for (int tile = 0; tile < NT; ++tile) {
        f32x16 p0, p1; float mn, al; bf16x8 pa0, pa1, pa2, pa3;
        qkt(p0, p1, lds + SEG_K + tile * SHM_K, qr, r32, hi);
        partialSM(p0, p1, m_reg, mn, al, bias2, tb4 + bias2 * (float)(tile * 64), own, lim0 - tile * 64);
        if (__any(al < 1.f)) {
#pragma unroll
            for (int d = 0; d < 4; ++d)
#pragma unroll
                for (int r = 0; r < 16; ++r) o[d][r] *= al; }
        finishSM(p0, p1, al, l_reg, pa0, pa1, pa2, pa3);
        pv_d0(o, vb0 + tile * SHM_V, pa0, pa1, pa2, pa3);
    }
    if (valid) {
        const float inv = 1.f / l_reg;
        const size_t rg = ((size_t)(b * SEQ + t) * N_HEADS + h) * 4 + slot;
        bf16* po = part_o + rg * HEAD_DIM + 4 * hi;
#pragma unroll
        for (int d0 = 0; d0 < 4; ++d0)
#pragma unroll
            for (int rq = 0; rq < 4; ++rq) { u32x2 w; w.x = cvt_pk_bf16(o[d0][rq * 4 + 0] * inv, o[d0][rq * 4 + 1] * inv); w.y = cvt_pk_bf16(o[d0][rq * 4 + 2] * inv, o[d0][rq * 4 + 3] * inv);
                *(u32x2*)(po + d0 * 32 + rq * 8) = w; }
        if (hi == 0) { f32x2 ml; ml.x = m_reg; ml.y = l_reg; *(f32x2*)(part_ml + rg * 2) = ml; }
    }
}
}
constexpr int CW_MQ = 20480;
__device__ __forceinline__ void phase_moba_attn2(KP P, int Lb, LAS unsigned char* lds) {
    int tz = threadIdx.x; asm volatile("" : "+v"(tz)); const int tid = tz, lane = tid & 63, wave = tid >> 6;
    const bf16* q = (const bf16*)(P->ws + WS_QKVI); const bf16* kv = (const bf16*)(P->ws + WS_KV);
    bf16* part_o = (bf16*)(P->ws + WS_PARTO); float* part_ml = (float*)(P->ws + WS_PML);
    const unsigned* lists = (const unsigned*)(P->ws + WS_LISTS); const unsigned* lcnt = (const unsigned*)(P->ws + WS_CTL) + CW_LCNT;
    unsigned* qhead = (unsigned*)(P->ws + WS_CTL) + CW_MQ + Lb * 64;
    LAS int* pre = (LAS int*)(lds + mb::SEG_PRE);
    LAS int* cn = pre + 260;
    LAS int* cur = pre + 520;
    if (tid < 256) cn[tid] = (int)lcnt[tid];
    __syncthreads();
    if (tid == 0) { int s2 = 0; for (int i = 0; i < 256; ++i) { pre[i] = s2; const int nch = (cn[i] + 255) >> 8; s2 += (nch + mb::SEGC - 1) / mb::SEGC; } pre[256] = s2; }
    __syncthreads();
    const int npast = pre[256], total = npast + 256;
    for (;;) {
        if (tid == 0) cur[0] = (int)__hip_atomic_fetch_add(qhead, 1u, __ATOMIC_RELAXED, __HIP_MEMORY_SCOPE_AGENT);
        __syncthreads();
        const int sg = cur[0];
        if (sg >= total) break;
        int b, g, kblk, li = 0, ch0, nch, n = 0; bool own;
        if (sg < npast) {
            int lo = 0, hi2 = 256;
            while (hi2 - lo > 1) { const int mid = (lo + hi2) >> 1; if (pre[mid] <= sg) lo = mid; else hi2 = mid; }
            li = lo; n = cn[li]; ch0 = (sg - pre[li]) * mb::SEGC; const int ncht = (n + 255) >> 8; nch = ncht - ch0 < mb::SEGC ? ncht - ch0 : mb::SEGC;
            kblk = li & 31; g = (li >> 5) & 1; b = li >> 6; own = false;
        } else { const int bi = sg - npast; kblk = bi & 31; g = (bi >> 5) & 1; b = bi >> 6; own = true; ch0 = 0; nch = 4; }
        mb::stage_block(kv, lds, tid, b, g, kblk);
        __syncthreads();
        const int ri = wave * 32 + (lane & 31);
        for (int c = 0; c < nch; ++c) {
            const int chunk = ch0 + c; int t, rh, slot, NT; bool valid;
            if (!own) { int idx = chunk * 256 + ri; valid = idx < n; if (!valid) idx = chunk * 256;
                const unsigned e = lists[(size_t)li * 32768 + idx];
                t = (int)(e & 0x1FFFu); rh = (int)((e >> 13) & 3u); slot = (int)((e >> 15) & 3u); NT = 4;
            } else { valid = true; t = kblk * MOBA_BLOCK + chunk * 64 + (ri >> 2); rh = ri & 3; slot = 3; NT = chunk + 1; }
            mb::chunk_rows(q, part_o, part_ml, lds, lane, b, g, kblk, NT, own, t, rh, slot, valid);
        }
        __syncthreads();
    }
}

__device__ __forceinline__ void phase_moba_combine(KP P) {
    int tz = threadIdx.x; asm volatile("" : "+v"(tz)); const int tid = tz;
    const bf16* part_o = (const bf16*)(P->ws + WS_PARTO); const float* part_ml = (const float*)(P->ws + WS_PML); bf16* attn = (bf16*)(P->ws + WS_ATTN);
    const int sub = tid & 15;
#pragma unroll 2
    for (int rg = (blockIdx.x * 512 + tid) >> 4; rg < NTOK * N_HEADS; rg += (gridDim.x * 512) >> 4) {
        const int tok = rg >> 3, own = (tok % SEQ) >> 8, nv = own < 3 ? own : 3;
        const float* ml = part_ml + (size_t)rg * 8;
        float m[4], l[4];
#pragma unroll
        for (int s2 = 0; s2 < 4; ++s2) { const bool ok = (s2 == 3) || (s2 < nv); m[s2] = ok ? ml[s2 * 2] : -INFINITY; l[s2] = ok ? ml[s2 * 2 + 1] : 0.f; }
        const float M = fmaxf(fmaxf(m[0], m[1]), fmaxf(m[2], m[3]));
        float w[4], W = 0.f;
#pragma unroll
        for (int s2 = 0; s2 < 4; ++s2) { w[s2] = l[s2] * __builtin_amdgcn_exp2f(m[s2] - M); W += w[s2]; }
        const float inv = 1.f / W;
        float acc[8] = {0.f, 0.f, 0.f, 0.f, 0.f, 0.f, 0.f, 0.f};
#pragma unroll
        for (int s2 = 0; s2 < 4; ++s2) {
            if ((s2 == 3) || (s2 < nv)) {
                const u32x4 v = *(const u32x4*)(part_o + ((size_t)rg * 4 + s2) * HEAD_DIM + sub * 8); const float ws2 = w[s2] * inv;
                acc[0] += ws2 * bflo(v.x); acc[1] += ws2 * bfhi(v.x); acc[2] += ws2 * bflo(v.y); acc[3] += ws2 * bfhi(v.y);
                acc[4] += ws2 * bflo(v.z); acc[5] += ws2 * bfhi(v.z); acc[6] += ws2 * bflo(v.w); acc[7] += ws2 * bfhi(v.w);
            }
        }
        u32x4 o; o.x = cvt_pk_bf16(acc[0], acc[1]); o.y = cvt_pk_bf16(acc[2], acc[3]); o.z = cvt_pk_bf16(acc[4], acc[5]); o.w = cvt_pk_bf16(acc[6], acc[7]);
        *(u32x4*)(attn + (size_t)rg * HEAD_DIM + sub * 8) = o;
    }
}


#ifndef D1_EXP
#define D1_EXP 0
#endif
constexpr int D1_QS = 4100, D1_SM = 32 * D1_QS, D1_SELIDX = D1_SM + 1024, D1_NT = 992;
__device__ __forceinline__ unsigned fkey2(float f) { const unsigned u = __float_as_uint(f); return (u & 0x80000000u) ? ~u : (u | 0x80000000u); }
template <int PASS, int EXP>
__device__ __forceinline__ void d1_scan(const bf16* __restrict__ ikb, int qt, int kt_end, int wave, int lane, const bf16x8 (&qb)[4][4], const float (&wv)[4], LAS unsigned char* lds, unsigned thr, float flo = 0.f, float finv = 0.f, unsigned bstar = 0) {
    typedef float f32x16 __attribute__((ext_vector_type(16)));
    const int r32 = lane & 31, hi = lane >> 5;
    LAS unsigned* hq = (LAS unsigned*)(lds + r32 * D1_QS);
    LAS unsigned* sm = (LAS unsigned*)(lds + D1_SM);
    bf16x8 ka[4];
    int kt = wave;
    if (kt <= kt_end) { const bf16* kp = ikb + (size_t)(kt * 32 + r32) * QLD + 8 * hi;
#pragma unroll
        for (int ks = 0; ks < 4; ++ks) ka[ks] = *(const bf16x8*)(kp + 16 * ks); }
    for (; kt <= kt_end; kt += 8) {
        bf16x8 kn[4];
#pragma unroll
        for (int ks = 0; ks < 4; ++ks) kn[ks] = ka[ks];
        if (kt + 8 <= kt_end) { const bf16* kp = ikb + (size_t)((kt + 8) * 32 + r32) * QLD + 8 * hi;
#pragma unroll
            for (int ks = 0; ks < 4; ++ks) kn[ks] = *(const bf16x8*)(kp + 16 * ks); }
        float sc[16];
#pragma unroll
        for (int r = 0; r < 16; ++r) sc[r] = 0.f;
#pragma unroll
        for (int h = 0; h < 4; ++h) { f32x16 acc = {};
#pragma unroll
            for (int ks = 0; ks < 4; ++ks) acc = __builtin_amdgcn_mfma_f32_32x32x16_bf16(ka[ks], qb[h][ks], acc, 0, 0, 0);
#pragma unroll
            for (int r = 0; r < 16; ++r) sc[r] = fmaf(wv[h], fmaxf(acc[r], 0.f), sc[r]); }
        int kbase = kt * 32 + 4 * hi; asm volatile("" : "+v"(kbase));
        const int lim = (kt == qt) ? (r32 - 4 * hi) : 64;
#pragma unroll
        for (int r = 0; r < 16; ++r) {
            const int kc = (r & 3) + 8 * (r >> 2);
            const bool valid = kc <= lim;
            const unsigned key = fkey2(sc[r]);
            if (PASS == 1) { if (EXP == 3) { if (key == 12345u) hq[0] = 1u; } else if (valid && EXP != 2) { const unsigned bin = key >> 21; (void)__hip_atomic_fetch_add(hq + (bin >> 1), 1u << (16 * (bin & 1)), __ATOMIC_RELAXED, __HIP_MEMORY_SCOPE_WORKGROUP); } }
            else if (PASS == 2) { if (valid && (key >> 21) == thr) { const unsigned bin = (key >> 10) & 2047u; (void)__hip_atomic_fetch_add(hq + (bin >> 1), 1u << (16 * (bin & 1)), __ATOMIC_RELAXED, __HIP_MEMORY_SCOPE_WORKGROUP); } }
            else if (PASS == 4) { if (valid && sc[r] >= flo) { unsigned bin = (unsigned)((sc[r] - flo) * finv); bin = bin > 2047u ? 2047u : bin; (void)__hip_atomic_fetch_add(hq + (bin >> 1), 1u << (16 * (bin & 1)), __ATOMIC_RELAXED, __HIP_MEMORY_SCOPE_WORKGROUP); } }
            else if (PASS == 5) { if (valid && sc[r] >= flo) { unsigned bin = (unsigned)((sc[r] - flo) * finv); bin = bin > 2047u ? 2047u : bin; const unsigned sidx = (unsigned)(kbase + kc);
                    if (bin > bstar) (void)__hip_atomic_fetch_or(hq + 512 + (sidx >> 5), 1u << (sidx & 31u), __ATOMIC_RELAXED, __HIP_MEMORY_SCOPE_WORKGROUP);
                    else if (bin == bstar) {
                        if (key == 0x80000000u) (void)__hip_atomic_fetch_or(hq + 768 + (sidx >> 5), 1u << (sidx & 31u), __ATOMIC_RELAXED, __HIP_MEMORY_SCOPE_WORKGROUP);
                        else { const unsigned cp = __hip_atomic_fetch_add(sm + 160 + r32, 1u, __ATOMIC_RELAXED, __HIP_MEMORY_SCOPE_WORKGROUP); if (cp < 256u) { hq[cp] = key; ((LAS unsigned short*)(hq + 256))[cp] = (unsigned short)sidx; } } } } }
            else { if (valid) { const unsigned p22 = key >> 10; const unsigned sidx = (unsigned)(kbase + kc);
                    if (p22 > thr) (void)__hip_atomic_fetch_or(hq + 512 + (sidx >> 5), 1u << (sidx & 31u), __ATOMIC_RELAXED, __HIP_MEMORY_SCOPE_WORKGROUP);
                    else if (p22 == thr) {
                        if (key == 0x80000000u) (void)__hip_atomic_fetch_or(hq + 768 + (sidx >> 5), 1u << (sidx & 31u), __ATOMIC_RELAXED, __HIP_MEMORY_SCOPE_WORKGROUP);
                        else { const unsigned cp = __hip_atomic_fetch_add(sm + 160 + r32, 1u, __ATOMIC_RELAXED, __HIP_MEMORY_SCOPE_WORKGROUP); if (cp < 256u) { hq[cp] = key; ((LAS unsigned short*)(hq + 256))[cp] = (unsigned short)sidx; } } } } }
        }
#pragma unroll
        for (int ks = 0; ks < 4; ++ks) ka[ks] = kn[ks];
    }
}
__device__ __forceinline__ bool d1_find(LAS unsigned* H, unsigned need, int lane, unsigned& bin_out, unsigned& above_out) {
    unsigned mine = 0;
#pragma unroll
    for (int i = 0; i < 16; ++i) { const unsigned w = H[lane * 16 + i]; mine += (w & 0xFFFFu) + (w >> 16); }
    unsigned inc = mine;
#pragma unroll
    for (int o = 1; o < 64; o <<= 1) { const unsigned v = __shfl_down(inc, o); if (lane + o < 64) inc += v; }
    const unsigned above = inc - mine; const bool found = (above < need) && (inc >= need);
    const unsigned long long bal = __ballot(found); const int src = bal ? (__ffsll((long long)bal) - 1) : 0;
    const unsigned ab0 = __shfl(above, src);
    unsigned cj = 0;
    if (lane < 32) { const int bidx = src * 32 + 31 - lane; const unsigned w = H[bidx >> 1]; cj = (bidx & 1) ? (w >> 16) : (w & 0xFFFFu); }
    unsigned inc2 = cj;
#pragma unroll
    for (int o = 1; o < 32; o <<= 1) { const unsigned v = __shfl_up(inc2, o); if (lane >= o) inc2 += v; }
    const bool hit = (lane < 32) && (ab0 + inc2 >= need) && (ab0 + inc2 - cj < need);
    const unsigned long long bal2 = __ballot(hit); const int l2 = bal2 ? (__ffsll((long long)bal2) - 1) : 0;
    bin_out = (unsigned)(src * 32 + 31 - l2); above_out = ab0 + __shfl(inc2 - cj, l2);
    return bal != 0ull;
}
template <int EXP>
__device__ __forceinline__ void phase_dsa_topk(KP P, LAS unsigned char* lds, size_t sel_off) {
    int tz = threadIdx.x; asm volatile("" : "+v"(tz)); const int tid = tz, lane = tid & 63, wave = tid >> 6, r32 = lane & 31, hi = lane >> 5;
    const bf16* qkvi = (const bf16*)(P->ws + WS_QKVI); const float* iw = (const float*)(P->ws + WS_IW); int* sel = (int*)(P->ws + sel_off);
    LAS unsigned* sm = (LAS unsigned*)(lds + D1_SM);
    const int G = gridDim.x, nrounds = (D1_NT + G - 1) / G;
    for (int rho = 0; rho < nrounds; ++rho) {
        const int pos = (rho & 1) ? (G - 1 - (int)blockIdx.x) : (int)blockIdx.x, i = rho * G + pos;
        if (i >= D1_NT) continue;
        const int qt = 255 - (i >> 2), b = i & 3, t0 = qt * 32, tok0 = b * SEQ + t0;
        for (int w = tid; w < (D1_SM + 1024) / 4; w += 512) ((LAS unsigned*)lds)[w] = 0u;
        bf16x8 qb[4][4]; float wv[4];
        { const bf16* qp = qkvi + (size_t)(tok0 + r32) * QLD + COL_IQ + 8 * hi;
#pragma unroll
          for (int h = 0; h < 4; ++h)
#pragma unroll
              for (int ks = 0; ks < 4; ++ks) qb[h][ks] = *(const bf16x8*)(qp + h * IDX_DIM + 16 * ks);
          const f32x4 w4 = *(const f32x4*)(iw + (size_t)(tok0 + r32) * 4); wv[0] = w4[0]; wv[1] = w4[1]; wv[2] = w4[2]; wv[3] = w4[3]; }
        const bf16* ikb = qkvi + (size_t)b * SEQ * QLD + COL_IK;
        __syncthreads();
        d1_scan<1, EXP>(ikb, qt, 7, wave, lane, qb, wv, lds, 0u);
        __syncthreads();
#pragma unroll 1
        for (int qq = 0; qq < 4; ++qq) { const int q = wave * 4 + qq; const unsigned n = (unsigned)(t0 + q + 1); unsigned klo = 196608u / n; klo = klo > 256u ? 256u : (klo < 1u ? 1u : klo);
            unsigned bs, ab, bmx, ab2; const bool ok1 = d1_find((LAS unsigned*)(lds + q * D1_QS), klo, lane, bs, ab), ok2 = d1_find((LAS unsigned*)(lds + q * D1_QS), 1u, lane, bmx, ab2);
            if (lane == 0) { const unsigned klo_key = bs << 21, khi_key = (bmx + 1u) << 21;
                const float lo = __uint_as_float((klo_key & 0x80000000u) ? (klo_key & 0x7FFFFFFFu) : ~klo_key), hi2 = __uint_as_float((khi_key & 0x80000000u) ? (khi_key & 0x7FFFFFFFu) : ~khi_key);
                const float span = (hi2 - lo) * 1.5f; const bool good = ok1 && ok2 && bmx < 2046u && span > 0.f && span < 3.0e38f;
                sm[q] = __float_as_uint(lo); sm[32 + q] = __float_as_uint(good ? 2047.f / span : 0.f); if (!good) sm[224] = 1u; } }
        __syncthreads();
        for (int w = tid; w < D1_SM / 4; w += 512) ((LAS unsigned*)lds)[w] = 0u;
        const float f_lo = __uint_as_float(sm[r32]), f_inv = __uint_as_float(sm[32 + r32]);
        __syncthreads();
        d1_scan<4, EXP>(ikb, qt, qt, wave, lane, qb, wv, lds, 0u, f_lo, f_inv);
        __syncthreads();
#pragma unroll 1
        for (int qq = 0; qq < 4; ++qq) { const int q = wave * 4 + qq; unsigned bin, ab; const bool ok = d1_find((LAS unsigned*)(lds + q * D1_QS), 256u, lane, bin, ab);
            if (lane == 0) { sm[64 + q] = bin; sm[96 + q] = 256u - ab; if (!ok || bin == 2047u) sm[224] = 1u; } }
        __syncthreads();
        for (int w = tid; w < D1_SM / 4; w += 512) ((LAS unsigned*)lds)[w] = 0u;
#ifndef D1_FORCE_FB
#define D1_FORCE_FB 0
#endif
        const unsigned f_bs = sm[64 + r32]; bool fast_ok = (sm[224] == 0u) && !D1_FORCE_FB;
        __syncthreads();
        if (fast_ok) {
            d1_scan<5, EXP>(ikb, qt, qt, wave, lane, qb, wv, lds, 0u, f_lo, f_inv, f_bs);
            __syncthreads();
            if (tid < 32 && sm[160 + tid] > 256u) sm[224] = 1u;
            __syncthreads();
            fast_ok = (sm[224] == 0u);
            __syncthreads();
        }
        if (!fast_ok) {
        for (int w = tid; w < (D1_SM + 1024) / 4; w += 512) ((LAS unsigned*)lds)[w] = 0u;
        __syncthreads();
        d1_scan<1, EXP>(ikb, qt, qt, wave, lane, qb, wv, lds, 0u);
        __syncthreads();
#pragma unroll 1
        for (int qq = 0; qq < 4; ++qq) { const int q = wave * 4 + qq; unsigned bin, ab; d1_find((LAS unsigned*)(lds + q * D1_QS), 256u, lane, bin, ab); if (lane == 0) { sm[q] = bin; sm[32 + q] = ab; } }
        __syncthreads();
        for (int w = tid; w < D1_SM / 4; w += 512) ((LAS unsigned*)lds)[w] = 0u;
        const unsigned b1 = sm[r32];
        __syncthreads();
        d1_scan<2, EXP>(ikb, qt, qt, wave, lane, qb, wv, lds, b1);
        __syncthreads();
#pragma unroll 1
        for (int qq = 0; qq < 4; ++qq) { const int q = wave * 4 + qq; const unsigned need2 = 256u - sm[32 + q]; unsigned bin, ab; d1_find((LAS unsigned*)(lds + q * D1_QS), need2, lane, bin, ab);
            if (lane == 0) { sm[64 + q] = (sm[q] << 11) | bin; sm[96 + q] = need2 - ab; } }
        __syncthreads();
        for (int w = tid; w < D1_SM / 4; w += 512) ((LAS unsigned*)lds)[w] = 0u;
        const unsigned T22 = sm[64 + r32];
        __syncthreads();
        d1_scan<3, EXP>(ikb, qt, qt, wave, lane, qb, wv, lds, T22);
        __syncthreads();
        }
#pragma unroll 1
        for (int qq = 0; qq < 4; ++qq) { const int q = wave * 4 + qq;
            const unsigned cc = sm[160 + q] < 256u ? sm[160 + q] : 256u, need3 = sm[96 + q];
            LAS unsigned* cand = (LAS unsigned*)(lds + q * D1_QS); LAS unsigned short* cidx = (LAS unsigned short*)(cand + 256); LAS unsigned* bm = cand + 512; LAS unsigned* tb = cand + 768;
            unsigned tw[4]; int cz = 0;
#pragma unroll
            for (int w = 0; w < 4; ++w) { tw[w] = tb[lane * 4 + w]; cz += __popc(tw[w]); }
            int incz = cz;
#pragma unroll
            for (int o = 1; o < 64; o <<= 1) { const int v = __shfl_up(incz, o); if (lane >= o) incz += v; }
            const int cztot = __shfl(incz, 63);
            int npos = 0;
            for (unsigned ci = lane; ci < ((cc + 63u) & ~63u); ci += 64) { const bool act = ci < cc; const unsigned mine = act ? cand[ci] : 0u; const unsigned mi = act ? (unsigned)cidx[ci] : 0u;
                npos += __popcll(__ballot(act && mine > 0x80000000u));
                unsigned rank = (mine < 0x80000000u) ? (unsigned)cztot : 0u;
                for (unsigned j = 0; j < cc; ++j) { const unsigned kj = cand[j]; const unsigned ij = (unsigned)cidx[j]; rank += (kj > mine || (kj == mine && ij < mi)) ? 1u : 0u; }
                if (act && rank < need3) (void)__hip_atomic_fetch_or(bm + (mi >> 5), 1u << (mi & 31u), __ATOMIC_RELAXED, __HIP_MEMORY_SCOPE_WORKGROUP); }
            { int need_z = (int)need3 - npos; need_z = need_z < 0 ? 0 : (need_z > cztot ? cztot : need_z);
              if (need_z > 0) { int pre = incz - cz;
#pragma unroll
                for (int w = 0; w < 4; ++w) { unsigned bits = tw[w]; const int pc = __popc(bits); int k = need_z - pre; k = k < 0 ? 0 : (k > pc ? pc : k);
                    unsigned keep = 0u; for (int x = 0; x < k; ++x) { const unsigned low = bits & (0u - bits); keep |= low; bits ^= low; }
                    if (keep) (void)__hip_atomic_fetch_or(bm + lane * 4 + w, keep, __ATOMIC_RELAXED, __HIP_MEMORY_SCOPE_WORKGROUP);
                    pre += pc; } } }
            asm volatile("s_waitcnt lgkmcnt(0)" ::: "memory");
            unsigned wds[4]; int c = 0;
#pragma unroll
            for (int w = 0; w < 4; ++w) { wds[w] = bm[lane * 4 + w]; c += __popc(wds[w]); }
            int inc = c;
#pragma unroll
            for (int o = 1; o < 64; o <<= 1) { const int v = __shfl_up(inc, o); if (lane >= o) inc += v; }
            const int total = __shfl(inc, 63); int off = inc - c;
            int* op = sel + (size_t)(tok0 + q) * TOPK;
            if (EXP != 7)
#pragma unroll
            for (int w = 0; w < 4; ++w) { unsigned bits = wds[w]; const int kb = lane * 128 + w * 32;
                while (bits) { const int k = __ffs((int)bits) - 1; if (off < TOPK) op[off] = kb + k; ++off; bits &= bits - 1u; } }
            for (int j = total + lane; j < TOPK; j += 64) op[j] = t0 + q;
        }
        __syncthreads();
    }
}

constexpr int CW_DQ = 16384 + 1024;
__device__ __forceinline__ void phase_dsa_attn(KP P, int L, LAS unsigned char* lds) {
    int tz = threadIdx.x; asm volatile("" : "+v"(tz)); const int tid = tz, lane = tid & 63, wave = tid >> 6;
    const bf16* qkvi = (const bf16*)(P->ws + WS_QKVI); const int* sel = (const int*)(P->ws + WS_SEL); bf16* attn = (bf16*)(P->ws + WS_ATTN);
    unsigned* qh = (unsigned*)(P->ws + WS_CTL) + CW_DQ + L * 8 * 64;
    LAS unsigned* idxs = (LAS unsigned*)(lds + wave * 8192);
    LAS float* pl = (LAS float*)(lds + wave * 8192 + 1024);
    LAS int* wq = (LAS int*)(lds + 65536 + wave * 16);
    const int r = lane & 3, ts_l = (lane & 15) >> 2, kq = lane >> 4, c16 = lane & 15;
    const unsigned myq = xb_xcc_id() & 7u;
    constexpr float CC = 0.08838834764831845f * 1.4426950408889634f;
    for (int qi = 0; qi < 8; ++qi) {
        const int qx = (int)((myq + (unsigned)qi) & 7u), b = qx >> 1, g = qx & 1;
        for (;;) {
            int item = 0;
            if (lane == 0) item = (int)__hip_atomic_fetch_add(qh + qx * 64, 1u, __ATOMIC_RELAXED, __HIP_MEMORY_SCOPE_AGENT);
            item = __builtin_amdgcn_readfirstlane(item);
            if (item >= SEQ) break;
            const int t = SEQ - 1 - item, tok = b * SEQ + t, cnt = (t + 1 < TOPK) ? (t + 1) : TOPK;
#pragma unroll
            for (int i = 0; i < 4; ++i) { const int j = lane + 64 * i; int sidx = 0; if (j < cnt) sidx = (t < TOPK) ? j : sel[(size_t)tok * TOPK + j]; idxs[j] = (unsigned)sidx; }
            asm volatile("s_waitcnt lgkmcnt(0)" ::: "memory");
            bf16x8 qm[4][4];
            { const bf16* qp = qkvi + (size_t)tok * QLD + (g * 4 + r) * HEAD_DIM + 8 * kq;
#pragma unroll
              for (int ks = 0; ks < 4; ++ks) { const bf16x8 v = *(const bf16x8*)(qp + 32 * ks);
#pragma unroll
                  for (int ts = 0; ts < 4; ++ts) qm[ts][ks] = (ts_l == ts) ? v : (bf16x8){0, 0, 0, 0, 0, 0, 0, 0}; } }
            f32x4 C[4];
            const bf16* kbase = qkvi + (size_t)b * SEQ * QLD + COL_K + g * HEAD_DIM + 8 * kq;
#pragma unroll
            for (int c = 0; c < 4; ++c) {
                C[c] = (f32x4){0.f, 0.f, 0.f, 0.f};
                bf16x8 a[4][4];
#pragma unroll
                for (int ts = 0; ts < 4; ++ts) { const unsigned sk = idxs[(4 * c + ts) * 16 + c16]; const bf16* kp = kbase + (size_t)sk * QLD;
#pragma unroll
                    for (int ks = 0; ks < 4; ++ks) a[ts][ks] = *(const bf16x8*)(kp + 32 * ks); }
#pragma unroll
                for (int ts = 0; ts < 4; ++ts)
#pragma unroll
                    for (int ks = 0; ks < 4; ++ks) C[c] = __builtin_amdgcn_mfma_f32_16x16x32_bf16(a[ts][ks], qm[ts][ks], C[c], 0, 0, 0);
            }
            const float bias2 = __builtin_amdgcn_exp2f(-(float)(g * 4 + r + 1)) * 1.4426950408889634f;
            float x[16]; float m = -INFINITY;
#pragma unroll
            for (int c = 0; c < 4; ++c) { const int k0 = (4 * c + ts_l) * 16 + 4 * kq; const u32x4 sp = *(const LAS u32x4*)(idxs + k0);
#pragma unroll
                for (int j = 0; j < 4; ++j) { const float v = (k0 + j < cnt) ? fmaf(C[c][j], CC, bias2 * (float)((int)sp[j] - t)) : -INFINITY; x[c * 4 + j] = v; m = fmaxf(m, v); } }
            m = fmaxf(m, __shfl_xor(m, 4)); m = fmaxf(m, __shfl_xor(m, 8)); m = fmaxf(m, __shfl_xor(m, 16)); m = fmaxf(m, __shfl_xor(m, 32));
            float sum = 0.f;
#pragma unroll
            for (int i = 0; i < 16; ++i) { x[i] = __builtin_amdgcn_exp2f(x[i] - m); sum += x[i]; }
            sum += __shfl_xor(sum, 4); sum += __shfl_xor(sum, 8); sum += __shfl_xor(sum, 16); sum += __shfl_xor(sum, 32);
            const float inv = 1.f / sum;
#pragma unroll
            for (int c = 0; c < 4; ++c) { const int k0 = (4 * c + ts_l) * 16 + 4 * kq;
#pragma unroll
                for (int j = 0; j < 4; ++j) pl[(k0 + j) * 4 + r] = x[c * 4 + j] * inv; }
            asm volatile("s_waitcnt lgkmcnt(0)" ::: "memory");
            float acc[4][8];
#pragma unroll
            for (int rr = 0; rr < 4; ++rr)
#pragma unroll
                for (int i = 0; i < 8; ++i) acc[rr][i] = 0.f;
            const bf16* vbase = qkvi + (size_t)b * SEQ * QLD + COL_V + g * HEAD_DIM + 8 * c16;
            const int nk4 = (cnt + 3) >> 2;
#pragma unroll 4
            for (int j4 = 0; j4 < nk4; ++j4) {
                const int key = 4 * j4 + kq; const unsigned sk = idxs[key];
                const u32x4 vv = *(const u32x4*)(vbase + (size_t)sk * QLD);
                const f32x4 pp = *(const LAS f32x4*)(pl + key * 4);
                const float vf[8] = {bflo(vv.x), bfhi(vv.x), bflo(vv.y), bfhi(vv.y), bflo(vv.z), bfhi(vv.z), bflo(vv.w), bfhi(vv.w)};
#pragma unroll
                for (int rr = 0; rr < 4; ++rr)
#pragma unroll
                    for (int i = 0; i < 8; ++i) acc[rr][i] = fmaf(pp[rr], vf[i], acc[rr][i]);
            }
#pragma unroll
            for (int rr = 0; rr < 4; ++rr)
#pragma unroll
                for (int i = 0; i < 8; ++i) { float v = acc[rr][i]; v += __shfl_xor(v, 16); v += __shfl_xor(v, 32); acc[rr][i] = v; }
            if (kq == 0) {
#pragma unroll
                for (int rr = 0; rr < 4; ++rr) { u32x4 o; o.x = cvt_pk_bf16(acc[rr][0], acc[rr][1]); o.y = cvt_pk_bf16(acc[rr][2], acc[rr][3]); o.z = cvt_pk_bf16(acc[rr][4], acc[rr][5]); o.w = cvt_pk_bf16(acc[rr][6], acc[rr][7]);
                    *(u32x4*)(attn + (size_t)tok * D_MODEL + (g * 4 + rr) * HEAD_DIM + 8 * c16) = o; }
            }
        }
    }
    (void)wq;
}


__device__ __forceinline__ int d2_swz(int i) { return ((i & 3) << 2) | ((i >> 2) & 3); }
__device__ __forceinline__ void phase_dsa_attn2(KP P, int L, LAS unsigned char* lds) {
    typedef short s16x4 __attribute__((ext_vector_type(4)));
    int tz = threadIdx.x; asm volatile("" : "+v"(tz)); const int tid = tz, lane = tid & 63, wave = __builtin_amdgcn_readfirstlane(tid >> 6);
    const bf16* qkvi = (const bf16*)(P->ws + WS_QKVI); const int* sel = (const int*)(P->ws + WS_SEL); bf16* attn = (bf16*)(P->ws + WS_ATTN);
    unsigned* qh = (unsigned*)(P->ws + WS_CTL) + CW_DQ + L * 8 * 64;
    LAS unsigned char* wl = lds + wave * 19456;
    LAS unsigned* idxs = (LAS unsigned*)wl;
    LAS unsigned char* pb = wl + 1024;
    LAS unsigned char* ring = wl + 3072;
    const int n16 = lane & 15, r = lane & 3, ts_l = n16 >> 2, kq = lane >> 4;
    const unsigned myq = xb_xcc_id() & 7u;
    constexpr float CC = 0.08838834764831845f * 1.4426950408889634f;
    unsigned dch[4];
#pragma unroll
    for (int j = 0; j < 4; ++j) dch[j] = (unsigned)((n16 ^ d2_swz(4 * j + kq)) * 16);
    unsigned aoff[4];
#pragma unroll
    for (int ks = 0; ks < 4; ++ks) aoff[ks] = (unsigned)(n16 * 256 + (((4 * ks + kq) ^ d2_swz(n16)) * 16));
    for (int qi = 0; qi < 8; ++qi) {
        const int qx = (int)((myq + (unsigned)qi) & 7u), b = qx >> 1, g = qx & 1;
        const char* kgb = (const char*)(qkvi + (size_t)b * SEQ * QLD + COL_K + g * HEAD_DIM);
        int item = 0;
        if (lane == 0) item = (int)__hip_atomic_fetch_add(qh + qx * 64, 1u, __ATOMIC_RELAXED, __HIP_MEMORY_SCOPE_AGENT);
        item = __builtin_amdgcn_readfirstlane(item);
        bool have_pf = false; int sx[4] = {0, 0, 0, 0}; bf16x8 qv[4] = {};
        while (item < SEQ) {
            const int t = SEQ - 1 - item, tok = b * SEQ + t, cnt = (t + 1 < TOPK) ? (t + 1) : TOPK;
            if (!have_pf) {
#pragma unroll
                for (int i = 0; i < 4; ++i) { const int j = lane + 64 * i; sx[i] = (t < TOPK) ? j : sel[(size_t)tok * TOPK + j]; }
                const bf16* qp = qkvi + (size_t)tok * QLD + (g * 4 + r) * HEAD_DIM + 8 * kq;
#pragma unroll
                for (int ks = 0; ks < 4; ++ks) qv[ks] = *(const bf16x8*)(qp + 32 * ks);
            }
#pragma unroll
            for (int i = 0; i < 4; ++i) { const int j = lane + 64 * i; idxs[j] = (j < cnt) ? (unsigned)sx[i] : 0u; }
            bf16x8 qm[4][4];
#pragma unroll
            for (int ks = 0; ks < 4; ++ks) {
#pragma unroll
                for (int ts = 0; ts < 4; ++ts) qm[ts][ks] = (ts_l == ts) ? qv[ks] : (bf16x8){0, 0, 0, 0, 0, 0, 0, 0}; }
            asm volatile("s_waitcnt vmcnt(0) lgkmcnt(0)" ::: "memory");
#define D2_ISSUE(s) do { const int kb_ = (s) & 15; const char* gb_ = kgb + ((s) >= 16 ? (COL_V - COL_K) * 2 : 0); LAS unsigned char* sl_ = ring + ((s) & 3) * 4096; \
        _Pragma("unroll") for (int j = 0; j < 4; ++j) { const unsigned sk_ = idxs[kb_ * 16 + 4 * j + kq]; \
            __builtin_amdgcn_global_load_lds((const unsigned*)(gb_ + (size_t)sk_ * (QLD * 2) + dch[j]), (LAS unsigned*)(sl_ + j * 1024), 16, 0, 0); } } while (0)
            int nraw = 0;
            if (lane == 0) nraw = (int)__hip_atomic_fetch_add(qh + qx * 64, 1u, __ATOMIC_RELAXED, __HIP_MEMORY_SCOPE_AGENT);
            D2_ISSUE(0); D2_ISSUE(1); D2_ISSUE(2); D2_ISSUE(3);
            f32x4 C[4];
#pragma unroll
            for (int c = 0; c < 4; ++c) C[c] = (f32x4){0.f, 0.f, 0.f, 0.f};
#pragma unroll
            for (int s2 = 0; s2 < 16; ++s2) {
                asm volatile("s_waitcnt vmcnt(12)" ::: "memory");
                LAS unsigned char* sl = ring + (s2 & 3) * 4096;
                bf16x8 a[4];
#pragma unroll
                for (int ks = 0; ks < 4; ++ks) a[ks] = *(const LAS bf16x8*)(sl + aoff[ks]);
#pragma unroll
                for (int ks = 0; ks < 4; ++ks) C[s2 >> 2] = __builtin_amdgcn_mfma_f32_16x16x32_bf16(a[ks], qm[s2 & 3][ks], C[s2 >> 2], 0, 0, 0);
                asm volatile("s_waitcnt lgkmcnt(0)" ::: "memory");
                D2_ISSUE(s2 + 4);
            }
            const float bias2 = __builtin_amdgcn_exp2f(-(float)(g * 4 + r + 1)) * 1.4426950408889634f;
            float x[16]; float m = -INFINITY;
#pragma unroll
            for (int c = 0; c < 4; ++c) { const int k0 = (4 * c + ts_l) * 16 + 4 * kq; const u32x4 sp = *(const LAS u32x4*)(idxs + k0);
#pragma unroll
                for (int j = 0; j < 4; ++j) { const float v = (k0 + j < cnt) ? fmaf(C[c][j], CC, bias2 * (float)((int)sp[j] - t)) : -INFINITY; x[c * 4 + j] = v; m = fmaxf(m, v); } }
            m = fmaxf(m, __shfl_xor(m, 4)); m = fmaxf(m, __shfl_xor(m, 8)); m = fmaxf(m, __shfl_xor(m, 16)); m = fmaxf(m, __shfl_xor(m, 32));
            float sum = 0.f;
#pragma unroll
            for (int i = 0; i < 16; ++i) { x[i] = __builtin_amdgcn_exp2f(x[i] - m); sum += x[i]; }
            sum += __shfl_xor(sum, 4); sum += __shfl_xor(sum, 8); sum += __shfl_xor(sum, 16); sum += __shfl_xor(sum, 32);
            const float inv = 1.f / sum;
#pragma unroll
            for (int c = 0; c < 4; ++c) { const int k0 = (4 * c + ts_l) * 16 + 4 * kq;
                u32x2 w; w.x = cvt_pk_bf16(x[c * 4 + 0] * inv, x[c * 4 + 1] * inv); w.y = cvt_pk_bf16(x[c * 4 + 2] * inv, x[c * 4 + 3] * inv);
                *(LAS u32x2*)(pb + (r * 256 + k0) * 2) = w; }
            asm volatile("s_waitcnt lgkmcnt(0)" ::: "memory");
            f32x4 O[8]; int nitem = SEQ;
#pragma unroll
            for (int db = 0; db < 8; ++db) O[db] = (f32x4){0.f, 0.f, 0.f, 0.f};
            const int q4 = n16 >> 2, p4 = n16 & 3;
#pragma unroll
            for (int u = 0; u < 8; ++u) {
                if (u < 7) asm volatile("s_waitcnt vmcnt(8)" ::: "memory"); else asm volatile("s_waitcnt vmcnt(0)" ::: "memory");
                LAS unsigned char* sl = ring + (((2 * u) & 3) + (kq >> 1)) * 4096;
                const bf16x8 pf = *(const LAS bf16x8*)(pb + (r * 256 + u * 32 + 8 * kq) * 2);
#pragma unroll
                for (int db = 0; db < 8; ++db) {
                    const int i0 = 8 * (kq & 1) + q4, i1 = i0 + 4;
                    const int a0 = (int)(unsigned)(uintptr_t)(sl + i0 * 256 + (((2 * db + (p4 >> 1)) ^ d2_swz(i0)) * 16) + 8 * (p4 & 1));
                    const int a1 = (int)(unsigned)(uintptr_t)(sl + i1 * 256 + (((2 * db + (p4 >> 1)) ^ d2_swz(i1)) * 16) + 8 * (p4 & 1));
                    const s16x4 v0 = mb::tr_read<0>(a0), v1 = mb::tr_read<0>(a1);
                    asm volatile("s_waitcnt lgkmcnt(0)" ::: "memory");
                    const bf16x8 vf = {v0[0], v0[1], v0[2], v0[3], v1[0], v1[1], v1[2], v1[3]};
                    O[db] = __builtin_amdgcn_mfma_f32_16x16x32_bf16(vf, pf, O[db], 0, 0, 0);
                }
                if (u == 0) {
                    nitem = __builtin_amdgcn_readfirstlane(nraw); have_pf = nitem < SEQ;
                    if (have_pf) { const int tn = SEQ - 1 - nitem, tokn = b * SEQ + tn;
#pragma unroll
                        for (int i = 0; i < 4; ++i) { const int j = lane + 64 * i; sx[i] = (tn < TOPK) ? j : sel[(size_t)tokn * TOPK + j]; }
                        const bf16* qpn = qkvi + (size_t)tokn * QLD + (g * 4 + r) * HEAD_DIM + 8 * kq;
#pragma unroll
                        for (int ks = 0; ks < 4; ++ks) qv[ks] = *(const bf16x8*)(qpn + 32 * ks); } }
                if (u < 6) { D2_ISSUE(16 + 2 * u + 4); D2_ISSUE(16 + 2 * u + 5); }
            }
#undef D2_ISSUE
            if (n16 < 4) {
                bf16* op = attn + (size_t)tok * D_MODEL + (g * 4 + n16) * HEAD_DIM + 4 * kq;
#pragma unroll
                for (int db = 0; db < 8; ++db) { u32x2 w; w.x = cvt_pk_bf16(O[db][0], O[db][1]); w.y = cvt_pk_bf16(O[db][2], O[db][3]); *(u32x2*)(op + 16 * db) = w; }
            }
            item = nitem;
        }
    }
}

__device__ __forceinline__ int opq(int x) { asm volatile("" : "+s"(x)); return x; }
__device__ __forceinline__ bool phase_active(int L, int k) {
    if (k >= 2 && k <= 6) { if (L < N_A) return k <= 3; if (k == 2) return L == N_A; }
    return k <= 14;
}
__global__ void __launch_bounds__(512, 2) fwd(Params P) {
    extern __shared__ __attribute__((aligned(16))) unsigned char lds_raw[];
    LAS unsigned char* lds = (LAS unsigned char*)lds_raw;
    const int tid = threadIdx.x;
    unsigned char* ws0 = P.ws;
    if (tid < 16) ((LAS unsigned*)(lds + LDS_MISC))[tid] = 0u;
    __syncthreads();
    const int lo = P.ph_lo, hi = P.ph_hi;
    const bool multi = (hi - lo) > 1;
    unsigned* barw = (unsigned*)(ws0 + WS_CTL) + CW_BAR + P.bar_idx * XCD_BAR_WORDS;
    XcdBarrier bar; bar.bar = barw; bar.x = 0; bar.st = nullptr;
    if (multi) bar = xcd_barrier_post(barw, (volatile LAS unsigned*)(lds + LDS_MISC));
#ifndef PHASE_MASK
#define PHASE_MASK 0xFFFF
#endif
#define IN(k) (((PHASE_MASK >> (k)) & 1) && opq(lo) <= (pb + (k)) && (pb + (k)) < hi && phase_active(L, (k)))
#define SEAM(k) do { if (IN(k) && (pb + (k) + 1) < hi) xcd_barrier(bar); } while (0)
#ifndef PROBE_MASK
#define PROBE_MASK 0
#endif
#define PROBED(k) (((PROBE_MASK) >> (k)) & 1)
    const int G = gridDim.x, c = blockIdx.x;
    for (int L = 0; L < DEPTH; ++L) {
        const int pb = L * 16;
        if (pb + 16 <= lo || pb >= hi) continue;
        const bool isA = L < N_A;
        if (IN(0)) { for (int rep = PROBED(0) ? 0 : 1; rep < 2; ++rep) { phase_convert(fresh_params(), L, lds); if (rep == 0) xcd_barrier(bar); } } SEAM(0);
        if (IN(1)) { for (int rep = PROBED(1) ? 0 : 1; rep < 2; ++rep) {
            KP Q = fresh_params(); unsigned char* ws = Q->ws; bf16* hb = (bf16*)(ws + WS_HB);
            if (isA) {
                gm::DenseOrder S; S.init(hb, ws + WS_WMIX, NTOK, 2048, D_MODEL, G, c);
                gm::EpiBf16 E{(bf16*)(ws + WS_QKVI), QLD, (float*)(ws + WS_IW)};
                gm::gemm_phase<gm::EpiBf16, gm::DenseOrder, false>(lds, D_MODEL, S, E);
            } else {
                if (L == N_A) {
                    gm::DenseOrder S; S.init(hb, ws + WS_WMIX + 6 * MiB, NTOK, 512, D_MODEL, G, c);
                    gm::EpiBf16 E{(bf16*)(ws + WS_KV), 512, nullptr};
                    gm::gemm_phase<gm::EpiBf16, gm::DenseOrder, false>(lds, D_MODEL, S, E);
                }
                gm::DenseOrder S; S.init(hb, ws + WS_WMIX, NTOK, D_MODEL, D_MODEL, G, c);
                gm::EpiBf16 E{(bf16*)(ws + WS_QKVI), D_MODEL, nullptr};
                gm::gemm_phase<gm::EpiBf16, gm::DenseOrder, false>(lds, D_MODEL, S, E);
            }
            if (rep == 0) xcd_barrier(bar);
        } } SEAM(1);
        if (IN(2)) { if (isA) { if (PROBED(2)) { phase_dsa_topk<D1_EXP>(fresh_params(), lds, WS_PL); xcd_barrier(bar); } phase_dsa_topk<0>(fresh_params(), lds, WS_SEL); } else phase_kmeans(fresh_params()); } SEAM(2);
        if (IN(3)) { if (isA) { for (int rep = PROBED(3) ? 0 : 1; rep < 2; ++rep) { phase_dsa_attn2(fresh_params(), rep == 0 ? L + 2 : L, lds); if (rep == 0) xcd_barrier(bar); } } else { for (int rep = PROBED(4) ? 0 : 1; rep < 2; ++rep) { phase_moba_gate2(fresh_params()); if (rep == 0) xcd_barrier(bar); } } } SEAM(3);
        if (IN(4)) { phase_moba_lists(fresh_params(), lds); } SEAM(4);
        if (IN(5)) { for (int rep = PROBED(5) ? 0 : 1; rep < 2; ++rep) { phase_moba_attn2(fresh_params(), (L - N_A) * 2 + rep, lds); if (rep == 0) xcd_barrier(bar); } } SEAM(5);
        if (IN(6)) { for (int rep = PROBED(6) ? 0 : 1; rep < 2; ++rep) { phase_moba_combine(fresh_params()); if (rep == 0) xcd_barrier(bar); } } SEAM(6);
        if (IN(7)) { for (int rep = PROBED(7) ? 0 : 1; rep < 2; ++rep) {
            KP Q = fresh_params(); unsigned char* ws = Q->ws; const float* hres = (L == 0) ? Q->in[0] : (const float*)(ws + WS_H); float* t = (float*)(ws + WS_T);
            { gm::DenseOrder S; S.init(ws + WS_ATTN, ws + WS_WMIX + 4 * MiB, NTOK, D_MODEL, D_MODEL, G, c);
              gm::EpiResid E{hres, t};
              gm::gemm_phase<gm::EpiResid, gm::DenseOrder, false>(lds, D_MODEL, S, E); }
            { gm::DenseOrder S; S.init(ws + WS_PB, ws + WS_WPLE, NTOK, D_MODEL, PLE_DIM, G, c);
              gm::EpiBf16 E{(bf16*)(ws + WS_PL), D_MODEL, nullptr};
              gm::gemm_phase<gm::EpiBf16, gm::DenseOrder, false>(lds, PLE_DIM, S, E); }
            if (rep == 0) xcd_barrier(bar);
        } } SEAM(7);
        if (IN(8)) { for (int rep = PROBED(8) ? 0 : 1; rep < 2; ++rep) { phase_ln_router(fresh_params(), L, lds, rep == 0 ? L + 4 : L); if (rep == 0) xcd_barrier(bar); } } SEAM(8);
        if (IN(9)) { phase_moe_prep(fresh_params(), L, lds); } SEAM(9);
        if (IN(10)) { for (int rep = PROBED(10) ? 0 : 1; rep < 2; ++rep) {
            KP Q = fresh_params(); unsigned char* ws = Q->ws; bf16* hb = (bf16*)(ws + WS_HB);
            const int* moe = (const int*)(ws + WS_MOE);
            gm::MoeOrder S; S.tile_e = moe + MO_TILE_E; S.tile_row0 = moe + MO_TILE_ROW0; S.tile_nv = moe + MO_TILE_NV; S.slot_tok = moe + MO_SLOT_TOK;
            S.n_units = (int)*((const unsigned*)(ws + WS_CTL) + CW_NTILES + L) * 4; S.G = G; S.c = c; S.K = D_MODEL; S.A = (const char*)hb; S.W = (const char*)(ws + WS_WGU);
            S.wstride = (size_t)D_MODEL * D_MODEL * 2; S.tB = (size_t)256 * D_MODEL * 2; S.gath = true;
            gm::EpiSwiglu E{(bf16*)(ws + WS_ACT)};
            gm::gemm_phase<gm::EpiSwiglu, gm::MoeOrder, true>(lds, D_MODEL, S, E);
            if (rep == 0) xcd_barrier(bar);
        } } SEAM(10);
        if (IN(11)) { for (int rep = PROBED(11) ? 0 : 1; rep < 2; ++rep) {
            KP Q = fresh_params(); unsigned char* ws = Q->ws;
            const int* moe = (const int*)(ws + WS_MOE);
            gm::MoeOrder S; S.tile_e = moe + MO_TILE_E; S.tile_row0 = moe + MO_TILE_ROW0; S.tile_nv = moe + MO_TILE_NV; S.slot_tok = moe + MO_SLOT_TOK;
            S.n_units = (int)*((const unsigned*)(ws + WS_CTL) + CW_NTILES + L) * 4; S.G = G; S.c = c; S.K = D_EXPERT; S.A = (const char*)(ws + WS_ACT); S.W = (const char*)(ws + WS_WD);
            S.wstride = (size_t)D_MODEL * D_EXPERT * 2; S.tB = (size_t)256 * D_EXPERT * 2; S.gath = false;
            gm::EpiMoeDown E{(bf16*)(ws + WS_Y)};
            gm::gemm_phase<gm::EpiMoeDown, gm::MoeOrder, false>(lds, D_EXPERT, S, E);
            if (rep == 0) xcd_barrier(bar);
        } } SEAM(11);
        if (IN(12)) { KP Q = fresh_params(); phase_ln<1, false>(Q, L, 1, lds, (float*)(Q->ws + WS_H), true); } SEAM(12);
        if (IN(13)) { for (int rep = PROBED(13) ? 0 : 1; rep < 2; ++rep) {
            KP Q = fresh_params(); unsigned char* ws = Q->ws; bf16* hb = (bf16*)(ws + WS_HB); float* h = (float*)(ws + WS_H); float* t = (float*)(ws + WS_T);
            gm::DenseOrder S; S.init(hb, ws + WS_WPG, NTOK, D_MODEL, D_MODEL, G, c);
            gm::EpiPle E{h, (const bf16*)(ws + WS_PL), t};
            gm::gemm_phase<gm::EpiPle, gm::DenseOrder, false>(lds, D_MODEL, S, E);
            if (rep == 0) xcd_barrier(bar);
        } } SEAM(13);
        if (IN(14)) { for (int rep = PROBED(14) ? 0 : 1; rep < 2; ++rep) { KP Q = fresh_params(); phase_ln<0, false>(Q, L, 2, lds, (L == DEPTH - 1) ? Q->out : (float*)(Q->ws + WS_H), L != DEPTH - 1); if (rep == 0) xcd_barrier(bar); } }
        if (L != DEPTH - 1) SEAM(14);
    }
#undef IN
#undef SEAM
}

#ifndef DEBUG_ATTN
#define DEBUG_ATTN 0
#endif
#if DEBUG_ATTN
__global__ void __launch_bounds__(256) dsa_scores(const bf16* __restrict__ qkvi  , const float* __restrict__ iw  , float* __restrict__ sc) {
    const int s0 = blockIdx.x * 64, t0 = blockIdx.y * 64;
    if (s0 > t0) return;
    __shared__ float Qs[64][68];
    __shared__ float Ks[64][68];
    const int tid = threadIdx.x, r = tid >> 2, kq = (tid & 3) * 16;
    {
        const bf16* kp = qkvi + (size_t)(s0 + r) * QLD + COL_IK + kq;
#pragma unroll
        for (int i = 0; i < 16; ++i) Ks[kq + i][r] = bf2f(kp[i]);
    }
    const int ty = tid >> 4, tx = tid & 15;
    float tot[4][4];
#pragma unroll
    for (int i = 0; i < 4; ++i)
#pragma unroll
        for (int j = 0; j < 4; ++j) tot[i][j] = 0.f;
    for (int hh = 0; hh < IDX_HEADS; ++hh) {
        __syncthreads();
        const bf16* qp = qkvi + (size_t)(t0 + r) * QLD + COL_IQ + hh * IDX_DIM + kq;
#pragma unroll
        for (int i = 0; i < 16; ++i) Qs[kq + i][r] = bf2f(qp[i]);
        __syncthreads();
        float acc[4][4];
#pragma unroll
        for (int i = 0; i < 4; ++i)
#pragma unroll
            for (int j = 0; j < 4; ++j) acc[i][j] = 0.f;
#pragma unroll 8
        for (int k = 0; k < 64; ++k) {
            const float4 a4 = *(const float4*)&Qs[k][ty * 4];
            const float4 b4 = *(const float4*)&Ks[k][tx * 4];
            const float a[4] = {a4.x, a4.y, a4.z, a4.w};
            const float b[4] = {b4.x, b4.y, b4.z, b4.w};
#pragma unroll
            for (int i = 0; i < 4; ++i)
#pragma unroll
                for (int j = 0; j < 4; ++j) acc[i][j] += a[i] * b[j];
        }
#pragma unroll
        for (int i = 0; i < 4; ++i) {
            const float w = iw[(size_t)(t0 + ty * 4 + i) * 4 + hh];
#pragma unroll
            for (int j = 0; j < 4; ++j) tot[i][j] += w * fmaxf(acc[i][j], 0.f);
        }
    }
#pragma unroll
    for (int i = 0; i < 4; ++i)
        *(float4*)(sc + (size_t)(t0 + ty * 4 + i) * SEQ + s0 + tx * 4) = make_float4(tot[i][0], tot[i][1], tot[i][2], tot[i][3]);
}

__device__ __forceinline__ unsigned fkey(float f) { const unsigned u = __float_as_uint(f); return (u & 0x80000000u) ? ~u : (u | 0x80000000u); }
__global__ void __launch_bounds__(256) dsa_topk(const float* __restrict__ sc, int* __restrict__ sel) {
    const int t = blockIdx.x, tid = threadIdx.x, n = t + 1;
    int* out = sel + (size_t)t * TOPK;
    if (n <= TOPK) { out[tid] = tid <= t ? tid : 0; return; }
    const float* row = sc + (size_t)t * SEQ;
    __shared__ unsigned hist[256];
    __shared__ unsigned s_prefix, s_need;
    __shared__ int wsum[2][4];
    unsigned prefix = 0, need = TOPK;
    for (int pass = 3; pass >= 0; --pass) {
        hist[tid] = 0;
        __syncthreads();
        for (int i = tid; i < n; i += 256) {
            const unsigned k = fkey(row[i]);
            const bool match = (pass == 3) ? true : ((k >> (8 * (pass + 1))) == prefix);
            if (match) atomicAdd(&hist[(k >> (8 * pass)) & 255u], 1u);
        }
        __syncthreads();
        if (tid == 0) {
            unsigned c = 0; int d = 255;
            for (; d > 0; --d) { if (c + hist[d] >= need) break; c += hist[d]; }
            s_prefix = (prefix << 8) | (unsigned)d; s_need = need - c;
        }
        __syncthreads();
        prefix = s_prefix; need = s_need;
        __syncthreads();
    }
    const unsigned T = prefix;
    const int n_gt = TOPK - (int)need;
    int run_gt = 0, run_eq = 0;
    const int lane = tid & 63, w = tid >> 6;
    for (int base = 0; base < n; base += 256) {
        const int i = base + tid;
        unsigned k = 0; bool gt = false, eq = false;
        if (i < n) { k = fkey(row[i]); gt = k > T; eq = k == T; }
        const unsigned long long mg = __ballot(gt), me = __ballot(eq);
        const unsigned long long lower = (lane == 0) ? 0ull : (~0ull >> (64 - lane));
        const int pg = __popcll(mg & lower), pe = __popcll(me & lower);
        if (lane == 0) { wsum[0][w] = __popcll(mg); wsum[1][w] = __popcll(me); }
        __syncthreads();
        int og = 0, oe = 0, tg = 0, te = 0;
        for (int x = 0; x < 4; ++x) { if (x < w) { og += wsum[0][x]; oe += wsum[1][x]; } tg += wsum[0][x]; te += wsum[1][x]; }
        if (gt) out[run_gt + og + pg] = i;
        if (eq) { const int rk = run_eq + oe + pe; if (rk < (int)need) out[n_gt + rk] = i; }
        run_gt += tg; run_eq += te;
        __syncthreads();
    }
}

__global__ void __launch_bounds__(256) dsa_attn(const bf16* __restrict__ qkvi, const int* __restrict__ sel, bf16* __restrict__ attn) {
    const int tok = blockIdx.x, b = tok / SEQ, t = tok % SEQ, tid = threadIdx.x;
    __shared__ float qs[D_MODEL];
    __shared__ float lg[N_HEADS][TOPK];
    __shared__ int sidx[TOPK];
    const int cnt = (t + 1 < TOPK) ? (t + 1) : TOPK;
    const bf16* prow = qkvi + (size_t)tok * QLD;
#pragma unroll
    for (int i = 0; i < 4; ++i) qs[tid * 4 + i] = bf2f(prow[tid * 4 + i]);
    int s = 0;
    if (tid < cnt) s = (t < TOPK) ? tid : sel[(size_t)tok * TOPK + tid];
    sidx[tid] = s;
    __syncthreads();
    const float scale = 0.08838834764831845f;
    if (tid < cnt) {
        const bf16* krow = qkvi + (size_t)(b * SEQ + s) * QLD + COL_K;
        for (int g = 0; g < N_KV; ++g) {
            float d[4] = {0.f, 0.f, 0.f, 0.f};
            for (int k = 0; k < HEAD_DIM; ++k) {
                const float kv = bf2f(krow[g * HEAD_DIM + k]);
#pragma unroll
                for (int r = 0; r < 4; ++r) d[r] += qs[(g * 4 + r) * HEAD_DIM + k] * kv;
            }
#pragma unroll
            for (int r = 0; r < 4; ++r) {
                const int hh = g * 4 + r;
                const float slope = exp2f(-(float)(hh + 1));
                lg[hh][tid] = d[r] * scale - slope * (float)(t - s);
            }
        }
    } else {
        for (int hh = 0; hh < N_HEADS; ++hh) lg[hh][tid] = -INFINITY;
    }
    __syncthreads();
    {
        const int lane = tid & 63, w = tid >> 6;
        for (int h2 = 0; h2 < 2; ++h2) {
            const int hh = w * 2 + h2;
            float v[4], m = -INFINITY;
#pragma unroll
            for (int i = 0; i < 4; ++i) { v[i] = lg[hh][lane + 64 * i]; m = fmaxf(m, v[i]); }
            for (int o = 32; o > 0; o >>= 1) m = fmaxf(m, __shfl_xor(m, o));
            float sum = 0.f;
#pragma unroll
            for (int i = 0; i < 4; ++i) { v[i] = expf(v[i] - m); sum += v[i]; }
            for (int o = 32; o > 0; o >>= 1) sum += __shfl_xor(sum, o);
            const float inv = 1.f / sum;
#pragma unroll
            for (int i = 0; i < 4; ++i) lg[hh][lane + 64 * i] = v[i] * inv;
        }
    }
    __syncthreads();
    {
        const int col = tid * 4, hh = col / HEAD_DIM, g = hh / HEAD_GROUP, d = col % HEAD_DIM;
        float acc[4] = {0.f, 0.f, 0.f, 0.f};
        for (int j = 0; j < cnt; ++j) {
            const float p = lg[hh][j];
            const u32x2 vv = *(const u32x2*)(qkvi + (size_t)(b * SEQ + sidx[j]) * QLD + COL_V + g * HEAD_DIM + d);
            acc[0] += p * bflo(vv.x); acc[1] += p * bfhi(vv.x); acc[2] += p * bflo(vv.y); acc[3] += p * bfhi(vv.y);
        }
        u32x2 o; o.x = cvt_pk_bf16(acc[0], acc[1]); o.y = cvt_pk_bf16(acc[2], acc[3]);
        *(u32x2*)(attn + (size_t)tok * D_MODEL + col) = o;
    }
}

__global__ void __launch_bounds__(128) kmeans_kernel(const bf16* __restrict__ kv, float* __restrict__ km) {
    const int blk = blockIdx.x % N_BLOCKS, g = (blockIdx.x / N_BLOCKS) % N_KV, b = blockIdx.x / (N_BLOCKS * N_KV), d = threadIdx.x;
    float s = 0.f;
    for (int i = 0; i < MOBA_BLOCK; ++i) s += bf2f(kv[(size_t)(b * SEQ + blk * MOBA_BLOCK + i) * 512 + g * HEAD_DIM + d]);
    km[((size_t)(b * N_KV + g) * N_BLOCKS + blk) * HEAD_DIM + d] = s * (1.f / MOBA_BLOCK);
}

__global__ void __launch_bounds__(256) moba_attn(const bf16* __restrict__ q, const bf16* __restrict__ kv, const float* __restrict__ km, bf16* __restrict__ attn) {
    const int tok = blockIdx.x, b = tok / SEQ, t = tok % SEQ, tid = threadIdx.x, own = t / MOBA_BLOCK;
    __shared__ float qs[HEAD_DIM];
    __shared__ float gate[N_BLOCKS];
    __shared__ int selb[3];
    __shared__ float lg[4 * MOBA_BLOCK];
    __shared__ float red[8];
    __shared__ float part[2][HEAD_DIM];
    const float scale = 0.08838834764831845f;
    for (int hh = 0; hh < N_HEADS; ++hh) {
        const int g = hh / HEAD_GROUP;
        const float slope = exp2f(-(float)(hh + 1));
        __syncthreads();
        if (tid < HEAD_DIM) qs[tid] = bf2f(q[(size_t)tok * D_MODEL + hh * HEAD_DIM + tid]);
        __syncthreads();
        if (tid < N_BLOCKS) {
            float gval = -INFINITY;
            if (tid < own) {
                const float* kp = km + ((size_t)(b * N_KV + g) * N_BLOCKS + tid) * HEAD_DIM;
                float s = 0.f;
                for (int k = 0; k < HEAD_DIM; ++k) s += qs[k] * kp[k];
                gval = s;
            }
            gate[tid] = gval;
        }
        __syncthreads();
        if (tid == 0) {
            unsigned used = 0u;
            for (int s = 0; s < 3; ++s) {
                int best = -1; float bv = 0.f;
                for (int j = 0; j < N_BLOCKS; ++j) if (!((used >> j) & 1u) && (best < 0 || gate[j] > bv)) { best = j; bv = gate[j]; }
                used |= 1u << best; selb[s] = best;
            }
        }
        __syncthreads();
        for (int s = 0; s < 4; ++s) {
            const int blk = (s < 3) ? selb[s] : own;
            const int kpos = blk * MOBA_BLOCK + tid;
            const bool valid = (s < 3) ? (blk < own) : (kpos <= t);
            float v = -INFINITY;
            if (valid) {
                const bf16* kp = kv + (size_t)(b * SEQ + kpos) * 512 + g * HEAD_DIM;
                float d = 0.f;
                for (int k = 0; k < HEAD_DIM; ++k) d += qs[k] * bf2f(kp[k]);
                v = d * scale - slope * (float)(t - kpos);
            }
            lg[s * MOBA_BLOCK + tid] = v;
        }
        __syncthreads();
        float m = fmaxf(fmaxf(lg[tid], lg[256 + tid]), fmaxf(lg[512 + tid], lg[768 + tid]));
        for (int o = 32; o > 0; o >>= 1) m = fmaxf(m, __shfl_xor(m, o));
        if ((tid & 63) == 0) red[tid >> 6] = m;
        __syncthreads();
        m = fmaxf(fmaxf(red[0], red[1]), fmaxf(red[2], red[3]));
        float e[4], sum = 0.f;
#pragma unroll
        for (int i = 0; i < 4; ++i) { e[i] = expf(lg[i * 256 + tid] - m); sum += e[i]; }
        for (int o = 32; o > 0; o >>= 1) sum += __shfl_xor(sum, o);
        if ((tid & 63) == 0) red[4 + (tid >> 6)] = sum;
        __syncthreads();
        const float inv = 1.f / (red[4] + red[5] + red[6] + red[7]);
#pragma unroll
        for (int i = 0; i < 4; ++i) lg[i * 256 + tid] = e[i] * inv;
        __syncthreads();
        {
            const int d = tid & 127, half = tid >> 7;
            float acc = 0.f;
            for (int s = 0; s < 4; ++s) {
                const int blk = (s < 3) ? selb[s] : own;
                const bool bvalid = (s < 3) ? (blk < own) : true;
                if (!bvalid) continue;
                const bf16* vp = kv + (size_t)(b * SEQ + blk * MOBA_BLOCK + half * 128) * 512 + KV_DIM + g * HEAD_DIM + d;
                const float* pp = lg + s * MOBA_BLOCK + half * 128;
                for (int j = 0; j < 128; ++j) { const float p = pp[j]; if (p != 0.f) acc += p * bf2f(vp[(size_t)j * 512]); }
            }
            part[half][d] = acc;
        }
        __syncthreads();
        if (tid < HEAD_DIM) attn[(size_t)tok * D_MODEL + hh * HEAD_DIM + tid] = (bf16)(cvt_pk_bf16(part[0][tid] + part[1][tid], 0.f) & 0xffffu);
    }
}


#endif
#ifndef DEBUG_ATTN
#define DEBUG_ATTN 0
#endif
#if DEBUG_ATTN
__global__ void dbg_compare(const bf16* __restrict__ a, const bf16* __restrict__ ref, size_t n, float* __restrict__ acc) {
    float d2 = 0.f, r2 = 0.f;
    for (size_t i = (size_t)blockIdx.x * blockDim.x + threadIdx.x; i < n; i += (size_t)gridDim.x * blockDim.x) { const float x = bf2f(a[i]), y = bf2f(ref[i]); d2 += (x - y) * (x - y); r2 += y * y; }
    d2 = wave_sum(d2); r2 = wave_sum(r2);
    if ((threadIdx.x & 63) == 0) { atomicAdd(&acc[0], d2); atomicAdd(&acc[1], r2); }
}
__global__ void dbg_scale(float* __restrict__ out, size_t n, const float* __restrict__ acc) {
    const float rv = acc[0] / fmaxf(acc[1], 1e-30f);
    float e = sqrtf(fminf(rv * 100.f, 4.f)); if (!(rv == rv)) e = 3.f;
    for (size_t i = (size_t)blockIdx.x * blockDim.x + threadIdx.x; i < n; i += (size_t)gridDim.x * blockDim.x) out[i] *= (1.f + e);
}
#endif

extern "C" void kernel_launch(void* const* d_in, const int* in_sizes, int n_in, void* d_out, int out_size, void* d_ws, size_t ws_size, hipStream_t stream) {
    static int grid = 0;
    if (grid == 0) {
        int dev = 0, cus = 0;
        (void)hipGetDevice(&dev); (void)hipDeviceGetAttribute(&cus, hipDeviceAttributeMultiprocessorCount, dev);
        (void)hipFuncSetAttribute((const void*)fwd, hipFuncAttributeMaxDynamicSharedMemorySize, LDS_BYTES);
        grid = cus > 0 ? cus : 256;
    }
    unsigned char* ws = (unsigned char*)d_ws;
    (void)hipMemsetAsync(ws + WS_CTL, 0, CTL_ZERO_BYTES, stream);
    Params P{};
    for (int i = 0; i < 18; ++i) P.in[i] = (const float*)d_in[i];
    P.out = (float*)d_out; P.ws = ws;
    int nlaunch = 0;
    auto run = [&](int lo, int hi) { P.ph_lo = lo; P.ph_hi = hi; P.bar_idx = nlaunch++; hipLaunchKernelGGL(fwd, dim3(grid), dim3(512), LDS_BYTES, stream, P); };
#if DEBUG_ATTN
    const bf16* qkvi = (const bf16*)(ws + WS_QKVI); bf16* attn = (bf16*)(ws + WS_ATTN); int* sel = (int*)(ws + WS_SEL);
    float* scores = (float*)(ws + WS_SCORES); const float* iw = (const float*)(ws + WS_IW); const bf16* kvb = (const bf16*)(ws + WS_KV); float* km = (float*)(ws + WS_KM);
#endif
#if DEBUG_ATTN == 0
    run(0, DEPTH * 16);
#else
    for (int L = 0; L < DEPTH; ++L) {
        const int pb = L * 16;
        if (L < N_A) {
#if DEBUG_ATTN == 4
            if (L == 1) {
                run(pb + 0, pb + 3);
                bf16* attn2 = (bf16*)(ws + WS_PL);
                dsa_attn<<<NTOK, 256, 0, stream>>>(qkvi, sel, attn2);
                run(pb + 3, pb + 4);
                dbg_compare<<<1024, 256, 0, stream>>>(attn, attn2, (size_t)NTOK * D_MODEL, (float*)(ws + WS_CTL) + 1024);
                run(pb + 7, pb + 15);
            } else
#endif
#if DEBUG_ATTN == 3
            if (L == 1) {
                run(pb + 0, pb + 2);
                bf16* attn2 = (bf16*)(ws + WS_PL);
                for (int b = 0; b < BATCH; ++b) {
                    dsa_scores<<<dim3(SEQ / 64, SEQ / 64), 256, 0, stream>>>(qkvi + (size_t)b * SEQ * QLD, iw + (size_t)b * SEQ * 4, scores);
                    dsa_topk<<<SEQ, 256, 0, stream>>>(scores, sel + (size_t)b * SEQ * TOPK);
                }
                dsa_attn<<<NTOK, 256, 0, stream>>>(qkvi, sel, attn2);
                run(pb + 2, pb + 4);
                dbg_compare<<<1024, 256, 0, stream>>>(attn, attn2, (size_t)NTOK * D_MODEL, (float*)(ws + WS_CTL) + 1024);
                run(pb + 7, pb + 15);
            } else
#endif
            { run(pb + 0, pb + 4); run(pb + 7, pb + 15); }
        } else {
            run(pb + 0, pb + 7);
#if DEBUG_ATTN == 1
            if (L == N_A) {
                bf16* attn2 = (bf16*)(ws + WS_PL);
                kmeans_kernel<<<BATCH * N_KV * N_BLOCKS, 128, 0, stream>>>(kvb, km + 65536);
                moba_attn<<<NTOK, 256, 0, stream>>>(qkvi, kvb, km + 65536, attn2);
                dbg_compare<<<1024, 256, 0, stream>>>(attn, attn2, (size_t)NTOK * D_MODEL, (float*)(ws + WS_CTL) + 1024);
            }
#endif
            run(pb + 7, pb + 15);
        }
    }
#endif
#if DEBUG_ATTN
    dbg_scale<<<1024, 256, 0, stream>>>((float*)d_out, (size_t)NTOK * D_MODEL, (const float*)(ws + WS_CTL) + 1024);
#endif
}
```

```cpp
#include <hip/hip_runtime.h>
#include <stdint.h>

#define D_MODEL 1024
#define BATCH 4
#define SEQ 8192
#define NTOK (BATCH * SEQ)
#define DEPTH 4
#define N_A 2
#define N_HEADS 8
#define HEAD_DIM 128
#define N_KV 2
#define HEAD_GROUP 4
#define KV_DIM 256
#define IDX_HEADS 4
#define IDX_DIM 64
#define TOPK 256
#define MOBA_BLOCK 256
#define N_BLOCKS 32
#define N_GROUPS 4
#define EPG 8
#define N_EXPERTS 32
#define D_EXPERT 512
#define PLE_DIM 256
#define A_COLS 1860
#define QLD 2048
#define COL_K 1024
#define COL_V 1280
#define COL_IQ 1536
#define COL_IK 1792
#define COL_IW 1856
#define ALPHA_F 1.6817928305074290f
#define LN_EPS 1e-5f
#define MAX_SLOTS (65536 + 8192)
#define MAX_MTILES (MAX_SLOTS / 256)

#define LAS __attribute__((address_space(3)))
#define GAS __attribute__((address_space(1)))
typedef unsigned short bf16;
typedef short bf16x8 __attribute__((ext_vector_type(8)));
typedef float f32x4 __attribute__((ext_vector_type(4)));
typedef float f32x2 __attribute__((ext_vector_type(2)));
typedef unsigned u32x4 __attribute__((ext_vector_type(4)));
typedef unsigned u32x2 __attribute__((ext_vector_type(2)));

__device__ __forceinline__ unsigned cvt_pk_bf16(float lo, float hi) { unsigned r; asm("v_cvt_pk_bf16_f32 %0, %1, %2" : "=v"(r) : "v"(lo), "v"(hi)); return r; }
__device__ __forceinline__ float bf2f(bf16 b) { return __uint_as_float(((unsigned)b) << 16); }
__device__ __forceinline__ float bflo(unsigned u) { return __uint_as_float(u << 16); }
__device__ __forceinline__ float bfhi(unsigned u) { return __uint_as_float(u & 0xffff0000u); }
template <int CTRL> __device__ __forceinline__ float dpp_add(float v) { return v + __int_as_float(__builtin_amdgcn_update_dpp(0, __float_as_int(v), CTRL, 0xF, 0xF, false)); }
__device__ __forceinline__ float row16_sum(float v) {
    v = dpp_add<0xB1>(v); v = dpp_add<0x4E>(v); v = dpp_add<0x141>(v); v = dpp_add<0x140>(v); return v;
}
__device__ __forceinline__ float wave_sum(float v) { v = row16_sum(v); v += __shfl_xor(v, 16); v += __shfl_xor(v, 32); return v; }

constexpr size_t MiB = 1u << 20;
constexpr size_t WS_CTL = 0, CTL_ZERO_BYTES = 1 * MiB;
constexpr size_t WS_WMIX = 2 * MiB;
constexpr size_t WS_WPG = 10 * MiB;
constexpr size_t WS_WPLE = 12 * MiB;
constexpr size_t WS_WGU = 16 * MiB;
constexpr size_t WS_WD = 80 * MiB;
constexpr size_t WS_PB = 112 * MiB;
constexpr size_t WS_H = 128 * MiB;
constexpr size_t WS_HB = 256 * MiB;
constexpr size_t WS_T = 320 * MiB;
constexpr size_t WS_KV = 448 * MiB;
constexpr size_t WS_PL = 480 * MiB;
constexpr size_t WS_QKVI = 544 * MiB;
constexpr size_t WS_ATTN = 672 * MiB;
constexpr size_t WS_SEL = 736 * MiB;
constexpr size_t WS_ACT = 544 * MiB;
constexpr size_t WS_Y = 616 * MiB;
constexpr size_t WS_MOE = 768 * MiB;
constexpr size_t WS_IW = 770 * MiB;
constexpr size_t WS_KM = 771 * MiB;
constexpr size_t WS_SCORES = 772 * MiB;
constexpr int MO_TOK_E = 0, MO_TOK_POS = NTOK * 2, MO_TOK_SLOT = NTOK * 4, MO_TOK_W = NTOK * 6, MO_SLOT_TOK = NTOK * 8, MO_TILE_E = MO_SLOT_TOK + MAX_SLOTS, MO_TILE_ROW0 = MO_TILE_E + 512, MO_TILE_NV = MO_TILE_ROW0 + 512;
constexpr int CW_BAR = 65536;
constexpr int CW_CNT = 16384;
constexpr int CW_NTILES = 16384 + 256;

constexpr int LDS_BYTES = 163840;
constexpr int LDS_MISC = 163840 - 256;
constexpr int NWAVES = 8;

#define XB_TMO      128
#define XB_XCNT(j)  (256  + 64 * (j))
#define XB_XSUB(j)  (1280 + 64 * (j))
#define XB_XGEN(j)  (2304 + 64 * (j))
#define XB_TOP      3328
#define XB_TOPGEN   3392
#define XCD_BAR_WORDS 3456
#define XB_SPIN_CAP (1u << 22)
__device__ __forceinline__ unsigned xb_ld(unsigned* p)              { return __hip_atomic_load(p, __ATOMIC_RELAXED, __HIP_MEMORY_SCOPE_AGENT); }
__device__ __forceinline__ unsigned xb_add(unsigned* p, unsigned v) { return __hip_atomic_fetch_add(p, v, __ATOMIC_RELAXED, __HIP_MEMORY_SCOPE_AGENT); }
__device__ __forceinline__ unsigned xb_xcc_id() { return (unsigned)__builtin_amdgcn_s_getreg((3 << 11) | 20) & 0xFu; }
#define XB_SPIN(cond, bar) do { unsigned _sp = 0; while (cond) { __builtin_amdgcn_s_sleep(1); \
    if ((++_sp & 255u) == 0u) { if (xb_ld(&(bar)[XB_TMO])) break; if (_sp > XB_SPIN_CAP) { atomicAdd(&(bar)[XB_TMO], 1u); break; } } } } while (0)
struct XcdBarrier { unsigned* bar; unsigned x; volatile LAS unsigned* st; };
__device__ __forceinline__ XcdBarrier xcd_barrier_post(unsigned* bar, volatile LAS unsigned* st) {
    XcdBarrier b; b.bar = bar; b.x = xb_xcc_id(); b.st = st;
    if (threadIdx.x == 0) (void)xb_add(&bar[XB_XCNT(b.x)], 1u);
    return b;
}
__device__ __forceinline__ void xcd_barrier_complete(unsigned* bar, unsigned x, unsigned& nloc, unsigned& nx) {
    const unsigned G = gridDim.x * gridDim.y * gridDim.z;
    unsigned sum, cnt, mine, sp = 0u;
    for (;;) {
        sum = 0u; cnt = 0u; mine = 0u;
#pragma unroll
        for (unsigned j = 0; j < 16; ++j) { const unsigned c = xb_ld(&bar[XB_XCNT(j)]); sum += c; cnt += (c > 0u) ? 1u : 0u; mine = (j == x) ? c : mine; }
        if (sum == G) break;
        __builtin_amdgcn_s_sleep(1);
        if ((++sp & 255u) == 0u) { if (xb_ld(&bar[XB_TMO])) break; if (sp > XB_SPIN_CAP) { atomicAdd(&bar[XB_TMO], 1u); break; } }
    }
    nloc = mine > 0u ? mine : 1u; nx = cnt > 0u ? cnt : 1u;
}
__device__ __forceinline__ void xcd_barrier(const XcdBarrier& b) {
    asm volatile("s_waitcnt vmcnt(0)" ::: "memory");
    __syncthreads();
    if (threadIdx.x == 0) {
        unsigned* bar = b.bar;
        __builtin_amdgcn_s_waitcnt(0);
        unsigned nloc = b.st[0], nx = b.st[1];
        if (nloc == 0u) { xcd_barrier_complete(bar, b.x, nloc, nx); b.st[0] = nloc; b.st[1] = nx; }
        const unsigned old = xb_add(&bar[XB_XSUB(b.x)], 1u);
        const unsigned gen = old / nloc;
        if (old + 1u == (gen + 1u) * nloc) {
            __builtin_amdgcn_fence(__ATOMIC_RELEASE, "agent");
            asm volatile("s_waitcnt vmcnt(0)" ::: "memory");
            const unsigned og = xb_add(&bar[XB_TOP], 1u);
            const unsigned tg = og / nx;
            if (og + 1u == (tg + 1u) * nx) xb_add(&bar[XB_TOPGEN], 1u);
            else XB_SPIN(xb_ld(&bar[XB_TOPGEN]) == tg, bar);
            __builtin_amdgcn_fence(__ATOMIC_ACQUIRE, "agent");
            xb_add(&bar[XB_XGEN(b.x)], 1u);
            asm volatile("s_waitcnt vmcnt(0)" ::: "memory");
        } else {
            XB_SPIN(xb_ld(&bar[XB_XGEN(b.x)]) == gen, bar);
            __builtin_amdgcn_fence(__ATOMIC_ACQUIRE, "agent");
            asm volatile("s_waitcnt vmcnt(0)" ::: "memory");
        }
    }
    __syncthreads();
}

namespace gm {
constexpr int BM = 256, BK = 64, HALF = 128, HTB = HALF * BK * 2, STAGE_BYTES = 8 * HTB, NXCD = 8, WGM = 8;
__host__ __device__ __forceinline__ int lds_byte(int r, int c) { const int st = (r >> 4) * 2 + (c >> 5), rr = r & 15, cc = c & 31, ob = rr * 64 + cc * 2; return st * 1024 + (ob ^ (((ob >> 9) & 1) << 5)); }
__host__ __device__ __forceinline__ void stage_rc(int b, int& R, int& C) { const int st = b / 1024, sb = b % 1024, swz = sb ^ (((sb >> 9) & 1) << 5); R = (st >> 1) * 16 + swz / 64; C = (st & 1) * 32 + (swz % 64) / 2; }
__host__ __device__ __forceinline__ int perm32(int rho) { const int n = rho >> 4, i = rho & 15; return 8 * (i >> 2) + 4 * n + (i & 3); }

struct Unit { const char* a; const char* b; int row0, col0, aux; };

struct DenseOrder {
    int nM, nN, nwg, G, c; const char* A; const char* B; size_t tA, tB;
    __device__ void init(const void* A_, const void* Bt_, int M, int N, int K, int G_, int c_) { nM = M / BM; nN = N / BM; nwg = nM * nN; G = G_; c = c_; A = (const char*)A_; B = (const char*)Bt_; tA = (size_t)BM * K * 2; tB = tA; }
    __device__ bool next(int i, Unit& u) const {
        const long L = (long)i * G + c; if (L >= nwg) return false;
        int wgid = (int)L; { const int q = nwg / NXCD, r = nwg % NXCD, xcd = wgid % NXCD, off = wgid / NXCD; wgid = (xcd < r ? xcd * (q + 1) : r * (q + 1) + (xcd - r) * q) + off; }
        const int nig = WGM * nN, gid = wgid / nig, fm = gid * WGM, gsz = (nM - fm) < WGM ? (nM - fm) : WGM;
        const int pm = fm + ((wgid % nig) % gsz), pn = (wgid % nig) / gsz;
        u.a = A + (size_t)pm * tA; u.b = B + (size_t)pn * tB; u.row0 = pm * BM; u.col0 = pn * BM; u.aux = 0; return true;
    }
    __device__ __forceinline__ void gather(const Unit&, unsigned (&)[2][2], const int (&)[2], const int (&)[2], int) const {}
};
struct MoeOrder {
    const int* tile_e; const int* tile_row0; const int* tile_nv; const int* slot_tok; int n_units, G, c, K; const char* A; const char* W; size_t wstride, tB; bool gath;
    __device__ bool next(int i, Unit& u) const {
        const int L = i * G + c; if (L >= n_units) return false;
        const int T = L >> 2, pn = L & 3;
        const int e = __builtin_amdgcn_readfirstlane(tile_e[T]), r0 = __builtin_amdgcn_readfirstlane(tile_row0[T]), nv = __builtin_amdgcn_readfirstlane(tile_nv[T]);
        u.a = gath ? A : A + (size_t)r0 * K * 2; u.b = W + (size_t)e * wstride + (size_t)pn * tB; u.row0 = r0; u.col0 = pn; u.aux = nv; return true;
    }
    __device__ __forceinline__ void gather(const Unit& u, unsigned (&vo)[2][2], const int (&sR)[2], const int (&sC)[2], int K_) const {
#pragma unroll
        for (int h = 0; h < 2; ++h)
#pragma unroll
            for (int i = 0; i < 2; ++i) { const int r = h * HALF + sR[i]; const int tok = (r < u.aux) ? slot_tok[u.row0 + r] : 0; vo[h][i] = (unsigned)(tok * K_ + sC[i]) * 2u; }
    }
};

template <class Epi, class Sched, bool GATHER>
__device__ __forceinline__ void gemm_phase(LAS unsigned char* lds, const int K, const Sched& S, const Epi& E) {
    int tz = threadIdx.x; asm volatile("" : "+v"(tz));
    const int tid = tz, wid = __builtin_amdgcn_readfirstlane(tid >> 6), lane = tid & 63, wr = wid >> 2, wc = wid & 3, fr = lane & 15, fq = lane >> 4;
    const int nt = K / BK;
    unsigned voffB[2], vA[2][2], vAn[2][2]; int sR[2], sC[2];
#pragma unroll
    for (int i = 0; i < 2; ++i) { int R, C; stage_rc(tid * 16 + i * 8192, R, C); const int Rb = Epi::PERM ? ((R & ~31) + perm32(R & 31)) : R;
        sR[i] = R; sC[i] = C; voffB[i] = (unsigned)(Rb * K + C) * 2u;
        vA[0][i] = (unsigned)(R * K + C) * 2u; vA[1][i] = (unsigned)((R + HALF) * K + C) * 2u; vAn[0][i] = vA[0][i]; vAn[1][i] = vA[1][i]; }
    const size_t kstep = (size_t)(BK * 2);
    const size_t hstep = (size_t)HALF * K * 2;
    const unsigned ldsw = (unsigned)wid * 1024u;
    const int aoff = lds_byte(wr * 64 + fr, fq * 8), boff = lds_byte(wc * 32 + fr, fq * 8);
#define PG8_SA(b, h) (((b) * 2 + (h)) * HTB)
#define PG8_SB(b, h) ((4 + (b) * 2 + (h)) * HTB)
#define PG8_STAGE(bufoff, gbase, voff) do { _Pragma("unroll") for (int _i = 0; _i < 2; ++_i) \
        __builtin_amdgcn_global_load_lds((const unsigned*)((const char*)(gbase) + (voff)[_i]), (LAS unsigned*)(lds + (bufoff) + ldsw + _i * 8192), 16, 0, 0); } while (0)
#define PG8_LDA(dst, b, h) do { _Pragma("unroll") for (int m = 0; m < 4; ++m) _Pragma("unroll") for (int k = 0; k < 2; ++k) dst[m][k] = *(const LAS bf16x8*)(lds + PG8_SA(b, h) + aoff + m * 2048 + k * 1024); } while (0)
#define PG8_LDB(dst, b, h) do { _Pragma("unroll") for (int n = 0; n < 2; ++n) _Pragma("unroll") for (int k = 0; k < 2; ++k) dst[n][k] = *(const LAS bf16x8*)(lds + PG8_SB(b, h) + boff + n * 2048 + k * 1024); } while (0)
#define PG8_MMA(ai, bj, At, Bt) do { __builtin_amdgcn_s_setprio(1); _Pragma("unroll") for (int m = 0; m < 4; ++m) _Pragma("unroll") for (int n = 0; n < 2; ++n) _Pragma("unroll") for (int k = 0; k < 2; ++k) \
        acc[ai][bj][m][n] = __builtin_amdgcn_mfma_f32_16x16x32_bf16(Bt[n][k], At[m][k], acc[ai][bj][m][n], 0, 0, 0); __builtin_amdgcn_s_setprio(0); } while (0)
#define PG8_WAIT_V(n) asm volatile("s_waitcnt vmcnt(" #n ")" ::: "memory")
#define PG8_WAIT_L(n) asm volatile("s_waitcnt lgkmcnt(" #n ")" ::: "memory")
#define PG8_BAR __builtin_amdgcn_s_barrier()
#define PG8_SCHED __builtin_amdgcn_sched_barrier(0)
    Unit cur, nxt; int ui = 0;
    if (!S.next(0, cur)) return;
    f32x4 acc[2][2][4][2];
#pragma unroll
    for (int a = 0; a < 2; ++a)
#pragma unroll
        for (int b = 0; b < 2; ++b)
#pragma unroll
            for (int m = 0; m < 4; ++m)
#pragma unroll
                for (int n = 0; n < 2; ++n) acc[a][b][m][n] = (f32x4){0.f, 0.f, 0.f, 0.f};
    bf16x8 At[4][2], B0[2][2], B1[2][2];
    const char* cA = cur.a; const char* cB = cur.b;
    if constexpr (GATHER) S.gather(cur, vA, sR, sC, K);
    PG8_STAGE(PG8_SB(0, 0), cB, voffB); PG8_STAGE(PG8_SB(0, 1), cB + hstep, voffB); PG8_STAGE(PG8_SA(0, 0), cA, vA[0]); PG8_STAGE(PG8_SA(0, 1), cA, vA[1]);
    if (wr == 1) PG8_BAR;
    PG8_WAIT_V(2); PG8_BAR;
    PG8_STAGE(PG8_SB(1, 0), cB + kstep, voffB); PG8_STAGE(PG8_SA(1, 0), cA + kstep, vA[0]); PG8_STAGE(PG8_SB(1, 1), cB + hstep + kstep, voffB);
    PG8_WAIT_V(6); PG8_BAR;
    for (;;) {
        const bool has_next = S.next(ui + 1, nxt);
        const char* nA = has_next ? nxt.a : cA; const char* nB = has_next ? nxt.b : cB;
        if constexpr (GATHER) {
            if (has_next) S.gather(nxt, vAn, sR, sC, K);
            else { vAn[0][0] = vA[0][0]; vAn[0][1] = vA[0][1]; vAn[1][0] = vA[1][0]; vAn[1][1] = vA[1][1]; }
        }
        for (int t = 0; t < nt; t += 2) {
            const bool last = (t == nt - 2);
            const char* a1 = cA + (size_t)(t + 1) * kstep;
            const char* a2 = last ? nA : cA + (size_t)(t + 2) * kstep; const char* b2 = last ? nB : cB + (size_t)(t + 2) * kstep;
            const char* a3 = a2 + kstep; const char* b3 = b2 + kstep;
            unsigned w0[2], w1[2];
            if constexpr (GATHER) { w0[0] = last ? vAn[0][0] : vA[0][0]; w0[1] = last ? vAn[0][1] : vA[0][1]; w1[0] = last ? vAn[1][0] : vA[1][0]; w1[1] = last ? vAn[1][1] : vA[1][1]; }
            else { w0[0] = vA[0][0]; w0[1] = vA[0][1]; w1[0] = vA[1][0]; w1[1] = vA[1][1]; }
            PG8_LDB(B0, 0, 0); PG8_LDB(B1, 0, 1); PG8_SCHED; PG8_LDA(At, 0, 0); PG8_STAGE(PG8_SA(1, 1), a1, vA[1]);
            PG8_WAIT_V(8); PG8_WAIT_L(0); PG8_BAR; PG8_MMA(0, 0, At, B0); PG8_MMA(0, 1, At, B1); PG8_BAR; PG8_SCHED;
            PG8_LDA(At, 0, 1); PG8_STAGE(PG8_SB(0, 0), b2, voffB); PG8_STAGE(PG8_SB(0, 1), b2 + hstep, voffB); PG8_STAGE(PG8_SA(0, 0), a2, w0);
            PG8_WAIT_V(8); PG8_WAIT_L(0); PG8_BAR; PG8_MMA(1, 0, At, B0); PG8_MMA(1, 1, At, B1); PG8_BAR; PG8_SCHED;
            PG8_LDB(B0, 1, 0); PG8_LDB(B1, 1, 1); PG8_SCHED; PG8_LDA(At, 1, 0); PG8_STAGE(PG8_SA(0, 1), a2, w1);
            PG8_WAIT_V(8); PG8_WAIT_L(0); PG8_BAR; PG8_MMA(0, 0, At, B0); PG8_MMA(0, 1, At, B1); PG8_BAR; PG8_SCHED;
            PG8_LDA(At, 1, 1); PG8_STAGE(PG8_SB(1, 0), b3, voffB); PG8_STAGE(PG8_SB(1, 1), b3 + hstep, voffB); PG8_STAGE(PG8_SA(1, 0), a3, w0);
            PG8_WAIT_V(8); PG8_WAIT_L(0); PG8_BAR; PG8_MMA(1, 0, At, B0); PG8_MMA(1, 1, At, B1); PG8_BAR; PG8_SCHED;
        }
        if (wr == 0) PG8_BAR;
        E(acc, cur, wr, wc, fr, fq);
        if (!has_next) break;
#pragma unroll
        for (int a = 0; a < 2; ++a)
#pragma unroll
            for (int b = 0; b < 2; ++b)
#pragma unroll
                for (int m = 0; m < 4; ++m)
#pragma unroll
                    for (int n = 0; n < 2; ++n) acc[a][b][m][n] = (f32x4){0.f, 0.f, 0.f, 0.f};
        cur = nxt; cA = nA; cB = nB; ++ui;
        if constexpr (GATHER) { vA[0][0] = vAn[0][0]; vA[0][1] = vAn[0][1]; vA[1][0] = vAn[1][0]; vA[1][1] = vAn[1][1]; }
        if (wr == 1) PG8_BAR;
    }
    PG8_WAIT_V(0);
    PG8_BAR;
#undef PG8_SA
#undef PG8_SB
#undef PG8_STAGE
#undef PG8_LDA
#undef PG8_LDB
#undef PG8_MMA
#undef PG8_WAIT_V
#undef PG8_WAIT_L
#undef PG8_BAR
#undef PG8_SCHED
}

#define EPI_ROWS(u, ai, m) ((u).row0 + (ai) * HALF + wr * 64 + (m) * 16 + fr)
struct EpiBf16 {
    static constexpr bool PERM = true;
    bf16* O; int ldc; float* iw;
    __device__ __forceinline__ void operator()(const f32x4 (&acc)[2][2][4][2], const Unit& u, int wr, int wc, int fr, int fq) const {
#pragma unroll
        for (int ai = 0; ai < 2; ++ai)
#pragma unroll
            for (int m = 0; m < 4; ++m) { const int row = EPI_ROWS(u, ai, m); bf16* rowp = O + (size_t)row * ldc + u.col0 + wc * 32 + 8 * fq;
#pragma unroll
                for (int bj = 0; bj < 2; ++bj) { const f32x4 v0 = acc[ai][bj][m][0], v1 = acc[ai][bj][m][1];
                    u32x4 w; w.x = cvt_pk_bf16(v0[0], v0[1]); w.y = cvt_pk_bf16(v0[2], v0[3]); w.z = cvt_pk_bf16(v1[0], v1[1]); w.w = cvt_pk_bf16(v1[2], v1[3]);
                    *(u32x4*)(rowp + bj * HALF) = w; }
                if (iw != nullptr && u.col0 == 1792 && wc == 2 && fq == 0) *(f32x4*)(iw + (size_t)row * 4) = acc[ai][0][m][0] * 0.0625f; }
    }
};
struct EpiResid {
    static constexpr bool PERM = false;
    const float* h; float* t;
    __device__ __forceinline__ void operator()(const f32x4 (&acc)[2][2][4][2], const Unit& u, int wr, int wc, int fr, int fq) const {
#pragma unroll
        for (int ai = 0; ai < 2; ++ai)
#pragma unroll
            for (int m = 0; m < 4; ++m) { const size_t o = (size_t)EPI_ROWS(u, ai, m) * D_MODEL + u.col0 + wc * 32 + 4 * fq;
#pragma unroll
                for (int bj = 0; bj < 2; ++bj)
#pragma unroll
                    for (int n = 0; n < 2; ++n) { const size_t oo = o + bj * HALF + n * 16; const f32x4 hv = *(const f32x4*)(h + oo); *(f32x4*)(t + oo) = hv * ALPHA_F + acc[ai][bj][m][n]; } }
    }
};
struct EpiPle {
    static constexpr bool PERM = false;
    const float* h; const bf16* pl; float* t;
    __device__ __forceinline__ void operator()(const f32x4 (&acc)[2][2][4][2], const Unit& u, int wr, int wc, int fr, int fq) const {
#pragma unroll
        for (int ai = 0; ai < 2; ++ai)
#pragma unroll
            for (int m = 0; m < 4; ++m) { const size_t o = (size_t)EPI_ROWS(u, ai, m) * D_MODEL + u.col0 + wc * 32 + 4 * fq;
#pragma unroll
                for (int bj = 0; bj < 2; ++bj)
#pragma unroll
                    for (int n = 0; n < 2; ++n) { const size_t oo = o + bj * HALF + n * 16; const f32x4 hv = *(const f32x4*)(h + oo); const u32x2 pv = *(const u32x2*)(pl + oo);
                        const f32x4 a = acc[ai][bj][m][n]; f32x4 r;
                        r[0] = fmaf(hv[0], ALPHA_F, bflo(pv.x) * __builtin_amdgcn_rcpf(1.f + __builtin_amdgcn_exp2f(a[0] * -1.4426950408889634f))); r[1] = fmaf(hv[1], ALPHA_F, bfhi(pv.x) * __builtin_amdgcn_rcpf(1.f + __builtin_amdgcn_exp2f(a[1] * -1.4426950408889634f)));
                        r[2] = fmaf(hv[2], ALPHA_F, bflo(pv.y) * __builtin_amdgcn_rcpf(1.f + __builtin_amdgcn_exp2f(a[2] * -1.4426950408889634f))); r[3] = fmaf(hv[3], ALPHA_F, bfhi(pv.y) * __builtin_amdgcn_rcpf(1.f + __builtin_amdgcn_exp2f(a[3] * -1.4426950408889634f)));
                        *(f32x4*)(t + oo) = r; } }
    }
};
struct EpiSwiglu {
    static constexpr bool PERM = true;
    bf16* act;
    __device__ __forceinline__ void operator()(const f32x4 (&acc)[2][2][4][2], const Unit& u, int wr, int wc, int fr, int fq) const {
#pragma unroll
        for (int ai = 0; ai < 2; ++ai)
#pragma unroll
            for (int m = 0; m < 4; ++m) { const int row = EPI_ROWS(u, ai, m); float r[8];
#pragma unroll
                for (int n = 0; n < 2; ++n)
#pragma unroll
                    for (int j = 0; j < 4; ++j) { const float g = acc[ai][0][m][n][j], uu = acc[ai][1][m][n][j]; r[n * 4 + j] = g * __builtin_amdgcn_rcpf(1.f + __builtin_amdgcn_exp2f(g * -1.4426950408889634f)) * uu; }
                u32x4 w; w.x = cvt_pk_bf16(r[0], r[1]); w.y = cvt_pk_bf16(r[2], r[3]); w.z = cvt_pk_bf16(r[4], r[5]); w.w = cvt_pk_bf16(r[6], r[7]);
                *(u32x4*)(act + (size_t)row * D_EXPERT + u.col0 * 128 + wc * 32 + 8 * fq) = w; }
    }
};
struct EpiMoeDown {
    static constexpr bool PERM = true;
    bf16* Y;
    __device__ __forceinline__ void operator()(const f32x4 (&acc)[2][2][4][2], const Unit& u, int wr, int wc, int fr, int fq) const {
#pragma unroll
        for (int ai = 0; ai < 2; ++ai)
#pragma unroll
            for (int m = 0; m < 4; ++m) { const int row = EPI_ROWS(u, ai, m); bf16* rowp = Y + (size_t)row * D_MODEL + u.col0 * 256 + wc * 32 + 8 * fq;
#pragma unroll
                for (int bj = 0; bj < 2; ++bj) { const f32x4 v0 = acc[ai][bj][m][0], v1 = acc[ai][bj][m][1];
                    u32x4 w; w.x = cvt_pk_bf16(v0[0], v0[1]); w.y = cvt_pk_bf16(v0[2], v0[3]); w.z = cvt_pk_bf16(v1[0], v1[1]); w.w = cvt_pk_bf16(v1[2], v1[3]);
                    *(u32x4*)(rowp + bj * HALF) = w; } }
    }
};
}

struct Params { const float* in[18]; float* out; unsigned char* ws; int ph_lo, ph_hi, bar_idx, pad; };
typedef const Params __attribute__((address_space(4)))* KP;
__device__ __forceinline__ KP fresh_params() { KP p = (KP)__builtin_amdgcn_kernarg_segment_ptr(); asm volatile("" : "+s"(p)); return p; }

__device__ __forceinline__ void tr_item(const float* W, int K, int N, bf16* WT, int row_off, LAS float* scr, int kb, int nb, int lane) {
    const int k0 = 64 * kb, n0 = 32 * nb;
    const bool ok = (n0 + (lane & 31)) < N;
    if (n0 + 32 <= N) {
        const int kr = lane >> 3, c4 = (lane & 7) * 4;
#pragma unroll
        for (int i = 0; i < 8; ++i) { const int kk = 8 * i + kr; const f32x4 v = *(const f32x4*)(W + (size_t)(k0 + kk) * N + n0 + c4);
            LAS float* d = scr + kk * 33 + c4; d[0] = v[0]; d[1] = v[1]; d[2] = v[2]; d[3] = v[3]; }
    } else {
#pragma unroll 8
        for (int i = 0; i < 32; ++i) { const int kk = 2 * i + (lane >> 5); scr[kk * 33 + (lane & 31)] = ok ? W[(size_t)(k0 + kk) * N + n0 + (lane & 31)] : 0.f; }
    }
    asm volatile("s_waitcnt lgkmcnt(0)" ::: "memory");
    const int c = lane & 7;
#pragma unroll
    for (int j = 0; j < 4; ++j) { const int n = (lane >> 3) + 8 * j; const LAS float* s = scr + (8 * c) * 33 + n;
        u32x4 o; o.x = cvt_pk_bf16(s[0 * 33], s[1 * 33]); o.y = cvt_pk_bf16(s[2 * 33], s[3 * 33]); o.z = cvt_pk_bf16(s[4 * 33], s[5 * 33]); o.w = cvt_pk_bf16(s[6 * 33], s[7 * 33]);
        *(u32x4*)(WT + (size_t)(row_off + n0 + n) * K + k0 + 8 * c) = o; }
    asm volatile("s_waitcnt lgkmcnt(0)" ::: "memory");
}
__device__ __forceinline__ void cvt_rows(const float* src, bf16* dst, size_t n4, int gtid, int gthreads) {
    for (size_t i = gtid; i < n4; i += gthreads) { const f32x4 v = *(const f32x4*)(src + i * 4); u32x2 o; o.x = cvt_pk_bf16(v[0], v[1]); o.y = cvt_pk_bf16(v[2], v[3]); *(u32x2*)(dst + i * 4) = o; }
}
__device__ __forceinline__ void phase_convert(KP P, int L, LAS unsigned char* lds) {
    int tz = threadIdx.x; asm volatile("" : "+v"(tz));
    const int tid = tz, lane = tid & 63, wave = tid >> 6;
    LAS float* scr = (LAS float*)(lds + wave * 16384);
    const int gw = blockIdx.x * NWAVES + wave, NGW = gridDim.x * NWAVES;
    unsigned char* ws = P->ws;
    bf16* wmix = (bf16*)(ws + WS_WMIX); bf16* wo_t = (bf16*)(ws + WS_WMIX + 4 * MiB); bf16* wkv_t = (bf16*)(ws + WS_WMIX + 6 * MiB);
    bf16* wpg_t = (bf16*)(ws + WS_WPG); bf16* wple_t = (bf16*)(ws + WS_WPLE); bf16* wgu_t = (bf16*)(ws + WS_WGU); bf16* wd_t = (bf16*)(ws + WS_WD);
    const bool isA = L < N_A; const int j = L - N_A;
    const float* w_first = isA ? P->in[2] + (size_t)L * D_MODEL * A_COLS : P->in[5] + (size_t)j * D_MODEL * D_MODEL;
    const int n_first = isA ? A_COLS : D_MODEL, nb_first = isA ? 64 : 32;
    const float* w_o = isA ? P->in[3] + (size_t)L * D_MODEL * D_MODEL : P->in[6] + (size_t)j * D_MODEL * D_MODEL;
    const int I_FIRST = 16 * nb_first, I_O = 16 * 32, I_KV = (L == N_A) ? 16 * 16 : 0, I_PG = 16 * 32, I_PLE = 4 * 32, I_G = 32 * 256, I_U = 32 * 256, I_D = 32 * 256;
    const int NITEMS = I_FIRST + I_O + I_KV + I_PG + I_PLE + I_G + I_U + I_D;
    const size_t wsz = (size_t)D_MODEL * D_EXPERT;
    for (int it = gw; it < NITEMS; it += NGW) {
        int r = it;
        if (r < I_FIRST) { tr_item(w_first, D_MODEL, n_first, wmix, 0, scr, r / nb_first, r % nb_first, lane); continue; } r -= I_FIRST;
        if (r < I_O) { tr_item(w_o, D_MODEL, D_MODEL, wo_t, 0, scr, r / 32, r % 32, lane); continue; } r -= I_O;
        if (r < I_KV) { tr_item(P->in[4], D_MODEL, 512, wkv_t, 0, scr, r / 16, r % 16, lane); continue; } r -= I_KV;
        if (r < I_PG) { tr_item(P->in[15] + (size_t)L * D_MODEL * D_MODEL, D_MODEL, D_MODEL, wpg_t, 0, scr, r / 32, r % 32, lane); continue; } r -= I_PG;
        if (r < I_PLE) { tr_item(P->in[14] + (size_t)L * PLE_DIM * D_MODEL, PLE_DIM, D_MODEL, wple_t, 0, scr, r / 32, r % 32, lane); continue; } r -= I_PLE;
        if (r < I_G + I_U) {
            const bool up = r >= I_G; if (up) r -= I_G;
            const int e = r >> 8, rem = r & 255, kb = rem >> 4, nb = rem & 15, n0 = nb * 32;
            const float* W = (up ? P->in[12] : P->in[11]) + ((size_t)L * N_EXPERTS + e) * wsz;
            const int row_off = (n0 >> 7) * 256 + (up ? 128 : 0) + (n0 & 127) - n0;
            tr_item(W, D_MODEL, D_EXPERT, wgu_t + (size_t)e * D_MODEL * D_MODEL, row_off, scr, kb, nb, lane); continue; }
        r -= I_G + I_U;
        { const int e = r >> 8, rem = r & 255, kb = rem >> 5, nb = rem & 31;
          tr_item(P->in[13] + ((size_t)L * N_EXPERTS + e) * wsz, D_EXPERT, D_MODEL, wd_t + (size_t)e * wsz, 0, scr, kb, nb, lane); }
    }
    const int gtid = blockIdx.x * 512 + tid, gthreads = gridDim.x * 512;
    { const float* wrg = P->in[7] + (size_t)L * D_MODEL * N_GROUPS; const float* wre = P->in[9] + (size_t)L * D_MODEL * N_EXPERTS; float* wrt = (float*)(ws + WS_WPLE + 1 * MiB);
      for (int i = gtid; i < D_MODEL * 36; i += gthreads) { const int c = i >> 10, k = i & 1023; wrt[i] = (c < 4) ? wrg[k * 4 + c] : wre[k * 32 + (c - 4)]; } }
    cvt_rows(P->in[1] + (size_t)L * NTOK * PLE_DIM, (bf16*)(ws + WS_PB), (size_t)NTOK * PLE_DIM / 4, gtid, gthreads);
    if (L == 0) cvt_rows(P->in[0], (bf16*)(ws + WS_HB), (size_t)NTOK * D_MODEL / 4, gtid, gthreads);
}

template <int SRC, bool ROUTER>
__device__ __forceinline__ void phase_ln(KP P, int L, int which, LAS unsigned char* lds, float* dst_f32, bool write_hb, int cidx = -1) {
    int tz = threadIdx.x; asm volatile("" : "+v"(tz));
    const int tid = tz, lane = tid & 63, wave = tid >> 6;
    unsigned char* ws = P->ws;
    const float* t = (const float*)(ws + WS_T); const float* h = (const float*)(ws + WS_H); bf16* hb = (bf16*)(ws + WS_HB);
    const bf16* Y = (const bf16*)(ws + WS_Y);
    int* moe = (int*)(ws + WS_MOE);
    const float* g = P->in[16] + (size_t)(L * 3 + which) * D_MODEL; const float* bt = P->in[17] + (size_t)(L * 3 + which) * D_MODEL;
    LAS float* Wl = (LAS float*)lds;
    LAS float* lgs = (LAS float*)(lds + 147456) + wave * 40;
    if (ROUTER) {
        const float* wrg = P->in[7] + (size_t)L * D_MODEL * N_GROUPS; const float* wre = P->in[9] + (size_t)L * D_MODEL * N_EXPERTS;
        for (int i = tid; i < D_MODEL * 36; i += 512) { const int k = i / 36, c = i % 36; Wl[c * D_MODEL + k] = (c < 4) ? wrg[k * 4 + c] : wre[k * 32 + (c - 4)]; }
        __syncthreads();
    }
    f32x4 gv[4], bv[4];
#pragma unroll
    for (int j = 0; j < 4; ++j) { gv[j] = *(const f32x4*)(g + 4 * lane + 256 * j); bv[j] = *(const f32x4*)(bt + 4 * lane + 256 * j); }
    const int gw = blockIdx.x * NWAVES + wave, NGW = gridDim.x * NWAVES;
    for (int row = gw; row < NTOK; row += NGW) {
        f32x4 v[4];
        if (SRC == 0) {
#pragma unroll
            for (int j = 0; j < 4; ++j) v[j] = *(const f32x4*)(t + (size_t)row * D_MODEL + 4 * lane + 256 * j);
        } else {
            const int s0 = moe[MO_TOK_SLOT + row * 2], s1 = moe[MO_TOK_SLOT + row * 2 + 1];
            const float w0 = ((const float*)moe)[MO_TOK_W + row * 2], w1 = ((const float*)moe)[MO_TOK_W + row * 2 + 1];
#pragma unroll
            for (int j = 0; j < 4; ++j) {
                const f32x4 hv = *(const f32x4*)(h + (size_t)row * D_MODEL + 4 * lane + 256 * j);
                const u32x2 y0 = *(const u32x2*)(Y + (size_t)s0 * D_MODEL + 4 * lane + 256 * j), y1 = *(const u32x2*)(Y + (size_t)s1 * D_MODEL + 4 * lane + 256 * j);
                v[j][0] = hv[0] * ALPHA_F + (w0 * bflo(y0.x) + w1 * bflo(y1.x)); v[j][1] = hv[1] * ALPHA_F + (w0 * bfhi(y0.x) + w1 * bfhi(y1.x));
                v[j][2] = hv[2] * ALPHA_F + (w0 * bflo(y0.y) + w1 * bflo(y1.y)); v[j][3] = hv[3] * ALPHA_F + (w0 * bfhi(y0.y) + w1 * bfhi(y1.y));
            }
        }
        float s = 0.f;
#pragma unroll
        for (int j = 0; j < 4; ++j) s += (v[j][0] + v[j][1]) + (v[j][2] + v[j][3]);
        const float mean = wave_sum(s) * (1.f / D_MODEL);
        float q = 0.f;
#pragma unroll
        for (int j = 0; j < 4; ++j) { v[j] = v[j] - mean; q += (v[j][0] * v[j][0] + v[j][1] * v[j][1]) + (v[j][2] * v[j][2] + v[j][3] * v[j][3]); }
        const float rstd = rsqrtf(wave_sum(q) * (1.f / D_MODEL) + LN_EPS);
#pragma unroll
        for (int j = 0; j < 4; ++j) { v[j] = v[j] * rstd * gv[j] + bv[j]; *(f32x4*)(dst_f32 + (size_t)row * D_MODEL + 4 * lane + 256 * j) = v[j]; }
        if (write_hb) {
#pragma unroll
            for (int j = 0; j < 4; ++j) { u32x2 o; o.x = cvt_pk_bf16(v[j][0], v[j][1]); o.y = cvt_pk_bf16(v[j][2], v[j][3]); *(u32x2*)(hb + (size_t)row * D_MODEL + 4 * lane + 256 * j) = o; }
        }
        if (ROUTER) {
            float lg[36];
#pragma unroll
            for (int c = 0; c < 36; ++c) {
                float a = 0.f;
#pragma unroll
                for (int j = 0; j < 4; ++j) { const f32x4 w = *(const LAS f32x4*)(Wl + c * D_MODEL + 4 * lane + 256 * j); a += (v[j][0] * w[0] + v[j][1] * w[1]) + (v[j][2] * w[2] + v[j][3] * w[3]); }
                lg[c] = wave_sum(a);
            }
            if (lane == 0) {
                const float* brg = P->in[8] + L * N_GROUPS; const float* bre = P->in[10] + L * N_EXPERTS;
                float gl[4];
#pragma unroll
                for (int jj = 0; jj < 4; ++jj) gl[jj] = lg[jj] + brg[jj];
                int gs = 0; float gmax = gl[0];
#pragma unroll
                for (int jj = 1; jj < 4; ++jj) if (gl[jj] > gmax) { gmax = gl[jj]; gs = jj; }
                float den = 0.f;
#pragma unroll
                for (int jj = 0; jj < 4; ++jj) den += expf(gl[jj] - gmax);
                const float gwt = 1.f / den;
                float el[8];
#pragma unroll
                for (int jj = 0; jj < 8; ++jj) el[jj] = 0.f;
#pragma unroll
                for (int c = 0; c < 32; ++c) { if ((c >> 3) == gs) el[c & 7] = lg[4 + c] + bre[c]; }
                int i0 = 0; float v0 = el[0];
#pragma unroll
                for (int jj = 1; jj < 8; ++jj) if (el[jj] > v0) { v0 = el[jj]; i0 = jj; }
                int i1 = -1; float v1 = 0.f;
#pragma unroll
                for (int jj = 0; jj < 8; ++jj) if (jj != i0 && (i1 < 0 || el[jj] > v1)) { v1 = el[jj]; i1 = jj; }
                const float e1 = expf(v1 - v0);
                const float w0 = gwt / (1.f + e1), w1 = gwt * e1 / (1.f + e1);
                const int ea = gs * 8 + i0, eb = gs * 8 + i1;
                unsigned* cnt = (unsigned*)(ws + WS_CTL) + CW_CNT + (cidx < 0 ? L : cidx) * 32;
                const int pa = (int)atomicAdd(&cnt[ea], 1u), pb = (int)atomicAdd(&cnt[eb], 1u);
                moe[MO_TOK_E + row * 2] = ea; moe[MO_TOK_E + row * 2 + 1] = eb; moe[MO_TOK_POS + row * 2] = pa; moe[MO_TOK_POS + row * 2 + 1] = pb;
                ((float*)moe)[MO_TOK_W + row * 2] = w0; ((float*)moe)[MO_TOK_W + row * 2 + 1] = w1;
            }
        }
    }
    (void)lgs;
}


__device__ __forceinline__ void phase_ln_router(KP P, int L, LAS unsigned char* lds, int cidx) {
    int tz = threadIdx.x; asm volatile("" : "+v"(tz)); const int tid = tz, lane = tid & 63, wave = tid >> 6;
    unsigned char* ws = P->ws;
    const float* t = (const float*)(ws + WS_T); float* h = (float*)(ws + WS_H); bf16* hb = (bf16*)(ws + WS_HB);
    int* moe = (int*)(ws + WS_MOE);
    const float* g = P->in[16] + (size_t)(L * 3) * D_MODEL; const float* bt = P->in[17] + (size_t)(L * 3) * D_MODEL;
    LAS float* Wl = (LAS float*)lds;
    LAS float* lgs = (LAS float*)(lds + 147456) + wave * 80;
    LAS int* lcnt = (LAS int*)(lds + 150016);
    LAS int* rinfo = (LAS int*)(lds + 150272);
    { const f32x4* wrt = (const f32x4*)(ws + WS_WPLE + 1 * MiB);
      for (int i = tid; i < D_MODEL * 36 / 4; i += 512) ((LAS f32x4*)Wl)[i] = wrt[i];
      if (tid < 64) lcnt[tid] = 0; }
    __syncthreads();
    f32x4 gv[4], bv[4];
#pragma unroll
    for (int j = 0; j < 4; ++j) { gv[j] = *(const f32x4*)(g + 4 * lane + 256 * j); bv[j] = *(const f32x4*)(bt + 4 * lane + 256 * j); }
    const float* brg = P->in[8] + L * N_GROUPS; const float* bre = P->in[10] + L * N_EXPERTS;
    const int gw = blockIdx.x * NWAVES + wave, NGW = gridDim.x * NWAVES;
    int it = 0;
    for (int pi = gw; pi < NTOK / 2; pi += NGW, ++it) {
        const int row0 = pi * 2;
        f32x4 va[4], vb[4];
#pragma unroll
        for (int j = 0; j < 4; ++j) { va[j] = *(const f32x4*)(t + (size_t)row0 * D_MODEL + 4 * lane + 256 * j); vb[j] = *(const f32x4*)(t + (size_t)(row0 + 1) * D_MODEL + 4 * lane + 256 * j); }
        float sa = 0.f, sb = 0.f;
#pragma unroll
        for (int j = 0; j < 4; ++j) { sa += (va[j][0] + va[j][1]) + (va[j][2] + va[j][3]); sb += (vb[j][0] + vb[j][1]) + (vb[j][2] + vb[j][3]); }
        const float ma = wave_sum(sa) * (1.f / D_MODEL), mb_ = wave_sum(sb) * (1.f / D_MODEL);
        float qa = 0.f, qb = 0.f;
#pragma unroll
        for (int j = 0; j < 4; ++j) { va[j] = va[j] - ma; vb[j] = vb[j] - mb_;
            qa += (va[j][0] * va[j][0] + va[j][1] * va[j][1]) + (va[j][2] * va[j][2] + va[j][3] * va[j][3]);
            qb += (vb[j][0] * vb[j][0] + vb[j][1] * vb[j][1]) + (vb[j][2] * vb[j][2] + vb[j][3] * vb[j][3]); }
        const float ra = rsqrtf(wave_sum(qa) * (1.f / D_MODEL) + LN_EPS), rb = rsqrtf(wave_sum(qb) * (1.f / D_MODEL) + LN_EPS);
#pragma unroll
        for (int j = 0; j < 4; ++j) { va[j] = va[j] * ra * gv[j] + bv[j]; vb[j] = vb[j] * rb * gv[j] + bv[j];
            *(f32x4*)(h + (size_t)row0 * D_MODEL + 4 * lane + 256 * j) = va[j]; *(f32x4*)(h + (size_t)(row0 + 1) * D_MODEL + 4 * lane + 256 * j) = vb[j];
            u32x2 oa, ob; oa.x = cvt_pk_bf16(va[j][0], va[j][1]); oa.y = cvt_pk_bf16(va[j][2], va[j][3]); ob.x = cvt_pk_bf16(vb[j][0], vb[j][1]); ob.y = cvt_pk_bf16(vb[j][2], vb[j][3]);
            *(u32x2*)(hb + (size_t)row0 * D_MODEL + 4 * lane + 256 * j) = oa; *(u32x2*)(hb + (size_t)(row0 + 1) * D_MODEL + 4 * lane + 256 * j) = ob; }
#pragma unroll
        for (int p = 0; p < 18; ++p) {
            f32x2 a0 = {0.f, 0.f}, a1 = {0.f, 0.f};
#pragma unroll
            for (int j = 0; j < 4; ++j) { const f32x4 w0 = *(const LAS f32x4*)(Wl + (2 * p) * D_MODEL + 4 * lane + 256 * j), w1 = *(const LAS f32x4*)(Wl + (2 * p + 1) * D_MODEL + 4 * lane + 256 * j);
#pragma unroll
                for (int i = 0; i < 4; ++i) { const f32x2 y = {va[j][i], vb[j][i]}; a0 = a0 + y * w0[i]; a1 = a1 + y * w1[i]; } }
            float ra2[2];
#pragma unroll
            for (int rr = 0; rr < 2; ++rr) {
                auto sw = __builtin_amdgcn_permlane32_swap(__float_as_uint(rr ? a0.y : a0.x), __float_as_uint(rr ? a1.y : a1.x), false, false);
                float v = __uint_as_float(sw[0]) + __uint_as_float(sw[1]);
                v = row16_sum(v); v += __shfl_xor(v, 16); ra2[rr] = v; }
            if ((lane & 31) == 0) { const int ci = 2 * p + (lane >> 5); lgs[ci] = ra2[0]; lgs[40 + ci] = ra2[1]; }
            __builtin_amdgcn_sched_barrier(0);
        }
        asm volatile("s_waitcnt lgkmcnt(0)" ::: "memory");
        if (lane == 0 || lane == 32) {
            const int rr = lane >> 5; LAS float* lg = lgs + rr * 40;
            float gl[4];
#pragma unroll
            for (int jj = 0; jj < 4; ++jj) gl[jj] = lg[jj] + brg[jj];
            int gs = 0; float gmax = gl[0];
#pragma unroll
            for (int jj = 1; jj < 4; ++jj) if (gl[jj] > gmax) { gmax = gl[jj]; gs = jj; }
            float den = 0.f;
#pragma unroll
            for (int jj = 0; jj < 4; ++jj) den += expf(gl[jj] - gmax);
            const float gwt = 1.f / den;
            float el[8];
#pragma unroll
            for (int jj = 0; jj < 8; ++jj) el[jj] = lg[4 + gs * 8 + jj] + bre[gs * 8 + jj];
            int i0 = 0; float v0 = el[0];
#pragma unroll
            for (int jj = 1; jj < 8; ++jj) if (el[jj] > v0) { v0 = el[jj]; i0 = jj; }
            int i1 = -1; float v1 = 0.f;
#pragma unroll
            for (int jj = 0; jj < 8; ++jj) if (jj != i0 && (i1 < 0 || el[jj] > v1)) { v1 = el[jj]; i1 = jj; }
            const float e1 = expf(v1 - v0);
            const float w0 = gwt / (1.f + e1), w1 = gwt * e1 / (1.f + e1);
            const int ea = gs * 8 + i0, eb = gs * 8 + i1;
            const int pa = __hip_atomic_fetch_add(lcnt + ea, 1, __ATOMIC_RELAXED, __HIP_MEMORY_SCOPE_WORKGROUP), pb2 = __hip_atomic_fetch_add(lcnt + eb, 1, __ATOMIC_RELAXED, __HIP_MEMORY_SCOPE_WORKGROUP);
            LAS int* ri = rinfo + ((it * NWAVES + wave) * 2 + rr) * 5;
            ri[0] = ea | (eb << 8); ri[1] = pa; ri[2] = pb2; ri[3] = __float_as_int(w0); ri[4] = __float_as_int(w1);
        }
    }
    __syncthreads();
    if (tid < 32) { const int n = lcnt[tid]; unsigned* cnt = (unsigned*)(ws + WS_CTL) + CW_CNT + cidx * 32; lcnt[32 + tid] = n ? (int)atomicAdd(&cnt[tid], (unsigned)n) : 0; }
    __syncthreads();
    for (int sl = tid; sl < it * NWAVES * 2; sl += 512) {
        const int i2 = sl / (NWAVES * 2), w2 = (sl >> 1) & (NWAVES - 1), rr = sl & 1;
        const int row = ((blockIdx.x * NWAVES + w2) + i2 * NGW) * 2 + rr;
        if (row < NTOK) { const LAS int* ri = rinfo + sl * 5; const int ea = ri[0] & 255, eb = ri[0] >> 8;
            moe[MO_TOK_E + row * 2] = ea; moe[MO_TOK_E + row * 2 + 1] = eb; moe[MO_TOK_POS + row * 2] = lcnt[32 + ea] + ri[1]; moe[MO_TOK_POS + row * 2 + 1] = lcnt[32 + eb] + ri[2];
            moe[MO_TOK_W + row * 2] = ri[3]; moe[MO_TOK_W + row * 2 + 1] = ri[4]; }
    }
}

__device__ __forceinline__ void phase_moe_prep(KP P, int L, LAS unsigned char* lds) {
    int tz = threadIdx.x; asm volatile("" : "+v"(tz));
    const int tid = tz;
    unsigned char* ws = P->ws; int* moe = (int*)(ws + WS_MOE);
    const unsigned* cnt = (const unsigned*)(ws + WS_CTL) + CW_CNT + L * 32;
    LAS int* sb = (LAS int*)lds;
    LAS int* sc = (LAS int*)lds + 64;
    if (tid < 32) sc[tid] = (int)cnt[tid];
    __syncthreads();
    if (tid == 0) { int s = 0; for (int e = 0; e < N_EXPERTS; ++e) { sb[e] = s; s += (sc[e] + 255) / 256 * 256; } sb[N_EXPERTS] = s; }
    __syncthreads();
    const int ntiles = sb[N_EXPERTS] / 256;
    if (blockIdx.x == 0) {
        if (tid == 0) *((unsigned*)(ws + WS_CTL) + CW_NTILES + L) = (unsigned)ntiles;
        for (int T = tid; T < ntiles; T += 512) {
            const int r = T * 256; int e = 0;
            for (int x = 0; x < N_EXPERTS; ++x) if (r >= sb[x] && r < sb[x + 1]) e = x;
            const int nv = sc[e] - (r - sb[e]);
            moe[MO_TILE_E + T] = e; moe[MO_TILE_ROW0 + T] = r; moe[MO_TILE_NV + T] = nv < 256 ? nv : 256;
        }
    }
    for (int a = blockIdx.x * 512 + tid; a < NTOK * 2; a += gridDim.x * 512) {
        const int slot = sb[moe[MO_TOK_E + a]] + moe[MO_TOK_POS + a];
        moe[MO_SLOT_TOK + slot] = a >> 1; moe[MO_TOK_SLOT + a] = slot;
    }
}


namespace mb {
typedef short s16x4 __attribute__((ext_vector_type(4)));
typedef float f32x16 __attribute__((ext_vector_type(16)));
constexpr int SHM_V = 64 * 128 * 2, SHM_K = 64 * 128 * 2, V_OFF = 0, K_OFF = 2 * SHM_V, PRE_OFF = 65536;
constexpr float SCALE = 0.08838834764831845f, LOG2E = 1.4426950408889634f, CC = SCALE * LOG2E, THRX = 8.f * LOG2E;
#define MB_KSWZ(row, colB) ((row) * 256 + ((colB) ^ (((row) & 7) << 4)))
__device__ __forceinline__ int v_st(int k, int c) { const int kk = (k & ~0xC) | ((k & 4) << 1) | ((k & 8) >> 1); return ((kk >> 3) * 4 + (c >> 5)) * 512 + ((kk & 7) * 32 + (c & 31)) * 2; }
__device__ __forceinline__ int v_rd_base(int lane) { return ((lane & 3) << 3) | (((lane >> 2) & 3) << 6) | (((lane >> 4) & 1) << 5) | (((lane >> 5) & 1) << 8); }
constexpr int v_rd_off(int d0, int ks, int half) { return d0 * 512 + ks * 4096 + half * 2048; }
template <int OFF> __device__ __forceinline__ s16x4 tr_read(int vb) { s16x4 r; asm volatile("ds_read_b64_tr_b16 %0, %1 offset:%2" : "=&v"(r) : "v"(vb), "i"(OFF) : "memory"); return r; }
#define MB_SBAR() __builtin_amdgcn_sched_barrier(0)

__device__ __forceinline__ void qkt(f32x16& p0, f32x16& p1, LAS unsigned char* Ks, const bf16x8 (&qr)[8], int r32, int hi) {
    p0 = f32x16{}; p1 = f32x16{};
#pragma unroll
    for (int d0 = 0; d0 < 8; ++d0) { const int cb = (d0 * 16 + hi * 8) * 2;
        const bf16x8 b0 = *(const LAS bf16x8*)(Ks + MB_KSWZ(r32, cb));
        const bf16x8 b1 = *(const LAS bf16x8*)(Ks + MB_KSWZ(32 + r32, cb));
        p0 = __builtin_amdgcn_mfma_f32_32x32x16_bf16(b0, qr[d0], p0, 0, 0, 0);
        p1 = __builtin_amdgcn_mfma_f32_32x32x16_bf16(b1, qr[d0], p1, 0, 0, 0); }
}
__device__ __forceinline__ void partialSM(f32x16& p0, f32x16& p1, float& m_reg, float& mn, float& alpha, float bias2, float tb4, bool own, int lim) {
#pragma unroll
    for (int r = 0; r < 16; ++r) { const float kc = (float)((r & 3) + 8 * (r >> 2));
        p0[r] = fmaf(p0[r], CC, fmaf(bias2, kc, tb4)); p1[r] = fmaf(p1[r], CC, fmaf(bias2, kc + 32.f, tb4)); }
    if (own) {
#pragma unroll
        for (int r = 0; r < 16; ++r) { const int kc = (r & 3) + 8 * (r >> 2); if (kc > lim) p0[r] = -INFINITY; if (kc + 32 > lim) p1[r] = -INFINITY; }
    }
    float pmax = p0[0];
#pragma unroll
    for (int r = 1; r < 16; ++r) pmax = fmaxf(pmax, p0[r]);
#pragma unroll
    for (int r = 0; r < 16; ++r) pmax = fmaxf(pmax, p1[r]);
    { auto rr = __builtin_amdgcn_permlane32_swap(__float_as_uint(pmax), __float_as_uint(pmax), false, false); pmax = fmaxf(__uint_as_float(rr[0]), __uint_as_float(rr[1])); }
    if (__builtin_expect(__all(pmax - m_reg <= THRX), 1)) { mn = m_reg; alpha = 1.f; }
    else { mn = fmaxf(m_reg, pmax); alpha = __builtin_amdgcn_exp2f(m_reg - mn); m_reg = mn; }
#pragma unroll
    for (int r = 0; r < 16; ++r) { p0[r] = p0[r] - mn; p1[r] = p1[r] - mn; }
#pragma unroll
    for (int r = 0; r < 16; ++r) p0[r] = __builtin_amdgcn_exp2f(p0[r]);
}
__device__ __forceinline__ void finishSM(f32x16& p0, f32x16& p1, float alpha, float& l_reg, bf16x8& pa0, bf16x8& pa1, bf16x8& pa2, bf16x8& pa3) {
#pragma unroll
    for (int r = 0; r < 16; ++r) p1[r] = __builtin_amdgcn_exp2f(p1[r]);
    float ps = 0.f;
#pragma unroll
    for (int r = 0; r < 16; ++r) ps += p0[r];
#pragma unroll
    for (int r = 0; r < 16; ++r) ps += p1[r];
    { auto rr = __builtin_amdgcn_permlane32_swap(__float_as_uint(ps), __float_as_uint(ps), false, false); ps = __uint_as_float(rr[0]) + __uint_as_float(rr[1]); }
    l_reg = l_reg * alpha + ps;
#define MB_PK4(P, BASE, OUT) do { unsigned a0 = cvt_pk_bf16(P[BASE + 0], P[BASE + 1]), a1 = cvt_pk_bf16(P[BASE + 2], P[BASE + 3]); \
    unsigned b0 = cvt_pk_bf16(P[BASE + 4], P[BASE + 5]), b1 = cvt_pk_bf16(P[BASE + 6], P[BASE + 7]); \
    auto r0 = __builtin_amdgcn_permlane32_swap(a0, b0, false, false); auto r1 = __builtin_amdgcn_permlane32_swap(a1, b1, false, false); \
    u32x4 w = {r0[0], r1[0], r0[1], r1[1]}; OUT = *reinterpret_cast<bf16x8*>(&w); } while (0)
    MB_PK4(p0, 0, pa0); MB_PK4(p0, 8, pa1); MB_PK4(p1, 0, pa2); MB_PK4(p1, 8, pa3);
#undef MB_PK4
}
template <int D0> __device__ __forceinline__ void pv_one(f32x16& od, int vb, bf16x8 pa0, bf16x8 pa1, bf16x8 pa2, bf16x8 pa3) {
    const s16x4 l0 = tr_read<v_rd_off(D0, 0, 0)>(vb), h0 = tr_read<v_rd_off(D0, 0, 1)>(vb), l1 = tr_read<v_rd_off(D0, 1, 0)>(vb), h1 = tr_read<v_rd_off(D0, 1, 1)>(vb);
    const s16x4 l2 = tr_read<v_rd_off(D0, 2, 0)>(vb), h2 = tr_read<v_rd_off(D0, 2, 1)>(vb), l3 = tr_read<v_rd_off(D0, 3, 0)>(vb), h3 = tr_read<v_rd_off(D0, 3, 1)>(vb);
    asm volatile("s_waitcnt lgkmcnt(0)" ::: "memory"); MB_SBAR();
#define MB_PK(L, H) (bf16x8){L[0], L[1], L[2], L[3], H[0], H[1], H[2], H[3]}
    od = __builtin_amdgcn_mfma_f32_32x32x16_bf16(MB_PK(l0, h0), pa0, od, 0, 0, 0);
    od = __builtin_amdgcn_mfma_f32_32x32x16_bf16(MB_PK(l1, h1), pa1, od, 0, 0, 0);
    od = __builtin_amdgcn_mfma_f32_32x32x16_bf16(MB_PK(l2, h2), pa2, od, 0, 0, 0);
    od = __builtin_amdgcn_mfma_f32_32x32x16_bf16(MB_PK(l3, h3), pa3, od, 0, 0, 0);
#undef MB_PK
}
__device__ __forceinline__ void pv_d0(f32x16 (&o)[4], int vb, bf16x8 pa0, bf16x8 pa1, bf16x8 pa2, bf16x8 pa3) {
    pv_one<0>(o[0], vb, pa0, pa1, pa2, pa3); pv_one<1>(o[1], vb, pa0, pa1, pa2, pa3); pv_one<2>(o[2], vb, pa0, pa1, pa2, pa3); pv_one<3>(o[3], vb, pa0, pa1, pa2, pa3);
}

__device__ __forceinline__ void item(const bf16* __restrict__ q, const bf16* __restrict__ kv, bf16* __restrict__ part_o, float* __restrict__ part_ml, LAS unsigned char* lds,
                                     int tid, int b, int g, int kblk, int NT, bool own, int t, int rh, int slot, bool valid) {
    const int lane = tid & 63, r32 = lane & 31, hi = lane >> 5;
    const int h = g * 4 + rh;
    const bf16* Kh = kv + (size_t)(b * SEQ + kblk * MOBA_BLOCK) * 512 + g * HEAD_DIM;
    float m_reg = -1e30f, l_reg = 0.f; f32x16 o[4] = {}; bf16x8 qr[8];
    { const bf16* Qw = q + (size_t)(b * SEQ + t) * D_MODEL + h * HEAD_DIM + hi * 8;
#pragma unroll
      for (int d0 = 0; d0 < 8; ++d0) qr[d0] = *(const bf16x8*)(Qw + d0 * 16); }
    const float bias2 = __builtin_amdgcn_exp2f(-(float)(h + 1)) * LOG2E;
    const int trel = t - kblk * MOBA_BLOCK;
    const float tb4 = bias2 * (float)(4 * hi - trel);
    const int lim0 = trel - 4 * hi;
    const int sr = tid >> 4, sc = (tid & 15) * 8, vst0 = v_st(sr, sc), vst1 = v_st(32 + sr, sc);
    const int vb0 = (int)(unsigned)(uintptr_t)(lds + V_OFF) + v_rd_base(lane);
    bf16x8 vsA0, vsA1, ksA0, ksA1, vsB0, vsB1, ksB0, ksB1;
    const unsigned vo0 = (unsigned)(sr * 512 + sc) * 2u, vo1 = vo0 + 32u * 1024u;
    const char* KhB = (const char*)Kh;
#define MB_SLOAD_A(k0) do { const char* kt_ = KhB + (size_t)(k0) * 1024; vsA0 = *(const bf16x8*)(kt_ + 512 + vo0); vsA1 = *(const bf16x8*)(kt_ + 512 + vo1); \
        ksA0 = *(const bf16x8*)(kt_ + vo0); ksA1 = *(const bf16x8*)(kt_ + vo1); } while (0)
#define MB_SLOAD_B(k0) do { const char* kt_ = KhB + (size_t)(k0) * 1024; vsB0 = *(const bf16x8*)(kt_ + 512 + vo0); vsB1 = *(const bf16x8*)(kt_ + 512 + vo1); \
        ksB0 = *(const bf16x8*)(kt_ + vo0); ksB1 = *(const bf16x8*)(kt_ + vo1); } while (0)
#define MB_SWRITE(bb, V0, V1, K0, K1) do { *(LAS bf16x8*)(lds + V_OFF + (bb) * SHM_V + vst0) = V0; *(LAS bf16x8*)(lds + V_OFF + (bb) * SHM_V + vst1) = V1; \
        *(LAS bf16x8*)(lds + K_OFF + (bb) * SHM_K + MB_KSWZ(sr, sc * 2)) = K0; *(LAS bf16x8*)(lds + K_OFF + (bb) * SHM_K + MB_KSWZ(32 + sr, sc * 2)) = K1; } while (0)
#define MB_SWAIT() asm volatile("s_waitcnt vmcnt(4)" ::: "memory")
#define MB_RESC(a) do { if (__any((a) < 1.f)) { _Pragma("unroll") for (int d = 0; d < 4; ++d) _Pragma("unroll") for (int r = 0; r < 16; ++r) o[d][r] *= (a); } } while (0)
#define MB_PSM(P0, P1, MN, AL, tile) partialSM(P0, P1, m_reg, MN, AL, bias2, tb4 + bias2 * (float)((tile) * 64), own, lim0 - (tile) * 64)
    f32x16 pA0, pA1, pB0, pB1; float mnA, mnB, alA, alB; bf16x8 pa0, pa1, pa2, pa3;
    MB_SLOAD_A(0); asm volatile("s_waitcnt vmcnt(0)" ::: "memory"); MB_SWRITE(0, vsA0, vsA1, ksA0, ksA1); __syncthreads();
    qkt(pA0, pA1, lds + K_OFF, qr, r32, hi); MB_PSM(pA0, pA1, mnA, alA, 0);
    MB_SLOAD_B(64); if (2 < NT) MB_SLOAD_A(128);
    MB_SWAIT(); MB_SWRITE(1, vsB0, vsB1, ksB0, ksB1); __syncthreads();
    for (int j = 1; j + 1 < NT; j += 2) {
        MB_SBAR(); qkt(pB0, pB1, lds + K_OFF + SHM_K, qr, r32, hi);
        finishSM(pA0, pA1, alA, l_reg, pa0, pa1, pa2, pa3); MB_SBAR();
        MB_SLOAD_B((j + 2) * 64); MB_SBAR();
        pv_d0(o, vb0, pa0, pa1, pa2, pa3); MB_PSM(pB0, pB1, mnB, alB, j);
        __syncthreads(); MB_SWAIT(); MB_SWRITE(0, vsA0, vsA1, ksA0, ksA1);
        MB_RESC(alB); __syncthreads();
        MB_SBAR(); qkt(pA0, pA1, lds + K_OFF, qr, r32, hi);
        finishSM(pB0, pB1, alB, l_reg, pa0, pa1, pa2, pa3); MB_SBAR();
        if (j + 3 < NT) MB_SLOAD_A((j + 3) * 64); MB_SBAR();
        pv_d0(o, vb0 + SHM_V, pa0, pa1, pa2, pa3); MB_PSM(pA0, pA1, mnA, alA, j + 1);
        __syncthreads(); MB_SWAIT(); MB_SWRITE(1, vsB0, vsB1, ksB0, ksB1);
        MB_RESC(alA); __syncthreads();
    }
    MB_SBAR(); qkt(pB0, pB1, lds + K_OFF + SHM_K, qr, r32, hi);
    finishSM(pA0, pA1, alA, l_reg, pa0, pa1, pa2, pa3); MB_SBAR();
    pv_d0(o, vb0, pa0, pa1, pa2, pa3); MB_PSM(pB0, pB1, mnB, alB, NT - 1);
    __syncthreads(); MB_RESC(alB);
    finishSM(pB0, pB1, alB, l_reg, pa0, pa1, pa2, pa3); MB_SBAR();
    pv_d0(o, vb0 + SHM_V, pa0, pa1, pa2, pa3);
    if (valid) {
        const float inv = 1.f / l_reg;
        const size_t rg = ((size_t)(b * SEQ + t) * N_HEADS + h) * 4 + slot;
        bf16* po = part_o + rg * HEAD_DIM + 4 * hi;
#pragma unroll
        for (int d0 = 0; d0 < 4; ++d0)
#pragma unroll
            for (int rq = 0; rq < 4; ++rq) { u32x2 w; w.x = cvt_pk_bf16(o[d0][rq * 4 + 0] * inv, o[d0][rq * 4 + 1] * inv); w.y = cvt_pk_bf16(o[d0][rq * 4 + 2] * inv, o[d0][rq * 4 + 3] * inv);
                *(u32x2*)(po + d0 * 32 + rq * 8) = w; }
        if (hi == 0) { f32x2 ml; ml.x = m_reg; ml.y = l_reg; *(f32x2*)(part_ml + rg * 2) = ml; }
    }
    __syncthreads();
#undef MB_SLOAD_A
#undef MB_SLOAD_B
#undef MB_SWRITE
#undef MB_SWAIT
#undef MB_RESC
#undef MB_PSM
}
}

constexpr size_t WS_SELB = WS_T;
constexpr size_t WS_PML = WS_T + 2 * MiB;
constexpr size_t WS_LISTS = WS_T + 16 * MiB;
constexpr size_t WS_PARTO = WS_SCORES;
constexpr int CW_LCNT = 16384 + 512;

__device__ __forceinline__ void phase_kmeans(KP P) {
    int tz = threadIdx.x; asm volatile("" : "+v"(tz)); const int tid = tz;
    const bf16* kv = (const bf16*)(P->ws + WS_KV); float* km = (float*)(P->ws + WS_KM);
    for (int it = blockIdx.x; it < BATCH * N_KV * N_BLOCKS; it += gridDim.x) {
        const int blk = it % N_BLOCKS, g = (it / N_BLOCKS) % N_KV, b = it / (N_BLOCKS * N_KV);
        if (tid < HEAD_DIM) { float s = 0.f;
            for (int i = 0; i < MOBA_BLOCK; ++i) s += bf2f(kv[(size_t)(b * SEQ + blk * MOBA_BLOCK + i) * 512 + g * HEAD_DIM + tid]);
            const float mval = s * (1.f / MOBA_BLOCK); km[(size_t)it * HEAD_DIM + tid] = mval;
            const unsigned hi16 = cvt_pk_bf16(mval, 0.f) & 0xffffu; const float rem = mval - bflo(hi16);
            bf16* kmh = (bf16*)(km + 65536); kmh[(size_t)it * HEAD_DIM + tid] = (bf16)hi16; kmh[(size_t)(BATCH * N_KV * N_BLOCKS + it) * HEAD_DIM + tid] = (bf16)(cvt_pk_bf16(rem, 0.f) & 0xffffu); }
    }
}
__device__ __forceinline__ void phase_moba_gate(KP P, LAS unsigned char* lds) {
    int tz = threadIdx.x; asm volatile("" : "+v"(tz)); const int tid = tz, lane = tid & 63, wave = tid >> 6;
    const bf16* q = (const bf16*)(P->ws + WS_QKVI); const float* km = (const float*)(P->ws + WS_KM); unsigned char* selb = (unsigned char*)(P->ws + WS_SELB);
    LAS float* qs = (LAS float*)(lds + wave * 2048);
    const int blk = lane & 31, half = lane >> 5;
    for (int it = blockIdx.x * NWAVES + wave; it < NTOK * 2; it += gridDim.x * NWAVES) {
        const int tok = it >> 1, g = it & 1, b = tok / SEQ, t = tok % SEQ, own = t >> 8;
        unsigned char* sb = selb + ((size_t)tok * 8 + g * 4) * 4;
        if (own < 3) { if (lane < 4) { for (int s2 = own; s2 < 3; ++s2) sb[lane * 4 + s2] = 0xFF; } }
        if (own == 0) continue;
        { const u32x4 w = *(const u32x4*)(q + (size_t)tok * D_MODEL + g * 512 + lane * 8);
          LAS float* d = qs + lane * 8;
          d[0] = bflo(w.x); d[1] = bfhi(w.x); d[2] = bflo(w.y); d[3] = bfhi(w.y); d[4] = bflo(w.z); d[5] = bfhi(w.z); d[6] = bflo(w.w); d[7] = bfhi(w.w); }
        asm volatile("s_waitcnt lgkmcnt(0)" ::: "memory");
        float acc[4] = {0.f, 0.f, 0.f, 0.f};
        const float* kp = km + ((size_t)(b * N_KV + g) * N_BLOCKS + blk) * HEAD_DIM + half * 64;
#pragma unroll 4
        for (int i = 0; i < 16; ++i) { const f32x4 kk = *(const f32x4*)(kp + 4 * i);
#pragma unroll
            for (int r = 0; r < 4; ++r) { const f32x4 qq = *(const LAS f32x4*)(qs + r * 128 + half * 64 + 4 * i); acc[r] += (kk[0] * qq[0] + kk[1] * qq[1]) + (kk[2] * qq[2] + kk[3] * qq[3]); } }
#pragma unroll
        for (int r = 0; r < 4; ++r) { acc[r] += __shfl_xor(acc[r], 32); if (blk >= own) acc[r] = -INFINITY; }
        int rank[4] = {0, 0, 0, 0};
#pragma unroll
        for (int j = 0; j < 32; ++j) {
#pragma unroll
            for (int r = 0; r < 4; ++r) { const float vj = __uint_as_float(__builtin_amdgcn_readlane(__float_as_uint(acc[r]), j)); rank[r] += (vj > acc[r] || (vj == acc[r] && j < blk)) ? 1 : 0; }
        }
        if (half == 0 && blk < own) {
#pragma unroll
            for (int r = 0; r < 4; ++r) if (rank[r] < 3) sb[r * 4 + rank[r]] = (unsigned char)blk;
        }
    }
}

__device__ __forceinline__ void phase_moba_gate2(KP P) {
    typedef float f32x16 __attribute__((ext_vector_type(16)));
    int tz = threadIdx.x; asm volatile("" : "+v"(tz)); const int tid = tz, lane = tid & 63, wave = tid >> 6, r32 = lane & 31, hi = lane >> 5;
    const bf16* q = (const bf16*)(P->ws + WS_QKVI); const bf16* kmh = (const bf16*)((const float*)(P->ws + WS_KM) + 65536); unsigned char* selb = (unsigned char*)(P->ws + WS_SELB);
    const int gw = blockIdx.x * NWAVES + wave, NGW = gridDim.x * NWAVES;
    int cur_bg = -1; bf16x8 ah[8], al[8];
    for (int tile = gw * 4; tile < 8192; tile += NGW * 4) {
#pragma unroll 1
        for (int sub = 0; sub < 4; ++sub) {
            const int tl = tile + sub, bg = tl >> 10, b = bg >> 1, g = bg & 1, rt = tl & 1023;
            if (bg != cur_bg) { cur_bg = bg;
                const bf16* kp = kmh + ((size_t)(b * N_KV + g) * N_BLOCKS + r32) * HEAD_DIM + 8 * hi;
#pragma unroll
                for (int ks = 0; ks < 8; ++ks) { ah[ks] = *(const bf16x8*)(kp + 16 * ks); al[ks] = *(const bf16x8*)(kp + (size_t)BATCH * N_KV * N_BLOCKS * HEAD_DIM + 16 * ks); } }
            const int row = rt * 32 + r32, t = row >> 2, rh = row & 3, own = t >> 8, tok = b * SEQ + t;
            const bf16* qp = q + (size_t)tok * D_MODEL + (g * 4 + rh) * HEAD_DIM + 8 * hi;
            f32x16 acc = {};
#pragma unroll
            for (int ks = 0; ks < 8; ++ks) { const bf16x8 qv = *(const bf16x8*)(qp + 16 * ks);
                acc = __builtin_amdgcn_mfma_f32_32x32x16_bf16(ah[ks], qv, acc, 0, 0, 0); acc = __builtin_amdgcn_mfma_f32_32x32x16_bf16(al[ks], qv, acc, 0, 0, 0); }
            float v[16];
#pragma unroll
            for (int r = 0; r < 16; ++r) { const int blk = (r & 3) + 8 * (r >> 2) + 4 * hi; v[r] = (blk < own) ? acc[r] : -INFINITY; }
            float bv[3]; int bi[3];
#pragma unroll
            for (int p = 0; p < 3; ++p) { float best = -INFINITY; int br = -1;
#pragma unroll
                for (int r = 0; r < 16; ++r) { if (v[r] > best) { best = v[r]; br = r; } }
                bv[p] = best; bi[p] = (br < 0) ? 255 : ((br & 3) + 8 * (br >> 2) + 4 * hi);
#pragma unroll
                for (int r = 0; r < 16; ++r) { if (r == br) v[r] = -INFINITY; } }
            float ov[3]; int oi[3];
#pragma unroll
            for (int p = 0; p < 3; ++p) { ov[p] = __shfl_xor(bv[p], 32); oi[p] = __shfl_xor(bi[p], 32); }
            int ia = 0, ib = 0; int res[3];
#pragma unroll
            for (int p = 0; p < 3; ++p) {
                const float va = (ia == 0) ? bv[0] : (ia == 1) ? bv[1] : (ia == 2) ? bv[2] : -INFINITY; const int xa = (ia == 0) ? bi[0] : (ia == 1) ? bi[1] : (ia == 2) ? bi[2] : 255;
                const float vb = (ib == 0) ? ov[0] : (ib == 1) ? ov[1] : (ib == 2) ? ov[2] : -INFINITY; const int xb = (ib == 0) ? oi[0] : (ib == 1) ? oi[1] : (ib == 2) ? oi[2] : 255;
                const bool takeA = (va > vb) || (va == vb && xa < xb);
                const float vv = takeA ? va : vb; const int xx = takeA ? xa : xb;
                res[p] = (vv > -INFINITY) ? xx : 255; if (takeA) ++ia; else ++ib; }
            if (hi == 0) { const unsigned w = (unsigned)res[0] | ((unsigned)res[1] << 8) | ((unsigned)res[2] << 16) | 0xFF000000u;
                *(unsigned*)(selb + ((size_t)tok * 8 + g * 4 + rh) * 4) = w; }
        }
    }
}

__device__ __forceinline__ void phase_moba_lists(KP P, LAS unsigned char* lds) {
    int tz = threadIdx.x; asm volatile("" : "+v"(tz)); const int tid = tz, lane = tid & 63, wave = tid >> 6;
    const u32x4* selb = (const u32x4*)(P->ws + WS_SELB); unsigned* lists = (unsigned*)(P->ws + WS_LISTS); unsigned* lcnt = (unsigned*)(P->ws + WS_CTL) + CW_LCNT;
    LAS int* wtot = (LAS int*)lds;
    for (int li = blockIdx.x; li < 256; li += gridDim.x) {
        const int j = li & 31, g = (li >> 5) & 1, b = li >> 6, base_t = (j + 1) * MOBA_BLOCK, n_t = SEQ - base_t;
        unsigned* out = lists + (size_t)li * 32768;
        int running = 0;
        for (int i0 = 0; i0 < n_t; i0 += 512) {
            const int ti = i0 + tid; const bool ok = ti < n_t; const int t = base_t + ti;
            u32x4 w = {0xFFFFFFFFu, 0xFFFFFFFFu, 0xFFFFFFFFu, 0xFFFFFFFFu};
            if (ok) w = selb[((size_t)(b * SEQ + t) * 8 + g * 4) / 4];
            int ms[4];
#pragma unroll
            for (int r = 0; r < 4; ++r) { const unsigned x = w[r]; ms[r] = ((x & 0xFFu) == (unsigned)j) ? 0 : (((x >> 8) & 0xFFu) == (unsigned)j) ? 1 : (((x >> 16) & 0xFFu) == (unsigned)j) ? 2 : -1; }
            const int c = (ms[0] >= 0) + (ms[1] >= 0) + (ms[2] >= 0) + (ms[3] >= 0);
            int inc = c;
#pragma unroll
            for (int o = 1; o < 64; o <<= 1) { const int v = __shfl_up(inc, o); if (lane >= o) inc += v; }
            __syncthreads();
            if (lane == 63) wtot[wave] = inc;
            __syncthreads();
            int woff = 0, tot = 0;
#pragma unroll
            for (int x = 0; x < NWAVES; ++x) { const int v = wtot[x]; if (x < wave) woff += v; tot += v; }
            int pos = running + woff + inc - c;
#pragma unroll
            for (int r = 0; r < 4; ++r) if (ms[r] >= 0) out[pos++] = (unsigned)t | ((unsigned)r << 13) | ((unsigned)ms[r] << 15);
            running += tot;
        }
        if (tid == 0) lcnt[li] = (unsigned)running;
        __syncthreads();
    }
}
__device__ __forceinline__ void phase_moba_attn(KP P, LAS unsigned char* lds) {
    int tz = threadIdx.x; asm volatile("" : "+v"(tz)); const int tid = tz, lane = tid & 63, wave = tid >> 6;
    const bf16* q = (const bf16*)(P->ws + WS_QKVI); const bf16* kv = (const bf16*)(P->ws + WS_KV);
    bf16* part_o = (bf16*)(P->ws + WS_PARTO); float* part_ml = (float*)(P->ws + WS_PML);
    const unsigned* lists = (const unsigned*)(P->ws + WS_LISTS); const unsigned* lcnt = (const unsigned*)(P->ws + WS_CTL) + CW_LCNT;
    LAS int* pre = (LAS int*)(lds + mb::PRE_OFF);
    LAS int* cn = pre + 260;
    if (tid < 256) cn[tid] = (int)lcnt[tid];
    __syncthreads();
    if (tid == 0) { int s = 0; for (int i = 0; i < 256; ++i) { pre[i] = s; s += (cn[i] + 255) >> 8; } pre[256] = s; }
    __syncthreads();
    const int npast = pre[256], total = npast + 1024;
    for (int it = blockIdx.x; it < total; it += gridDim.x) {
        int b, g, kblk, NT, t, rh, slot; bool own, valid;
        const int ri = wave * 32 + (lane & 31);
        if (it < npast) {
            int lo = 0, hi = 256;
            while (hi - lo > 1) { const int mid = (lo + hi) >> 1; if (pre[mid] <= it) lo = mid; else hi = mid; }
            const int li = lo, chunk = it - pre[li], n = cn[li];
            kblk = li & 31; g = (li >> 5) & 1; b = li >> 6; NT = 4; own = false;
            int idx = chunk * 256 + ri; valid = idx < n; if (!valid) idx = chunk * 256;
            const unsigned e = lists[(size_t)li * 32768 + idx];
            t = (int)(e & 0x1FFFu); rh = (int)((e >> 13) & 3u); slot = (int)((e >> 15) & 3u);
        } else {
            const int oi = it - npast, chunk = oi & 3, bi = oi >> 2;
            kblk = bi & 31; g = (bi >> 5) & 1; b = bi >> 6; NT = chunk < 2 ? 2 : 4; own = true; valid = true;
            t = kblk * MOBA_BLOCK + chunk * 64 + (ri >> 2); rh = ri & 3; slot = 3;
        }
        mb::item(q, kv, part_o, part_ml, lds, tid, b, g, kblk, NT, own, t, rh, slot, valid);
    }
}

namespace mb {
constexpr int SEG_K = 0, SEG_V = 65536, SEG_PRE = 131072, SEGC = 8;
__device__ __forceinline__ void stage_block(const bf16* __restrict__ kv, LAS unsigned char* lds, int tid, int b, int g, int kblk) {
    const char* KhB = (const char*)(kv + (size_t)(b * SEQ + kblk * MOBA_BLOCK) * 512 + g * HEAD_DIM);
    const int sr = tid >> 4, sc = (tid & 15) * 8, vst0 = v_st(sr, sc), vst1 = v_st(32 + sr, sc);
    const unsigned vo0 = (unsigned)(sr * 512 + sc) * 2u, vo1 = vo0 + 32u * 1024u;
#pragma unroll
    for (int h2 = 0; h2 < 2; ++h2) {
        bf16x8 kx[2][2], vx[2][2];
#pragma unroll
        for (int tt = 0; tt < 2; ++tt) { const char* kt_ = KhB + (size_t)((h2 * 2 + tt) * 64) * 1024;
            kx[tt][0] = *(const bf16x8*)(kt_ + vo0); kx[tt][1] = *(const bf16x8*)(kt_ + vo1); vx[tt][0] = *(const bf16x8*)(kt_ + 512 + vo0); vx[tt][1] = *(const bf16x8*)(kt_ + 512 + vo1); }
#pragma unroll
        for (int tt = 0; tt < 2; ++tt) { const int tile = h2 * 2 + tt;
            *(LAS bf16x8*)(lds + SEG_K + tile * SHM_K + MB_KSWZ(sr, sc * 2)) = kx[tt][0]; *(LAS bf16x8*)(lds + SEG_K + tile * SHM_K + MB_KSWZ(32 + sr, sc * 2)) = kx[tt][1];
            *(LAS bf16x8*)(lds + SEG_V + tile * SHM_V + vst0) = vx[tt][0]; *(LAS bf16x8*)(lds + SEG_V + tile * SHM_V + vst1) = vx[tt][1]; }
    }
}
__device__ __forceinline__ void chunk_rows(const bf16* __restrict__ q, bf16* __restrict__ part_o, float* __restrict__ part_ml, LAS unsigned char* lds, int lane,
                                           int b, int g, int kblk, int NT, bool own, int t, int rh, int slot, bool valid) {
    const int r32 = lane & 31, hi = lane >> 5, h = g * 4 + rh;
    float m_reg = -1e30f, l_reg = 0.f; f32x16 o[4] = {}; bf16x8 qr[8];
    { const bf16* Qw = q + (size_t)(b * SEQ + t) * D_MODEL + h * HEAD_DIM + hi * 8;
#pragma unroll
      for (int d0 = 0; d0 < 8; ++d0) qr[d0] = *(const bf16x8*)(Qw + d0 * 16); }
    const float bias2 = __builtin_amdgcn_exp2f(-(float)(h + 1)) * LOG2E;
    const int trel = t - kblk * MOBA_BLOCK;
    const float tb4 = bias2 * (float)(4 * hi - trel);
    const int lim0 = trel - 4 * hi;
    const int vb0 = (int)(unsigned)(uintptr_t)(lds + SEG_V) + v_rd_base(lane);
    for (int tile = 0; tile < NT; ++tile) {
        f32x16 p0, p1; float mn, al; bf16x8 pa0, pa1, pa2, pa3;
        qkt(p0, p1, lds + SEG_K + tile * SHM_K, qr, r32, hi);
        partialSM(p0, p1, m_reg, mn, al, bias2, tb4 + bias2 * (float)(tile * 64), own, lim0 - tile * 64);
        if (__any(al < 1.f)) {
#pragma unroll
            for (int d = 0; d < 4; ++d)
#pragma unroll
                for (int r = 0; r < 16; ++r) o[d][r] *= al; }
        finishSM(p0, p1, al, l_reg, pa0, pa1, pa2, pa3);
        pv_d0(o, vb0 + tile * SHM_V, pa0, pa1, pa2, pa3);
    }
    if (valid) {
        const float inv = 1.f / l_reg;
        const size_t rg = ((size_t)(b * SEQ + t) * N_HEADS + h) * 4 + slot;
        bf16* po = part_o + rg * HEAD_DIM + 4 * hi;
#pragma unroll
        for (int d0 = 0; d0 < 4; ++d0)
#pragma unroll
            for (int rq = 0; rq < 4; ++rq) { u32x2 w; w.x = cvt_pk_bf16(o[d0][rq * 4 + 0] * inv, o[d0][rq * 4 + 1] * inv); w.y = cvt_pk_bf16(o[d0][rq * 4 + 2] * inv, o[d0][rq * 4 + 3] * inv);
                *(u32x2*)(po + d0 * 32 + rq * 8) = w; }
        if (hi == 0) { f32x2 ml; ml.x = m_reg; ml.y = l_reg; *(f32x2*)(part_ml + rg * 2) = ml; }
    }
}
}
constexpr int CW_MQ = 20480;
__device__ __forceinline__ void phase_moba_attn2(KP P, int Lb, LAS unsigned char* lds) {
    int tz = threadIdx.x; asm volatile("" : "+v"(tz)); const int tid = tz, lane = tid & 63, wave = tid >> 6;
    const bf16* q = (const bf16*)(P->ws + WS_QKVI); const bf16* kv = (const bf16*)(P->ws + WS_KV);
    bf16* part_o = (bf16*)(P->ws + WS_PARTO); float* part_ml = (float*)(P->ws + WS_PML);
    const unsigned* lists = (const unsigned*)(P->ws + WS_LISTS); const unsigned* lcnt = (const unsigned*)(P->ws + WS_CTL) + CW_LCNT;
    unsigned* qhead = (unsigned*)(P->ws + WS_CTL) + CW_MQ + Lb * 64;
    LAS int* pre = (LAS int*)(lds + mb::SEG_PRE);
    LAS int* cn = pre + 260;
    LAS int* cur = pre + 520;
    if (tid < 256) cn[tid] = (int)lcnt[tid];
    __syncthreads();
    if (tid == 0) { int s2 = 0; for (int i = 0; i < 256; ++i) { pre[i] = s2; const int nch = (cn[i] + 255) >> 8; s2 += (nch + mb::SEGC - 1) / mb::SEGC; } pre[256] = s2; }
    __syncthreads();
    const int npast = pre[256], total = npast + 256;
    for (;;) {
        if (tid == 0) cur[0] = (int)__hip_atomic_fetch_add(qhead, 1u, __ATOMIC_RELAXED, __HIP_MEMORY_SCOPE_AGENT);
        __syncthreads();
        const int sg = cur[0];
        if (sg >= total) break;
        int b, g, kblk, li = 0, ch0, nch, n = 0; bool own;
        if (sg < npast) {
            int lo = 0, hi2 = 256;
            while (hi2 - lo > 1) { const int mid = (lo + hi2) >> 1; if (pre[mid] <= sg) lo = mid; else hi2 = mid; }
            li = lo; n = cn[li]; ch0 = (sg - pre[li]) * mb::SEGC; const int ncht = (n + 255) >> 8; nch = ncht - ch0 < mb::SEGC ? ncht - ch0 : mb::SEGC;
            kblk = li & 31; g = (li >> 5) & 1; b = li >> 6; own = false;
        } else { const int bi = sg - npast; kblk = bi & 31; g = (bi >> 5) & 1; b = bi >> 6; own = true; ch0 = 0; nch = 4; }
        mb::stage_block(kv, lds, tid, b, g, kblk);
        __syncthreads();
        const int ri = wave * 32 + (lane & 31);
        for (int c = 0; c < nch; ++c) {
            const int chunk = ch0 + c; int t, rh, slot, NT; bool valid;
            if (!own) { int idx = chunk * 256 + ri; valid = idx < n; if (!valid) idx = chunk * 256;
                const unsigned e = lists[(size_t)li * 32768 + idx];
                t = (int)(e & 0x1FFFu); rh = (int)((e >> 13) & 3u); slot = (int)((e >> 15) & 3u); NT = 4;
            } else { valid = true; t = kblk * MOBA_BLOCK + chunk * 64 + (ri >> 2); rh = ri & 3; slot = 3; NT = chunk + 1; }
            mb::chunk_rows(q, part_o, part_ml, lds, lane, b, g, kblk, NT, own, t, rh, slot, valid);
        }
        __syncthreads();
    }
}

__device__ __forceinline__ void phase_moba_combine(KP P) {
    int tz = threadIdx.x; asm volatile("" : "+v"(tz)); const int tid = tz;
    const bf16* part_o = (const bf16*)(P->ws + WS_PARTO); const float* part_ml = (const float*)(P->ws + WS_PML); bf16* attn = (bf16*)(P->ws + WS_ATTN);
    const int sub = tid & 15;
#pragma unroll 2
    for (int rg = (blockIdx.x * 512 + tid) >> 4; rg < NTOK * N_HEADS; rg += (gridDim.x * 512) >> 4) {
        const int tok = rg >> 3, own = (tok % SEQ) >> 8, nv = own < 3 ? own : 3;
        const float* ml = part_ml + (size_t)rg * 8;
        float m[4], l[4];
#pragma unroll
        for (int s2 = 0; s2 < 4; ++s2) { const bool ok = (s2 == 3) || (s2 < nv); m[s2] = ok ? ml[s2 * 2] : -INFINITY; l[s2] = ok ? ml[s2 * 2 + 1] : 0.f; }
        const float M = fmaxf(fmaxf(m[0], m[1]), fmaxf(m[2], m[3]));
        float w[4], W = 0.f;
#pragma unroll
        for (int s2 = 0; s2 < 4; ++s2) { w[s2] = l[s2] * __builtin_amdgcn_exp2f(m[s2] - M); W += w[s2]; }
        const float inv = 1.f / W;
        float acc[8] = {0.f, 0.f, 0.f, 0.f, 0.f, 0.f, 0.f, 0.f};
#pragma unroll
        for (int s2 = 0; s2 < 4; ++s2) {
            if ((s2 == 3) || (s2 < nv)) {
                const u32x4 v = *(const u32x4*)(part_o + ((size_t)rg * 4 + s2) * HEAD_DIM + sub * 8); const float ws2 = w[s2] * inv;
                acc[0] += ws2 * bflo(v.x); acc[1] += ws2 * bfhi(v.x); acc[2] += ws2 * bflo(v.y); acc[3] += ws2 * bfhi(v.y);
                acc[4] += ws2 * bflo(v.z); acc[5] += ws2 * bfhi(v.z); acc[6] += ws2 * bflo(v.w); acc[7] += ws2 * bfhi(v.w);
            }
        }
        u32x4 o; o.x = cvt_pk_bf16(acc[0], acc[1]); o.y = cvt_pk_bf16(acc[2], acc[3]); o.z = cvt_pk_bf16(acc[4], acc[5]); o.w = cvt_pk_bf16(acc[6], acc[7]);
        *(u32x4*)(attn + (size_t)rg * HEAD_DIM + sub * 8) = o;
    }
}


#ifndef D1_EXP
#define D1_EXP 0
#endif
constexpr int D1_QS = 4100, D1_SM = 32 * D1_QS, D1_SELIDX = D1_SM + 1024, D1_NT = 992;
__device__ __forceinline__ unsigned fkey2(float f) { const unsigned u = __float_as_uint(f); return (u & 0x80000000u) ? ~u : (u | 0x80000000u); }
template <int PASS, int EXP>
__device__ __forceinline__ void d1_scan(const bf16* __restrict__ ikb, int qt, int kt_end, int wave, int lane, const bf16x8 (&qb)[4][4], const float (&wv)[4], LAS unsigned char* lds, unsigned thr, float flo = 0.f, float finv = 0.f, unsigned bstar = 0) {
    typedef float f32x16 __attribute__((ext_vector_type(16)));
    const int r32 = lane & 31, hi = lane >> 5;
    LAS unsigned* hq = (LAS unsigned*)(lds + r32 * D1_QS);
    LAS unsigned* sm = (LAS unsigned*)(lds + D1_SM);
    bf16x8 ka[4];
    int kt = wave;
    if (kt <= kt_end) { const bf16* kp = ikb + (size_t)(kt * 32 + r32) * QLD + 8 * hi;
#pragma unroll
        for (int ks = 0; ks < 4; ++ks) ka[ks] = *(const bf16x8*)(kp + 16 * ks); }
    for (; kt <= kt_end; kt += 8) {
        bf16x8 kn[4];
#pragma unroll
        for (int ks = 0; ks < 4; ++ks) kn[ks] = ka[ks];
        if (kt + 8 <= kt_end) { const bf16* kp = ikb + (size_t)((kt + 8) * 32 + r32) * QLD + 8 * hi;
#pragma unroll
            for (int ks = 0; ks < 4; ++ks) kn[ks] = *(const bf16x8*)(kp + 16 * ks); }
        float sc[16];
#pragma unroll
        for (int r = 0; r < 16; ++r) sc[r] = 0.f;
#pragma unroll
        for (int h = 0; h < 4; ++h) { f32x16 acc = {};
#pragma unroll
            for (int ks = 0; ks < 4; ++ks) acc = __builtin_amdgcn_mfma_f32_32x32x16_bf16(ka[ks], qb[h][ks], acc, 0, 0, 0);
#pragma unroll
            for (int r = 0; r < 16; ++r) sc[r] = fmaf(wv[h], fmaxf(acc[r], 0.f), sc[r]); }
        int kbase = kt * 32 + 4 * hi; asm volatile("" : "+v"(kbase));
        const int lim = (kt == qt) ? (r32 - 4 * hi) : 64;
#pragma unroll
        for (int r = 0; r < 16; ++r) {
            const int kc = (r & 3) + 8 * (r >> 2);
            const bool valid = kc <= lim;
            const unsigned key = fkey2(sc[r]);
            if (PASS == 1) { if (EXP == 3) { if (key == 12345u) hq[0] = 1u; } else if (valid && EXP != 2) { const unsigned bin = key >> 21; (void)__hip_atomic_fetch_add(hq + (bin >> 1), 1u << (16 * (bin & 1)), __ATOMIC_RELAXED, __HIP_MEMORY_SCOPE_WORKGROUP); } }
            else if (PASS == 2) { if (valid && (key >> 21) == thr) { const unsigned bin = (key >> 10) & 2047u; (void)__hip_atomic_fetch_add(hq + (bin >> 1), 1u << (16 * (bin & 1)), __ATOMIC_RELAXED, __HIP_MEMORY_SCOPE_WORKGROUP); } }
            else if (PASS == 4) { if (valid && sc[r] >= flo) { unsigned bin = (unsigned)((sc[r] - flo) * finv); bin = bin > 2047u ? 2047u : bin; (void)__hip_atomic_fetch_add(hq + (bin >> 1), 1u << (16 * (bin & 1)), __ATOMIC_RELAXED, __HIP_MEMORY_SCOPE_WORKGROUP); } }
            else if (PASS == 5) { if (valid && sc[r] >= flo) { unsigned bin = (unsigned)((sc[r] - flo) * finv); bin = bin > 2047u ? 2047u : bin; const unsigned sidx = (unsigned)(kbase + kc);
                    if (bin > bstar) (void)__hip_atomic_fetch_or(hq + 512 + (sidx >> 5), 1u << (sidx & 31u), __ATOMIC_RELAXED, __HIP_MEMORY_SCOPE_WORKGROUP);
                    else if (bin == bstar) {
                        if (key == 0x80000000u) (void)__hip_atomic_fetch_or(hq + 768 + (sidx >> 5), 1u << (sidx & 31u), __ATOMIC_RELAXED, __HIP_MEMORY_SCOPE_WORKGROUP);
                        else { const unsigned cp = __hip_atomic_fetch_add(sm + 160 + r32, 1u, __ATOMIC_RELAXED, __HIP_MEMORY_SCOPE_WORKGROUP); if (cp < 256u) { hq[cp] = key; ((LAS unsigned short*)(hq + 256))[cp] = (unsigned short)sidx; } } } } }
            else { if (valid) { const unsigned p22 = key >> 10; const unsigned sidx = (unsigned)(kbase + kc);
                    if (p22 > thr) (void)__hip_atomic_fetch_or(hq + 512 + (sidx >> 5), 1u << (sidx & 31u), __ATOMIC_RELAXED, __HIP_MEMORY_SCOPE_WORKGROUP);
                    else if (p22 == thr) {
                        if (key == 0x80000000u) (void)__hip_atomic_fetch_or(hq + 768 + (sidx >> 5), 1u << (sidx & 31u), __ATOMIC_RELAXED, __HIP_MEMORY_SCOPE_WORKGROUP);
                        else { const unsigned cp = __hip_atomic_fetch_add(sm + 160 + r32, 1u, __ATOMIC_RELAXED, __HIP_MEMORY_SCOPE_WORKGROUP); if (cp < 256u) { hq[cp] = key; ((LAS unsigned short*)(hq + 256))[cp] = (unsigned short)sidx; } } } } }
        }
#pragma unroll
        for (int ks = 0; ks < 4; ++ks) ka[ks] = kn[ks];
    }
}
__device__ __forceinline__ bool d1_find(LAS unsigned* H, unsigned need, int lane, unsigned& bin_out, unsigned& above_out) {
    unsigned mine = 0;
#pragma unroll
    for (int i = 0; i < 16; ++i) { const unsigned w = H[lane * 16 + i]; mine += (w & 0xFFFFu) + (w >> 16); }
    unsigned inc = mine;
#pragma unroll
    for (int o = 1; o < 64; o <<= 1) { const unsigned v = __shfl_down(inc, o); if (lane + o < 64) inc += v; }
    const unsigned above = inc - mine; const bool found = (above < need) && (inc >= need);
    const unsigned long long bal = __ballot(found); const int src = bal ? (__ffsll((long long)bal) - 1) : 0;
    const unsigned ab0 = __shfl(above, src);
    unsigned cj = 0;
    if (lane < 32) { const int bidx = src * 32 + 31 - lane; const unsigned w = H[bidx >> 1]; cj = (bidx & 1) ? (w >> 16) : (w & 0xFFFFu); }
    unsigned inc2 = cj;
#pragma unroll
    for (int o = 1; o < 32; o <<= 1) { const unsigned v = __shfl_up(inc2, o); if (lane >= o) inc2 += v; }
    const bool hit = (lane < 32) && (ab0 + inc2 >= need) && (ab0 + inc2 - cj < need);
    const unsigned long long bal2 = __ballot(hit); const int l2 = bal2 ? (__ffsll((long long)bal2) - 1) : 0;
    bin_out = (unsigned)(src * 32 + 31 - l2); above_out = ab0 + __shfl(inc2 - cj, l2);
    return bal != 0ull;
}
template <int EXP>
__device__ __forceinline__ void phase_dsa_topk(KP P, LAS unsigned char* lds, size_t sel_off) {
    int tz = threadIdx.x; asm volatile("" : "+v"(tz)); const int tid = tz, lane = tid & 63, wave = tid >> 6, r32 = lane & 31, hi = lane >> 5;
    const bf16* qkvi = (const bf16*)(P->ws + WS_QKVI); const float* iw = (const float*)(P->ws + WS_IW); int* sel = (int*)(P->ws + sel_off);
    LAS unsigned* sm = (LAS unsigned*)(lds + D1_SM);
    const int G = gridDim.x, nrounds = (D1_NT + G - 1) / G;
    for (int rho = 0; rho < nrounds; ++rho) {
        const int pos = (rho & 1) ? (G - 1 - (int)blockIdx.x) : (int)blockIdx.x, i = rho * G + pos;
        if (i >= D1_NT) continue;
        const int qt = 255 - (i >> 2), b = i & 3, t0 = qt * 32, tok0 = b * SEQ + t0;
        for (int w = tid; w < (D1_SM + 1024) / 4; w += 512) ((LAS unsigned*)lds)[w] = 0u;
        bf16x8 qb[4][4]; float wv[4];
        { const bf16* qp = qkvi + (size_t)(tok0 + r32) * QLD + COL_IQ + 8 * hi;
#pragma unroll
          for (int h = 0; h < 4; ++h)
#pragma unroll
              for (int ks = 0; ks < 4; ++ks) qb[h][ks] = *(const bf16x8*)(qp + h * IDX_DIM + 16 * ks);
          const f32x4 w4 = *(const f32x4*)(iw + (size_t)(tok0 + r32) * 4); wv[0] = w4[0]; wv[1] = w4[1]; wv[2] = w4[2]; wv[3] = w4[3]; }
        const bf16* ikb = qkvi + (size_t)b * SEQ * QLD + COL_IK;
        __syncthreads();
        d1_scan<1, EXP>(ikb, qt, 7, wave, lane, qb, wv, lds, 0u);
        __syncthreads();
#pragma unroll 1
        for (int qq = 0; qq < 4; ++qq) { const int q = wave * 4 + qq; const unsigned n = (unsigned)(t0 + q + 1); unsigned klo = 196608u / n; klo = klo > 256u ? 256u : (klo < 1u ? 1u : klo);
            unsigned bs, ab, bmx, ab2; const bool ok1 = d1_find((LAS unsigned*)(lds + q * D1_QS), klo, lane, bs, ab), ok2 = d1_find((LAS unsigned*)(lds + q * D1_QS), 1u, lane, bmx, ab2);
            if (lane == 0) { const unsigned klo_key = bs << 21, khi_key = (bmx + 1u) << 21;
                const float lo = __uint_as_float((klo_key & 0x80000000u) ? (klo_key & 0x7FFFFFFFu) : ~klo_key), hi2 = __uint_as_float((khi_key & 0x80000000u) ? (khi_key & 0x7FFFFFFFu) : ~khi_key);
                const float span = (hi2 - lo) * 1.5f; const bool good = ok1 && ok2 && bmx < 2046u && span > 0.f && span < 3.0e38f;
                sm[q] = __float_as_uint(lo); sm[32 + q] = __float_as_uint(good ? 2047.f / span : 0.f); if (!good) sm[224] = 1u; } }
        __syncthreads();
        for (int w = tid; w < D1_SM / 4; w += 512) ((LAS unsigned*)lds)[w] = 0u;
        const float f_lo = __uint_as_float(sm[r32]), f_inv = __uint_as_float(sm[32 + r32]);
        __syncthreads();
        d1_scan<4, EXP>(ikb, qt, qt, wave, lane, qb, wv, lds, 0u, f_lo, f_inv);
        __syncthreads();
#pragma unroll 1
        for (int qq = 0; qq < 4; ++qq) { const int q = wave * 4 + qq; unsigned bin, ab; const bool ok = d1_find((LAS unsigned*)(lds + q * D1_QS), 256u, lane, bin, ab);
            if (lane == 0) { sm[64 + q] = bin; sm[96 + q] = 256u - ab; if (!ok || bin == 2047u) sm[224] = 1u; } }
        __syncthreads();
        for (int w = tid; w < D1_SM / 4; w += 512) ((LAS unsigned*)lds)[w] = 0u;
#ifndef D1_FORCE_FB
#define D1_FORCE_FB 0
#endif
        const unsigned f_bs = sm[64 + r32]; bool fast_ok = (sm[224] == 0u) && !D1_FORCE_FB;
        __syncthreads();
        if (fast_ok) {
            d1_scan<5, EXP>(ikb, qt, qt, wave, lane, qb, wv, lds, 0u, f_lo, f_inv, f_bs);
            __syncthreads();
            if (tid < 32 && sm[160 + tid] > 256u) sm[224] = 1u;
            __syncthreads();
            fast_ok = (sm[224] == 0u);
            __syncthreads();
        }
        if (!fast_ok) {
        for (int w = tid; w < (D1_SM + 1024) / 4; w += 512) ((LAS unsigned*)lds)[w] = 0u;
        __syncthreads();
        d1_scan<1, EXP>(ikb, qt, qt, wave, lane, qb, wv, lds, 0u);
        __syncthreads();
#pragma unroll 1
        for (int qq = 0; qq < 4; ++qq) { const int q = wave * 4 + qq; unsigned bin, ab; d1_find((LAS unsigned*)(lds + q * D1_QS), 256u, lane, bin, ab); if (lane == 0) { sm[q] = bin; sm[32 + q] = ab; } }
        __syncthreads();
        for (int w = tid; w < D1_SM / 4; w += 512) ((LAS unsigned*)lds)[w] = 0u;
        const unsigned b1 = sm[r32];
        __syncthreads();
        d1_scan<2, EXP>(ikb, qt, qt, wave, lane, qb, wv, lds, b1);
        __syncthreads();
#pragma unroll 1
        for (int qq = 0; qq < 4; ++qq) { const int q = wave * 4 + qq; const unsigned need2 = 256u - sm[32 + q]; unsigned bin, ab; d1_find((LAS unsigned*)(lds + q * D1_QS), need2, lane, bin, ab);
            if (lane == 0) { sm[64 + q] = (sm[q] << 11) | bin; sm[96 + q] = need2 - ab; } }
        __syncthreads();
        for (int w = tid; w < D1_SM / 4; w += 512) ((LAS unsigned*)lds)[w] = 0u;
        const unsigned T22 = sm[64 + r32];
        __syncthreads();
        d1_scan<3, EXP>(ikb, qt, qt, wave, lane, qb, wv, lds, T22);
        __syncthreads();
        }
#pragma unroll 1
        for (int qq = 0; qq < 4; ++qq) { const int q = wave * 4 + qq;
            const unsigned cc = sm[160 + q] < 256u ? sm[160 + q] : 256u, need3 = sm[96 + q];
            LAS unsigned* cand = (LAS unsigned*)(lds + q * D1_QS); LAS unsigned short* cidx = (LAS unsigned short*)(cand + 256); LAS unsigned* bm = cand + 512; LAS unsigned* tb = cand + 768;
            unsigned tw[4]; int cz = 0;
#pragma unroll
            for (int w = 0; w < 4; ++w) { tw[w] = tb[lane * 4 + w]; cz += __popc(tw[w]); }
            int incz = cz;
#pragma unroll
            for (int o = 1; o < 64; o <<= 1) { const int v = __shfl_up(incz, o); if (lane >= o) incz += v; }
            const int cztot = __shfl(incz, 63);
            int npos = 0;
            for (unsigned ci = lane; ci < ((cc + 63u) & ~63u); ci += 64) { const bool act = ci < cc; const unsigned mine = act ? cand[ci] : 0u; const unsigned mi = act ? (unsigned)cidx[ci] : 0u;
                npos += __popcll(__ballot(act && mine > 0x80000000u));
                unsigned rank = (mine < 0x80000000u) ? (unsigned)cztot : 0u;
                for (unsigned j = 0; j < cc; ++j) { const unsigned kj = cand[j]; const unsigned ij = (unsigned)cidx[j]; rank += (kj > mine || (kj == mine && ij < mi)) ? 1u : 0u; }
                if (act && rank < need3) (void)__hip_atomic_fetch_or(bm + (mi >> 5), 1u << (mi & 31u), __ATOMIC_RELAXED, __HIP_MEMORY_SCOPE_WORKGROUP); }
            { int need_z = (int)need3 - npos; need_z = need_z < 0 ? 0 : (need_z > cztot ? cztot : need_z);
              if (need_z > 0) { int pre = incz - cz;
#pragma unroll
                for (int w = 0; w < 4; ++w) { unsigned bits = tw[w]; const int pc = __popc(bits); int k = need_z - pre; k = k < 0 ? 0 : (k > pc ? pc : k);
                    unsigned keep = 0u; for (int x = 0; x < k; ++x) { const unsigned low = bits & (0u - bits); keep |= low; bits ^= low; }
                    if (keep) (void)__hip_atomic_fetch_or(bm + lane * 4 + w, keep, __ATOMIC_RELAXED, __HIP_MEMORY_SCOPE_WORKGROUP);
                    pre += pc; } } }
            asm volatile("s_waitcnt lgkmcnt(0)" ::: "memory");
            unsigned wds[4]; int c = 0;
#pragma unroll
            for (int w = 0; w < 4; ++w) { wds[w] = bm[lane * 4 + w]; c += __popc(wds[w]); }
            int inc = c;
#pragma unroll
            for (int o = 1; o < 64; o <<= 1) { const int v = __shfl_up(inc, o); if (lane >= o) inc += v; }
            const int total = __shfl(inc, 63); int off = inc - c;
            int* op = sel + (size_t)(tok0 + q) * TOPK;
            if (EXP != 7)
#pragma unroll
            for (int w = 0; w < 4; ++w) { unsigned bits = wds[w]; const int kb = lane * 128 + w * 32;
                while (bits) { const int k = __ffs((int)bits) - 1; if (off < TOPK) op[off] = kb + k; ++off; bits &= bits - 1u; } }
            for (int j = total + lane; j < TOPK; j += 64) op[j] = t0 + q;
        }
        __syncthreads();
    }
}

constexpr int CW_DQ = 16384 + 1024;
__device__ __forceinline__ void phase_dsa_attn(KP P, int L, LAS unsigned char* lds) {
    int tz = threadIdx.x; asm volatile("" : "+v"(tz)); const int tid = tz, lane = tid & 63, wave = tid >> 6;
    const bf16* qkvi = (const bf16*)(P->ws + WS_QKVI); const int* sel = (const int*)(P->ws + WS_SEL); bf16* attn = (bf16*)(P->ws + WS_ATTN);
    unsigned* qh = (unsigned*)(P->ws + WS_CTL) + CW_DQ + L * 8 * 64;
    LAS unsigned* idxs = (LAS unsigned*)(lds + wave * 8192);
    LAS float* pl = (LAS float*)(lds + wave * 8192 + 1024);
    LAS int* wq = (LAS int*)(lds + 65536 + wave * 16);
    const int r = lane & 3, ts_l = (lane & 15) >> 2, kq = lane >> 4, c16 = lane & 15;
    const unsigned myq = xb_xcc_id() & 7u;
    constexpr float CC = 0.08838834764831845f * 1.4426950408889634f;
    for (int qi = 0; qi < 8; ++qi) {
        const int qx = (int)((myq + (unsigned)qi) & 7u), b = qx >> 1, g = qx & 1;
        for (;;) {
            int item = 0;
            if (lane == 0) item = (int)__hip_atomic_fetch_add(qh + qx * 64, 1u, __ATOMIC_RELAXED, __HIP_MEMORY_SCOPE_AGENT);
            item = __builtin_amdgcn_readfirstlane(item);
            if (item >= SEQ) break;
            const int t = SEQ - 1 - item, tok = b * SEQ + t, cnt = (t + 1 < TOPK) ? (t + 1) : TOPK;
#pragma unroll
            for (int i = 0; i < 4; ++i) { const int j = lane + 64 * i; int sidx = 0; if (j < cnt) sidx = (t < TOPK) ? j : sel[(size_t)tok * TOPK + j]; idxs[j] = (unsigned)sidx; }
            asm volatile("s_waitcnt lgkmcnt(0)" ::: "memory");
            bf16x8 qm[4][4];
            { const bf16* qp = qkvi + (size_t)tok * QLD + (g * 4 + r) * HEAD_DIM + 8 * kq;
#pragma unroll
              for (int ks = 0; ks < 4; ++ks) { const bf16x8 v = *(const bf16x8*)(qp + 32 * ks);
#pragma unroll
                  for (int ts = 0; ts < 4; ++ts) qm[ts][ks] = (ts_l == ts) ? v : (bf16x8){0, 0, 0, 0, 0, 0, 0, 0}; } }
            f32x4 C[4];
            const bf16* kbase = qkvi + (size_t)b * SEQ * QLD + COL_K + g * HEAD_DIM + 8 * kq;
#pragma unroll
            for (int c = 0; c < 4; ++c) {
                C[c] = (f32x4){0.f, 0.f, 0.f, 0.f};
                bf16x8 a[4][4];
#pragma unroll
                for (int ts = 0; ts < 4; ++ts) { const unsigned sk = idxs[(4 * c + ts) * 16 + c16]; const bf16* kp = kbase + (size_t)sk * QLD;
#pragma unroll
                    for (int ks = 0; ks < 4; ++ks) a[ts][ks] = *(const bf16x8*)(kp + 32 * ks); }
#pragma unroll
                for (int ts = 0; ts < 4; ++ts)
#pragma unroll
                    for (int ks = 0; ks < 4; ++ks) C[c] = __builtin_amdgcn_mfma_f32_16x16x32_bf16(a[ts][ks], qm[ts][ks], C[c], 0, 0, 0);
            }
            const float bias2 = __builtin_amdgcn_exp2f(-(float)(g * 4 + r + 1)) * 1.4426950408889634f;
            float x[16]; float m = -INFINITY;
#pragma unroll
            for (int c = 0; c < 4; ++c) { const int k0 = (4 * c + ts_l) * 16 + 4 * kq; const u32x4 sp = *(const LAS u32x4*)(idxs + k0);
#pragma unroll
                for (int j = 0; j < 4; ++j) { const float v = (k0 + j < cnt) ? fmaf(C[c][j], CC, bias2 * (float)((int)sp[j] - t)) : -INFINITY; x[c * 4 + j] = v; m = fmaxf(m, v); } }
            m = fmaxf(m, __shfl_xor(m, 4)); m = fmaxf(m, __shfl_xor(m, 8)); m = fmaxf(m, __shfl_xor(m, 16)); m = fmaxf(m, __shfl_xor(m, 32));
            float sum = 0.f;
#pragma unroll
            for (int i = 0; i < 16; ++i) { x[i] = __builtin_amdgcn_exp2f(x[i] - m); sum += x[i]; }
            sum += __shfl_xor(sum, 4); sum += __shfl_xor(sum, 8); sum += __shfl_xor(sum, 16); sum += __shfl_xor(sum, 32);
            const float inv = 1.f / sum;
#pragma unroll
            for (int c = 0; c < 4; ++c) { const int k0 = (4 * c + ts_l) * 16 + 4 * kq;
#pragma unroll
                for (int j = 0; j < 4; ++j) pl[(k0 + j) * 4 + r] = x[c * 4 + j] * inv; }
            asm volatile("s_waitcnt lgkmcnt(0)" ::: "memory");
            float acc[4][8];
#pragma unroll
            for (int rr = 0; rr < 4; ++rr)
#pragma unroll
                for (int i = 0; i < 8; ++i) acc[rr][i] = 0.f;
            const bf16* vbase = qkvi + (size_t)b * SEQ * QLD + COL_V + g * HEAD_DIM + 8 * c16;
            const int nk4 = (cnt + 3) >> 2;
#pragma unroll 4
            for (int j4 = 0; j4 < nk4; ++j4) {
                const int key = 4 * j4 + kq; const unsigned sk = idxs[key];
                const u32x4 vv = *(const u32x4*)(vbase + (size_t)sk * QLD);
                const f32x4 pp = *(const LAS f32x4*)(pl + key * 4);
                const float vf[8] = {bflo(vv.x), bfhi(vv.x), bflo(vv.y), bfhi(vv.y), bflo(vv.z), bfhi(vv.z), bflo(vv.w), bfhi(vv.w)};
#pragma unroll
                for (int rr = 0; rr < 4; ++rr)
#pragma unroll
                    for (int i = 0; i < 8; ++i) acc[rr][i] = fmaf(pp[rr], vf[i], acc[rr][i]);
            }
#pragma unroll
            for (int rr = 0; rr < 4; ++rr)
#pragma unroll
                for (int i = 0; i < 8; ++i) { float v = acc[rr][i]; v += __shfl_xor(v, 16); v += __shfl_xor(v, 32); acc[rr][i] = v; }
            if (kq == 0) {
#pragma unroll
                for (int rr = 0; rr < 4; ++rr) { u32x4 o; o.x = cvt_pk_bf16(acc[rr][0], acc[rr][1]); o.y = cvt_pk_bf16(acc[rr][2], acc[rr][3]); o.z = cvt_pk_bf16(acc[rr][4], acc[rr][5]); o.w = cvt_pk_bf16(acc[rr][6], acc[rr][7]);
                    *(u32x4*)(attn + (size_t)tok * D_MODEL + (g * 4 + rr) * HEAD_DIM + 8 * c16) = o; }
            }
        }
    }
    (void)wq;
}


__device__ __forceinline__ int d2_swz(int i) { return ((i & 3) << 2) | ((i >> 2) & 3); }
__device__ __forceinline__ void phase_dsa_attn2(KP P, int L, LAS unsigned char* lds) {
    typedef short s16x4 __attribute__((ext_vector_type(4)));
    int tz = threadIdx.x; asm volatile("" : "+v"(tz)); const int tid = tz, lane = tid & 63, wave = __builtin_amdgcn_readfirstlane(tid >> 6);
    const bf16* qkvi = (const bf16*)(P->ws + WS_QKVI); const int* sel = (const int*)(P->ws + WS_SEL); bf16* attn = (bf16*)(P->ws + WS_ATTN);
    unsigned* qh = (unsigned*)(P->ws + WS_CTL) + CW_DQ + L * 8 * 64;
    LAS unsigned char* wl = lds + wave * 19456;
    LAS unsigned* idxs = (LAS unsigned*)wl;
    LAS unsigned char* pb = wl + 1024;
    LAS unsigned char* ring = wl + 3072;
    const int n16 = lane & 15, r = lane & 3, ts_l = n16 >> 2, kq = lane >> 4;
    const unsigned myq = xb_xcc_id() & 7u;
    constexpr float CC = 0.08838834764831845f * 1.4426950408889634f;
    unsigned dch[4];
#pragma unroll
    for (int j = 0; j < 4; ++j) dch[j] = (unsigned)((n16 ^ d2_swz(4 * j + kq)) * 16);
    unsigned aoff[4];
#pragma unroll
    for (int ks = 0; ks < 4; ++ks) aoff[ks] = (unsigned)(n16 * 256 + (((4 * ks + kq) ^ d2_swz(n16)) * 16));
    for (int qi = 0; qi < 8; ++qi) {
        const int qx = (int)((myq + (unsigned)qi) & 7u), b = qx >> 1, g = qx & 1;
        const char* kgb = (const char*)(qkvi + (size_t)b * SEQ * QLD + COL_K + g * HEAD_DIM);
        int item = 0;
        if (lane == 0) item = (int)__hip_atomic_fetch_add(qh + qx * 64, 1u, __ATOMIC_RELAXED, __HIP_MEMORY_SCOPE_AGENT);
        item = __builtin_amdgcn_readfirstlane(item);
        bool have_pf = false; int sx[4] = {0, 0, 0, 0}; bf16x8 qv[4] = {};
        while (item < SEQ) {
            const int t = SEQ - 1 - item, tok = b * SEQ + t, cnt = (t + 1 < TOPK) ? (t + 1) : TOPK;
            if (!have_pf) {
#pragma unroll
                for (int i = 0; i < 4; ++i) { const int j = lane + 64 * i; sx[i] = (t < TOPK) ? j : sel[(size_t)tok * TOPK + j]; }
                const bf16* qp = qkvi + (size_t)tok * QLD + (g * 4 + r) * HEAD_DIM + 8 * kq;
#pragma unroll
                for (int ks = 0; ks < 4; ++ks) qv[ks] = *(const bf16x8*)(qp + 32 * ks);
            }
#pragma unroll
            for (int i = 0; i < 4; ++i) { const int j = lane + 64 * i; idxs[j] = (j < cnt) ? (unsigned)sx[i] : 0u; }
            bf16x8 qm[4][4];
#pragma unroll
            for (int ks = 0; ks < 4; ++ks) {
#pragma unroll
                for (int ts = 0; ts < 4; ++ts) qm[ts][ks] = (ts_l == ts) ? qv[ks] : (bf16x8){0, 0, 0, 0, 0, 0, 0, 0}; }
            asm volatile("s_waitcnt vmcnt(0) lgkmcnt(0)" ::: "memory");
#define D2_ISSUE(s) do { const int kb_ = (s) & 15; const char* gb_ = kgb + ((s) >= 16 ? (COL_V - COL_K) * 2 : 0); LAS unsigned char* sl_ = ring + ((s) & 3) * 4096; \
        _Pragma("unroll") for (int j = 0; j < 4; ++j) { const unsigned sk_ = idxs[kb_ * 16 + 4 * j + kq]; \
            __builtin_amdgcn_global_load_lds((const unsigned*)(gb_ + (size_t)sk_ * (QLD * 2) + dch[j]), (LAS unsigned*)(sl_ + j * 1024), 16, 0, 0); } } while (0)
            int nraw = 0;
            if (lane == 0) nraw = (int)__hip_atomic_fetch_add(qh + qx * 64, 1u, __ATOMIC_RELAXED, __HIP_MEMORY_SCOPE_AGENT);
            D2_ISSUE(0); D2_ISSUE(1); D2_ISSUE(2); D2_ISSUE(3);
            f32x4 C[4];
#pragma unroll
            for (int c = 0; c < 4; ++c) C[c] = (f32x4){0.f, 0.f, 0.f, 0.f};
#pragma unroll
            for (int s2 = 0; s2 < 16; ++s2) {
                asm volatile("s_waitcnt vmcnt(12)" ::: "memory");
                LAS unsigned char* sl = ring + (s2 & 3) * 4096;
                bf16x8 a[4];
#pragma unroll
                for (int ks = 0; ks < 4; ++ks) a[ks] = *(const LAS bf16x8*)(sl + aoff[ks]);
#pragma unroll
                for (int ks = 0; ks < 4; ++ks) C[s2 >> 2] = __builtin_amdgcn_mfma_f32_16x16x32_bf16(a[ks], qm[s2 & 3][ks], C[s2 >> 2], 0, 0, 0);
                asm volatile("s_waitcnt lgkmcnt(0)" ::: "memory");
                D2_ISSUE(s2 + 4);
            }
            const float bias2 = __builtin_amdgcn_exp2f(-(float)(g * 4 + r + 1)) * 1.4426950408889634f;
            float x[16]; float m = -INFINITY;
#pragma unroll
            for (int c = 0; c < 4; ++c) { const int k0 = (4 * c + ts_l) * 16 + 4 * kq; const u32x4 sp = *(const LAS u32x4*)(idxs + k0);
#pragma unroll
                for (int j = 0; j < 4; ++j) { const float v = (k0 + j < cnt) ? fmaf(C[c][j], CC, bias2 * (float)((int)sp[j] - t)) : -INFINITY; x[c * 4 + j] = v; m = fmaxf(m, v); } }
            m = fmaxf(m, __shfl_xor(m, 4)); m = fmaxf(m, __shfl_xor(m, 8)); m = fmaxf(m, __shfl_xor(m, 16)); m = fmaxf(m, __shfl_xor(m, 32));
            float sum = 0.f;
#pragma unroll
            for (int i = 0; i < 16; ++i) { x[i] = __builtin_amdgcn_exp2f(x[i] - m); sum += x[i]; }
            sum += __shfl_xor(sum, 4); sum += __shfl_xor(sum, 8); sum += __shfl_xor(sum, 16); sum += __shfl_xor(sum, 32);
            const float inv = 1.f / sum;
#pragma unroll
            for (int c = 0; c < 4; ++c) { const int k0 = (4 * c + ts_l) * 16 + 4 * kq;
                u32x2 w; w.x = cvt_pk_bf16(x[c * 4 + 0] * inv, x[c * 4 + 1] * inv); w.y = cvt_pk_bf16(x[c * 4 + 2] * inv, x[c * 4 + 3] * inv);
                *(LAS u32x2*)(pb + (r * 256 + k0) * 2) = w; }
            asm volatile("s_waitcnt lgkmcnt(0)" ::: "memory");
            f32x4 O[8]; int nitem = SEQ;
#pragma unroll
            for (int db = 0; db < 8; ++db) O[db] = (f32x4){0.f, 0.f, 0.f, 0.f};
            const int q4 = n16 >> 2, p4 = n16 & 3;
#pragma unroll
            for (int u = 0; u < 8; ++u) {
                if (u < 7) asm volatile("s_waitcnt vmcnt(8)" ::: "memory"); else asm volatile("s_waitcnt vmcnt(0)" ::: "memory");
                LAS unsigned char* sl = ring + (((2 * u) & 3) + (kq >> 1)) * 4096;
                const bf16x8 pf = *(const LAS bf16x8*)(pb + (r * 256 + u * 32 + 8 * kq) * 2);
#pragma unroll
                for (int db = 0; db < 8; ++db) {
                    const int i0 = 8 * (kq & 1) + q4, i1 = i0 + 4;
                    const int a0 = (int)(unsigned)(uintptr_t)(sl + i0 * 256 + (((2 * db + (p4 >> 1)) ^ d2_swz(i0)) * 16) + 8 * (p4 & 1));
                    const int a1 = (int)(unsigned)(uintptr_t)(sl + i1 * 256 + (((2 * db + (p4 >> 1)) ^ d2_swz(i1)) * 16) + 8 * (p4 & 1));
                    const s16x4 v0 = mb::tr_read<0>(a0), v1 = mb::tr_read<0>(a1);
                    asm volatile("s_waitcnt lgkmcnt(0)" ::: "memory");
                    const bf16x8 vf = {v0[0], v0[1], v0[2], v0[3], v1[0], v1[1], v1[2], v1[3]};
                    O[db] = __builtin_amdgcn_mfma_f32_16x16x32_bf16(vf, pf, O[db], 0, 0, 0);
                }
                if (u == 0) {
                    nitem = __builtin_amdgcn_readfirstlane(nraw); have_pf = nitem < SEQ;
                    if (have_pf) { const int tn = SEQ - 1 - nitem, tokn = b * SEQ + tn;
#pragma unroll
                        for (int i = 0; i < 4; ++i) { const int j = lane + 64 * i; sx[i] = (tn < TOPK) ? j : sel[(size_t)tokn * TOPK + j]; }
                        const bf16* qpn = qkvi + (size_t)tokn * QLD + (g * 4 + r) * HEAD_DIM + 8 * kq;
#pragma unroll
                        for (int ks = 0; ks < 4; ++ks) qv[ks] = *(const bf16x8*)(qpn + 32 * ks); } }
                if (u < 6) { D2_ISSUE(16 + 2 * u + 4); D2_ISSUE(16 + 2 * u + 5); }
            }
#undef D2_ISSUE
            if (n16 < 4) {
                bf16* op = attn + (size_t)tok * D_MODEL + (g * 4 + n16) * HEAD_DIM + 4 * kq;
#pragma unroll
                for (int db = 0; db < 8; ++db) { u32x2 w; w.x = cvt_pk_bf16(O[db][0], O[db][1]); w.y = cvt_pk_bf16(O[db][2], O[db][3]); *(u32x2*)(op + 16 * db) = w; }
            }
            item = nitem;
        }
    }
}

__device__ __forceinline__ int opq(int x) { asm volatile("" : "+s"(x)); return x; }
__device__ __forceinline__ bool phase_active(int L, int k) {
    if (k >= 2 && k <= 6) { if (L < N_A) return k <= 3; if (k == 2) return L == N_A; }
    return k <= 14;
}
__global__ void __launch_bounds__(512, 2) fwd(Params P) {
    extern __shared__ __attribute__((aligned(16))) unsigned char lds_raw[];
    LAS unsigned char* lds = (LAS unsigned char*)lds_raw;
    const int tid = threadIdx.x;
    unsigned char* ws0 = P.ws;
    if (tid < 16) ((LAS unsigned*)(lds + LDS_MISC))[tid] = 0u;
    __syncthreads();
    const int lo = P.ph_lo, hi = P.ph_hi;
    const bool multi = (hi - lo) > 1;
    unsigned* barw = (unsigned*)(ws0 + WS_CTL) + CW_BAR + P.bar_idx * XCD_BAR_WORDS;
    XcdBarrier bar; bar.bar = barw; bar.x = 0; bar.st = nullptr;
    if (multi) bar = xcd_barrier_post(barw, (volatile LAS unsigned*)(lds + LDS_MISC));
#ifndef PHASE_MASK
#define PHASE_MASK 0xFFFF
#endif
#define IN(k) (((PHASE_MASK >> (k)) & 1) && opq(lo) <= (pb + (k)) && (pb + (k)) < hi && phase_active(L, (k)))
#define SEAM(k) do { if (IN(k) && (pb + (k) + 1) < hi) xcd_barrier(bar); } while (0)
#ifndef PROBE_MASK
#define PROBE_MASK 0
#endif
#define PROBED(k) (((PROBE_MASK) >> (k)) & 1)
    const int G = gridDim.x, c = blockIdx.x;
    for (int L = 0; L < DEPTH; ++L) {
        const int pb = L * 16;
        if (pb + 16 <= lo || pb >= hi) continue;
        const bool isA = L < N_A;
        if (IN(0)) { for (int rep = PROBED(0) ? 0 : 1; rep < 2; ++rep) { phase_convert(fresh_params(), L, lds); if (rep == 0) xcd_barrier(bar); } } SEAM(0);
        if (IN(1)) { for (int rep = PROBED(1) ? 0 : 1; rep < 2; ++rep) {
            KP Q = fresh_params(); unsigned char* ws = Q->ws; bf16* hb = (bf16*)(ws + WS_HB);
            if (isA) {
                gm::DenseOrder S; S.init(hb, ws + WS_WMIX, NTOK, 2048, D_MODEL, G, c);
                gm::EpiBf16 E{(bf16*)(ws + WS_QKVI), QLD, (float*)(ws + WS_IW)};
                gm::gemm_phase<gm::EpiBf16, gm::DenseOrder, false>(lds, D_MODEL, S, E);
            } else {
                if (L == N_A) {
                    gm::DenseOrder S; S.init(hb, ws + WS_WMIX + 6 * MiB, NTOK, 512, D_MODEL, G, c);
                    gm::EpiBf16 E{(bf16*)(ws + WS_KV), 512, nullptr};
                    gm::gemm_phase<gm::EpiBf16, gm::DenseOrder, false>(lds, D_MODEL, S, E);
                }
                gm::DenseOrder S; S.init(hb, ws + WS_WMIX, NTOK, D_MODEL, D_MODEL, G, c);
                gm::EpiBf16 E{(bf16*)(ws + WS_QKVI), D_MODEL, nullptr};
                gm::gemm_phase<gm::EpiBf16, gm::DenseOrder, false>(lds, D_MODEL, S, E);
            }
            if (rep == 0) xcd_barrier(bar);
        } } SEAM(1);
        if (IN(2)) { if (isA) { if (PROBED(2)) { phase_dsa_topk<D1_EXP>(fresh_params(), lds, WS_PL); xcd_barrier(bar); } phase_dsa_topk<0>(fresh_params(), lds, WS_SEL); } else phase_kmeans(fresh_params()); } SEAM(2);
        if (IN(3)) { if (isA) { for (int rep = PROBED(3) ? 0 : 1; rep < 2; ++rep) { phase_dsa_attn2(fresh_params(), rep == 0 ? L + 2 : L, lds); if (rep == 0) xcd_barrier(bar); } } else { for (int rep = PROBED(4) ? 0 : 1; rep < 2; ++rep) { phase_moba_gate2(fresh_params()); if (rep == 0) xcd_barrier(bar); } } } SEAM(3);
        if (IN(4)) { phase_moba_lists(fresh_params(), lds); } SEAM(4);
        if (IN(5)) { for (int rep = PROBED(5) ? 0 : 1; rep < 2; ++rep) { phase_moba_attn2(fresh_params(), (L - N_A) * 2 + rep, lds); if (rep == 0) xcd_barrier(bar); } } SEAM(5);
        if (IN(6)) { for (int rep = PROBED(6) ? 0 : 1; rep < 2; ++rep) { phase_moba_combine(fresh_params()); if (rep == 0) xcd_barrier(bar); } } SEAM(6);
        if (IN(7)) { for (int rep = PROBED(7) ? 0 : 1; rep < 2; ++rep) {
            KP Q = fresh_params(); unsigned char* ws = Q->ws; const float* hres = (L == 0) ? Q->in[0] : (const float*)(ws + WS_H); float* t = (float*)(ws + WS_T);
            { gm::DenseOrder S; S.init(ws + WS_ATTN, ws + WS_WMIX + 4 * MiB, NTOK, D_MODEL, D_MODEL, G, c);
              gm::EpiResid E{hres, t};
              gm::gemm_phase<gm::EpiResid, gm::DenseOrder, false>(lds, D_MODEL, S, E); }
            { gm::DenseOrder S; S.init(ws + WS_PB, ws + WS_WPLE, NTOK, D_MODEL, PLE_DIM, G, c);
              gm::EpiBf16 E{(bf16*)(ws + WS_PL), D_MODEL, nullptr};
              gm::gemm_phase<gm::EpiBf16, gm::DenseOrder, false>(lds, PLE_DIM, S, E); }
            if (rep == 0) xcd_barrier(bar);
        } } SEAM(7);
        if (IN(8)) { for (int rep = PROBED(8) ? 0 : 1; rep < 2; ++rep) { phase_ln_router(fresh_params(), L, lds, rep == 0 ? L + 4 : L); if (rep == 0) xcd_barrier(bar); } } SEAM(8);
        if (IN(9)) { phase_moe_prep(fresh_params(), L, lds); } SEAM(9);
        if (IN(10)) { for (int rep = PROBED(10) ? 0 : 1; rep < 2; ++rep) {
            KP Q = fresh_params(); unsigned char* ws = Q->ws; bf16* hb = (bf16*)(ws + WS_HB);
            const int* moe = (const int*)(ws + WS_MOE);
            gm::MoeOrder S; S.tile_e = moe + MO_TILE_E; S.tile_row0 = moe + MO_TILE_ROW0; S.tile_nv = moe + MO_TILE_NV; S.slot_tok = moe + MO_SLOT_TOK;
            S.n_units = (int)*((const unsigned*)(ws + WS_CTL) + CW_NTILES + L) * 4; S.G = G; S.c = c; S.K = D_MODEL; S.A = (const char*)hb; S.W = (const char*)(ws + WS_WGU);
            S.wstride = (size_t)D_MODEL * D_MODEL * 2; S.tB = (size_t)256 * D_MODEL * 2; S.gath = true;
            gm::EpiSwiglu E{(bf16*)(ws + WS_ACT)};
            gm::gemm_phase<gm::EpiSwiglu, gm::MoeOrder, true>(lds, D_MODEL, S, E);
            if (rep == 0) xcd_barrier(bar);
        } } SEAM(10);
        if (IN(11)) { for (int rep = PROBED(11) ? 0 : 1; rep < 2; ++rep) {
            KP Q = fresh_params(); unsigned char* ws = Q->ws;
            const int* moe = (const int*)(ws + WS_MOE);
            gm::MoeOrder S; S.tile_e = moe + MO_TILE_E; S.tile_row0 = moe + MO_TILE_ROW0; S.tile_nv = moe + MO_TILE_NV; S.slot_tok = moe + MO_SLOT_TOK;
            S.n_units = (int)*((const unsigned*)(ws + WS_CTL) + CW_NTILES + L) * 4; S.G = G; S.c = c; S.K = D_EXPERT; S.A = (const char*)(ws + WS_ACT); S.W = (const char*)(ws + WS_WD);
            S.wstride = (size_t)D_MODEL * D_EXPERT * 2; S.tB = (size_t)256 * D_EXPERT * 2; S.gath = false;
            gm::EpiMoeDown E{(bf16*)(ws + WS_Y)};
            gm::gemm_phase<gm::EpiMoeDown, gm::MoeOrder, false>(lds, D_EXPERT, S, E);
            if (rep == 0) xcd_barrier(bar);
        } } SEAM(11);
        if (IN(12)) { KP Q = fresh_params(); phase_ln<1, false>(Q, L, 1, lds, (float*)(Q->ws + WS_H), true); } SEAM(12);
        if (IN(13)) { for (int rep = PROBED(13) ? 0 : 1; rep < 2; ++rep) {
            KP Q = fresh_params(); unsigned char* ws = Q->ws; bf16* hb = (bf16*)(ws + WS_HB); float* h = (float*)(ws + WS_H); float* t = (float*)(ws + WS_T);
            gm::DenseOrder S; S.init(hb, ws + WS_WPG, NTOK, D_MODEL, D_MODEL, G, c);
            gm::EpiPle E{h, (const bf16*)(ws + WS_PL), t};
            gm::gemm_phase<gm::EpiPle, gm::DenseOrder, false>(lds, D_MODEL, S, E);
            if (rep == 0) xcd_barrier(bar);
        } } SEAM(13);
        if (IN(14)) { for (int rep = PROBED(14) ? 0 : 1; rep < 2; ++rep) { KP Q = fresh_params(); phase_ln<0, false>(Q, L, 2, lds, (L == DEPTH - 1) ? Q->out : (float*)(Q->ws + WS_H), L != DEPTH - 1); if (rep == 0) xcd_barrier(bar); } }
        if (L != DEPTH - 1) SEAM(14);
    }
#undef IN
#undef SEAM
}

#ifndef DEBUG_ATTN
#define DEBUG_ATTN 0
#endif
#if DEBUG_ATTN
__global__ void __launch_bounds__(256) dsa_scores(const bf16* __restrict__ qkvi  , const float* __restrict__ iw  , float* __restrict__ sc) {
    const int s0 = blockIdx.x * 64, t0 = blockIdx.y * 64;
    if (s0 > t0) return;
    __shared__ float Qs[64][68];
    __shared__ float Ks[64][68];
    const int tid = threadIdx.x, r = tid >> 2, kq = (tid & 3) * 16;
    {
        const bf16* kp = qkvi + (size_t)(s0 + r) * QLD + COL_IK + kq;
#pragma unroll
        for (int i = 0; i < 16; ++i) Ks[kq + i][r] = bf2f(kp[i]);
    }
    const int ty = tid >> 4, tx = tid & 15;
    float tot[4][4];
#pragma unroll
    for (int i = 0; i < 4; ++i)
#pragma unroll
        for (int j = 0; j < 4; ++j) tot[i][j] = 0.f;
    for (int hh = 0; hh < IDX_HEADS; ++hh) {
        __syncthreads();
        const bf16* qp = qkvi + (size_t)(t0 + r) * QLD + COL_IQ + hh * IDX_DIM + kq;
#pragma unroll
        for (int i = 0; i < 16; ++i) Qs[kq + i][r] = bf2f(qp[i]);
        __syncthreads();
        float acc[4][4];
#pragma unroll
        for (int i = 0; i < 4; ++i)
#pragma unroll
            for (int j = 0; j < 4; ++j) acc[i][j] = 0.f;
#pragma unroll 8
        for (int k = 0; k < 64; ++k) {
            const float4 a4 = *(const float4*)&Qs[k][ty * 4];
            const float4 b4 = *(const float4*)&Ks[k][tx * 4];
            const float a[4] = {a4.x, a4.y, a4.z, a4.w};
            const float b[4] = {b4.x, b4.y, b4.z, b4.w};
#pragma unroll
            for (int i = 0; i < 4; ++i)
#pragma unroll
                for (int j = 0; j < 4; ++j) acc[i][j] += a[i] * b[j];
        }
#pragma unroll
        for (int i = 0; i < 4; ++i) {
            const float w = iw[(size_t)(t0 + ty * 4 + i) * 4 + hh];
#pragma unroll
            for (int j = 0; j < 4; ++j) tot[i][j] += w * fmaxf(acc[i][j], 0.f);
        }
    }
#pragma unroll
    for (int i = 0; i < 4; ++i)
        *(float4*)(sc + (size_t)(t0 + ty * 4 + i) * SEQ + s0 + tx * 4) = make_float4(tot[i][0], tot[i][1], tot[i][2], tot[i][3]);
}

__device__ __forceinline__ unsigned fkey(float f) { const unsigned u = __float_as_uint(f); return (u & 0x80000000u) ? ~u : (u | 0x80000000u); }
__global__ void __launch_bounds__(256) dsa_topk(const float* __restrict__ sc, int* __restrict__ sel) {
    const int t = blockIdx.x, tid = threadIdx.x, n = t + 1;
    int* out = sel + (size_t)t * TOPK;
    if (n <= TOPK) { out[tid] = tid <= t ? tid : 0; return; }
    const float* row = sc + (size_t)t * SEQ;
    __shared__ unsigned hist[256];
    __shared__ unsigned s_prefix, s_need;
    __shared__ int wsum[2][4];
    unsigned prefix = 0, need = TOPK;
    for (int pass = 3; pass >= 0; --pass) {
        hist[tid] = 0;
        __syncthreads();
        for (int i = tid; i < n; i += 256) {
            const unsigned k = fkey(row[i]);
            const bool match = (pass == 3) ? true : ((k >> (8 * (pass + 1))) == prefix);
            if (match) atomicAdd(&hist[(k >> (8 * pass)) & 255u], 1u);
        }
        __syncthreads();
        if (tid == 0) {
            unsigned c = 0; int d = 255;
            for (; d > 0; --d) { if (c + hist[d] >= need) break; c += hist[d]; }
            s_prefix = (prefix << 8) | (unsigned)d; s_need = need - c;
        }
        __syncthreads();
        prefix = s_prefix; need = s_need;
        __syncthreads();
    }
    const unsigned T = prefix;
    const int n_gt = TOPK - (int)need;
    int run_gt = 0, run_eq = 0;
    const int lane = tid & 63, w = tid >> 6;
    for (int base = 0; base < n; base += 256) {
        const int i = base + tid;
        unsigned k = 0; bool gt = false, eq = false;
        if (i < n) { k = fkey(row[i]); gt = k > T; eq = k == T; }
        const unsigned long long mg = __ballot(gt), me = __ballot(eq);
        const unsigned long long lower = (lane == 0) ? 0ull : (~0ull >> (64 - lane));
        const int pg = __popcll(mg & lower), pe = __popcll(me & lower);
        if (lane == 0) { wsum[0][w] = __popcll(mg); wsum[1][w] = __popcll(me); }
        __syncthreads();
        int og = 0, oe = 0, tg = 0, te = 0;
        for (int x = 0; x < 4; ++x) { if (x < w) { og += wsum[0][x]; oe += wsum[1][x]; } tg += wsum[0][x]; te += wsum[1][x]; }
        if (gt) out[run_gt + og + pg] = i;
        if (eq) { const int rk = run_eq + oe + pe; if (rk < (int)need) out[n_gt + rk] = i; }
        run_gt += tg; run_eq += te;
        __syncthreads();
    }
}

__global__ void __launch_bounds__(256) dsa_attn(const bf16* __restrict__ qkvi, const int* __restrict__ sel, bf16* __restrict__ attn) {
    const int tok = blockIdx.x, b = tok / SEQ, t = tok % SEQ, tid = threadIdx.x;
    __shared__ float qs[D_MODEL];
    __shared__ float lg[N_HEADS][TOPK];
    __shared__ int sidx[TOPK];
    const int cnt = (t + 1 < TOPK) ? (t + 1) : TOPK;
    const bf16* prow = qkvi + (size_t)tok * QLD;
#pragma unroll
    for (int i = 0; i < 4; ++i) qs[tid * 4 + i] = bf2f(prow[tid * 4 + i]);
    int s = 0;
    if (tid < cnt) s = (t < TOPK) ? tid : sel[(size_t)tok * TOPK + tid];
    sidx[tid] = s;
    __syncthreads();
    const float scale = 0.08838834764831845f;
    if (tid < cnt) {
        const bf16* krow = qkvi + (size_t)(b * SEQ + s) * QLD + COL_K;
        for (int g = 0; g < N_KV; ++g) {
            float d[4] = {0.f, 0.f, 0.f, 0.f};
            for (int k = 0; k < HEAD_DIM; ++k) {
                const float kv = bf2f(krow[g * HEAD_DIM + k]);
#pragma unroll
                for (int r = 0; r < 4; ++r) d[r] += qs[(g * 4 + r) * HEAD_DIM + k] * kv;
            }
#pragma unroll
            for (int r = 0; r < 4; ++r) {
                const int hh = g * 4 + r;
                const float slope = exp2f(-(float)(hh + 1));
                lg[hh][tid] = d[r] * scale - slope * (float)(t - s);
            }
        }
    } else {
        for (int hh = 0; hh < N_HEADS; ++hh) lg[hh][tid] = -INFINITY;
    }
    __syncthreads();
    {
        const int lane = tid & 63, w = tid >> 6;
        for (int h2 = 0; h2 < 2; ++h2) {
            const int hh = w * 2 + h2;
            float v[4], m = -INFINITY;
#pragma unroll
            for (int i = 0; i < 4; ++i) { v[i] = lg[hh][lane + 64 * i]; m = fmaxf(m, v[i]); }
            for (int o = 32; o > 0; o >>= 1) m = fmaxf(m, __shfl_xor(m, o));
            float sum = 0.f;
#pragma unroll
            for (int i = 0; i < 4; ++i) { v[i] = expf(v[i] - m); sum += v[i]; }
            for (int o = 32; o > 0; o >>= 1) sum += __shfl_xor(sum, o);
            const float inv = 1.f / sum;
#pragma unroll
            for (int i = 0; i < 4; ++i) lg[hh][lane + 64 * i] = v[i] * inv;
        }
    }
    __syncthreads();
    {
        const int col = tid * 4, hh = col / HEAD_DIM, g = hh / HEAD_GROUP, d = col % HEAD_DIM;
        float acc[4] = {0.f, 0.f, 0.f, 0.f};
        for (int j = 0; j < cnt; ++j) {
            const float p = lg[hh][j];
            const u32x2 vv = *(const u32x2*)(qkvi + (size_t)(b * SEQ + sidx[j]) * QLD + COL_V + g * HEAD_DIM + d);
            acc[0] += p * bflo(vv.x); acc[1] += p * bfhi(vv.x); acc[2] += p * bflo(vv.y); acc[3] += p * bfhi(vv.y);
        }
        u32x2 o; o.x = cvt_pk_bf16(acc[0], acc[1]); o.y = cvt_pk_bf16(acc[2], acc[3]);
        *(u32x2*)(attn + (size_t)tok * D_MODEL + col) = o;
    }
}

__global__ void __launch_bounds__(128) kmeans_kernel(const bf16* __restrict__ kv, float* __restrict__ km) {
    const int blk = blockIdx.x % N_BLOCKS, g = (blockIdx.x / N_BLOCKS) % N_KV, b = blockIdx.x / (N_BLOCKS * N_KV), d = threadIdx.x;
    float s = 0.f;
    for (int i = 0; i < MOBA_BLOCK; ++i) s += bf2f(kv[(size_t)(b * SEQ + blk * MOBA_BLOCK + i) * 512 + g * HEAD_DIM + d]);
    km[((size_t)(b * N_KV + g) * N_BLOCKS + blk) * HEAD_DIM + d] = s * (1.f / MOBA_BLOCK);
}

__global__ void __launch_bounds__(256) moba_attn(const bf16* __restrict__ q, const bf16* __restrict__ kv, const float* __restrict__ km, bf16* __restrict__ attn) {
    const int tok = blockIdx.x, b = tok / SEQ, t = tok % SEQ, tid = threadIdx.x, own = t / MOBA_BLOCK;
    __shared__ float qs[HEAD_DIM];
    __shared__ float gate[N_BLOCKS];
    __shared__ int selb[3];
    __shared__ float lg[4 * MOBA_BLOCK];
    __shared__ float red[8];
    __shared__ float part[2][HEAD_DIM];
    const float scale = 0.08838834764831845f;
    for (int hh = 0; hh < N_HEADS; ++hh) {
        const int g = hh / HEAD_GROUP;
        const float slope = exp2f(-(float)(hh + 1));
        __syncthreads();
        if (tid < HEAD_DIM) qs[tid] = bf2f(q[(size_t)tok * D_MODEL + hh * HEAD_DIM + tid]);
        __syncthreads();
        if (tid < N_BLOCKS) {
            float gval = -INFINITY;
            if (tid < own) {
                const float* kp = km + ((size_t)(b * N_KV + g) * N_BLOCKS + tid) * HEAD_DIM;
                float s = 0.f;
                for (int k = 0; k < HEAD_DIM; ++k) s += qs[k] * kp[k];
                gval = s;
            }
            gate[tid] = gval;
        }
        __syncthreads();
        if (tid == 0) {
            unsigned used = 0u;
            for (int s = 0; s < 3; ++s) {
                int best = -1; float bv = 0.f;
                for (int j = 0; j < N_BLOCKS; ++j) if (!((used >> j) & 1u) && (best < 0 || gate[j] > bv)) { best = j; bv = gate[j]; }
                used |= 1u << best; selb[s] = best;
            }
        }
        __syncthreads();
        for (int s = 0; s < 4; ++s) {
            const int blk = (s < 3) ? selb[s] : own;
            const int kpos = blk * MOBA_BLOCK + tid;
            const bool valid = (s < 3) ? (blk < own) : (kpos <= t);
            float v = -INFINITY;
            if (valid) {
                const bf16* kp = kv + (size_t)(b * SEQ + kpos) * 512 + g * HEAD_DIM;
                float d = 0.f;
                for (int k = 0; k < HEAD_DIM; ++k) d += qs[k] * bf2f(kp[k]);
                v = d * scale - slope * (float)(t - kpos);
            }
            lg[s * MOBA_BLOCK + tid] = v;
        }
        __syncthreads();
        float m = fmaxf(fmaxf(lg[tid], lg[256 + tid]), fmaxf(lg[512 + tid], lg[768 + tid]));
        for (int o = 32; o > 0; o >>= 1) m = fmaxf(m, __shfl_xor(m, o));
        if ((tid & 63) == 0) red[tid >> 6] = m;
        __syncthreads();
        m = fmaxf(fmaxf(red[0], red[1]), fmaxf(red[2], red[3]));
        float e[4], sum = 0.f;
#pragma unroll
        for (int i = 0; i < 4; ++i) { e[i] = expf(lg[i * 256 + tid] - m); sum += e[i]; }
        for (int o = 32; o > 0; o >>= 1) sum += __shfl_xor(sum, o);
        if ((tid & 63) == 0) red[4 + (tid >> 6)] = sum;
        __syncthreads();
        const float inv = 1.f / (red[4] + red[5] + red[6] + red[7]);
#pragma unroll
        for (int i = 0; i < 4; ++i) lg[i * 256 + tid] = e[i] * inv;
        __syncthreads();
        {
            const int d = tid & 127, half = tid >> 7;
            float acc = 0.f;
            for (int s = 0; s < 4; ++s) {
                const int blk = (s < 3) ? selb[s] : own;
                const bool bvalid = (s < 3) ? (blk < own) : true;
                if (!bvalid) continue;
                const bf16* vp = kv + (size_t)(b * SEQ + blk * MOBA_BLOCK + half * 128) * 512 + KV_DIM + g * HEAD_DIM + d;
                const float* pp = lg + s * MOBA_BLOCK + half * 128;
                for (int j = 0; j < 128; ++j) { const float p = pp[j]; if (p != 0.f) acc += p * bf2f(vp[(size_t)j * 512]); }
            }
            part[half][d] = acc;
        }
        __syncthreads();
        if (tid < HEAD_DIM) attn[(size_t)tok * D_MODEL + hh * HEAD_DIM + tid] = (bf16)(cvt_pk_bf16(part[0][tid] + part[1][tid], 0.f) & 0xffffu);
    }
}


#endif
#ifndef DEBUG_ATTN
#define DEBUG_ATTN 0
#endif
#if DEBUG_ATTN
__global__ void dbg_compare(const bf16* __restrict__ a, const bf16* __restrict__ ref, size_t n, float* __restrict__ acc) {
    float d2 = 0.f, r2 = 0.f;
    for (size_t i = (size_t)blockIdx.x * blockDim.x + threadIdx.x; i < n; i += (size_t)gridDim.x * blockDim.x) { const float x = bf2f(a[i]), y = bf2f(ref[i]); d2 += (x - y) * (x - y); r2 += y * y; }
    d2 = wave_sum(d2); r2 = wave_sum(r2);
    if ((threadIdx.x & 63) == 0) { atomicAdd(&acc[0], d2); atomicAdd(&acc[1], r2); }
}
__global__ void dbg_scale(float* __restrict__ out, size_t n, const float* __restrict__ acc) {
    const float rv = acc[0] / fmaxf(acc[1], 1e-30f);
    float e = sqrtf(fminf(rv * 100.f, 4.f)); if (!(rv == rv)) e = 3.f;
    for (size_t i = (size_t)blockIdx.x * blockDim.x + threadIdx.x; i < n; i += (size_t)gridDim.x * blockDim.x) out[i] *= (1.f + e);
}
#endif

extern "C" void kernel_launch(void* const* d_in, const int* in_sizes, int n_in, void* d_out, int out_size, void* d_ws, size_t ws_size, hipStream_t stream) {
    static int grid = 0;
    if (grid == 0) {
        int dev = 0, cus = 0;
        (void)hipGetDevice(&dev); (void)hipDeviceGetAttribute(&cus, hipDeviceAttributeMultiprocessorCount, dev);
        (void)hipFuncSetAttribute((const void*)fwd, hipFuncAttributeMaxDynamicSharedMemorySize, LDS_BYTES);
        grid = cus > 0 ? cus : 256;
    }
    unsigned char* ws = (unsigned char*)d_ws;
    (void)hipMemsetAsync(ws + WS_CTL, 0, CTL_ZERO_BYTES, stream);
    Params P{};
    for (int i = 0; i < 18; ++i) P.in[i] = (const float*)d_in[i];
    P.out = (float*)d_out; P.ws = ws;
    int nlaunch = 0;
    auto run = [&](int lo, int hi) { P.ph_lo = lo; P.ph_hi = hi; P.bar_idx = nlaunch++; hipLaunchKernelGGL(fwd, dim3(grid), dim3(512), LDS_BYTES, stream, P); };
#if DEBUG_ATTN
    const bf16* qkvi = (const bf16*)(ws + WS_QKVI); bf16* attn = (bf16*)(ws + WS_ATTN); int* sel = (int*)(ws + WS_SEL);
    float* scores = (float*)(ws + WS_SCORES); const float* iw = (const float*)(ws + WS_IW); const bf16* kvb = (const bf16*)(ws + WS_KV); float* km = (float*)(ws + WS_KM);
#endif
#if DEBUG_ATTN == 0
    run(0, DEPTH * 16);
#else
    for (int L = 0; L < DEPTH; ++L) {
        const int pb = L * 16;
        if (L < N_A) {
#if DEBUG_ATTN == 4
            if (L == 1) {
                run(pb + 0, pb + 3);
                bf16* attn2 = (bf16*)(ws + WS_PL);
                dsa_attn<<<NTOK, 256, 0, stream>>>(qkvi, sel, attn2);
                run(pb + 3, pb + 4);
                dbg_compare<<<1024, 256, 0, stream>>>(attn, attn2, (size_t)NTOK * D_MODEL, (float*)(ws + WS_CTL) + 1024);
                run(pb + 7, pb + 15);
            } else
#endif
#if DEBUG_ATTN == 3
            if (L == 1) {
                run(pb + 0, pb + 2);
                bf16* attn2 = (bf16*)(ws + WS_PL);
                for (int b = 0; b < BATCH; ++b) {
                    dsa_scores<<<dim3(SEQ / 64, SEQ / 64), 256, 0, stream>>>(qkvi + (size_t)b * SEQ * QLD, iw + (size_t)b * SEQ * 4, scores);
                    dsa_topk<<<SEQ, 256, 0, stream>>>(scores, sel + (size_t)b * SEQ * TOPK);
                }
                dsa_attn<<<NTOK, 256, 0, stream>>>(qkvi, sel, attn2);
                run(pb + 2, pb + 4);
                dbg_compare<<<1024, 256, 0, stream>>>(attn, attn2, (size_t)NTOK * D_MODEL, (float*)(ws + WS_CTL) + 1024);
                run(pb + 7, pb + 15);
            } else
#endif
            { run(pb + 0, pb + 4); run(pb + 7, pb + 15); }
        } else {
            run(pb + 0, pb + 7);
#if DEBUG_ATTN == 1
            if (L == N_A) {
                bf16* attn2 = (bf16*)(ws + WS_PL);
                kmeans_kernel<<<BATCH * N_KV * N_BLOCKS, 128, 0, stream>>>(kvb, km + 65536);
                moba_attn<<<NTOK, 256, 0, stream>>>(qkvi, kvb, km + 65536, attn2);
                dbg_compare<<<1024, 256, 0, stream>>>(attn, attn2, (size_t)NTOK * D_MODEL, (float*)(ws + WS_CTL) + 1024);
            }
#endif
            run(pb + 7, pb + 15);
        }
    }
#endif
#if DEBUG_ATTN
    dbg_scale<<<1024, 256, 0, stream>>>((float*)d_out, (size_t)NTOK * D_MODEL, (const float*)(ws + WS_CTL) + 1024);
#endif
}
```

```cpp
#include <hip/hip_runtime.h>
#include <stdint.h>

#define D_MODEL 1024
#define BATCH 4
#define SEQ 8192
#define NTOK (BATCH * SEQ)
#define DEPTH 4
#define N_A 2
#define N_HEADS 8
#define HEAD_DIM 128
#define N_KV 2
#define HEAD_GROUP 4
#define KV_DIM 256
#define IDX_HEADS 4
#define IDX_DIM 64
#define TOPK 256
#define MOBA_BLOCK 256
#define N_BLOCKS 32
#define N_GROUPS 4
#define EPG 8
#define N_EXPERTS 32
#define D_EXPERT 512
#define PLE_DIM 256
#define A_COLS 1860
#define QLD 2048
#define COL_K 1024
#define COL_V 1280
#define COL_IQ 1536
#define COL_IK 1792
#define COL_IW 1856
#define ALPHA_F 1.6817928305074290f
#define LN_EPS 1e-5f
#define MAX_SLOTS (65536 + 8192)
#define MAX_MTILES (MAX_SLOTS / 256)

#define LAS __attribute__((address_space(3)))
#define GAS __attribute__((address_space(1)))
typedef unsigned short bf16;
typedef short bf16x8 __attribute__((ext_vector_type(8)));
typedef float f32x4 __attribute__((ext_vector_type(4)));
typedef float f32x2 __attribute__((ext_vector_type(2)));
typedef unsigned u32x4 __attribute__((ext_vector_type(4)));
typedef unsigned u32x2 __attribute__((ext_vector_type(2)));
typedef _Float16 f16x4 __attribute__((ext_vector_type(4)));

__device__ __forceinline__ unsigned cvt_pk_bf16(float lo, float hi) { unsigned r; asm("v_cvt_pk_bf16_f32 %0, %1, %2" : "=v"(r) : "v"(lo), "v"(hi)); return r; }
__device__ __forceinline__ float bf2f(bf16 b) { return __uint_as_float(((unsigned)b) << 16); }
__device__ __forceinline__ float bflo(unsigned u) { return __uint_as_float(u << 16); }
__device__ __forceinline__ float bfhi(unsigned u) { return __uint_as_float(u & 0xffff0000u); }
template <int CTRL> __device__ __forceinline__ float dpp_add(float v) { return v + __int_as_float(__builtin_amdgcn_update_dpp(0, __float_as_int(v), CTRL, 0xF, 0xF, false)); }
__device__ __forceinline__ float row16_sum(float v) {
    v = dpp_add<0xB1>(v); v = dpp_add<0x4E>(v); v = dpp_add<0x141>(v); v = dpp_add<0x140>(v); return v;
}
__device__ __forceinline__ float wave_sum(float v) { v = row16_sum(v); v += __shfl_xor(v, 16); v += __shfl_xor(v, 32); return v; }

constexpr size_t MiB = 1u << 20;
constexpr size_t WS_CTL = 0, CTL_ZERO_BYTES = 1 * MiB;
constexpr size_t WS_WMIX = 2 * MiB;
constexpr size_t WS_WPG = 10 * MiB;
constexpr size_t WS_WPLE = 12 * MiB;
constexpr size_t WS_WGU = 16 * MiB;
constexpr size_t WS_WD = 80 * MiB;
constexpr size_t WS_PB = 112 * MiB;
constexpr size_t WS_H = 128 * MiB;
constexpr size_t WS_HB = 256 * MiB;
constexpr size_t WS_T = 320 * MiB;
constexpr size_t WS_KV = 448 * MiB;
constexpr size_t WS_PL = 480 * MiB;
constexpr size_t WS_QKVI = 544 * MiB;
constexpr size_t WS_ATTN = 672 * MiB;
constexpr size_t WS_SEL = 736 * MiB;
constexpr size_t WS_ACT = 544 * MiB;
constexpr size_t WS_Y = 616 * MiB;
constexpr size_t WS_MOE = 768 * MiB;
constexpr size_t WS_IW = 770 * MiB;
constexpr size_t WS_KM = 771 * MiB;
constexpr size_t WS_SCORES = 772 * MiB;
constexpr int MO_TOK_E = 0, MO_TOK_POS = NTOK * 2, MO_TOK_SLOT = NTOK * 4, MO_TOK_W = NTOK * 6, MO_SLOT_TOK = NTOK * 8, MO_TILE_E = MO_SLOT_TOK + MAX_SLOTS, MO_TILE_ROW0 = MO_TILE_E + 512, MO_TILE_NV = MO_TILE_ROW0 + 512;
constexpr int CW_BAR = 65536;
constexpr int CW_CNT = 16384;
constexpr int CW_NTILES = 16384 + 256;

constexpr int LDS_BYTES = 163840;
constexpr int LDS_MISC = 163840 - 256;
constexpr int NWAVES = 8;

#define XB_TMO      128
#define XB_XCNT(j)  (256  + 64 * (j))
#define XB_XSUB(j)  (1280 + 64 * (j))
#define XB_XGEN(j)  (2304 + 64 * (j))
#define XB_TOP      3328
#define XB_TOPGEN   3392
#define XCD_BAR_WORDS 3456
#define XB_SPIN_CAP (1u << 22)
__device__ __forceinline__ unsigned xb_ld(unsigned* p)              { return __hip_atomic_load(p, __ATOMIC_RELAXED, __HIP_MEMORY_SCOPE_AGENT); }
__device__ __forceinline__ unsigned xb_add(unsigned* p, unsigned v) { return __hip_atomic_fetch_add(p, v, __ATOMIC_RELAXED, __HIP_MEMORY_SCOPE_AGENT); }
__device__ __forceinline__ unsigned xb_xcc_id() { return (unsigned)__builtin_amdgcn_s_getreg((3 << 11) | 20) & 0xFu; }
#define XB_SPIN(cond, bar) do { unsigned _sp = 0; while (cond) { __builtin_amdgcn_s_sleep(1); \
    if ((++_sp & 255u) == 0u) { if (xb_ld(&(bar)[XB_TMO])) break; if (_sp > XB_SPIN_CAP) { atomicAdd(&(bar)[XB_TMO], 1u); break; } } } } while (0)
struct XcdBarrier { unsigned* bar; unsigned x; volatile LAS unsigned* st; };
__device__ __forceinline__ XcdBarrier xcd_barrier_post(unsigned* bar, volatile LAS unsigned* st) {
    XcdBarrier b; b.bar = bar; b.x = xb_xcc_id(); b.st = st;
    if (threadIdx.x == 0) (void)xb_add(&bar[XB_XCNT(b.x)], 1u);
    return b;
}
__device__ __forceinline__ void xcd_barrier_complete(unsigned* bar, unsigned x, unsigned& nloc, unsigned& nx) {
    const unsigned G = gridDim.x * gridDim.y * gridDim.z;
    unsigned sum, cnt, mine, sp = 0u;
    for (;;) {
        sum = 0u; cnt = 0u; mine = 0u;
#pragma unroll
        for (unsigned j = 0; j < 16; ++j) { const unsigned c = xb_ld(&bar[XB_XCNT(j)]); sum += c; cnt += (c > 0u) ? 1u : 0u; mine = (j == x) ? c : mine; }
        if (sum == G) break;
        __builtin_amdgcn_s_sleep(1);
        if ((++sp & 255u) == 0u) { if (xb_ld(&bar[XB_TMO])) break; if (sp > XB_SPIN_CAP) { atomicAdd(&bar[XB_TMO], 1u); break; } }
    }
    nloc = mine > 0u ? mine : 1u; nx = cnt > 0u ? cnt : 1u;
}
__device__ __forceinline__ void xcd_barrier(const XcdBarrier& b) {
    asm volatile("s_waitcnt vmcnt(0)" ::: "memory");
    __syncthreads();
    if (threadIdx.x == 0) {
        unsigned* bar = b.bar;
        __builtin_amdgcn_s_waitcnt(0);
        unsigned nloc = b.st[0], nx = b.st[1];
        if (nloc == 0u) { xcd_barrier_complete(bar, b.x, nloc, nx); b.st[0] = nloc; b.st[1] = nx; }
        const unsigned old = xb_add(&bar[XB_XSUB(b.x)], 1u);
        const unsigned gen = old / nloc;
        if (old + 1u == (gen + 1u) * nloc) {
            __builtin_amdgcn_fence(__ATOMIC_RELEASE, "agent");
            asm volatile("s_waitcnt vmcnt(0)" ::: "memory");
            const unsigned og = xb_add(&bar[XB_TOP], 1u);
            const unsigned tg = og / nx;
            if (og + 1u == (tg + 1u) * nx) xb_add(&bar[XB_TOPGEN], 1u);
            else XB_SPIN(xb_ld(&bar[XB_TOPGEN]) == tg, bar);
            __builtin_amdgcn_fence(__ATOMIC_ACQUIRE, "agent");
            xb_add(&bar[XB_XGEN(b.x)], 1u);
            asm volatile("s_waitcnt vmcnt(0)" ::: "memory");
        } else {
            XB_SPIN(xb_ld(&bar[XB_XGEN(b.x)]) == gen, bar);
            __builtin_amdgcn_fence(__ATOMIC_ACQUIRE, "agent");
            asm volatile("s_waitcnt vmcnt(0)" ::: "memory");
        }
    }
    __syncthreads();
}

namespace gm {
constexpr int BM = 256, BK = 64, HALF = 128, HTB = HALF * BK * 2, STAGE_BYTES = 8 * HTB, NXCD = 8, WGM = 8;
__host__ __device__ __forceinline__ int lds_byte(int r, int c) { const int st = (r >> 4) * 2 + (c >> 5), rr = r & 15, cc = c & 31, ob = rr * 64 + cc * 2; return st * 1024 + (ob ^ (((ob >> 9) & 1) << 5)); }
__host__ __device__ __forceinline__ void stage_rc(int b, int& R, int& C) { const int st = b / 1024, sb = b % 1024, swz = sb ^ (((sb >> 9) & 1) << 5); R = (st >> 1) * 16 + swz / 64; C = (st & 1) * 32 + (swz % 64) / 2; }
__host__ __device__ __forceinline__ int perm32(int rho) { const int n = rho >> 4, i = rho & 15; return 8 * (i >> 2) + 4 * n + (i & 3); }

struct Unit { const char* a; const char* b; int row0, col0, aux; };

struct DenseOrder {
    int nM, nN, nwg, G, c; const char* A; const char* B; size_t tA, tB;
    __device__ void init(const void* A_, const void* Bt_, int M, int N, int K, int G_, int c_) { nM = M / BM; nN = N / BM; nwg = nM * nN; G = G_; c = c_; A = (const char*)A_; B = (const char*)Bt_; tA = (size_t)BM * K * 2; tB = tA; }
    __device__ bool next(int i, Unit& u) const {
        const long L = (long)i * G + c; if (L >= nwg) return false;
        int wgid = (int)L; { const int q = nwg / NXCD, r = nwg % NXCD, xcd = wgid % NXCD, off = wgid / NXCD; wgid = (xcd < r ? xcd * (q + 1) : r * (q + 1) + (xcd - r) * q) + off; }
        const int nig = WGM * nN, gid = wgid / nig, fm = gid * WGM, gsz = (nM - fm) < WGM ? (nM - fm) : WGM;
        const int pm = fm + ((wgid % nig) % gsz), pn = (wgid % nig) / gsz;
        u.a = A + (size_t)pm * tA; u.b = B + (size_t)pn * tB; u.row0 = pm * BM; u.col0 = pn * BM; u.aux = 0; return true;
    }
    __device__ __forceinline__ void gather(const Unit&, unsigned (&)[2][2], const int (&)[2], const int (&)[2], int) const {}
};
struct MoeOrder {
    const int* tile_e; const int* tile_row0; const int* tile_nv; const int* slot_tok; int n_units, G, c, K; const char* A; const char* W; size_t wstride, tB; bool gath;
    __device__ bool next(int i, Unit& u) const {
        const int L = i * G + c; if (L >= n_units) return false;
        const int T = L >> 2, pn = L & 3;
        const int e = __builtin_amdgcn_readfirstlane(tile_e[T]), r0 = __builtin_amdgcn_readfirstlane(tile_row0[T]), nv = __builtin_amdgcn_readfirstlane(tile_nv[T]);
        u.a = gath ? A : A + (size_t)r0 * K * 2; u.b = W + (size_t)e * wstride + (size_t)pn * tB; u.row0 = r0; u.col0 = pn; u.aux = nv; return true;
    }
    __device__ __forceinline__ void gather(const Unit& u, unsigned (&vo)[2][2], const int (&sR)[2], const int (&sC)[2], int K_) const {
#pragma unroll
        for (int h = 0; h < 2; ++h)
#pragma unroll
            for (int i = 0; i < 2; ++i) { const int r = h * HALF + sR[i]; const int tok = (r < u.aux) ? slot_tok[u.row0 + r] : 0; vo[h][i] = (unsigned)(tok * K_ + sC[i]) * 2u; }
    }
};

template <class Epi, class Sched, bool GATHER>
__device__ __forceinline__ void gemm_phase(LAS unsigned char* lds, const int K, const Sched& S, const Epi& E) {
    int tz = threadIdx.x; asm volatile("" : "+v"(tz));
    const int tid = tz, wid = __builtin_amdgcn_readfirstlane(tid >> 6), lane = tid & 63, wr = wid >> 2, wc = wid & 3, fr = lane & 15, fq = lane >> 4;
    const int nt = K / BK;
    unsigned voffB[2], vA[2][2], vAn[2][2]; int sR[2], sC[2];
#pragma unroll
    for (int i = 0; i < 2; ++i) { int R, C; stage_rc(tid * 16 + i * 8192, R, C); const int Rb = Epi::PERM ? ((R & ~31) + perm32(R & 31)) : R;
        sR[i] = R; sC[i] = C; voffB[i] = (unsigned)(Rb * K + C) * 2u;
        vA[0][i] = (unsigned)(R * K + C) * 2u; vA[1][i] = (unsigned)((R + HALF) * K + C) * 2u; vAn[0][i] = vA[0][i]; vAn[1][i] = vA[1][i]; }
    const size_t kstep = (size_t)(BK * 2);
    const size_t hstep = (size_t)HALF * K * 2;
    const unsigned ldsw = (unsigned)wid * 1024u;
    const int aoff = lds_byte(wr * 64 + fr, fq * 8), boff = lds_byte(wc * 32 + fr, fq * 8);
#define PG8_SA(b, h) (((b) * 2 + (h)) * HTB)
#define PG8_SB(b, h) ((4 + (b) * 2 + (h)) * HTB)
#define PG8_STAGE(bufoff, gbase, voff) do { _Pragma("unroll") for (int _i = 0; _i < 2; ++_i) \
        __builtin_amdgcn_global_load_lds((const unsigned*)((const char*)(gbase) + (voff)[_i]), (LAS unsigned*)(lds + (bufoff) + ldsw + _i * 8192), 16, 0, 0); } while (0)
#define PG8_LDA(dst, b, h) do { _Pragma("unroll") for (int m = 0; m < 4; ++m) _Pragma("unroll") for (int k = 0; k < 2; ++k) dst[m][k] = *(const LAS bf16x8*)(lds + PG8_SA(b, h) + aoff + m * 2048 + k * 1024); } while (0)
#define PG8_LDB(dst, b, h) do { _Pragma("unroll") for (int n = 0; n < 2; ++n) _Pragma("unroll") for (int k = 0; k < 2; ++k) dst[n][k] = *(const LAS bf16x8*)(lds + PG8_SB(b, h) + boff + n * 2048 + k * 1024); } while (0)
#define PG8_MMA(ai, bj, At, Bt) do { __builtin_amdgcn_s_setprio(1); _Pragma("unroll") for (int m = 0; m < 4; ++m) _Pragma("unroll") for (int n = 0; n < 2; ++n) _Pragma("unroll") for (int k = 0; k < 2; ++k) \
        acc[ai][bj][m][n] = __builtin_amdgcn_mfma_f32_16x16x32_bf16(Bt[n][k], At[m][k], acc[ai][bj][m][n], 0, 0, 0); __builtin_amdgcn_s_setprio(0); } while (0)
#define PG8_WAIT_V(n) asm volatile("s_waitcnt vmcnt(" #n ")" ::: "memory")
#define PG8_WAIT_L(n) asm volatile("s_waitcnt lgkmcnt(" #n ")" ::: "memory")
#define PG8_BAR __builtin_amdgcn_s_barrier()
#define PG8_SCHED __builtin_amdgcn_sched_barrier(0)
    Unit cur, nxt; int ui = 0;
    if (!S.next(0, cur)) return;
    f32x4 acc[2][2][4][2];
#pragma unroll
    for (int a = 0; a < 2; ++a)
#pragma unroll
        for (int b = 0; b < 2; ++b)
#pragma unroll
            for (int m = 0; m < 4; ++m)
#pragma unroll
                for (int n = 0; n < 2; ++n) acc[a][b][m][n] = (f32x4){0.f, 0.f, 0.f, 0.f};
    bf16x8 At[4][2], B0[2][2], B1[2][2];
    const char* cA = cur.a; const char* cB = cur.b;
    if constexpr (GATHER) S.gather(cur, vA, sR, sC, K);
    PG8_STAGE(PG8_SB(0, 0), cB, voffB); PG8_STAGE(PG8_SB(0, 1), cB + hstep, voffB); PG8_STAGE(PG8_SA(0, 0), cA, vA[0]); PG8_STAGE(PG8_SA(0, 1), cA, vA[1]);
    if (wr == 1) PG8_BAR;
    PG8_WAIT_V(2); PG8_BAR;
    PG8_STAGE(PG8_SB(1, 0), cB + kstep, voffB); PG8_STAGE(PG8_SA(1, 0), cA + kstep, vA[0]); PG8_STAGE(PG8_SB(1, 1), cB + hstep + kstep, voffB);
    PG8_WAIT_V(6); PG8_BAR;
    for (;;) {
        const bool has_next = S.next(ui + 1, nxt);
        const char* nA = has_next ? nxt.a : cA; const char* nB = has_next ? nxt.b : cB;
        if constexpr (GATHER) {
            if (has_next) S.gather(nxt, vAn, sR, sC, K);
            else { vAn[0][0] = vA[0][0]; vAn[0][1] = vA[0][1]; vAn[1][0] = vA[1][0]; vAn[1][1] = vA[1][1]; }
        }
        for (int t = 0; t < nt; t += 2) {
            const bool last = (t == nt - 2);
            const char* a1 = cA + (size_t)(t + 1) * kstep;
            const char* a2 = last ? nA : cA + (size_t)(t + 2) * kstep; const char* b2 = last ? nB : cB + (size_t)(t + 2) * kstep;
            const char* a3 = a2 + kstep; const char* b3 = b2 + kstep;
            unsigned w0[2], w1[2];
            if constexpr (GATHER) { w0[0] = last ? vAn[0][0] : vA[0][0]; w0[1] = last ? vAn[0][1] : vA[0][1]; w1[0] = last ? vAn[1][0] : vA[1][0]; w1[1] = last ? vAn[1][1] : vA[1][1]; }
            else { w0[0] = vA[0][0]; w0[1] = vA[0][1]; w1[0] = vA[1][0]; w1[1] = vA[1][1]; }
            PG8_LDB(B0, 0, 0); PG8_LDB(B1, 0, 1); PG8_SCHED; PG8_LDA(At, 0, 0); PG8_STAGE(PG8_SA(1, 1), a1, vA[1]);
            PG8_WAIT_V(8); PG8_WAIT_L(0); PG8_BAR; PG8_MMA(0, 0, At, B0); PG8_MMA(0, 1, At, B1); PG8_BAR; PG8_SCHED;
            PG8_LDA(At, 0, 1); PG8_STAGE(PG8_SB(0, 0), b2, voffB); PG8_STAGE(PG8_SB(0, 1), b2 + hstep, voffB); PG8_STAGE(PG8_SA(0, 0), a2, w0);
            PG8_WAIT_V(8); PG8_WAIT_L(0); PG8_BAR; PG8_MMA(1, 0, At, B0); PG8_MMA(1, 1, At, B1); PG8_BAR; PG8_SCHED;
            PG8_LDB(B0, 1, 0); PG8_LDB(B1, 1, 1); PG8_SCHED; PG8_LDA(At, 1, 0); PG8_STAGE(PG8_SA(0, 1), a2, w1);
            PG8_WAIT_V(8); PG8_WAIT_L(0); PG8_BAR; PG8_MMA(0, 0, At, B0); PG8_MMA(0, 1, At, B1); PG8_BAR; PG8_SCHED;
            PG8_LDA(At, 1, 1); PG8_STAGE(PG8_SB(1, 0), b3, voffB); PG8_STAGE(PG8_SB(1, 1), b3 + hstep, voffB); PG8_STAGE(PG8_SA(1, 0), a3, w0);
            PG8_WAIT_V(8); PG8_WAIT_L(0); PG8_BAR; PG8_MMA(1, 0, At, B0); PG8_MMA(1, 1, At, B1); PG8_BAR; PG8_SCHED;
        }
        if (wr == 0) PG8_BAR;
        E(acc, cur, wr, wc, fr, fq);
        if (!has_next) break;
#pragma unroll
        for (int a = 0; a < 2; ++a)
#pragma unroll
            for (int b = 0; b < 2; ++b)
#pragma unroll
                for (int m = 0; m < 4; ++m)
#pragma unroll
                    for (int n = 0; n < 2; ++n) acc[a][b][m][n] = (f32x4){0.f, 0.f, 0.f, 0.f};
        cur = nxt; cA = nA; cB = nB; ++ui;
        if constexpr (GATHER) { vA[0][0] = vAn[0][0]; vA[0][1] = vAn[0][1]; vA[1][0] = vAn[1][0]; vA[1][1] = vAn[1][1]; }
        if (wr == 1) PG8_BAR;
    }
    PG8_WAIT_V(0);
    PG8_BAR;
#undef PG8_SA
#undef PG8_SB
#undef PG8_STAGE
#undef PG8_LDA
#undef PG8_LDB
#undef PG8_MMA
#undef PG8_WAIT_V
#undef PG8_WAIT_L
#undef PG8_BAR
#undef PG8_SCHED
}

#define EPI_ROWS(u, ai, m) ((u).row0 + (ai) * HALF + wr * 64 + (m) * 16 + fr)
struct EpiBf16 {
    static constexpr bool PERM = true;
    bf16* O; int ldc; float* iw;
    __device__ __forceinline__ void operator()(const f32x4 (&acc)[2][2][4][2], const Unit& u, int wr, int wc, int fr, int fq) const {
#pragma unroll
        for (int ai = 0; ai < 2; ++ai)
#pragma unroll
            for (int m = 0; m < 4; ++m) { const int row = EPI_ROWS(u, ai, m); bf16* rowp = O + (size_t)row * ldc + u.col0 + wc * 32 + 8 * fq;
#pragma unroll
                for (int bj = 0; bj < 2; ++bj) { const f32x4 v0 = acc[ai][bj][m][0], v1 = acc[ai][bj][m][1];
                    u32x4 w; w.x = cvt_pk_bf16(v0[0], v0[1]); w.y = cvt_pk_bf16(v0[2], v0[3]); w.z = cvt_pk_bf16(v1[0], v1[1]); w.w = cvt_pk_bf16(v1[2], v1[3]);
                    *(u32x4*)(rowp + bj * HALF) = w; }
                if (iw != nullptr && u.col0 == 1792 && wc == 2 && fq == 0) *(f32x4*)(iw + (size_t)row * 4) = acc[ai][0][m][0] * 0.0625f; }
    }
};
struct EpiResid {
    static constexpr bool PERM = false;
    const float* h; _Float16* t;
    __device__ __forceinline__ void operator()(const f32x4 (&acc)[2][2][4][2], const Unit& u, int wr, int wc, int fr, int fq) const {
#pragma unroll
        for (int ai = 0; ai < 2; ++ai)
#pragma unroll
            for (int m = 0; m < 4; ++m) { const size_t o = (size_t)EPI_ROWS(u, ai, m) * D_MODEL + u.col0 + wc * 32 + 4 * fq;
#pragma unroll
                for (int bj = 0; bj < 2; ++bj)
#pragma unroll
                    for (int n = 0; n < 2; ++n) { const size_t oo = o + bj * HALF + n * 16; const f32x4 hv = *(const f32x4*)(h + oo); const f32x4 tv = hv * ALPHA_F + acc[ai][bj][m][n]; *(f16x4*)(t + oo) = (f16x4){(_Float16)tv[0], (_Float16)tv[1], (_Float16)tv[2], (_Float16)tv[3]}; } }
    }
};
struct EpiPle {
    static constexpr bool PERM = false;
    const float* h; const bf16* pl; _Float16* t;
    __device__ __forceinline__ void operator()(const f32x4 (&acc)[2][2][4][2], const Unit& u, int wr, int wc, int fr, int fq) const {
#pragma unroll
        for (int ai = 0; ai < 2; ++ai)
#pragma unroll
            for (int m = 0; m < 4; ++m) { const size_t o = (size_t)EPI_ROWS(u, ai, m) * D_MODEL + u.col0 + wc * 32 + 4 * fq;
#pragma unroll
                for (int bj = 0; bj < 2; ++bj)
#pragma unroll
                    for (int n = 0; n < 2; ++n) { const size_t oo = o + bj * HALF + n * 16; const f32x4 hv = *(const f32x4*)(h + oo); const u32x2 pv = *(const u32x2*)(pl + oo);
                        const f32x4 a = acc[ai][bj][m][n]; f32x4 r;
                        r[0] = fmaf(hv[0], ALPHA_F, bflo(pv.x) * __builtin_amdgcn_rcpf(1.f + __builtin_amdgcn_exp2f(a[0] * -1.4426950408889634f))); r[1] = fmaf(hv[1], ALPHA_F, bfhi(pv.x) * __builtin_amdgcn_rcpf(1.f + __builtin_amdgcn_exp2f(a[1] * -1.4426950408889634f)));
                        r[2] = fmaf(hv[2], ALPHA_F, bflo(pv.y) * __builtin_amdgcn_rcpf(1.f + __builtin_amdgcn_exp2f(a[2] * -1.4426950408889634f))); r[3] = fmaf(hv[3], ALPHA_F, bfhi(pv.y) * __builtin_amdgcn_rcpf(1.f + __builtin_amdgcn_exp2f(a[3] * -1.4426950408889634f)));
                        *(f16x4*)(t + oo) = (f16x4){(_Float16)r[0], (_Float16)r[1], (_Float16)r[2], (_Float16)r[3]}; } }
    }
};
struct EpiSwiglu {
    static constexpr bool PERM = true;
    bf16* act;
    __device__ __forceinline__ void operator()(const f32x4 (&acc)[2][2][4][2], const Unit& u, int wr, int wc, int fr, int fq) const {
#pragma unroll
        for (int ai = 0; ai < 2; ++ai)
#pragma unroll
            for (int m = 0; m < 4; ++m) { const int row = EPI_ROWS(u, ai, m); float r[8];
#pragma unroll
                for (int n = 0; n < 2; ++n)
#pragma unroll
                    for (int j = 0; j < 4; ++j) { const float g = acc[ai][0][m][n][j], uu = acc[ai][1][m][n][j]; r[n * 4 + j] = g * __builtin_amdgcn_rcpf(1.f + __builtin_amdgcn_exp2f(g * -1.4426950408889634f)) * uu; }
                u32x4 w; w.x = cvt_pk_bf16(r[0], r[1]); w.y = cvt_pk_bf16(r[2], r[3]); w.z = cvt_pk_bf16(r[4], r[5]); w.w = cvt_pk_bf16(r[6], r[7]);
                *(u32x4*)(act + (size_t)row * D_EXPERT + u.col0 * 128 + wc * 32 + 8 * fq) = w; }
    }
};
struct EpiMoeDown {
    static constexpr bool PERM = true;
    bf16* Y;
    __device__ __forceinline__ void operator()(const f32x4 (&acc)[2][2][4][2], const Unit& u, int wr, int wc, int fr, int fq) const {
#pragma unroll
        for (int ai = 0; ai < 2; ++ai)
#pragma unroll
            for (int m = 0; m < 4; ++m) { const int row = EPI_ROWS(u, ai, m); bf16* rowp = Y + (size_t)row * D_MODEL + u.col0 * 256 + wc * 32 + 8 * fq;
#pragma unroll
                for (int bj = 0; bj < 2; ++bj) { const f32x4 v0 = acc[ai][bj][m][0], v1 = acc[ai][bj][m][1];
                    u32x4 w; w.x = cvt_pk_bf16(v0[0], v0[1]); w.y = cvt_pk_bf16(v0[2], v0[3]); w.z = cvt_pk_bf16(v1[0], v1[1]); w.w = cvt_pk_bf16(v1[2], v1[3]);
                    *(u32x4*)(rowp + bj * HALF) = w; } }
    }
};
}

struct Params { const float* in[18]; float* out; unsigned char* ws; int ph_lo, ph_hi, bar_idx, pad; };
typedef const Params __attribute__((address_space(4)))* KP;
__device__ __forceinline__ KP fresh_params() { KP p = (KP)__builtin_amdgcn_kernarg_segment_ptr(); asm volatile("" : "+s"(p)); return p; }

__device__ __forceinline__ void tr_item(const float* W, int K, int N, bf16* WT, int row_off, LAS float* scr, int kb, int nb, int lane) {
    const int k0 = 64 * kb, n0 = 32 * nb;
    const bool ok = (n0 + (lane & 31)) < N;
    if (n0 + 32 <= N) {
        const int kr = lane >> 3, c4 = (lane & 7) * 4;
#pragma unroll
        for (int i = 0; i < 8; ++i) { const int kk = 8 * i + kr; const f32x4 v = *(const f32x4*)(W + (size_t)(k0 + kk) * N + n0 + c4);
            LAS float* d = scr + kk * 33 + c4; d[0] = v[0]; d[1] = v[1]; d[2] = v[2]; d[3] = v[3]; }
    } else {
#pragma unroll 8
        for (int i = 0; i < 32; ++i) { const int kk = 2 * i + (lane >> 5); scr[kk * 33 + (lane & 31)] = ok ? W[(size_t)(k0 + kk) * N + n0 + (lane & 31)] : 0.f; }
    }
    asm volatile("s_waitcnt lgkmcnt(0)" ::: "memory");
    const int c = lane & 7;
#pragma unroll
    for (int j = 0; j < 4; ++j) { const int n = (lane >> 3) + 8 * j; const LAS float* s = scr + (8 * c) * 33 + n;
        u32x4 o; o.x = cvt_pk_bf16(s[0 * 33], s[1 * 33]); o.y = cvt_pk_bf16(s[2 * 33], s[3 * 33]); o.z = cvt_pk_bf16(s[4 * 33], s[5 * 33]); o.w = cvt_pk_bf16(s[6 * 33], s[7 * 33]);
        *(u32x4*)(WT + (size_t)(row_off + n0 + n) * K + k0 + 8 * c) = o; }
    asm volatile("s_waitcnt lgkmcnt(0)" ::: "memory");
}
__device__ __forceinline__ void cvt_rows(const float* src, bf16* dst, size_t n4, int gtid, int gthreads) {
    for (size_t i = gtid; i < n4; i += gthreads) { const f32x4 v = *(const f32x4*)(src + i * 4); u32x2 o; o.x = cvt_pk_bf16(v[0], v[1]); o.y = cvt_pk_bf16(v[2], v[3]); *(u32x2*)(dst + i * 4) = o; }
}
__device__ __forceinline__ void phase_convert(KP P, int L, LAS unsigned char* lds) {
    int tz = threadIdx.x; asm volatile("" : "+v"(tz));
    const int tid = tz, lane = tid & 63, wave = tid >> 6;
    LAS float* scr = (LAS float*)(lds + wave * 16384);
    const int gw = blockIdx.x * NWAVES + wave, NGW = gridDim.x * NWAVES;
    unsigned char* ws = P->ws;
    bf16* wmix = (bf16*)(ws + WS_WMIX); bf16* wo_t = (bf16*)(ws + WS_WMIX + 4 * MiB); bf16* wkv_t = (bf16*)(ws + WS_WMIX + 6 * MiB);
    bf16* wpg_t = (bf16*)(ws + WS_WPG); bf16* wple_t = (bf16*)(ws + WS_WPLE); bf16* wgu_t = (bf16*)(ws + WS_WGU); bf16* wd_t = (bf16*)(ws + WS_WD);
    const bool isA = L < N_A; const int j = L - N_A;
    const float* w_first = isA ? P->in[2] + (size_t)L * D_MODEL * A_COLS : P->in[5] + (size_t)j * D_MODEL * D_MODEL;
    const int n_first = isA ? A_COLS : D_MODEL, nb_first = isA ? 64 : 32;
    const float* w_o = isA ? P->in[3] + (size_t)L * D_MODEL * D_MODEL : P->in[6] + (size_t)j * D_MODEL * D_MODEL;
    const int I_FIRST = 16 * nb_first, I_O = 16 * 32, I_KV = (L == N_A) ? 16 * 16 : 0, I_PG = 16 * 32, I_PLE = 4 * 32, I_G = 32 * 256, I_U = 32 * 256, I_D = 32 * 256;
    const int NITEMS = I_FIRST + I_O + I_KV + I_PG + I_PLE + I_G + I_U + I_D;
    const size_t wsz = (size_t)D_MODEL * D_EXPERT;
    for (int it = gw; it < NITEMS; it += NGW) {
        int r = it;
        if (r < I_FIRST) { tr_item(w_first, D_MODEL, n_first, wmix, 0, scr, r / nb_first, r % nb_first, lane); continue; } r -= I_FIRST;
        if (r < I_O) { tr_item(w_o, D_MODEL, D_MODEL, wo_t, 0, scr, r / 32, r % 32, lane); continue; } r -= I_O;
        if (r < I_KV) { tr_item(P->in[4], D_MODEL, 512, wkv_t, 0, scr, r / 16, r % 16, lane); continue; } r -= I_KV;
        if (r < I_PG) { tr_item(P->in[15] + (size_t)L * D_MODEL * D_MODEL, D_MODEL, D_MODEL, wpg_t, 0, scr, r / 32, r % 32, lane); continue; } r -= I_PG;
        if (r < I_PLE) { tr_item(P->in[14] + (size_t)L * PLE_DIM * D_MODEL, PLE_DIM, D_MODEL, wple_t, 0, scr, r / 32, r % 32, lane); continue; } r -= I_PLE;
        if (r < I_G + I_U) {
            const bool up = r >= I_G; if (up) r -= I_G;
            const int e = r >> 8, rem = r & 255, kb = rem >> 4, nb = rem & 15, n0 = nb * 32;
            const float* W = (up ? P->in[12] : P->in[11]) + ((size_t)L * N_EXPERTS + e) * wsz;
            const int row_off = (n0 >> 7) * 256 + (up ? 128 : 0) + (n0 & 127) - n0;
            tr_item(W, D_MODEL, D_EXPERT, wgu_t + (size_t)e * D_MODEL * D_MODEL, row_off, scr, kb, nb, lane); continue; }
        r -= I_G + I_U;
        { const int e = r >> 8, rem = r & 255, kb = rem >> 5, nb = rem & 31;
          tr_item(P->in[13] + ((size_t)L * N_EXPERTS + e) * wsz, D_EXPERT, D_MODEL, wd_t + (size_t)e * wsz, 0, scr, kb, nb, lane); }
    }
    const int gtid = blockIdx.x * 512 + tid, gthreads = gridDim.x * 512;
    { const float* wrg = P->in[7] + (size_t)L * D_MODEL * N_GROUPS; const float* wre = P->in[9] + (size_t)L * D_MODEL * N_EXPERTS; float* wrt = (float*)(ws + WS_WPLE + 1 * MiB);
      for (int i = gtid; i < D_MODEL * 36; i += gthreads) { const int c = i >> 10, k = i & 1023; wrt[i] = (c < 4) ? wrg[k * 4 + c] : wre[k * 32 + (c - 4)]; } }
    cvt_rows(P->in[1] + (size_t)L * NTOK * PLE_DIM, (bf16*)(ws + WS_PB), (size_t)NTOK * PLE_DIM / 4, gtid, gthreads);
    if (L == 0) cvt_rows(P->in[0], (bf16*)(ws + WS_HB), (size_t)NTOK * D_MODEL / 4, gtid, gthreads);
}

template <int SRC, bool ROUTER>
__device__ __forceinline__ void phase_ln(KP P, int L, int which, LAS unsigned char* lds, float* dst_f32, bool write_hb, int cidx = -1) {
    int tz = threadIdx.x; asm volatile("" : "+v"(tz));
    const int tid = tz, lane = tid & 63, wave = tid >> 6;
    unsigned char* ws = P->ws;
    const _Float16* t = (const _Float16*)(ws + WS_T); const float* h = (const float*)(ws + WS_H); bf16* hb = (bf16*)(ws + WS_HB);
    const bf16* Y = (const bf16*)(ws + WS_Y);
    int* moe = (int*)(ws + WS_MOE);
    const float* g = P->in[16] + (size_t)(L * 3 + which) * D_MODEL; const float* bt = P->in[17] + (size_t)(L * 3 + which) * D_MODEL;
    LAS float* Wl = (LAS float*)lds;
    LAS float* lgs = (LAS float*)(lds + 147456) + wave * 40;
    if (ROUTER) {
        const float* wrg = P->in[7] + (size_t)L * D_MODEL * N_GROUPS; const float* wre = P->in[9] + (size_t)L * D_MODEL * N_EXPERTS;
        for (int i = tid; i < D_MODEL * 36; i += 512) { const int k = i / 36, c = i % 36; Wl[c * D_MODEL + k] = (c < 4) ? wrg[k * 4 + c] : wre[k * 32 + (c - 4)]; }
        __syncthreads();
    }
    f32x4 gv[4], bv[4];
#pragma unroll
    for (int j = 0; j < 4; ++j) { gv[j] = *(const f32x4*)(g + 4 * lane + 256 * j); bv[j] = *(const f32x4*)(bt + 4 * lane + 256 * j); }
    const int gw = blockIdx.x * NWAVES + wave, NGW = gridDim.x * NWAVES;
    for (int row = gw; row < NTOK; row += NGW) {
        f32x4 v[4];
        if (SRC == 0) {
#pragma unroll
            for (int j = 0; j < 4; ++j) { const f16x4 tv = *(const f16x4*)(t + (size_t)row * D_MODEL + 4 * lane + 256 * j); v[j] = (f32x4){(float)tv[0], (float)tv[1], (float)tv[2], (float)tv[3]}; }
        } else {
            const int s0 = moe[MO_TOK_SLOT + row * 2], s1 = moe[MO_TOK_SLOT + row * 2 + 1];
            const float w0 = ((const float*)moe)[MO_TOK_W + row * 2], w1 = ((const float*)moe)[MO_TOK_W + row * 2 + 1];
#pragma unroll
            for (int j = 0; j < 4; ++j) {
                const f32x4 hv = *(const f32x4*)(h + (size_t)row * D_MODEL + 4 * lane + 256 * j);
                const u32x2 y0 = *(const u32x2*)(Y + (size_t)s0 * D_MODEL + 4 * lane + 256 * j), y1 = *(const u32x2*)(Y + (size_t)s1 * D_MODEL + 4 * lane + 256 * j);
                v[j][0] = hv[0] * ALPHA_F + (w0 * bflo(y0.x) + w1 * bflo(y1.x)); v[j][1] = hv[1] * ALPHA_F + (w0 * bfhi(y0.x) + w1 * bfhi(y1.x));
                v[j][2] = hv[2] * ALPHA_F + (w0 * bflo(y0.y) + w1 * bflo(y1.y)); v[j][3] = hv[3] * ALPHA_F + (w0 * bfhi(y0.y) + w1 * bfhi(y1.y));
            }
        }
        float s = 0.f;
#pragma unroll
        for (int j = 0; j < 4; ++j) s += (v[j][0] + v[j][1]) + (v[j][2] + v[j][3]);
        const float mean = wave_sum(s) * (1.f / D_MODEL);
        float q = 0.f;
#pragma unroll
        for (int j = 0; j < 4; ++j) { v[j] = v[j] - mean; q += (v[j][0] * v[j][0] + v[j][1] * v[j][1]) + (v[j][2] * v[j][2] + v[j][3] * v[j][3]); }
        const float rstd = rsqrtf(wave_sum(q) * (1.f / D_MODEL) + LN_EPS);
#pragma unroll
        for (int j = 0; j < 4; ++j) { v[j] = v[j] * rstd * gv[j] + bv[j]; *(f32x4*)(dst_f32 + (size_t)row * D_MODEL + 4 * lane + 256 * j) = v[j]; }
        if (write_hb) {
#pragma unroll
            for (int j = 0; j < 4; ++j) { u32x2 o; o.x = cvt_pk_bf16(v[j][0], v[j][1]); o.y = cvt_pk_bf16(v[j][2], v[j][3]); *(u32x2*)(hb + (size_t)row * D_MODEL + 4 * lane + 256 * j) = o; }
        }
        if (ROUTER) {
            float lg[36];
#pragma unroll
            for (int c = 0; c < 36; ++c) {
                float a = 0.f;
#pragma unroll
                for (int j = 0; j < 4; ++j) { const f32x4 w = *(const LAS f32x4*)(Wl + c * D_MODEL + 4 * lane + 256 * j); a += (v[j][0] * w[0] + v[j][1] * w[1]) + (v[j][2] * w[2] + v[j][3] * w[3]); }
                lg[c] = wave_sum(a);
            }
            if (lane == 0) {
                const float* brg = P->in[8] + L * N_GROUPS; const float* bre = P->in[10] + L * N_EXPERTS;
                float gl[4];
#pragma unroll
                for (int jj = 0; jj < 4; ++jj) gl[jj] = lg[jj] + brg[jj];
                int gs = 0; float gmax = gl[0];
#pragma unroll
                for (int jj = 1; jj < 4; ++jj) if (gl[jj] > gmax) { gmax = gl[jj]; gs = jj; }
                float den = 0.f;
#pragma unroll
                for (int jj = 0; jj < 4; ++jj) den += expf(gl[jj] - gmax);
                const float gwt = 1.f / den;
                float el[8];
#pragma unroll
                for (int jj = 0; jj < 8; ++jj) el[jj] = 0.f;
#pragma unroll
                for (int c = 0; c < 32; ++c) { if ((c >> 3) == gs) el[c & 7] = lg[4 + c] + bre[c]; }
                int i0 = 0; float v0 = el[0];
#pragma unroll
                for (int jj = 1; jj < 8; ++jj) if (el[jj] > v0) { v0 = el[jj]; i0 = jj; }
                int i1 = -1; float v1 = 0.f;
#pragma unroll
                for (int jj = 0; jj < 8; ++jj) if (jj != i0 && (i1 < 0 || el[jj] > v1)) { v1 = el[jj]; i1 = jj; }
                const float e1 = expf(v1 - v0);
                const float w0 = gwt / (1.f + e1), w1 = gwt * e1 / (1.f + e1);
                const int ea = gs * 8 + i0, eb = gs * 8 + i1;
                unsigned* cnt = (unsigned*)(ws + WS_CTL) + CW_CNT + (cidx < 0 ? L : cidx) * 32;
                const int pa = (int)atomicAdd(&cnt[ea], 1u), pb = (int)atomicAdd(&cnt[eb], 1u);
                moe[MO_TOK_E + row * 2] = ea; moe[MO_TOK_E + row * 2 + 1] = eb; moe[MO_TOK_POS + row * 2] = pa; moe[MO_TOK_POS + row * 2 + 1] = pb;
                ((float*)moe)[MO_TOK_W + row * 2] = w0; ((float*)moe)[MO_TOK_W + row * 2 + 1] = w1;
            }
        }
    }
    (void)lgs;
}


__device__ __forceinline__ void phase_ln_router(KP P, int L, LAS unsigned char* lds, int cidx) {
    int tz = threadIdx.x; asm volatile("" : "+v"(tz)); const int tid = tz, lane = tid & 63, wave = tid >> 6;
    unsigned char* ws = P->ws;
    const _Float16* t = (const _Float16*)(ws + WS_T); float* h = (float*)(ws + WS_H); bf16* hb = (bf16*)(ws + WS_HB);
    int* moe = (int*)(ws + WS_MOE);
    const float* g = P->in[16] + (size_t)(L * 3) * D_MODEL; const float* bt = P->in[17] + (size_t)(L * 3) * D_MODEL;
    LAS float* Wl = (LAS float*)lds;
    LAS float* lgs = (LAS float*)(lds + 147456) + wave * 80;
    LAS int* lcnt = (LAS int*)(lds + 150016);
    LAS int* rinfo = (LAS int*)(lds + 150272);
    { const f32x4* wrt = (const f32x4*)(ws + WS_WPLE + 1 * MiB);
      for (int i = tid; i < D_MODEL * 36 / 4; i += 512) ((LAS f32x4*)Wl)[i] = wrt[i];
      if (tid < 64) lcnt[tid] = 0; }
    __syncthreads();
    f32x4 gv[4], bv[4];
#pragma unroll
    for (int j = 0; j < 4; ++j) { gv[j] = *(const f32x4*)(g + 4 * lane + 256 * j); bv[j] = *(const f32x4*)(bt + 4 * lane + 256 * j); }
    const float* brg = P->in[8] + L * N_GROUPS; const float* bre = P->in[10] + L * N_EXPERTS;
    const int gw = blockIdx.x * NWAVES + wave, NGW = gridDim.x * NWAVES;
    int it = 0;
    for (int pi = gw; pi < NTOK / 2; pi += NGW, ++it) {
        const int row0 = pi * 2;
        f32x4 va[4], vb[4];
#pragma unroll
        for (int j = 0; j < 4; ++j) { const f16x4 ta = *(const f16x4*)(t + (size_t)row0 * D_MODEL + 4 * lane + 256 * j), tb2 = *(const f16x4*)(t + (size_t)(row0 + 1) * D_MODEL + 4 * lane + 256 * j);
            va[j] = (f32x4){(float)ta[0], (float)ta[1], (float)ta[2], (float)ta[3]}; vb[j] = (f32x4){(float)tb2[0], (float)tb2[1], (float)tb2[2], (float)tb2[3]}; }
        float sa = 0.f, sb = 0.f;
#pragma unroll
        for (int j = 0; j < 4; ++j) { sa += (va[j][0] + va[j][1]) + (va[j][2] + va[j][3]); sb += (vb[j][0] + vb[j][1]) + (vb[j][2] + vb[j][3]); }
        const float ma = wave_sum(sa) * (1.f / D_MODEL), mb_ = wave_sum(sb) * (1.f / D_MODEL);
        float qa = 0.f, qb = 0.f;
#pragma unroll
        for (int j = 0; j < 4; ++j) { va[j] = va[j] - ma; vb[j] = vb[j] - mb_;
            qa += (va[j][0] * va[j][0] + va[j][1] * va[j][1]) + (va[j][2] * va[j][2] + va[j][3] * va[j][3]);
            qb += (vb[j][0] * vb[j][0] + vb[j][1] * vb[j][1]) + (vb[j][2] * vb[j][2] + vb[j][3] * vb[j][3]); }
        const float ra = rsqrtf(wave_sum(qa) * (1.f / D_MODEL) + LN_EPS), rb = rsqrtf(wave_sum(qb) * (1.f / D_MODEL) + LN_EPS);
#pragma unroll
        for (int j = 0; j < 4; ++j) { va[j] = va[j] * ra * gv[j] + bv[j]; vb[j] = vb[j] * rb * gv[j] + bv[j];
            *(f32x4*)(h + (size_t)row0 * D_MODEL + 4 * lane + 256 * j) = va[j]; *(f32x4*)(h + (size_t)(row0 + 1) * D_MODEL + 4 * lane + 256 * j) = vb[j];
            u32x2 oa, ob; oa.x = cvt_pk_bf16(va[j][0], va[j][1]); oa.y = cvt_pk_bf16(va[j][2], va[j][3]); ob.x = cvt_pk_bf16(vb[j][0], vb[j][1]); ob.y = cvt_pk_bf16(vb[j][2], vb[j][3]);
            *(u32x2*)(hb + (size_t)row0 * D_MODEL + 4 * lane + 256 * j) = oa; *(u32x2*)(hb + (size_t)(row0 + 1) * D_MODEL + 4 * lane + 256 * j) = ob; }
#pragma unroll
        for (int p = 0; p < 18; ++p) {
            f32x2 a0 = {0.f, 0.f}, a1 = {0.f, 0.f};
#pragma unroll
            for (int j = 0; j < 4; ++j) { const f32x4 w0 = *(const LAS f32x4*)(Wl + (2 * p) * D_MODEL + 4 * lane + 256 * j), w1 = *(const LAS f32x4*)(Wl + (2 * p + 1) * D_MODEL + 4 * lane + 256 * j);
#pragma unroll
                for (int i = 0; i < 4; ++i) { const f32x2 y = {va[j][i], vb[j][i]}; a0 = a0 + y * w0[i]; a1 = a1 + y * w1[i]; } }
            float ra2[2];
#pragma unroll
            for (int rr = 0; rr < 2; ++rr) {
                auto sw = __builtin_amdgcn_permlane32_swap(__float_as_uint(rr ? a0.y : a0.x), __float_as_uint(rr ? a1.y : a1.x), false, false);
                float v = __uint_as_float(sw[0]) + __uint_as_float(sw[1]);
                v = row16_sum(v); v += __shfl_xor(v, 16); ra2[rr] = v; }
            if ((lane & 31) == 0) { const int ci = 2 * p + (lane >> 5); lgs[ci] = ra2[0]; lgs[40 + ci] = ra2[1]; }
            __builtin_amdgcn_sched_barrier(0);
        }
        asm volatile("s_waitcnt lgkmcnt(0)" ::: "memory");
        if (lane == 0 || lane == 32) {
            const int rr = lane >> 5; LAS float* lg = lgs + rr * 40;
            float gl[4];
#pragma unroll
            for (int jj = 0; jj < 4; ++jj) gl[jj] = lg[jj] + brg[jj];
            int gs = 0; float gmax = gl[0];
#pragma unroll
            for (int jj = 1; jj < 4; ++jj) if (gl[jj] > gmax) { gmax = gl[jj]; gs = jj; }
            float den = 0.f;
#pragma unroll
            for (int jj = 0; jj < 4; ++jj) den += expf(gl[jj] - gmax);
            const float gwt = 1.f / den;
            float el[8];
#pragma unroll
            for (int jj = 0; jj < 8; ++jj) el[jj] = lg[4 + gs * 8 + jj] + bre[gs * 8 + jj];
            int i0 = 0; float v0 = el[0];
#pragma unroll
            for (int jj = 1; jj < 8; ++jj) if (el[jj] > v0) { v0 = el[jj]; i0 = jj; }
            int i1 = -1; float v1 = 0.f;
#pragma unroll
            for (int jj = 0; jj < 8; ++jj) if (jj != i0 && (i1 < 0 || el[jj] > v1)) { v1 = el[jj]; i1 = jj; }
            const float e1 = expf(v1 - v0);
            const float w0 = gwt / (1.f + e1), w1 = gwt * e1 / (1.f + e1);
            const int ea = gs * 8 + i0, eb = gs * 8 + i1;
            const int pa = __hip_atomic_fetch_add(lcnt + ea, 1, __ATOMIC_RELAXED, __HIP_MEMORY_SCOPE_WORKGROUP), pb2 = __hip_atomic_fetch_add(lcnt + eb, 1, __ATOMIC_RELAXED, __HIP_MEMORY_SCOPE_WORKGROUP);
            LAS int* ri = rinfo + ((it * NWAVES + wave) * 2 + rr) * 5;
            ri[0] = ea | (eb << 8); ri[1] = pa; ri[2] = pb2; ri[3] = __float_as_int(w0); ri[4] = __float_as_int(w1);
        }
    }
    __syncthreads();
    if (tid < 32) { const int n = lcnt[tid]; unsigned* cnt = (unsigned*)(ws + WS_CTL) + CW_CNT + cidx * 32; lcnt[32 + tid] = n ? (int)atomicAdd(&cnt[tid], (unsigned)n) : 0; }
    __syncthreads();
    for (int sl = tid; sl < it * NWAVES * 2; sl += 512) {
        const int i2 = sl / (NWAVES * 2), w2 = (sl >> 1) & (NWAVES - 1), rr = sl & 1;
        const int row = ((blockIdx.x * NWAVES + w2) + i2 * NGW) * 2 + rr;
        if (row < NTOK) { const LAS int* ri = rinfo + sl * 5; const int ea = ri[0] & 255, eb = ri[0] >> 8;
            moe[MO_TOK_E + row * 2] = ea; moe[MO_TOK_E + row * 2 + 1] = eb; moe[MO_TOK_POS + row * 2] = lcnt[32 + ea] + ri[1]; moe[MO_TOK_POS + row * 2 + 1] = lcnt[32 + eb] + ri[2];
            moe[MO_TOK_W + row * 2] = ri[3]; moe[MO_TOK_W + row * 2 + 1] = ri[4]; }
    }
}

__device__ __forceinline__ void phase_moe_prep(KP P, int L, LAS unsigned char* lds) {
    int tz = threadIdx.x; asm volatile("" : "+v"(tz));
    const int tid = tz;
    unsigned char* ws = P->ws; int* moe = (int*)(ws + WS_MOE);
    const unsigned* cnt = (const unsigned*)(ws + WS_CTL) + CW_CNT + L * 32;
    LAS int* sb = (LAS int*)lds;
    LAS int* sc = (LAS int*)lds + 64;
    if (tid < 32) sc[tid] = (int)cnt[tid];
    __syncthreads();
    if (tid == 0) { int s = 0; for (int e = 0; e < N_EXPERTS; ++e) { sb[e] = s; s += (sc[e] + 255) / 256 * 256; } sb[N_EXPERTS] = s; }
    __syncthreads();
    const int ntiles = sb[N_EXPERTS] / 256;
    if (blockIdx.x == 0) {
        if (tid == 0) *((unsigned*)(ws + WS_CTL) + CW_NTILES + L) = (unsigned)ntiles;
        for (int T = tid; T < ntiles; T += 512) {
            const int r = T * 256; int e = 0;
            for (int x = 0; x < N_EXPERTS; ++x) if (r >= sb[x] && r < sb[x + 1]) e = x;
            const int nv = sc[e] - (r - sb[e]);
            moe[MO_TILE_E + T] = e; moe[MO_TILE_ROW0 + T] = r; moe[MO_TILE_NV + T] = nv < 256 ? nv : 256;
        }
    }
    for (int a = blockIdx.x * 512 + tid; a < NTOK * 2; a += gridDim.x * 512) {
        const int slot = sb[moe[MO_TOK_E + a]] + moe[MO_TOK_POS + a];
        moe[MO_SLOT_TOK + slot] = a >> 1; moe[MO_TOK_SLOT + a] = slot;
    }
}


namespace mb {
typedef short s16x4 __attribute__((ext_vector_type(4)));
typedef float f32x16 __attribute__((ext_vector_type(16)));
constexpr int SHM_V = 64 * 128 * 2, SHM_K = 64 * 128 * 2, V_OFF = 0, K_OFF = 2 * SHM_V, PRE_OFF = 65536;
constexpr float SCALE = 0.08838834764831845f, LOG2E = 1.4426950408889634f, CC = SCALE * LOG2E, THRX = 8.f * LOG2E;
#define MB_KSWZ(row, colB) ((row) * 256 + ((colB) ^ (((row) & 7) << 4)))
__device__ __forceinline__ int v_st(int k, int c) { const int kk = (k & ~0xC) | ((k & 4) << 1) | ((k & 8) >> 1); return ((kk >> 3) * 4 + (c >> 5)) * 512 + ((kk & 7) * 32 + (c & 31)) * 2; }
__device__ __forceinline__ int v_rd_base(int lane) { return ((lane & 3) << 3) | (((lane >> 2) & 3) << 6) | (((lane >> 4) & 1) << 5) | (((lane >> 5) & 1) << 8); }
constexpr int v_rd_off(int d0, int ks, int half) { return d0 * 512 + ks * 4096 + half * 2048; }
template <int OFF> __device__ __forceinline__ s16x4 tr_read(int vb) { s16x4 r; asm volatile("ds_read_b64_tr_b16 %0, %1 offset:%2" : "=&v"(r) : "v"(vb), "i"(OFF) : "memory"); return r; }
#define MB_SBAR() __builtin_amdgcn_sched_barrier(0)

__device__ __forceinline__ void qkt(f32x16& p0, f32x16& p1, LAS unsigned char* Ks, const bf16x8 (&qr)[8], int r32, int hi) {
    p0 = f32x16{}; p1 = f32x16{};
#pragma unroll
    for (int d0 = 0; d0 < 8; ++d0) { const int cb = (d0 * 16 + hi * 8) * 2;
        const bf16x8 b0 = *(const LAS bf16x8*)(Ks + MB_KSWZ(r32, cb));
        const bf16x8 b1 = *(const LAS bf16x8*)(Ks + MB_KSWZ(32 + r32, cb));
        p0 = __builtin_amdgcn_mfma_f32_32x32x16_bf16(b0, qr[d0], p0, 0, 0, 0);
        p1 = __builtin_amdgcn_mfma_f32_32x32x16_bf16(b1, qr[d0], p1, 0, 0, 0); }
}
__device__ __forceinline__ void partialSM(f32x16& p0, f32x16& p1, float& m_reg, float& mn, float& alpha, float bias2, float tb4, bool own, int lim) {
#pragma unroll
    for (int r = 0; r < 16; ++r) { const float kc = (float)((r & 3) + 8 * (r >> 2));
        p0[r] = fmaf(p0[r], CC, fmaf(bias2, kc, tb4)); p1[r] = fmaf(p1[r], CC, fmaf(bias2, kc + 32.f, tb4)); }
    if (own) {
#pragma unroll
        for (int r = 0; r < 16; ++r) { const int kc = (r & 3) + 8 * (r >> 2); if (kc > lim) p0[r] = -INFINITY; if (kc + 32 > lim) p1[r] = -INFINITY; }
    }
    float pmax = p0[0];
#pragma unroll
    for (int r = 1; r < 16; ++r) pmax = fmaxf(pmax, p0[r]);
#pragma unroll
    for (int r = 0; r < 16; ++r) pmax = fmaxf(pmax, p1[r]);
    { auto rr = __builtin_amdgcn_permlane32_swap(__float_as_uint(pmax), __float_as_uint(pmax), false, false); pmax = fmaxf(__uint_as_float(rr[0]), __uint_as_float(rr[1])); }
    if (__builtin_expect(__all(pmax - m_reg <= THRX), 1)) { mn = m_reg; alpha = 1.f; }
    else { mn = fmaxf(m_reg, pmax); alpha = __builtin_amdgcn_exp2f(m_reg - mn); m_reg = mn; }
#pragma unroll
    for (int r = 0; r < 16; ++r) { p0[r] = p0[r] - mn; p1[r] = p1[r] - mn; }
#pragma unroll
    for (int r = 0; r < 16; ++r) p0[r] = __builtin_amdgcn_exp2f(p0[r]);
}
__device__ __forceinline__ void finishSM(f32x16& p0, f32x16& p1, float alpha, float& l_reg, bf16x8& pa0, bf16x8& pa1, bf16x8& pa2, bf16x8& pa3) {
#pragma unroll
    for (int r = 0; r < 16; ++r) p1[r] = __builtin_amdgcn_exp2f(p1[r]);
    float ps = 0.f;
#pragma unroll
    for (int r = 0; r < 16; ++r) ps += p0[r];
#pragma unroll
    for (int r = 0; r < 16; ++r) ps += p1[r];
    { auto rr = __builtin_amdgcn_permlane32_swap(__float_as_uint(ps), __float_as_uint(ps), false, false); ps = __uint_as_float(rr[0]) + __uint_as_float(rr[1]); }
    l_reg = l_reg * alpha + ps;
#define MB_PK4(P, BASE, OUT) do { unsigned a0 = cvt_pk_bf16(P[BASE + 0], P[BASE + 1]), a1 = cvt_pk_bf16(P[BASE + 2], P[BASE + 3]); \
    unsigned b0 = cvt_pk_bf16(P[BASE + 4], P[BASE + 5]), b1 = cvt_pk_bf16(P[BASE + 6], P[BASE + 7]); \
    auto r0 = __builtin_amdgcn_permlane32_swap(a0, b0, false, false); auto r1 = __builtin_amdgcn_permlane32_swap(a1, b1, false, false); \
    u32x4 w = {r0[0], r1[0], r0[1], r1[1]}; OUT = *reinterpret_cast<bf16x8*>(&w); } while (0)
    MB_PK4(p0, 0, pa0); MB_PK4(p0, 8, pa1); MB_PK4(p1, 0, pa2); MB_PK4(p1, 8, pa3);
#undef MB_PK4
}
template <int D0> __device__ __forceinline__ void pv_one(f32x16& od, int vb, bf16x8 pa0, bf16x8 pa1, bf16x8 pa2, bf16x8 pa3) {
    const s16x4 l0 = tr_read<v_rd_off(D0, 0, 0)>(vb), h0 = tr_read<v_rd_off(D0, 0, 1)>(vb), l1 = tr_read<v_rd_off(D0, 1, 0)>(vb), h1 = tr_read<v_rd_off(D0, 1, 1)>(vb);
    const s16x4 l2 = tr_read<v_rd_off(D0, 2, 0)>(vb), h2 = tr_read<v_rd_off(D0, 2, 1)>(vb), l3 = tr_read<v_rd_off(D0, 3, 0)>(vb), h3 = tr_read<v_rd_off(D0, 3, 1)>(vb);
    asm volatile("s_waitcnt lgkmcnt(0)" ::: "memory"); MB_SBAR();
#define MB_PK(L, H) (bf16x8){L[0], L[1], L[2], L[3], H[0], H[1], H[2], H[3]}
    od = __builtin_amdgcn_mfma_f32_32x32x16_bf16(MB_PK(l0, h0), pa0, od, 0, 0, 0);
    od = __builtin_amdgcn_mfma_f32_32x32x16_bf16(MB_PK(l1, h1), pa1, od, 0, 0, 0);
    od = __builtin_amdgcn_mfma_f32_32x32x16_bf16(MB_PK(l2, h2), pa2, od, 0, 0, 0);
    od = __builtin_amdgcn_mfma_f32_32x32x16_bf16(MB_PK(l3, h3), pa3, od, 0, 0, 0);
#undef MB_PK
}
__device__ __forceinline__ void pv_d0(f32x16 (&o)[4], int vb, bf16x8 pa0, bf16x8 pa1, bf16x8 pa2, bf16x8 pa3) {
    pv_one<0>(o[0], vb, pa0, pa1, pa2, pa3); pv_one<1>(o[1], vb, pa0, pa1, pa2, pa3); pv_one<2>(o[2], vb, pa0, pa1, pa2, pa3); pv_one<3>(o[3], vb, pa0, pa1, pa2, pa3);
}

__device__ __forceinline__ void item(const bf16* __restrict__ q, const bf16* __restrict__ kv, bf16* __restrict__ part_o, float* __restrict__ part_ml, LAS unsigned char* lds,
                                     int tid, int b, int g, int kblk, int NT, bool own, int t, int rh, int slot, bool valid) {
    const int lane = tid & 63, r32 = lane & 31, hi = lane >> 5;
    const int h = g * 4 + rh;
    const bf16* Kh = kv + (size_t)(b * SEQ + kblk * MOBA_BLOCK) * 512 + g * HEAD_DIM;
    float m_reg = -1e30f, l_reg = 0.f; f32x16 o[4] = {}; bf16x8 qr[8];
    { const bf16* Qw = q + (size_t)(b * SEQ + t) * D_MODEL + h * HEAD_DIM + hi * 8;
#pragma unroll
      for (int d0 = 0; d0 < 8; ++d0) qr[d0] = *(const bf16x8*)(Qw + d0 * 16); }
    const float bias2 = __builtin_amdgcn_exp2f(-(float)(h + 1)) * LOG2E;
    const int trel = t - kblk * MOBA_BLOCK;
    const float tb4 = bias2 * (float)(4 * hi - trel);
    const int lim0 = trel - 4 * hi;
    const int sr = tid >> 4, sc = (tid & 15) * 8, vst0 = v_st(sr, sc), vst1 = v_st(32 + sr, sc);
    const int vb0 = (int)(unsigned)(uintptr_t)(lds + V_OFF) + v_rd_base(lane);
    bf16x8 vsA0, vsA1, ksA0, ksA1, vsB0, vsB1, ksB0, ksB1;
    const unsigned vo0 = (unsigned)(sr * 512 + sc) * 2u, vo1 = vo0 + 32u * 1024u;
    const char* KhB = (const char*)Kh;
#define MB_SLOAD_A(k0) do { const char* kt_ = KhB + (size_t)(k0) * 1024; vsA0 = *(const bf16x8*)(kt_ + 512 + vo0); vsA1 = *(const bf16x8*)(kt_ + 512 + vo1); \
        ksA0 = *(const bf16x8*)(kt_ + vo0); ksA1 = *(const bf16x8*)(kt_ + vo1); } while (0)
#define MB_SLOAD_B(k0) do { const char* kt_ = KhB + (size_t)(k0) * 1024; vsB0 = *(const bf16x8*)(kt_ + 512 + vo0); vsB1 = *(const bf16x8*)(kt_ + 512 + vo1); \
        ksB0 = *(const bf16x8*)(kt_ + vo0); ksB1 = *(const bf16x8*)(kt_ + vo1); } while (0)
#define MB_SWRITE(bb, V0, V1, K0, K1) do { *(LAS bf16x8*)(lds + V_OFF + (bb) * SHM_V + vst0) = V0; *(LAS bf16x8*)(lds + V_OFF + (bb) * SHM_V + vst1) = V1; \
        *(LAS bf16x8*)(lds + K_OFF + (bb) * SHM_K + MB_KSWZ(sr, sc * 2)) = K0; *(LAS bf16x8*)(lds + K_OFF + (bb) * SHM_K + MB_KSWZ(32 + sr, sc * 2)) = K1; } while (0)
#define MB_SWAIT() asm volatile("s_waitcnt vmcnt(4)" ::: "memory")
#define MB_RESC(a) do { if (__any((a) < 1.f)) { _Pragma("unroll") for (int d = 0; d < 4; ++d) _Pragma("unroll") for (int r = 0; r < 16; ++r) o[d][r] *= (a); } } while (0)
#define MB_PSM(P0, P1, MN, AL, tile) partialSM(P0, P1, m_reg, MN, AL, bias2, tb4 + bias2 * (float)((tile) * 64), own, lim0 - (tile) * 64)
    f32x16 pA0, pA1, pB0, pB1; float mnA, mnB, alA, alB; bf16x8 pa0, pa1, pa2, pa3;
    MB_SLOAD_A(0); asm volatile("s_waitcnt vmcnt(0)" ::: "memory"); MB_SWRITE(0, vsA0, vsA1, ksA0, ksA1); __syncthreads();
    qkt(pA0, pA1, lds + K_OFF, qr, r32, hi); MB_PSM(pA0, pA1, mnA, alA, 0);
    MB_SLOAD_B(64); if (2 < NT) MB_SLOAD_A(128);
    MB_SWAIT(); MB_SWRITE(1, vsB0, vsB1, ksB0, ksB1); __syncthreads();
    for (int j = 1; j + 1 < NT; j += 2) {
        MB_SBAR(); qkt(pB0, pB1, lds + K_OFF + SHM_K, qr, r32, hi);
        finishSM(pA0, pA1, alA, l_reg, pa0, pa1, pa2, pa3); MB_SBAR();
        MB_SLOAD_B((j + 2) * 64); MB_SBAR();
        pv_d0(o, vb0, pa0, pa1, pa2, pa3); MB_PSM(pB0, pB1, mnB, alB, j);
        __syncthreads(); MB_SWAIT(); MB_SWRITE(0, vsA0, vsA1, ksA0, ksA1);
        MB_RESC(alB); __syncthreads();
        MB_SBAR(); qkt(pA0, pA1, lds + K_OFF, qr, r32, hi);
        finishSM(pB0, pB1, alB, l_reg, pa0, pa1, pa2, pa3); MB_SBAR();
        if (j + 3 < NT) MB_SLOAD_A((j + 3) * 64); MB_SBAR();
        pv_d0(o, vb0 + SHM_V, pa0, pa1, pa2, pa3); MB_PSM(pA0, pA1, mnA, alA, j + 1);
        __syncthreads(); MB_SWAIT(); MB_SWRITE(1, vsB0, vsB1, ksB0, ksB1);
        MB_RESC(alA); __syncthreads();
    }
    MB_SBAR(); qkt(pB0, pB1, lds + K_OFF + SHM_K, qr, r32, hi);
    finishSM(pA0, pA1, alA, l_reg, pa0, pa1, pa2, pa3); MB_SBAR();
    pv_d0(o, vb0, pa0, pa1, pa2, pa3); MB_PSM(pB0, pB1, mnB, alB, NT - 1);
    __syncthreads(); MB_RESC(alB);
    finishSM(pB0, pB1, alB, l_reg, pa0, pa1, pa2, pa3); MB_SBAR();
    pv_d0(o, vb0 + SHM_V, pa0, pa1, pa2, pa3);
    if (valid) {
        const float inv = 1.f / l_reg;
        const size_t rg = ((size_t)(b * SEQ + t) * N_HEADS + h) * 4 + slot;
        bf16* po = part_o + rg * HEAD_DIM + 4 * hi;
#pragma unroll
        for (int d0 = 0; d0 < 4; ++d0)
#pragma unroll
            for (int rq = 0; rq < 4; ++rq) { u32x2 w; w.x = cvt_pk_bf16(o[d0][rq * 4 + 0] * inv, o[d0][rq * 4 + 1] * inv); w.y = cvt_pk_bf16(o[d0][rq * 4 + 2] * inv, o[d0][rq * 4 + 3] * inv);
                *(u32x2*)(po + d0 * 32 + rq * 8) = w; }
        if (hi == 0) { f32x2 ml; ml.x = m_reg; ml.y = l_reg; *(f32x2*)(part_ml + rg * 2) = ml; }
    }
    __syncthreads();
#undef MB_SLOAD_A
#undef MB_SLOAD_B
#undef MB_SWRITE
#undef MB_SWAIT
#undef MB_RESC
#undef MB_PSM
}
}

constexpr size_t WS_SELB = WS_T;
constexpr size_t WS_PML = WS_T + 2 * MiB;
constexpr size_t WS_LISTS = WS_T + 16 * MiB;
constexpr size_t WS_PARTO = WS_SCORES;
constexpr int CW_LCNT = 16384 + 512;

__device__ __forceinline__ void phase_kmeans(KP P) {
    int tz = threadIdx.x; asm volatile("" : "+v"(tz)); const int tid = tz;
    const bf16* kv = (const bf16*)(P->ws + WS_KV); float* km = (float*)(P->ws + WS_KM);
    for (int it = blockIdx.x; it < BATCH * N_KV * N_BLOCKS; it += gridDim.x) {
        const int blk = it % N_BLOCKS, g = (it / N_BLOCKS) % N_KV, b = it / (N_BLOCKS * N_KV);
        if (tid < HEAD_DIM) { float s = 0.f;
            for (int i = 0; i < MOBA_BLOCK; ++i) s += bf2f(kv[(size_t)(b * SEQ + blk * MOBA_BLOCK + i) * 512 + g * HEAD_DIM + tid]);
            const float mval = s * (1.f / MOBA_BLOCK); km[(size_t)it * HEAD_DIM + tid] = mval;
            const unsigned hi16 = cvt_pk_bf16(mval, 0.f) & 0xffffu; const float rem = mval - bflo(hi16);
            bf16* kmh = (bf16*)(km + 65536); kmh[(size_t)it * HEAD_DIM + tid] = (bf16)hi16; kmh[(size_t)(BATCH * N_KV * N_BLOCKS + it) * HEAD_DIM + tid] = (bf16)(cvt_pk_bf16(rem, 0.f) & 0xffffu); }
    }
}
__device__ __forceinline__ void phase_moba_gate(KP P, LAS unsigned char* lds) {
    int tz = threadIdx.x; asm volatile("" : "+v"(tz)); const int tid = tz, lane = tid & 63, wave = tid >> 6;
    const bf16* q = (const bf16*)(P->ws + WS_QKVI); const float* km = (const float*)(P->ws + WS_KM); unsigned char* selb = (unsigned char*)(P->ws + WS_SELB);
    LAS float* qs = (LAS float*)(lds + wave * 2048);
    const int blk = lane & 31, half = lane >> 5;
    for (int it = blockIdx.x * NWAVES + wave; it < NTOK * 2; it += gridDim.x * NWAVES) {
        const int tok = it >> 1, g = it & 1, b = tok / SEQ, t = tok % SEQ, own = t >> 8;
        unsigned char* sb = selb + ((size_t)tok * 8 + g * 4) * 4;
        if (own < 3) { if (lane < 4) { for (int s2 = own; s2 < 3; ++s2) sb[lane * 4 + s2] = 0xFF; } }
        if (own == 0) continue;
        { const u32x4 w = *(const u32x4*)(q + (size_t)tok * D_MODEL + g * 512 + lane * 8);
          LAS float* d = qs + lane * 8;
          d[0] = bflo(w.x); d[1] = bfhi(w.x); d[2] = bflo(w.y); d[3] = bfhi(w.y); d[4] = bflo(w.z); d[5] = bfhi(w.z); d[6] = bflo(w.w); d[7] = bfhi(w.w); }
        asm volatile("s_waitcnt lgkmcnt(0)" ::: "memory");
        float acc[4] = {0.f, 0.f, 0.f, 0.f};
        const float* kp = km + ((size_t)(b * N_KV + g) * N_BLOCKS + blk) * HEAD_DIM + half * 64;
#pragma unroll 4
        for (int i = 0; i < 16; ++i) { const f32x4 kk = *(const f32x4*)(kp + 4 * i);
#pragma unroll
            for (int r = 0; r < 4; ++r) { const f32x4 qq = *(const LAS f32x4*)(qs + r * 128 + half * 64 + 4 * i); acc[r] += (kk[0] * qq[0] + kk[1] * qq[1]) + (kk[2] * qq[2] + kk[3] * qq[3]); } }
#pragma unroll
        for (int r = 0; r < 4; ++r) { acc[r] += __shfl_xor(acc[r], 32); if (blk >= own) acc[r] = -INFINITY; }
        int rank[4] = {0, 0, 0, 0};
#pragma unroll
        for (int j = 0; j < 32; ++j) {
#pragma unroll
            for (int r = 0; r < 4; ++r) { const float vj = __uint_as_float(__builtin_amdgcn_readlane(__float_as_uint(acc[r]), j)); rank[r] += (vj > acc[r] || (vj == acc[r] && j < blk)) ? 1 : 0; }
        }
        if (half == 0 && blk < own) {
#pragma unroll
            for (int r = 0; r < 4; ++r) if (rank[r] < 3) sb[r * 4 + rank[r]] = (unsigned char)blk;
        }
    }
}

__device__ __forceinline__ void phase_moba_gate2(KP P) {
    typedef float f32x16 __attribute__((ext_vector_type(16)));
    int tz = threadIdx.x; asm volatile("" : "+v"(tz)); const int tid = tz, lane = tid & 63, wave = tid >> 6, r32 = lane & 31, hi = lane >> 5;
    const bf16* q = (const bf16*)(P->ws + WS_QKVI); const bf16* kmh = (const bf16*)((const float*)(P->ws + WS_KM) + 65536); unsigned char* selb = (unsigned char*)(P->ws + WS_SELB);
    const int gw = blockIdx.x * NWAVES + wave, NGW = gridDim.x * NWAVES;
    int cur_bg = -1; bf16x8 ah[8], al[8];
    for (int tile = gw * 4; tile < 8192; tile += NGW * 4) {
#pragma unroll 1
        for (int sub = 0; sub < 4; ++sub) {
            const int tl = tile + sub, bg = tl >> 10, b = bg >> 1, g = bg & 1, rt = tl & 1023;
            if (bg != cur_bg) { cur_bg = bg;
                const bf16* kp = kmh + ((size_t)(b * N_KV + g) * N_BLOCKS + r32) * HEAD_DIM + 8 * hi;
#pragma unroll
                for (int ks = 0; ks < 8; ++ks) { ah[ks] = *(const bf16x8*)(kp + 16 * ks); al[ks] = *(const bf16x8*)(kp + (size_t)BATCH * N_KV * N_BLOCKS * HEAD_DIM + 16 * ks); } }
            const int row = rt * 32 + r32, t = row >> 2, rh = row & 3, own = t >> 8, tok = b * SEQ + t;
            const bf16* qp = q + (size_t)tok * D_MODEL + (g * 4 + rh) * HEAD_DIM + 8 * hi;
            f32x16 acc = {};
#pragma unroll
            for (int ks = 0; ks < 8; ++ks) { const bf16x8 qv = *(const bf16x8*)(qp + 16 * ks);
                acc = __builtin_amdgcn_mfma_f32_32x32x16_bf16(ah[ks], qv, acc, 0, 0, 0); acc = __builtin_amdgcn_mfma_f32_32x32x16_bf16(al[ks], qv, acc, 0, 0, 0); }
            float v[16];
#pragma unroll
            for (int r = 0; r < 16; ++r) { const int blk = (r & 3) + 8 * (r >> 2) + 4 * hi; v[r] = (blk < own) ? acc[r] : -INFINITY; }
            float bv[3]; int bi[3];
#pragma unroll
            for (int p = 0; p < 3; ++p) { float best = -INFINITY; int br = -1;
#pragma unroll
                for (int r = 0; r < 16; ++r) { if (v[r] > best) { best = v[r]; br = r; } }
                bv[p] = best; bi[p] = (br < 0) ? 255 : ((br & 3) + 8 * (br >> 2) + 4 * hi);
#pragma unroll
                for (int r = 0; r < 16; ++r) { if (r == br) v[r] = -INFINITY; } }
            float ov[3]; int oi[3];
#pragma unroll
            for (int p = 0; p < 3; ++p) { ov[p] = __shfl_xor(bv[p], 32); oi[p] = __shfl_xor(bi[p], 32); }
            int ia = 0, ib = 0; int res[3];
#pragma unroll
            for (int p = 0; p < 3; ++p) {
                const float va = (ia == 0) ? bv[0] : (ia == 1) ? bv[1] : (ia == 2) ? bv[2] : -INFINITY; const int xa = (ia == 0) ? bi[0] : (ia == 1) ? bi[1] : (ia == 2) ? bi[2] : 255;
                const float vb = (ib == 0) ? ov[0] : (ib == 1) ? ov[1] : (ib == 2) ? ov[2] : -INFINITY; const int xb = (ib == 0) ? oi[0] : (ib == 1) ? oi[1] : (ib == 2) ? oi[2] : 255;
                const bool takeA = (va > vb) || (va == vb && xa < xb);
                const float vv = takeA ? va : vb; const int xx = takeA ? xa : xb;
                res[p] = (vv > -INFINITY) ? xx : 255; if (takeA) ++ia; else ++ib; }
            if (hi == 0) { const unsigned w = (unsigned)res[0] | ((unsigned)res[1] << 8) | ((unsigned)res[2] << 16) | 0xFF000000u;
                *(unsigned*)(selb + ((size_t)tok * 8 + g * 4 + rh) * 4) = w; }
        }
    }
}

__device__ __forceinline__ void phase_moba_lists(KP P, LAS unsigned char* lds) {
    int tz = threadIdx.x; asm volatile("" : "+v"(tz)); const int tid = tz, lane = tid & 63, wave = tid >> 6;
    const u32x4* selb = (const u32x4*)(P->ws + WS_SELB); unsigned* lists = (unsigned*)(P->ws + WS_LISTS); unsigned* lcnt = (unsigned*)(P->ws + WS_CTL) + CW_LCNT;
    LAS int* wtot = (LAS int*)lds;
    for (int li = blockIdx.x; li < 256; li += gridDim.x) {
        const int j = li & 31, g = (li >> 5) & 1, b = li >> 6, base_t = (j + 1) * MOBA_BLOCK, n_t = SEQ - base_t;
        unsigned* out = lists + (size_t)li * 32768;
        int running = 0;
        for (int i0 = 0; i0 < n_t; i0 += 512) {
            const int ti = i0 + tid; const bool ok = ti < n_t; const int t = base_t + ti;
            u32x4 w = {0xFFFFFFFFu, 0xFFFFFFFFu, 0xFFFFFFFFu, 0xFFFFFFFFu};
            if (ok) w = selb[((size_t)(b * SEQ + t) * 8 + g * 4) / 4];
            int ms[4];
#pragma unroll
            for (int r = 0; r < 4; ++r) { const unsigned x = w[r]; ms[r] = ((x & 0xFFu) == (unsigned)j) ? 0 : (((x >> 8) & 0xFFu) == (unsigned)j) ? 1 : (((x >> 16) & 0xFFu) == (unsigned)j) ? 2 : -1; }
            const int c = (ms[0] >= 0) + (ms[1] >= 0) + (ms[2] >= 0) + (ms[3] >= 0);
            int inc = c;
#pragma unroll
            for (int o = 1; o < 64; o <<= 1) { const int v = __shfl_up(inc, o); if (lane >= o) inc += v; }
            __syncthreads();
            if (lane == 63) wtot[wave] = inc;
            __syncthreads();
            int woff = 0, tot = 0;
#pragma unroll
            for (int x = 0; x < NWAVES; ++x) { const int v = wtot[x]; if (x < wave) woff += v; tot += v; }
            int pos = running + woff + inc - c;
#pragma unroll
            for (int r = 0; r < 4; ++r) if (ms[r] >= 0) out[pos++] = (unsigned)t | ((unsigned)r << 13) | ((unsigned)ms[r] << 15);
            running += tot;
        }
        if (tid == 0) lcnt[li] = (unsigned)running;
        __syncthreads();
    }
}
__device__ __forceinline__ void phase_moba_attn(KP P, LAS unsigned char* lds) {
    int tz = threadIdx.x; asm volatile("" : "+v"(tz)); const int tid = tz, lane = tid & 63, wave = tid >> 6;
    const bf16* q = (const bf16*)(P->ws + WS_QKVI); const bf16* kv = (const bf16*)(P->ws + WS_KV);
    bf16* part_o = (bf16*)(P->ws + WS_PARTO); float* part_ml = (float*)(P->ws + WS_PML);
    const unsigned* lists = (const unsigned*)(P->ws + WS_LISTS); const unsigned* lcnt = (const unsigned*)(P->ws + WS_CTL) + CW_LCNT;
    LAS int* pre = (LAS int*)(lds + mb::PRE_OFF);
    LAS int* cn = pre + 260;
    if (tid < 256) cn[tid] = (int)lcnt[tid];
    __syncthreads();
    if (tid == 0) { int s = 0; for (int i = 0; i < 256; ++i) { pre[i] = s; s += (cn[i] + 255) >> 8; } pre[256] = s; }
    __syncthreads();
    const int npast = pre[256], total = npast + 1024;
    for (int it = blockIdx.x; it < total; it += gridDim.x) {
        int b, g, kblk, NT, t, rh, slot; bool own, valid;
        const int ri = wave * 32 + (lane & 31);
        if (it < npast) {
            int lo = 0, hi = 256;
            while (hi - lo > 1) { const int mid = (lo + hi) >> 1; if (pre[mid] <= it) lo = mid; else hi = mid; }
            const int li = lo, chunk = it - pre[li], n = cn[li];
            kblk = li & 31; g = (li >> 5) & 1; b = li >> 6; NT = 4; own = false;
            int idx = chunk * 256 + ri; valid = idx < n; if (!valid) idx = chunk * 256;
            const unsigned e = lists[(size_t)li * 32768 + idx];
            t = (int)(e & 0x1FFFu); rh = (int)((e >> 13) & 3u); slot = (int)((e >> 15) & 3u);
        } else {
            const int oi = it - npast, chunk = oi & 3, bi = oi >> 2;
            kblk = bi & 31; g = (bi >> 5) & 1; b = bi >> 6; NT = chunk < 2 ? 2 : 4; own = true; valid = true;
            t = kblk * MOBA_BLOCK + chunk * 64 + (ri >> 2); rh = ri & 3; slot = 3;
        }
        mb::item(q, kv, part_o, part_ml, lds, tid, b, g, kblk, NT, own, t, rh, slot, valid);
    }
}

namespace mb {
constexpr int SEG_K = 0, SEG_V = 65536, SEG_PRE = 131072, SEGC = 8;
__device__ __forceinline__ void stage_block(const bf16* __restrict__ kv, LAS unsigned char* lds, int tid, int b, int g, int kblk) {
    const char* KhB = (const char*)(kv + (size_t)(b * SEQ + kblk * MOBA_BLOCK) * 512 + g * HEAD_DIM);
    const int sr = tid >> 4, sc = (tid & 15) * 8, vst0 = v_st(sr, sc), vst1 = v_st(32 + sr, sc);
    const unsigned vo0 = (unsigned)(sr * 512 + sc) * 2u, vo1 = vo0 + 32u * 1024u;
#pragma unroll
    for (int h2 = 0; h2 < 2; ++h2) {
        bf16x8 kx[2][2], vx[2][2];
#pragma unroll
        for (int tt = 0; tt < 2; ++tt) { const char* kt_ = KhB + (size_t)((h2 * 2 + tt) * 64) * 1024;
            kx[tt][0] = *(const bf16x8*)(kt_ + vo0); kx[tt][1] = *(const bf16x8*)(kt_ + vo1); vx[tt][0] = *(const bf16x8*)(kt_ + 512 + vo0); vx[tt][1] = *(const bf16x8*)(kt_ + 512 + vo1); }
#pragma unroll
        for (int tt = 0; tt < 2; ++tt) { const int tile = h2 * 2 + tt;
            *(LAS bf16x8*)(lds + SEG_K + tile * SHM_K + MB_KSWZ(sr, sc * 2)) = kx[tt][0]; *(LAS bf16x8*)(lds + SEG_K + tile * SHM_K + MB_KSWZ(32 + sr, sc * 2)) = kx[tt][1];
            *(LAS bf16x8*)(lds + SEG_V + tile * SHM_V + vst0) = vx[tt][0]; *(LAS bf16x8*)(lds + SEG_V + tile * SHM_V + vst1) = vx[tt][1]; }
    }
}
__device__ __forceinline__ void chunk_rows(const bf16* __restrict__ q, bf16* __restrict__ part_o, float* __restrict__ part_ml, LAS unsigned char* lds, int lane,
                                           int b, int g, int kblk, int NT, bool own, int t, int rh, int slot, bool valid) {
    const int r32 = lane & 31, hi = lane >> 5, h = g * 4 + rh;
    float m_reg = -1e30f, l_reg = 0.f; f32x16 o[4] = {}; bf16x8 qr[8];
    { const bf16* Qw = q + (size_t)(b * SEQ + t) * D_MODEL + h * HEAD_DIM + hi * 8;
#pragma unroll
      for (int d0 = 0; d0 < 8; ++d0) qr[d0] = *(const bf16x8*)(Qw + d0 * 16); }
    const float bias2 = __builtin_amdgcn_exp2f(-(float)(h + 1)) * LOG2E;
    const int trel = t - kblk * MOBA_BLOCK;
    const float tb4 = bias2 * (float)(4 * hi - trel);
    const int lim0 = trel - 4 * hi;
    const int vb0 = (int)(unsigned)(uintptr_t)(lds + SEG_V) + v_rd_base(lane);
    for (int tile = 0; tile < NT; ++tile) {
        f32x16 p0, p1; float mn, al; bf16x8 pa0, pa1, pa2, pa3;
        qkt(p0, p1, lds + SEG_K + tile * SHM_K, qr, r32, hi);
        partialSM(p0, p1, m_reg, mn, al, bias2, tb4 + bias2 * (float)(tile * 64), own, lim0 - tile * 64);
        if (__any(al < 1.f)) {
#pragma unroll
            for (int d = 0; d < 4; ++d)
#pragma unroll
                for (int r = 0; r < 16; ++r) o[d][r] *= al; }
        finishSM(p0, p1, al, l_reg, pa0, pa1, pa2, pa3);
        pv_d0(o, vb0 + tile * SHM_V, pa0, pa1, pa2, pa3);
    }
    if (valid) {
        const float inv = 1.f / l_reg;
        const size_t rg = ((size_t)(b * SEQ + t) * N_HEADS + h) * 4 + slot;
        bf16* po = part_o + rg * HEAD_DIM + 4 * hi;
#pragma unroll
        for (int d0 = 0; d0 < 4; ++d0)
#pragma unroll
            for (int rq = 0; rq < 4; ++rq) { u32x2 w; w.x = cvt_pk_bf16(o[d0][rq * 4 + 0] * inv, o[d0][rq * 4 + 1] * inv); w.y = cvt_pk_bf16(o[d0][rq * 4 + 2] * inv, o[d0][rq * 4 + 3] * inv);
                *(u32x2*)(po + d0 * 32 + rq * 8) = w; }
        if (hi == 0) { f32x2 ml; ml.x = m_reg; ml.y = l_reg; *(f32x2*)(part_ml + rg * 2) = ml; }
    }
}
}
constexpr int CW_MQ = 20480;
__device__ __forceinline__ void phase_moba_attn2(KP P, int Lb, LAS unsigned char* lds) {
    int tz = threadIdx.x; asm volatile("" : "+v"(tz)); const int tid = tz, lane = tid & 63, wave = tid >> 6;
    const bf16* q = (const bf16*)(P->ws + WS_QKVI); const bf16* kv = (const bf16*)(P->ws + WS_KV);
    bf16* part_o = (bf16*)(P->ws + WS_PARTO); float* part_ml = (float*)(P->ws + WS_PML);
    const unsigned* lists = (const unsigned*)(P->ws + WS_LISTS); const unsigned* lcnt = (const unsigned*)(P->ws + WS_CTL) + CW_LCNT;
    unsigned* qhead = (unsigned*)(P->ws + WS_CTL) + CW_MQ + Lb * 64;
    LAS int* pre = (LAS int*)(lds + mb::SEG_PRE);
    LAS int* cn = pre + 260;
    LAS int* cur = pre + 520;
    if (tid < 256) cn[tid] = (int)lcnt[tid];
    __syncthreads();
    if (tid == 0) { int s2 = 0; for (int i = 0; i < 256; ++i) { pre[i] = s2; const int nch = (cn[i] + 255) >> 8; s2 += (nch + mb::SEGC - 1) / mb::SEGC; } pre[256] = s2; }
    __syncthreads();
    const int npast = pre[256], total = npast + 256;
    for (;;) {
        if (tid == 0) cur[0] = (int)__hip_atomic_fetch_add(qhead, 1u, __ATOMIC_RELAXED, __HIP_MEMORY_SCOPE_AGENT);
        __syncthreads();
        const int sg = cur[0];
        if (sg >= total) break;
        int b, g, kblk, li = 0, ch0, nch, n = 0; bool own;
        if (sg < npast) {
            int lo = 0, hi2 = 256;
            while (hi2 - lo > 1) { const int mid = (lo + hi2) >> 1; if (pre[mid] <= sg) lo = mid; else hi2 = mid; }
            li = lo; n = cn[li]; ch0 = (sg - pre[li]) * mb::SEGC; const int ncht = (n + 255) >> 8; nch = ncht - ch0 < mb::SEGC ? ncht - ch0 : mb::SEGC;
            kblk = li & 31; g = (li >> 5) & 1; b = li >> 6; own = false;
        } else { const int bi = sg - npast; kblk = bi & 31; g = (bi >> 5) & 1; b = bi >> 6; own = true; ch0 = 0; nch = 4; }
        mb::stage_block(kv, lds, tid, b, g, kblk);
        __syncthreads();
        const int ri = wave * 32 + (lane & 31);
        for (int c = 0; c < nch; ++c) {
            const int chunk = ch0 + c; int t, rh, slot, NT; bool valid;
            if (!own) { int idx = chunk * 256 + ri; valid = idx < n; if (!valid) idx = chunk * 256;
                const unsigned e = lists[(size_t)li * 32768 + idx];
                t = (int)(e & 0x1FFFu); rh = (int)((e >> 13) & 3u); slot = (int)((e >> 15) & 3u); NT = 4;
            } else { valid = true; t = kblk * MOBA_BLOCK + chunk * 64 + (ri >> 2); rh = ri & 3; slot = 3; NT = chunk + 1; }
            mb::chunk_rows(q, part_o, part_ml, lds, lane, b, g, kblk, NT, own, t, rh, slot, valid);
        }
        __syncthreads();
    }
}

__device__ __forceinline__ void phase_moba_combine(KP P) {
    int tz = threadIdx.x; asm volatile("" : "+v"(tz)); const int tid = tz;
    const bf16* part_o = (const bf16*)(P->ws + WS_PARTO); const float* part_ml = (const float*)(P->ws + WS_PML); bf16* attn = (bf16*)(P->ws + WS_ATTN);
    const int sub = tid & 15;
#pragma unroll 2
    for (int rg = (blockIdx.x * 512 + tid) >> 4; rg < NTOK * N_HEADS; rg += (gridDim.x * 512) >> 4) {
        const int tok = rg >> 3, own = (tok % SEQ) >> 8, nv = own < 3 ? own : 3;
        const float* ml = part_ml + (size_t)rg * 8;
        float m[4], l[4];
#pragma unroll
        for (int s2 = 0; s2 < 4; ++s2) { const bool ok = (s2 == 3) || (s2 < nv); m[s2] = ok ? ml[s2 * 2] : -INFINITY; l[s2] = ok ? ml[s2 * 2 + 1] : 0.f; }
        const float M = fmaxf(fmaxf(m[0], m[1]), fmaxf(m[2], m[3]));
        float w[4], W = 0.f;
#pragma unroll
        for (int s2 = 0; s2 < 4; ++s2) { w[s2] = l[s2] * __builtin_amdgcn_exp2f(m[s2] - M); W += w[s2]; }
        const float inv = 1.f / W;
        float acc[8] = {0.f, 0.f, 0.f, 0.f, 0.f, 0.f, 0.f, 0.f};
#pragma unroll
        for (int s2 = 0; s2 < 4; ++s2) {
            if ((s2 == 3) || (s2 < nv)) {
                const u32x4 v = *(const u32x4*)(part_o + ((size_t)rg * 4 + s2) * HEAD_DIM + sub * 8); const float ws2 = w[s2] * inv;
                acc[0] += ws2 * bflo(v.x); acc[1] += ws2 * bfhi(v.x); acc[2] += ws2 * bflo(v.y); acc[3] += ws2 * bfhi(v.y);
                acc[4] += ws2 * bflo(v.z); acc[5] += ws2 * bfhi(v.z); acc[6] += ws2 * bflo(v.w); acc[7] += ws2 * bfhi(v.w);
            }
        }
        u32x4 o; o.x = cvt_pk_bf16(acc[0], acc[1]); o.y = cvt_pk_bf16(acc[2], acc[3]); o.z = cvt_pk_bf16(acc[4], acc[5]); o.w = cvt_pk_bf16(acc[6], acc[7]);
        *(u32x4*)(attn + (size_t)rg * HEAD_DIM + sub * 8) = o;
    }
}


#ifndef D1_EXP
#define D1_EXP 0
#endif
constexpr int D1_QS = 4100, D1_SM = 32 * D1_QS, D1_SELIDX = D1_SM + 1024, D1_NT = 992;
__device__ __forceinline__ unsigned fkey2(float f) { const unsigned u = __float_as_uint(f); return (u & 0x80000000u) ? ~u : (u | 0x80000000u); }
template <int PASS, int EXP>
__device__ __forceinline__ void d1_scan(const bf16* __restrict__ ikb, int qt, int kt_end, int wave, int lane, const bf16x8 (&qb)[4][4], const float (&wv)[4], LAS unsigned char* lds, unsigned thr, float flo = 0.f, float finv = 0.f, unsigned bstar = 0) {
    typedef float f32x16 __attribute__((ext_vector_type(16)));
    const int r32 = lane & 31, hi = lane >> 5;
    LAS unsigned* hq = (LAS unsigned*)(lds + r32 * D1_QS);
    LAS unsigned* sm = (LAS unsigned*)(lds + D1_SM);
    bf16x8 ka[4];
    int kt = wave;
    if (kt <= kt_end) { const bf16* kp = ikb + (size_t)(kt * 32 + r32) * QLD + 8 * hi;
#pragma unroll
        for (int ks = 0; ks < 4; ++ks) ka[ks] = *(const bf16x8*)(kp + 16 * ks); }
    for (; kt <= kt_end; kt += 8) {
        bf16x8 kn[4];
#pragma unroll
        for (int ks = 0; ks < 4; ++ks) kn[ks] = ka[ks];
        if (kt + 8 <= kt_end) { const bf16* kp = ikb + (size_t)((kt + 8) * 32 + r32) * QLD + 8 * hi;
#pragma unroll
            for (int ks = 0; ks < 4; ++ks) kn[ks] = *(const bf16x8*)(kp + 16 * ks); }
        float sc[16];
#pragma unroll
        for (int r = 0; r < 16; ++r) sc[r] = 0.f;
#pragma unroll
        for (int h = 0; h < 4; ++h) { f32x16 acc = {};
#pragma unroll
            for (int ks = 0; ks < 4; ++ks) acc = __builtin_amdgcn_mfma_f32_32x32x16_bf16(ka[ks], qb[h][ks], acc, 0, 0, 0);
#pragma unroll
            for (int r = 0; r < 16; ++r) sc[r] = fmaf(wv[h], fmaxf(acc[r], 0.f), sc[r]); }
        int kbase = kt * 32 + 4 * hi; asm volatile("" : "+v"(kbase));
        const int lim = (kt == qt) ? (r32 - 4 * hi) : 64;
#pragma unroll
        for (int r = 0; r < 16; ++r) {
            const int kc = (r & 3) + 8 * (r >> 2);
            const bool valid = kc <= lim;
            const unsigned key = fkey2(sc[r]);
            if (PASS == 1) { if (EXP == 3) { if (key == 12345u) hq[0] = 1u; } else if (valid && EXP != 2) { const unsigned bin = key >> 21; (void)__hip_atomic_fetch_add(hq + (bin >> 1), 1u << (16 * (bin & 1)), __ATOMIC_RELAXED, __HIP_MEMORY_SCOPE_WORKGROUP); } }
            else if (PASS == 2) { if (valid && (key >> 21) == thr) { const unsigned bin = (key >> 10) & 2047u; (void)__hip_atomic_fetch_add(hq + (bin >> 1), 1u << (16 * (bin & 1)), __ATOMIC_RELAXED, __HIP_MEMORY_SCOPE_WORKGROUP); } }
            else if (PASS == 4) { if (valid && sc[r] >= flo) { unsigned bin = (unsigned)((sc[r] - flo) * finv); bin = bin > 2047u ? 2047u : bin; (void)__hip_atomic_fetch_add(hq + (bin >> 1), 1u << (16 * (bin & 1)), __ATOMIC_RELAXED, __HIP_MEMORY_SCOPE_WORKGROUP); } }
            else if (PASS == 5) { if (valid && sc[r] >= flo) { unsigned bin = (unsigned)((sc[r] - flo) * finv); bin = bin > 2047u ? 2047u : bin; const unsigned sidx = (unsigned)(kbase + kc);
                    if (bin > bstar) (void)__hip_atomic_fetch_or(hq + 512 + (sidx >> 5), 1u << (sidx & 31u), __ATOMIC_RELAXED, __HIP_MEMORY_SCOPE_WORKGROUP);
                    else if (bin == bstar) {
                        if (key == 0x80000000u) (void)__hip_atomic_fetch_or(hq + 768 + (sidx >> 5), 1u << (sidx & 31u), __ATOMIC_RELAXED, __HIP_MEMORY_SCOPE_WORKGROUP);
                        else { const unsigned cp = __hip_atomic_fetch_add(sm + 160 + r32, 1u, __ATOMIC_RELAXED, __HIP_MEMORY_SCOPE_WORKGROUP); if (cp < 256u) { hq[cp] = key; ((LAS unsigned short*)(hq + 256))[cp] = (unsigned short)sidx; } } } } }
            else { if (valid) { const unsigned p22 = key >> 10; const unsigned sidx = (unsigned)(kbase + kc);
                    if (p22 > thr) (void)__hip_atomic_fetch_or(hq + 512 + (sidx >> 5), 1u << (sidx & 31u), __ATOMIC_RELAXED, __HIP_MEMORY_SCOPE_WORKGROUP);
                    else if (p22 == thr) {
                        if (key == 0x80000000u) (void)__hip_atomic_fetch_or(hq + 768 + (sidx >> 5), 1u << (sidx & 31u), __ATOMIC_RELAXED, __HIP_MEMORY_SCOPE_WORKGROUP);
                        else { const unsigned cp = __hip_atomic_fetch_add(sm + 160 + r32, 1u, __ATOMIC_RELAXED, __HIP_MEMORY_SCOPE_WORKGROUP); if (cp < 256u) { hq[cp] = key; ((LAS unsigned short*)(hq + 256))[cp] = (unsigned short)sidx; } } } } }
        }
#pragma unroll
        for (int ks = 0; ks < 4; ++ks) ka[ks] = kn[ks];
    }
}
__device__ __forceinline__ bool d1_find(LAS unsigned* H, unsigned need, int lane, unsigned& bin_out, unsigned& above_out) {
    unsigned mine = 0;
#pragma unroll
    for (int i = 0; i < 16; ++i) { const unsigned w = H[lane * 16 + i]; mine += (w & 0xFFFFu) + (w >> 16); }
    unsigned inc = mine;
#pragma unroll
    for (int o = 1; o < 64; o <<= 1) { const unsigned v = __shfl_down(inc, o); if (lane + o < 64) inc += v; }
    const unsigned above = inc - mine; const bool found = (above < need) && (inc >= need);
    const unsigned long long bal = __ballot(found); const int src = bal ? (__ffsll((long long)bal) - 1) : 0;
    const unsigned ab0 = __shfl(above, src);
    unsigned cj = 0;
    if (lane < 32) { const int bidx = src * 32 + 31 - lane; const unsigned w = H[bidx >> 1]; cj = (bidx & 1) ? (w >> 16) : (w & 0xFFFFu); }
    unsigned inc2 = cj;
#pragma unroll
    for (int o = 1; o < 32; o <<= 1) { const unsigned v = __shfl_up(inc2, o); if (lane >= o) inc2 += v; }
    const bool hit = (lane < 32) && (ab0 + inc2 >= need) && (ab0 + inc2 - cj < need);
    const unsigned long long bal2 = __ballot(hit); const int l2 = bal2 ? (__ffsll((long long)bal2) - 1) : 0;
    bin_out = (unsigned)(src * 32 + 31 - l2); above_out = ab0 + __shfl(inc2 - cj, l2);
    return bal != 0ull;
}
template <int EXP>
__device__ __forceinline__ void phase_dsa_topk(KP P, LAS unsigned char* lds, size_t sel_off) {
    int tz = threadIdx.x; asm volatile("" : "+v"(tz)); const int tid = tz, lane = tid & 63, wave = tid >> 6, r32 = lane & 31, hi = lane >> 5;
    const bf16* qkvi = (const bf16*)(P->ws + WS_QKVI); const float* iw = (const float*)(P->ws + WS_IW); int* sel = (int*)(P->ws + sel_off);
    LAS unsigned* sm = (LAS unsigned*)(lds + D1_SM);
    const int G = gridDim.x, nrounds = (D1_NT + G - 1) / G;
    for (int rho = 0; rho < nrounds; ++rho) {
        const int pos = (rho & 1) ? (G - 1 - (int)blockIdx.x) : (int)blockIdx.x, i = rho * G + pos;
        if (i >= D1_NT) continue;
        const int qt = 255 - (i >> 2), b = i & 3, t0 = qt * 32, tok0 = b * SEQ + t0;
        for (int w = tid; w < (D1_SM + 1024) / 4; w += 512) ((LAS unsigned*)lds)[w] = 0u;
        bf16x8 qb[4][4]; float wv[4];
        { const bf16* qp = qkvi + (size_t)(tok0 + r32) * QLD + COL_IQ + 8 * hi;
#pragma unroll
          for (int h = 0; h < 4; ++h)
#pragma unroll
              for (int ks = 0; ks < 4; ++ks) qb[h][ks] = *(const bf16x8*)(qp + h * IDX_DIM + 16 * ks);
          const f32x4 w4 = *(const f32x4*)(iw + (size_t)(tok0 + r32) * 4); wv[0] = w4[0]; wv[1] = w4[1]; wv[2] = w4[2]; wv[3] = w4[3]; }
        const bf16* ikb = qkvi + (size_t)b * SEQ * QLD + COL_IK;
        __syncthreads();
        d1_scan<1, EXP>(ikb, qt, 7, wave, lane, qb, wv, lds, 0u);
        __syncthreads();
#pragma unroll 1
        for (int qq = 0; qq < 4; ++qq) { const int q = wave * 4 + qq; const unsigned n = (unsigned)(t0 + q + 1); unsigned klo = 196608u / n; klo = klo > 256u ? 256u : (klo < 1u ? 1u : klo);
            unsigned bs, ab, bmx, ab2; const bool ok1 = d1_find((LAS unsigned*)(lds + q * D1_QS), klo, lane, bs, ab), ok2 = d1_find((LAS unsigned*)(lds + q * D1_QS), 1u, lane, bmx, ab2);
            if (lane == 0) { const unsigned klo_key = bs << 21, khi_key = (bmx + 1u) << 21;
                const float lo = __uint_as_float((klo_key & 0x80000000u) ? (klo_key & 0x7FFFFFFFu) : ~klo_key), hi2 = __uint_as_float((khi_key & 0x80000000u) ? (khi_key & 0x7FFFFFFFu) : ~khi_key);
                const float span = (hi2 - lo) * 1.5f; const bool good = ok1 && ok2 && bmx < 2046u && span > 0.f && span < 3.0e38f;
                sm[q] = __float_as_uint(lo); sm[32 + q] = __float_as_uint(good ? 2047.f / span : 0.f); if (!good) sm[224] = 1u; } }
        __syncthreads();
        for (int w = tid; w < D1_SM / 4; w += 512) ((LAS unsigned*)lds)[w] = 0u;
        const float f_lo = __uint_as_float(sm[r32]), f_inv = __uint_as_float(sm[32 + r32]);
        __syncthreads();
        d1_scan<4, EXP>(ikb, qt, qt, wave, lane, qb, wv, lds, 0u, f_lo, f_inv);
        __syncthreads();
#pragma unroll 1
        for (int qq = 0; qq < 4; ++qq) { const int q = wave * 4 + qq; unsigned bin, ab; const bool ok = d1_find((LAS unsigned*)(lds + q * D1_QS), 256u, lane, bin, ab);
            if (lane == 0) { sm[64 + q] = bin; sm[96 + q] = 256u - ab; if (!ok || bin == 2047u) sm[224] = 1u; } }
        __syncthreads();
        for (int w = tid; w < D1_SM / 4; w += 512) ((LAS unsigned*)lds)[w] = 0u;
#ifndef D1_FORCE_FB
#define D1_FORCE_FB 0
#endif
        const unsigned f_bs = sm[64 + r32]; bool fast_ok = (sm[224] == 0u) && !D1_FORCE_FB;
        __syncthreads();
        if (fast_ok) {
            d1_scan<5, EXP>(ikb, qt, qt, wave, lane, qb, wv, lds, 0u, f_lo, f_inv, f_bs);
            __syncthreads();
            if (tid < 32 && sm[160 + tid] > 256u) sm[224] = 1u;
            __syncthreads();
            fast_ok = (sm[224] == 0u);
            __syncthreads();
        }
        if (!fast_ok) {
        for (int w = tid; w < (D1_SM + 1024) / 4; w += 512) ((LAS unsigned*)lds)[w] = 0u;
        __syncthreads();
        d1_scan<1, EXP>(ikb, qt, qt, wave, lane, qb, wv, lds, 0u);
        __syncthreads();
#pragma unroll 1
        for (int qq = 0; qq < 4; ++qq) { const int q = wave * 4 + qq; unsigned bin, ab; d1_find((LAS unsigned*)(lds + q * D1_QS), 256u, lane, bin, ab); if (lane == 0) { sm[q] = bin; sm[32 + q] = ab; } }
        __syncthreads();
        for (int w = tid; w < D1_SM / 4; w += 512) ((LAS unsigned*)lds)[w] = 0u;
        const unsigned b1 = sm[r32];
        __syncthreads();
        d1_scan<2, EXP>(ikb, qt, qt, wave, lane, qb, wv, lds, b1);
        __syncthreads();
#pragma unroll 1
        for (int qq = 0; qq < 4; ++qq) { const int q = wave * 4 + qq; const unsigned need2 = 256u - sm[32 + q]; unsigned bin, ab; d1_find((LAS unsigned*)(lds + q * D1_QS), need2, lane, bin, ab);
            if (lane == 0) { sm[64 + q] = (sm[q] << 11) | bin; sm[96 + q] = need2 - ab; } }
        __syncthreads();
        for (int w = tid; w < D1_SM / 4; w += 512) ((LAS unsigned*)lds)[w] = 0u;
        const unsigned T22 = sm[64 + r32];
        __syncthreads();
        d1_scan<3, EXP>(ikb, qt, qt, wave, lane, qb, wv, lds, T22);
        __syncthreads();
        }
#pragma unroll 1
        for (int qq = 0; qq < 4; ++qq) { const int q = wave * 4 + qq;
            const unsigned cc = sm[160 + q] < 256u ? sm[160 + q] : 256u, need3 = sm[96 + q];
            LAS unsigned* cand = (LAS unsigned*)(lds + q * D1_QS); LAS unsigned short* cidx = (LAS unsigned short*)(cand + 256); LAS unsigned* bm = cand + 512; LAS unsigned* tb = cand + 768;
            unsigned tw[4]; int cz = 0;
#pragma unroll
            for (int w = 0; w < 4; ++w) { tw[w] = tb[lane * 4 + w]; cz += __popc(tw[w]); }
            int incz = cz;
#pragma unroll
            for (int o = 1; o < 64; o <<= 1) { const int v = __shfl_up(incz, o); if (lane >= o) incz += v; }
            const int cztot = __shfl(incz, 63);
            int npos = 0;
            for (unsigned ci = lane; ci < ((cc + 63u) & ~63u); ci += 64) { const bool act = ci < cc; const unsigned mine = act ? cand[ci] : 0u; const unsigned mi = act ? (unsigned)cidx[ci] : 0u;
                npos += __popcll(__ballot(act && mine > 0x80000000u));
                unsigned rank = (mine < 0x80000000u) ? (unsigned)cztot : 0u;
                for (unsigned j = 0; j < cc; ++j) { const unsigned kj = cand[j]; const unsigned ij = (unsigned)cidx[j]; rank += (kj > mine || (kj == mine && ij < mi)) ? 1u : 0u; }
                if (act && rank < need3) (void)__hip_atomic_fetch_or(bm + (mi >> 5), 1u << (mi & 31u), __ATOMIC_RELAXED, __HIP_MEMORY_SCOPE_WORKGROUP); }
            { int need_z = (int)need3 - npos; need_z = need_z < 0 ? 0 : (need_z > cztot ? cztot : need_z);
              if (need_z > 0) { int pre = incz - cz;
#pragma unroll
                for (int w = 0; w < 4; ++w) { unsigned bits = tw[w]; const int pc = __popc(bits); int k = need_z - pre; k = k < 0 ? 0 : (k > pc ? pc : k);
                    unsigned keep = 0u; for (int x = 0; x < k; ++x) { const unsigned low = bits & (0u - bits); keep |= low; bits ^= low; }
                    if (keep) (void)__hip_atomic_fetch_or(bm + lane * 4 + w, keep, __ATOMIC_RELAXED, __HIP_MEMORY_SCOPE_WORKGROUP);
                    pre += pc; } } }
            asm volatile("s_waitcnt lgkmcnt(0)" ::: "memory");
            unsigned wds[4]; int c = 0;
#pragma unroll
            for (int w = 0; w < 4; ++w) { wds[w] = bm[lane * 4 + w]; c += __popc(wds[w]); }
            int inc = c;
#pragma unroll
            for (int o = 1; o < 64; o <<= 1) { const int v = __shfl_up(inc, o); if (lane >= o) inc += v; }
            const int total = __shfl(inc, 63); int off = inc - c;
            int* op = sel + (size_t)(tok0 + q) * TOPK;
            if (EXP != 7)
#pragma unroll
            for (int w = 0; w < 4; ++w) { unsigned bits = wds[w]; const int kb = lane * 128 + w * 32;
                while (bits) { const int k = __ffs((int)bits) - 1; if (off < TOPK) op[off] = kb + k; ++off; bits &= bits - 1u; } }
            for (int j = total + lane; j < TOPK; j += 64) op[j] = t0 + q;
        }
        __syncthreads();
    }
}

constexpr int CW_DQ = 16384 + 1024;
__device__ __forceinline__ void phase_dsa_attn(KP P, int L, LAS unsigned char* lds) {
    int tz = threadIdx.x; asm volatile("" : "+v"(tz)); const int tid = tz, lane = tid & 63, wave = tid >> 6;
    const bf16* qkvi = (const bf16*)(P->ws + WS_QKVI); const int* sel = (const int*)(P->ws + WS_SEL); bf16* attn = (bf16*)(P->ws + WS_ATTN);
    unsigned* qh = (unsigned*)(P->ws + WS_CTL) + CW_DQ + L * 8 * 64;
    LAS unsigned* idxs = (LAS unsigned*)(lds + wave * 8192);
    LAS float* pl = (LAS float*)(lds + wave * 8192 + 1024);
    LAS int* wq = (LAS int*)(lds + 65536 + wave * 16);
    const int r = lane & 3, ts_l = (lane & 15) >> 2, kq = lane >> 4, c16 = lane & 15;
    const unsigned myq = xb_xcc_id() & 7u;
    constexpr float CC = 0.08838834764831845f * 1.4426950408889634f;
    for (int qi = 0; qi < 8; ++qi) {
        const int qx = (int)((myq + (unsigned)qi) & 7u), b = qx >> 1, g = qx & 1;
        for (;;) {
            int item = 0;
            if (lane == 0) item = (int)__hip_atomic_fetch_add(qh + qx * 64, 1u, __ATOMIC_RELAXED, __HIP_MEMORY_SCOPE_AGENT);
            item = __builtin_amdgcn_readfirstlane(item);
            if (item >= SEQ) break;
            const int t = SEQ - 1 - item, tok = b * SEQ + t, cnt = (t + 1 < TOPK) ? (t + 1) : TOPK;
#pragma unroll
            for (int i = 0; i < 4; ++i) { const int j = lane + 64 * i; int sidx = 0; if (j < cnt) sidx = (t < TOPK) ? j : sel[(size_t)tok * TOPK + j]; idxs[j] = (unsigned)sidx; }
            asm volatile("s_waitcnt lgkmcnt(0)" ::: "memory");
            bf16x8 qm[4][4];
            { const bf16* qp = qkvi + (size_t)tok * QLD + (g * 4 + r) * HEAD_DIM + 8 * kq;
#pragma unroll
              for (int ks = 0; ks < 4; ++ks) { const bf16x8 v = *(const bf16x8*)(qp + 32 * ks);
#pragma unroll
                  for (int ts = 0; ts < 4; ++ts) qm[ts][ks] = (ts_l == ts) ? v : (bf16x8){0, 0, 0, 0, 0, 0, 0, 0}; } }
            f32x4 C[4];
            const bf16* kbase = qkvi + (size_t)b * SEQ * QLD + COL_K + g * HEAD_DIM + 8 * kq;
#pragma unroll
            for (int c = 0; c < 4; ++c) {
                C[c] = (f32x4){0.f, 0.f, 0.f, 0.f};
                bf16x8 a[4][4];
#pragma unroll
                for (int ts = 0; ts < 4; ++ts) { const unsigned sk = idxs[(4 * c + ts) * 16 + c16]; const bf16* kp = kbase + (size_t)sk * QLD;
#pragma unroll
                    for (int ks = 0; ks < 4; ++ks) a[ts][ks] = *(const bf16x8*)(kp + 32 * ks); }
#pragma unroll
                for (int ts = 0; ts < 4; ++ts)
#pragma unroll
                    for (int ks = 0; ks < 4; ++ks) C[c] = __builtin_amdgcn_mfma_f32_16x16x32_bf16(a[ts][ks], qm[ts][ks], C[c], 0, 0, 0);
            }
            const float bias2 = __builtin_amdgcn_exp2f(-(float)(g * 4 + r + 1)) * 1.4426950408889634f;
            float x[16]; float m = -INFINITY;
#pragma unroll
            for (int c = 0; c < 4; ++c) { const int k0 = (4 * c + ts_l) * 16 + 4 * kq; const u32x4 sp = *(const LAS u32x4*)(idxs + k0);
#pragma unroll
                for (int j = 0; j < 4; ++j) { const float v = (k0 + j < cnt) ? fmaf(C[c][j], CC, bias2 * (float)((int)sp[j] - t)) : -INFINITY; x[c * 4 + j] = v; m = fmaxf(m, v); } }
            m = fmaxf(m, __shfl_xor(m, 4)); m = fmaxf(m, __shfl_xor(m, 8)); m = fmaxf(m, __shfl_xor(m, 16)); m = fmaxf(m, __shfl_xor(m, 32));
            float sum = 0.f;
#pragma unroll
            for (int i = 0; i < 16; ++i) { x[i] = __builtin_amdgcn_exp2f(x[i] - m); sum += x[i]; }
            sum += __shfl_xor(sum, 4); sum += __shfl_xor(sum, 8); sum += __shfl_xor(sum, 16); sum += __shfl_xor(sum, 32);
            const float inv = 1.f / sum;
#pragma unroll
            for (int c = 0; c < 4; ++c) { const int k0 = (4 * c + ts_l) * 16 + 4 * kq;
#pragma unroll
                for (int j = 0; j < 4; ++j) pl[(k0 + j) * 4 + r] = x[c * 4 + j] * inv; }
            asm volatile("s_waitcnt lgkmcnt(0)" ::: "memory");
            float acc[4][8];
#pragma unroll
            for (int rr = 0; rr < 4; ++rr)
#pragma unroll
                for (int i = 0; i < 8; ++i) acc[rr][i] = 0.f;
            const bf16* vbase = qkvi + (size_t)b * SEQ * QLD + COL_V + g * HEAD_DIM + 8 * c16;
            const int nk4 = (cnt + 3) >> 2;
#pragma unroll 4
            for (int j4 = 0; j4 < nk4; ++j4) {
                const int key = 4 * j4 + kq; const unsigned sk = idxs[key];
                const u32x4 vv = *(const u32x4*)(vbase + (size_t)sk * QLD);
                const f32x4 pp = *(const LAS f32x4*)(pl + key * 4);
                const float vf[8] = {bflo(vv.x), bfhi(vv.x), bflo(vv.y), bfhi(vv.y), bflo(vv.z), bfhi(vv.z), bflo(vv.w), bfhi(vv.w)};
#pragma unroll
                for (int rr = 0; rr < 4; ++rr)
#pragma unroll
                    for (int i = 0; i < 8; ++i) acc[rr][i] = fmaf(pp[rr], vf[i], acc[rr][i]);
            }
#pragma unroll
            for (int rr = 0; rr < 4; ++rr)
#pragma unroll
                for (int i = 0; i < 8; ++i) { float v = acc[rr][i]; v += __shfl_xor(v, 16); v += __shfl_xor(v, 32); acc[rr][i] = v; }
            if (kq == 0) {
#pragma unroll
                for (int rr = 0; rr < 4; ++rr) { u32x4 o; o.x = cvt_pk_bf16(acc[rr][0], acc[rr][1]); o.y = cvt_pk_bf16(acc[rr][2], acc[rr][3]); o.z = cvt_pk_bf16(acc[rr][4], acc[rr][5]); o.w = cvt_pk_bf16(acc[rr][6], acc[rr][7]);
                    *(u32x4*)(attn + (size_t)tok * D_MODEL + (g * 4 + rr) * HEAD_DIM + 8 * c16) = o; }
            }
        }
    }
    (void)wq;
}


__device__ __forceinline__ int d2_swz(int i) { return ((i & 3) << 2) | ((i >> 2) & 3); }
__device__ __forceinline__ void phase_dsa_attn2(KP P, int L, LAS unsigned char* lds) {
    typedef short s16x4 __attribute__((ext_vector_type(4)));
    int tz = threadIdx.x; asm volatile("" : "+v"(tz)); const int tid = tz, lane = tid & 63, wave = __builtin_amdgcn_readfirstlane(tid >> 6);
    const bf16* qkvi = (const bf16*)(P->ws + WS_QKVI); const int* sel = (const int*)(P->ws + WS_SEL); bf16* attn = (bf16*)(P->ws + WS_ATTN);
    unsigned* qh = (unsigned*)(P->ws + WS_CTL) + CW_DQ + L * 8 * 64;
    LAS unsigned char* wl = lds + wave * 19456;
    LAS unsigned* idxs = (LAS unsigned*)wl;
    LAS unsigned char* pb = wl + 1024;
    LAS unsigned char* ring = wl + 3072;
    const int n16 = lane & 15, r = lane & 3, ts_l = n16 >> 2, kq = lane >> 4;
    const unsigned myq = xb_xcc_id() & 7u;
    constexpr float CC = 0.08838834764831845f * 1.4426950408889634f;
    unsigned dch[4];
#pragma unroll
    for (int j = 0; j < 4; ++j) dch[j] = (unsigned)((n16 ^ d2_swz(4 * j + kq)) * 16);
    unsigned aoff[4];
#pragma unroll
    for (int ks = 0; ks < 4; ++ks) aoff[ks] = (unsigned)(n16 * 256 + (((4 * ks + kq) ^ d2_swz(n16)) * 16));
    for (int qi = 0; qi < 8; ++qi) {
        const int qx = (int)((myq + (unsigned)qi) & 7u), b = qx >> 1, g = qx & 1;
        const char* kgb = (const char*)(qkvi + (size_t)b * SEQ * QLD + COL_K + g * HEAD_DIM);
        int item = 0;
        if (lane == 0) item = (int)__hip_atomic_fetch_add(qh + qx * 64, 1u, __ATOMIC_RELAXED, __HIP_MEMORY_SCOPE_AGENT);
        item = __builtin_amdgcn_readfirstlane(item);
        bool have_pf = false; int sx[4] = {0, 0, 0, 0}; bf16x8 qv[4] = {};
        while (item < SEQ) {
            const int t = SEQ - 1 - item, tok = b * SEQ + t, cnt = (t + 1 < TOPK) ? (t + 1) : TOPK;
            if (!have_pf) {
#pragma unroll
                for (int i = 0; i < 4; ++i) { const int j = lane + 64 * i; sx[i] = (t < TOPK) ? j : sel[(size_t)tok * TOPK + j]; }
                const bf16* qp = qkvi + (size_t)tok * QLD + (g * 4 + r) * HEAD_DIM + 8 * kq;
#pragma unroll
                for (int ks = 0; ks < 4; ++ks) qv[ks] = *(const bf16x8*)(qp + 32 * ks);
            }
#pragma unroll
            for (int i = 0; i < 4; ++i) { const int j = lane + 64 * i; idxs[j] = (j < cnt) ? (unsigned)sx[i] : 0u; }
            bf16x8 qm[4][4];
#pragma unroll
            for (int ks = 0; ks < 4; ++ks) {
#pragma unroll
                for (int ts = 0; ts < 4; ++ts) qm[ts][ks] = (ts_l == ts) ? qv[ks] : (bf16x8){0, 0, 0, 0, 0, 0, 0, 0}; }
            asm volatile("s_waitcnt vmcnt(0) lgkmcnt(0)" ::: "memory");
#define D2_ISSUE(s) do { const int kb_ = (s) & 15; const char* gb_ = kgb + ((s) >= 16 ? (COL_V - COL_K) * 2 : 0); LAS unsigned char* sl_ = ring + ((s) & 3) * 4096; \
        _Pragma("unroll") for (int j = 0; j < 4; ++j) { const unsigned sk_ = idxs[kb_ * 16 + 4 * j + kq]; \
            __builtin_amdgcn_global_load_lds((const unsigned*)(gb_ + (size_t)sk_ * (QLD * 2) + dch[j]), (LAS unsigned*)(sl_ + j * 1024), 16, 0, 0); } } while (0)
            int nraw = 0;
            if (lane == 0) nraw = (int)__hip_atomic_fetch_add(qh + qx * 64, 1u, __ATOMIC_RELAXED, __HIP_MEMORY_SCOPE_AGENT);
            D2_ISSUE(0); D2_ISSUE(1); D2_ISSUE(2); D2_ISSUE(3);
            f32x4 C[4];
#pragma unroll
            for (int c = 0; c < 4; ++c) C[c] = (f32x4){0.f, 0.f, 0.f, 0.f};
#pragma unroll
            for (int s2 = 0; s2 < 16; ++s2) {
                asm volatile("s_waitcnt vmcnt(12)" ::: "memory");
                LAS unsigned char* sl = ring + (s2 & 3) * 4096;
                bf16x8 a[4];
#pragma unroll
                for (int ks = 0; ks < 4; ++ks) a[ks] = *(const LAS bf16x8*)(sl + aoff[ks]);
#pragma unroll
                for (int ks = 0; ks < 4; ++ks) C[s2 >> 2] = __builtin_amdgcn_mfma_f32_16x16x32_bf16(a[ks], qm[s2 & 3][ks], C[s2 >> 2], 0, 0, 0);
                asm volatile("s_waitcnt lgkmcnt(0)" ::: "memory");
                D2_ISSUE(s2 + 4);
            }
            const float bias2 = __builtin_amdgcn_exp2f(-(float)(g * 4 + r + 1)) * 1.4426950408889634f;
            float x[16]; float m = -INFINITY;
#pragma unroll
            for (int c = 0; c < 4; ++c) { const int k0 = (4 * c + ts_l) * 16 + 4 * kq; const u32x4 sp = *(const LAS u32x4*)(idxs + k0);
#pragma unroll
                for (int j = 0; j < 4; ++j) { const float v = (k0 + j < cnt) ? fmaf(C[c][j], CC, bias2 * (float)((int)sp[j] - t)) : -INFINITY; x[c * 4 + j] = v; m = fmaxf(m, v); } }
            m = fmaxf(m, __shfl_xor(m, 4)); m = fmaxf(m, __shfl_xor(m, 8)); m = fmaxf(m, __shfl_xor(m, 16)); m = fmaxf(m, __shfl_xor(m, 32));
            float sum = 0.f;
#pragma unroll
            for (int i = 0; i < 16; ++i) { x[i] = __builtin_amdgcn_exp2f(x[i] - m); sum += x[i]; }
            sum += __shfl_xor(sum, 4); sum += __shfl_xor(sum, 8); sum += __shfl_xor(sum, 16); sum += __shfl_xor(sum, 32);
            const float inv = 1.f / sum;
#pragma unroll
            for (int c = 0; c < 4; ++c) { const int k0 = (4 * c + ts_l) * 16 + 4 * kq;
                u32x2 w; w.x = cvt_pk_bf16(x[c * 4 + 0] * inv, x[c * 4 + 1] * inv); w.y = cvt_pk_bf16(x[c * 4 + 2] * inv, x[c * 4 + 3] * inv);
                *(LAS u32x2*)(pb + (r * 256 + k0) * 2) = w; }
            asm volatile("s_waitcnt lgkmcnt(0)" ::: "memory");
            f32x4 O[8]; int nitem = SEQ;
#pragma unroll
            for (int db = 0; db < 8; ++db) O[db] = (f32x4){0.f, 0.f, 0.f, 0.f};
            const int q4 = n16 >> 2, p4 = n16 & 3;
#pragma unroll
            for (int u = 0; u < 8; ++u) {
                if (u < 7) asm volatile("s_waitcnt vmcnt(8)" ::: "memory"); else asm volatile("s_waitcnt vmcnt(0)" ::: "memory");
                LAS unsigned char* sl = ring + (((2 * u) & 3) + (kq >> 1)) * 4096;
                const bf16x8 pf = *(const LAS bf16x8*)(pb + (r * 256 + u * 32 + 8 * kq) * 2);
#pragma unroll
                for (int db = 0; db < 8; ++db) {
                    const int i0 = 8 * (kq & 1) + q4, i1 = i0 + 4;
                    const int a0 = (int)(unsigned)(uintptr_t)(sl + i0 * 256 + (((2 * db + (p4 >> 1)) ^ d2_swz(i0)) * 16) + 8 * (p4 & 1));
                    const int a1 = (int)(unsigned)(uintptr_t)(sl + i1 * 256 + (((2 * db + (p4 >> 1)) ^ d2_swz(i1)) * 16) + 8 * (p4 & 1));
                    const s16x4 v0 = mb::tr_read<0>(a0), v1 = mb::tr_read<0>(a1);
                    asm volatile("s_waitcnt lgkmcnt(0)" ::: "memory");
                    const bf16x8 vf = {v0[0], v0[1], v0[2], v0[3], v1[0], v1[1], v1[2], v1[3]};
                    O[db] = __builtin_amdgcn_mfma_f32_16x16x32_bf16(vf, pf, O[db], 0, 0, 0);
                }
                if (u == 0) {
                    nitem = __builtin_amdgcn_readfirstlane(nraw); have_pf = nitem < SEQ;
                    if (have_pf) { const int tn = SEQ - 1 - nitem, tokn = b * SEQ + tn;
#pragma unroll
                        for (int i = 0; i < 4; ++i) { const int j = lane + 64 * i; sx[i] = (tn < TOPK) ? j : sel[(size_t)tokn * TOPK + j]; }
                        const bf16* qpn = qkvi + (size_t)tokn * QLD + (g * 4 + r) * HEAD_DIM + 8 * kq;
#pragma unroll
                        for (int ks = 0; ks < 4; ++ks) qv[ks] = *(const bf16x8*)(qpn + 32 * ks); } }
                if (u < 6) { D2_ISSUE(16 + 2 * u + 4); D2_ISSUE(16 + 2 * u + 5); }
            }
#undef D2_ISSUE
            if (n16 < 4) {
                bf16* op = attn + (size_t)tok * D_MODEL + (g * 4 + n16) * HEAD_DIM + 4 * kq;
#pragma unroll
                for (int db = 0; db < 8; ++db) { u32x2 w; w.x = cvt_pk_bf16(O[db][0], O[db][1]); w.y = cvt_pk_bf16(O[db][2], O[db][3]); *(u32x2*)(op + 16 * db) = w; }
            }
            item = nitem;
        }
    }
}

__device__ __forceinline__ int opq(int x) { asm volatile("" : "+s"(x)); return x; }
__device__ __forceinline__ bool phase_active(int L, int k) {
    if (k >= 2 && k <= 6) { if (L < N_A) return k <= 3; if (k == 2) return L == N_A; }
    return k <= 14;
}
__global__ void __launch_bounds__(512, 2) fwd(Params P) {
    extern __shared__ __attribute__((aligned(16))) unsigned char lds_raw[];
    LAS unsigned char* lds = (LAS unsigned char*)lds_raw;
    const int tid = threadIdx.x;
    unsigned char* ws0 = P.ws;
    if (tid < 16) ((LAS unsigned*)(lds + LDS_MISC))[tid] = 0u;
    __syncthreads();
    const int lo = P.ph_lo, hi = P.ph_hi;
    const bool multi = (hi - lo) > 1;
    unsigned* barw = (unsigned*)(ws0 + WS_CTL) + CW_BAR + P.bar_idx * XCD_BAR_WORDS;
    XcdBarrier bar; bar.bar = barw; bar.x = 0; bar.st = nullptr;
    if (multi) bar = xcd_barrier_post(barw, (volatile LAS unsigned*)(lds + LDS_MISC));
#ifndef PHASE_MASK
#define PHASE_MASK 0xFFFF
#endif
#define IN(k) (((PHASE_MASK >> (k)) & 1) && opq(lo) <= (pb + (k)) && (pb + (k)) < hi && phase_active(L, (k)))
#define SEAM(k) do { if (IN(k) && (pb + (k) + 1) < hi) xcd_barrier(bar); } while (0)
#ifndef PROBE_MASK
#define PROBE_MASK 0
#endif
#define PROBED(k) (((PROBE_MASK) >> (k)) & 1)
    const int G = gridDim.x, c = blockIdx.x;
    for (int L = 0; L < DEPTH; ++L) {
        const int pb = L * 16;
        if (pb + 16 <= lo || pb >= hi) continue;
        const bool isA = L < N_A;
        if (IN(0)) { for (int rep = PROBED(0) ? 0 : 1; rep < 2; ++rep) { phase_convert(fresh_params(), L, lds); if (rep == 0) xcd_barrier(bar); } } SEAM(0);
        if (IN(1)) { for (int rep = PROBED(1) ? 0 : 1; rep < 2; ++rep) {
            KP Q = fresh_params(); unsigned char* ws = Q->ws; bf16* hb = (bf16*)(ws + WS_HB);
            if (isA) {
                gm::DenseOrder S; S.init(hb, ws + WS_WMIX, NTOK, 2048, D_MODEL, G, c);
                gm::EpiBf16 E{(bf16*)(ws + WS_QKVI), QLD, (float*)(ws + WS_IW)};
                gm::gemm_phase<gm::EpiBf16, gm::DenseOrder, false>(lds, D_MODEL, S, E);
            } else {
                if (L == N_A) {
                    gm::DenseOrder S; S.init(hb, ws + WS_WMIX + 6 * MiB, NTOK, 512, D_MODEL, G, c);
                    gm::EpiBf16 E{(bf16*)(ws + WS_KV), 512, nullptr};
                    gm::gemm_phase<gm::EpiBf16, gm::DenseOrder, false>(lds, D_MODEL, S, E);
                }
                gm::DenseOrder S; S.init(hb, ws + WS_WMIX, NTOK, D_MODEL, D_MODEL, G, c);
                gm::EpiBf16 E{(bf16*)(ws + WS_QKVI), D_MODEL, nullptr};
                gm::gemm_phase<gm::EpiBf16, gm::DenseOrder, false>(lds, D_MODEL, S, E);
            }
            if (rep == 0) xcd_barrier(bar);
        } } SEAM(1);
        if (IN(2)) { if (isA) { if (PROBED(2)) { phase_dsa_topk<D1_EXP>(fresh_params(), lds, WS_PL); xcd_barrier(bar); } phase_dsa_topk<0>(fresh_params(), lds, WS_SEL); } else phase_kmeans(fresh_params()); } SEAM(2);
        if (IN(3)) { if (isA) { for (int rep = PROBED(3) ? 0 : 1; rep < 2; ++rep) { phase_dsa_attn2(fresh_params(), rep == 0 ? L + 2 : L, lds); if (rep == 0) xcd_barrier(bar); } } else { for (int rep = PROBED(4) ? 0 : 1; rep < 2; ++rep) { phase_moba_gate2(fresh_params()); if (rep == 0) xcd_barrier(bar); } } } SEAM(3);
        if (IN(4)) { phase_moba_lists(fresh_params(), lds); } SEAM(4);
        if (IN(5)) { for (int rep = PROBED(5) ? 0 : 1; rep < 2; ++rep) { phase_moba_attn2(fresh_params(), (L - N_A) * 2 + rep, lds); if (rep == 0) xcd_barrier(bar); } } SEAM(5);
        if (IN(6)) { for (int rep = PROBED(6) ? 0 : 1; rep < 2; ++rep) { phase_moba_combine(fresh_params()); if (rep == 0) xcd_barrier(bar); } } SEAM(6);
        if (IN(7)) { for (int rep = PROBED(7) ? 0 : 1; rep < 2; ++rep) {
            KP Q = fresh_params(); unsigned char* ws = Q->ws; const float* hres = (L == 0) ? Q->in[0] : (const float*)(ws + WS_H); _Float16* t = (_Float16*)(ws + WS_T);
            { gm::DenseOrder S; S.init(ws + WS_ATTN, ws + WS_WMIX + 4 * MiB, NTOK, D_MODEL, D_MODEL, G, c);
              gm::EpiResid E{hres, t};
              gm::gemm_phase<gm::EpiResid, gm::DenseOrder, false>(lds, D_MODEL, S, E); }
            { gm::DenseOrder S; S.init(ws + WS_PB, ws + WS_WPLE, NTOK, D_MODEL, PLE_DIM, G, c);
              gm::EpiBf16 E{(bf16*)(ws + WS_PL), D_MODEL, nullptr};
              gm::gemm_phase<gm::EpiBf16, gm::DenseOrder, false>(lds, PLE_DIM, S, E); }
            if (rep == 0) xcd_barrier(bar);
        } } SEAM(7);
        if (IN(8)) { for (int rep = PROBED(8) ? 0 : 1; rep < 2; ++rep) { phase_ln_router(fresh_params(), L, lds, rep == 0 ? L + 4 : L); if (rep == 0) xcd_barrier(bar); } } SEAM(8);
        if (IN(9)) { phase_moe_prep(fresh_params(), L, lds); } SEAM(9);
        if (IN(10)) { for (int rep = PROBED(10) ? 0 : 1; rep < 2; ++rep) {
            KP Q = fresh_params(); unsigned char* ws = Q->ws; bf16* hb = (bf16*)(ws + WS_HB);
            const int* moe = (const int*)(ws + WS_MOE);
            gm::MoeOrder S; S.tile_e = moe + MO_TILE_E; S.tile_row0 = moe + MO_TILE_ROW0; S.tile_nv = moe + MO_TILE_NV; S.slot_tok = moe + MO_SLOT_TOK;
            S.n_units = (int)*((const unsigned*)(ws + WS_CTL) + CW_NTILES + L) * 4; S.G = G; S.c = c; S.K = D_MODEL; S.A = (const char*)hb; S.W = (const char*)(ws + WS_WGU);
            S.wstride = (size_t)D_MODEL * D_MODEL * 2; S.tB = (size_t)256 * D_MODEL * 2; S.gath = true;
            gm::EpiSwiglu E{(bf16*)(ws + WS_ACT)};
            gm::gemm_phase<gm::EpiSwiglu, gm::MoeOrder, true>(lds, D_MODEL, S, E);
            if (rep == 0) xcd_barrier(bar);
        } } SEAM(10);
        if (IN(11)) { for (int rep = PROBED(11) ? 0 : 1; rep < 2; ++rep) {
            KP Q = fresh_params(); unsigned char* ws = Q->ws;
            const int* moe = (const int*)(ws + WS_MOE);
            gm::MoeOrder S; S.tile_e = moe + MO_TILE_E; S.tile_row0 = moe + MO_TILE_ROW0; S.tile_nv = moe + MO_TILE_NV; S.slot_tok = moe + MO_SLOT_TOK;
            S.n_units = (int)*((const unsigned*)(ws + WS_CTL) + CW_NTILES + L) * 4; S.G = G; S.c = c; S.K = D_EXPERT; S.A = (const char*)(ws + WS_ACT); S.W = (const char*)(ws + WS_WD);
            S.wstride = (size_t)D_MODEL * D_EXPERT * 2; S.tB = (size_t)256 * D_EXPERT * 2; S.gath = false;
            gm::EpiMoeDown E{(bf16*)(ws + WS_Y)};
            gm::gemm_phase<gm::EpiMoeDown, gm::MoeOrder, false>(lds, D_EXPERT, S, E);
            if (rep == 0) xcd_barrier(bar);
        } } SEAM(11);
        if (IN(12)) { KP Q = fresh_params(); phase_ln<1, false>(Q, L, 1, lds, (float*)(Q->ws + WS_H), true); } SEAM(12);
        if (IN(13)) { for (int rep = PROBED(13) ? 0 : 1; rep < 2; ++rep) {
            KP Q = fresh_params(); unsigned char* ws = Q->ws; bf16* hb = (bf16*)(ws + WS_HB); float* h = (float*)(ws + WS_H); _Float16* t = (_Float16*)(ws + WS_T);
            gm::DenseOrder S; S.init(hb, ws + WS_WPG, NTOK, D_MODEL, D_MODEL, G, c);
            gm::EpiPle E{h, (const bf16*)(ws + WS_PL), t};
            gm::gemm_phase<gm::EpiPle, gm::DenseOrder, false>(lds, D_MODEL, S, E);
            if (rep == 0) xcd_barrier(bar);
        } } SEAM(13);
        if (IN(14)) { for (int rep = PROBED(14) ? 0 : 1; rep < 2; ++rep) { KP Q = fresh_params(); phase_ln<0, false>(Q, L, 2, lds, (L == DEPTH - 1) ? Q->out : (float*)(Q->ws + WS_H), L != DEPTH - 1); if (rep == 0) xcd_barrier(bar); } }
        if (L != DEPTH - 1) SEAM(14);
    }
#undef IN
#undef SEAM
}

#ifndef DEBUG_ATTN
#define DEBUG_ATTN 0
#endif
#if DEBUG_ATTN
__global__ void __launch_bounds__(256) dsa_scores(const bf16* __restrict__ qkvi  , const float* __restrict__ iw  , float* __restrict__ sc) {
    const int s0 = blockIdx.x * 64, t0 = blockIdx.y * 64;
    if (s0 > t0) return;
    __shared__ float Qs[64][68];
    __shared__ float Ks[64][68];
    const int tid = threadIdx.x, r = tid >> 2, kq = (tid & 3) * 16;
    {
        const bf16* kp = qkvi + (size_t)(s0 + r) * QLD + COL_IK + kq;
#pragma unroll
        for (int i = 0; i < 16; ++i) Ks[kq + i][r] = bf2f(kp[i]);
    }
    const int ty = tid >> 4, tx = tid & 15;
    float tot[4][4];
#pragma unroll
    for (int i = 0; i < 4; ++i)
#pragma unroll
        for (int j = 0; j < 4; ++j) tot[i][j] = 0.f;
    for (int hh = 0; hh < IDX_HEADS; ++hh) {
        __syncthreads();
        const bf16* qp = qkvi + (size_t)(t0 + r) * QLD + COL_IQ + hh * IDX_DIM + kq;
#pragma unroll
        for (int i = 0; i < 16; ++i) Qs[kq + i][r] = bf2f(qp[i]);
        __syncthreads();
        float acc[4][4];
#pragma unroll
        for (int i = 0; i < 4; ++i)
#pragma unroll
            for (int j = 0; j < 4; ++j) acc[i][j] = 0.f;
#pragma unroll 8
        for (int k = 0; k < 64; ++k) {
            const float4 a4 = *(const float4*)&Qs[k][ty * 4];
            const float4 b4 = *(const float4*)&Ks[k][tx * 4];
            const float a[4] = {a4.x, a4.y, a4.z, a4.w};
            const float b[4] = {b4.x, b4.y, b4.z, b4.w};
#pragma unroll
            for (int i = 0; i < 4; ++i)
#pragma unroll
                for (int j = 0; j < 4; ++j) acc[i][j] += a[i] * b[j];
        }
#pragma unroll
        for (int i = 0; i < 4; ++i) {
            const float w = iw[(size_t)(t0 + ty * 4 + i) * 4 + hh];
#pragma unroll
            for (int j = 0; j < 4; ++j) tot[i][j] += w * fmaxf(acc[i][j], 0.f);
        }
    }
#pragma unroll
    for (int i = 0; i < 4; ++i)
        *(float4*)(sc + (size_t)(t0 + ty * 4 + i) * SEQ + s0 + tx * 4) = make_float4(tot[i][0], tot[i][1], tot[i][2], tot[i][3]);
}

__device__ __forceinline__ unsigned fkey(float f) { const unsigned u = __float_as_uint(f); return (u & 0x80000000u) ? ~u : (u | 0x80000000u); }
__global__ void __launch_bounds__(256) dsa_topk(const float* __restrict__ sc, int* __restrict__ sel) {
    const int t = blockIdx.x, tid = threadIdx.x, n = t + 1;
    int* out = sel + (size_t)t * TOPK;
    if (n <= TOPK) { out[tid] = tid <= t ? tid : 0; return; }
    const float* row = sc + (size_t)t * SEQ;
    __shared__ unsigned hist[256];
    __shared__ unsigned s_prefix, s_need;
    __shared__ int wsum[2][4];
    unsigned prefix = 0, need = TOPK;
    for (int pass = 3; pass >= 0; --pass) {
        hist[tid] = 0;
        __syncthreads();
        for (int i = tid; i < n; i += 256) {
            const unsigned k = fkey(row[i]);
            const bool match = (pass == 3) ? true : ((k >> (8 * (pass + 1))) == prefix);
            if (match) atomicAdd(&hist[(k >> (8 * pass)) & 255u], 1u);
        }
        __syncthreads();
        if (tid == 0) {
            unsigned c = 0; int d = 255;
            for (; d > 0; --d) { if (c + hist[d] >= need) break; c += hist[d]; }
            s_prefix = (prefix << 8) | (unsigned)d; s_need = need - c;
        }
        __syncthreads();
        prefix = s_prefix; need = s_need;
        __syncthreads();
    }
    const unsigned T = prefix;
    const int n_gt = TOPK - (int)need;
    int run_gt = 0, run_eq = 0;
    const int lane = tid & 63, w = tid >> 6;
    for (int base = 0; base < n; base += 256) {
        const int i = base + tid;
        unsigned k = 0; bool gt = false, eq = false;
        if (i < n) { k = fkey(row[i]); gt = k > T; eq = k == T; }
        const unsigned long long mg = __ballot(gt), me = __ballot(eq);
        const unsigned long long lower = (lane == 0) ? 0ull : (~0ull >> (64 - lane));
        const int pg = __popcll(mg & lower), pe = __popcll(me & lower);
        if (lane == 0) { wsum[0][w] = __popcll(mg); wsum[1][w] = __popcll(me); }
        __syncthreads();
        int og = 0, oe = 0, tg = 0, te = 0;
        for (int x = 0; x < 4; ++x) { if (x < w) { og += wsum[0][x]; oe += wsum[1][x]; } tg += wsum[0][x]; te += wsum[1][x]; }
        if (gt) out[run_gt + og + pg] = i;
        if (eq) { const int rk = run_eq + oe + pe; if (rk < (int)need) out[n_gt + rk] = i; }
        run_gt += tg; run_eq += te;
        __syncthreads();
    }
}

__global__ void __launch_bounds__(256) dsa_attn(const bf16* __restrict__ qkvi, const int* __restrict__ sel, bf16* __restrict__ attn) {
    const int tok = blockIdx.x, b = tok / SEQ, t = tok % SEQ, tid = threadIdx.x;
    __shared__ float qs[D_MODEL];
    __shared__ float lg[N_HEADS][TOPK];
    __shared__ int sidx[TOPK];
    const int cnt = (t + 1 < TOPK) ? (t + 1) : TOPK;
    const bf16* prow = qkvi + (size_t)tok * QLD;
#pragma unroll
    for (int i = 0; i < 4; ++i) qs[tid * 4 + i] = bf2f(prow[tid * 4 + i]);
    int s = 0;
    if (tid < cnt) s = (t < TOPK) ? tid : sel[(size_t)tok * TOPK + tid];
    sidx[tid] = s;
    __syncthreads();
    const float scale = 0.08838834764831845f;
    if (tid < cnt) {
        const bf16* krow = qkvi + (size_t)(b * SEQ + s) * QLD + COL_K;
        for (int g = 0; g < N_KV; ++g) {
            float d[4] = {0.f, 0.f, 0.f, 0.f};
            for (int k = 0; k < HEAD_DIM; ++k) {
                const float kv = bf2f(krow[g * HEAD_DIM + k]);
#pragma unroll
                for (int r = 0; r < 4; ++r) d[r] += qs[(g * 4 + r) * HEAD_DIM + k] * kv;
            }
#pragma unroll
            for (int r = 0; r < 4; ++r) {
                const int hh = g * 4 + r;
                const float slope = exp2f(-(float)(hh + 1));
                lg[hh][tid] = d[r] * scale - slope * (float)(t - s);
            }
        }
    } else {
        for (int hh = 0; hh < N_HEADS; ++hh) lg[hh][tid] = -INFINITY;
    }
    __syncthreads();
    {
        const int lane = tid & 63, w = tid >> 6;
        for (int h2 = 0; h2 < 2; ++h2) {
            const int hh = w * 2 + h2;
            float v[4], m = -INFINITY;
#pragma unroll
            for (int i = 0; i < 4; ++i) { v[i] = lg[hh][lane + 64 * i]; m = fmaxf(m, v[i]); }
            for (int o = 32; o > 0; o >>= 1) m = fmaxf(m, __shfl_xor(m, o));
            float sum = 0.f;
#pragma unroll
            for (int i = 0; i < 4; ++i) { v[i] = expf(v[i] - m); sum += v[i]; }
            for (int o = 32; o > 0; o >>= 1) sum += __shfl_xor(sum, o);
            const float inv = 1.f / sum;
#pragma unroll
            for (int i = 0; i < 4; ++i) lg[hh][lane + 64 * i] = v[i] * inv;
        }
    }
    __syncthreads();
    {
        const int col = tid * 4, hh = col / HEAD_DIM, g = hh / HEAD_GROUP, d = col % HEAD_DIM;
        float acc[4] = {0.f, 0.f, 0.f, 0.f};
        for (int j = 0; j < cnt; ++j) {
            const float p = lg[hh][j];
            const u32x2 vv = *(const u32x2*)(qkvi + (size_t)(b * SEQ + sidx[j]) * QLD + COL_V + g * HEAD_DIM + d);
            acc[0] += p * bflo(vv.x); acc[1] += p * bfhi(vv.x); acc[2] += p * bflo(vv.y); acc[3] += p * bfhi(vv.y);
        }
        u32x2 o; o.x = cvt_pk_bf16(acc[0], acc[1]); o.y = cvt_pk_bf16(acc[2], acc[3]);
        *(u32x2*)(attn + (size_t)tok * D_MODEL + col) = o;
    }
}

__global__ void __launch_bounds__(128) kmeans_kernel(const bf16* __restrict__ kv, float* __restrict__ km) {
    const int blk = blockIdx.x % N_BLOCKS, g = (blockIdx.x / N_BLOCKS) % N_KV, b = blockIdx.x / (N_BLOCKS * N_KV), d = threadIdx.x;
    float s = 0.f;
    for (int i = 0; i < MOBA_BLOCK; ++i) s += bf2f(kv[(size_t)(b * SEQ + blk * MOBA_BLOCK + i) * 512 + g * HEAD_DIM + d]);
    km[((size_t)(b * N_KV + g) * N_BLOCKS + blk) * HEAD_DIM + d] = s * (1.f / MOBA_BLOCK);
}

__global__ void __launch_bounds__(256) moba_attn(const bf16* __restrict__ q, const bf16* __restrict__ kv, const float* __restrict__ km, bf16* __restrict__ attn) {
    const int tok = blockIdx.x, b = tok / SEQ, t = tok % SEQ, tid = threadIdx.x, own = t / MOBA_BLOCK;
    __shared__ float qs[HEAD_DIM];
    __shared__ float gate[N_BLOCKS];
    __shared__ int selb[3];
    __shared__ float lg[4 * MOBA_BLOCK];
    __shared__ float red[8];
    __shared__ float part[2][HEAD_DIM];
    const float scale = 0.08838834764831845f;
    for (int hh = 0; hh < N_HEADS; ++hh) {
        const int g = hh / HEAD_GROUP;
        const float slope = exp2f(-(float)(hh + 1));
        __syncthreads();
        if (tid < HEAD_DIM) qs[tid] = bf2f(q[(size_t)tok * D_MODEL + hh * HEAD_DIM + tid]);
        __syncthreads();
        if (tid < N_BLOCKS) {
            float gval = -INFINITY;
            if (tid < own) {
                const float* kp = km + ((size_t)(b * N_KV + g) * N_BLOCKS + tid) * HEAD_DIM;
                float s = 0.f;
                for (int k = 0; k < HEAD_DIM; ++k) s += qs[k] * kp[k];
                gval = s;
            }
            gate[tid] = gval;
        }
        __syncthreads();
        if (tid == 0) {
            unsigned used = 0u;
            for (int s = 0; s < 3; ++s) {
                int best = -1; float bv = 0.f;
                for (int j = 0; j < N_BLOCKS; ++j) if (!((used >> j) & 1u) && (best < 0 || gate[j] > bv)) { best = j; bv = gate[j]; }
                used |= 1u << best; selb[s] = best;
            }
        }
        __syncthreads();
        for (int s = 0; s < 4; ++s) {
            const int blk = (s < 3) ? selb[s] : own;
            const int kpos = blk * MOBA_BLOCK + tid;
            const bool valid = (s < 3) ? (blk < own) : (kpos <= t);
            float v = -INFINITY;
            if (valid) {
                const bf16* kp = kv + (size_t)(b * SEQ + kpos) * 512 + g * HEAD_DIM;
                float d = 0.f;
                for (int k = 0; k < HEAD_DIM; ++k) d += qs[k] * bf2f(kp[k]);
                v = d * scale - slope * (float)(t - kpos);
            }
            lg[s * MOBA_BLOCK + tid] = v;
        }
        __syncthreads();
        float m = fmaxf(fmaxf(lg[tid], lg[256 + tid]), fmaxf(lg[512 + tid], lg[768 + tid]));
        for (int o = 32; o > 0; o >>= 1) m = fmaxf(m, __shfl_xor(m, o));
        if ((tid & 63) == 0) red[tid >> 6] = m;
        __syncthreads();
        m = fmaxf(fmaxf(red[0], red[1]), fmaxf(red[2], red[3]));
        float e[4], sum = 0.f;
#pragma unroll
        for (int i = 0; i < 4; ++i) { e[i] = expf(lg[i * 256 + tid] - m); sum += e[i]; }
        for (int o = 32; o > 0; o >>= 1) sum += __shfl_xor(sum, o);
        if ((tid & 63) == 0) red[4 + (tid >> 6)] = sum;
        __syncthreads();
        const float inv = 1.f / (red[4] + red[5] + red[6] + red[7]);
#pragma unroll
        for (int i = 0; i < 4; ++i) lg[i * 256 + tid] = e[i] * inv;
        __syncthreads();
        {
            const int d = tid & 127, half = tid >> 7;
            float acc = 0.f;
            for (int s = 0; s < 4; ++s) {
                const int blk = (s < 3) ? selb[s] : own;
                const bool bvalid = (s < 3) ? (blk < own) : true;
                if (!bvalid) continue;
                const bf16* vp = kv + (size_t)(b * SEQ + blk * MOBA_BLOCK + half * 128) * 512 + KV_DIM + g * HEAD_DIM + d;
                const float* pp = lg + s * MOBA_BLOCK + half * 128;
                for (int j = 0; j < 128; ++j) { const float p = pp[j]; if (p != 0.f) acc += p * bf2f(vp[(size_t)j * 512]); }
            }
            part[half][d] = acc;
        }
        __syncthreads();
        if (tid < HEAD_DIM) attn[(size_t)tok * D_MODEL + hh * HEAD_DIM + tid] = (bf16)(cvt_pk_bf16(part[0][tid] + part[1][tid], 0.f) & 0xffffu);
    }
}


#endif
#ifndef DEBUG_ATTN
#define DEBUG_ATTN 0
#endif
#if DEBUG_ATTN
__global__ void dbg_compare(const bf16* __restrict__ a, const bf16* __restrict__ ref, size_t n, float* __restrict__ acc) {
    float d2 = 0.f, r2 = 0.f;
    for (size_t i = (size_t)blockIdx.x * blockDim.x + threadIdx.x; i < n; i += (size_t)gridDim.x * blockDim.x) { const float x = bf2f(a[i]), y = bf2f(ref[i]); d2 += (x - y) * (x - y); r2 += y * y; }
    d2 = wave_sum(d2); r2 = wave_sum(r2);
    if ((threadIdx.x & 63) == 0) { atomicAdd(&acc[0], d2); atomicAdd(&acc[1], r2); }
}
__global__ void dbg_scale(float* __restrict__ out, size_t n, const float* __restrict__ acc) {
    const float rv = acc[0] / fmaxf(acc[1], 1e-30f);
    float e = sqrtf(fminf(rv * 100.f, 4.f)); if (!(rv == rv)) e = 3.f;
    for (size_t i = (size_t)blockIdx.x * blockDim.x + threadIdx.x; i < n; i += (size_t)gridDim.x * blockDim.x) out[i] *= (1.f + e);
}
#endif

extern "C" void kernel_launch(void* const* d_in, const int* in_sizes, int n_in, void* d_out, int out_size, void* d_ws, size_t ws_size, hipStream_t stream) {
    static int grid = 0;
    if (grid == 0) {
        int dev = 0, cus = 0;
        (void)hipGetDevice(&dev); (void)hipDeviceGetAttribute(&cus, hipDeviceAttributeMultiprocessorCount, dev);
        (void)hipFuncSetAttribute((const void*)fwd, hipFuncAttributeMaxDynamicSharedMemorySize, LDS_BYTES);
        grid = cus > 0 ? cus : 256;
    }
    unsigned char* ws = (unsigned char*)d_ws;
    (void)hipMemsetAsync(ws + WS_CTL, 0, CTL_ZERO_BYTES, stream);
    Params P{};
    for (int i = 0; i < 18; ++i) P.in[i] = (const float*)d_in[i];
    P.out = (float*)d_out; P.ws = ws;
    int nlaunch = 0;
    auto run = [&](int lo, int hi) { P.ph_lo = lo; P.ph_hi = hi; P.bar_idx = nlaunch++; hipLaunchKernelGGL(fwd, dim3(grid), dim3(512), LDS_BYTES, stream, P); };
#if DEBUG_ATTN
    const bf16* qkvi = (const bf16*)(ws + WS_QKVI); bf16* attn = (bf16*)(ws + WS_ATTN); int* sel = (int*)(ws + WS_SEL);
    float* scores = (float*)(ws + WS_SCORES); const float* iw = (const float*)(ws + WS_IW); const bf16* kvb = (const bf16*)(ws + WS_KV); float* km = (float*)(ws + WS_KM);
#endif
#if DEBUG_ATTN == 0
    run(0, DEPTH * 16);
#else
    for (int L = 0; L < DEPTH; ++L) {
        const int pb = L * 16;
        if (L < N_A) {
#if DEBUG_ATTN == 4
            if (L == 1) {
                run(pb + 0, pb + 3);
                bf16* attn2 = (bf16*)(ws + WS_PL);
                dsa_attn<<<NTOK, 256, 0, stream>>>(qkvi, sel, attn2);
                run(pb + 3, pb + 4);
                dbg_compare<<<1024, 256, 0, stream>>>(attn, attn2, (size_t)NTOK * D_MODEL, (float*)(ws + WS_CTL) + 1024);
                run(pb + 7, pb + 15);
            } else
#endif
#if DEBUG_ATTN == 3
            if (L == 1) {
                run(pb + 0, pb + 2);
                bf16* attn2 = (bf16*)(ws + WS_PL);
                for (int b = 0; b < BATCH; ++b) {
                    dsa_scores<<<dim3(SEQ / 64, SEQ / 64), 256, 0, stream>>>(qkvi + (size_t)b * SEQ * QLD, iw + (size_t)b * SEQ * 4, scores);
                    dsa_topk<<<SEQ, 256, 0, stream>>>(scores, sel + (size_t)b * SEQ * TOPK);
                }
                dsa_attn<<<NTOK, 256, 0, stream>>>(qkvi, sel, attn2);
                run(pb + 2, pb + 4);
                dbg_compare<<<1024, 256, 0, stream>>>(attn, attn2, (size_t)NTOK * D_MODEL, (float*)(ws + WS_CTL) + 1024);
                run(pb + 7, pb + 15);
            } else
#endif
            { run(pb + 0, pb + 4); run(pb + 7, pb + 15); }
        } else {
            run(pb + 0, pb + 7);
#if DEBUG_ATTN == 1
            if (L == N_A) {
                bf16* attn2 = (bf16*)(ws + WS_PL);
                kmeans_kernel<<<BATCH * N_KV * N_BLOCKS, 128, 0, stream>>>(kvb, km + 65536);
                moba_attn<<<NTOK, 256, 0, stream>>>(qkvi, kvb, km + 65536, attn2);
                dbg_compare<<<1024, 256, 0, stream>>>(attn, attn2, (size_t)NTOK * D_MODEL, (float*)(ws + WS_CTL) + 1024);
            }
#endif
            run(pb + 7, pb + 15);
        }
    }
#endif
#if DEBUG_ATTN
    dbg_scale<<<1024, 256, 0, stream>>>((float*)d_out, (size_t)NTOK * D_MODEL, (const float*)(ws + WS_CTL) + 1024);
#endif
}
```

```cpp
#include <hip/hip_runtime.h>
#include <stdint.h>

#define D_MODEL 1024
#define BATCH 4
#define SEQ 8192
#define NTOK (BATCH * SEQ)
#define DEPTH 4
#define N_A 2
#define N_HEADS 8
#define HEAD_DIM 128
#define N_KV 2
#define HEAD_GROUP 4
#define KV_DIM 256
#define IDX_HEADS 4
#define IDX_DIM 64
#define TOPK 256
#define MOBA_BLOCK 256
#define N_BLOCKS 32
#define N_GROUPS 4
#define EPG 8
#define N_EXPERTS 32
#define D_EXPERT 512
#define PLE_DIM 256
#define A_COLS 1860
#define QLD 2048
#define COL_K 1024
#define COL_V 1280
#define COL_IQ 1536
#define COL_IK 1792
#define COL_IW 1856
#define ALPHA_F 1.6817928305074290f
#define LN_EPS 1e-5f
#define MAX_SLOTS (65536 + 8192)
#define MAX_MTILES (MAX_SLOTS / 256)

#define LAS __attribute__((address_space(3)))
#define GAS __attribute__((address_space(1)))
typedef unsigned short bf16;
typedef short bf16x8 __attribute__((ext_vector_type(8)));
typedef float f32x4 __attribute__((ext_vector_type(4)));
typedef float f32x2 __attribute__((ext_vector_type(2)));
typedef unsigned u32x4 __attribute__((ext_vector_type(4)));
typedef unsigned u32x2 __attribute__((ext_vector_type(2)));
typedef _Float16 f16x4 __attribute__((ext_vector_type(4)));

__device__ __forceinline__ unsigned cvt_pk_bf16(float lo, float hi) { unsigned r; asm("v_cvt_pk_bf16_f32 %0, %1, %2" : "=v"(r) : "v"(lo), "v"(hi)); return r; }
__device__ __forceinline__ float bf2f(bf16 b) { return __uint_as_float(((unsigned)b) << 16); }
__device__ __forceinline__ float bflo(unsigned u) { return __uint_as_float(u << 16); }
__device__ __forceinline__ float bfhi(unsigned u) { return __uint_as_float(u & 0xffff0000u); }
template <int CTRL> __device__ __forceinline__ float dpp_add(float v) { return v + __int_as_float(__builtin_amdgcn_update_dpp(0, __float_as_int(v), CTRL, 0xF, 0xF, false)); }
__device__ __forceinline__ float row16_sum(float v) {
    v = dpp_add<0xB1>(v); v = dpp_add<0x4E>(v); v = dpp_add<0x141>(v); v = dpp_add<0x140>(v); return v;
}
__device__ __forceinline__ float wave_sum(float v) { v = row16_sum(v); v += __shfl_xor(v, 16); v += __shfl_xor(v, 32); return v; }

constexpr size_t MiB = 1u << 20;
constexpr size_t WS_CTL = 0, CTL_ZERO_BYTES = 1 * MiB;
constexpr size_t WS_WMIX = 2 * MiB;
constexpr size_t WS_WPG = 10 * MiB;
constexpr size_t WS_WPLE = 12 * MiB;
constexpr size_t WS_WGU = 16 * MiB;
constexpr size_t WS_WD = 80 * MiB;
constexpr size_t WS_PB = 112 * MiB;
constexpr size_t WS_H = 128 * MiB;
constexpr size_t WS_HB = 256 * MiB;
constexpr size_t WS_T = 320 * MiB;
constexpr size_t WS_KV = 448 * MiB;
constexpr size_t WS_PL = 480 * MiB;
constexpr size_t WS_QKVI = 544 * MiB;
constexpr size_t WS_ATTN = 672 * MiB;
constexpr size_t WS_SEL = 736 * MiB;
constexpr size_t WS_ACT = 544 * MiB;
constexpr size_t WS_Y = 616 * MiB;
constexpr size_t WS_MOE = 768 * MiB;
constexpr size_t WS_IW = 770 * MiB;
constexpr size_t WS_KM = 771 * MiB;
constexpr size_t WS_SCORES = 772 * MiB;
constexpr int MO_TOK_E = 0, MO_TOK_POS = NTOK * 2, MO_TOK_SLOT = NTOK * 4, MO_TOK_W = NTOK * 6, MO_SLOT_TOK = NTOK * 8, MO_TILE_E = MO_SLOT_TOK + MAX_SLOTS, MO_TILE_ROW0 = MO_TILE_E + 512, MO_TILE_NV = MO_TILE_ROW0 + 512;
constexpr int CW_BAR = 65536;
constexpr int CW_CNT = 16384;
constexpr int CW_NTILES = 16384 + 256;

constexpr int LDS_BYTES = 163840;
constexpr int LDS_MISC = 163840 - 256;
constexpr int NWAVES = 8;

#define XB_TMO      128
#define XB_XCNT(j)  (256  + 64 * (j))
#define XB_XSUB(j)  (1280 + 64 * (j))
#define XB_XGEN(j)  (2304 + 64 * (j))
#define XB_TOP      3328
#define XB_TOPGEN   3392
#define XCD_BAR_WORDS 3456
#define XB_SPIN_CAP (1u << 22)
__device__ __forceinline__ unsigned xb_ld(unsigned* p)              { return __hip_atomic_load(p, __ATOMIC_RELAXED, __HIP_MEMORY_SCOPE_AGENT); }
__device__ __forceinline__ unsigned xb_add(unsigned* p, unsigned v) { return __hip_atomic_fetch_add(p, v, __ATOMIC_RELAXED, __HIP_MEMORY_SCOPE_AGENT); }
__device__ __forceinline__ unsigned xb_xcc_id() { return (unsigned)__builtin_amdgcn_s_getreg((3 << 11) | 20) & 0xFu; }
#define XB_SPIN(cond, bar) do { unsigned _sp = 0; while (cond) { __builtin_amdgcn_s_sleep(1); \
    if ((++_sp & 255u) == 0u) { if (xb_ld(&(bar)[XB_TMO])) break; if (_sp > XB_SPIN_CAP) { atomicAdd(&(bar)[XB_TMO], 1u); break; } } } } while (0)
struct XcdBarrier { unsigned* bar; unsigned x; volatile LAS unsigned* st; };
__device__ __forceinline__ XcdBarrier xcd_barrier_post(unsigned* bar, volatile LAS unsigned* st) {
    XcdBarrier b; b.bar = bar; b.x = xb_xcc_id(); b.st = st;
    if (threadIdx.x == 0) (void)xb_add(&bar[XB_XCNT(b.x)], 1u);
    return b;
}
__device__ __forceinline__ void xcd_barrier_complete(unsigned* bar, unsigned x, unsigned& nloc, unsigned& nx) {
    const unsigned G = gridDim.x * gridDim.y * gridDim.z;
    unsigned sum, cnt, mine, sp = 0u;
    for (;;) {
        sum = 0u; cnt = 0u; mine = 0u;
#pragma unroll
        for (unsigned j = 0; j < 16; ++j) { const unsigned c = xb_ld(&bar[XB_XCNT(j)]); sum += c; cnt += (c > 0u) ? 1u : 0u; mine = (j == x) ? c : mine; }
        if (sum == G) break;
        __builtin_amdgcn_s_sleep(1);
        if ((++sp & 255u) == 0u) { if (xb_ld(&bar[XB_TMO])) break; if (sp > XB_SPIN_CAP) { atomicAdd(&bar[XB_TMO], 1u); break; } }
    }
    nloc = mine > 0u ? mine : 1u; nx = cnt > 0u ? cnt : 1u;
}
__device__ __forceinline__ void xcd_barrier(const XcdBarrier& b) {
    asm volatile("s_waitcnt vmcnt(0)" ::: "memory");
    __syncthreads();
    if (threadIdx.x == 0) {
        unsigned* bar = b.bar;
        __builtin_amdgcn_s_waitcnt(0);
        unsigned nloc = b.st[0], nx = b.st[1];
        if (nloc == 0u) { xcd_barrier_complete(bar, b.x, nloc, nx); b.st[0] = nloc; b.st[1] = nx; }
        const unsigned old = xb_add(&bar[XB_XSUB(b.x)], 1u);
        const unsigned gen = old / nloc;
        if (old + 1u == (gen + 1u) * nloc) {
            __builtin_amdgcn_fence(__ATOMIC_RELEASE, "agent");
            asm volatile("s_waitcnt vmcnt(0)" ::: "memory");
            const unsigned og = xb_add(&bar[XB_TOP], 1u);
            const unsigned tg = og / nx;
            if (og + 1u == (tg + 1u) * nx) xb_add(&bar[XB_TOPGEN], 1u);
            else XB_SPIN(xb_ld(&bar[XB_TOPGEN]) == tg, bar);
            __builtin_amdgcn_fence(__ATOMIC_ACQUIRE, "agent");
            xb_add(&bar[XB_XGEN(b.x)], 1u);
            asm volatile("s_waitcnt vmcnt(0)" ::: "memory");
        } else {
            XB_SPIN(xb_ld(&bar[XB_XGEN(b.x)]) == gen, bar);
            __builtin_amdgcn_fence(__ATOMIC_ACQUIRE, "agent");
            asm volatile("s_waitcnt vmcnt(0)" ::: "memory");
        }
    }
    __syncthreads();
}

namespace gm {
constexpr int BM = 256, BK = 64, HALF = 128, HTB = HALF * BK * 2, STAGE_BYTES = 8 * HTB, NXCD = 8, WGM = 8;
__host__ __device__ __forceinline__ int lds_byte(int r, int c) { const int st = (r >> 4) * 2 + (c >> 5), rr = r & 15, cc = c & 31, ob = rr * 64 + cc * 2; return st * 1024 + (ob ^ (((ob >> 9) & 1) << 5)); }
__host__ __device__ __forceinline__ void stage_rc(int b, int& R, int& C) { const int st = b / 1024, sb = b % 1024, swz = sb ^ (((sb >> 9) & 1) << 5); R = (st >> 1) * 16 + swz / 64; C = (st & 1) * 32 + (swz % 64) / 2; }
__host__ __device__ __forceinline__ int perm32(int rho) { const int n = rho >> 4, i = rho & 15; return 8 * (i >> 2) + 4 * n + (i & 3); }

struct Unit { const char* a; const char* b; int row0, col0, aux; };

struct DenseOrder {
    int nM, nN, nwg, G, c; const char* A; const char* B; size_t tA, tB;
    __device__ void init(const void* A_, const void* Bt_, int M, int N, int K, int G_, int c_) { nM = M / BM; nN = N / BM; nwg = nM * nN; G = G_; c = c_; A = (const char*)A_; B = (const char*)Bt_; tA = (size_t)BM * K * 2; tB = tA; }
    __device__ bool next(int i, Unit& u) const {
        const long L = (long)i * G + c; if (L >= nwg) return false;
        int wgid = (int)L; { const int q = nwg / NXCD, r = nwg % NXCD, xcd = wgid % NXCD, off = wgid / NXCD; wgid = (xcd < r ? xcd * (q + 1) : r * (q + 1) + (xcd - r) * q) + off; }
        const int nig = WGM * nN, gid = wgid / nig, fm = gid * WGM, gsz = (nM - fm) < WGM ? (nM - fm) : WGM;
        const int pm = fm + ((wgid % nig) % gsz), pn = (wgid % nig) / gsz;
        u.a = A + (size_t)pm * tA; u.b = B + (size_t)pn * tB; u.row0 = pm * BM; u.col0 = pn * BM; u.aux = 0; return true;
    }
    __device__ __forceinline__ void gather(const Unit&, unsigned (&)[2][2], const int (&)[2], const int (&)[2], int) const {}
};
struct MoeOrder {
    const int* tile_e; const int* tile_row0; const int* tile_nv; const int* slot_tok; int n_units, G, c, K; const char* A; const char* W; size_t wstride, tB; bool gath;
    __device__ bool next(int i, Unit& u) const {
        const int L = i * G + c; if (L >= n_units) return false;
        const int T = L >> 2, pn = L & 3;
        const int e = __builtin_amdgcn_readfirstlane(tile_e[T]), r0 = __builtin_amdgcn_readfirstlane(tile_row0[T]), nv = __builtin_amdgcn_readfirstlane(tile_nv[T]);
        u.a = gath ? A : A + (size_t)r0 * K * 2; u.b = W + (size_t)e * wstride + (size_t)pn * tB; u.row0 = r0; u.col0 = pn; u.aux = nv; return true;
    }
    __device__ __forceinline__ void gather(const Unit& u, unsigned (&vo)[2][2], const int (&sR)[2], const int (&sC)[2], int K_) const {
#pragma unroll
        for (int h = 0; h < 2; ++h)
#pragma unroll
            for (int i = 0; i < 2; ++i) { const int r = h * HALF + sR[i]; const int tok = (r < u.aux) ? slot_tok[u.row0 + r] : 0; vo[h][i] = (unsigned)(tok * K_ + sC[i]) * 2u; }
    }
};

template <class Epi, class Sched, bool GATHER>
__device__ __forceinline__ void gemm_phase(LAS unsigned char* lds, const int K, const Sched& S, const Epi& E) {
    int tz = threadIdx.x; asm volatile("" : "+v"(tz));
    const int tid = tz, wid = __builtin_amdgcn_readfirstlane(tid >> 6), lane = tid & 63, wr = wid >> 2, wc = wid & 3, fr = lane & 15, fq = lane >> 4;
    const int nt = K / BK;
    unsigned voffB[2], vA[2][2], vAn[2][2]; int sR[2], sC[2];
#pragma unroll
    for (int i = 0; i < 2; ++i) { int R, C; stage_rc(tid * 16 + i * 8192, R, C); const int Rb = Epi::PERM ? ((R & ~31) + perm32(R & 31)) : R;
        sR[i] = R; sC[i] = C; voffB[i] = (unsigned)(Rb * K + C) * 2u;
        vA[0][i] = (unsigned)(R * K + C) * 2u; vA[1][i] = (unsigned)((R + HALF) * K + C) * 2u; vAn[0][i] = vA[0][i]; vAn[1][i] = vA[1][i]; }
    const size_t kstep = (size_t)(BK * 2);
    const size_t hstep = (size_t)HALF * K * 2;
    const unsigned ldsw = (unsigned)wid * 1024u;
    const int aoff = lds_byte(wr * 64 + fr, fq * 8), boff = lds_byte(wc * 32 + fr, fq * 8);
#define PG8_SA(b, h) (((b) * 2 + (h)) * HTB)
#define PG8_SB(b, h) ((4 + (b) * 2 + (h)) * HTB)
#define PG8_STAGE(bufoff, gbase, voff) do { _Pragma("unroll") for (int _i = 0; _i < 2; ++_i) \
        __builtin_amdgcn_global_load_lds((const unsigned*)((const char*)(gbase) + (voff)[_i]), (LAS unsigned*)(lds + (bufoff) + ldsw + _i * 8192), 16, 0, 0); } while (0)
#define PG8_LDA(dst, b, h) do { _Pragma("unroll") for (int m = 0; m < 4; ++m) _Pragma("unroll") for (int k = 0; k < 2; ++k) dst[m][k] = *(const LAS bf16x8*)(lds + PG8_SA(b, h) + aoff + m * 2048 + k * 1024); } while (0)
#define PG8_LDB(dst, b, h) do { _Pragma("unroll") for (int n = 0; n < 2; ++n) _Pragma("unroll") for (int k = 0; k < 2; ++k) dst[n][k] = *(const LAS bf16x8*)(lds + PG8_SB(b, h) + boff + n * 2048 + k * 1024); } while (0)
#define PG8_MMA(ai, bj, At, Bt) do { __builtin_amdgcn_s_setprio(1); _Pragma("unroll") for (int m = 0; m < 4; ++m) _Pragma("unroll") for (int n = 0; n < 2; ++n) _Pragma("unroll") for (int k = 0; k < 2; ++k) \
        acc[ai][bj][m][n] = __builtin_amdgcn_mfma_f32_16x16x32_bf16(Bt[n][k], At[m][k], acc[ai][bj][m][n], 0, 0, 0); __builtin_amdgcn_s_setprio(0); } while (0)
#define PG8_WAIT_V(n) asm volatile("s_waitcnt vmcnt(" #n ")" ::: "memory")
#define PG8_WAIT_L(n) asm volatile("s_waitcnt lgkmcnt(" #n ")" ::: "memory")
#define PG8_BAR __builtin_amdgcn_s_barrier()
#define PG8_SCHED __builtin_amdgcn_sched_barrier(0)
    Unit cur, nxt; int ui = 0;
    if (!S.next(0, cur)) return;
    f32x4 acc[2][2][4][2];
#pragma unroll
    for (int a = 0; a < 2; ++a)
#pragma unroll
        for (int b = 0; b < 2; ++b)
#pragma unroll
            for (int m = 0; m < 4; ++m)
#pragma unroll
                for (int n = 0; n < 2; ++n) acc[a][b][m][n] = (f32x4){0.f, 0.f, 0.f, 0.f};
    bf16x8 At[4][2], B0[2][2], B1[2][2];
    const char* cA = cur.a; const char* cB = cur.b;
    if constexpr (GATHER) S.gather(cur, vA, sR, sC, K);
    PG8_STAGE(PG8_SB(0, 0), cB, voffB); PG8_STAGE(PG8_SB(0, 1), cB + hstep, voffB); PG8_STAGE(PG8_SA(0, 0), cA, vA[0]); PG8_STAGE(PG8_SA(0, 1), cA, vA[1]);
    if (wr == 1) PG8_BAR;
    PG8_WAIT_V(2); PG8_BAR;
    PG8_STAGE(PG8_SB(1, 0), cB + kstep, voffB); PG8_STAGE(PG8_SA(1, 0), cA + kstep, vA[0]); PG8_STAGE(PG8_SB(1, 1), cB + hstep + kstep, voffB);
    PG8_WAIT_V(6); PG8_BAR;
    for (;;) {
        const bool has_next = S.next(ui + 1, nxt);
        const char* nA = has_next ? nxt.a : cA; const char* nB = has_next ? nxt.b : cB;
        if constexpr (GATHER) {
            if (has_next) S.gather(nxt, vAn, sR, sC, K);
            else { vAn[0][0] = vA[0][0]; vAn[0][1] = vA[0][1]; vAn[1][0] = vA[1][0]; vAn[1][1] = vA[1][1]; }
        }
        for (int t = 0; t < nt; t += 2) {
            const bool last = (t == nt - 2);
            const char* a1 = cA + (size_t)(t + 1) * kstep;
            const char* a2 = last ? nA : cA + (size_t)(t + 2) * kstep; const char* b2 = last ? nB : cB + (size_t)(t + 2) * kstep;
            const char* a3 = a2 + kstep; const char* b3 = b2 + kstep;
            unsigned w0[2], w1[2];
            if constexpr (GATHER) { w0[0] = last ? vAn[0][0] : vA[0][0]; w0[1] = last ? vAn[0][1] : vA[0][1]; w1[0] = last ? vAn[1][0] : vA[1][0]; w1[1] = last ? vAn[1][1] : vA[1][1]; }
            else { w0[0] = vA[0][0]; w0[1] = vA[0][1]; w1[0] = vA[1][0]; w1[1] = vA[1][1]; }
            PG8_LDB(B0, 0, 0); PG8_LDB(B1, 0, 1); PG8_SCHED; PG8_LDA(At, 0, 0); PG8_STAGE(PG8_SA(1, 1), a1, vA[1]);
            PG8_WAIT_V(8); PG8_WAIT_L(0); PG8_BAR; PG8_MMA(0, 0, At, B0); PG8_MMA(0, 1, At, B1); PG8_BAR; PG8_SCHED;
            PG8_LDA(At, 0, 1); PG8_STAGE(PG8_SB(0, 0), b2, voffB); PG8_STAGE(PG8_SB(0, 1), b2 + hstep, voffB); PG8_STAGE(PG8_SA(0, 0), a2, w0);
            PG8_WAIT_V(8); PG8_WAIT_L(0); PG8_BAR; PG8_MMA(1, 0, At, B0); PG8_MMA(1, 1, At, B1); PG8_BAR; PG8_SCHED;
            PG8_LDB(B0, 1, 0); PG8_LDB(B1, 1, 1); PG8_SCHED; PG8_LDA(At, 1, 0); PG8_STAGE(PG8_SA(0, 1), a2, w1);
            PG8_WAIT_V(8); PG8_WAIT_L(0); PG8_BAR; PG8_MMA(0, 0, At, B0); PG8_MMA(0, 1, At, B1); PG8_BAR; PG8_SCHED;
            PG8_LDA(At, 1, 1); PG8_STAGE(PG8_SB(1, 0), b3, voffB); PG8_STAGE(PG8_SB(1, 1), b3 + hstep, voffB); PG8_STAGE(PG8_SA(1, 0), a3, w0);
            PG8_WAIT_V(8); PG8_WAIT_L(0); PG8_BAR; PG8_MMA(1, 0, At, B0); PG8_MMA(1, 1, At, B1); PG8_BAR; PG8_SCHED;
        }
        if (wr == 0) PG8_BAR;
        E(acc, cur, wr, wc, fr, fq);
        if (!has_next) break;
#pragma unroll
        for (int a = 0; a < 2; ++a)
#pragma unroll
            for (int b = 0; b < 2; ++b)
#pragma unroll
                for (int m = 0; m < 4; ++m)
#pragma unroll
                    for (int n = 0; n < 2; ++n) acc[a][b][m][n] = (f32x4){0.f, 0.f, 0.f, 0.f};
        cur = nxt; cA = nA; cB = nB; ++ui;
        if constexpr (GATHER) { vA[0][0] = vAn[0][0]; vA[0][1] = vAn[0][1]; vA[1][0] = vAn[1][0]; vA[1][1] = vAn[1][1]; }
        if (wr == 1) PG8_BAR;
    }
    PG8_WAIT_V(0);
    PG8_BAR;
#undef PG8_SA
#undef PG8_SB
#undef PG8_STAGE
#undef PG8_LDA
#undef PG8_LDB
#undef PG8_MMA
#undef PG8_WAIT_V
#undef PG8_WAIT_L
#undef PG8_BAR
#undef PG8_SCHED
}

#define EPI_ROWS(u, ai, m) ((u).row0 + (ai) * HALF + wr * 64 + (m) * 16 + fr)
struct EpiBf16 {
    static constexpr bool PERM = true;
    bf16* O; int ldc; float* iw;
    __device__ __forceinline__ void operator()(const f32x4 (&acc)[2][2][4][2], const Unit& u, int wr, int wc, int fr, int fq) const {
#pragma unroll
        for (int ai = 0; ai < 2; ++ai)
#pragma unroll
            for (int m = 0; m < 4; ++m) { const int row = EPI_ROWS(u, ai, m); bf16* rowp = O + (size_t)row * ldc + u.col0 + wc * 32 + 8 * fq;
#pragma unroll
                for (int bj = 0; bj < 2; ++bj) { const f32x4 v0 = acc[ai][bj][m][0], v1 = acc[ai][bj][m][1];
                    u32x4 w; w.x = cvt_pk_bf16(v0[0], v0[1]); w.y = cvt_pk_bf16(v0[2], v0[3]); w.z = cvt_pk_bf16(v1[0], v1[1]); w.w = cvt_pk_bf16(v1[2], v1[3]);
                    *(u32x4*)(rowp + bj * HALF) = w; }
                if (iw != nullptr && u.col0 == 1792 && wc == 2 && fq == 0) *(f32x4*)(iw + (size_t)row * 4) = acc[ai][0][m][0] * 0.0625f; }
    }
};
struct EpiResid {
    static constexpr bool PERM = false;
    const float* h; _Float16* t;
    __device__ __forceinline__ void operator()(const f32x4 (&acc)[2][2][4][2], const Unit& u, int wr, int wc, int fr, int fq) const {
#pragma unroll
        for (int ai = 0; ai < 2; ++ai)
#pragma unroll
            for (int m = 0; m < 4; ++m) { const size_t o = (size_t)EPI_ROWS(u, ai, m) * D_MODEL + u.col0 + wc * 32 + 4 * fq;
#pragma unroll
                for (int bj = 0; bj < 2; ++bj)
#pragma unroll
                    for (int n = 0; n < 2; ++n) { const size_t oo = o + bj * HALF + n * 16; const f32x4 hv = *(const f32x4*)(h + oo); const f32x4 tv = hv * ALPHA_F + acc[ai][bj][m][n]; *(f16x4*)(t + oo) = (f16x4){(_Float16)tv[0], (_Float16)tv[1], (_Float16)tv[2], (_Float16)tv[3]}; } }
    }
};
struct EpiPle {
    static constexpr bool PERM = false;
    const float* h; const bf16* pl; _Float16* t;
    __device__ __forceinline__ void operator()(const f32x4 (&acc)[2][2][4][2], const Unit& u, int wr, int wc, int fr, int fq) const {
#pragma unroll
        for (int ai = 0; ai < 2; ++ai)
#pragma unroll
            for (int m = 0; m < 4; ++m) { const size_t o = (size_t)EPI_ROWS(u, ai, m) * D_MODEL + u.col0 + wc * 32 + 4 * fq;
#pragma unroll
                for (int bj = 0; bj < 2; ++bj)
#pragma unroll
                    for (int n = 0; n < 2; ++n) { const size_t oo = o + bj * HALF + n * 16; const f32x4 hv = *(const f32x4*)(h + oo); const u32x2 pv = *(const u32x2*)(pl + oo);
                        const f32x4 a = acc[ai][bj][m][n]; f32x4 r;
                        r[0] = fmaf(hv[0], ALPHA_F, bflo(pv.x) * __builtin_amdgcn_rcpf(1.f + __builtin_amdgcn_exp2f(a[0] * -1.4426950408889634f))); r[1] = fmaf(hv[1], ALPHA_F, bfhi(pv.x) * __builtin_amdgcn_rcpf(1.f + __builtin_amdgcn_exp2f(a[1] * -1.4426950408889634f)));
                        r[2] = fmaf(hv[2], ALPHA_F, bflo(pv.y) * __builtin_amdgcn_rcpf(1.f + __builtin_amdgcn_exp2f(a[2] * -1.4426950408889634f))); r[3] = fmaf(hv[3], ALPHA_F, bfhi(pv.y) * __builtin_amdgcn_rcpf(1.f + __builtin_amdgcn_exp2f(a[3] * -1.4426950408889634f)));
                        *(f16x4*)(t + oo) = (f16x4){(_Float16)r[0], (_Float16)r[1], (_Float16)r[2], (_Float16)r[3]}; } }
    }
};
struct EpiSwiglu {
    static constexpr bool PERM = true;
    bf16* act;
    __device__ __forceinline__ void operator()(const f32x4 (&acc)[2][2][4][2], const Unit& u, int wr, int wc, int fr, int fq) const {
#pragma unroll
        for (int ai = 0; ai < 2; ++ai)
#pragma unroll
            for (int m = 0; m < 4; ++m) { const int row = EPI_ROWS(u, ai, m); float r[8];
#pragma unroll
                for (int n = 0; n < 2; ++n)
#pragma unroll
                    for (int j = 0; j < 4; ++j) { const float g = acc[ai][0][m][n][j], uu = acc[ai][1][m][n][j]; r[n * 4 + j] = g * __builtin_amdgcn_rcpf(1.f + __builtin_amdgcn_exp2f(g * -1.4426950408889634f)) * uu; }
                u32x4 w; w.x = cvt_pk_bf16(r[0], r[1]); w.y = cvt_pk_bf16(r[2], r[3]); w.z = cvt_pk_bf16(r[4], r[5]); w.w = cvt_pk_bf16(r[6], r[7]);
                *(u32x4*)(act + (size_t)row * D_EXPERT + u.col0 * 128 + wc * 32 + 8 * fq) = w; }
    }
};
struct EpiMoeDown {
    static constexpr bool PERM = true;
    bf16* Y;
    __device__ __forceinline__ void operator()(const f32x4 (&acc)[2][2][4][2], const Unit& u, int wr, int wc, int fr, int fq) const {
#pragma unroll
        for (int ai = 0; ai < 2; ++ai)
#pragma unroll
            for (int m = 0; m < 4; ++m) { const int row = EPI_ROWS(u, ai, m); bf16* rowp = Y + (size_t)row * D_MODEL + u.col0 * 256 + wc * 32 + 8 * fq;
#pragma unroll
                for (int bj = 0; bj < 2; ++bj) { const f32x4 v0 = acc[ai][bj][m][0], v1 = acc[ai][bj][m][1];
                    u32x4 w; w.x = cvt_pk_bf16(v0[0], v0[1]); w.y = cvt_pk_bf16(v0[2], v0[3]); w.z = cvt_pk_bf16(v1[0], v1[1]); w.w = cvt_pk_bf16(v1[2], v1[3]);
                    *(u32x4*)(rowp + bj * HALF) = w; } }
    }
};
}

struct Params { const float* in[18]; float* out; unsigned char* ws; int ph_lo, ph_hi, bar_idx, pad; };
typedef const Params __attribute__((address_space(4)))* KP;
__device__ __forceinline__ KP fresh_params() { KP p = (KP)__builtin_amdgcn_kernarg_segment_ptr(); asm volatile("" : "+s"(p)); return p; }

__device__ __forceinline__ void tr_item(const float* W, int K, int N, bf16* WT, int row_off, LAS float* scr, int kb, int nb, int lane) {
    const int k0 = 64 * kb, n0 = 32 * nb;
    const bool ok = (n0 + (lane & 31)) < N;
    if (n0 + 32 <= N) {
        const int kr = lane >> 3, c4 = (lane & 7) * 4;
#pragma unroll
        for (int i = 0; i < 8; ++i) { const int kk = 8 * i + kr; const f32x4 v = *(const f32x4*)(W + (size_t)(k0 + kk) * N + n0 + c4);
            LAS float* d = scr + kk * 33 + c4; d[0] = v[0]; d[1] = v[1]; d[2] = v[2]; d[3] = v[3]; }
    } else {
#pragma unroll 8
        for (int i = 0; i < 32; ++i) { const int kk = 2 * i + (lane >> 5); scr[kk * 33 + (lane & 31)] = ok ? W[(size_t)(k0 + kk) * N + n0 + (lane & 31)] : 0.f; }
    }
    asm volatile("s_waitcnt lgkmcnt(0)" ::: "memory");
    const int c = lane & 7;
#pragma unroll
    for (int j = 0; j < 4; ++j) { const int n = (lane >> 3) + 8 * j; const LAS float* s = scr + (8 * c) * 33 + n;
        u32x4 o; o.x = cvt_pk_bf16(s[0 * 33], s[1 * 33]); o.y = cvt_pk_bf16(s[2 * 33], s[3 * 33]); o.z = cvt_pk_bf16(s[4 * 33], s[5 * 33]); o.w = cvt_pk_bf16(s[6 * 33], s[7 * 33]);
        *(u32x4*)(WT + (size_t)(row_off + n0 + n) * K + k0 + 8 * c) = o; }
    asm volatile("s_waitcnt lgkmcnt(0)" ::: "memory");
}
__device__ __forceinline__ void cvt_rows(const float* src, bf16* dst, size_t n4, int gtid, int gthreads) {
    for (size_t i = gtid; i < n4; i += gthreads) { const f32x4 v = *(const f32x4*)(src + i * 4); u32x2 o; o.x = cvt_pk_bf16(v[0], v[1]); o.y = cvt_pk_bf16(v[2], v[3]); *(u32x2*)(dst + i * 4) = o; }
}
__device__ __forceinline__ void phase_convert(KP P, int L, LAS unsigned char* lds) {
    int tz = threadIdx.x; asm volatile("" : "+v"(tz));
    const int tid = tz, lane = tid & 63, wave = tid >> 6;
    LAS float* scr = (LAS float*)(lds + wave * 16384);
    const int gw = blockIdx.x * NWAVES + wave, NGW = gridDim.x * NWAVES;
    unsigned char* ws = P->ws;
    bf16* wmix = (bf16*)(ws + WS_WMIX); bf16* wo_t = (bf16*)(ws + WS_WMIX + 4 * MiB); bf16* wkv_t = (bf16*)(ws + WS_WMIX + 6 * MiB);
    bf16* wpg_t = (bf16*)(ws + WS_WPG); bf16* wple_t = (bf16*)(ws + WS_WPLE); bf16* wgu_t = (bf16*)(ws + WS_WGU); bf16* wd_t = (bf16*)(ws + WS_WD);
    const bool isA = L < N_A; const int j = L - N_A;
    const float* w_first = isA ? P->in[2] + (size_t)L * D_MODEL * A_COLS : P->in[5] + (size_t)j * D_MODEL * D_MODEL;
    const int n_first = isA ? A_COLS : D_MODEL, nb_first = isA ? 64 : 32;
    const float* w_o = isA ? P->in[3] + (size_t)L * D_MODEL * D_MODEL : P->in[6] + (size_t)j * D_MODEL * D_MODEL;
    const int I_FIRST = 16 * nb_first, I_O = 16 * 32, I_KV = (L == N_A) ? 16 * 16 : 0, I_PG = 16 * 32, I_PLE = 4 * 32, I_G = 32 * 256, I_U = 32 * 256, I_D = 32 * 256;
    const int NITEMS = I_FIRST + I_O + I_KV + I_PG + I_PLE + I_G + I_U + I_D;
    const size_t wsz = (size_t)D_MODEL * D_EXPERT;
    for (int it = gw; it < NITEMS; it += NGW) {
        int r = it;
        if (r < I_FIRST) { tr_item(w_first, D_MODEL, n_first, wmix, 0, scr, r / nb_first, r % nb_first, lane); continue; } r -= I_FIRST;
        if (r < I_O) { tr_item(w_o, D_MODEL, D_MODEL, wo_t, 0, scr, r / 32, r % 32, lane); continue; } r -= I_O;
        if (r < I_KV) { tr_item(P->in[4], D_MODEL, 512, wkv_t, 0, scr, r / 16, r % 16, lane); continue; } r -= I_KV;
        if (r < I_PG) { tr_item(P->in[15] + (size_t)L * D_MODEL * D_MODEL, D_MODEL, D_MODEL, wpg_t, 0, scr, r / 32, r % 32, lane); continue; } r -= I_PG;
        if (r < I_PLE) { tr_item(P->in[14] + (size_t)L * PLE_DIM * D_MODEL, PLE_DIM, D_MODEL, wple_t, 0, scr, r / 32, r % 32, lane); continue; } r -= I_PLE;
        if (r < I_G + I_U) {
            const bool up = r >= I_G; if (up) r -= I_G;
            const int e = r >> 8, rem = r & 255, kb = rem >> 4, nb = rem & 15, n0 = nb * 32;
            const float* W = (up ? P->in[12] : P->in[11]) + ((size_t)L * N_EXPERTS + e) * wsz;
            const int row_off = (n0 >> 7) * 256 + (up ? 128 : 0) + (n0 & 127) - n0;
            tr_item(W, D_MODEL, D_EXPERT, wgu_t + (size_t)e * D_MODEL * D_MODEL, row_off, scr, kb, nb, lane); continue; }
        r -= I_G + I_U;
        { const int e = r >> 8, rem = r & 255, kb = rem >> 5, nb = rem & 31;
          tr_item(P->in[13] + ((size_t)L * N_EXPERTS + e) * wsz, D_EXPERT, D_MODEL, wd_t + (size_t)e * wsz, 0, scr, kb, nb, lane); }
    }
    const int gtid = blockIdx.x * 512 + tid, gthreads = gridDim.x * 512;
    { const float* wrg = P->in[7] + (size_t)L * D_MODEL * N_GROUPS; const float* wre = P->in[9] + (size_t)L * D_MODEL * N_EXPERTS; float* wrt = (float*)(ws + WS_WPLE + 1 * MiB);
      for (int i = gtid; i < D_MODEL * 36; i += gthreads) { const int c = i >> 10, k = i & 1023; wrt[i] = (c < 4) ? wrg[k * 4 + c] : wre[k * 32 + (c - 4)]; } }
    cvt_rows(P->in[1] + (size_t)L * NTOK * PLE_DIM, (bf16*)(ws + WS_PB), (size_t)NTOK * PLE_DIM / 4, gtid, gthreads);
    if (L == 0) cvt_rows(P->in[0], (bf16*)(ws + WS_HB), (size_t)NTOK * D_MODEL / 4, gtid, gthreads);
}

template <int SRC, bool ROUTER>
__device__ __forceinline__ void phase_ln(KP P, int L, int which, LAS unsigned char* lds, float* dst_f32, bool write_hb, int cidx = -1) {
    int tz = threadIdx.x; asm volatile("" : "+v"(tz));
    const int tid = tz, lane = tid & 63, wave = tid >> 6;
    unsigned char* ws = P->ws;
    const _Float16* t = (const _Float16*)(ws + WS_T); const float* h = (const float*)(ws + WS_H); bf16* hb = (bf16*)(ws + WS_HB);
    const bf16* Y = (const bf16*)(ws + WS_Y);
    int* moe = (int*)(ws + WS_MOE);
    const float* g = P->in[16] + (size_t)(L * 3 + which) * D_MODEL; const float* bt = P->in[17] + (size_t)(L * 3 + which) * D_MODEL;
    LAS float* Wl = (LAS float*)lds;
    LAS float* lgs = (LAS float*)(lds + 147456) + wave * 40;
    if (ROUTER) {
        const float* wrg = P->in[7] + (size_t)L * D_MODEL * N_GROUPS; const float* wre = P->in[9] + (size_t)L * D_MODEL * N_EXPERTS;
        for (int i = tid; i < D_MODEL * 36; i += 512) { const int k = i / 36, c = i % 36; Wl[c * D_MODEL + k] = (c < 4) ? wrg[k * 4 + c] : wre[k * 32 + (c - 4)]; }
        __syncthreads();
    }
    f32x4 gv[4], bv[4];
#pragma unroll
    for (int j = 0; j < 4; ++j) { gv[j] = *(const f32x4*)(g + 4 * lane + 256 * j); bv[j] = *(const f32x4*)(bt + 4 * lane + 256 * j); }
    const int gw = blockIdx.x * NWAVES + wave, NGW = gridDim.x * NWAVES;
    for (int row = gw; row < NTOK; row += NGW) {
        f32x4 v[4];
        if (SRC == 0) {
#pragma unroll
            for (int j = 0; j < 4; ++j) { const f16x4 tv = *(const f16x4*)(t + (size_t)row * D_MODEL + 4 * lane + 256 * j); v[j] = (f32x4){(float)tv[0], (float)tv[1], (float)tv[2], (float)tv[3]}; }
        } else {
            const int s0 = moe[MO_TOK_SLOT + row * 2], s1 = moe[MO_TOK_SLOT + row * 2 + 1];
            const float w0 = ((const float*)moe)[MO_TOK_W + row * 2], w1 = ((const float*)moe)[MO_TOK_W + row * 2 + 1];
#pragma unroll
            for (int j = 0; j < 4; ++j) {
                const f32x4 hv = *(const f32x4*)(h + (size_t)row * D_MODEL + 4 * lane + 256 * j);
                const u32x2 y0 = *(const u32x2*)(Y + (size_t)s0 * D_MODEL + 4 * lane + 256 * j), y1 = *(const u32x2*)(Y + (size_t)s1 * D_MODEL + 4 * lane + 256 * j);
                v[j][0] = hv[0] * ALPHA_F + (w0 * bflo(y0.x) + w1 * bflo(y1.x)); v[j][1] = hv[1] * ALPHA_F + (w0 * bfhi(y0.x) + w1 * bfhi(y1.x));
                v[j][2] = hv[2] * ALPHA_F + (w0 * bflo(y0.y) + w1 * bflo(y1.y)); v[j][3] = hv[3] * ALPHA_F + (w0 * bfhi(y0.y) + w1 * bfhi(y1.y));
            }
        }
        float s = 0.f;
#pragma unroll
        for (int j = 0; j < 4; ++j) s += (v[j][0] + v[j][1]) + (v[j][2] + v[j][3]);
        const float mean = wave_sum(s) * (1.f / D_MODEL);
        float q = 0.f;
#pragma unroll
        for (int j = 0; j < 4; ++j) { v[j] = v[j] - mean; q += (v[j][0] * v[j][0] + v[j][1] * v[j][1]) + (v[j][2] * v[j][2] + v[j][3] * v[j][3]); }
        const float rstd = rsqrtf(wave_sum(q) * (1.f / D_MODEL) + LN_EPS);
#pragma unroll
        for (int j = 0; j < 4; ++j) { v[j] = v[j] * rstd * gv[j] + bv[j]; *(f32x4*)(dst_f32 + (size_t)row * D_MODEL + 4 * lane + 256 * j) = v[j]; }
        if (write_hb) {
#pragma unroll
            for (int j = 0; j < 4; ++j) { u32x2 o; o.x = cvt_pk_bf16(v[j][0], v[j][1]); o.y = cvt_pk_bf16(v[j][2], v[j][3]); *(u32x2*)(hb + (size_t)row * D_MODEL + 4 * lane + 256 * j) = o; }
        }
        if (ROUTER) {
            float lg[36];
#pragma unroll
            for (int c = 0; c < 36; ++c) {
                float a = 0.f;
#pragma unroll
                for (int j = 0; j < 4; ++j) { const f32x4 w = *(const LAS f32x4*)(Wl + c * D_MODEL + 4 * lane + 256 * j); a += (v[j][0] * w[0] + v[j][1] * w[1]) + (v[j][2] * w[2] + v[j][3] * w[3]); }
                lg[c] = wave_sum(a);
            }
            if (lane == 0) {
                const float* brg = P->in[8] + L * N_GROUPS; const float* bre = P->in[10] + L * N_EXPERTS;
                float gl[4];
#pragma unroll
                for (int jj = 0; jj < 4; ++jj) gl[jj] = lg[jj] + brg[jj];
                int gs = 0; float gmax = gl[0];
#pragma unroll
                for (int jj = 1; jj < 4; ++jj) if (gl[jj] > gmax) { gmax = gl[jj]; gs = jj; }
                float den = 0.f;
#pragma unroll
                for (int jj = 0; jj < 4; ++jj) den += expf(gl[jj] - gmax);
                const float gwt = 1.f / den;
                float el[8];
#pragma unroll
                for (int jj = 0; jj < 8; ++jj) el[jj] = 0.f;
#pragma unroll
                for (int c = 0; c < 32; ++c) { if ((c >> 3) == gs) el[c & 7] = lg[4 + c] + bre[c]; }
                int i0 = 0; float v0 = el[0];
#pragma unroll
                for (int jj = 1; jj < 8; ++jj) if (el[jj] > v0) { v0 = el[jj]; i0 = jj; }
                int i1 = -1; float v1 = 0.f;
#pragma unroll
                for (int jj = 0; jj < 8; ++jj) if (jj != i0 && (i1 < 0 || el[jj] > v1)) { v1 = el[jj]; i1 = jj; }
                const float e1 = expf(v1 - v0);
                const float w0 = gwt / (1.f + e1), w1 = gwt * e1 / (1.f + e1);
                const int ea = gs * 8 + i0, eb = gs * 8 + i1;
                unsigned* cnt = (unsigned*)(ws + WS_CTL) + CW_CNT + (cidx < 0 ? L : cidx) * 32;
                const int pa = (int)atomicAdd(&cnt[ea], 1u), pb = (int)atomicAdd(&cnt[eb], 1u);
                moe[MO_TOK_E + row * 2] = ea; moe[MO_TOK_E + row * 2 + 1] = eb; moe[MO_TOK_POS + row * 2] = pa; moe[MO_TOK_POS + row * 2 + 1] = pb;
                ((float*)moe)[MO_TOK_W + row * 2] = w0; ((float*)moe)[MO_TOK_W + row * 2 + 1] = w1;
            }
        }
    }
    (void)lgs;
}


__device__ __forceinline__ void phase_ln_router(KP P, int L, LAS unsigned char* lds, int cidx) {
    int tz = threadIdx.x; asm volatile("" : "+v"(tz)); const int tid = tz, lane = tid & 63, wave = tid >> 6;
    unsigned char* ws = P->ws;
    const _Float16* t = (const _Float16*)(ws + WS_T); float* h = (float*)(ws + WS_H); bf16* hb = (bf16*)(ws + WS_HB);
    int* moe = (int*)(ws + WS_MOE);
    const float* g = P->in[16] + (size_t)(L * 3) * D_MODEL; const float* bt = P->in[17] + (size_t)(L * 3) * D_MODEL;
    LAS float* Wl = (LAS float*)lds;
    LAS float* lgs = (LAS float*)(lds + 147456) + wave * 80;
    LAS int* lcnt = (LAS int*)(lds + 150016);
    LAS int* rinfo = (LAS int*)(lds + 150272);
    { const f32x4* wrt = (const f32x4*)(ws + WS_WPLE + 1 * MiB);
      for (int i = tid; i < D_MODEL * 36 / 4; i += 512) ((LAS f32x4*)Wl)[i] = wrt[i];
      if (tid < 64) lcnt[tid] = 0; }
    __syncthreads();
    f32x4 gv[4], bv[4];
#pragma unroll
    for (int j = 0; j < 4; ++j) { gv[j] = *(const f32x4*)(g + 4 * lane + 256 * j); bv[j] = *(const f32x4*)(bt + 4 * lane + 256 * j); }
    const float* brg = P->in[8] + L * N_GROUPS; const float* bre = P->in[10] + L * N_EXPERTS;
    const int gw = blockIdx.x * NWAVES + wave, NGW = gridDim.x * NWAVES;
    int it = 0;
    for (int pi = gw; pi < NTOK / 2; pi += NGW, ++it) {
        const int row0 = pi * 2;
        f32x4 va[4], vb[4];
#pragma unroll
        for (int j = 0; j < 4; ++j) { const f16x4 ta = *(const f16x4*)(t + (size_t)row0 * D_MODEL + 4 * lane + 256 * j), tb2 = *(const f16x4*)(t + (size_t)(row0 + 1) * D_MODEL + 4 * lane + 256 * j);
            va[j] = (f32x4){(float)ta[0], (float)ta[1], (float)ta[2], (float)ta[3]}; vb[j] = (f32x4){(float)tb2[0], (float)tb2[1], (float)tb2[2], (float)tb2[3]}; }
        float sa = 0.f, sb = 0.f;
#pragma unroll
        for (int j = 0; j < 4; ++j) { sa += (va[j][0] + va[j][1]) + (va[j][2] + va[j][3]); sb += (vb[j][0] + vb[j][1]) + (vb[j][2] + vb[j][3]); }
        const float ma = wave_sum(sa) * (1.f / D_MODEL), mb_ = wave_sum(sb) * (1.f / D_MODEL);
        float qa = 0.f, qb = 0.f;
#pragma unroll
        for (int j = 0; j < 4; ++j) { va[j] = va[j] - ma; vb[j] = vb[j] - mb_;
            qa += (va[j][0] * va[j][0] + va[j][1] * va[j][1]) + (va[j][2] * va[j][2] + va[j][3] * va[j][3]);
            qb += (vb[j][0] * vb[j][0] + vb[j][1] * vb[j][1]) + (vb[j][2] * vb[j][2] + vb[j][3] * vb[j][3]); }
        const float ra = rsqrtf(wave_sum(qa) * (1.f / D_MODEL) + LN_EPS), rb = rsqrtf(wave_sum(qb) * (1.f / D_MODEL) + LN_EPS);
#pragma unroll
        for (int j = 0; j < 4; ++j) { va[j] = va[j] * ra * gv[j] + bv[j]; vb[j] = vb[j] * rb * gv[j] + bv[j];
            *(f32x4*)(h + (size_t)row0 * D_MODEL + 4 * lane + 256 * j) = va[j]; *(f32x4*)(h + (size_t)(row0 + 1) * D_MODEL + 4 * lane + 256 * j) = vb[j];
            u32x2 oa, ob; oa.x = cvt_pk_bf16(va[j][0], va[j][1]); oa.y = cvt_pk_bf16(va[j][2], va[j][3]); ob.x = cvt_pk_bf16(vb[j][0], vb[j][1]); ob.y = cvt_pk_bf16(vb[j][2], vb[j][3]);
            *(u32x2*)(hb + (size_t)row0 * D_MODEL + 4 * lane + 256 * j) = oa; *(u32x2*)(hb + (size_t)(row0 + 1) * D_MODEL + 4 * lane + 256 * j) = ob; }
#pragma unroll
        for (int p = 0; p < 18; ++p) {
            f32x2 a0 = {0.f, 0.f}, a1 = {0.f, 0.f};
#pragma unroll
            for (int j = 0; j < 4; ++j) { const f32x4 w0 = *(const LAS f32x4*)(Wl + (2 * p) * D_MODEL + 4 * lane + 256 * j), w1 = *(const LAS f32x4*)(Wl + (2 * p + 1) * D_MODEL + 4 * lane + 256 * j);
#pragma unroll
                for (int i = 0; i < 4; ++i) { const f32x2 y = {va[j][i], vb[j][i]}; a0 = a0 + y * w0[i]; a1 = a1 + y * w1[i]; } }
            float ra2[2];
#pragma unroll
            for (int rr = 0; rr < 2; ++rr) {
                auto sw = __builtin_amdgcn_permlane32_swap(__float_as_uint(rr ? a0.y : a0.x), __float_as_uint(rr ? a1.y : a1.x), false, false);
                float v = __uint_as_float(sw[0]) + __uint_as_float(sw[1]);
                v = row16_sum(v); v += __shfl_xor(v, 16); ra2[rr] = v; }
            if ((lane & 31) == 0) { const int ci = 2 * p + (lane >> 5); lgs[ci] = ra2[0]; lgs[40 + ci] = ra2[1]; }
            __builtin_amdgcn_sched_barrier(0);
        }
        asm volatile("s_waitcnt lgkmcnt(0)" ::: "memory");
        if (lane == 0 || lane == 32) {
            const int rr = lane >> 5; LAS float* lg = lgs + rr * 40;
            float gl[4];
#pragma unroll
            for (int jj = 0; jj < 4; ++jj) gl[jj] = lg[jj] + brg[jj];
            int gs = 0; float gmax = gl[0];
#pragma unroll
            for (int jj = 1; jj < 4; ++jj) if (gl[jj] > gmax) { gmax = gl[jj]; gs = jj; }
            float den = 0.f;
#pragma unroll
            for (int jj = 0; jj < 4; ++jj) den += expf(gl[jj] - gmax);
            const float gwt = 1.f / den;
            float el[8];
#pragma unroll
            for (int jj = 0; jj < 8; ++jj) el[jj] = lg[4 + gs * 8 + jj] + bre[gs * 8 + jj];
            int i0 = 0; float v0 = el[0];
#pragma unroll
            for (int jj = 1; jj < 8; ++jj) if (el[jj] > v0) { v0 = el[jj]; i0 = jj; }
            int i1 = -1; float v1 = 0.f;
#pragma unroll
            for (int jj = 0; jj < 8; ++jj) if (jj != i0 && (i1 < 0 || el[jj] > v1)) { v1 = el[jj]; i1 = jj; }
            const float e1 = expf(v1 - v0);
            const float w0 = gwt / (1.f + e1), w1 = gwt * e1 / (1.f + e1);
            const int ea = gs * 8 + i0, eb = gs * 8 + i1;
            const int pa = __hip_atomic_fetch_add(lcnt + ea, 1, __ATOMIC_RELAXED, __HIP_MEMORY_SCOPE_WORKGROUP), pb2 = __hip_atomic_fetch_add(lcnt + eb, 1, __ATOMIC_RELAXED, __HIP_MEMORY_SCOPE_WORKGROUP);
            LAS int* ri = rinfo + ((it * NWAVES + wave) * 2 + rr) * 5;
            ri[0] = ea | (eb << 8); ri[1] = pa; ri[2] = pb2; ri[3] = __float_as_int(w0); ri[4] = __float_as_int(w1);
        }
    }
    __syncthreads();
    if (tid < 32) { const int n = lcnt[tid]; unsigned* cnt = (unsigned*)(ws + WS_CTL) + CW_CNT + cidx * 32; lcnt[32 + tid] = n ? (int)atomicAdd(&cnt[tid], (unsigned)n) : 0; }
    __syncthreads();
    for (int sl = tid; sl < it * NWAVES * 2; sl += 512) {
        const int i2 = sl / (NWAVES * 2), w2 = (sl >> 1) & (NWAVES - 1), rr = sl & 1;
        const int row = ((blockIdx.x * NWAVES + w2) + i2 * NGW) * 2 + rr;
        if (row < NTOK) { const LAS int* ri = rinfo + sl * 5; const int ea = ri[0] & 255, eb = ri[0] >> 8;
            moe[MO_TOK_E + row * 2] = ea; moe[MO_TOK_E + row * 2 + 1] = eb; moe[MO_TOK_POS + row * 2] = lcnt[32 + ea] + ri[1]; moe[MO_TOK_POS + row * 2 + 1] = lcnt[32 + eb] + ri[2];
            moe[MO_TOK_W + row * 2] = ri[3]; moe[MO_TOK_W + row * 2 + 1] = ri[4]; }
    }
}

__device__ __forceinline__ void phase_moe_prep(KP P, int L, LAS unsigned char* lds) {
    int tz = threadIdx.x; asm volatile("" : "+v"(tz));
    const int tid = tz;
    unsigned char* ws = P->ws; int* moe = (int*)(ws + WS_MOE);
    const unsigned* cnt = (const unsigned*)(ws + WS_CTL) + CW_CNT + L * 32;
    LAS int* sb = (LAS int*)lds;
    LAS int* sc = (LAS int*)lds + 64;
    if (tid < 32) sc[tid] = (int)cnt[tid];
    __syncthreads();
    if (tid == 0) { int s = 0; for (int e = 0; e < N_EXPERTS; ++e) { sb[e] = s; s += (sc[e] + 255) / 256 * 256; } sb[N_EXPERTS] = s; }
    __syncthreads();
    const int ntiles = sb[N_EXPERTS] / 256;
    if (blockIdx.x == 0) {
        if (tid == 0) *((unsigned*)(ws + WS_CTL) + CW_NTILES + L) = (unsigned)ntiles;
        for (int T = tid; T < ntiles; T += 512) {
            const int r = T * 256; int e = 0;
            for (int x = 0; x < N_EXPERTS; ++x) if (r >= sb[x] && r < sb[x + 1]) e = x;
            const int nv = sc[e] - (r - sb[e]);
            moe[MO_TILE_E + T] = e; moe[MO_TILE_ROW0 + T] = r; moe[MO_TILE_NV + T] = nv < 256 ? nv : 256;
        }
    }
    for (int a = blockIdx.x * 512 + tid; a < NTOK * 2; a += gridDim.x * 512) {
        const int slot = sb[moe[MO_TOK_E + a]] + moe[MO_TOK_POS + a];
        moe[MO_SLOT_TOK + slot] = a >> 1; moe[MO_TOK_SLOT + a] = slot;
    }
}


namespace mb {
typedef short s16x4 __attribute__((ext_vector_type(4)));
typedef float f32x16 __attribute__((ext_vector_type(16)));
constexpr int SHM_V = 64 * 128 * 2, SHM_K = 64 * 128 * 2, V_OFF = 0, K_OFF = 2 * SHM_V, PRE_OFF = 65536;
constexpr float SCALE = 0.08838834764831845f, LOG2E = 1.4426950408889634f, CC = SCALE * LOG2E, THRX = 8.f * LOG2E;
#define MB_KSWZ(row, colB) ((row) * 256 + ((colB) ^ (((row) & 7) << 4)))
__device__ __forceinline__ int v_st(int k, int c) { const int kk = (k & ~0xC) | ((k & 4) << 1) | ((k & 8) >> 1); return ((kk >> 3) * 4 + (c >> 5)) * 512 + ((kk & 7) * 32 + (c & 31)) * 2; }
__device__ __forceinline__ int v_rd_base(int lane) { return ((lane & 3) << 3) | (((lane >> 2) & 3) << 6) | (((lane >> 4) & 1) << 5) | (((lane >> 5) & 1) << 8); }
constexpr int v_rd_off(int d0, int ks, int half) { return d0 * 512 + ks * 4096 + half * 2048; }
template <int OFF> __device__ __forceinline__ s16x4 tr_read(int vb) { s16x4 r; asm volatile("ds_read_b64_tr_b16 %0, %1 offset:%2" : "=&v"(r) : "v"(vb), "i"(OFF) : "memory"); return r; }
#define MB_SBAR() __builtin_amdgcn_sched_barrier(0)

__device__ __forceinline__ void qkt(f32x16& p0, f32x16& p1, LAS unsigned char* Ks, const bf16x8 (&qr)[8], int r32, int hi) {
    p0 = f32x16{}; p1 = f32x16{};
#pragma unroll
    for (int d0 = 0; d0 < 8; ++d0) { const int cb = (d0 * 16 + hi * 8) * 2;
        const bf16x8 b0 = *(const LAS bf16x8*)(Ks + MB_KSWZ(r32, cb));
        const bf16x8 b1 = *(const LAS bf16x8*)(Ks + MB_KSWZ(32 + r32, cb));
        p0 = __builtin_amdgcn_mfma_f32_32x32x16_bf16(b0, qr[d0], p0, 0, 0, 0);
        p1 = __builtin_amdgcn_mfma_f32_32x32x16_bf16(b1, qr[d0], p1, 0, 0, 0); }
}
__device__ __forceinline__ void partialSM(f32x16& p0, f32x16& p1, float& m_reg, float& mn, float& alpha, float bias2, float tb4, bool own, int lim) {
#pragma unroll
    for (int r = 0; r < 16; ++r) { const float kc = (float)((r & 3) + 8 * (r >> 2));
        p0[r] = fmaf(p0[r], CC, fmaf(bias2, kc, tb4)); p1[r] = fmaf(p1[r], CC, fmaf(bias2, kc + 32.f, tb4)); }
    if (own) {
#pragma unroll
        for (int r = 0; r < 16; ++r) { const int kc = (r & 3) + 8 * (r >> 2); if (kc > lim) p0[r] = -INFINITY; if (kc + 32 > lim) p1[r] = -INFINITY; }
    }
    float pmax = p0[0];
#pragma unroll
    for (int r = 1; r < 16; ++r) pmax = fmaxf(pmax, p0[r]);
#pragma unroll
    for (int r = 0; r < 16; ++r) pmax = fmaxf(pmax, p1[r]);
    { auto rr = __builtin_amdgcn_permlane32_swap(__float_as_uint(pmax), __float_as_uint(pmax), false, false); pmax = fmaxf(__uint_as_float(rr[0]), __uint_as_float(rr[1])); }
    if (__builtin_expect(__all(pmax - m_reg <= THRX), 1)) { mn = m_reg; alpha = 1.f; }
    else { mn = fmaxf(m_reg, pmax); alpha = __builtin_amdgcn_exp2f(m_reg - mn); m_reg = mn; }
#pragma unroll
    for (int r = 0; r < 16; ++r) { p0[r] = p0[r] - mn; p1[r] = p1[r] - mn; }
#pragma unroll
    for (int r = 0; r < 16; ++r) p0[r] = __builtin_amdgcn_exp2f(p0[r]);
}
__device__ __forceinline__ void finishSM(f32x16& p0, f32x16& p1, float alpha, float& l_reg, bf16x8& pa0, bf16x8& pa1, bf16x8& pa2, bf16x8& pa3) {
#pragma unroll
    for (int r = 0; r < 16; ++r) p1[r] = __builtin_amdgcn_exp2f(p1[r]);
    float ps = 0.f;
#pragma unroll
    for (int r = 0; r < 16; ++r) ps += p0[r];
#pragma unroll
    for (int r = 0; r < 16; ++r) ps += p1[r];
    { auto rr = __builtin_amdgcn_permlane32_swap(__float_as_uint(ps), __float_as_uint(ps), false, false); ps = __uint_as_float(rr[0]) + __uint_as_float(rr[1]); }
    l_reg = l_reg * alpha + ps;
#define MB_PK4(P, BASE, OUT) do { unsigned a0 = cvt_pk_bf16(P[BASE + 0], P[BASE + 1]), a1 = cvt_pk_bf16(P[BASE + 2], P[BASE + 3]); \
    unsigned b0 = cvt_pk_bf16(P[BASE + 4], P[BASE + 5]), b1 = cvt_pk_bf16(P[BASE + 6], P[BASE + 7]); \
    auto r0 = __builtin_amdgcn_permlane32_swap(a0, b0, false, false); auto r1 = __builtin_amdgcn_permlane32_swap(a1, b1, false, false); \
    u32x4 w = {r0[0], r1[0], r0[1], r1[1]}; OUT = *reinterpret_cast<bf16x8*>(&w); } while (0)
    MB_PK4(p0, 0, pa0); MB_PK4(p0, 8, pa1); MB_PK4(p1, 0, pa2); MB_PK4(p1, 8, pa3);
#undef MB_PK4
}
template <int D0> __device__ __forceinline__ void pv_one(f32x16& od, int vb, bf16x8 pa0, bf16x8 pa1, bf16x8 pa2, bf16x8 pa3) {
    const s16x4 l0 = tr_read<v_rd_off(D0, 0, 0)>(vb), h0 = tr_read<v_rd_off(D0, 0, 1)>(vb), l1 = tr_read<v_rd_off(D0, 1, 0)>(vb), h1 = tr_read<v_rd_off(D0, 1, 1)>(vb);
    const s16x4 l2 = tr_read<v_rd_off(D0, 2, 0)>(vb), h2 = tr_read<v_rd_off(D0, 2, 1)>(vb), l3 = tr_read<v_rd_off(D0, 3, 0)>(vb), h3 = tr_read<v_rd_off(D0, 3, 1)>(vb);
    asm volatile("s_waitcnt lgkmcnt(0)" ::: "memory"); MB_SBAR();
#define MB_PK(L, H) (bf16x8){L[0], L[1], L[2], L[3], H[0], H[1], H[2], H[3]}
    od = __builtin_amdgcn_mfma_f32_32x32x16_bf16(MB_PK(l0, h0), pa0, od, 0, 0, 0);
    od = __builtin_amdgcn_mfma_f32_32x32x16_bf16(MB_PK(l1, h1), pa1, od, 0, 0, 0);
    od = __builtin_amdgcn_mfma_f32_32x32x16_bf16(MB_PK(l2, h2), pa2, od, 0, 0, 0);
    od = __builtin_amdgcn_mfma_f32_32x32x16_bf16(MB_PK(l3, h3), pa3, od, 0, 0, 0);
#undef MB_PK
}
__device__ __forceinline__ void pv_d0(f32x16 (&o)[4], int vb, bf16x8 pa0, bf16x8 pa1, bf16x8 pa2, bf16x8 pa3) {
    pv_one<0>(o[0], vb, pa0, pa1, pa2, pa3); pv_one<1>(o[1], vb, pa0, pa1, pa2, pa3); pv_one<2>(o[2], vb, pa0, pa1, pa2, pa3); pv_one<3>(o[3], vb, pa0, pa1, pa2, pa3);
}

__device__ __forceinline__ void item(const bf16* __restrict__ q, const bf16* __restrict__ kv, bf16* __restrict__ part_o, float* __restrict__ part_ml, LAS unsigned char* lds,
                                     int tid, int b, int g, int kblk, int NT, bool own, int t, int rh, int slot, bool valid) {
    const int lane = tid & 63, r32 = lane & 31, hi = lane >> 5;
    const int h = g * 4 + rh;
    const bf16* Kh = kv + (size_t)(b * SEQ + kblk * MOBA_BLOCK) * 512 + g * HEAD_DIM;
    float m_reg = -1e30f, l_reg = 0.f; f32x16 o[4] = {}; bf16x8 qr[8];
    { const bf16* Qw = q + (size_t)(b * SEQ + t) * D_MODEL + h * HEAD_DIM + hi * 8;
#pragma unroll
      for (int d0 = 0; d0 < 8; ++d0) qr[d0] = *(const bf16x8*)(Qw + d0 * 16); }
    const float bias2 = __builtin_amdgcn_exp2f(-(float)(h + 1)) * LOG2E;
    const int trel = t - kblk * MOBA_BLOCK;
    const float tb4 = bias2 * (float)(4 * hi - trel);
    const int lim0 = trel - 4 * hi;
    const int sr = tid >> 4, sc = (tid & 15) * 8, vst0 = v_st(sr, sc), vst1 = v_st(32 + sr, sc);
    const int vb0 = (int)(unsigned)(uintptr_t)(lds + V_OFF) + v_rd_base(lane);
    bf16x8 vsA0, vsA1, ksA0, ksA1, vsB0, vsB1, ksB0, ksB1;
    const unsigned vo0 = (unsigned)(sr * 512 + sc) * 2u, vo1 = vo0 + 32u * 1024u;
    const char* KhB = (const char*)Kh;
#define MB_SLOAD_A(k0) do { const char* kt_ = KhB + (size_t)(k0) * 1024; vsA0 = *(const bf16x8*)(kt_ + 512 + vo0); vsA1 = *(const bf16x8*)(kt_ + 512 + vo1); \
        ksA0 = *(const bf16x8*)(kt_ + vo0); ksA1 = *(const bf16x8*)(kt_ + vo1); } while (0)
#define MB_SLOAD_B(k0) do { const char* kt_ = KhB + (size_t)(k0) * 1024; vsB0 = *(const bf16x8*)(kt_ + 512 + vo0); vsB1 = *(const bf16x8*)(kt_ + 512 + vo1); \
        ksB0 = *(const bf16x8*)(kt_ + vo0); ksB1 = *(const bf16x8*)(kt_ + vo1); } while (0)
#define MB_SWRITE(bb, V0, V1, K0, K1) do { *(LAS bf16x8*)(lds + V_OFF + (bb) * SHM_V + vst0) = V0; *(LAS bf16x8*)(lds + V_OFF + (bb) * SHM_V + vst1) = V1; \
        *(LAS bf16x8*)(lds + K_OFF + (bb) * SHM_K + MB_KSWZ(sr, sc * 2)) = K0; *(LAS bf16x8*)(lds + K_OFF + (bb) * SHM_K + MB_KSWZ(32 + sr, sc * 2)) = K1; } while (0)
#define MB_SWAIT() asm volatile("s_waitcnt vmcnt(4)" ::: "memory")
#define MB_RESC(a) do { if (__any((a) < 1.f)) { _Pragma("unroll") for (int d = 0; d < 4; ++d) _Pragma("unroll") for (int r = 0; r < 16; ++r) o[d][r] *= (a); } } while (0)
#define MB_PSM(P0, P1, MN, AL, tile) partialSM(P0, P1, m_reg, MN, AL, bias2, tb4 + bias2 * (float)((tile) * 64), own, lim0 - (tile) * 64)
    f32x16 pA0, pA1, pB0, pB1; float mnA, mnB, alA, alB; bf16x8 pa0, pa1, pa2, pa3;
    MB_SLOAD_A(0); asm volatile("s_waitcnt vmcnt(0)" ::: "memory"); MB_SWRITE(0, vsA0, vsA1, ksA0, ksA1); __syncthreads();
    qkt(pA0, pA1, lds + K_OFF, qr, r32, hi); MB_PSM(pA0, pA1, mnA, alA, 0);
    MB_SLOAD_B(64); if (2 < NT) MB_SLOAD_A(128);
    MB_SWAIT(); MB_SWRITE(1, vsB0, vsB1, ksB0, ksB1); __syncthreads();
    for (int j = 1; j + 1 < NT; j += 2) {
        MB_SBAR(); qkt(pB0, pB1, lds + K_OFF + SHM_K, qr, r32, hi);
        finishSM(pA0, pA1, alA, l_reg, pa0, pa1, pa2, pa3); MB_SBAR();
        MB_SLOAD_B((j + 2) * 64); MB_SBAR();
        pv_d0(o, vb0, pa0, pa1, pa2, pa3); MB_PSM(pB0, pB1, mnB, alB, j);
        __syncthreads(); MB_SWAIT(); MB_SWRITE(0, vsA0, vsA1, ksA0, ksA1);
        MB_RESC(alB); __syncthreads();
        MB_SBAR(); qkt(pA0, pA1, lds + K_OFF, qr, r32, hi);
        finishSM(pB0, pB1, alB, l_reg, pa0, pa1, pa2, pa3); MB_SBAR();
        if (j + 3 < NT) MB_SLOAD_A((j + 3) * 64); MB_SBAR();
        pv_d0(o, vb0 + SHM_V, pa0, pa1, pa2, pa3); MB_PSM(pA0, pA1, mnA, alA, j + 1);
        __syncthreads(); MB_SWAIT(); MB_SWRITE(1, vsB0, vsB1, ksB0, ksB1);
        MB_RESC(alA); __syncthreads();
    }
    MB_SBAR(); qkt(pB0, pB1, lds + K_OFF + SHM_K, qr, r32, hi);
    finishSM(pA0, pA1, alA, l_reg, pa0, pa1, pa2, pa3); MB_SBAR();
    pv_d0(o, vb0, pa0, pa1, pa2, pa3); MB_PSM(pB0, pB1, mnB, alB, NT - 1);
    __syncthreads(); MB_RESC(alB);
    finishSM(pB0, pB1, alB, l_reg, pa0, pa1, pa2, pa3); MB_SBAR();
    pv_d0(o, vb0 + SHM_V, pa0, pa1, pa2, pa3);
    if (valid) {
        const float inv = 1.f / l_reg;
        const size_t rg = ((size_t)(b * SEQ + t) * N_HEADS + h) * 4 + slot;
        bf16* po = part_o + rg * HEAD_DIM + 4 * hi;
#pragma unroll
        for (int d0 = 0; d0 < 4; ++d0)
#pragma unroll
            for (int rq = 0; rq < 4; ++rq) { u32x2 w; w.x = cvt_pk_bf16(o[d0][rq * 4 + 0] * inv, o[d0][rq * 4 + 1] * inv); w.y = cvt_pk_bf16(o[d0][rq * 4 + 2] * inv, o[d0][rq * 4 + 3] * inv);
                *(u32x2*)(po + d0 * 32 + rq * 8) = w; }
        if (hi == 0) { f32x2 ml; ml.x = m_reg; ml.y = l_reg; *(f32x2*)(part_ml + rg * 2) = ml; }
    }
    __syncthreads();
#undef MB_SLOAD_A
#undef MB_SLOAD_B
#undef MB_SWRITE
#undef MB_SWAIT
#undef MB_RESC
#undef MB_PSM
}
}

constexpr size_t WS_SELB = WS_T;
constexpr size_t WS_PML = WS_T + 2 * MiB;
constexpr size_t WS_LISTS = WS_T + 16 * MiB;
constexpr size_t WS_PARTO = WS_SCORES;
constexpr int CW_LCNT = 16384 + 512;

__device__ __forceinline__ void phase_kmeans(KP P) {
    int tz = threadIdx.x; asm volatile("" : "+v"(tz)); const int tid = tz;
    const bf16* kv = (const bf16*)(P->ws + WS_KV); float* km = (float*)(P->ws + WS_KM);
    for (int it = blockIdx.x; it < BATCH * N_KV * N_BLOCKS; it += gridDim.x) {
        const int blk = it % N_BLOCKS, g = (it / N_BLOCKS) % N_KV, b = it / (N_BLOCKS * N_KV);
        if (tid < HEAD_DIM) { float s = 0.f;
            for (int i = 0; i < MOBA_BLOCK; ++i) s += bf2f(kv[(size_t)(b * SEQ + blk * MOBA_BLOCK + i) * 512 + g * HEAD_DIM + tid]);
            const float mval = s * (1.f / MOBA_BLOCK); km[(size_t)it * HEAD_DIM + tid] = mval;
            const unsigned hi16 = cvt_pk_bf16(mval, 0.f) & 0xffffu; const float rem = mval - bflo(hi16);
            bf16* kmh = (bf16*)(km + 65536); kmh[(size_t)it * HEAD_DIM + tid] = (bf16)hi16; kmh[(size_t)(BATCH * N_KV * N_BLOCKS + it) * HEAD_DIM + tid] = (bf16)(cvt_pk_bf16(rem, 0.f) & 0xffffu); }
    }
}
__device__ __forceinline__ void phase_moba_gate(KP P, LAS unsigned char* lds) {
    int tz = threadIdx.x; asm volatile("" : "+v"(tz)); const int tid = tz, lane = tid & 63, wave = tid >> 6;
    const bf16* q = (const bf16*)(P->ws + WS_QKVI); const float* km = (const float*)(P->ws + WS_KM); unsigned char* selb = (unsigned char*)(P->ws + WS_SELB);
    LAS float* qs = (LAS float*)(lds + wave * 2048);
    const int blk = lane & 31, half = lane >> 5;
    for (int it = blockIdx.x * NWAVES + wave; it < NTOK * 2; it += gridDim.x * NWAVES) {
        const int tok = it >> 1, g = it & 1, b = tok / SEQ, t = tok % SEQ, own = t >> 8;
        unsigned char* sb = selb + ((size_t)tok * 8 + g * 4) * 4;
        if (own < 3) { if (lane < 4) { for (int s2 = own; s2 < 3; ++s2) sb[lane * 4 + s2] = 0xFF; } }
        if (own == 0) continue;
        { const u32x4 w = *(const u32x4*)(q + (size_t)tok * D_MODEL + g * 512 + lane * 8);
          LAS float* d = qs + lane * 8;
          d[0] = bflo(w.x); d[1] = bfhi(w.x); d[2] = bflo(w.y); d[3] = bfhi(w.y); d[4] = bflo(w.z); d[5] = bfhi(w.z); d[6] = bflo(w.w); d[7] = bfhi(w.w); }
        asm volatile("s_waitcnt lgkmcnt(0)" ::: "memory");
        float acc[4] = {0.f, 0.f, 0.f, 0.f};
        const float* kp = km + ((size_t)(b * N_KV + g) * N_BLOCKS + blk) * HEAD_DIM + half * 64;
#pragma unroll 4
        for (int i = 0; i < 16; ++i) { const f32x4 kk = *(const f32x4*)(kp + 4 * i);
#pragma unroll
            for (int r = 0; r < 4; ++r) { const f32x4 qq = *(const LAS f32x4*)(qs + r * 128 + half * 64 + 4 * i); acc[r] += (kk[0] * qq[0] + kk[1] * qq[1]) + (kk[2] * qq[2] + kk[3] * qq[3]); } }
#pragma unroll
        for (int r = 0; r < 4; ++r) { acc[r] += __shfl_xor(acc[r], 32); if (blk >= own) acc[r] = -INFINITY; }
        int rank[4] = {0, 0, 0, 0};
#pragma unroll
        for (int j = 0; j < 32; ++j) {
#pragma unroll
            for (int r = 0; r < 4; ++r) { const float vj = __uint_as_float(__builtin_amdgcn_readlane(__float_as_uint(acc[r]), j)); rank[r] += (vj > acc[r] || (vj == acc[r] && j < blk)) ? 1 : 0; }
        }
        if (half == 0 && blk < own) {
#pragma unroll
            for (int r = 0; r < 4; ++r) if (rank[r] < 3) sb[r * 4 + rank[r]] = (unsigned char)blk;
        }
    }
}

__device__ __forceinline__ void phase_moba_gate2(KP P) {
    typedef float f32x16 __attribute__((ext_vector_type(16)));
    int tz = threadIdx.x; asm volatile("" : "+v"(tz)); const int tid = tz, lane = tid & 63, wave = tid >> 6, r32 = lane & 31, hi = lane >> 5;
    const bf16* q = (const bf16*)(P->ws + WS_QKVI); const bf16* kmh = (const bf16*)((const float*)(P->ws + WS_KM) + 65536); unsigned char* selb = (unsigned char*)(P->ws + WS_SELB);
    const int gw = blockIdx.x * NWAVES + wave, NGW = gridDim.x * NWAVES;
    int cur_bg = -1; bf16x8 ah[8], al[8];
    for (int tile = gw * 4; tile < 8192; tile += NGW * 4) {
#pragma unroll 1
        for (int sub = 0; sub < 4; ++sub) {
            const int tl = tile + sub, bg = tl >> 10, b = bg >> 1, g = bg & 1, rt = tl & 1023;
            if (bg != cur_bg) { cur_bg = bg;
                const bf16* kp = kmh + ((size_t)(b * N_KV + g) * N_BLOCKS + r32) * HEAD_DIM + 8 * hi;
#pragma unroll
                for (int ks = 0; ks < 8; ++ks) { ah[ks] = *(const bf16x8*)(kp + 16 * ks); al[ks] = *(const bf16x8*)(kp + (size_t)BATCH * N_KV * N_BLOCKS * HEAD_DIM + 16 * ks); } }
            const int row = rt * 32 + r32, t = row >> 2, rh = row & 3, own = t >> 8, tok = b * SEQ + t;
            const bf16* qp = q + (size_t)tok * D_MODEL + (g * 4 + rh) * HEAD_DIM + 8 * hi;
            f32x16 acc = {};
#pragma unroll
            for (int ks = 0; ks < 8; ++ks) { const bf16x8 qv = *(const bf16x8*)(qp + 16 * ks);
                acc = __builtin_amdgcn_mfma_f32_32x32x16_bf16(ah[ks], qv, acc, 0, 0, 0); acc = __builtin_amdgcn_mfma_f32_32x32x16_bf16(al[ks], qv, acc, 0, 0, 0); }
            float v[16];
#pragma unroll
            for (int r = 0; r < 16; ++r) { const int blk = (r & 3) + 8 * (r >> 2) + 4 * hi; v[r] = (blk < own) ? acc[r] : -INFINITY; }
            float bv[3]; int bi[3];
#pragma unroll
            for (int p = 0; p < 3; ++p) { float best = -INFINITY; int br = -1;
#pragma unroll
                for (int r = 0; r < 16; ++r) { if (v[r] > best) { best = v[r]; br = r; } }
                bv[p] = best; bi[p] = (br < 0) ? 255 : ((br & 3) + 8 * (br >> 2) + 4 * hi);
#pragma unroll
                for (int r = 0; r < 16; ++r) { if (r == br) v[r] = -INFINITY; } }
            float ov[3]; int oi[3];
#pragma unroll
            for (int p = 0; p < 3; ++p) { ov[p] = __shfl_xor(bv[p], 32); oi[p] = __shfl_xor(bi[p], 32); }
            int ia = 0, ib = 0; int res[3];
#pragma unroll
            for (int p = 0; p < 3; ++p) {
                const float va = (ia == 0) ? bv[0] : (ia == 1) ? bv[1] : (ia == 2) ? bv[2] : -INFINITY; const int xa = (ia == 0) ? bi[0] : (ia == 1) ? bi[1] : (ia == 2) ? bi[2] : 255;
                const float vb = (ib == 0) ? ov[0] : (ib == 1) ? ov[1] : (ib == 2) ? ov[2] : -INFINITY; const int xb = (ib == 0) ? oi[0] : (ib == 1) ? oi[1] : (ib == 2) ? oi[2] : 255;
                const bool takeA = (va > vb) || (va == vb && xa < xb);
                const float vv = takeA ? va : vb; const int xx = takeA ? xa : xb;
                res[p] = (vv > -INFINITY) ? xx : 255; if (takeA) ++ia; else ++ib; }
            if (hi == 0) { const unsigned w = (unsigned)res[0] | ((unsigned)res[1] << 8) | ((unsigned)res[2] << 16) | 0xFF000000u;
                *(unsigned*)(selb + ((size_t)tok * 8 + g * 4 + rh) * 4) = w; }
        }
    }
}

__device__ __forceinline__ void phase_moba_lists(KP P, LAS unsigned char* lds) {
    int tz = threadIdx.x; asm volatile("" : "+v"(tz)); const int tid = tz, lane = tid & 63, wave = tid >> 6;
    const u32x4* selb = (const u32x4*)(P->ws + WS_SELB); unsigned* lists = (unsigned*)(P->ws + WS_LISTS); unsigned* lcnt = (unsigned*)(P->ws + WS_CTL) + CW_LCNT;
    LAS int* wtot = (LAS int*)lds;
    for (int li = blockIdx.x; li < 256; li += gridDim.x) {
        const int j = li & 31, g = (li >> 5) & 1, b = li >> 6, base_t = (j + 1) * MOBA_BLOCK, n_t = SEQ - base_t;
        unsigned* out = lists + (size_t)li * 32768;
        int running = 0;
        for (int i0 = 0; i0 < n_t; i0 += 512) {
            const int ti = i0 + tid; const bool ok = ti < n_t; const int t = base_t + ti;
            u32x4 w = {0xFFFFFFFFu, 0xFFFFFFFFu, 0xFFFFFFFFu, 0xFFFFFFFFu};
            if (ok) w = selb[((size_t)(b * SEQ + t) * 8 + g * 4) / 4];
            int ms[4];
#pragma unroll
            for (int r = 0; r < 4; ++r) { const unsigned x = w[r]; ms[r] = ((x & 0xFFu) == (unsigned)j) ? 0 : (((x >> 8) & 0xFFu) == (unsigned)j) ? 1 : (((x >> 16) & 0xFFu) == (unsigned)j) ? 2 : -1; }
            const int c = (ms[0] >= 0) + (ms[1] >= 0) + (ms[2] >= 0) + (ms[3] >= 0);
            int inc = c;
#pragma unroll
            for (int o = 1; o < 64; o <<= 1) { const int v = __shfl_up(inc, o); if (lane >= o) inc += v; }
            __syncthreads();
            if (lane == 63) wtot[wave] = inc;
            __syncthreads();
            int woff = 0, tot = 0;
#pragma unroll
            for (int x = 0; x < NWAVES; ++x) { const int v = wtot[x]; if (x < wave) woff += v; tot += v; }
            int pos = running + woff + inc - c;
#pragma unroll
            for (int r = 0; r < 4; ++r) if (ms[r] >= 0) out[pos++] = (unsigned)t | ((unsigned)r << 13) | ((unsigned)ms[r] << 15);
            running += tot;
        }
        if (tid == 0) lcnt[li] = (unsigned)running;
        __syncthreads();
    }
}
__device__ __forceinline__ void phase_moba_attn(KP P, LAS unsigned char* lds) {
    int tz = threadIdx.x; asm volatile("" : "+v"(tz)); const int tid = tz, lane = tid & 63, wave = tid >> 6;
    const bf16* q = (const bf16*)(P->ws + WS_QKVI); const bf16* kv = (const bf16*)(P->ws + WS_KV);
    bf16* part_o = (bf16*)(P->ws + WS_PARTO); float* part_ml = (float*)(P->ws + WS_PML);
    const unsigned* lists = (const unsigned*)(P->ws + WS_LISTS); const unsigned* lcnt = (const unsigned*)(P->ws + WS_CTL) + CW_LCNT;
    LAS int* pre = (LAS int*)(lds + mb::PRE_OFF);
    LAS int* cn = pre + 260;
    if (tid < 256) cn[tid] = (int)lcnt[tid];
    __syncthreads();
    if (tid == 0) { int s = 0; for (int i = 0; i < 256; ++i) { pre[i] = s; s += (cn[i] + 255) >> 8; } pre[256] = s; }
    __syncthreads();
    const int npast = pre[256], total = npast + 1024;
    for (int it = blockIdx.x; it < total; it += gridDim.x) {
        int b, g, kblk, NT, t, rh, slot; bool own, valid;
        const int ri = wave * 32 + (lane & 31);
        if (it < npast) {
            int lo = 0, hi = 256;
            while (hi - lo > 1) { const int mid = (lo + hi) >> 1; if (pre[mid] <= it) lo = mid; else hi = mid; }
            const int li = lo, chunk = it - pre[li], n = cn[li];
            kblk = li & 31; g = (li >> 5) & 1; b = li >> 6; NT = 4; own = false;
            int idx = chunk * 256 + ri; valid = idx < n; if (!valid) idx = chunk * 256;
            const unsigned e = lists[(size_t)li * 32768 + idx];
            t = (int)(e & 0x1FFFu); rh = (int)((e >> 13) & 3u); slot = (int)((e >> 15) & 3u);
        } else {
            const int oi = it - npast, chunk = oi & 3, bi = oi >> 2;
            kblk = bi & 31; g = (bi >> 5) & 1; b = bi >> 6; NT = chunk < 2 ? 2 : 4; own = true; valid = true;
            t = kblk * MOBA_BLOCK + chunk * 64 + (ri >> 2); rh = ri & 3; slot = 3;
        }
        mb::item(q, kv, part_o, part_ml, lds, tid, b, g, kblk, NT, own, t, rh, slot, valid);
    }
}

namespace mb {
constexpr int SEG_K = 0, SEG_V = 65536, SEG_PRE = 131072, SEGC = 8;
__device__ __forceinline__ void stage_block(const bf16* __restrict__ kv, LAS unsigned char* lds, int tid, int b, int g, int kblk) {
    const char* KhB = (const char*)(kv + (size_t)(b * SEQ + kblk * MOBA_BLOCK) * 512 + g * HEAD_DIM);
    const int sr = tid >> 4, sc = (tid & 15) * 8, vst0 = v_st(sr, sc), vst1 = v_st(32 + sr, sc);
    const unsigned vo0 = (unsigned)(sr * 512 + sc) * 2u, vo1 = vo0 + 32u * 1024u;
#pragma unroll
    for (int h2 = 0; h2 < 2; ++h2) {
        bf16x8 kx[2][2], vx[2][2];
#pragma unroll
        for (int tt = 0; tt < 2; ++tt) { const char* kt_ = KhB + (size_t)((h2 * 2 + tt) * 64) * 1024;
            kx[tt][0] = *(const bf16x8*)(kt_ + vo0); kx[tt][1] = *(const bf16x8*)(kt_ + vo1); vx[tt][0] = *(const bf16x8*)(kt_ + 512 + vo0); vx[tt][1] = *(const bf16x8*)(kt_ + 512 + vo1); }
#pragma unroll
        for (int tt = 0; tt < 2; ++tt) { const int tile = h2 * 2 + tt;
            *(LAS bf16x8*)(lds + SEG_K + tile * SHM_K + MB_KSWZ(sr, sc * 2)) = kx[tt][0]; *(LAS bf16x8*)(lds + SEG_K + tile * SHM_K + MB_KSWZ(32 + sr, sc * 2)) = kx[tt][1];
            *(LAS bf16x8*)(lds + SEG_V + tile * SHM_V + vst0) = vx[tt][0]; *(LAS bf16x8*)(lds + SEG_V + tile * SHM_V + vst1) = vx[tt][1]; }
    }
}
__device__ __forceinline__ void chunk_rows(const bf16* __restrict__ q, bf16* __restrict__ part_o, float* __restrict__ part_ml, LAS unsigned char* lds, int lane,
                                           int b, int g, int kblk, int NT, bool own, int t, int rh, int slot, bool valid) {
    const int r32 = lane & 31, hi = lane >> 5, h = g * 4 + rh;
    float m_reg = -1e30f, l_reg = 0.f; f32x16 o[4] = {}; bf16x8 qr[8];
    { const bf16* Qw = q + (size_t)(b * SEQ + t) * D_MODEL + h * HEAD_DIM + hi * 8;
#pragma unroll
      for (int d0 = 0; d0 < 8; ++d0) qr[d0] = *(const bf16x8*)(Qw + d0 * 16); }
    const float bias2 = __builtin_amdgcn_exp2f(-(float)(h + 1)) * LOG2E;
    const int trel = t - kblk * MOBA_BLOCK;
    const float tb4 = bias2 * (float)(4 * hi - trel);
    const int lim0 = trel - 4 * hi;
    const int vb0 = (int)(unsigned)(uintptr_t)(lds + SEG_V) + v_rd_base(lane);
    for (int tile = 0; tile < NT; ++tile) {
        f32x16 p0, p1; float mn, al; bf16x8 pa0, pa1, pa2, pa3;
        qkt(p0, p1, lds + SEG_K + tile * SHM_K, qr, r32, hi);
        partialSM(p0, p1, m_reg, mn, al, bias2, tb4 + bias2 * (float)(tile * 64), own, lim0 - tile * 64);
        if (__any(al < 1.f)) {
#pragma unroll
            for (int d = 0; d < 4; ++d)
#pragma unroll
                for (int r = 0; r < 16; ++r) o[d][r] *= al; }
        finishSM(p0, p1, al, l_reg, pa0, pa1, pa2, pa3);
        pv_d0(o, vb0 + tile * SHM_V, pa0, pa1, pa2, pa3);
    }
    if (valid) {
        const float inv = 1.f / l_reg;
        const size_t rg = ((size_t)(b * SEQ + t) * N_HEADS + h) * 4 + slot;
        bf16* po = part_o + rg * HEAD_DIM + 4 * hi;
#pragma unroll
        for (int d0 = 0; d0 < 4; ++d0)
#pragma unroll
            for (int rq = 0; rq < 4; ++rq) { u32x2 w; w.x = cvt_pk_bf16(o[d0][rq * 4 + 0] * inv, o[d0][rq * 4 + 1] * inv); w.y = cvt_pk_bf16(o[d0][rq * 4 + 2] * inv, o[d0][rq * 4 + 3] * inv);
                *(u32x2*)(po + d0 * 32 + rq * 8) = w; }
        if (hi == 0) { f32x2 ml; ml.x = m_reg; ml.y = l_reg; *(f32x2*)(part_ml + rg * 2) = ml; }
    }
}
}
constexpr int CW_MQ = 20480;
__device__ __forceinline__ void phase_moba_attn2(KP P, int Lb, LAS unsigned char* lds) {
    int tz = threadIdx.x; asm volatile("" : "+v"(tz)); const int tid = tz, lane = tid & 63, wave = tid >> 6;
    const bf16* q = (const bf16*)(P->ws + WS_QKVI); const bf16* kv = (const bf16*)(P->ws + WS_KV);
    bf16* part_o = (bf16*)(P->ws + WS_PARTO); float* part_ml = (float*)(P->ws + WS_PML);
    const unsigned* lists = (const unsigned*)(P->ws + WS_LISTS); const unsigned* lcnt = (const unsigned*)(P->ws + WS_CTL) + CW_LCNT;
    unsigned* qhead = (unsigned*)(P->ws + WS_CTL) + CW_MQ + Lb * 64;
    LAS int* pre = (LAS int*)(lds + mb::SEG_PRE);
    LAS int* cn = pre + 260;
    LAS int* cur = pre + 520;
    if (tid < 256) cn[tid] = (int)lcnt[tid];
    __syncthreads();
    if (tid == 0) { int s2 = 0; for (int i = 0; i < 256; ++i) { pre[i] = s2; const int nch = (cn[i] + 255) >> 8; s2 += (nch + mb::SEGC - 1) / mb::SEGC; } pre[256] = s2; }
    __syncthreads();
    const int npast = pre[256], total = npast + 256;
    for (;;) {
        if (tid == 0) cur[0] = (int)__hip_atomic_fetch_add(qhead, 1u, __ATOMIC_RELAXED, __HIP_MEMORY_SCOPE_AGENT);
        __syncthreads();
        const int sg = cur[0];
        if (sg >= total) break;
        int b, g, kblk, li = 0, ch0, nch, n = 0; bool own;
        if (sg < npast) {
            int lo = 0, hi2 = 256;
            while (hi2 - lo > 1) { const int mid = (lo + hi2) >> 1; if (pre[mid] <= sg) lo = mid; else hi2 = mid; }
            li = lo; n = cn[li]; ch0 = (sg - pre[li]) * mb::SEGC; const int ncht = (n + 255) >> 8; nch = ncht - ch0 < mb::SEGC ? ncht - ch0 : mb::SEGC;
            kblk = li & 31; g = (li >> 5) & 1; b = li >> 6; own = false;
        } else { const int bi = sg - npast; kblk = bi & 31; g = (bi >> 5) & 1; b = bi >> 6; own = true; ch0 = 0; nch = 4; }
        mb::stage_block(kv, lds, tid, b, g, kblk);
        __syncthreads();
        const int ri = wave * 32 + (lane & 31);
        for (int c = 0; c < nch; ++c) {
            const int chunk = ch0 + c; int t, rh, slot, NT; bool valid;
            if (!own) { int idx = chunk * 256 + ri; valid = idx < n; if (!valid) idx = chunk * 256;
                const unsigned e = lists[(size_t)li * 32768 + idx];
                t = (int)(e & 0x1FFFu); rh = (int)((e >> 13) & 3u); slot = (int)((e >> 15) & 3u); NT = 4;
            } else { valid = true; t = kblk * MOBA_BLOCK + chunk * 64 + (ri >> 2); rh = ri & 3; slot = 3; NT = chunk + 1; }
            mb::chunk_rows(q, part_o, part_ml, lds, lane, b, g, kblk, NT, own, t, rh, slot, valid);
        }
        __syncthreads();
    }
}

__device__ __forceinline__ void phase_moba_combine(KP P) {
    int tz = threadIdx.x; asm volatile("" : "+v"(tz)); const int tid = tz;
    const bf16* part_o = (const bf16*)(P->ws + WS_PARTO); const float* part_ml = (const float*)(P->ws + WS_PML); bf16* attn = (bf16*)(P->ws + WS_ATTN);
    const int sub = tid & 15;
    const int stride = (gridDim.x * 512) >> 4;
    for (int rg0 = (blockIdx.x * 512 + tid) >> 4; rg0 < NTOK * N_HEADS; rg0 += 2 * stride) {
        f32x4 mlv[2][2]; u32x4 pv[2][4]; bool has[2];
#pragma unroll
        for (int u = 0; u < 2; ++u) { const int rg = rg0 + u * stride; has[u] = rg < NTOK * N_HEADS; const int rgc = has[u] ? rg : rg0;
            mlv[u][0] = *(const f32x4*)(part_ml + (size_t)rgc * 8); mlv[u][1] = *(const f32x4*)(part_ml + (size_t)rgc * 8 + 4);
#pragma unroll
            for (int s2 = 0; s2 < 4; ++s2) pv[u][s2] = *(const u32x4*)(part_o + ((size_t)rgc * 4 + s2) * HEAD_DIM + sub * 8); }
#pragma unroll
        for (int u = 0; u < 2; ++u) { const int rg = rg0 + u * stride;
            if (!has[u]) continue;
            const int tok = rg >> 3, own = (tok % SEQ) >> 8, nv = own < 3 ? own : 3;
            const float mm[4] = {mlv[u][0][0], mlv[u][0][2], mlv[u][1][0], mlv[u][1][2]}, ll[4] = {mlv[u][0][1], mlv[u][0][3], mlv[u][1][1], mlv[u][1][3]};
            float m[4], l[4];
#pragma unroll
            for (int s2 = 0; s2 < 4; ++s2) { const bool ok = (s2 == 3) || (s2 < nv); m[s2] = ok ? mm[s2] : -INFINITY; l[s2] = ok ? ll[s2] : 0.f; }
            const float M = fmaxf(fmaxf(m[0], m[1]), fmaxf(m[2], m[3]));
            float w[4], W = 0.f;
#pragma unroll
            for (int s2 = 0; s2 < 4; ++s2) { w[s2] = l[s2] * __builtin_amdgcn_exp2f(m[s2] - M); W += w[s2]; }
            const float inv = 1.f / W;
            float acc[8] = {0.f, 0.f, 0.f, 0.f, 0.f, 0.f, 0.f, 0.f};
#pragma unroll
            for (int s2 = 0; s2 < 4; ++s2) { const bool ok = (s2 == 3) || (s2 < nv); const u32x4 v = pv[u][s2]; const float ws2 = ok ? w[s2] * inv : 0.f;
                if (ok) { acc[0] += ws2 * bflo(v.x); acc[1] += ws2 * bfhi(v.x); acc[2] += ws2 * bflo(v.y); acc[3] += ws2 * bfhi(v.y);
                          acc[4] += ws2 * bflo(v.z); acc[5] += ws2 * bfhi(v.z); acc[6] += ws2 * bflo(v.w); acc[7] += ws2 * bfhi(v.w); } }
            u32x4 o; o.x = cvt_pk_bf16(acc[0], acc[1]); o.y = cvt_pk_bf16(acc[2], acc[3]); o.z = cvt_pk_bf16(acc[4], acc[5]); o.w = cvt_pk_bf16(acc[6], acc[7]);
            *(u32x4*)(attn + (size_t)rg * HEAD_DIM + sub * 8) = o;
        }
    }
}


#ifndef D1_EXP
#define D1_EXP 0
#endif
constexpr int D1_QS = 4100, D1_SM = 32 * D1_QS, D1_SELIDX = D1_SM + 1024, D1_NT = 992;
__device__ __forceinline__ unsigned fkey2(float f) { const unsigned u = __float_as_uint(f); return (u & 0x80000000u) ? ~u : (u | 0x80000000u); }
template <int PASS, int EXP>
__device__ __forceinline__ void d1_scan(const bf16* __restrict__ ikb, int qt, int kt_end, int wave, int lane, const bf16x8 (&qb)[4][4], const float (&wv)[4], LAS unsigned char* lds, unsigned thr, float flo = 0.f, float finv = 0.f, unsigned bstar = 0) {
    typedef float f32x16 __attribute__((ext_vector_type(16)));
    const int r32 = lane & 31, hi = lane >> 5;
    LAS unsigned* hq = (LAS unsigned*)(lds + r32 * D1_QS);
    LAS unsigned* sm = (LAS unsigned*)(lds + D1_SM);
    bf16x8 ka[4];
    int kt = wave;
    if (kt <= kt_end) { const bf16* kp = ikb + (size_t)(kt * 32 + r32) * QLD + 8 * hi;
#pragma unroll
        for (int ks = 0; ks < 4; ++ks) ka[ks] = *(const bf16x8*)(kp + 16 * ks); }
    for (; kt <= kt_end; kt += 8) {
        bf16x8 kn[4];
#pragma unroll
        for (int ks = 0; ks < 4; ++ks) kn[ks] = ka[ks];
        if (kt + 8 <= kt_end) { const bf16* kp = ikb + (size_t)((kt + 8) * 32 + r32) * QLD + 8 * hi;
#pragma unroll
            for (int ks = 0; ks < 4; ++ks) kn[ks] = *(const bf16x8*)(kp + 16 * ks); }
        float sc[16];
#pragma unroll
        for (int r = 0; r < 16; ++r) sc[r] = 0.f;
#pragma unroll
        for (int h = 0; h < 4; ++h) { f32x16 acc = {};
#pragma unroll
            for (int ks = 0; ks < 4; ++ks) acc = __builtin_amdgcn_mfma_f32_32x32x16_bf16(ka[ks], qb[h][ks], acc, 0, 0, 0);
#pragma unroll
            for (int r = 0; r < 16; ++r) sc[r] = fmaf(wv[h], fmaxf(acc[r], 0.f), sc[r]); }
        int kbase = kt * 32 + 4 * hi; asm volatile("" : "+v"(kbase));
        const int lim = (kt == qt) ? (r32 - 4 * hi) : 64;
#pragma unroll
        for (int r = 0; r < 16; ++r) {
            const int kc = (r & 3) + 8 * (r >> 2);
            const bool valid = kc <= lim;
            const unsigned key = fkey2(sc[r]);
            if (PASS == 1) { if (EXP == 3) { if (key == 12345u) hq[0] = 1u; } else if (valid && EXP != 2) { const unsigned bin = key >> 21; (void)__hip_atomic_fetch_add(hq + (bin >> 1), 1u << (16 * (bin & 1)), __ATOMIC_RELAXED, __HIP_MEMORY_SCOPE_WORKGROUP); } }
            else if (PASS == 2) { if (valid && (key >> 21) == thr) { const unsigned bin = (key >> 10) & 2047u; (void)__hip_atomic_fetch_add(hq + (bin >> 1), 1u << (16 * (bin & 1)), __ATOMIC_RELAXED, __HIP_MEMORY_SCOPE_WORKGROUP); } }
            else if (PASS == 4) { if (valid && sc[r] >= flo) { unsigned bin = (unsigned)((sc[r] - flo) * finv); bin = bin > 2047u ? 2047u : bin; (void)__hip_atomic_fetch_add(hq + (bin >> 1), 1u << (16 * (bin & 1)), __ATOMIC_RELAXED, __HIP_MEMORY_SCOPE_WORKGROUP); } }
            else if (PASS == 5) { if (valid && sc[r] >= flo) { unsigned bin = (unsigned)((sc[r] - flo) * finv); bin = bin > 2047u ? 2047u : bin; const unsigned sidx = (unsigned)(kbase + kc);
                    if (bin > bstar) (void)__hip_atomic_fetch_or(hq + 512 + (sidx >> 5), 1u << (sidx & 31u), __ATOMIC_RELAXED, __HIP_MEMORY_SCOPE_WORKGROUP);
                    else if (bin == bstar) {
                        if (key == 0x80000000u) (void)__hip_atomic_fetch_or(hq + 768 + (sidx >> 5), 1u << (sidx & 31u), __ATOMIC_RELAXED, __HIP_MEMORY_SCOPE_WORKGROUP);
                        else { const unsigned cp = __hip_atomic_fetch_add(sm + 160 + r32, 1u, __ATOMIC_RELAXED, __HIP_MEMORY_SCOPE_WORKGROUP); if (cp < 256u) { hq[cp] = key; ((LAS unsigned short*)(hq + 256))[cp] = (unsigned short)sidx; } } } } }
            else { if (valid) { const unsigned p22 = key >> 10; const unsigned sidx = (unsigned)(kbase + kc);
                    if (p22 > thr) (void)__hip_atomic_fetch_or(hq + 512 + (sidx >> 5), 1u << (sidx & 31u), __ATOMIC_RELAXED, __HIP_MEMORY_SCOPE_WORKGROUP);
                    else if (p22 == thr) {
                        if (key == 0x80000000u) (void)__hip_atomic_fetch_or(hq + 768 + (sidx >> 5), 1u << (sidx & 31u), __ATOMIC_RELAXED, __HIP_MEMORY_SCOPE_WORKGROUP);
                        else { const unsigned cp = __hip_atomic_fetch_add(sm + 160 + r32, 1u, __ATOMIC_RELAXED, __HIP_MEMORY_SCOPE_WORKGROUP); if (cp < 256u) { hq[cp] = key; ((LAS unsigned short*)(hq + 256))[cp] = (unsigned short)sidx; } } } } }
        }
#pragma unroll
        for (int ks = 0; ks < 4; ++ks) ka[ks] = kn[ks];
    }
}
__device__ __forceinline__ bool d1_find(LAS unsigned* H, unsigned need, int lane, unsigned& bin_out, unsigned& above_out) {
    unsigned mine = 0;
#pragma unroll
    for (int i = 0; i < 16; ++i) { const unsigned w = H[lane * 16 + i]; mine += (w & 0xFFFFu) + (w >> 16); }
    unsigned inc = mine;
#pragma unroll
    for (int o = 1; o < 64; o <<= 1) { const unsigned v = __shfl_down(inc, o); if (lane + o < 64) inc += v; }
    const unsigned above = inc - mine; const bool found = (above < need) && (inc >= need);
    const unsigned long long bal = __ballot(found); const int src = bal ? (__ffsll((long long)bal) - 1) : 0;
    const unsigned ab0 = __shfl(above, src);
    unsigned cj = 0;
    if (lane < 32) { const int bidx = src * 32 + 31 - lane; const unsigned w = H[bidx >> 1]; cj = (bidx & 1) ? (w >> 16) : (w & 0xFFFFu); }
    unsigned inc2 = cj;
#pragma unroll
    for (int o = 1; o < 32; o <<= 1) { const unsigned v = __shfl_up(inc2, o); if (lane >= o) inc2 += v; }
    const bool hit = (lane < 32) && (ab0 + inc2 >= need) && (ab0 + inc2 - cj < need);
    const unsigned long long bal2 = __ballot(hit); const int l2 = bal2 ? (__ffsll((long long)bal2) - 1) : 0;
    bin_out = (unsigned)(src * 32 + 31 - l2); above_out = ab0 + __shfl(inc2 - cj, l2);
    return bal != 0ull;
}
template <int EXP>
__device__ __forceinline__ void phase_dsa_topk(KP P, LAS unsigned char* lds, size_t sel_off) {
    int tz = threadIdx.x; asm volatile("" : "+v"(tz)); const int tid = tz, lane = tid & 63, wave = tid >> 6, r32 = lane & 31, hi = lane >> 5;
    const bf16* qkvi = (const bf16*)(P->ws + WS_QKVI); const float* iw = (const float*)(P->ws + WS_IW); int* sel = (int*)(P->ws + sel_off);
    LAS unsigned* sm = (LAS unsigned*)(lds + D1_SM);
    const int G = gridDim.x, nrounds = (D1_NT + G - 1) / G;
    for (int rho = 0; rho < nrounds; ++rho) {
        const int pos = (rho & 1) ? (G - 1 - (int)blockIdx.x) : (int)blockIdx.x, i = rho * G + pos;
        if (i >= D1_NT) continue;
        const int qt = 255 - (i >> 2), b = i & 3, t0 = qt * 32, tok0 = b * SEQ + t0;
        for (int w = tid; w < (D1_SM + 1024) / 4; w += 512) ((LAS unsigned*)lds)[w] = 0u;
        bf16x8 qb[4][4]; float wv[4];
        { const bf16* qp = qkvi + (size_t)(tok0 + r32) * QLD + COL_IQ + 8 * hi;
#pragma unroll
          for (int h = 0; h < 4; ++h)
#pragma unroll
              for (int ks = 0; ks < 4; ++ks) qb[h][ks] = *(const bf16x8*)(qp + h * IDX_DIM + 16 * ks);
          const f32x4 w4 = *(const f32x4*)(iw + (size_t)(tok0 + r32) * 4); wv[0] = w4[0]; wv[1] = w4[1]; wv[2] = w4[2]; wv[3] = w4[3]; }
        const bf16* ikb = qkvi + (size_t)b * SEQ * QLD + COL_IK;
        __syncthreads();
        d1_scan<1, EXP>(ikb, qt, 7, wave, lane, qb, wv, lds, 0u);
        __syncthreads();
#pragma unroll 1
        for (int qq = 0; qq < 4; ++qq) { const int q = wave * 4 + qq; const unsigned n = (unsigned)(t0 + q + 1); unsigned klo = 196608u / n; klo = klo > 256u ? 256u : (klo < 1u ? 1u : klo);
            unsigned bs, ab, bmx, ab2; const bool ok1 = d1_find((LAS unsigned*)(lds + q * D1_QS), klo, lane, bs, ab), ok2 = d1_find((LAS unsigned*)(lds + q * D1_QS), 1u, lane, bmx, ab2);
            if (lane == 0) { const unsigned klo_key = bs << 21, khi_key = (bmx + 1u) << 21;
                const float lo = __uint_as_float((klo_key & 0x80000000u) ? (klo_key & 0x7FFFFFFFu) : ~klo_key), hi2 = __uint_as_float((khi_key & 0x80000000u) ? (khi_key & 0x7FFFFFFFu) : ~khi_key);
                const float span = (hi2 - lo) * 1.5f; const bool good = ok1 && ok2 && bmx < 2046u && span > 0.f && span < 3.0e38f;
                sm[q] = __float_as_uint(lo); sm[32 + q] = __float_as_uint(good ? 2047.f / span : 0.f); if (!good) sm[224] = 1u; } }
        __syncthreads();
        for (int w = tid; w < D1_SM / 4; w += 512) ((LAS unsigned*)lds)[w] = 0u;
        const float f_lo = __uint_as_float(sm[r32]), f_inv = __uint_as_float(sm[32 + r32]);
        __syncthreads();
        d1_scan<4, EXP>(ikb, qt, qt, wave, lane, qb, wv, lds, 0u, f_lo, f_inv);
        __syncthreads();
#pragma unroll 1
        for (int qq = 0; qq < 4; ++qq) { const int q = wave * 4 + qq; unsigned bin, ab; const bool ok = d1_find((LAS unsigned*)(lds + q * D1_QS), 256u, lane, bin, ab);
            if (lane == 0) { sm[64 + q] = bin; sm[96 + q] = 256u - ab; if (!ok || bin == 2047u) sm[224] = 1u; } }
        __syncthreads();
        for (int w = tid; w < D1_SM / 4; w += 512) ((LAS unsigned*)lds)[w] = 0u;
#ifndef D1_FORCE_FB
#define D1_FORCE_FB 0
#endif
        const unsigned f_bs = sm[64 + r32]; bool fast_ok = (sm[224] == 0u) && !D1_FORCE_FB;
        __syncthreads();
        if (fast_ok) {
            d1_scan<5, EXP>(ikb, qt, qt, wave, lane, qb, wv, lds, 0u, f_lo, f_inv, f_bs);
            __syncthreads();
            if (tid < 32 && sm[160 + tid] > 256u) sm[224] = 1u;
            __syncthreads();
            fast_ok = (sm[224] == 0u);
            __syncthreads();
        }
        if (!fast_ok) {
        for (int w = tid; w < (D1_SM + 1024) / 4; w += 512) ((LAS unsigned*)lds)[w] = 0u;
        __syncthreads();
        d1_scan<1, EXP>(ikb, qt, qt, wave, lane, qb, wv, lds, 0u);
        __syncthreads();
#pragma unroll 1
        for (int qq = 0; qq < 4; ++qq) { const int q = wave * 4 + qq; unsigned bin, ab; d1_find((LAS unsigned*)(lds + q * D1_QS), 256u, lane, bin, ab); if (lane == 0) { sm[q] = bin; sm[32 + q] = ab; } }
        __syncthreads();
        for (int w = tid; w < D1_SM / 4; w += 512) ((LAS unsigned*)lds)[w] = 0u;
        const unsigned b1 = sm[r32];
        __syncthreads();
        d1_scan<2, EXP>(ikb, qt, qt, wave, lane, qb, wv, lds, b1);
        __syncthreads();
#pragma unroll 1
        for (int qq = 0; qq < 4; ++qq) { const int q = wave * 4 + qq; const unsigned need2 = 256u - sm[32 + q]; unsigned bin, ab; d1_find((LAS unsigned*)(lds + q * D1_QS), need2, lane, bin, ab);
            if (lane == 0) { sm[64 + q] = (sm[q] << 11) | bin; sm[96 + q] = need2 - ab; } }
        __syncthreads();
        for (int w = tid; w < D1_SM / 4; w += 512) ((LAS unsigned*)lds)[w] = 0u;
        const unsigned T22 = sm[64 + r32];
        __syncthreads();
        d1_scan<3, EXP>(ikb, qt, qt, wave, lane, qb, wv, lds, T22);
        __syncthreads();
        }
#pragma unroll 1
        for (int qq = 0; qq < 4; ++qq) { const int q = wave * 4 + qq;
            const unsigned cc = sm[160 + q] < 256u ? sm[160 + q] : 256u, need3 = sm[96 + q];
            LAS unsigned* cand = (LAS unsigned*)(lds + q * D1_QS); LAS unsigned short* cidx = (LAS unsigned short*)(cand + 256); LAS unsigned* bm = cand + 512; LAS unsigned* tb = cand + 768;
            unsigned tw[4]; int cz = 0;
#pragma unroll
            for (int w = 0; w < 4; ++w) { tw[w] = tb[lane * 4 + w]; cz += __popc(tw[w]); }
            int incz = cz;
#pragma unroll
            for (int o = 1; o < 64; o <<= 1) { const int v = __shfl_up(incz, o); if (lane >= o) incz += v; }
            const int cztot = __shfl(incz, 63);
            int npos = 0;
            for (unsigned ci = lane; ci < ((cc + 63u) & ~63u); ci += 64) { const bool act = ci < cc; const unsigned mine = act ? cand[ci] : 0u; const unsigned mi = act ? (unsigned)cidx[ci] : 0u;
                npos += __popcll(__ballot(act && mine > 0x80000000u));
                unsigned rank = (mine < 0x80000000u) ? (unsigned)cztot : 0u;
                for (unsigned j = 0; j < cc; ++j) { const unsigned kj = cand[j]; const unsigned ij = (unsigned)cidx[j]; rank += (kj > mine || (kj == mine && ij < mi)) ? 1u : 0u; }
                if (act && rank < need3) (void)__hip_atomic_fetch_or(bm + (mi >> 5), 1u << (mi & 31u), __ATOMIC_RELAXED, __HIP_MEMORY_SCOPE_WORKGROUP); }
            { int need_z = (int)need3 - npos; need_z = need_z < 0 ? 0 : (need_z > cztot ? cztot : need_z);
              if (need_z > 0) { int pre = incz - cz;
#pragma unroll
                for (int w = 0; w < 4; ++w) { unsigned bits = tw[w]; const int pc = __popc(bits); int k = need_z - pre; k = k < 0 ? 0 : (k > pc ? pc : k);
                    unsigned keep = 0u; for (int x = 0; x < k; ++x) { const unsigned low = bits & (0u - bits); keep |= low; bits ^= low; }
                    if (keep) (void)__hip_atomic_fetch_or(bm + lane * 4 + w, keep, __ATOMIC_RELAXED, __HIP_MEMORY_SCOPE_WORKGROUP);
                    pre += pc; } } }
            asm volatile("s_waitcnt lgkmcnt(0)" ::: "memory");
            unsigned wds[4]; int c = 0;
#pragma unroll
            for (int w = 0; w < 4; ++w) { wds[w] = bm[lane * 4 + w]; c += __popc(wds[w]); }
            int inc = c;
#pragma unroll
            for (int o = 1; o < 64; o <<= 1) { const int v = __shfl_up(inc, o); if (lane >= o) inc += v; }
            const int total = __shfl(inc, 63); int off = inc - c;
            int* op = sel + (size_t)(tok0 + q) * TOPK;
            if (EXP != 7)
#pragma unroll
            for (int w = 0; w < 4; ++w) { unsigned bits = wds[w]; const int kb = lane * 128 + w * 32;
                while (bits) { const int k = __ffs((int)bits) - 1; if (off < TOPK) op[off] = kb + k; ++off; bits &= bits - 1u; } }
            for (int j = total + lane; j < TOPK; j += 64) op[j] = t0 + q;
        }
        __syncthreads();
    }
}

constexpr int CW_DQ = 16384 + 1024;
__device__ __forceinline__ void phase_dsa_attn(KP P, int L, LAS unsigned char* lds) {
    int tz = threadIdx.x; asm volatile("" : "+v"(tz)); const int tid = tz, lane = tid & 63, wave = tid >> 6;
    const bf16* qkvi = (const bf16*)(P->ws + WS_QKVI); const int* sel = (const int*)(P->ws + WS_SEL); bf16* attn = (bf16*)(P->ws + WS_ATTN);
    unsigned* qh = (unsigned*)(P->ws + WS_CTL) + CW_DQ + L * 8 * 64;
    LAS unsigned* idxs = (LAS unsigned*)(lds + wave * 8192);
    LAS float* pl = (LAS float*)(lds + wave * 8192 + 1024);
    LAS int* wq = (LAS int*)(lds + 65536 + wave * 16);
    const int r = lane & 3, ts_l = (lane & 15) >> 2, kq = lane >> 4, c16 = lane & 15;
    const unsigned myq = xb_xcc_id() & 7u;
    constexpr float CC = 0.08838834764831845f * 1.4426950408889634f;
    for (int qi = 0; qi < 8; ++qi) {
        const int qx = (int)((myq + (unsigned)qi) & 7u), b = qx >> 1, g = qx & 1;
        for (;;) {
            int item = 0;
            if (lane == 0) item = (int)__hip_atomic_fetch_add(qh + qx * 64, 1u, __ATOMIC_RELAXED, __HIP_MEMORY_SCOPE_AGENT);
            item = __builtin_amdgcn_readfirstlane(item);
            if (item >= SEQ) break;
            const int t = SEQ - 1 - item, tok = b * SEQ + t, cnt = (t + 1 < TOPK) ? (t + 1) : TOPK;
#pragma unroll
            for (int i = 0; i < 4; ++i) { const int j = lane + 64 * i; int sidx = 0; if (j < cnt) sidx = (t < TOPK) ? j : sel[(size_t)tok * TOPK + j]; idxs[j] = (unsigned)sidx; }
            asm volatile("s_waitcnt lgkmcnt(0)" ::: "memory");
            bf16x8 qm[4][4];
            { const bf16* qp = qkvi + (size_t)tok * QLD + (g * 4 + r) * HEAD_DIM + 8 * kq;
#pragma unroll
              for (int ks = 0; ks < 4; ++ks) { const bf16x8 v = *(const bf16x8*)(qp + 32 * ks);
#pragma unroll
                  for (int ts = 0; ts < 4; ++ts) qm[ts][ks] = (ts_l == ts) ? v : (bf16x8){0, 0, 0, 0, 0, 0, 0, 0}; } }
            f32x4 C[4];
            const bf16* kbase = qkvi + (size_t)b * SEQ * QLD + COL_K + g * HEAD_DIM + 8 * kq;
#pragma unroll
            for (int c = 0; c < 4; ++c) {
                C[c] = (f32x4){0.f, 0.f, 0.f, 0.f};
                bf16x8 a[4][4];
#pragma unroll
                for (int ts = 0; ts < 4; ++ts) { const unsigned sk = idxs[(4 * c + ts) * 16 + c16]; const bf16* kp = kbase + (size_t)sk * QLD;
#pragma unroll
                    for (int ks = 0; ks < 4; ++ks) a[ts][ks] = *(const bf16x8*)(kp + 32 * ks); }
#pragma unroll
                for (int ts = 0; ts < 4; ++ts)
#pragma unroll
                    for (int ks = 0; ks < 4; ++ks) C[c] = __builtin_amdgcn_mfma_f32_16x16x32_bf16(a[ts][ks], qm[ts][ks], C[c], 0, 0, 0);
            }
            const float bias2 = __builtin_amdgcn_exp2f(-(float)(g * 4 + r + 1)) * 1.4426950408889634f;
            float x[16]; float m = -INFINITY;
#pragma unroll
            for (int c = 0; c < 4; ++c) { const int k0 = (4 * c + ts_l) * 16 + 4 * kq; const u32x4 sp = *(const LAS u32x4*)(idxs + k0);
#pragma unroll
                for (int j = 0; j < 4; ++j) { const float v = (k0 + j < cnt) ? fmaf(C[c][j], CC, bias2 * (float)((int)sp[j] - t)) : -INFINITY; x[c * 4 + j] = v; m = fmaxf(m, v); } }
            m = fmaxf(m, __shfl_xor(m, 4)); m = fmaxf(m, __shfl_xor(m, 8)); m = fmaxf(m, __shfl_xor(m, 16)); m = fmaxf(m, __shfl_xor(m, 32));
            float sum = 0.f;
#pragma unroll
            for (int i = 0; i < 16; ++i) { x[i] = __builtin_amdgcn_exp2f(x[i] - m); sum += x[i]; }
            sum += __shfl_xor(sum, 4); sum += __shfl_xor(sum, 8); sum += __shfl_xor(sum, 16); sum += __shfl_xor(sum, 32);
            const float inv = 1.f / sum;
#pragma unroll
            for (int c = 0; c < 4; ++c) { const int k0 = (4 * c + ts_l) * 16 + 4 * kq;
#pragma unroll
                for (int j = 0; j < 4; ++j) pl[(k0 + j) * 4 + r] = x[c * 4 + j] * inv; }
            asm volatile("s_waitcnt lgkmcnt(0)" ::: "memory");
            float acc[4][8];
#pragma unroll
            for (int rr = 0; rr < 4; ++rr)
#pragma unroll
                for (int i = 0; i < 8; ++i) acc[rr][i] = 0.f;
            const bf16* vbase = qkvi + (size_t)b * SEQ * QLD + COL_V + g * HEAD_DIM + 8 * c16;
            const int nk4 = (cnt + 3) >> 2;
#pragma unroll 4
            for (int j4 = 0; j4 < nk4; ++j4) {
                const int key = 4 * j4 + kq; const unsigned sk = idxs[key];
                const u32x4 vv = *(const u32x4*)(vbase + (size_t)sk * QLD);
                const f32x4 pp = *(const LAS f32x4*)(pl + key * 4);
                const float vf[8] = {bflo(vv.x), bfhi(vv.x), bflo(vv.y), bfhi(vv.y), bflo(vv.z), bfhi(vv.z), bflo(vv.w), bfhi(vv.w)};
#pragma unroll
                for (int rr = 0; rr < 4; ++rr)
#pragma unroll
                    for (int i = 0; i < 8; ++i) acc[rr][i] = fmaf(pp[rr], vf[i], acc[rr][i]);
            }
#pragma unroll
            for (int rr = 0; rr < 4; ++rr)
#pragma unroll
                for (int i = 0; i < 8; ++i) { float v = acc[rr][i]; v += __shfl_xor(v, 16); v += __shfl_xor(v, 32); acc[rr][i] = v; }
            if (kq == 0) {
#pragma unroll
                for (int rr = 0; rr < 4; ++rr) { u32x4 o; o.x = cvt_pk_bf16(acc[rr][0], acc[rr][1]); o.y = cvt_pk_bf16(acc[rr][2], acc[rr][3]); o.z = cvt_pk_bf16(acc[rr][4], acc[rr][5]); o.w = cvt_pk_bf16(acc[rr][6], acc[rr][7]);
                    *(u32x4*)(attn + (size_t)tok * D_MODEL + (g * 4 + rr) * HEAD_DIM + 8 * c16) = o; }
            }
        }
    }
    (void)wq;
}


__device__ __forceinline__ int d2_swz(int i) { return ((i & 3) << 2) | ((i >> 2) & 3); }
__device__ __forceinline__ void phase_dsa_attn2(KP P, int L, LAS unsigned char* lds) {
    typedef short s16x4 __attribute__((ext_vector_type(4)));
    int tz = threadIdx.x; asm volatile("" : "+v"(tz)); const int tid = tz, lane = tid & 63, wave = __builtin_amdgcn_readfirstlane(tid >> 6);
    const bf16* qkvi = (const bf16*)(P->ws + WS_QKVI); const int* sel = (const int*)(P->ws + WS_SEL); bf16* attn = (bf16*)(P->ws + WS_ATTN);
    unsigned* qh = (unsigned*)(P->ws + WS_CTL) + CW_DQ + L * 8 * 64;
    LAS unsigned char* wl = lds + wave * 19456;
    LAS unsigned* idxs = (LAS unsigned*)wl;
    LAS unsigned char* pb = wl + 1024;
    LAS unsigned char* ring = wl + 3072;
    const int n16 = lane & 15, r = lane & 3, ts_l = n16 >> 2, kq = lane >> 4;
    const unsigned myq = xb_xcc_id() & 7u;
    constexpr float CC = 0.08838834764831845f * 1.4426950408889634f;
    unsigned dch[4];
#pragma unroll
    for (int j = 0; j < 4; ++j) dch[j] = (unsigned)((n16 ^ d2_swz(4 * j + kq)) * 16);
    unsigned aoff[4];
#pragma unroll
    for (int ks = 0; ks < 4; ++ks) aoff[ks] = (unsigned)(n16 * 256 + (((4 * ks + kq) ^ d2_swz(n16)) * 16));
    for (int qi = 0; qi < 8; ++qi) {
        const int qx = (int)((myq + (unsigned)qi) & 7u), b = qx >> 1, g = qx & 1;
        const char* kgb = (const char*)(qkvi + (size_t)b * SEQ * QLD + COL_K + g * HEAD_DIM);
        int item = 0;
        if (lane == 0) item = (int)__hip_atomic_fetch_add(qh + qx * 64, 1u, __ATOMIC_RELAXED, __HIP_MEMORY_SCOPE_AGENT);
        item = __builtin_amdgcn_readfirstlane(item);
        bool have_pf = false; int sx[4] = {0, 0, 0, 0}; bf16x8 qv[4] = {};
        while (item < SEQ) {
            const int t = SEQ - 1 - item, tok = b * SEQ + t, cnt = (t + 1 < TOPK) ? (t + 1) : TOPK;
            if (!have_pf) {
#pragma unroll
                for (int i = 0; i < 4; ++i) { const int j = lane + 64 * i; sx[i] = (t < TOPK) ? j : sel[(size_t)tok * TOPK + j]; }
                const bf16* qp = qkvi + (size_t)tok * QLD + (g * 4 + r) * HEAD_DIM + 8 * kq;
#pragma unroll
                for (int ks = 0; ks < 4; ++ks) qv[ks] = *(const bf16x8*)(qp + 32 * ks);
            }
#pragma unroll
            for (int i = 0; i < 4; ++i) { const int j = lane + 64 * i; idxs[j] = (j < cnt) ? (unsigned)sx[i] : 0u; }
            bf16x8 qm[4][4];
#pragma unroll
            for (int ks = 0; ks < 4; ++ks) {
#pragma unroll
                for (int ts = 0; ts < 4; ++ts) qm[ts][ks] = (ts_l == ts) ? qv[ks] : (bf16x8){0, 0, 0, 0, 0, 0, 0, 0}; }
            asm volatile("s_waitcnt vmcnt(0) lgkmcnt(0)" ::: "memory");
#define D2_ISSUE(s) do { const int kb_ = (s) & 15; const char* gb_ = kgb + ((s) >= 16 ? (COL_V - COL_K) * 2 : 0); LAS unsigned char* sl_ = ring + ((s) & 3) * 4096; \
        _Pragma("unroll") for (int j = 0; j < 4; ++j) { const unsigned sk_ = idxs[kb_ * 16 + 4 * j + kq]; \
            __builtin_amdgcn_global_load_lds((const unsigned*)(gb_ + (size_t)sk_ * (QLD * 2) + dch[j]), (LAS unsigned*)(sl_ + j * 1024), 16, 0, 0); } } while (0)
            int nraw = 0;
            if (lane == 0) nraw = (int)__hip_atomic_fetch_add(qh + qx * 64, 1u, __ATOMIC_RELAXED, __HIP_MEMORY_SCOPE_AGENT);
            D2_ISSUE(0); D2_ISSUE(1); D2_ISSUE(2); D2_ISSUE(3);
            f32x4 C[4];
#pragma unroll
            for (int c = 0; c < 4; ++c) C[c] = (f32x4){0.f, 0.f, 0.f, 0.f};
#pragma unroll
            for (int s2 = 0; s2 < 16; ++s2) {
                asm volatile("s_waitcnt vmcnt(12)" ::: "memory");
                LAS unsigned char* sl = ring + (s2 & 3) * 4096;
                bf16x8 a[4];
#pragma unroll
                for (int ks = 0; ks < 4; ++ks) a[ks] = *(const LAS bf16x8*)(sl + aoff[ks]);
#pragma unroll
                for (int ks = 0; ks < 4; ++ks) C[s2 >> 2] = __builtin_amdgcn_mfma_f32_16x16x32_bf16(a[ks], qm[s2 & 3][ks], C[s2 >> 2], 0, 0, 0);
                asm volatile("s_waitcnt lgkmcnt(0)" ::: "memory");
                D2_ISSUE(s2 + 4);
            }
            const float bias2 = __builtin_amdgcn_exp2f(-(float)(g * 4 + r + 1)) * 1.4426950408889634f;
            float x[16]; float m = -INFINITY;
#pragma unroll
            for (int c = 0; c < 4; ++c) { const int k0 = (4 * c + ts_l) * 16 + 4 * kq; const u32x4 sp = *(const LAS u32x4*)(idxs + k0);
#pragma unroll
                for (int j = 0; j < 4; ++j) { const float v = (k0 + j < cnt) ? fmaf(C[c][j], CC, bias2 * (float)((int)sp[j] - t)) : -INFINITY; x[c * 4 + j] = v; m = fmaxf(m, v); } }
            m = fmaxf(m, __shfl_xor(m, 4)); m = fmaxf(m, __shfl_xor(m, 8)); m = fmaxf(m, __shfl_xor(m, 16)); m = fmaxf(m, __shfl_xor(m, 32));
            float sum = 0.f;
#pragma unroll
            for (int i = 0; i < 16; ++i) { x[i] = __builtin_amdgcn_exp2f(x[i] - m); sum += x[i]; }
            sum += __shfl_xor(sum, 4); sum += __shfl_xor(sum, 8); sum += __shfl_xor(sum, 16); sum += __shfl_xor(sum, 32);
            const float inv = 1.f / sum;
#pragma unroll
            for (int c = 0; c < 4; ++c) { const int k0 = (4 * c + ts_l) * 16 + 4 * kq;
                u32x2 w; w.x = cvt_pk_bf16(x[c * 4 + 0] * inv, x[c * 4 + 1] * inv); w.y = cvt_pk_bf16(x[c * 4 + 2] * inv, x[c * 4 + 3] * inv);
                *(LAS u32x2*)(pb + (r * 256 + k0) * 2) = w; }
            asm volatile("s_waitcnt lgkmcnt(0)" ::: "memory");
            f32x4 O[8]; int nitem = SEQ;
#pragma unroll
            for (int db = 0; db < 8; ++db) O[db] = (f32x4){0.f, 0.f, 0.f, 0.f};
            const int q4 = n16 >> 2, p4 = n16 & 3;
#pragma unroll
            for (int u = 0; u < 8; ++u) {
                if (u < 7) asm volatile("s_waitcnt vmcnt(8)" ::: "memory"); else asm volatile("s_waitcnt vmcnt(0)" ::: "memory");
                LAS unsigned char* sl = ring + (((2 * u) & 3) + (kq >> 1)) * 4096;
                const bf16x8 pf = *(const LAS bf16x8*)(pb + (r * 256 + u * 32 + 8 * kq) * 2);
#pragma unroll
                for (int db = 0; db < 8; ++db) {
                    const int i0 = 8 * (kq & 1) + q4, i1 = i0 + 4;
                    const int a0 = (int)(unsigned)(uintptr_t)(sl + i0 * 256 + (((2 * db + (p4 >> 1)) ^ d2_swz(i0)) * 16) + 8 * (p4 & 1));
                    const int a1 = (int)(unsigned)(uintptr_t)(sl + i1 * 256 + (((2 * db + (p4 >> 1)) ^ d2_swz(i1)) * 16) + 8 * (p4 & 1));
                    const s16x4 v0 = mb::tr_read<0>(a0), v1 = mb::tr_read<0>(a1);
                    asm volatile("s_waitcnt lgkmcnt(0)" ::: "memory");
                    const bf16x8 vf = {v0[0], v0[1], v0[2], v0[3], v1[0], v1[1], v1[2], v1[3]};
                    O[db] = __builtin_amdgcn_mfma_f32_16x16x32_bf16(vf, pf, O[db], 0, 0, 0);
                }
                if (u == 0) {
                    nitem = __builtin_amdgcn_readfirstlane(nraw); have_pf = nitem < SEQ;
                    if (have_pf) { const int tn = SEQ - 1 - nitem, tokn = b * SEQ + tn;
#pragma unroll
                        for (int i = 0; i < 4; ++i) { const int j = lane + 64 * i; sx[i] = (tn < TOPK) ? j : sel[(size_t)tokn * TOPK + j]; }
                        const bf16* qpn = qkvi + (size_t)tokn * QLD + (g * 4 + r) * HEAD_DIM + 8 * kq;
#pragma unroll
                        for (int ks = 0; ks < 4; ++ks) qv[ks] = *(const bf16x8*)(qpn + 32 * ks); } }
                if (u < 6) { D2_ISSUE(16 + 2 * u + 4); D2_ISSUE(16 + 2 * u + 5); }
            }
#undef D2_ISSUE
            if (n16 < 4) {
                bf16* op = attn + (size_t)tok * D_MODEL + (g * 4 + n16) * HEAD_DIM + 4 * kq;
#pragma unroll
                for (int db = 0; db < 8; ++db) { u32x2 w; w.x = cvt_pk_bf16(O[db][0], O[db][1]); w.y = cvt_pk_bf16(O[db][2], O[db][3]); *(u32x2*)(op + 16 * db) = w; }
            }
            item = nitem;
        }
    }
}

__device__ __forceinline__ int opq(int x) { asm volatile("" : "+s"(x)); return x; }
__device__ __forceinline__ bool phase_active(int L, int k) {
    if (k >= 2 && k <= 6) { if (L < N_A) return k <= 3; if (k == 2) return L == N_A; }
    return k <= 14;
}
__global__ void __launch_bounds__(512, 2) fwd(Params P) {
    extern __shared__ __attribute__((aligned(16))) unsigned char lds_raw[];
    LAS unsigned char* lds = (LAS unsigned char*)lds_raw;
    const int tid = threadIdx.x;
    unsigned char* ws0 = P.ws;
    if (tid < 16) ((LAS unsigned*)(lds + LDS_MISC))[tid] = 0u;
    __syncthreads();
    const int lo = P.ph_lo, hi = P.ph_hi;
    const bool multi = (hi - lo) > 1;
    unsigned* barw = (unsigned*)(ws0 + WS_CTL) + CW_BAR + P.bar_idx * XCD_BAR_WORDS;
    XcdBarrier bar; bar.bar = barw; bar.x = 0; bar.st = nullptr;
    if (multi) bar = xcd_barrier_post(barw, (volatile LAS unsigned*)(lds + LDS_MISC));
#ifndef PHASE_MASK
#define PHASE_MASK 0xFFFF
#endif
#define IN(k) (((PHASE_MASK >> (k)) & 1) && opq(lo) <= (pb + (k)) && (pb + (k)) < hi && phase_active(L, (k)))
#define SEAM(k) do { if (IN(k) && (pb + (k) + 1) < hi) xcd_barrier(bar); } while (0)
#ifndef PROBE_MASK
#define PROBE_MASK 0
#endif
#define PROBED(k) (((PROBE_MASK) >> (k)) & 1)
    const int G = gridDim.x, c = blockIdx.x;
    for (int L = 0; L < DEPTH; ++L) {
        const int pb = L * 16;
        if (pb + 16 <= lo || pb >= hi) continue;
        const bool isA = L < N_A;
        if (IN(0)) { for (int rep = PROBED(0) ? 0 : 1; rep < 2; ++rep) { phase_convert(fresh_params(), L, lds); if (rep == 0) xcd_barrier(bar); } } SEAM(0);
        if (IN(1)) { for (int rep = PROBED(1) ? 0 : 1; rep < 2; ++rep) {
            KP Q = fresh_params(); unsigned char* ws = Q->ws; bf16* hb = (bf16*)(ws + WS_HB);
            if (isA) {
                gm::DenseOrder S; S.init(hb, ws + WS_WMIX, NTOK, 2048, D_MODEL, G, c);
                gm::EpiBf16 E{(bf16*)(ws + WS_QKVI), QLD, (float*)(ws + WS_IW)};
                gm::gemm_phase<gm::EpiBf16, gm::DenseOrder, false>(lds, D_MODEL, S, E);
            } else {
                if (L == N_A) {
                    gm::DenseOrder S; S.init(hb, ws + WS_WMIX + 6 * MiB, NTOK, 512, D_MODEL, G, c);
                    gm::EpiBf16 E{(bf16*)(ws + WS_KV), 512, nullptr};
                    gm::gemm_phase<gm::EpiBf16, gm::DenseOrder, false>(lds, D_MODEL, S, E);
                }
                gm::DenseOrder S; S.init(hb, ws + WS_WMIX, NTOK, D_MODEL, D_MODEL, G, c);
                gm::EpiBf16 E{(bf16*)(ws + WS_QKVI), D_MODEL, nullptr};
                gm::gemm_phase<gm::EpiBf16, gm::DenseOrder, false>(lds, D_MODEL, S, E);
            }
            if (rep == 0) xcd_barrier(bar);
        } } SEAM(1);
        if (IN(2)) { if (isA) { if (PROBED(2)) { phase_dsa_topk<D1_EXP>(fresh_params(), lds, WS_PL); xcd_barrier(bar); } phase_dsa_topk<0>(fresh_params(), lds, WS_SEL); } else phase_kmeans(fresh_params()); } SEAM(2);
        if (IN(3)) { if (isA) { for (int rep = PROBED(3) ? 0 : 1; rep < 2; ++rep) { phase_dsa_attn2(fresh_params(), rep == 0 ? L + 2 : L, lds); if (rep == 0) xcd_barrier(bar); } } else { for (int rep = PROBED(4) ? 0 : 1; rep < 2; ++rep) { phase_moba_gate2(fresh_params()); if (rep == 0) xcd_barrier(bar); } } } SEAM(3);
        if (IN(4)) { phase_moba_lists(fresh_params(), lds); } SEAM(4);
        if (IN(5)) { for (int rep = PROBED(5) ? 0 : 1; rep < 2; ++rep) { phase_moba_attn2(fresh_params(), (L - N_A) * 2 + rep, lds); if (rep == 0) xcd_barrier(bar); } } SEAM(5);
        if (IN(6)) { for (int rep = PROBED(6) ? 0 : 1; rep < 2; ++rep) { phase_moba_combine(fresh_params()); if (rep == 0) xcd_barrier(bar); } } SEAM(6);
        if (IN(7)) { for (int rep = PROBED(7) ? 0 : 1; rep < 2; ++rep) {
            KP Q = fresh_params(); unsigned char* ws = Q->ws; const float* hres = (L == 0) ? Q->in[0] : (const float*)(ws + WS_H); _Float16* t = (_Float16*)(ws + WS_T);
            { gm::DenseOrder S; S.init(ws + WS_ATTN, ws + WS_WMIX + 4 * MiB, NTOK, D_MODEL, D_MODEL, G, c);
              gm::EpiResid E{hres, t};
              gm::gemm_phase<gm::EpiResid, gm::DenseOrder, false>(lds, D_MODEL, S, E); }
            { gm::DenseOrder S; S.init(ws + WS_PB, ws + WS_WPLE, NTOK, D_MODEL, PLE_DIM, G, c);
              gm::EpiBf16 E{(bf16*)(ws + WS_PL), D_MODEL, nullptr};
              gm::gemm_phase<gm::EpiBf16, gm::DenseOrder, false>(lds, PLE_DIM, S, E); }
            if (rep == 0) xcd_barrier(bar);
        } } SEAM(7);
        if (IN(8)) { for (int rep = PROBED(8) ? 0 : 1; rep < 2; ++rep) { phase_ln_router(fresh_params(), L, lds, rep == 0 ? L + 4 : L); if (rep == 0) xcd_barrier(bar); } } SEAM(8);
        if (IN(9)) { phase_moe_prep(fresh_params(), L, lds); } SEAM(9);
        if (IN(10)) { for (int rep = PROBED(10) ? 0 : 1; rep < 2; ++rep) {
            KP Q = fresh_params(); unsigned char* ws = Q->ws; bf16* hb = (bf16*)(ws + WS_HB);
            const int* moe = (const int*)(ws + WS_MOE);
            gm::MoeOrder S; S.tile_e = moe + MO_TILE_E; S.tile_row0 = moe + MO_TILE_ROW0; S.tile_nv = moe + MO_TILE_NV; S.slot_tok = moe + MO_SLOT_TOK;
            S.n_units = (int)*((const unsigned*)(ws + WS_CTL) + CW_NTILES + L) * 4; S.G = G; S.c = c; S.K = D_MODEL; S.A = (const char*)hb; S.W = (const char*)(ws + WS_WGU);
            S.wstride = (size_t)D_MODEL * D_MODEL * 2; S.tB = (size_t)256 * D_MODEL * 2; S.gath = true;
            gm::EpiSwiglu E{(bf16*)(ws + WS_ACT)};
            gm::gemm_phase<gm::EpiSwiglu, gm::MoeOrder, true>(lds, D_MODEL, S, E);
            if (rep == 0) xcd_barrier(bar);
        } } SEAM(10);
        if (IN(11)) { for (int rep = PROBED(11) ? 0 : 1; rep < 2; ++rep) {
            KP Q = fresh_params(); unsigned char* ws = Q->ws;
            const int* moe = (const int*)(ws + WS_MOE);
            gm::MoeOrder S; S.tile_e = moe + MO_TILE_E; S.tile_row0 = moe + MO_TILE_ROW0; S.tile_nv = moe + MO_TILE_NV; S.slot_tok = moe + MO_SLOT_TOK;
            S.n_units = (int)*((const unsigned*)(ws + WS_CTL) + CW_NTILES + L) * 4; S.G = G; S.c = c; S.K = D_EXPERT; S.A = (const char*)(ws + WS_ACT); S.W = (const char*)(ws + WS_WD);
            S.wstride = (size_t)D_MODEL * D_EXPERT * 2; S.tB = (size_t)256 * D_EXPERT * 2; S.gath = false;
            gm::EpiMoeDown E{(bf16*)(ws + WS_Y)};
            gm::gemm_phase<gm::EpiMoeDown, gm::MoeOrder, false>(lds, D_EXPERT, S, E);
            if (rep == 0) xcd_barrier(bar);
        } } SEAM(11);
        if (IN(12)) { KP Q = fresh_params(); phase_ln<1, false>(Q, L, 1, lds, (float*)(Q->ws + WS_H), true); } SEAM(12);
        if (IN(13)) { for (int rep = PROBED(13) ? 0 : 1; rep < 2; ++rep) {
            KP Q = fresh_params(); unsigned char* ws = Q->ws; bf16* hb = (bf16*)(ws + WS_HB); float* h = (float*)(ws + WS_H); _Float16* t = (_Float16*)(ws + WS_T);
            gm::DenseOrder S; S.init(hb, ws + WS_WPG, NTOK, D_MODEL, D_MODEL, G, c);
            gm::EpiPle E{h, (const bf16*)(ws + WS_PL), t};
            gm::gemm_phase<gm::EpiPle, gm::DenseOrder, false>(lds, D_MODEL, S, E);
            if (rep == 0) xcd_barrier(bar);
        } } SEAM(13);
        if (IN(14)) { for (int rep = PROBED(14) ? 0 : 1; rep < 2; ++rep) { KP Q = fresh_params(); phase_ln<0, false>(Q, L, 2, lds, (L == DEPTH - 1) ? Q->out : (float*)(Q->ws + WS_H), L != DEPTH - 1); if (rep == 0) xcd_barrier(bar); } }
        if (L != DEPTH - 1) SEAM(14);
    }
#undef IN
#undef SEAM
}

#ifndef DEBUG_ATTN
#define DEBUG_ATTN 0
#endif
#if DEBUG_ATTN
__global__ void __launch_bounds__(256) dsa_scores(const bf16* __restrict__ qkvi  , const float* __restrict__ iw  , float* __restrict__ sc) {
    const int s0 = blockIdx.x * 64, t0 = blockIdx.y * 64;
    if (s0 > t0) return;
    __shared__ float Qs[64][68];
    __shared__ float Ks[64][68];
    const int tid = threadIdx.x, r = tid >> 2, kq = (tid & 3) * 16;
    {
        const bf16* kp = qkvi + (size_t)(s0 + r) * QLD + COL_IK + kq;
#pragma unroll
        for (int i = 0; i < 16; ++i) Ks[kq + i][r] = bf2f(kp[i]);
    }
    const int ty = tid >> 4, tx = tid & 15;
    float tot[4][4];
#pragma unroll
    for (int i = 0; i < 4; ++i)
#pragma unroll
        for (int j = 0; j < 4; ++j) tot[i][j] = 0.f;
    for (int hh = 0; hh < IDX_HEADS; ++hh) {
        __syncthreads();
        const bf16* qp = qkvi + (size_t)(t0 + r) * QLD + COL_IQ + hh * IDX_DIM + kq;
#pragma unroll
        for (int i = 0; i < 16; ++i) Qs[kq + i][r] = bf2f(qp[i]);
        __syncthreads();
        float acc[4][4];
#pragma unroll
        for (int i = 0; i < 4; ++i)
#pragma unroll
            for (int j = 0; j < 4; ++j) acc[i][j] = 0.f;
#pragma unroll 8
        for (int k = 0; k < 64; ++k) {
            const float4 a4 = *(const float4*)&Qs[k][ty * 4];
            const float4 b4 = *(const float4*)&Ks[k][tx * 4];
            const float a[4] = {a4.x, a4.y, a4.z, a4.w};
            const float b[4] = {b4.x, b4.y, b4.z, b4.w};
#pragma unroll
            for (int i = 0; i < 4; ++i)
#pragma unroll
                for (int j = 0; j < 4; ++j) acc[i][j] += a[i] * b[j];
        }
#pragma unroll
        for (int i = 0; i < 4; ++i) {
            const float w = iw[(size_t)(t0 + ty * 4 + i) * 4 + hh];
#pragma unroll
            for (int j = 0; j < 4; ++j) tot[i][j] += w * fmaxf(acc[i][j], 0.f);
        }
    }
#pragma unroll
    for (int i = 0; i < 4; ++i)
        *(float4*)(sc + (size_t)(t0 + ty * 4 + i) * SEQ + s0 + tx * 4) = make_float4(tot[i][0], tot[i][1], tot[i][2], tot[i][3]);
}

__device__ __forceinline__ unsigned fkey(float f) { const unsigned u = __float_as_uint(f); return (u & 0x80000000u) ? ~u : (u | 0x80000000u); }
__global__ void __launch_bounds__(256) dsa_topk(const float* __restrict__ sc, int* __restrict__ sel) {
    const int t = blockIdx.x, tid = threadIdx.x, n = t + 1;
    int* out = sel + (size_t)t * TOPK;
    if (n <= TOPK) { out[tid] = tid <= t ? tid : 0; return; }
    const float* row = sc + (size_t)t * SEQ;
    __shared__ unsigned hist[256];
    __shared__ unsigned s_prefix, s_need;
    __shared__ int wsum[2][4];
    unsigned prefix = 0, need = TOPK;
    for (int pass = 3; pass >= 0; --pass) {
        hist[tid] = 0;
        __syncthreads();
        for (int i = tid; i < n; i += 256) {
            const unsigned k = fkey(row[i]);
            const bool match = (pass == 3) ? true : ((k >> (8 * (pass + 1))) == prefix);
            if (match) atomicAdd(&hist[(k >> (8 * pass)) & 255u], 1u);
        }
        __syncthreads();
        if (tid == 0) {
            unsigned c = 0; int d = 255;
            for (; d > 0; --d) { if (c + hist[d] >= need) break; c += hist[d]; }
            s_prefix = (prefix << 8) | (unsigned)d; s_need = need - c;
        }
        __syncthreads();
        prefix = s_prefix; need = s_need;
        __syncthreads();
    }
    const unsigned T = prefix;
    const int n_gt = TOPK - (int)need;
    int run_gt = 0, run_eq = 0;
    const int lane = tid & 63, w = tid >> 6;
    for (int base = 0; base < n; base += 256) {
        const int i = base + tid;
        unsigned k = 0; bool gt = false, eq = false;
        if (i < n) { k = fkey(row[i]); gt = k > T; eq = k == T; }
        const unsigned long long mg = __ballot(gt), me = __ballot(eq);
        const unsigned long long lower = (lane == 0) ? 0ull : (~0ull >> (64 - lane));
        const int pg = __popcll(mg & lower), pe = __popcll(me & lower);
        if (lane == 0) { wsum[0][w] = __popcll(mg); wsum[1][w] = __popcll(me); }
        __syncthreads();
        int og = 0, oe = 0, tg = 0, te = 0;
        for (int x = 0; x < 4; ++x) { if (x < w) { og += wsum[0][x]; oe += wsum[1][x]; } tg += wsum[0][x]; te += wsum[1][x]; }
        if (gt) out[run_gt + og + pg] = i;
        if (eq) { const int rk = run_eq + oe + pe; if (rk < (int)need) out[n_gt + rk] = i; }
        run_gt += tg; run_eq += te;
        __syncthreads();
    }
}

__global__ void __launch_bounds__(256) dsa_attn(const bf16* __restrict__ qkvi, const int* __restrict__ sel, bf16* __restrict__ attn) {
    const int tok = blockIdx.x, b = tok / SEQ, t = tok % SEQ, tid = threadIdx.x;
    __shared__ float qs[D_MODEL];
    __shared__ float lg[N_HEADS][TOPK];
    __shared__ int sidx[TOPK];
    const int cnt = (t + 1 < TOPK) ? (t + 1) : TOPK;
    const bf16* prow = qkvi + (size_t)tok * QLD;
#pragma unroll
    for (int i = 0; i < 4; ++i) qs[tid * 4 + i] = bf2f(prow[tid * 4 + i]);
    int s = 0;
    if (tid < cnt) s = (t < TOPK) ? tid : sel[(size_t)tok * TOPK + tid];
    sidx[tid] = s;
    __syncthreads();
    const float scale = 0.08838834764831845f;
    if (tid < cnt) {
        const bf16* krow = qkvi + (size_t)(b * SEQ + s) * QLD + COL_K;
        for (int g = 0; g < N_KV; ++g) {
            float d[4] = {0.f, 0.f, 0.f, 0.f};
            for (int k = 0; k < HEAD_DIM; ++k) {
                const float kv = bf2f(krow[g * HEAD_DIM + k]);
#pragma unroll
                for (int r = 0; r < 4; ++r) d[r] += qs[(g * 4 + r) * HEAD_DIM + k] * kv;
            }
#pragma unroll
            for (int r = 0; r < 4; ++r) {
                const int hh = g * 4 + r;
                const float slope = exp2f(-(float)(hh + 1));
                lg[hh][tid] = d[r] * scale - slope * (float)(t - s);
            }
        }
    } else {
        for (int hh = 0; hh < N_HEADS; ++hh) lg[hh][tid] = -INFINITY;
    }
    __syncthreads();
    {
        const int lane = tid & 63, w = tid >> 6;
        for (int h2 = 0; h2 < 2; ++h2) {
            const int hh = w * 2 + h2;
            float v[4], m = -INFINITY;
#pragma unroll
            for (int i = 0; i < 4; ++i) { v[i] = lg[hh][lane + 64 * i]; m = fmaxf(m, v[i]); }
            for (int o = 32; o > 0; o >>= 1) m = fmaxf(m, __shfl_xor(m, o));
            float sum = 0.f;
#pragma unroll
            for (int i = 0; i < 4; ++i) { v[i] = expf(v[i] - m); sum += v[i]; }
            for (int o = 32; o > 0; o >>= 1) sum += __shfl_xor(sum, o);
            const float inv = 1.f / sum;
#pragma unroll
            for (int i = 0; i < 4; ++i) lg[hh][lane + 64 * i] = v[i] * inv;
        }
    }
    __syncthreads();
    {
        const int col = tid * 4, hh = col / HEAD_DIM, g = hh / HEAD_GROUP, d = col % HEAD_DIM;
        float acc[4] = {0.f, 0.f, 0.f, 0.f};
        for (int j = 0; j < cnt; ++j) {
            const float p = lg[hh][j];
            const u32x2 vv = *(const u32x2*)(qkvi + (size_t)(b * SEQ + sidx[j]) * QLD + COL_V + g * HEAD_DIM + d);
            acc[0] += p * bflo(vv.x); acc[1] += p * bfhi(vv.x); acc[2] += p * bflo(vv.y); acc[3] += p * bfhi(vv.y);
        }
        u32x2 o; o.x = cvt_pk_bf16(acc[0], acc[1]); o.y = cvt_pk_bf16(acc[2], acc[3]);
        *(u32x2*)(attn + (size_t)tok * D_MODEL + col) = o;
    }
}

__global__ void __launch_bounds__(128) kmeans_kernel(const bf16* __restrict__ kv, float* __restrict__ km) {
    const int blk = blockIdx.x % N_BLOCKS, g = (blockIdx.x / N_BLOCKS) % N_KV, b = blockIdx.x / (N_BLOCKS * N_KV), d = threadIdx.x;
    float s = 0.f;
    for (int i = 0; i < MOBA_BLOCK; ++i) s += bf2f(kv[(size_t)(b * SEQ + blk * MOBA_BLOCK + i) * 512 + g * HEAD_DIM + d]);
    km[((size_t)(b * N_KV + g) * N_BLOCKS + blk) * HEAD_DIM + d] = s * (1.f / MOBA_BLOCK);
}

__global__ void __launch_bounds__(256) moba_attn(const bf16* __restrict__ q, const bf16* __restrict__ kv, const float* __restrict__ km, bf16* __restrict__ attn) {
    const int tok = blockIdx.x, b = tok / SEQ, t = tok % SEQ, tid = threadIdx.x, own = t / MOBA_BLOCK;
    __shared__ float qs[HEAD_DIM];
    __shared__ float gate[N_BLOCKS];
    __shared__ int selb[3];
    __shared__ float lg[4 * MOBA_BLOCK];
    __shared__ float red[8];
    __shared__ float part[2][HEAD_DIM];
    const float scale = 0.08838834764831845f;
    for (int hh = 0; hh < N_HEADS; ++hh) {
        const int g = hh / HEAD_GROUP;
        const float slope = exp2f(-(float)(hh + 1));
        __syncthreads();
        if (tid < HEAD_DIM) qs[tid] = bf2f(q[(size_t)tok * D_MODEL + hh * HEAD_DIM + tid]);
        __syncthreads();
        if (tid < N_BLOCKS) {
            float gval = -INFINITY;
            if (tid < own) {
                const float* kp = km + ((size_t)(b * N_KV + g) * N_BLOCKS + tid) * HEAD_DIM;
                float s = 0.f;
                for (int k = 0; k < HEAD_DIM; ++k) s += qs[k] * kp[k];
                gval = s;
            }
            gate[tid] = gval;
        }
        __syncthreads();
        if (tid == 0) {
            unsigned used = 0u;
            for (int s = 0; s < 3; ++s) {
                int best = -1; float bv = 0.f;
                for (int j = 0; j < N_BLOCKS; ++j) if (!((used >> j) & 1u) && (best < 0 || gate[j] > bv)) { best = j; bv = gate[j]; }
                used |= 1u << best; selb[s] = best;
            }
        }
        __syncthreads();
        for (int s = 0; s < 4; ++s) {
            const int blk = (s < 3) ? selb[s] : own;
            const int kpos = blk * MOBA_BLOCK + tid;
            const bool valid = (s < 3) ? (blk < own) : (kpos <= t);
            float v = -INFINITY;
            if (valid) {
                const bf16* kp = kv + (size_t)(b * SEQ + kpos) * 512 + g * HEAD_DIM;
                float d = 0.f;
                for (int k = 0; k < HEAD_DIM; ++k) d += qs[k] * bf2f(kp[k]);
                v = d * scale - slope * (float)(t - kpos);
            }
            lg[s * MOBA_BLOCK + tid] = v;
        }
        __syncthreads();
        float m = fmaxf(fmaxf(lg[tid], lg[256 + tid]), fmaxf(lg[512 + tid], lg[768 + tid]));
        for (int o = 32; o > 0; o >>= 1) m = fmaxf(m, __shfl_xor(m, o));
        if ((tid & 63) == 0) red[tid >> 6] = m;
        __syncthreads();
        m = fmaxf(fmaxf(red[0], red[1]), fmaxf(red[2], red[3]));
        float e[4], sum = 0.f;
#pragma unroll
        for (int i = 0; i < 4; ++i) { e[i] = expf(lg[i * 256 + tid] - m); sum += e[i]; }
        for (int o = 32; o > 0; o >>= 1) sum += __shfl_xor(sum, o);
        if ((tid & 63) == 0) red[4 + (tid >> 6)] = sum;
        __syncthreads();
        const float inv = 1.f / (red[4] + red[5] + red[6] + red[7]);
#pragma unroll
        for (int i = 0; i < 4; ++i) lg[i * 256 + tid] = e[i] * inv;
        __syncthreads();
        {
            const int d = tid & 127, half = tid >> 7;
            float acc = 0.f;
            for (int s = 0; s < 4; ++s) {
                const int blk = (s < 3) ? selb[s] : own;
                const bool bvalid = (s < 3) ? (blk < own) : true;
                if (!bvalid) continue;
                const bf16* vp = kv + (size_t)(b * SEQ + blk * MOBA_BLOCK + half * 128) * 512 + KV_DIM + g * HEAD_DIM + d;
                const float* pp = lg + s * MOBA_BLOCK + half * 128;
                for (int j = 0; j < 128; ++j) { const float p = pp[j]; if (p != 0.f) acc += p * bf2f(vp[(size_t)j * 512]); }
            }
            part[half][d] = acc;
        }
        __syncthreads();
        if (tid < HEAD_DIM) attn[(size_t)tok * D_MODEL + hh * HEAD_DIM + tid] = (bf16)(cvt_pk_bf16(part[0][tid] + part[1][tid], 0.f) & 0xffffu);
    }
}


#endif
#ifndef DEBUG_ATTN
#define DEBUG_ATTN 0
#endif
#if DEBUG_ATTN
__global__ void dbg_compare(const bf16* __restrict__ a, const bf16* __restrict__ ref, size_t n, float* __restrict__ acc) {
    float d2 = 0.f, r2 = 0.f;
    for (size_t i = (size_t)blockIdx.x * blockDim.x + threadIdx.x; i < n; i += (size_t)gridDim.x * blockDim.x) { const float x = bf2f(a[i]), y = bf2f(ref[i]); d2 += (x - y) * (x - y); r2 += y * y; }
    d2 = wave_sum(d2); r2 = wave_sum(r2);
    if ((threadIdx.x & 63) == 0) { atomicAdd(&acc[0], d2); atomicAdd(&acc[1], r2); }
}
__global__ void dbg_scale(float* __restrict__ out, size_t n, const float* __restrict__ acc) {
    const float rv = acc[0] / fmaxf(acc[1], 1e-30f);
    float e = sqrtf(fminf(rv * 100.f, 4.f)); if (!(rv == rv)) e = 3.f;
    for (size_t i = (size_t)blockIdx.x * blockDim.x + threadIdx.x; i < n; i += (size_t)gridDim.x * blockDim.x) out[i] *= (1.f + e);
}
#endif

extern "C" void kernel_launch(void* const* d_in, const int* in_sizes, int n_in, void* d_out, int out_size, void* d_ws, size_t ws_size, hipStream_t stream) {
    static int grid = 0;
    if (grid == 0) {
        int dev = 0, cus = 0;
        (void)hipGetDevice(&dev); (void)hipDeviceGetAttribute(&cus, hipDeviceAttributeMultiprocessorCount, dev);
        (void)hipFuncSetAttribute((const void*)fwd, hipFuncAttributeMaxDynamicSharedMemorySize, LDS_BYTES);
        grid = cus > 0 ? cus : 256;
    }
    unsigned char* ws = (unsigned char*)d_ws;
    (void)hipMemsetAsync(ws + WS_CTL, 0, CTL_ZERO_BYTES, stream);
    Params P{};
    for (int i = 0; i < 18; ++i) P.in[i] = (const float*)d_in[i];
    P.out = (float*)d_out; P.ws = ws;
    int nlaunch = 0;
    auto run = [&](int lo, int hi) { P.ph_lo = lo; P.ph_hi = hi; P.bar_idx = nlaunch++; hipLaunchKernelGGL(fwd, dim3(grid), dim3(512), LDS_BYTES, stream, P); };
#if DEBUG_ATTN
    const bf16* qkvi = (const bf16*)(ws + WS_QKVI); bf16* attn = (bf16*)(ws + WS_ATTN); int* sel = (int*)(ws + WS_SEL);
    float* scores = (float*)(ws + WS_SCORES); const float* iw = (const float*)(ws + WS_IW); const bf16* kvb = (const bf16*)(ws + WS_KV); float* km = (float*)(ws + WS_KM);
#endif
#if DEBUG_ATTN == 0
    run(0, DEPTH * 16);
#else
    for (int L = 0; L < DEPTH; ++L) {
        const int pb = L * 16;
        if (L < N_A) {
#if DEBUG_ATTN == 4
            if (L == 1) {
                run(pb + 0, pb + 3);
                bf16* attn2 = (bf16*)(ws + WS_PL);
                dsa_attn<<<NTOK, 256, 0, stream>>>(qkvi, sel, attn2);
                run(pb + 3, pb + 4);
                dbg_compare<<<1024, 256, 0, stream>>>(attn, attn2, (size_t)NTOK * D_MODEL, (float*)(ws + WS_CTL) + 1024);
                run(pb + 7, pb + 15);
            } else
#endif
#if DEBUG_ATTN == 3
            if (L == 1) {
                run(pb + 0, pb + 2);
                bf16* attn2 = (bf16*)(ws + WS_PL);
                for (int b = 0; b < BATCH; ++b) {
                    dsa_scores<<<dim3(SEQ / 64, SEQ / 64), 256, 0, stream>>>(qkvi + (size_t)b * SEQ * QLD, iw + (size_t)b * SEQ * 4, scores);
                    dsa_topk<<<SEQ, 256, 0, stream>>>(scores, sel + (size_t)b * SEQ * TOPK);
                }
                dsa_attn<<<NTOK, 256, 0, stream>>>(qkvi, sel, attn2);
                run(pb + 2, pb + 4);
                dbg_compare<<<1024, 256, 0, stream>>>(attn, attn2, (size_t)NTOK * D_MODEL, (float*)(ws + WS_CTL) + 1024);
                run(pb + 7, pb + 15);
            } else
#endif
            { run(pb + 0, pb + 4); run(pb + 7, pb + 15); }
        } else {
            run(pb + 0, pb + 7);
#if DEBUG_ATTN == 1
            if (L == N_A) {
                bf16* attn2 = (bf16*)(ws + WS_PL);
                kmeans_kernel<<<BATCH * N_KV * N_BLOCKS, 128, 0, stream>>>(kvb, km + 65536);
                moba_attn<<<NTOK, 256, 0, stream>>>(qkvi, kvb, km + 65536, attn2);
                dbg_compare<<<1024, 256, 0, stream>>>(attn, attn2, (size_t)NTOK * D_MODEL, (float*)(ws + WS_CTL) + 1024);
            }
#endif
            run(pb + 7, pb + 15);
        }
    }
#endif
#if DEBUG_ATTN
    dbg_scale<<<1024, 256, 0, stream>>>((float*)d_out, (size_t)NTOK * D_MODEL, (const float*)(ws + WS_CTL) + 1024);
#endif
}
```

```cpp
#include <hip/hip_runtime.h>
#include <stdint.h>

#define D_MODEL 1024
#define BATCH 4
#define SEQ 8192
#define NTOK (BATCH * SEQ)
#define DEPTH 4
#define N_A 2
#define N_HEADS 8
#define HEAD_DIM 128
#define N_KV 2
#define HEAD_GROUP 4
#define KV_DIM 256
#define IDX_HEADS 4
#define IDX_DIM 64
#define TOPK 256
#define MOBA_BLOCK 256
#define N_BLOCKS 32
#define N_GROUPS 4
#define EPG 8
#define N_EXPERTS 32
#define D_EXPERT 512
#define PLE_DIM 256
#define A_COLS 1860
#define QLD 2048
#define COL_K 1024
#define COL_V 1280
#define COL_IQ 1536
#define COL_IK 1792
#define COL_IW 1856
#define ALPHA_F 1.6817928305074290f
#define LN_EPS 1e-5f
#define MAX_SLOTS (65536 + 8192)
#define MAX_MTILES (MAX_SLOTS / 256)

#define LAS __attribute__((address_space(3)))
#define GAS __attribute__((address_space(1)))
typedef unsigned short bf16;
typedef short bf16x8 __attribute__((ext_vector_type(8)));
typedef float f32x4 __attribute__((ext_vector_type(4)));
typedef float f32x2 __attribute__((ext_vector_type(2)));
typedef unsigned u32x4 __attribute__((ext_vector_type(4)));
typedef unsigned u32x2 __attribute__((ext_vector_type(2)));
typedef _Float16 f16x4 __attribute__((ext_vector_type(4)));

__device__ __forceinline__ unsigned cvt_pk_bf16(float lo, float hi) { unsigned r; asm("v_cvt_pk_bf16_f32 %0, %1, %2" : "=v"(r) : "v"(lo), "v"(hi)); return r; }
__device__ __forceinline__ float bf2f(bf16 b) { return __uint_as_float(((unsigned)b) << 16); }
__device__ __forceinline__ float bflo(unsigned u) { return __uint_as_float(u << 16); }
__device__ __forceinline__ float bfhi(unsigned u) { return __uint_as_float(u & 0xffff0000u); }
template <int CTRL> __device__ __forceinline__ float dpp_add(float v) { return v + __int_as_float(__builtin_amdgcn_update_dpp(0, __float_as_int(v), CTRL, 0xF, 0xF, false)); }
__device__ __forceinline__ float row16_sum(float v) {
    v = dpp_add<0xB1>(v); v = dpp_add<0x4E>(v); v = dpp_add<0x141>(v); v = dpp_add<0x140>(v); return v;
}
__device__ __forceinline__ float wave_sum(float v) { v = row16_sum(v); v += __shfl_xor(v, 16); v += __shfl_xor(v, 32); return v; }

constexpr size_t MiB = 1u << 20;
constexpr size_t WS_CTL = 0, CTL_ZERO_BYTES = 1 * MiB;
constexpr size_t WS_WMIX = 2 * MiB;
constexpr size_t WS_WPG = 10 * MiB;
constexpr size_t WS_WPLE = 12 * MiB;
constexpr size_t WS_WGU = 16 * MiB;
constexpr size_t WS_WD = 80 * MiB;
constexpr size_t WS_PB = 112 * MiB;
constexpr size_t WS_H = 128 * MiB;
constexpr size_t WS_HB = 256 * MiB;
constexpr size_t WS_T = 320 * MiB;
constexpr size_t WS_KV = 448 * MiB;
constexpr size_t WS_PL = 480 * MiB;
constexpr size_t WS_QKVI = 544 * MiB;
constexpr size_t WS_ATTN = 672 * MiB;
constexpr size_t WS_SEL = 736 * MiB;
constexpr size_t WS_ACT = 544 * MiB;
constexpr size_t WS_Y = 616 * MiB;
constexpr size_t WS_MOE = 768 * MiB;
constexpr size_t WS_IW = 770 * MiB;
constexpr size_t WS_KM = 771 * MiB;
constexpr size_t WS_SCORES = 772 * MiB;
constexpr int MO_TOK_E = 0, MO_TOK_POS = NTOK * 2, MO_TOK_SLOT = NTOK * 4, MO_TOK_W = NTOK * 6, MO_SLOT_TOK = NTOK * 8, MO_TILE_E = MO_SLOT_TOK + MAX_SLOTS, MO_TILE_ROW0 = MO_TILE_E + 512, MO_TILE_NV = MO_TILE_ROW0 + 512;
constexpr int CW_BAR = 65536;
constexpr int CW_CNT = 16384;
constexpr int CW_NTILES = 16384 + 256;

constexpr int LDS_BYTES = 163840;
constexpr int LDS_MISC = 163840 - 256;
constexpr int NWAVES = 8;

#define XB_TMO      128
#define XB_XCNT(j)  (256  + 64 * (j))
#define XB_XSUB(j)  (1280 + 64 * (j))
#define XB_XGEN(j)  (2304 + 64 * (j))
#define XB_TOP      3328
#define XB_TOPGEN   3392
#define XCD_BAR_WORDS 3456
#define XB_SPIN_CAP (1u << 22)
__device__ __forceinline__ unsigned xb_ld(unsigned* p)              { return __hip_atomic_load(p, __ATOMIC_RELAXED, __HIP_MEMORY_SCOPE_AGENT); }
__device__ __forceinline__ unsigned xb_add(unsigned* p, unsigned v) { return __hip_atomic_fetch_add(p, v, __ATOMIC_RELAXED, __HIP_MEMORY_SCOPE_AGENT); }
__device__ __forceinline__ unsigned xb_xcc_id() { return (unsigned)__builtin_amdgcn_s_getreg((3 << 11) | 20) & 0xFu; }
#define XB_SPIN(cond, bar) do { unsigned _sp = 0; while (cond) { __builtin_amdgcn_s_sleep(1); \
    if ((++_sp & 255u) == 0u) { if (xb_ld(&(bar)[XB_TMO])) break; if (_sp > XB_SPIN_CAP) { atomicAdd(&(bar)[XB_TMO], 1u); break; } } } } while (0)
struct XcdBarrier { unsigned* bar; unsigned x; volatile LAS unsigned* st; };
__device__ __forceinline__ XcdBarrier xcd_barrier_post(unsigned* bar, volatile LAS unsigned* st) {
    XcdBarrier b; b.bar = bar; b.x = xb_xcc_id(); b.st = st;
    if (threadIdx.x == 0) (void)xb_add(&bar[XB_XCNT(b.x)], 1u);
    return b;
}
__device__ __forceinline__ void xcd_barrier_complete(unsigned* bar, unsigned x, unsigned& nloc, unsigned& nx) {
    const unsigned G = gridDim.x * gridDim.y * gridDim.z;
    unsigned sum, cnt, mine, sp = 0u;
    for (;;) {
        sum = 0u; cnt = 0u; mine = 0u;
#pragma unroll
        for (unsigned j = 0; j < 16; ++j) { const unsigned c = xb_ld(&bar[XB_XCNT(j)]); sum += c; cnt += (c > 0u) ? 1u : 0u; mine = (j == x) ? c : mine; }
        if (sum == G) break;
        __builtin_amdgcn_s_sleep(1);
        if ((++sp & 255u) == 0u) { if (xb_ld(&bar[XB_TMO])) break; if (sp > XB_SPIN_CAP) { atomicAdd(&bar[XB_TMO], 1u); break; } }
    }
    nloc = mine > 0u ? mine : 1u; nx = cnt > 0u ? cnt : 1u;
}
__device__ __forceinline__ void xcd_barrier(const XcdBarrier& b) {
    asm volatile("s_waitcnt vmcnt(0)" ::: "memory");
    __syncthreads();
    if (threadIdx.x == 0) {
        unsigned* bar = b.bar;
        __builtin_amdgcn_s_waitcnt(0);
        unsigned nloc = b.st[0], nx = b.st[1];
        if (nloc == 0u) { xcd_barrier_complete(bar, b.x, nloc, nx); b.st[0] = nloc; b.st[1] = nx; }
        const unsigned old = xb_add(&bar[XB_XSUB(b.x)], 1u);
        const unsigned gen = old / nloc;
        if (old + 1u == (gen + 1u) * nloc) {
            __builtin_amdgcn_fence(__ATOMIC_RELEASE, "agent");
            asm volatile("s_waitcnt vmcnt(0)" ::: "memory");
            const unsigned og = xb_add(&bar[XB_TOP], 1u);
            const unsigned tg = og / nx;
            if (og + 1u == (tg + 1u) * nx) xb_add(&bar[XB_TOPGEN], 1u);
            else XB_SPIN(xb_ld(&bar[XB_TOPGEN]) == tg, bar);
            __builtin_amdgcn_fence(__ATOMIC_ACQUIRE, "agent");
            xb_add(&bar[XB_XGEN(b.x)], 1u);
            asm volatile("s_waitcnt vmcnt(0)" ::: "memory");
        } else {
            XB_SPIN(xb_ld(&bar[XB_XGEN(b.x)]) == gen, bar);
            __builtin_amdgcn_fence(__ATOMIC_ACQUIRE, "agent");
            asm volatile("s_waitcnt vmcnt(0)" ::: "memory");
        }
    }
    __syncthreads();
}

namespace gm {
constexpr int BM = 256, BK = 64, HALF = 128, HTB = HALF * BK * 2, STAGE_BYTES = 8 * HTB, NXCD = 8, WGM = 8;
__host__ __device__ __forceinline__ int lds_byte(int r, int c) { const int st = (r >> 4) * 2 + (c >> 5), rr = r & 15, cc = c & 31, ob = rr * 64 + cc * 2; return st * 1024 + (ob ^ (((ob >> 9) & 1) << 5)); }
__host__ __device__ __forceinline__ void stage_rc(int b, int& R, int& C) { const int st = b / 1024, sb = b % 1024, swz = sb ^ (((sb >> 9) & 1) << 5); R = (st >> 1) * 16 + swz / 64; C = (st & 1) * 32 + (swz % 64) / 2; }
__host__ __device__ __forceinline__ int perm32(int rho) { const int n = rho >> 4, i = rho & 15; return 8 * (i >> 2) + 4 * n + (i & 3); }

struct Unit { const char* a; const char* b; int row0, col0, aux; };

struct DenseOrder {
    int nM, nN, nwg, G, c; const char* A; const char* B; size_t tA, tB;
    __device__ void init(const void* A_, const void* Bt_, int M, int N, int K, int G_, int c_) { nM = M / BM; nN = N / BM; nwg = nM * nN; G = G_; c = c_; A = (const char*)A_; B = (const char*)Bt_; tA = (size_t)BM * K * 2; tB = tA; }
    __device__ bool next(int i, Unit& u) const {
        const long L = (long)i * G + c; if (L >= nwg) return false;
        int wgid = (int)L; { const int q = nwg / NXCD, r = nwg % NXCD, xcd = wgid % NXCD, off = wgid / NXCD; wgid = (xcd < r ? xcd * (q + 1) : r * (q + 1) + (xcd - r) * q) + off; }
        const int nig = WGM * nN, gid = wgid / nig, fm = gid * WGM, gsz = (nM - fm) < WGM ? (nM - fm) : WGM;
        const int pm = fm + ((wgid % nig) % gsz), pn = (wgid % nig) / gsz;
        u.a = A + (size_t)pm * tA; u.b = B + (size_t)pn * tB; u.row0 = pm * BM; u.col0 = pn * BM; u.aux = 0; return true;
    }
    __device__ __forceinline__ void gather(const Unit&, unsigned (&)[2][2], const int (&)[2], const int (&)[2], int) const {}
};
struct MoeOrder {
    const int* tile_e; const int* tile_row0; const int* tile_nv; const int* slot_tok; int n_units, G, c, K; const char* A; const char* W; size_t wstride, tB; bool gath;
    __device__ bool next(int i, Unit& u) const {
        const int L = i * G + c; if (L >= n_units) return false;
        const int T = L >> 2, pn = L & 3;
        const int e = __builtin_amdgcn_readfirstlane(tile_e[T]), r0 = __builtin_amdgcn_readfirstlane(tile_row0[T]), nv = __builtin_amdgcn_readfirstlane(tile_nv[T]);
        u.a = gath ? A : A + (size_t)r0 * K * 2; u.b = W + (size_t)e * wstride + (size_t)pn * tB; u.row0 = r0; u.col0 = pn; u.aux = nv; return true;
    }
    __device__ __forceinline__ void gather(const Unit& u, unsigned (&vo)[2][2], const int (&sR)[2], const int (&sC)[2], int K_) const {
#pragma unroll
        for (int h = 0; h < 2; ++h)
#pragma unroll
            for (int i = 0; i < 2; ++i) { const int r = h * HALF + sR[i]; const int tok = (r < u.aux) ? slot_tok[u.row0 + r] : 0; vo[h][i] = (unsigned)(tok * K_ + sC[i]) * 2u; }
    }
};

template <class Epi, class Sched, bool GATHER>
__device__ __forceinline__ void gemm_phase(LAS unsigned char* lds, const int K, const Sched& S, const Epi& E) {
    int tz = threadIdx.x; asm volatile("" : "+v"(tz));
    const int tid = tz, wid = __builtin_amdgcn_readfirstlane(tid >> 6), lane = tid & 63, wr = wid >> 2, wc = wid & 3, fr = lane & 15, fq = lane >> 4;
    const int nt = K / BK;
    unsigned voffB[2], vA[2][2], vAn[2][2]; int sR[2], sC[2];
#pragma unroll
    for (int i = 0; i < 2; ++i) { int R, C; stage_rc(tid * 16 + i * 8192, R, C); const int Rb = Epi::PERM ? ((R & ~31) + perm32(R & 31)) : R;
        sR[i] = R; sC[i] = C; voffB[i] = (unsigned)(Rb * K + C) * 2u;
        vA[0][i] = (unsigned)(R * K + C) * 2u; vA[1][i] = (unsigned)((R + HALF) * K + C) * 2u; vAn[0][i] = vA[0][i]; vAn[1][i] = vA[1][i]; }
    const size_t kstep = (size_t)(BK * 2);
    const size_t hstep = (size_t)HALF * K * 2;
    const unsigned ldsw = (unsigned)wid * 1024u;
    const int aoff = lds_byte(wr * 64 + fr, fq * 8), boff = lds_byte(wc * 32 + fr, fq * 8);
#define PG8_SA(b, h) (((b) * 2 + (h)) * HTB)
#define PG8_SB(b, h) ((4 + (b) * 2 + (h)) * HTB)
#define PG8_STAGE(bufoff, gbase, voff) do { _Pragma("unroll") for (int _i = 0; _i < 2; ++_i) \
        __builtin_amdgcn_global_load_lds((const unsigned*)((const char*)(gbase) + (voff)[_i]), (LAS unsigned*)(lds + (bufoff) + ldsw + _i * 8192), 16, 0, 0); } while (0)
#define PG8_LDA(dst, b, h) do { _Pragma("unroll") for (int m = 0; m < 4; ++m) _Pragma("unroll") for (int k = 0; k < 2; ++k) dst[m][k] = *(const LAS bf16x8*)(lds + PG8_SA(b, h) + aoff + m * 2048 + k * 1024); } while (0)
#define PG8_LDB(dst, b, h) do { _Pragma("unroll") for (int n = 0; n < 2; ++n) _Pragma("unroll") for (int k = 0; k < 2; ++k) dst[n][k] = *(const LAS bf16x8*)(lds + PG8_SB(b, h) + boff + n * 2048 + k * 1024); } while (0)
#define PG8_MMA(ai, bj, At, Bt) do { __builtin_amdgcn_s_setprio(1); _Pragma("unroll") for (int m = 0; m < 4; ++m) _Pragma("unroll") for (int n = 0; n < 2; ++n) _Pragma("unroll") for (int k = 0; k < 2; ++k) \
        acc[ai][bj][m][n] = __builtin_amdgcn_mfma_f32_16x16x32_bf16(Bt[n][k], At[m][k], acc[ai][bj][m][n], 0, 0, 0); __builtin_amdgcn_s_setprio(0); } while (0)
#define PG8_WAIT_V(n) asm volatile("s_waitcnt vmcnt(" #n ")" ::: "memory")
#define PG8_WAIT_L(n) asm volatile("s_waitcnt lgkmcnt(" #n ")" ::: "memory")
#define PG8_BAR __builtin_amdgcn_s_barrier()
#define PG8_SCHED __builtin_amdgcn_sched_barrier(0)
    Unit cur, nxt; int ui = 0;
    if (!S.next(0, cur)) return;
    f32x4 acc[2][2][4][2];
#pragma unroll
    for (int a = 0; a < 2; ++a)
#pragma unroll
        for (int b = 0; b < 2; ++b)
#pragma unroll
            for (int m = 0; m < 4; ++m)
#pragma unroll
                for (int n = 0; n < 2; ++n) acc[a][b][m][n] = (f32x4){0.f, 0.f, 0.f, 0.f};
    bf16x8 At[4][2], B0[2][2], B1[2][2];
    const char* cA = cur.a; const char* cB = cur.b;
    if constexpr (GATHER) S.gather(cur, vA, sR, sC, K);
    PG8_STAGE(PG8_SB(0, 0), cB, voffB); PG8_STAGE(PG8_SB(0, 1), cB + hstep, voffB); PG8_STAGE(PG8_SA(0, 0), cA, vA[0]); PG8_STAGE(PG8_SA(0, 1), cA, vA[1]);
    if (wr == 1) PG8_BAR;
    PG8_WAIT_V(2); PG8_BAR;
    PG8_STAGE(PG8_SB(1, 0), cB + kstep, voffB); PG8_STAGE(PG8_SA(1, 0), cA + kstep, vA[0]); PG8_STAGE(PG8_SB(1, 1), cB + hstep + kstep, voffB);
    PG8_WAIT_V(6); PG8_BAR;
    for (;;) {
        const bool has_next = S.next(ui + 1, nxt);
        const char* nA = has_next ? nxt.a : cA; const char* nB = has_next ? nxt.b : cB;
        if constexpr (GATHER) {
            if (has_next) S.gather(nxt, vAn, sR, sC, K);
            else { vAn[0][0] = vA[0][0]; vAn[0][1] = vA[0][1]; vAn[1][0] = vA[1][0]; vAn[1][1] = vA[1][1]; }
        }
        for (int t = 0; t < nt; t += 2) {
            const bool last = (t == nt - 2);
            const char* a1 = cA + (size_t)(t + 1) * kstep;
            const char* a2 = last ? nA : cA + (size_t)(t + 2) * kstep; const char* b2 = last ? nB : cB + (size_t)(t + 2) * kstep;
            const char* a3 = a2 + kstep; const char* b3 = b2 + kstep;
            unsigned w0[2], w1[2];
            if constexpr (GATHER) { w0[0] = last ? vAn[0][0] : vA[0][0]; w0[1] = last ? vAn[0][1] : vA[0][1]; w1[0] = last ? vAn[1][0] : vA[1][0]; w1[1] = last ? vAn[1][1] : vA[1][1]; }
            else { w0[0] = vA[0][0]; w0[1] = vA[0][1]; w1[0] = vA[1][0]; w1[1] = vA[1][1]; }
            PG8_LDB(B0, 0, 0); PG8_LDB(B1, 0, 1); PG8_SCHED; PG8_LDA(At, 0, 0); PG8_STAGE(PG8_SA(1, 1), a1, vA[1]);
            PG8_WAIT_V(8); PG8_WAIT_L(0); PG8_BAR; PG8_MMA(0, 0, At, B0); PG8_MMA(0, 1, At, B1); PG8_BAR; PG8_SCHED;
            PG8_LDA(At, 0, 1); PG8_STAGE(PG8_SB(0, 0), b2, voffB); PG8_STAGE(PG8_SB(0, 1), b2 + hstep, voffB); PG8_STAGE(PG8_SA(0, 0), a2, w0);
            PG8_WAIT_V(8); PG8_WAIT_L(0); PG8_BAR; PG8_MMA(1, 0, At, B0); PG8_MMA(1, 1, At, B1); PG8_BAR; PG8_SCHED;
            PG8_LDB(B0, 1, 0); PG8_LDB(B1, 1, 1); PG8_SCHED; PG8_LDA(At, 1, 0); PG8_STAGE(PG8_SA(0, 1), a2, w1);
            PG8_WAIT_V(8); PG8_WAIT_L(0); PG8_BAR; PG8_MMA(0, 0, At, B0); PG8_MMA(0, 1, At, B1); PG8_BAR; PG8_SCHED;
            PG8_LDA(At, 1, 1); PG8_STAGE(PG8_SB(1, 0), b3, voffB); PG8_STAGE(PG8_SB(1, 1), b3 + hstep, voffB); PG8_STAGE(PG8_SA(1, 0), a3, w0);
            PG8_WAIT_V(8); PG8_WAIT_L(0); PG8_BAR; PG8_MMA(1, 0, At, B0); PG8_MMA(1, 1, At, B1); PG8_BAR; PG8_SCHED;
        }
        if (wr == 0) PG8_BAR;
        E(acc, cur, wr, wc, fr, fq);
        if (!has_next) break;
#pragma unroll
        for (int a = 0; a < 2; ++a)
#pragma unroll
            for (int b = 0; b < 2; ++b)
#pragma unroll
                for (int m = 0; m < 4; ++m)
#pragma unroll
                    for (int n = 0; n < 2; ++n) acc[a][b][m][n] = (f32x4){0.f, 0.f, 0.f, 0.f};
        cur = nxt; cA = nA; cB = nB; ++ui;
        if constexpr (GATHER) { vA[0][0] = vAn[0][0]; vA[0][1] = vAn[0][1]; vA[1][0] = vAn[1][0]; vA[1][1] = vAn[1][1]; }
        if (wr == 1) PG8_BAR;
    }
    PG8_WAIT_V(0);
    PG8_BAR;
#undef PG8_SA
#undef PG8_SB
#undef PG8_STAGE
#undef PG8_LDA
#undef PG8_LDB
#undef PG8_MMA
#undef PG8_WAIT_V
#undef PG8_WAIT_L
#undef PG8_BAR
#undef PG8_SCHED
}

#define EPI_ROWS(u, ai, m) ((u).row0 + (ai) * HALF + wr * 64 + (m) * 16 + fr)
struct EpiBf16 {
    static constexpr bool PERM = true;
    bf16* O; int ldc; float* iw;
    __device__ __forceinline__ void operator()(const f32x4 (&acc)[2][2][4][2], const Unit& u, int wr, int wc, int fr, int fq) const {
#pragma unroll
        for (int ai = 0; ai < 2; ++ai)
#pragma unroll
            for (int m = 0; m < 4; ++m) { const int row = EPI_ROWS(u, ai, m); bf16* rowp = O + (size_t)row * ldc + u.col0 + wc * 32 + 8 * fq;
#pragma unroll
                for (int bj = 0; bj < 2; ++bj) { const f32x4 v0 = acc[ai][bj][m][0], v1 = acc[ai][bj][m][1];
                    u32x4 w; w.x = cvt_pk_bf16(v0[0], v0[1]); w.y = cvt_pk_bf16(v0[2], v0[3]); w.z = cvt_pk_bf16(v1[0], v1[1]); w.w = cvt_pk_bf16(v1[2], v1[3]);
                    *(u32x4*)(rowp + bj * HALF) = w; }
                if (iw != nullptr && u.col0 == 1792 && wc == 2 && fq == 0) *(f32x4*)(iw + (size_t)row * 4) = acc[ai][0][m][0] * 0.0625f; }
    }
};
struct EpiResid {
    static constexpr bool PERM = false;
    const float* h; _Float16* t;
    __device__ __forceinline__ void operator()(const f32x4 (&acc)[2][2][4][2], const Unit& u, int wr, int wc, int fr, int fq) const {
#pragma unroll
        for (int ai = 0; ai < 2; ++ai)
#pragma unroll
            for (int m = 0; m < 4; ++m) { const size_t o = (size_t)EPI_ROWS(u, ai, m) * D_MODEL + u.col0 + wc * 32 + 4 * fq;
#pragma unroll
                for (int bj = 0; bj < 2; ++bj)
#pragma unroll
                    for (int n = 0; n < 2; ++n) { const size_t oo = o + bj * HALF + n * 16; const f32x4 hv = *(const f32x4*)(h + oo); const f32x4 tv = hv * ALPHA_F + acc[ai][bj][m][n]; *(f16x4*)(t + oo) = (f16x4){(_Float16)tv[0], (_Float16)tv[1], (_Float16)tv[2], (_Float16)tv[3]}; } }
    }
};
struct EpiPle {
    static constexpr bool PERM = false;
    const float* h; const bf16* pl; _Float16* t;
    __device__ __forceinline__ void operator()(const f32x4 (&acc)[2][2][4][2], const Unit& u, int wr, int wc, int fr, int fq) const {
#pragma unroll
        for (int ai = 0; ai < 2; ++ai)
#pragma unroll
            for (int m = 0; m < 4; ++m) { const size_t o = (size_t)EPI_ROWS(u, ai, m) * D_MODEL + u.col0 + wc * 32 + 4 * fq;
#pragma unroll
                for (int bj = 0; bj < 2; ++bj)
#pragma unroll
                    for (int n = 0; n < 2; ++n) { const size_t oo = o + bj * HALF + n * 16; const f32x4 hv = *(const f32x4*)(h + oo); const u32x2 pv = *(const u32x2*)(pl + oo);
                        const f32x4 a = acc[ai][bj][m][n]; f32x4 r;
                        r[0] = fmaf(hv[0], ALPHA_F, bflo(pv.x) * __builtin_amdgcn_rcpf(1.f + __builtin_amdgcn_exp2f(a[0] * -1.4426950408889634f))); r[1] = fmaf(hv[1], ALPHA_F, bfhi(pv.x) * __builtin_amdgcn_rcpf(1.f + __builtin_amdgcn_exp2f(a[1] * -1.4426950408889634f)));
                        r[2] = fmaf(hv[2], ALPHA_F, bflo(pv.y) * __builtin_amdgcn_rcpf(1.f + __builtin_amdgcn_exp2f(a[2] * -1.4426950408889634f))); r[3] = fmaf(hv[3], ALPHA_F, bfhi(pv.y) * __builtin_amdgcn_rcpf(1.f + __builtin_amdgcn_exp2f(a[3] * -1.4426950408889634f)));
                        *(f16x4*)(t + oo) = (f16x4){(_Float16)r[0], (_Float16)r[1], (_Float16)r[2], (_Float16)r[3]}; } }
    }
};
struct EpiSwiglu {
    static constexpr bool PERM = true;
    bf16* act;
    __device__ __forceinline__ void operator()(const f32x4 (&acc)[2][2][4][2], const Unit& u, int wr, int wc, int fr, int fq) const {
#pragma unroll
        for (int ai = 0; ai < 2; ++ai)
#pragma unroll
            for (int m = 0; m < 4; ++m) { const int row = EPI_ROWS(u, ai, m); float r[8];
#pragma unroll
                for (int n = 0; n < 2; ++n)
#pragma unroll
                    for (int j = 0; j < 4; ++j) { const float g = acc[ai][0][m][n][j], uu = acc[ai][1][m][n][j]; r[n * 4 + j] = g * __builtin_amdgcn_rcpf(1.f + __builtin_amdgcn_exp2f(g * -1.4426950408889634f)) * uu; }
                u32x4 w; w.x = cvt_pk_bf16(r[0], r[1]); w.y = cvt_pk_bf16(r[2], r[3]); w.z = cvt_pk_bf16(r[4], r[5]); w.w = cvt_pk_bf16(r[6], r[7]);
                *(u32x4*)(act + (size_t)row * D_EXPERT + u.col0 * 128 + wc * 32 + 8 * fq) = w; }
    }
};
struct EpiMoeDown {
    static constexpr bool PERM = true;
    bf16* Y;
    __device__ __forceinline__ void operator()(const f32x4 (&acc)[2][2][4][2], const Unit& u, int wr, int wc, int fr, int fq) const {
#pragma unroll
        for (int ai = 0; ai < 2; ++ai)
#pragma unroll
            for (int m = 0; m < 4; ++m) { const int row = EPI_ROWS(u, ai, m); bf16* rowp = Y + (size_t)row * D_MODEL + u.col0 * 256 + wc * 32 + 8 * fq;
#pragma unroll
                for (int bj = 0; bj < 2; ++bj) { const f32x4 v0 = acc[ai][bj][m][0], v1 = acc[ai][bj][m][1];
                    u32x4 w; w.x = cvt_pk_bf16(v0[0], v0[1]); w.y = cvt_pk_bf16(v0[2], v0[3]); w.z = cvt_pk_bf16(v1[0], v1[1]); w.w = cvt_pk_bf16(v1[2], v1[3]);
                    *(u32x4*)(rowp + bj * HALF) = w; } }
    }
};
}

struct Params { const float* in[18]; float* out; unsigned char* ws; int ph_lo, ph_hi, bar_idx, pad; };
typedef const Params __attribute__((address_space(4)))* KP;
__device__ __forceinline__ KP fresh_params() { KP p = (KP)__builtin_amdgcn_kernarg_segment_ptr(); asm volatile("" : "+s"(p)); return p; }

__device__ __forceinline__ void tr_item(const float* W, int K, int N, bf16* WT, int row_off, LAS float* scr, int kb, int nb, int lane) {
    const int k0 = 64 * kb, n0 = 32 * nb;
    const bool ok = (n0 + (lane & 31)) < N;
    if (n0 + 32 <= N) {
        const int kr = lane >> 3, c4 = (lane & 7) * 4;
#pragma unroll
        for (int i = 0; i < 8; ++i) { const int kk = 8 * i + kr; const f32x4 v = *(const f32x4*)(W + (size_t)(k0 + kk) * N + n0 + c4);
            LAS float* d = scr + kk * 33 + c4; d[0] = v[0]; d[1] = v[1]; d[2] = v[2]; d[3] = v[3]; }
    } else {
#pragma unroll 8
        for (int i = 0; i < 32; ++i) { const int kk = 2 * i + (lane >> 5); scr[kk * 33 + (lane & 31)] = ok ? W[(size_t)(k0 + kk) * N + n0 + (lane & 31)] : 0.f; }
    }
    asm volatile("s_waitcnt lgkmcnt(0)" ::: "memory");
    const int c = lane & 7;
#pragma unroll
    for (int j = 0; j < 4; ++j) { const int n = (lane >> 3) + 8 * j; const LAS float* s = scr + (8 * c) * 33 + n;
        u32x4 o; o.x = cvt_pk_bf16(s[0 * 33], s[1 * 33]); o.y = cvt_pk_bf16(s[2 * 33], s[3 * 33]); o.z = cvt_pk_bf16(s[4 * 33], s[5 * 33]); o.w = cvt_pk_bf16(s[6 * 33], s[7 * 33]);
        *(u32x4*)(WT + (size_t)(row_off + n0 + n) * K + k0 + 8 * c) = o; }
    asm volatile("s_waitcnt lgkmcnt(0)" ::: "memory");
}
__device__ __forceinline__ void cvt_rows(const float* src, bf16* dst, size_t n4, int gtid, int gthreads) {
    size_t i = gtid;
    for (; i + 3 * (size_t)gthreads < n4; i += 4 * (size_t)gthreads) {
        f32x4 v[4];
#pragma unroll
        for (int u = 0; u < 4; ++u) v[u] = *(const f32x4*)(src + (i + u * (size_t)gthreads) * 4);
#pragma unroll
        for (int u = 0; u < 4; ++u) { u32x2 o; o.x = cvt_pk_bf16(v[u][0], v[u][1]); o.y = cvt_pk_bf16(v[u][2], v[u][3]); *(u32x2*)(dst + (i + u * (size_t)gthreads) * 4) = o; }
    }
    for (; i < n4; i += gthreads) { const f32x4 v = *(const f32x4*)(src + i * 4); u32x2 o; o.x = cvt_pk_bf16(v[0], v[1]); o.y = cvt_pk_bf16(v[2], v[3]); *(u32x2*)(dst + i * 4) = o; }
}
__device__ __forceinline__ void phase_convert(KP P, int L, LAS unsigned char* lds) {
    int tz = threadIdx.x; asm volatile("" : "+v"(tz));
    const int tid = tz, lane = tid & 63, wave = tid >> 6;
    LAS float* scr = (LAS float*)(lds + wave * 17408);
    const int gw = blockIdx.x * NWAVES + wave, NGW = gridDim.x * NWAVES;
    unsigned char* ws = P->ws;
    bf16* wmix = (bf16*)(ws + WS_WMIX); bf16* wo_t = (bf16*)(ws + WS_WMIX + 4 * MiB); bf16* wkv_t = (bf16*)(ws + WS_WMIX + 6 * MiB);
    bf16* wpg_t = (bf16*)(ws + WS_WPG); bf16* wple_t = (bf16*)(ws + WS_WPLE); bf16* wgu_t = (bf16*)(ws + WS_WGU); bf16* wd_t = (bf16*)(ws + WS_WD);
    const bool isA = L < N_A; const int j = L - N_A;
    const float* w_first = isA ? P->in[2] + (size_t)L * D_MODEL * A_COLS : P->in[5] + (size_t)j * D_MODEL * D_MODEL;
    const int n_first = isA ? A_COLS : D_MODEL, nb_first = isA ? 64 : 32;
    const float* w_o = isA ? P->in[3] + (size_t)L * D_MODEL * D_MODEL : P->in[6] + (size_t)j * D_MODEL * D_MODEL;
    const int I_FIRST = 16 * nb_first, I_O = 16 * 32, I_KV = (L == N_A) ? 16 * 16 : 0, I_PG = 16 * 32, I_PLE = 4 * 32, I_G = 32 * 256, I_U = 32 * 256, I_D = 32 * 256;
    const int NITEMS = I_FIRST + I_O + I_KV + I_PG + I_PLE + I_G + I_U + I_D;
    const size_t wsz = (size_t)D_MODEL * D_EXPERT;
#define CV_DECODE(IT, W_, K_, N_, WT_, RO_, KB_, NB_) do { int r = (IT); \
        if (r < I_FIRST) { W_ = w_first; K_ = D_MODEL; N_ = n_first; WT_ = wmix; RO_ = 0; KB_ = r / nb_first; NB_ = r % nb_first; break; } r -= I_FIRST; \
        if (r < I_O) { W_ = w_o; K_ = D_MODEL; N_ = D_MODEL; WT_ = wo_t; RO_ = 0; KB_ = r / 32; NB_ = r % 32; break; } r -= I_O; \
        if (r < I_KV) { W_ = P->in[4]; K_ = D_MODEL; N_ = 512; WT_ = wkv_t; RO_ = 0; KB_ = r / 16; NB_ = r % 16; break; } r -= I_KV; \
        if (r < I_PG) { W_ = P->in[15] + (size_t)L * D_MODEL * D_MODEL; K_ = D_MODEL; N_ = D_MODEL; WT_ = wpg_t; RO_ = 0; KB_ = r / 32; NB_ = r % 32; break; } r -= I_PG; \
        if (r < I_PLE) { W_ = P->in[14] + (size_t)L * PLE_DIM * D_MODEL; K_ = PLE_DIM; N_ = D_MODEL; WT_ = wple_t; RO_ = 0; KB_ = r / 32; NB_ = r % 32; break; } r -= I_PLE; \
        if (r < I_G + I_U) { const bool up = r >= I_G; if (up) r -= I_G; const int e = r >> 8, rem = r & 255, n0 = (rem & 15) * 32; \
            W_ = (up ? P->in[12] : P->in[11]) + ((size_t)L * N_EXPERTS + e) * wsz; K_ = D_MODEL; N_ = D_EXPERT; WT_ = wgu_t + (size_t)e * D_MODEL * D_MODEL; \
            RO_ = (n0 >> 7) * 256 + (up ? 128 : 0) + (n0 & 127) - n0; KB_ = rem >> 4; NB_ = rem & 15; break; } \
        r -= I_G + I_U; { const int e = r >> 8, rem = r & 255; W_ = P->in[13] + ((size_t)L * N_EXPERTS + e) * wsz; K_ = D_EXPERT; N_ = D_MODEL; WT_ = wd_t + (size_t)e * wsz; RO_ = 0; KB_ = rem >> 5; NB_ = rem & 31; } } while (0)
    LAS float* scr2 = scr + 64 * 33;
    for (int it = gw; it < NITEMS; it += 2 * NGW) {
        const float* W0; int K0, N0, RO0, KB0, NB0; bf16* WT0; CV_DECODE(it, W0, K0, N0, WT0, RO0, KB0, NB0);
        const int it1 = it + NGW;
        if (it1 >= NITEMS) { tr_item(W0, K0, N0, WT0, RO0, scr, KB0, NB0, lane); continue; }
        const float* W1; int K1, N1, RO1, KB1, NB1; bf16* WT1; CV_DECODE(it1, W1, K1, N1, WT1, RO1, KB1, NB1);
        if (NB0 * 32 + 32 > N0 || NB1 * 32 + 32 > N1) { tr_item(W0, K0, N0, WT0, RO0, scr, KB0, NB0, lane); tr_item(W1, K1, N1, WT1, RO1, scr, KB1, NB1, lane); continue; }
        const int kr = lane >> 3, c4 = (lane & 7) * 4;
        f32x4 va[8], vb2[8];
#pragma unroll
        for (int i = 0; i < 8; ++i) { va[i] = *(const f32x4*)(W0 + (size_t)(64 * KB0 + 8 * i + kr) * N0 + 32 * NB0 + c4); vb2[i] = *(const f32x4*)(W1 + (size_t)(64 * KB1 + 8 * i + kr) * N1 + 32 * NB1 + c4); }
#pragma unroll
        for (int i = 0; i < 8; ++i) { LAS float* d = scr + (8 * i + kr) * 33 + c4; d[0] = va[i][0]; d[1] = va[i][1]; d[2] = va[i][2]; d[3] = va[i][3];
            LAS float* d2 = scr2 + (8 * i + kr) * 33 + c4; d2[0] = vb2[i][0]; d2[1] = vb2[i][1]; d2[2] = vb2[i][2]; d2[3] = vb2[i][3]; }
        asm volatile("s_waitcnt lgkmcnt(0)" ::: "memory");
        { const int c = lane & 7;
#pragma unroll
          for (int jj = 0; jj < 4; ++jj) { const int n = (lane >> 3) + 8 * jj; const LAS float* s0 = scr + (8 * c) * 33 + n; const LAS float* s1 = scr2 + (8 * c) * 33 + n;
              u32x4 o0, o1; o0.x = cvt_pk_bf16(s0[0 * 33], s0[1 * 33]); o0.y = cvt_pk_bf16(s0[2 * 33], s0[3 * 33]); o0.z = cvt_pk_bf16(s0[4 * 33], s0[5 * 33]); o0.w = cvt_pk_bf16(s0[6 * 33], s0[7 * 33]);
              o1.x = cvt_pk_bf16(s1[0 * 33], s1[1 * 33]); o1.y = cvt_pk_bf16(s1[2 * 33], s1[3 * 33]); o1.z = cvt_pk_bf16(s1[4 * 33], s1[5 * 33]); o1.w = cvt_pk_bf16(s1[6 * 33], s1[7 * 33]);
              *(u32x4*)(WT0 + (size_t)(RO0 + 32 * NB0 + n) * K0 + 64 * KB0 + 8 * c) = o0; *(u32x4*)(WT1 + (size_t)(RO1 + 32 * NB1 + n) * K1 + 64 * KB1 + 8 * c) = o1; } }
        asm volatile("s_waitcnt lgkmcnt(0)" ::: "memory");
    }
#undef CV_DECODE
    const int gtid = blockIdx.x * 512 + tid, gthreads = gridDim.x * 512;
    { const float* wrg = P->in[7] + (size_t)L * D_MODEL * N_GROUPS; const float* wre = P->in[9] + (size_t)L * D_MODEL * N_EXPERTS; float* wrt = (float*)(ws + WS_WPLE + 1 * MiB);
      for (int i = gtid; i < D_MODEL * 36; i += gthreads) { const int c = i >> 10, k = i & 1023; wrt[i] = (c < 4) ? wrg[k * 4 + c] : wre[k * 32 + (c - 4)]; } }
    cvt_rows(P->in[1] + (size_t)L * NTOK * PLE_DIM, (bf16*)(ws + WS_PB), (size_t)NTOK * PLE_DIM / 4, gtid, gthreads);
    if (L == 0) cvt_rows(P->in[0], (bf16*)(ws + WS_HB), (size_t)NTOK * D_MODEL / 4, gtid, gthreads);
}

template <int SRC, bool ROUTER>
__device__ __forceinline__ void phase_ln(KP P, int L, int which, LAS unsigned char* lds, float* dst_f32, bool write_hb, int cidx = -1) {
    int tz = threadIdx.x; asm volatile("" : "+v"(tz)); const int tid = tz, lane = tid & 63, wave = tid >> 6;
    unsigned char* ws = P->ws;
    const _Float16* t = (const _Float16*)(ws + WS_T); const float* h = (const float*)(ws + WS_H); bf16* hb = (bf16*)(ws + WS_HB);
    const bf16* Y = (const bf16*)(ws + WS_Y);
    const int* moe = (const int*)(ws + WS_MOE);
    const float* g = P->in[16] + (size_t)(L * 3 + which) * D_MODEL; const float* bt = P->in[17] + (size_t)(L * 3 + which) * D_MODEL;
    f32x4 gv[4], bv[4];
#pragma unroll
    for (int j = 0; j < 4; ++j) { gv[j] = *(const f32x4*)(g + 4 * lane + 256 * j); bv[j] = *(const f32x4*)(bt + 4 * lane + 256 * j); }
    const int gw = blockIdx.x * NWAVES + wave, NGW = gridDim.x * NWAVES;
    for (int pi = gw; pi < NTOK / 2; pi += NGW) {
        const int row0 = pi * 2;
        f32x4 v[2][4];
        if (SRC == 0) {
            f16x4 tv[2][4];
#pragma unroll
            for (int u = 0; u < 2; ++u)
#pragma unroll
                for (int j = 0; j < 4; ++j) tv[u][j] = *(const f16x4*)(t + (size_t)(row0 + u) * D_MODEL + 4 * lane + 256 * j);
#pragma unroll
            for (int u = 0; u < 2; ++u)
#pragma unroll
                for (int j = 0; j < 4; ++j) v[u][j] = (f32x4){(float)tv[u][j][0], (float)tv[u][j][1], (float)tv[u][j][2], (float)tv[u][j][3]};
        } else {
            int sl[2][2]; float wq[2][2]; f32x4 hv[2][4]; u32x2 y0[2][4], y1[2][4];
#pragma unroll
            for (int u = 0; u < 2; ++u) { sl[u][0] = moe[MO_TOK_SLOT + (row0 + u) * 2]; sl[u][1] = moe[MO_TOK_SLOT + (row0 + u) * 2 + 1];
                wq[u][0] = ((const float*)moe)[MO_TOK_W + (row0 + u) * 2]; wq[u][1] = ((const float*)moe)[MO_TOK_W + (row0 + u) * 2 + 1];
#pragma unroll
                for (int j = 0; j < 4; ++j) hv[u][j] = *(const f32x4*)(h + (size_t)(row0 + u) * D_MODEL + 4 * lane + 256 * j); }
#pragma unroll
            for (int u = 0; u < 2; ++u)
#pragma unroll
                for (int j = 0; j < 4; ++j) { y0[u][j] = *(const u32x2*)(Y + (size_t)sl[u][0] * D_MODEL + 4 * lane + 256 * j); y1[u][j] = *(const u32x2*)(Y + (size_t)sl[u][1] * D_MODEL + 4 * lane + 256 * j); }
#pragma unroll
            for (int u = 0; u < 2; ++u)
#pragma unroll
                for (int j = 0; j < 4; ++j) { const float w0 = wq[u][0], w1 = wq[u][1];
                    v[u][j][0] = hv[u][j][0] * ALPHA_F + (w0 * bflo(y0[u][j].x) + w1 * bflo(y1[u][j].x)); v[u][j][1] = hv[u][j][1] * ALPHA_F + (w0 * bfhi(y0[u][j].x) + w1 * bfhi(y1[u][j].x));
                    v[u][j][2] = hv[u][j][2] * ALPHA_F + (w0 * bflo(y0[u][j].y) + w1 * bflo(y1[u][j].y)); v[u][j][3] = hv[u][j][3] * ALPHA_F + (w0 * bfhi(y0[u][j].y) + w1 * bfhi(y1[u][j].y)); }
        }
#pragma unroll
        for (int u = 0; u < 2; ++u) {
            const int row = row0 + u;
            float s = 0.f;
#pragma unroll
            for (int j = 0; j < 4; ++j) s += (v[u][j][0] + v[u][j][1]) + (v[u][j][2] + v[u][j][3]);
            const float mean = wave_sum(s) * (1.f / D_MODEL);
            float q = 0.f;
#pragma unroll
            for (int j = 0; j < 4; ++j) { v[u][j] = v[u][j] - mean; q += (v[u][j][0] * v[u][j][0] + v[u][j][1] * v[u][j][1]) + (v[u][j][2] * v[u][j][2] + v[u][j][3] * v[u][j][3]); }
            const float rstd = rsqrtf(wave_sum(q) * (1.f / D_MODEL) + LN_EPS);
#pragma unroll
            for (int j = 0; j < 4; ++j) { v[u][j] = v[u][j] * rstd * gv[j] + bv[j]; *(f32x4*)(dst_f32 + (size_t)row * D_MODEL + 4 * lane + 256 * j) = v[u][j]; }
            if (write_hb) {
#pragma unroll
                for (int j = 0; j < 4; ++j) { u32x2 o; o.x = cvt_pk_bf16(v[u][j][0], v[u][j][1]); o.y = cvt_pk_bf16(v[u][j][2], v[u][j][3]); *(u32x2*)(hb + (size_t)row * D_MODEL + 4 * lane + 256 * j) = o; }
            }
        }
    }
    (void)lds; (void)cidx;
}

__device__ __forceinline__ void phase_ln_router(KP P, int L, LAS unsigned char* lds, int cidx) {
    int tz = threadIdx.x; asm volatile("" : "+v"(tz)); const int tid = tz, lane = tid & 63, wave = tid >> 6;
    unsigned char* ws = P->ws;
    const _Float16* t = (const _Float16*)(ws + WS_T); float* h = (float*)(ws + WS_H); bf16* hb = (bf16*)(ws + WS_HB);
    int* moe = (int*)(ws + WS_MOE);
    const float* g = P->in[16] + (size_t)(L * 3) * D_MODEL; const float* bt = P->in[17] + (size_t)(L * 3) * D_MODEL;
    LAS float* Wl = (LAS float*)lds;
    LAS float* lgs = (LAS float*)(lds + 147456) + wave * 80;
    LAS int* lcnt = (LAS int*)(lds + 150016);
    LAS int* rinfo = (LAS int*)(lds + 150272);
    { const f32x4* wrt = (const f32x4*)(ws + WS_WPLE + 1 * MiB);
      for (int i = tid; i < D_MODEL * 36 / 4; i += 512) ((LAS f32x4*)Wl)[i] = wrt[i];
      if (tid < 64) lcnt[tid] = 0; }
    __syncthreads();
    f32x4 gv[4], bv[4];
#pragma unroll
    for (int j = 0; j < 4; ++j) { gv[j] = *(const f32x4*)(g + 4 * lane + 256 * j); bv[j] = *(const f32x4*)(bt + 4 * lane + 256 * j); }
    const float* brg = P->in[8] + L * N_GROUPS; const float* bre = P->in[10] + L * N_EXPERTS;
    const int gw = blockIdx.x * NWAVES + wave, NGW = gridDim.x * NWAVES;
    int it = 0;
    for (int pi = gw; pi < NTOK / 2; pi += NGW, ++it) {
        const int row0 = pi * 2;
        f32x4 va[4], vb[4];
#pragma unroll
        for (int j = 0; j < 4; ++j) { const f16x4 ta = *(const f16x4*)(t + (size_t)row0 * D_MODEL + 4 * lane + 256 * j), tb2 = *(const f16x4*)(t + (size_t)(row0 + 1) * D_MODEL + 4 * lane + 256 * j);
            va[j] = (f32x4){(float)ta[0], (float)ta[1], (float)ta[2], (float)ta[3]}; vb[j] = (f32x4){(float)tb2[0], (float)tb2[1], (float)tb2[2], (float)tb2[3]}; }
        float sa = 0.f, sb = 0.f;
#pragma unroll
        for (int j = 0; j < 4; ++j) { sa += (va[j][0] + va[j][1]) + (va[j][2] + va[j][3]); sb += (vb[j][0] + vb[j][1]) + (vb[j][2] + vb[j][3]); }
        const float ma = wave_sum(sa) * (1.f / D_MODEL), mb_ = wave_sum(sb) * (1.f / D_MODEL);
        float qa = 0.f, qb = 0.f;
#pragma unroll
        for (int j = 0; j < 4; ++j) { va[j] = va[j] - ma; vb[j] = vb[j] - mb_;
            qa += (va[j][0] * va[j][0] + va[j][1] * va[j][1]) + (va[j][2] * va[j][2] + va[j][3] * va[j][3]);
            qb += (vb[j][0] * vb[j][0] + vb[j][1] * vb[j][1]) + (vb[j][2] * vb[j][2] + vb[j][3] * vb[j][3]); }
        const float ra = rsqrtf(wave_sum(qa) * (1.f / D_MODEL) + LN_EPS), rb = rsqrtf(wave_sum(qb) * (1.f / D_MODEL) + LN_EPS);
#pragma unroll
        for (int j = 0; j < 4; ++j) { va[j] = va[j] * ra * gv[j] + bv[j]; vb[j] = vb[j] * rb * gv[j] + bv[j];
            *(f32x4*)(h + (size_t)row0 * D_MODEL + 4 * lane + 256 * j) = va[j]; *(f32x4*)(h + (size_t)(row0 + 1) * D_MODEL + 4 * lane + 256 * j) = vb[j];
            u32x2 oa, ob; oa.x = cvt_pk_bf16(va[j][0], va[j][1]); oa.y = cvt_pk_bf16(va[j][2], va[j][3]); ob.x = cvt_pk_bf16(vb[j][0], vb[j][1]); ob.y = cvt_pk_bf16(vb[j][2], vb[j][3]);
            *(u32x2*)(hb + (size_t)row0 * D_MODEL + 4 * lane + 256 * j) = oa; *(u32x2*)(hb + (size_t)(row0 + 1) * D_MODEL + 4 * lane + 256 * j) = ob; }
#pragma unroll
        for (int p = 0; p < 18; ++p) {
            f32x2 a0 = {0.f, 0.f}, a1 = {0.f, 0.f};
#pragma unroll
            for (int j = 0; j < 4; ++j) { const f32x4 w0 = *(const LAS f32x4*)(Wl + (2 * p) * D_MODEL + 4 * lane + 256 * j), w1 = *(const LAS f32x4*)(Wl + (2 * p + 1) * D_MODEL + 4 * lane + 256 * j);
#pragma unroll
                for (int i = 0; i < 4; ++i) { const f32x2 y = {va[j][i], vb[j][i]}; a0 = a0 + y * w0[i]; a1 = a1 + y * w1[i]; } }
            float ra2[2];
#pragma unroll
            for (int rr = 0; rr < 2; ++rr) {
                auto sw = __builtin_amdgcn_permlane32_swap(__float_as_uint(rr ? a0.y : a0.x), __float_as_uint(rr ? a1.y : a1.x), false, false);
                float v = __uint_as_float(sw[0]) + __uint_as_float(sw[1]);
                v = row16_sum(v); v += __shfl_xor(v, 16); ra2[rr] = v; }
            if ((lane & 31) == 0) { const int ci = 2 * p + (lane >> 5); lgs[ci] = ra2[0]; lgs[40 + ci] = ra2[1]; }
            __builtin_amdgcn_sched_barrier(0);
        }
        asm volatile("s_waitcnt lgkmcnt(0)" ::: "memory");
        if (lane == 0 || lane == 32) {
            const int rr = lane >> 5; LAS float* lg = lgs + rr * 40;
            float gl[4];
#pragma unroll
            for (int jj = 0; jj < 4; ++jj) gl[jj] = lg[jj] + brg[jj];
            int gs = 0; float gmax = gl[0];
#pragma unroll
            for (int jj = 1; jj < 4; ++jj) if (gl[jj] > gmax) { gmax = gl[jj]; gs = jj; }
            float den = 0.f;
#pragma unroll
            for (int jj = 0; jj < 4; ++jj) den += expf(gl[jj] - gmax);
            const float gwt = 1.f / den;
            float el[8];
#pragma unroll
            for (int jj = 0; jj < 8; ++jj) el[jj] = lg[4 + gs * 8 + jj] + bre[gs * 8 + jj];
            int i0 = 0; float v0 = el[0];
#pragma unroll
            for (int jj = 1; jj < 8; ++jj) if (el[jj] > v0) { v0 = el[jj]; i0 = jj; }
            int i1 = -1; float v1 = 0.f;
#pragma unroll
            for (int jj = 0; jj < 8; ++jj) if (jj != i0 && (i1 < 0 || el[jj] > v1)) { v1 = el[jj]; i1 = jj; }
            const float e1 = expf(v1 - v0);
            const float w0 = gwt / (1.f + e1), w1 = gwt * e1 / (1.f + e1);
            const int ea = gs * 8 + i0, eb = gs * 8 + i1;
            const int pa = __hip_atomic_fetch_add(lcnt + ea, 1, __ATOMIC_RELAXED, __HIP_MEMORY_SCOPE_WORKGROUP), pb2 = __hip_atomic_fetch_add(lcnt + eb, 1, __ATOMIC_RELAXED, __HIP_MEMORY_SCOPE_WORKGROUP);
            LAS int* ri = rinfo + ((it * NWAVES + wave) * 2 + rr) * 5;
            ri[0] = ea | (eb << 8); ri[1] = pa; ri[2] = pb2; ri[3] = __float_as_int(w0); ri[4] = __float_as_int(w1);
        }
    }
    __syncthreads();
    if (tid < 32) { const int n = lcnt[tid]; unsigned* cnt = (unsigned*)(ws + WS_CTL) + CW_CNT + cidx * 32; lcnt[32 + tid] = n ? (int)atomicAdd(&cnt[tid], (unsigned)n) : 0; }
    __syncthreads();
    for (int sl = tid; sl < it * NWAVES * 2; sl += 512) {
        const int i2 = sl / (NWAVES * 2), w2 = (sl >> 1) & (NWAVES - 1), rr = sl & 1;
        const int row = ((blockIdx.x * NWAVES + w2) + i2 * NGW) * 2 + rr;
        if (row < NTOK) { const LAS int* ri = rinfo + sl * 5; const int ea = ri[0] & 255, eb = ri[0] >> 8;
            moe[MO_TOK_E + row * 2] = ea; moe[MO_TOK_E + row * 2 + 1] = eb; moe[MO_TOK_POS + row * 2] = lcnt[32 + ea] + ri[1]; moe[MO_TOK_POS + row * 2 + 1] = lcnt[32 + eb] + ri[2];
            moe[MO_TOK_W + row * 2] = ri[3]; moe[MO_TOK_W + row * 2 + 1] = ri[4]; }
    }
}

__device__ __forceinline__ void phase_moe_prep(KP P, int L, LAS unsigned char* lds) {
    int tz = threadIdx.x; asm volatile("" : "+v"(tz));
    const int tid = tz;
    unsigned char* ws = P->ws; int* moe = (int*)(ws + WS_MOE);
    const unsigned* cnt = (const unsigned*)(ws + WS_CTL) + CW_CNT + L * 32;
    LAS int* sb = (LAS int*)lds;
    LAS int* sc = (LAS int*)lds + 64;
    if (tid < 32) sc[tid] = (int)cnt[tid];
    __syncthreads();
    if (tid == 0) { int s = 0; for (int e = 0; e < N_EXPERTS; ++e) { sb[e] = s; s += (sc[e] + 255) / 256 * 256; } sb[N_EXPERTS] = s; }
    __syncthreads();
    const int ntiles = sb[N_EXPERTS] / 256;
    if (blockIdx.x == 0) {
        if (tid == 0) *((unsigned*)(ws + WS_CTL) + CW_NTILES + L) = (unsigned)ntiles;
        for (int T = tid; T < ntiles; T += 512) {
            const int r = T * 256; int e = 0;
            for (int x = 0; x < N_EXPERTS; ++x) if (r >= sb[x] && r < sb[x + 1]) e = x;
            const int nv = sc[e] - (r - sb[e]);
            moe[MO_TILE_E + T] = e; moe[MO_TILE_ROW0 + T] = r; moe[MO_TILE_NV + T] = nv < 256 ? nv : 256;
        }
    }
    for (int a = blockIdx.x * 512 + tid; a < NTOK * 2; a += gridDim.x * 512) {
        const int slot = sb[moe[MO_TOK_E + a]] + moe[MO_TOK_POS + a];
        moe[MO_SLOT_TOK + slot] = a >> 1; moe[MO_TOK_SLOT + a] = slot;
    }
}


namespace mb {
typedef short s16x4 __attribute__((ext_vector_type(4)));
typedef float f32x16 __attribute__((ext_vector_type(16)));
constexpr int SHM_V = 64 * 128 * 2, SHM_K = 64 * 128 * 2, V_OFF = 0, K_OFF = 2 * SHM_V, PRE_OFF = 65536;
constexpr float SCALE = 0.08838834764831845f, LOG2E = 1.4426950408889634f, CC = SCALE * LOG2E, THRX = 8.f * LOG2E;
#define MB_KSWZ(row, colB) ((row) * 256 + ((colB) ^ (((row) & 7) << 4)))
__device__ __forceinline__ int v_st(int k, int c) { const int kk = (k & ~0xC) | ((k & 4) << 1) | ((k & 8) >> 1); return ((kk >> 3) * 4 + (c >> 5)) * 512 + ((kk & 7) * 32 + (c & 31)) * 2; }
__device__ __forceinline__ int v_rd_base(int lane) { return ((lane & 3) << 3) | (((lane >> 2) & 3) << 6) | (((lane >> 4) & 1) << 5) | (((lane >> 5) & 1) << 8); }
constexpr int v_rd_off(int d0, int ks, int half) { return d0 * 512 + ks * 4096 + half * 2048; }
template <int OFF> __device__ __forceinline__ s16x4 tr_read(int vb) { s16x4 r; asm volatile("ds_read_b64_tr_b16 %0, %1 offset:%2" : "=&v"(r) : "v"(vb), "i"(OFF) : "memory"); return r; }
#define MB_SBAR() __builtin_amdgcn_sched_barrier(0)

__device__ __forceinline__ void qkt(f32x16& p0, f32x16& p1, LAS unsigned char* Ks, const bf16x8 (&qr)[8], int r32, int hi) {
    p0 = f32x16{}; p1 = f32x16{};
#pragma unroll
    for (int d0 = 0; d0 < 8; ++d0) { const int cb = (d0 * 16 + hi * 8) * 2;
        const bf16x8 b0 = *(const LAS bf16x8*)(Ks + MB_KSWZ(r32, cb));
        const bf16x8 b1 = *(const LAS bf16x8*)(Ks + MB_KSWZ(32 + r32, cb));
        p0 = __builtin_amdgcn_mfma_f32_32x32x16_bf16(b0, qr[d0], p0, 0, 0, 0);
        p1 = __builtin_amdgcn_mfma_f32_32x32x16_bf16(b1, qr[d0], p1, 0, 0, 0); }
}
__device__ __forceinline__ void partialSM(f32x16& p0, f32x16& p1, float& m_reg, float& mn, float& alpha, float bias2, float tb4, bool own, int lim) {
#pragma unroll
    for (int r = 0; r < 16; ++r) { const float kc = (float)((r & 3) + 8 * (r >> 2));
        p0[r] = fmaf(p0[r], CC, fmaf(bias2, kc, tb4)); p1[r] = fmaf(p1[r], CC, fmaf(bias2, kc + 32.f, tb4)); }
    if (own) {
#pragma unroll
        for (int r = 0; r < 16; ++r) { const int kc = (r & 3) + 8 * (r >> 2); if (kc > lim) p0[r] = -INFINITY; if (kc + 32 > lim) p1[r] = -INFINITY; }
    }
    float pmax = p0[0];
#pragma unroll
    for (int r = 1; r < 16; ++r) pmax = fmaxf(pmax, p0[r]);
#pragma unroll
    for (int r = 0; r < 16; ++r) pmax = fmaxf(pmax, p1[r]);
    { auto rr = __builtin_amdgcn_permlane32_swap(__float_as_uint(pmax), __float_as_uint(pmax), false, false); pmax = fmaxf(__uint_as_float(rr[0]), __uint_as_float(rr[1])); }
    if (__builtin_expect(__all(pmax - m_reg <= THRX), 1)) { mn = m_reg; alpha = 1.f; }
    else { mn = fmaxf(m_reg, pmax); alpha = __builtin_amdgcn_exp2f(m_reg - mn); m_reg = mn; }
#pragma unroll
    for (int r = 0; r < 16; ++r) { p0[r] = p0[r] - mn; p1[r] = p1[r] - mn; }
#pragma unroll
    for (int r = 0; r < 16; ++r) p0[r] = __builtin_amdgcn_exp2f(p0[r]);
}
__device__ __forceinline__ void finishSM(f32x16& p0, f32x16& p1, float alpha, float& l_reg, bf16x8& pa0, bf16x8& pa1, bf16x8& pa2, bf16x8& pa3) {
#pragma unroll
    for (int r = 0; r < 16; ++r) p1[r] = __builtin_amdgcn_exp2f(p1[r]);
    float ps = 0.f;
#pragma unroll
    for (int r = 0; r < 16; ++r) ps += p0[r];
#pragma unroll
    for (int r = 0; r < 16; ++r) ps += p1[r];
    { auto rr = __builtin_amdgcn_permlane32_swap(__float_as_uint(ps), __float_as_uint(ps), false, false); ps = __uint_as_float(rr[0]) + __uint_as_float(rr[1]); }
    l_reg = l_reg * alpha + ps;
#define MB_PK4(P, BASE, OUT) do { unsigned a0 = cvt_pk_bf16(P[BASE + 0], P[BASE + 1]), a1 = cvt_pk_bf16(P[BASE + 2], P[BASE + 3]); \
    unsigned b0 = cvt_pk_bf16(P[BASE + 4], P[BASE + 5]), b1 = cvt_pk_bf16(P[BASE + 6], P[BASE + 7]); \
    auto r0 = __builtin_amdgcn_permlane32_swap(a0, b0, false, false); auto r1 = __builtin_amdgcn_permlane32_swap(a1, b1, false, false); \
    u32x4 w = {r0[0], r1[0], r0[1], r1[1]}; OUT = *reinterpret_cast<bf16x8*>(&w); } while (0)
    MB_PK4(p0, 0, pa0); MB_PK4(p0, 8, pa1); MB_PK4(p1, 0, pa2); MB_PK4(p1, 8, pa3);
#undef MB_PK4
}
template <int D0> __device__ __forceinline__ void pv_one(f32x16& od, int vb, bf16x8 pa0, bf16x8 pa1, bf16x8 pa2, bf16x8 pa3) {
    const s16x4 l0 = tr_read<v_rd_off(D0, 0, 0)>(vb), h0 = tr_read<v_rd_off(D0, 0, 1)>(vb), l1 = tr_read<v_rd_off(D0, 1, 0)>(vb), h1 = tr_read<v_rd_off(D0, 1, 1)>(vb);
    const s16x4 l2 = tr_read<v_rd_off(D0, 2, 0)>(vb), h2 = tr_read<v_rd_off(D0, 2, 1)>(vb), l3 = tr_read<v_rd_off(D0, 3, 0)>(vb), h3 = tr_read<v_rd_off(D0, 3, 1)>(vb);
    asm volatile("s_waitcnt lgkmcnt(0)" ::: "memory"); MB_SBAR();
#define MB_PK(L, H) (bf16x8){L[0], L[1], L[2], L[3], H[0], H[1], H[2], H[3]}
    od = __builtin_amdgcn_mfma_f32_32x32x16_bf16(MB_PK(l0, h0), pa0, od, 0, 0, 0);
    od = __builtin_amdgcn_mfma_f32_32x32x16_bf16(MB_PK(l1, h1), pa1, od, 0, 0, 0);
    od = __builtin_amdgcn_mfma_f32_32x32x16_bf16(MB_PK(l2, h2), pa2, od, 0, 0, 0);
    od = __builtin_amdgcn_mfma_f32_32x32x16_bf16(MB_PK(l3, h3), pa3, od, 0, 0, 0);
#undef MB_PK
}
__device__ __forceinline__ void pv_d0(f32x16 (&o)[4], int vb, bf16x8 pa0, bf16x8 pa1, bf16x8 pa2, bf16x8 pa3) {
    pv_one<0>(o[0], vb, pa0, pa1, pa2, pa3); pv_one<1>(o[1], vb, pa0, pa1, pa2, pa3); pv_one<2>(o[2], vb, pa0, pa1, pa2, pa3); pv_one<3>(o[3], vb, pa0, pa1, pa2, pa3);
}

__device__ __forceinline__ void item(const bf16* __restrict__ q, const bf16* __restrict__ kv, bf16* __restrict__ part_o, float* __restrict__ part_ml, LAS unsigned char* lds,
                                     int tid, int b, int g, int kblk, int NT, bool own, int t, int rh, int slot, bool valid) {
    const int lane = tid & 63, r32 = lane & 31, hi = lane >> 5;
    const int h = g * 4 + rh;
    const bf16* Kh = kv + (size_t)(b * SEQ + kblk * MOBA_BLOCK) * 512 + g * HEAD_DIM;
    float m_reg = -1e30f, l_reg = 0.f; f32x16 o[4] = {}; bf16x8 qr[8];
    { const bf16* Qw = q + (size_t)(b * SEQ + t) * D_MODEL + h * HEAD_DIM + hi * 8;
#pragma unroll
      for (int d0 = 0; d0 < 8; ++d0) qr[d0] = *(const bf16x8*)(Qw + d0 * 16); }
    const float bias2 = __builtin_amdgcn_exp2f(-(float)(h + 1)) * LOG2E;
    const int trel = t - kblk * MOBA_BLOCK;
    const float tb4 = bias2 * (float)(4 * hi - trel);
    const int lim0 = trel - 4 * hi;
    const int sr = tid >> 4, sc = (tid & 15) * 8, vst0 = v_st(sr, sc), vst1 = v_st(32 + sr, sc);
    const int vb0 = (int)(unsigned)(uintptr_t)(lds + V_OFF) + v_rd_base(lane);
    bf16x8 vsA0, vsA1, ksA0, ksA1, vsB0, vsB1, ksB0, ksB1;
    const unsigned vo0 = (unsigned)(sr * 512 + sc) * 2u, vo1 = vo0 + 32u * 1024u;
    const char* KhB = (const char*)Kh;
#define MB_SLOAD_A(k0) do { const char* kt_ = KhB + (size_t)(k0) * 1024; vsA0 = *(const bf16x8*)(kt_ + 512 + vo0); vsA1 = *(const bf16x8*)(kt_ + 512 + vo1); \
        ksA0 = *(const bf16x8*)(kt_ + vo0); ksA1 = *(const bf16x8*)(kt_ + vo1); } while (0)
#define MB_SLOAD_B(k0) do { const char* kt_ = KhB + (size_t)(k0) * 1024; vsB0 = *(const bf16x8*)(kt_ + 512 + vo0); vsB1 = *(const bf16x8*)(kt_ + 512 + vo1); \
        ksB0 = *(const bf16x8*)(kt_ + vo0); ksB1 = *(const bf16x8*)(kt_ + vo1); } while (0)
#define MB_SWRITE(bb, V0, V1, K0, K1) do { *(LAS bf16x8*)(lds + V_OFF + (bb) * SHM_V + vst0) = V0; *(LAS bf16x8*)(lds + V_OFF + (bb) * SHM_V + vst1) = V1; \
        *(LAS bf16x8*)(lds + K_OFF + (bb) * SHM_K + MB_KSWZ(sr, sc * 2)) = K0; *(LAS bf16x8*)(lds + K_OFF + (bb) * SHM_K + MB_KSWZ(32 + sr, sc * 2)) = K1; } while (0)
#define MB_SWAIT() asm volatile("s_waitcnt vmcnt(4)" ::: "memory")
#define MB_RESC(a) do { if (__any((a) < 1.f)) { _Pragma("unroll") for (int d = 0; d < 4; ++d) _Pragma("unroll") for (int r = 0; r < 16; ++r) o[d][r] *= (a); } } while (0)
#define MB_PSM(P0, P1, MN, AL, tile) partialSM(P0, P1, m_reg, MN, AL, bias2, tb4 + bias2 * (float)((tile) * 64), own, lim0 - (tile) * 64)
    f32x16 pA0, pA1, pB0, pB1; float mnA, mnB, alA, alB; bf16x8 pa0, pa1, pa2, pa3;
    MB_SLOAD_A(0); asm volatile("s_waitcnt vmcnt(0)" ::: "memory"); MB_SWRITE(0, vsA0, vsA1, ksA0, ksA1); __syncthreads();
    qkt(pA0, pA1, lds + K_OFF, qr, r32, hi); MB_PSM(pA0, pA1, mnA, alA, 0);
    MB_SLOAD_B(64); if (2 < NT) MB_SLOAD_A(128);
    MB_SWAIT(); MB_SWRITE(1, vsB0, vsB1, ksB0, ksB1); __syncthreads();
    for (int j = 1; j + 1 < NT; j += 2) {
        MB_SBAR(); qkt(pB0, pB1, lds + K_OFF + SHM_K, qr, r32, hi);
        finishSM(pA0, pA1, alA, l_reg, pa0, pa1, pa2, pa3); MB_SBAR();
        MB_SLOAD_B((j + 2) * 64); MB_SBAR();
        pv_d0(o, vb0, pa0, pa1, pa2, pa3); MB_PSM(pB0, pB1, mnB, alB, j);
        __syncthreads(); MB_SWAIT(); MB_SWRITE(0, vsA0, vsA1, ksA0, ksA1);
        MB_RESC(alB); __syncthreads();
        MB_SBAR(); qkt(pA0, pA1, lds + K_OFF, qr, r32, hi);
        finishSM(pB0, pB1, alB, l_reg, pa0, pa1, pa2, pa3); MB_SBAR();
        if (j + 3 < NT) MB_SLOAD_A((j + 3) * 64); MB_SBAR();
        pv_d0(o, vb0 + SHM_V, pa0, pa1, pa2, pa3); MB_PSM(pA0, pA1, mnA, alA, j + 1);
        __syncthreads(); MB_SWAIT(); MB_SWRITE(1, vsB0, vsB1, ksB0, ksB1);
        MB_RESC(alA); __syncthreads();
    }
    MB_SBAR(); qkt(pB0, pB1, lds + K_OFF + SHM_K, qr, r32, hi);
    finishSM(pA0, pA1, alA, l_reg, pa0, pa1, pa2, pa3); MB_SBAR();
    pv_d0(o, vb0, pa0, pa1, pa2, pa3); MB_PSM(pB0, pB1, mnB, alB, NT - 1);
    __syncthreads(); MB_RESC(alB);
    finishSM(pB0, pB1, alB, l_reg, pa0, pa1, pa2, pa3); MB_SBAR();
    pv_d0(o, vb0 + SHM_V, pa0, pa1, pa2, pa3);
    if (valid) {
        const float inv = 1.f / l_reg;
        const size_t rg = ((size_t)(b * SEQ + t) * N_HEADS + h) * 4 + slot;
        bf16* po = part_o + rg * HEAD_DIM + 4 * hi;
#pragma unroll
        for (int d0 = 0; d0 < 4; ++d0)
#pragma unroll
            for (int rq = 0; rq < 4; ++rq) { u32x2 w; w.x = cvt_pk_bf16(o[d0][rq * 4 + 0] * inv, o[d0][rq * 4 + 1] * inv); w.y = cvt_pk_bf16(o[d0][rq * 4 + 2] * inv, o[d0][rq * 4 + 3] * inv);
                *(u32x2*)(po + d0 * 32 + rq * 8) = w; }
        if (hi == 0) { f32x2 ml; ml.x = m_reg; ml.y = l_reg; *(f32x2*)(part_ml + rg * 2) = ml; }
    }
    __syncthreads();
#undef MB_SLOAD_A
#undef MB_SLOAD_B
#undef MB_SWRITE
#undef MB_SWAIT
#undef MB_RESC
#undef MB_PSM
}
}

constexpr size_t WS_SELB = WS_T;
constexpr size_t WS_PML = WS_T + 2 * MiB;
constexpr size_t WS_LISTS = WS_T + 16 * MiB;
constexpr size_t WS_PARTO = WS_SCORES;
constexpr int CW_LCNT = 16384 + 512;

__device__ __forceinline__ void phase_kmeans(KP P) {
    int tz = threadIdx.x; asm volatile("" : "+v"(tz)); const int tid = tz;
    const bf16* kv = (const bf16*)(P->ws + WS_KV); float* km = (float*)(P->ws + WS_KM);
    for (int it = blockIdx.x; it < BATCH * N_KV * N_BLOCKS; it += gridDim.x) {
        const int blk = it % N_BLOCKS, g = (it / N_BLOCKS) % N_KV, b = it / (N_BLOCKS * N_KV);
        if (tid < HEAD_DIM) { float s = 0.f;
            for (int i = 0; i < MOBA_BLOCK; ++i) s += bf2f(kv[(size_t)(b * SEQ + blk * MOBA_BLOCK + i) * 512 + g * HEAD_DIM + tid]);
            const float mval = s * (1.f / MOBA_BLOCK); km[(size_t)it * HEAD_DIM + tid] = mval;
            const unsigned hi16 = cvt_pk_bf16(mval, 0.f) & 0xffffu; const float rem = mval - bflo(hi16);
            bf16* kmh = (bf16*)(km + 65536); kmh[(size_t)it * HEAD_DIM + tid] = (bf16)hi16; kmh[(size_t)(BATCH * N_KV * N_BLOCKS + it) * HEAD_DIM + tid] = (bf16)(cvt_pk_bf16(rem, 0.f) & 0xffffu); }
    }
}
__device__ __forceinline__ void phase_moba_gate(KP P, LAS unsigned char* lds) {
    int tz = threadIdx.x; asm volatile("" : "+v"(tz)); const int tid = tz, lane = tid & 63, wave = tid >> 6;
    const bf16* q = (const bf16*)(P->ws + WS_QKVI); const float* km = (const float*)(P->ws + WS_KM); unsigned char* selb = (unsigned char*)(P->ws + WS_SELB);
    LAS float* qs = (LAS float*)(lds + wave * 2048);
    const int blk = lane & 31, half = lane >> 5;
    for (int it = blockIdx.x * NWAVES + wave; it < NTOK * 2; it += gridDim.x * NWAVES) {
        const int tok = it >> 1, g = it & 1, b = tok / SEQ, t = tok % SEQ, own = t >> 8;
        unsigned char* sb = selb + ((size_t)tok * 8 + g * 4) * 4;
        if (own < 3) { if (lane < 4) { for (int s2 = own; s2 < 3; ++s2) sb[lane * 4 + s2] = 0xFF; } }
        if (own == 0) continue;
        { const u32x4 w = *(const u32x4*)(q + (size_t)tok * D_MODEL + g * 512 + lane * 8);
          LAS float* d = qs + lane * 8;
          d[0] = bflo(w.x); d[1] = bfhi(w.x); d[2] = bflo(w.y); d[3] = bfhi(w.y); d[4] = bflo(w.z); d[5] = bfhi(w.z); d[6] = bflo(w.w); d[7] = bfhi(w.w); }
        asm volatile("s_waitcnt lgkmcnt(0)" ::: "memory");
        float acc[4] = {0.f, 0.f, 0.f, 0.f};
        const float* kp = km + ((size_t)(b * N_KV + g) * N_BLOCKS + blk) * HEAD_DIM + half * 64;
#pragma unroll 4
        for (int i = 0; i < 16; ++i) { const f32x4 kk = *(const f32x4*)(kp + 4 * i);
#pragma unroll
            for (int r = 0; r < 4; ++r) { const f32x4 qq = *(const LAS f32x4*)(qs + r * 128 + half * 64 + 4 * i); acc[r] += (kk[0] * qq[0] + kk[1] * qq[1]) + (kk[2] * qq[2] + kk[3] * qq[3]); } }
#pragma unroll
        for (int r = 0; r < 4; ++r) { acc[r] += __shfl_xor(acc[r], 32); if (blk >= own) acc[r] = -INFINITY; }
        int rank[4] = {0, 0, 0, 0};
#pragma unroll
        for (int j = 0; j < 32; ++j) {
#pragma unroll
            for (int r = 0; r < 4; ++r) { const float vj = __uint_as_float(__builtin_amdgcn_readlane(__float_as_uint(acc[r]), j)); rank[r] += (vj > acc[r] || (vj == acc[r] && j < blk)) ? 1 : 0; }
        }
        if (half == 0 && blk < own) {
#pragma unroll
            for (int r = 0; r < 4; ++r) if (rank[r] < 3) sb[r * 4 + rank[r]] = (unsigned char)blk;
        }
    }
}

__device__ __forceinline__ void phase_moba_gate2(KP P) {
    typedef float f32x16 __attribute__((ext_vector_type(16)));
    int tz = threadIdx.x; asm volatile("" : "+v"(tz)); const int tid = tz, lane = tid & 63, wave = tid >> 6, r32 = lane & 31, hi = lane >> 5;
    const bf16* q = (const bf16*)(P->ws + WS_QKVI); const bf16* kmh = (const bf16*)((const float*)(P->ws + WS_KM) + 65536); unsigned char* selb = (unsigned char*)(P->ws + WS_SELB);
    const int gw = blockIdx.x * NWAVES + wave, NGW = gridDim.x * NWAVES;
    int cur_bg = -1; bf16x8 ah[8], al[8];
    for (int tile = gw * 4; tile < 8192; tile += NGW * 4) {
#pragma unroll 1
        for (int sub = 0; sub < 4; ++sub) {
            const int tl = tile + sub, bg = tl >> 10, b = bg >> 1, g = bg & 1, rt = tl & 1023;
            if (bg != cur_bg) { cur_bg = bg;
                const bf16* kp = kmh + ((size_t)(b * N_KV + g) * N_BLOCKS + r32) * HEAD_DIM + 8 * hi;
#pragma unroll
                for (int ks = 0; ks < 8; ++ks) { ah[ks] = *(const bf16x8*)(kp + 16 * ks); al[ks] = *(const bf16x8*)(kp + (size_t)BATCH * N_KV * N_BLOCKS * HEAD_DIM + 16 * ks); } }
            const int row = rt * 32 + r32, t = row >> 2, rh = row & 3, own = t >> 8, tok = b * SEQ + t;
            const bf16* qp = q + (size_t)tok * D_MODEL + (g * 4 + rh) * HEAD_DIM + 8 * hi;
            f32x16 acc = {};
#pragma unroll
            for (int ks = 0; ks < 8; ++ks) { const bf16x8 qv = *(const bf16x8*)(qp + 16 * ks);
                acc = __builtin_amdgcn_mfma_f32_32x32x16_bf16(ah[ks], qv, acc, 0, 0, 0); acc = __builtin_amdgcn_mfma_f32_32x32x16_bf16(al[ks], qv, acc, 0, 0, 0); }
            float v[16];
#pragma unroll
            for (int r = 0; r < 16; ++r) { const int blk = (r & 3) + 8 * (r >> 2) + 4 * hi; v[r] = (blk < own) ? acc[r] : -INFINITY; }
            float bv[3]; int bi[3];
#pragma unroll
            for (int p = 0; p < 3; ++p) { float best = -INFINITY; int br = -1;
#pragma unroll
                for (int r = 0; r < 16; ++r) { if (v[r] > best) { best = v[r]; br = r; } }
                bv[p] = best; bi[p] = (br < 0) ? 255 : ((br & 3) + 8 * (br >> 2) + 4 * hi);
#pragma unroll
                for (int r = 0; r < 16; ++r) { if (r == br) v[r] = -INFINITY; } }
            float ov[3]; int oi[3];
#pragma unroll
            for (int p = 0; p < 3; ++p) { ov[p] = __shfl_xor(bv[p], 32); oi[p] = __shfl_xor(bi[p], 32); }
            int ia = 0, ib = 0; int res[3];
#pragma unroll
            for (int p = 0; p < 3; ++p) {
                const float va = (ia == 0) ? bv[0] : (ia == 1) ? bv[1] : (ia == 2) ? bv[2] : -INFINITY; const int xa = (ia == 0) ? bi[0] : (ia == 1) ? bi[1] : (ia == 2) ? bi[2] : 255;
                const float vb = (ib == 0) ? ov[0] : (ib == 1) ? ov[1] : (ib == 2) ? ov[2] : -INFINITY; const int xb = (ib == 0) ? oi[0] : (ib == 1) ? oi[1] : (ib == 2) ? oi[2] : 255;
                const bool takeA = (va > vb) || (va == vb && xa < xb);
                const float vv = takeA ? va : vb; const int xx = takeA ? xa : xb;
                res[p] = (vv > -INFINITY) ? xx : 255; if (takeA) ++ia; else ++ib; }
            if (hi == 0) { const unsigned w = (unsigned)res[0] | ((unsigned)res[1] << 8) | ((unsigned)res[2] << 16) | 0xFF000000u;
                *(unsigned*)(selb + ((size_t)tok * 8 + g * 4 + rh) * 4) = w; }
        }
    }
}

__device__ __forceinline__ void phase_moba_lists(KP P, LAS unsigned char* lds) {
    int tz = threadIdx.x; asm volatile("" : "+v"(tz)); const int tid = tz, lane = tid & 63, wave = tid >> 6;
    const u32x4* selb = (const u32x4*)(P->ws + WS_SELB); unsigned* lists = (unsigned*)(P->ws + WS_LISTS); unsigned* lcnt = (unsigned*)(P->ws + WS_CTL) + CW_LCNT;
    LAS int* wtot = (LAS int*)lds;
    for (int li = blockIdx.x; li < 256; li += gridDim.x) {
        const int j = li & 31, g = (li >> 5) & 1, b = li >> 6, base_t = (j + 1) * MOBA_BLOCK, n_t = SEQ - base_t;
        unsigned* out = lists + (size_t)li * 32768;
        int running = 0;
        for (int i0 = 0; i0 < n_t; i0 += 512) {
            const int ti = i0 + tid; const bool ok = ti < n_t; const int t = base_t + ti;
            u32x4 w = {0xFFFFFFFFu, 0xFFFFFFFFu, 0xFFFFFFFFu, 0xFFFFFFFFu};
            if (ok) w = selb[((size_t)(b * SEQ + t) * 8 + g * 4) / 4];
            int ms[4];
#pragma unroll
            for (int r = 0; r < 4; ++r) { const unsigned x = w[r]; ms[r] = ((x & 0xFFu) == (unsigned)j) ? 0 : (((x >> 8) & 0xFFu) == (unsigned)j) ? 1 : (((x >> 16) & 0xFFu) == (unsigned)j) ? 2 : -1; }
            const int c = (ms[0] >= 0) + (ms[1] >= 0) + (ms[2] >= 0) + (ms[3] >= 0);
            int inc = c;
#pragma unroll
            for (int o = 1; o < 64; o <<= 1) { const int v = __shfl_up(inc, o); if (lane >= o) inc += v; }
            __syncthreads();
            if (lane == 63) wtot[wave] = inc;
            __syncthreads();
            int woff = 0, tot = 0;
#pragma unroll
            for (int x = 0; x < NWAVES; ++x) { const int v = wtot[x]; if (x < wave) woff += v; tot += v; }
            int pos = running + woff + inc - c;
#pragma unroll
            for (int r = 0; r < 4; ++r) if (ms[r] >= 0) out[pos++] = (unsigned)t | ((unsigned)r << 13) | ((unsigned)ms[r] << 15);
            running += tot;
        }
        if (tid == 0) lcnt[li] = (unsigned)running;
        __syncthreads();
    }
}
__device__ __forceinline__ void phase_moba_attn(KP P, LAS unsigned char* lds) {
    int tz = threadIdx.x; asm volatile("" : "+v"(tz)); const int tid = tz, lane = tid & 63, wave = tid >> 6;
    const bf16* q = (const bf16*)(P->ws + WS_QKVI); const bf16* kv = (const bf16*)(P->ws + WS_KV);
    bf16* part_o = (bf16*)(P->ws + WS_PARTO); float* part_ml = (float*)(P->ws + WS_PML);
    const unsigned* lists = (const unsigned*)(P->ws + WS_LISTS); const unsigned* lcnt = (const unsigned*)(P->ws + WS_CTL) + CW_LCNT;
    LAS int* pre = (LAS int*)(lds + mb::PRE_OFF);
    LAS int* cn = pre + 260;
    if (tid < 256) cn[tid] = (int)lcnt[tid];
    __syncthreads();
    if (tid == 0) { int s = 0; for (int i = 0; i < 256; ++i) { pre[i] = s; s += (cn[i] + 255) >> 8; } pre[256] = s; }
    __syncthreads();
    const int npast = pre[256], total = npast + 1024;
    for (int it = blockIdx.x; it < total; it += gridDim.x) {
        int b, g, kblk, NT, t, rh, slot; bool own, valid;
        const int ri = wave * 32 + (lane & 31);
        if (it < npast) {
            int lo = 0, hi = 256;
            while (hi - lo > 1) { const int mid = (lo + hi) >> 1; if (pre[mid] <= it) lo = mid; else hi = mid; }
            const int li = lo, chunk = it - pre[li], n = cn[li];
            kblk = li & 31; g = (li >> 5) & 1; b = li >> 6; NT = 4; own = false;
            int idx = chunk * 256 + ri; valid = idx < n; if (!valid) idx = chunk * 256;
            const unsigned e = lists[(size_t)li * 32768 + idx];
            t = (int)(e & 0x1FFFu); rh = (int)((e >> 13) & 3u); slot = (int)((e >> 15) & 3u);
        } else {
            const int oi = it - npast, chunk = oi & 3, bi = oi >> 2;
            kblk = bi & 31; g = (bi >> 5) & 1; b = bi >> 6; NT = chunk < 2 ? 2 : 4; own = true; valid = true;
            t = kblk * MOBA_BLOCK + chunk * 64 + (ri >> 2); rh = ri & 3; slot = 3;
        }
        mb::item(q, kv, part_o, part_ml, lds, tid, b, g, kblk, NT, own, t, rh, slot, valid);
    }
}

namespace mb {
constexpr int SEG_K = 0, SEG_V = 65536, SEG_PRE = 131072, SEGC = 8;
__device__ __forceinline__ void stage_block(const bf16* __restrict__ kv, LAS unsigned char* lds, int tid, int b, int g, int kblk) {
    const char* KhB = (const char*)(kv + (size_t)(b * SEQ + kblk * MOBA_BLOCK) * 512 + g * HEAD_DIM);
    const int sr = tid >> 4, sc = (tid & 15) * 8, vst0 = v_st(sr, sc), vst1 = v_st(32 + sr, sc);
    const unsigned vo0 = (unsigned)(sr * 512 + sc) * 2u, vo1 = vo0 + 32u * 1024u;
#pragma unroll
    for (int h2 = 0; h2 < 2; ++h2) {
        bf16x8 kx[2][2], vx[2][2];
#pragma unroll
        for (int tt = 0; tt < 2; ++tt) { const char* kt_ = KhB + (size_t)((h2 * 2 + tt) * 64) * 1024;
            kx[tt][0] = *(const bf16x8*)(kt_ + vo0); kx[tt][1] = *(const bf16x8*)(kt_ + vo1); vx[tt][0] = *(const bf16x8*)(kt_ + 512 + vo0); vx[tt][1] = *(const bf16x8*)(kt_ + 512 + vo1); }
#pragma unroll
        for (int tt = 0; tt < 2; ++tt) { const int tile = h2 * 2 + tt;
            *(LAS bf16x8*)(lds + SEG_K + tile * SHM_K + MB_KSWZ(sr, sc * 2)) = kx[tt][0]; *(LAS bf16x8*)(lds + SEG_K + tile * SHM_K + MB_KSWZ(32 + sr, sc * 2)) = kx[tt][1];
            *(LAS bf16x8*)(lds + SEG_V + tile * SHM_V + vst0) = vx[tt][0]; *(LAS bf16x8*)(lds + SEG_V + tile * SHM_V + vst1) = vx[tt][1]; }
    }
}
__device__ __forceinline__ void chunk_rows(const bf16* __restrict__ q, bf16* __restrict__ part_o, float* __restrict__ part_ml, LAS unsigned char* lds, int lane,
                                           int b, int g, int kblk, int NT, bool own, int t, int rh, int slot, bool valid) {
    const int r32 = lane & 31, hi = lane >> 5, h = g * 4 + rh;
    float m_reg = -1e30f, l_reg = 0.f; f32x16 o[4] = {}; bf16x8 qr[8];
    { const bf16* Qw = q + (size_t)(b * SEQ + t) * D_MODEL + h * HEAD_DIM + hi * 8;
#pragma unroll
      for (int d0 = 0; d0 < 8; ++d0) qr[d0] = *(const bf16x8*)(Qw + d0 * 16); }
    const float bias2 = __builtin_amdgcn_exp2f(-(float)(h + 1)) * LOG2E;
    const int trel = t - kblk * MOBA_BLOCK;
    const float tb4 = bias2 * (float)(4 * hi - trel);
    const int lim0 = trel - 4 * hi;
    const int vb0 = (int)(unsigned)(uintptr_t)(lds + SEG_V) + v_rd_base(lane);
    for (int tile = 0; tile < NT; ++tile) {
        f32x16 p0, p1; float mn, al; bf16x8 pa0, pa1, pa2, pa3;
        qkt(p0, p1, lds + SEG_K + tile * SHM_K, qr, r32, hi);
        partialSM(p0, p1, m_reg, mn, al, bias2, tb4 + bias2 * (float)(tile * 64), own, lim0 - tile * 64);
        if (__any(al < 1.f)) {
#pragma unroll
            for (int d = 0; d < 4; ++d)
#pragma unroll
                for (int r = 0; r < 16; ++r) o[d][r] *= al; }
        finishSM(p0, p1, al, l_reg, pa0, pa1, pa2, pa3);
        pv_d0(o, vb0 + tile * SHM_V, pa0, pa1, pa2, pa3);
    }
    if (valid) {
        const float inv = 1.f / l_reg;
        const size_t rg = ((size_t)(b * SEQ + t) * N_HEADS + h) * 4 + slot;
        bf16* po = part_o + rg * HEAD_DIM + 4 * hi;
#pragma unroll
        for (int d0 = 0; d0 < 4; ++d0)
#pragma unroll
            for (int rq = 0; rq < 4; ++rq) { u32x2 w; w.x = cvt_pk_bf16(o[d0][rq * 4 + 0] * inv, o[d0][rq * 4 + 1] * inv); w.y = cvt_pk_bf16(o[d0][rq * 4 + 2] * inv, o[d0][rq * 4 + 3] * inv);
                *(u32x2*)(po + d0 * 32 + rq * 8) = w; }
        if (hi == 0) { f32x2 ml; ml.x = m_reg; ml.y = l_reg; *(f32x2*)(part_ml + rg * 2) = ml; }
    }
}
}
constexpr int CW_MQ = 20480;
__device__ __forceinline__ void phase_moba_attn2(KP P, int Lb, LAS unsigned char* lds) {
    int tz = threadIdx.x; asm volatile("" : "+v"(tz)); const int tid = tz, lane = tid & 63, wave = tid >> 6;
    const bf16* q = (const bf16*)(P->ws + WS_QKVI); const bf16* kv = (const bf16*)(P->ws + WS_KV);
    bf16* part_o = (bf16*)(P->ws + WS_PARTO); float* part_ml = (float*)(P->ws + WS_PML);
    const unsigned* lists = (const unsigned*)(P->ws + WS_LISTS); const unsigned* lcnt = (const unsigned*)(P->ws + WS_CTL) + CW_LCNT;
    unsigned* qhead = (unsigned*)(P->ws + WS_CTL) + CW_MQ + Lb * 64;
    LAS int* pre = (LAS int*)(lds + mb::SEG_PRE);
    LAS int* cn = pre + 260;
    LAS int* cur = pre + 520;
    if (tid < 256) cn[tid] = (int)lcnt[tid];
    __syncthreads();
    if (tid == 0) { int s2 = 0; for (int i = 0; i < 256; ++i) { pre[i] = s2; const int nch = (cn[i] + 255) >> 8; s2 += (nch + mb::SEGC - 1) / mb::SEGC; } pre[256] = s2; }
    __syncthreads();
    const int npast = pre[256], total = npast + 256;
    for (;;) {
        if (tid == 0) cur[0] = (int)__hip_atomic_fetch_add(qhead, 1u, __ATOMIC_RELAXED, __HIP_MEMORY_SCOPE_AGENT);
        __syncthreads();
        const int sg = cur[0];
        if (sg >= total) break;
        int b, g, kblk, li = 0, ch0, nch, n = 0; bool own;
        if (sg < npast) {
            int lo = 0, hi2 = 256;
            while (hi2 - lo > 1) { const int mid = (lo + hi2) >> 1; if (pre[mid] <= sg) lo = mid; else hi2 = mid; }
            li = lo; n = cn[li]; ch0 = (sg - pre[li]) * mb::SEGC; const int ncht = (n + 255) >> 8; nch = ncht - ch0 < mb::SEGC ? ncht - ch0 : mb::SEGC;
            kblk = li & 31; g = (li >> 5) & 1; b = li >> 6; own = false;
        } else { const int bi = sg - npast; kblk = bi & 31; g = (bi >> 5) & 1; b = bi >> 6; own = true; ch0 = 0; nch = 4; }
        mb::stage_block(kv, lds, tid, b, g, kblk);
        __syncthreads();
        const int ri = wave * 32 + (lane & 31);
        for (int c = 0; c < nch; ++c) {
            const int chunk = ch0 + c; int t, rh, slot, NT; bool valid;
            if (!own) { int idx = chunk * 256 + ri; valid = idx < n; if (!valid) idx = chunk * 256;
                const unsigned e = lists[(size_t)li * 32768 + idx];
                t = (int)(e & 0x1FFFu); rh = (int)((e >> 13) & 3u); slot = (int)((e >> 15) & 3u); NT = 4;
            } else { valid = true; t = kblk * MOBA_BLOCK + chunk * 64 + (ri >> 2); rh = ri & 3; slot = 3; NT = chunk + 1; }
            mb::chunk_rows(q, part_o, part_ml, lds, lane, b, g, kblk, NT, own, t, rh, slot, valid);
        }
        __syncthreads();
    }
}

__device__ __forceinline__ void phase_moba_combine(KP P) {
    int tz = threadIdx.x; asm volatile("" : "+v"(tz)); const int tid = tz;
    const bf16* part_o = (const bf16*)(P->ws + WS_PARTO); const float* part_ml = (const float*)(P->ws + WS_PML); bf16* attn = (bf16*)(P->ws + WS_ATTN);
    const int sub = tid & 15;
    const int stride = (gridDim.x * 512) >> 4;
    for (int rg0 = (blockIdx.x * 512 + tid) >> 4; rg0 < NTOK * N_HEADS; rg0 += 2 * stride) {
        f32x4 mlv[2][2]; u32x4 pv[2][4]; bool has[2];
#pragma unroll
        for (int u = 0; u < 2; ++u) { const int rg = rg0 + u * stride; has[u] = rg < NTOK * N_HEADS; const int rgc = has[u] ? rg : rg0;
            mlv[u][0] = *(const f32x4*)(part_ml + (size_t)rgc * 8); mlv[u][1] = *(const f32x4*)(part_ml + (size_t)rgc * 8 + 4);
#pragma unroll
            for (int s2 = 0; s2 < 4; ++s2) pv[u][s2] = *(const u32x4*)(part_o + ((size_t)rgc * 4 + s2) * HEAD_DIM + sub * 8); }
#pragma unroll
        for (int u = 0; u < 2; ++u) { const int rg = rg0 + u * stride;
            if (!has[u]) continue;
            const int tok = rg >> 3, own = (tok % SEQ) >> 8, nv = own < 3 ? own : 3;
            const float mm[4] = {mlv[u][0][0], mlv[u][0][2], mlv[u][1][0], mlv[u][1][2]}, ll[4] = {mlv[u][0][1], mlv[u][0][3], mlv[u][1][1], mlv[u][1][3]};
            float m[4], l[4];
#pragma unroll
            for (int s2 = 0; s2 < 4; ++s2) { const bool ok = (s2 == 3) || (s2 < nv); m[s2] = ok ? mm[s2] : -INFINITY; l[s2] = ok ? ll[s2] : 0.f; }
            const float M = fmaxf(fmaxf(m[0], m[1]), fmaxf(m[2], m[3]));
            float w[4], W = 0.f;
#pragma unroll
            for (int s2 = 0; s2 < 4; ++s2) { w[s2] = l[s2] * __builtin_amdgcn_exp2f(m[s2] - M); W += w[s2]; }
            const float inv = 1.f / W;
            float acc[8] = {0.f, 0.f, 0.f, 0.f, 0.f, 0.f, 0.f, 0.f};
#pragma unroll
            for (int s2 = 0; s2 < 4; ++s2) { const bool ok = (s2 == 3) || (s2 < nv); const u32x4 v = pv[u][s2]; const float ws2 = ok ? w[s2] * inv : 0.f;
                if (ok) { acc[0] += ws2 * bflo(v.x); acc[1] += ws2 * bfhi(v.x); acc[2] += ws2 * bflo(v.y); acc[3] += ws2 * bfhi(v.y);
                          acc[4] += ws2 * bflo(v.z); acc[5] += ws2 * bfhi(v.z); acc[6] += ws2 * bflo(v.w); acc[7] += ws2 * bfhi(v.w); } }
            u32x4 o; o.x = cvt_pk_bf16(acc[0], acc[1]); o.y = cvt_pk_bf16(acc[2], acc[3]); o.z = cvt_pk_bf16(acc[4], acc[5]); o.w = cvt_pk_bf16(acc[6], acc[7]);
            *(u32x4*)(attn + (size_t)rg * HEAD_DIM + sub * 8) = o;
        }
    }
}


#ifndef D1_EXP
#define D1_EXP 0
#endif
constexpr int D1_QS = 4100, D1_SM = 32 * D1_QS, D1_SELIDX = D1_SM + 1024, D1_NT = 992;
__device__ __forceinline__ unsigned fkey2(float f) { const unsigned u = __float_as_uint(f); return (u & 0x80000000u) ? ~u : (u | 0x80000000u); }
template <int PASS, int EXP>
__device__ __forceinline__ void d1_scan(const bf16* __restrict__ ikb, int qt, int kt_end, int wave, int lane, const bf16x8 (&qb)[4][4], const float (&wv)[4], LAS unsigned char* lds, unsigned thr, float flo = 0.f, float finv = 0.f, unsigned bstar = 0) {
    typedef float f32x16 __attribute__((ext_vector_type(16)));
    const int r32 = lane & 31, hi = lane >> 5;
    LAS unsigned* hq = (LAS unsigned*)(lds + r32 * D1_QS);
    LAS unsigned* sm = (LAS unsigned*)(lds + D1_SM);
    bf16x8 ka[4];
    int kt = wave;
    if (kt <= kt_end) { const bf16* kp = ikb + (size_t)(kt * 32 + r32) * QLD + 8 * hi;
#pragma unroll
        for (int ks = 0; ks < 4; ++ks) ka[ks] = *(const bf16x8*)(kp + 16 * ks); }
    for (; kt <= kt_end; kt += 8) {
        bf16x8 kn[4];
#pragma unroll
        for (int ks = 0; ks < 4; ++ks) kn[ks] = ka[ks];
        if (kt + 8 <= kt_end) { const bf16* kp = ikb + (size_t)((kt + 8) * 32 + r32) * QLD + 8 * hi;
#pragma unroll
            for (int ks = 0; ks < 4; ++ks) kn[ks] = *(const bf16x8*)(kp + 16 * ks); }
        float sc[16];
#pragma unroll
        for (int r = 0; r < 16; ++r) sc[r] = 0.f;
#pragma unroll
        for (int h = 0; h < 4; ++h) { f32x16 acc = {};
#pragma unroll
            for (int ks = 0; ks < 4; ++ks) acc = __builtin_amdgcn_mfma_f32_32x32x16_bf16(ka[ks], qb[h][ks], acc, 0, 0, 0);
#pragma unroll
            for (int r = 0; r < 16; ++r) sc[r] = fmaf(wv[h], fmaxf(acc[r], 0.f), sc[r]); }
        int kbase = kt * 32 + 4 * hi; asm volatile("" : "+v"(kbase));
        const int lim = (kt == qt) ? (r32 - 4 * hi) : 64;
#pragma unroll
        for (int r = 0; r < 16; ++r) {
            const int kc = (r & 3) + 8 * (r >> 2);
            const bool valid = kc <= lim;
            const unsigned key = fkey2(sc[r]);
            if (PASS == 1) { if (EXP == 3) { if (key == 12345u) hq[0] = 1u; } else if (valid && EXP != 2) { const unsigned bin = key >> 21; (void)__hip_atomic_fetch_add(hq + (bin >> 1), 1u << (16 * (bin & 1)), __ATOMIC_RELAXED, __HIP_MEMORY_SCOPE_WORKGROUP); } }
            else if (PASS == 2) { if (valid && (key >> 21) == thr) { const unsigned bin = (key >> 10) & 2047u; (void)__hip_atomic_fetch_add(hq + (bin >> 1), 1u << (16 * (bin & 1)), __ATOMIC_RELAXED, __HIP_MEMORY_SCOPE_WORKGROUP); } }
            else if (PASS == 4) { if (valid && sc[r] >= flo) { unsigned bin = (unsigned)((sc[r] - flo) * finv); bin = bin > 2047u ? 2047u : bin; (void)__hip_atomic_fetch_add(hq + (bin >> 1), 1u << (16 * (bin & 1)), __ATOMIC_RELAXED, __HIP_MEMORY_SCOPE_WORKGROUP); } }
            else if (PASS == 5) { if (valid && sc[r] >= flo) { unsigned bin = (unsigned)((sc[r] - flo) * finv); bin = bin > 2047u ? 2047u : bin; const unsigned sidx = (unsigned)(kbase + kc);
                    if (bin > bstar) (void)__hip_atomic_fetch_or(hq + 512 + (sidx >> 5), 1u << (sidx & 31u), __ATOMIC_RELAXED, __HIP_MEMORY_SCOPE_WORKGROUP);
                    else if (bin == bstar) {
                        if (key == 0x80000000u) (void)__hip_atomic_fetch_or(hq + 768 + (sidx >> 5), 1u << (sidx & 31u), __ATOMIC_RELAXED, __HIP_MEMORY_SCOPE_WORKGROUP);
                        else { const unsigned cp = __hip_atomic_fetch_add(sm + 160 + r32, 1u, __ATOMIC_RELAXED, __HIP_MEMORY_SCOPE_WORKGROUP); if (cp < 256u) { hq[cp] = key; ((LAS unsigned short*)(hq + 256))[cp] = (unsigned short)sidx; } } } } }
            else { if (valid) { const unsigned p22 = key >> 10; const unsigned sidx = (unsigned)(kbase + kc);
                    if (p22 > thr) (void)__hip_atomic_fetch_or(hq + 512 + (sidx >> 5), 1u << (sidx & 31u), __ATOMIC_RELAXED, __HIP_MEMORY_SCOPE_WORKGROUP);
                    else if (p22 == thr) {
                        if (key == 0x80000000u) (void)__hip_atomic_fetch_or(hq + 768 + (sidx >> 5), 1u << (sidx & 31u), __ATOMIC_RELAXED, __HIP_MEMORY_SCOPE_WORKGROUP);
                        else { const unsigned cp = __hip_atomic_fetch_add(sm + 160 + r32, 1u, __ATOMIC_RELAXED, __HIP_MEMORY_SCOPE_WORKGROUP); if (cp < 256u) { hq[cp] = key; ((LAS unsigned short*)(hq + 256))[cp] = (unsigned short)sidx; } } } } }
        }
#pragma unroll
        for (int ks = 0; ks < 4; ++ks) ka[ks] = kn[ks];
    }
}
__device__ __forceinline__ bool d1_find(LAS unsigned* H, unsigned need, int lane, unsigned& bin_out, unsigned& above_out) {
    unsigned mine = 0;
#pragma unroll
    for (int i = 0; i < 16; ++i) { const unsigned w = H[lane * 16 + i]; mine += (w & 0xFFFFu) + (w >> 16); }
    unsigned inc = mine;
#pragma unroll
    for (int o = 1; o < 64; o <<= 1) { const unsigned v = __shfl_down(inc, o); if (lane + o < 64) inc += v; }
    const unsigned above = inc - mine; const bool found = (above < need) && (inc >= need);
    const unsigned long long bal = __ballot(found); const int src = bal ? (__ffsll((long long)bal) - 1) : 0;
    const unsigned ab0 = __shfl(above, src);
    unsigned cj = 0;
    if (lane < 32) { const int bidx = src * 32 + 31 - lane; const unsigned w = H[bidx >> 1]; cj = (bidx & 1) ? (w >> 16) : (w & 0xFFFFu); }
    unsigned inc2 = cj;
#pragma unroll
    for (int o = 1; o < 32; o <<= 1) { const unsigned v = __shfl_up(inc2, o); if (lane >= o) inc2 += v; }
    const bool hit = (lane < 32) && (ab0 + inc2 >= need) && (ab0 + inc2 - cj < need);
    const unsigned long long bal2 = __ballot(hit); const int l2 = bal2 ? (__ffsll((long long)bal2) - 1) : 0;
    bin_out = (unsigned)(src * 32 + 31 - l2); above_out = ab0 + __shfl(inc2 - cj, l2);
    return bal != 0ull;
}
template <int EXP>
__device__ __forceinline__ void phase_dsa_topk(KP P, LAS unsigned char* lds, size_t sel_off) {
    int tz = threadIdx.x; asm volatile("" : "+v"(tz)); const int tid = tz, lane = tid & 63, wave = tid >> 6, r32 = lane & 31, hi = lane >> 5;
    const bf16* qkvi = (const bf16*)(P->ws + WS_QKVI); const float* iw = (const float*)(P->ws + WS_IW); int* sel = (int*)(P->ws + sel_off);
    LAS unsigned* sm = (LAS unsigned*)(lds + D1_SM);
    const int G = gridDim.x, nrounds = (D1_NT + G - 1) / G;
    for (int rho = 0; rho < nrounds; ++rho) {
        const int pos = (rho & 1) ? (G - 1 - (int)blockIdx.x) : (int)blockIdx.x, i = rho * G + pos;
        if (i >= D1_NT) continue;
        const int qt = 255 - (i >> 2), b = i & 3, t0 = qt * 32, tok0 = b * SEQ + t0;
        for (int w = tid; w < (D1_SM + 1024) / 4; w += 512) ((LAS unsigned*)lds)[w] = 0u;
        bf16x8 qb[4][4]; float wv[4];
        { const bf16* qp = qkvi + (size_t)(tok0 + r32) * QLD + COL_IQ + 8 * hi;
#pragma unroll
          for (int h = 0; h < 4; ++h)
#pragma unroll
              for (int ks = 0; ks < 4; ++ks) qb[h][ks] = *(const bf16x8*)(qp + h * IDX_DIM + 16 * ks);
          const f32x4 w4 = *(const f32x4*)(iw + (size_t)(tok0 + r32) * 4); wv[0] = w4[0]; wv[1] = w4[1]; wv[2] = w4[2]; wv[3] = w4[3]; }
        const bf16* ikb = qkvi + (size_t)b * SEQ * QLD + COL_IK;
        __syncthreads();
        d1_scan<1, EXP>(ikb, qt, 7, wave, lane, qb, wv, lds, 0u);
        __syncthreads();
#pragma unroll 1
        for (int qq = 0; qq < 4; ++qq) { const int q = wave * 4 + qq; const unsigned n = (unsigned)(t0 + q + 1); unsigned klo = 196608u / n; klo = klo > 256u ? 256u : (klo < 1u ? 1u : klo);
            unsigned bs, ab, bmx, ab2; const bool ok1 = d1_find((LAS unsigned*)(lds + q * D1_QS), klo, lane, bs, ab), ok2 = d1_find((LAS unsigned*)(lds + q * D1_QS), 1u, lane, bmx, ab2);
            if (lane == 0) { const unsigned klo_key = bs << 21, khi_key = (bmx + 1u) << 21;
                const float lo = __uint_as_float((klo_key & 0x80000000u) ? (klo_key & 0x7FFFFFFFu) : ~klo_key), hi2 = __uint_as_float((khi_key & 0x80000000u) ? (khi_key & 0x7FFFFFFFu) : ~khi_key);
                const float span = (hi2 - lo) * 1.5f; const bool good = ok1 && ok2 && bmx < 2046u && span > 0.f && span < 3.0e38f;
                sm[q] = __float_as_uint(lo); sm[32 + q] = __float_as_uint(good ? 2047.f / span : 0.f); if (!good) sm[224] = 1u; } }
        __syncthreads();
        for (int w = tid; w < D1_SM / 4; w += 512) ((LAS unsigned*)lds)[w] = 0u;
        const float f_lo = __uint_as_float(sm[r32]), f_inv = __uint_as_float(sm[32 + r32]);
        __syncthreads();
        d1_scan<4, EXP>(ikb, qt, qt, wave, lane, qb, wv, lds, 0u, f_lo, f_inv);
        __syncthreads();
#pragma unroll 1
        for (int qq = 0; qq < 4; ++qq) { const int q = wave * 4 + qq; unsigned bin, ab; const bool ok = d1_find((LAS unsigned*)(lds + q * D1_QS), 256u, lane, bin, ab);
            if (lane == 0) { sm[64 + q] = bin; sm[96 + q] = 256u - ab; if (!ok || bin == 2047u) sm[224] = 1u; } }
        __syncthreads();
        for (int w = tid; w < D1_SM / 4; w += 512) ((LAS unsigned*)lds)[w] = 0u;
#ifndef D1_FORCE_FB
#define D1_FORCE_FB 0
#endif
        const unsigned f_bs = sm[64 + r32]; bool fast_ok = (sm[224] == 0u) && !D1_FORCE_FB;
        __syncthreads();
        if (fast_ok) {
            d1_scan<5, EXP>(ikb, qt, qt, wave, lane, qb, wv, lds, 0u, f_lo, f_inv, f_bs);
            __syncthreads();
            if (tid < 32 && sm[160 + tid] > 256u) sm[224] = 1u;
            __syncthreads();
            fast_ok = (sm[224] == 0u);
            __syncthreads();
        }
        if (!fast_ok) {
        for (int w = tid; w < (D1_SM + 1024) / 4; w += 512) ((LAS unsigned*)lds)[w] = 0u;
        __syncthreads();
        d1_scan<1, EXP>(ikb, qt, qt, wave, lane, qb, wv, lds, 0u);
        __syncthreads();
#pragma unroll 1
        for (int qq = 0; qq < 4; ++qq) { const int q = wave * 4 + qq; unsigned bin, ab; d1_find((LAS unsigned*)(lds + q * D1_QS), 256u, lane, bin, ab); if (lane == 0) { sm[q] = bin; sm[32 + q] = ab; } }
        __syncthreads();
        for (int w = tid; w < D1_SM / 4; w += 512) ((LAS unsigned*)lds)[w] = 0u;
        const unsigned b1 = sm[r32];
        __syncthreads();
        d1_scan<2, EXP>(ikb, qt, qt, wave, lane, qb, wv, lds, b1);
        __syncthreads();
#pragma unroll 1
        for (int qq = 0; qq < 4; ++qq) { const int q = wave * 4 + qq; const unsigned need2 = 256u - sm[32 + q]; unsigned bin, ab; d1_find((LAS unsigned*)(lds + q * D1_QS), need2, lane, bin, ab);
            if (lane == 0) { sm[64 + q] = (sm[q] << 11) | bin; sm[96 + q] = need2 - ab; } }
        __syncthreads();
        for (int w = tid; w < D1_SM / 4; w += 512) ((LAS unsigned*)lds)[w] = 0u;
        const unsigned T22 = sm[64 + r32];
        __syncthreads();
        d1_scan<3, EXP>(ikb, qt, qt, wave, lane, qb, wv, lds, T22);
        __syncthreads();
        }
#pragma unroll 1
        for (int qq = 0; qq < 4; ++qq) { const int q = wave * 4 + qq;
            const unsigned cc = sm[160 + q] < 256u ? sm[160 + q] : 256u, need3 = sm[96 + q];
            LAS unsigned* cand = (LAS unsigned*)(lds + q * D1_QS); LAS unsigned short* cidx = (LAS unsigned short*)(cand + 256); LAS unsigned* bm = cand + 512; LAS unsigned* tb = cand + 768;
            unsigned tw[4]; int cz = 0;
#pragma unroll
            for (int w = 0; w < 4; ++w) { tw[w] = tb[lane * 4 + w]; cz += __popc(tw[w]); }
            int incz = cz;
#pragma unroll
            for (int o = 1; o < 64; o <<= 1) { const int v = __shfl_up(incz, o); if (lane >= o) incz += v; }
            const int cztot = __shfl(incz, 63);
            int npos = 0;
            for (unsigned ci = lane; ci < ((cc + 63u) & ~63u); ci += 64) { const bool act = ci < cc; const unsigned mine = act ? cand[ci] : 0u; const unsigned mi = act ? (unsigned)cidx[ci] : 0u;
                npos += __popcll(__ballot(act && mine > 0x80000000u));
                unsigned rank = (mine < 0x80000000u) ? (unsigned)cztot : 0u;
                for (unsigned j = 0; j < cc; ++j) { const unsigned kj = cand[j]; const unsigned ij = (unsigned)cidx[j]; rank += (kj > mine || (kj == mine && ij < mi)) ? 1u : 0u; }
                if (act && rank < need3) (void)__hip_atomic_fetch_or(bm + (mi >> 5), 1u << (mi & 31u), __ATOMIC_RELAXED, __HIP_MEMORY_SCOPE_WORKGROUP); }
            { int need_z = (int)need3 - npos; need_z = need_z < 0 ? 0 : (need_z > cztot ? cztot : need_z);
              if (need_z > 0) { int pre = incz - cz;
#pragma unroll
                for (int w = 0; w < 4; ++w) { unsigned bits = tw[w]; const int pc = __popc(bits); int k = need_z - pre; k = k < 0 ? 0 : (k > pc ? pc : k);
                    unsigned keep = 0u; for (int x = 0; x < k; ++x) { const unsigned low = bits & (0u - bits); keep |= low; bits ^= low; }
                    if (keep) (void)__hip_atomic_fetch_or(bm + lane * 4 + w, keep, __ATOMIC_RELAXED, __HIP_MEMORY_SCOPE_WORKGROUP);
                    pre += pc; } } }
            asm volatile("s_waitcnt lgkmcnt(0)" ::: "memory");
            unsigned wds[4]; int c = 0;
#pragma unroll
            for (int w = 0; w < 4; ++w) { wds[w] = bm[lane * 4 + w]; c += __popc(wds[w]); }
            int inc = c;
#pragma unroll
            for (int o = 1; o < 64; o <<= 1) { const int v = __shfl_up(inc, o); if (lane >= o) inc += v; }
            const int total = __shfl(inc, 63); int off = inc - c;
            int* op = sel + (size_t)(tok0 + q) * TOPK;
            if (EXP != 7)
#pragma unroll
            for (int w = 0; w < 4; ++w) { unsigned bits = wds[w]; const int kb = lane * 128 + w * 32;
                while (bits) { const int k = __ffs((int)bits) - 1; if (off < TOPK) op[off] = kb + k; ++off; bits &= bits - 1u; } }
            for (int j = total + lane; j < TOPK; j += 64) op[j] = t0 + q;
        }
        __syncthreads();
    }
}

constexpr int CW_DQ = 16384 + 1024;
__device__ __forceinline__ void phase_dsa_attn(KP P, int L, LAS unsigned char* lds) {
    int tz = threadIdx.x; asm volatile("" : "+v"(tz)); const int tid = tz, lane = tid & 63, wave = tid >> 6;
    const bf16* qkvi = (const bf16*)(P->ws + WS_QKVI); const int* sel = (const int*)(P->ws + WS_SEL); bf16* attn = (bf16*)(P->ws + WS_ATTN);
    unsigned* qh = (unsigned*)(P->ws + WS_CTL) + CW_DQ + L * 8 * 64;
    LAS unsigned* idxs = (LAS unsigned*)(lds + wave * 8192);
    LAS float* pl = (LAS float*)(lds + wave * 8192 + 1024);
    LAS int* wq = (LAS int*)(lds + 65536 + wave * 16);
    const int r = lane & 3, ts_l = (lane & 15) >> 2, kq = lane >> 4, c16 = lane & 15;
    const unsigned myq = xb_xcc_id() & 7u;
    constexpr float CC = 0.08838834764831845f * 1.4426950408889634f;
    for (int qi = 0; qi < 8; ++qi) {
        const int qx = (int)((myq + (unsigned)qi) & 7u), b = qx >> 1, g = qx & 1;
        for (;;) {
            int item = 0;
            if (lane == 0) item = (int)__hip_atomic_fetch_add(qh + qx * 64, 1u, __ATOMIC_RELAXED, __HIP_MEMORY_SCOPE_AGENT);
            item = __builtin_amdgcn_readfirstlane(item);
            if (item >= SEQ) break;
            const int t = SEQ - 1 - item, tok = b * SEQ + t, cnt = (t + 1 < TOPK) ? (t + 1) : TOPK;
#pragma unroll
            for (int i = 0; i < 4; ++i) { const int j = lane + 64 * i; int sidx = 0; if (j < cnt) sidx = (t < TOPK) ? j : sel[(size_t)tok * TOPK + j]; idxs[j] = (unsigned)sidx; }
            asm volatile("s_waitcnt lgkmcnt(0)" ::: "memory");
            bf16x8 qm[4][4];
            { const bf16* qp = qkvi + (size_t)tok * QLD + (g * 4 + r) * HEAD_DIM + 8 * kq;
#pragma unroll
              for (int ks = 0; ks < 4; ++ks) { const bf16x8 v = *(const bf16x8*)(qp + 32 * ks);
#pragma unroll
                  for (int ts = 0; ts < 4; ++ts) qm[ts][ks] = (ts_l == ts) ? v : (bf16x8){0, 0, 0, 0, 0, 0, 0, 0}; } }
            f32x4 C[4];
            const bf16* kbase = qkvi + (size_t)b * SEQ * QLD + COL_K + g * HEAD_DIM + 8 * kq;
#pragma unroll
            for (int c = 0; c < 4; ++c) {
                C[c] = (f32x4){0.f, 0.f, 0.f, 0.f};
                bf16x8 a[4][4];
#pragma unroll
                for (int ts = 0; ts < 4; ++ts) { const unsigned sk = idxs[(4 * c + ts) * 16 + c16]; const bf16* kp = kbase + (size_t)sk * QLD;
#pragma unroll
                    for (int ks = 0; ks < 4; ++ks) a[ts][ks] = *(const bf16x8*)(kp + 32 * ks); }
#pragma unroll
                for (int ts = 0; ts < 4; ++ts)
#pragma unroll
                    for (int ks = 0; ks < 4; ++ks) C[c] = __builtin_amdgcn_mfma_f32_16x16x32_bf16(a[ts][ks], qm[ts][ks], C[c], 0, 0, 0);
            }
            const float bias2 = __builtin_amdgcn_exp2f(-(float)(g * 4 + r + 1)) * 1.4426950408889634f;
            float x[16]; float m = -INFINITY;
#pragma unroll
            for (int c = 0; c < 4; ++c) { const int k0 = (4 * c + ts_l) * 16 + 4 * kq; const u32x4 sp = *(const LAS u32x4*)(idxs + k0);
#pragma unroll
                for (int j = 0; j < 4; ++j) { const float v = (k0 + j < cnt) ? fmaf(C[c][j], CC, bias2 * (float)((int)sp[j] - t)) : -INFINITY; x[c * 4 + j] = v; m = fmaxf(m, v); } }
            m = fmaxf(m, __shfl_xor(m, 4)); m = fmaxf(m, __shfl_xor(m, 8)); m = fmaxf(m, __shfl_xor(m, 16)); m = fmaxf(m, __shfl_xor(m, 32));
            float sum = 0.f;
#pragma unroll
            for (int i = 0; i < 16; ++i) { x[i] = __builtin_amdgcn_exp2f(x[i] - m); sum += x[i]; }
            sum += __shfl_xor(sum, 4); sum += __shfl_xor(sum, 8); sum += __shfl_xor(sum, 16); sum += __shfl_xor(sum, 32);
            const float inv = 1.f / sum;
#pragma unroll
            for (int c = 0; c < 4; ++c) { const int k0 = (4 * c + ts_l) * 16 + 4 * kq;
#pragma unroll
                for (int j = 0; j < 4; ++j) pl[(k0 + j) * 4 + r] = x[c * 4 + j] * inv; }
            asm volatile("s_waitcnt lgkmcnt(0)" ::: "memory");
            float acc[4][8];
#pragma unroll
            for (int rr = 0; rr < 4; ++rr)
#pragma unroll
                for (int i = 0; i < 8; ++i) acc[rr][i] = 0.f;
            const bf16* vbase = qkvi + (size_t)b * SEQ * QLD + COL_V + g * HEAD_DIM + 8 * c16;
            const int nk4 = (cnt + 3) >> 2;
#pragma unroll 4
            for (int j4 = 0; j4 < nk4; ++j4) {
                const int key = 4 * j4 + kq; const unsigned sk = idxs[key];
                const u32x4 vv = *(const u32x4*)(vbase + (size_t)sk * QLD);
                const f32x4 pp = *(const LAS f32x4*)(pl + key * 4);
                const float vf[8] = {bflo(vv.x), bfhi(vv.x), bflo(vv.y), bfhi(vv.y), bflo(vv.z), bfhi(vv.z), bflo(vv.w), bfhi(vv.w)};
#pragma unroll
                for (int rr = 0; rr < 4; ++rr)
#pragma unroll
                    for (int i = 0; i < 8; ++i) acc[rr][i] = fmaf(pp[rr], vf[i], acc[rr][i]);
            }
#pragma unroll
            for (int rr = 0; rr < 4; ++rr)
#pragma unroll
                for (int i = 0; i < 8; ++i) { float v = acc[rr][i]; v += __shfl_xor(v, 16); v += __shfl_xor(v, 32); acc[rr][i] = v; }
            if (kq == 0) {
#pragma unroll
                for (int rr = 0; rr < 4; ++rr) { u32x4 o; o.x = cvt_pk_bf16(acc[rr][0], acc[rr][1]); o.y = cvt_pk_bf16(acc[rr][2], acc[rr][3]); o.z = cvt_pk_bf16(acc[rr][4], acc[rr][5]); o.w = cvt_pk_bf16(acc[rr][6], acc[rr][7]);
                    *(u32x4*)(attn + (size_t)tok * D_MODEL + (g * 4 + rr) * HEAD_DIM + 8 * c16) = o; }
            }
        }
    }
    (void)wq;
}


__device__ __forceinline__ int d2_swz(int i) { return ((i & 3) << 2) | ((i >> 2) & 3); }
__device__ __forceinline__ void phase_dsa_attn2(KP P, int L, LAS unsigned char* lds) {
    typedef short s16x4 __attribute__((ext_vector_type(4)));
    int tz = threadIdx.x; asm volatile("" : "+v"(tz)); const int tid = tz, lane = tid & 63, wave = __builtin_amdgcn_readfirstlane(tid >> 6);
    const bf16* qkvi = (const bf16*)(P->ws + WS_QKVI); const int* sel = (const int*)(P->ws + WS_SEL); bf16* attn = (bf16*)(P->ws + WS_ATTN);
    unsigned* qh = (unsigned*)(P->ws + WS_CTL) + CW_DQ + L * 8 * 64;
    LAS unsigned char* wl = lds + wave * 19456;
    LAS unsigned* idxs = (LAS unsigned*)wl;
    LAS unsigned char* pb = wl + 1024;
    LAS unsigned char* ring = wl + 3072;
    const int n16 = lane & 15, r = lane & 3, ts_l = n16 >> 2, kq = lane >> 4;
    const unsigned myq = xb_xcc_id() & 7u;
    constexpr float CC = 0.08838834764831845f * 1.4426950408889634f;
    unsigned dch[4];
#pragma unroll
    for (int j = 0; j < 4; ++j) dch[j] = (unsigned)((n16 ^ d2_swz(4 * j + kq)) * 16);
    unsigned aoff[4];
#pragma unroll
    for (int ks = 0; ks < 4; ++ks) aoff[ks] = (unsigned)(n16 * 256 + (((4 * ks + kq) ^ d2_swz(n16)) * 16));
    for (int qi = 0; qi < 8; ++qi) {
        const int qx = (int)((myq + (unsigned)qi) & 7u), b = qx >> 1, g = qx & 1;
        const char* kgb = (const char*)(qkvi + (size_t)b * SEQ * QLD + COL_K + g * HEAD_DIM);
        int item = 0;
        if (lane == 0) item = (int)__hip_atomic_fetch_add(qh + qx * 64, 1u, __ATOMIC_RELAXED, __HIP_MEMORY_SCOPE_AGENT);
        item = __builtin_amdgcn_readfirstlane(item);
        bool have_pf = false; int sx[4] = {0, 0, 0, 0}; bf16x8 qv[4] = {};
        while (item < SEQ) {
            const int t = SEQ - 1 - item, tok = b * SEQ + t, cnt = (t + 1 < TOPK) ? (t + 1) : TOPK;
            if (!have_pf) {
#pragma unroll
                for (int i = 0; i < 4; ++i) { const int j = lane + 64 * i; sx[i] = (t < TOPK) ? j : sel[(size_t)tok * TOPK + j]; }
                const bf16* qp = qkvi + (size_t)tok * QLD + (g * 4 + r) * HEAD_DIM + 8 * kq;
#pragma unroll
                for (int ks = 0; ks < 4; ++ks) qv[ks] = *(const bf16x8*)(qp + 32 * ks);
            }
#pragma unroll
            for (int i = 0; i < 4; ++i) { const int j = lane + 64 * i; idxs[j] = (j < cnt) ? (unsigned)sx[i] : 0u; }
            bf16x8 qm[4][4];
#pragma unroll
            for (int ks = 0; ks < 4; ++ks) {
#pragma unroll
                for (int ts = 0; ts < 4; ++ts) qm[ts][ks] = (ts_l == ts) ? qv[ks] : (bf16x8){0, 0, 0, 0, 0, 0, 0, 0}; }
            asm volatile("s_waitcnt vmcnt(0) lgkmcnt(0)" ::: "memory");
#define D2_ISSUE(s) do { const int kb_ = (s) & 15; const char* gb_ = kgb + ((s) >= 16 ? (COL_V - COL_K) * 2 : 0); LAS unsigned char* sl_ = ring + ((s) & 3) * 4096; \
        _Pragma("unroll") for (int j = 0; j < 4; ++j) { const unsigned sk_ = idxs[kb_ * 16 + 4 * j + kq]; \
            __builtin_amdgcn_global_load_lds((const unsigned*)(gb_ + (size_t)sk_ * (QLD * 2) + dch[j]), (LAS unsigned*)(sl_ + j * 1024), 16, 0, 0); } } while (0)
            int nraw = 0;
            if (lane == 0) nraw = (int)__hip_atomic_fetch_add(qh + qx * 64, 1u, __ATOMIC_RELAXED, __HIP_MEMORY_SCOPE_AGENT);
            D2_ISSUE(0); D2_ISSUE(1); D2_ISSUE(2); D2_ISSUE(3);
            f32x4 C[4];
#pragma unroll
            for (int c = 0; c < 4; ++c) C[c] = (f32x4){0.f, 0.f, 0.f, 0.f};
#pragma unroll
            for (int s2 = 0; s2 < 16; ++s2) {
                asm volatile("s_waitcnt vmcnt(12)" ::: "memory");
                LAS unsigned char* sl = ring + (s2 & 3) * 4096;
                bf16x8 a[4];
#pragma unroll
                for (int ks = 0; ks < 4; ++ks) a[ks] = *(const LAS bf16x8*)(sl + aoff[ks]);
#pragma unroll
                for (int ks = 0; ks < 4; ++ks) C[s2 >> 2] = __builtin_amdgcn_mfma_f32_16x16x32_bf16(a[ks], qm[s2 & 3][ks], C[s2 >> 2], 0, 0, 0);
                asm volatile("s_waitcnt lgkmcnt(0)" ::: "memory");
                D2_ISSUE(s2 + 4);
            }
            const float bias2 = __builtin_amdgcn_exp2f(-(float)(g * 4 + r + 1)) * 1.4426950408889634f;
            float x[16]; float m = -INFINITY;
#pragma unroll
            for (int c = 0; c < 4; ++c) { const int k0 = (4 * c + ts_l) * 16 + 4 * kq; const u32x4 sp = *(const LAS u32x4*)(idxs + k0);
#pragma unroll
                for (int j = 0; j < 4; ++j) { const float v = (k0 + j < cnt) ? fmaf(C[c][j], CC, bias2 * (float)((int)sp[j] - t)) : -INFINITY; x[c * 4 + j] = v; m = fmaxf(m, v); } }
            m = fmaxf(m, __shfl_xor(m, 4)); m = fmaxf(m, __shfl_xor(m, 8)); m = fmaxf(m, __shfl_xor(m, 16)); m = fmaxf(m, __shfl_xor(m, 32));
            float sum = 0.f;
#pragma unroll
            for (int i = 0; i < 16; ++i) { x[i] = __builtin_amdgcn_exp2f(x[i] - m); sum += x[i]; }
            sum += __shfl_xor(sum, 4); sum += __shfl_xor(sum, 8); sum += __shfl_xor(sum, 16); sum += __shfl_xor(sum, 32);
            const float inv = 1.f / sum;
#pragma unroll
            for (int c = 0; c < 4; ++c) { const int k0 = (4 * c + ts_l) * 16 + 4 * kq;
                u32x2 w; w.x = cvt_pk_bf16(x[c * 4 + 0] * inv, x[c * 4 + 1] * inv); w.y = cvt_pk_bf16(x[c * 4 + 2] * inv, x[c * 4 + 3] * inv);
                *(LAS u32x2*)(pb + (r * 256 + k0) * 2) = w; }
            asm volatile("s_waitcnt lgkmcnt(0)" ::: "memory");
            f32x4 O[8]; int nitem = SEQ;
#pragma unroll
            for (int db = 0; db < 8; ++db) O[db] = (f32x4){0.f, 0.f, 0.f, 0.f};
            const int q4 = n16 >> 2, p4 = n16 & 3;
#pragma unroll
            for (int u = 0; u < 8; ++u) {
                if (u < 7) asm volatile("s_waitcnt vmcnt(8)" ::: "memory"); else asm volatile("s_waitcnt vmcnt(0)" ::: "memory");
                LAS unsigned char* sl = ring + (((2 * u) & 3) + (kq >> 1)) * 4096;
                const bf16x8 pf = *(const LAS bf16x8*)(pb + (r * 256 + u * 32 + 8 * kq) * 2);
#pragma unroll
                for (int db = 0; db < 8; ++db) {
                    const int i0 = 8 * (kq & 1) + q4, i1 = i0 + 4;
                    const int a0 = (int)(unsigned)(uintptr_t)(sl + i0 * 256 + (((2 * db + (p4 >> 1)) ^ d2_swz(i0)) * 16) + 8 * (p4 & 1));
                    const int a1 = (int)(unsigned)(uintptr_t)(sl + i1 * 256 + (((2 * db + (p4 >> 1)) ^ d2_swz(i1)) * 16) + 8 * (p4 & 1));
                    const s16x4 v0 = mb::tr_read<0>(a0), v1 = mb::tr_read<0>(a1);
                    asm volatile("s_waitcnt lgkmcnt(0)" ::: "memory");
                    const bf16x8 vf = {v0[0], v0[1], v0[2], v0[3], v1[0], v1[1], v1[2], v1[3]};
                    O[db] = __builtin_amdgcn_mfma_f32_16x16x32_bf16(vf, pf, O[db], 0, 0, 0);
                }
                if (u == 0) {
                    nitem = __builtin_amdgcn_readfirstlane(nraw); have_pf = nitem < SEQ;
                    if (have_pf) { const int tn = SEQ - 1 - nitem, tokn = b * SEQ + tn;
#pragma unroll
                        for (int i = 0; i < 4; ++i) { const int j = lane + 64 * i; sx[i] = (tn < TOPK) ? j : sel[(size_t)tokn * TOPK + j]; }
                        const bf16* qpn = qkvi + (size_t)tokn * QLD + (g * 4 + r) * HEAD_DIM + 8 * kq;
#pragma unroll
                        for (int ks = 0; ks < 4; ++ks) qv[ks] = *(const bf16x8*)(qpn + 32 * ks); } }
                if (u < 6) { D2_ISSUE(16 + 2 * u + 4); D2_ISSUE(16 + 2 * u + 5); }
            }
#undef D2_ISSUE
            if (n16 < 4) {
                bf16* op = attn + (size_t)tok * D_MODEL + (g * 4 + n16) * HEAD_DIM + 4 * kq;
#pragma unroll
                for (int db = 0; db < 8; ++db) { u32x2 w; w.x = cvt_pk_bf16(O[db][0], O[db][1]); w.y = cvt_pk_bf16(O[db][2], O[db][3]); *(u32x2*)(op + 16 * db) = w; }
            }
            item = nitem;
        }
    }
}

__device__ __forceinline__ int opq(int x) { asm volatile("" : "+s"(x)); return x; }
__device__ __forceinline__ bool phase_active(int L, int k) {
    if (k >= 2 && k <= 6) { if (L < N_A) return k <= 3; if (k == 2) return L == N_A; }
    return k <= 14;
}
__global__ void __launch_bounds__(512, 2) fwd(Params P) {
    extern __shared__ __attribute__((aligned(16))) unsigned char lds_raw[];
    LAS unsigned char* lds = (LAS unsigned char*)lds_raw;
    const int tid = threadIdx.x;
    unsigned char* ws0 = P.ws;
    if (tid < 16) ((LAS unsigned*)(lds + LDS_MISC))[tid] = 0u;
    __syncthreads();
    const int lo = P.ph_lo, hi = P.ph_hi;
    const bool multi = (hi - lo) > 1;
    unsigned* barw = (unsigned*)(ws0 + WS_CTL) + CW_BAR + P.bar_idx * XCD_BAR_WORDS;
    XcdBarrier bar; bar.bar = barw; bar.x = 0; bar.st = nullptr;
    if (multi) bar = xcd_barrier_post(barw, (volatile LAS unsigned*)(lds + LDS_MISC));
#ifndef PHASE_MASK
#define PHASE_MASK 0xFFFF
#endif
#define IN(k) (((PHASE_MASK >> (k)) & 1) && opq(lo) <= (pb + (k)) && (pb + (k)) < hi && phase_active(L, (k)))
#define SEAM(k) do { if (IN(k) && (pb + (k) + 1) < hi) xcd_barrier(bar); } while (0)
#ifndef PROBE_MASK
#define PROBE_MASK 0
#endif
#define PROBED(k) (((PROBE_MASK) >> (k)) & 1)
    const int G = gridDim.x, c = blockIdx.x;
    for (int L = 0; L < DEPTH; ++L) {
        const int pb = L * 16;
        if (pb + 16 <= lo || pb >= hi) continue;
        const bool isA = L < N_A;
        if (IN(0)) { for (int rep = PROBED(0) ? 0 : 1; rep < 2; ++rep) { phase_convert(fresh_params(), L, lds); if (rep == 0) xcd_barrier(bar); } } SEAM(0);
        if (IN(1)) { for (int rep = PROBED(1) ? 0 : 1; rep < 2; ++rep) {
            KP Q = fresh_params(); unsigned char* ws = Q->ws; bf16* hb = (bf16*)(ws + WS_HB);
            if (isA) {
                gm::DenseOrder S; S.init(hb, ws + WS_WMIX, NTOK, 2048, D_MODEL, G, c);
                gm::EpiBf16 E{(bf16*)(ws + WS_QKVI), QLD, (float*)(ws + WS_IW)};
                gm::gemm_phase<gm::EpiBf16, gm::DenseOrder, false>(lds, D_MODEL, S, E);
            } else {
                if (L == N_A) {
                    gm::DenseOrder S; S.init(hb, ws + WS_WMIX + 6 * MiB, NTOK, 512, D_MODEL, G, c);
                    gm::EpiBf16 E{(bf16*)(ws + WS_KV), 512, nullptr};
                    gm::gemm_phase<gm::EpiBf16, gm::DenseOrder, false>(lds, D_MODEL, S, E);
                }
                gm::DenseOrder S; S.init(hb, ws + WS_WMIX, NTOK, D_MODEL, D_MODEL, G, c);
                gm::EpiBf16 E{(bf16*)(ws + WS_QKVI), D_MODEL, nullptr};
                gm::gemm_phase<gm::EpiBf16, gm::DenseOrder, false>(lds, D_MODEL, S, E);
            }
            if (rep == 0) xcd_barrier(bar);
        } } SEAM(1);
        if (IN(2)) { if (isA) { if (PROBED(2)) { phase_dsa_topk<D1_EXP>(fresh_params(), lds, WS_PL); xcd_barrier(bar); } phase_dsa_topk<0>(fresh_params(), lds, WS_SEL); } else phase_kmeans(fresh_params()); } SEAM(2);
        if (IN(3)) { if (isA) { for (int rep = PROBED(3) ? 0 : 1; rep < 2; ++rep) { phase_dsa_attn2(fresh_params(), rep == 0 ? L + 2 : L, lds); if (rep == 0) xcd_barrier(bar); } } else { for (int rep = PROBED(4) ? 0 : 1; rep < 2; ++rep) { phase_moba_gate2(fresh_params()); if (rep == 0) xcd_barrier(bar); } } } SEAM(3);
        if (IN(4)) { phase_moba_lists(fresh_params(), lds); } SEAM(4);
        if (IN(5)) { for (int rep = PROBED(5) ? 0 : 1; rep < 2; ++rep) { phase_moba_attn2(fresh_params(), (L - N_A) * 2 + rep, lds); if (rep == 0) xcd_barrier(bar); } } SEAM(5);
        if (IN(6)) { for (int rep = PROBED(6) ? 0 : 1; rep < 2; ++rep) { phase_moba_combine(fresh_params()); if (rep == 0) xcd_barrier(bar); } } SEAM(6);
        if (IN(7)) { for (int rep = PROBED(7) ? 0 : 1; rep < 2; ++rep) {
            KP Q = fresh_params(); unsigned char* ws = Q->ws; const float* hres = (L == 0) ? Q->in[0] : (const float*)(ws + WS_H); _Float16* t = (_Float16*)(ws + WS_T);
            { gm::DenseOrder S; S.init(ws + WS_ATTN, ws + WS_WMIX + 4 * MiB, NTOK, D_MODEL, D_MODEL, G, c);
              gm::EpiResid E{hres, t};
              gm::gemm_phase<gm::EpiResid, gm::DenseOrder, false>(lds, D_MODEL, S, E); }
            { gm::DenseOrder S; S.init(ws + WS_PB, ws + WS_WPLE, NTOK, D_MODEL, PLE_DIM, G, c);
              gm::EpiBf16 E{(bf16*)(ws + WS_PL), D_MODEL, nullptr};
              gm::gemm_phase<gm::EpiBf16, gm::DenseOrder, false>(lds, PLE_DIM, S, E); }
            if (rep == 0) xcd_barrier(bar);
        } } SEAM(7);
        if (IN(8)) { for (int rep = PROBED(8) ? 0 : 1; rep < 2; ++rep) { phase_ln_router(fresh_params(), L, lds, rep == 0 ? L + 4 : L); if (rep == 0) xcd_barrier(bar); } } SEAM(8);
        if (IN(9)) { phase_moe_prep(fresh_params(), L, lds); } SEAM(9);
        if (IN(10)) { for (int rep = PROBED(10) ? 0 : 1; rep < 2; ++rep) {
            KP Q = fresh_params(); unsigned char* ws = Q->ws; bf16* hb = (bf16*)(ws + WS_HB);
            const int* moe = (const int*)(ws + WS_MOE);
            gm::MoeOrder S; S.tile_e = moe + MO_TILE_E; S.tile_row0 = moe + MO_TILE_ROW0; S.tile_nv = moe + MO_TILE_NV; S.slot_tok = moe + MO_SLOT_TOK;
            S.n_units = (int)*((const unsigned*)(ws + WS_CTL) + CW_NTILES + L) * 4; S.G = G; S.c = c; S.K = D_MODEL; S.A = (const char*)hb; S.W = (const char*)(ws + WS_WGU);
            S.wstride = (size_t)D_MODEL * D_MODEL * 2; S.tB = (size_t)256 * D_MODEL * 2; S.gath = true;
            gm::EpiSwiglu E{(bf16*)(ws + WS_ACT)};
            gm::gemm_phase<gm::EpiSwiglu, gm::MoeOrder, true>(lds, D_MODEL, S, E);
            if (rep == 0) xcd_barrier(bar);
        } } SEAM(10);
        if (IN(11)) { for (int rep = PROBED(11) ? 0 : 1; rep < 2; ++rep) {
            KP Q = fresh_params(); unsigned char* ws = Q->ws;
            const int* moe = (const int*)(ws + WS_MOE);
            gm::MoeOrder S; S.tile_e = moe + MO_TILE_E; S.tile_row0 = moe + MO_TILE_ROW0; S.tile_nv = moe + MO_TILE_NV; S.slot_tok = moe + MO_SLOT_TOK;
            S.n_units = (int)*((const unsigned*)(ws + WS_CTL) + CW_NTILES + L) * 4; S.G = G; S.c = c; S.K = D_EXPERT; S.A = (const char*)(ws + WS_ACT); S.W = (const char*)(ws + WS_WD);
            S.wstride = (size_t)D_MODEL * D_EXPERT * 2; S.tB = (size_t)256 * D_EXPERT * 2; S.gath = false;
            gm::EpiMoeDown E{(bf16*)(ws + WS_Y)};
            gm::gemm_phase<gm::EpiMoeDown, gm::MoeOrder, false>(lds, D_EXPERT, S, E);
            if (rep == 0) xcd_barrier(bar);
        } } SEAM(11);
        if (IN(12)) { KP Q = fresh_params(); phase_ln<1, false>(Q, L, 1, lds, (float*)(Q->ws + WS_H), true); } SEAM(12);
        if (IN(13)) { for (int rep = PROBED(13) ? 0 : 1; rep < 2; ++rep) {
            KP Q = fresh_params(); unsigned char* ws = Q->ws; bf16* hb = (bf16*)(ws + WS_HB); float* h = (float*)(ws + WS_H); _Float16* t = (_Float16*)(ws + WS_T);
            gm::DenseOrder S; S.init(hb, ws + WS_WPG, NTOK, D_MODEL, D_MODEL, G, c);
            gm::EpiPle E{h, (const bf16*)(ws + WS_PL), t};
            gm::gemm_phase<gm::EpiPle, gm::DenseOrder, false>(lds, D_MODEL, S, E);
            if (rep == 0) xcd_barrier(bar);
        } } SEAM(13);
        if (IN(14)) { for (int rep = PROBED(14) ? 0 : 1; rep < 2; ++rep) { KP Q = fresh_params(); phase_ln<0, false>(Q, L, 2, lds, (L == DEPTH - 1) ? Q->out : (float*)(Q->ws + WS_H), L != DEPTH - 1); if (rep == 0) xcd_barrier(bar); } }
        if (L != DEPTH - 1) SEAM(14);
    }
#undef IN
#undef SEAM
}

#ifndef DEBUG_ATTN
#define DEBUG_ATTN 0
#endif
#if DEBUG_ATTN
__global__ void __launch_bounds__(256) dsa_scores(const bf16* __restrict__ qkvi  , const float* __restrict__ iw  , float* __restrict__ sc) {
    const int s0 = blockIdx.x * 64, t0 = blockIdx.y * 64;
    if (s0 > t0) return;
    __shared__ float Qs[64][68];
    __shared__ float Ks[64][68];
    const int tid = threadIdx.x, r = tid >> 2, kq = (tid & 3) * 16;
    {
        const bf16* kp = qkvi + (size_t)(s0 + r) * QLD + COL_IK + kq;
#pragma unroll
        for (int i = 0; i < 16; ++i) Ks[kq + i][r] = bf2f(kp[i]);
    }
    const int ty = tid >> 4, tx = tid & 15;
    float tot[4][4];
#pragma unroll
    for (int i = 0; i < 4; ++i)
#pragma unroll
        for (int j = 0; j < 4; ++j) tot[i][j] = 0.f;
    for (int hh = 0; hh < IDX_HEADS; ++hh) {
        __syncthreads();
        const bf16* qp = qkvi + (size_t)(t0 + r) * QLD + COL_IQ + hh * IDX_DIM + kq;
#pragma unroll
        for (int i = 0; i < 16; ++i) Qs[kq + i][r] = bf2f(qp[i]);
        __syncthreads();
        float acc[4][4];
#pragma unroll
        for (int i = 0; i < 4; ++i)
#pragma unroll
            for (int j = 0; j < 4; ++j) acc[i][j] = 0.f;
#pragma unroll 8
        for (int k = 0; k < 64; ++k) {
            const float4 a4 = *(const float4*)&Qs[k][ty * 4];
            const float4 b4 = *(const float4*)&Ks[k][tx * 4];
            const float a[4] = {a4.x, a4.y, a4.z, a4.w};
            const float b[4] = {b4.x, b4.y, b4.z, b4.w};
#pragma unroll
            for (int i = 0; i < 4; ++i)
#pragma unroll
                for (int j = 0; j < 4; ++j) acc[i][j] += a[i] * b[j];
        }
#pragma unroll
        for (int i = 0; i < 4; ++i) {
            const float w = iw[(size_t)(t0 + ty * 4 + i) * 4 + hh];
#pragma unroll
            for (int j = 0; j < 4; ++j) tot[i][j] += w * fmaxf(acc[i][j], 0.f);
        }
    }
#pragma unroll
    for (int i = 0; i < 4; ++i)
        *(float4*)(sc + (size_t)(t0 + ty * 4 + i) * SEQ + s0 + tx * 4) = make_float4(tot[i][0], tot[i][1], tot[i][2], tot[i][3]);
}

__device__ __forceinline__ unsigned fkey(float f) { const unsigned u = __float_as_uint(f); return (u & 0x80000000u) ? ~u : (u | 0x80000000u); }
__global__ void __launch_bounds__(256) dsa_topk(const float* __restrict__ sc, int* __restrict__ sel) {
    const int t = blockIdx.x, tid = threadIdx.x, n = t + 1;
    int* out = sel + (size_t)t * TOPK;
    if (n <= TOPK) { out[tid] = tid <= t ? tid : 0; return; }
    const float* row = sc + (size_t)t * SEQ;
    __shared__ unsigned hist[256];
    __shared__ unsigned s_prefix, s_need;
    __shared__ int wsum[2][4];
    unsigned prefix = 0, need = TOPK;
    for (int pass = 3; pass >= 0; --pass) {
        hist[tid] = 0;
        __syncthreads();
        for (int i = tid; i < n; i += 256) {
            const unsigned k = fkey(row[i]);
            const bool match = (pass == 3) ? true : ((k >> (8 * (pass + 1))) == prefix);
            if (match) atomicAdd(&hist[(k >> (8 * pass)) & 255u], 1u);
        }
        __syncthreads();
        if (tid == 0) {
            unsigned c = 0; int d = 255;
            for (; d > 0; --d) { if (c + hist[d] >= need) break; c += hist[d]; }
            s_prefix = (prefix << 8) | (unsigned)d; s_need = need - c;
        }
        __syncthreads();
        prefix = s_prefix; need = s_need;
        __syncthreads();
    }
    const unsigned T = prefix;
    const int n_gt = TOPK - (int)need;
    int run_gt = 0, run_eq = 0;
    const int lane = tid & 63, w = tid >> 6;
    for (int base = 0; base < n; base += 256) {
        const int i = base + tid;
        unsigned k = 0; bool gt = false, eq = false;
        if (i < n) { k = fkey(row[i]); gt = k > T; eq = k == T; }
        const unsigned long long mg = __ballot(gt), me = __ballot(eq);
        const unsigned long long lower = (lane == 0) ? 0ull : (~0ull >> (64 - lane));
        const int pg = __popcll(mg & lower), pe = __popcll(me & lower);
        if (lane == 0) { wsum[0][w] = __popcll(mg); wsum[1][w] = __popcll(me); }
        __syncthreads();
        int og = 0, oe = 0, tg = 0, te = 0;
        for (int x = 0; x < 4; ++x) { if (x < w) { og += wsum[0][x]; oe += wsum[1][x]; } tg += wsum[0][x]; te += wsum[1][x]; }
        if (gt) out[run_gt + og + pg] = i;
        if (eq) { const int rk = run_eq + oe + pe; if (rk < (int)need) out[n_gt + rk] = i; }
        run_gt += tg; run_eq += te;
        __syncthreads();
    }
}

__global__ void __launch_bounds__(256) dsa_attn(const bf16* __restrict__ qkvi, const int* __restrict__ sel, bf16* __restrict__ attn) {
    const int tok = blockIdx.x, b = tok / SEQ, t = tok % SEQ, tid = threadIdx.x;
    __shared__ float qs[D_MODEL];
    __shared__ float lg[N_HEADS][TOPK];
    __shared__ int sidx[TOPK];
    const int cnt = (t + 1 < TOPK) ? (t + 1) : TOPK;
    const bf16* prow = qkvi + (size_t)tok * QLD;
#pragma unroll
    for (int i = 0; i < 4; ++i) qs[tid * 4 + i] = bf2f(prow[tid * 4 + i]);
    int s = 0;
    if (tid < cnt) s = (t < TOPK) ? tid : sel[(size_t)tok * TOPK + tid];
    sidx[tid] = s;
    __syncthreads();
    const float scale = 0.08838834764831845f;
    if (tid < cnt) {
        const bf16* krow = qkvi + (size_t)(b * SEQ + s) * QLD + COL_K;
        for (int g = 0; g < N_KV; ++g) {
            float d[4] = {0.f, 0.f, 0.f, 0.f};
            for (int k = 0; k < HEAD_DIM; ++k) {
                const float kv = bf2f(krow[g * HEAD_DIM + k]);
#pragma unroll
                for (int r = 0; r < 4; ++r) d[r] += qs[(g * 4 + r) * HEAD_DIM + k] * kv;
            }
#pragma unroll
            for (int r = 0; r < 4; ++r) {
                const int hh = g * 4 + r;
                const float slope = exp2f(-(float)(hh + 1));
                lg[hh][tid] = d[r] * scale - slope * (float)(t - s);
            }
        }
    } else {
        for (int hh = 0; hh < N_HEADS; ++hh) lg[hh][tid] = -INFINITY;
    }
    __syncthreads();
    {
        const int lane = tid & 63, w = tid >> 6;
        for (int h2 = 0; h2 < 2; ++h2) {
            const int hh = w * 2 + h2;
            float v[4], m = -INFINITY;
#pragma unroll
            for (int i = 0; i < 4; ++i) { v[i] = lg[hh][lane + 64 * i]; m = fmaxf(m, v[i]); }
            for (int o = 32; o > 0; o >>= 1) m = fmaxf(m, __shfl_xor(m, o));
            float sum = 0.f;
#pragma unroll
            for (int i = 0; i < 4; ++i) { v[i] = expf(v[i] - m); sum += v[i]; }
            for (int o = 32; o > 0; o >>= 1) sum += __shfl_xor(sum, o);
            const float inv = 1.f / sum;
#pragma unroll
            for (int i = 0; i < 4; ++i) lg[hh][lane + 64 * i] = v[i] * inv;
        }
    }
    __syncthreads();
    {
        const int col = tid * 4, hh = col / HEAD_DIM, g = hh / HEAD_GROUP, d = col % HEAD_DIM;
        float acc[4] = {0.f, 0.f, 0.f, 0.f};
        for (int j = 0; j < cnt; ++j) {
            const float p = lg[hh][j];
            const u32x2 vv = *(const u32x2*)(qkvi + (size_t)(b * SEQ + sidx[j]) * QLD + COL_V + g * HEAD_DIM + d);
            acc[0] += p * bflo(vv.x); acc[1] += p * bfhi(vv.x); acc[2] += p * bflo(vv.y); acc[3] += p * bfhi(vv.y);
        }
        u32x2 o; o.x = cvt_pk_bf16(acc[0], acc[1]); o.y = cvt_pk_bf16(acc[2], acc[3]);
        *(u32x2*)(attn + (size_t)tok * D_MODEL + col) = o;
    }
}

__global__ void __launch_bounds__(128) kmeans_kernel(const bf16* __restrict__ kv, float* __restrict__ km) {
    const int blk = blockIdx.x % N_BLOCKS, g = (blockIdx.x / N_BLOCKS) % N_KV, b = blockIdx.x / (N_BLOCKS * N_KV), d = threadIdx.x;
    float s = 0.f;
    for (int i = 0; i < MOBA_BLOCK; ++i) s += bf2f(kv[(size_t)(b * SEQ + blk * MOBA_BLOCK + i) * 512 + g * HEAD_DIM + d]);
    km[((size_t)(b * N_KV + g) * N_BLOCKS + blk) * HEAD_DIM + d] = s * (1.f / MOBA_BLOCK);
}

__global__ void __launch_bounds__(256) moba_attn(const bf16* __restrict__ q, const bf16* __restrict__ kv, const float* __restrict__ km, bf16* __restrict__ attn) {
    const int tok = blockIdx.x, b = tok / SEQ, t = tok % SEQ, tid = threadIdx.x, own = t / MOBA_BLOCK;
    __shared__ float qs[HEAD_DIM];
    __shared__ float gate[N_BLOCKS];
    __shared__ int selb[3];
    __shared__ float lg[4 * MOBA_BLOCK];
    __shared__ float red[8];
    __shared__ float part[2][HEAD_DIM];
    const float scale = 0.08838834764831845f;
    for (int hh = 0; hh < N_HEADS; ++hh) {
        const int g = hh / HEAD_GROUP;
        const float slope = exp2f(-(float)(hh + 1));
        __syncthreads();
        if (tid < HEAD_DIM) qs[tid] = bf2f(q[(size_t)tok * D_MODEL + hh * HEAD_DIM + tid]);
        __syncthreads();
        if (tid < N_BLOCKS) {
            float gval = -INFINITY;
            if (tid < own) {
                const float* kp = km + ((size_t)(b * N_KV + g) * N_BLOCKS + tid) * HEAD_DIM;
                float s = 0.f;
                for (int k = 0; k < HEAD_DIM; ++k) s += qs[k] * kp[k];
                gval = s;
            }
            gate[tid] = gval;
        }
        __syncthreads();
        if (tid == 0) {
            unsigned used = 0u;
            for (int s = 0; s < 3; ++s) {
                int best = -1; float bv = 0.f;
                for (int j = 0; j < N_BLOCKS; ++j) if (!((used >> j) & 1u) && (best < 0 || gate[j] > bv)) { best = j; bv = gate[j]; }
                used |= 1u << best; selb[s] = best;
            }
        }
        __syncthreads();
        for (int s = 0; s < 4; ++s) {
            const int blk = (s < 3) ? selb[s] : own;
            const int kpos = blk * MOBA_BLOCK + tid;
            const bool valid = (s < 3) ? (blk < own) : (kpos <= t);
            float v = -INFINITY;
            if (valid) {
                const bf16* kp = kv + (size_t)(b * SEQ + kpos) * 512 + g * HEAD_DIM;
                float d = 0.f;
                for (int k = 0; k < HEAD_DIM; ++k) d += qs[k] * bf2f(kp[k]);
                v = d * scale - slope * (float)(t - kpos);
            }
            lg[s * MOBA_BLOCK + tid] = v;
        }
        __syncthreads();
        float m = fmaxf(fmaxf(lg[tid], lg[256 + tid]), fmaxf(lg[512 + tid], lg[768 + tid]));
        for (int o = 32; o > 0; o >>= 1) m = fmaxf(m, __shfl_xor(m, o));
        if ((tid & 63) == 0) red[tid >> 6] = m;
        __syncthreads();
        m = fmaxf(fmaxf(red[0], red[1]), fmaxf(red[2], red[3]));
        float e[4], sum = 0.f;
#pragma unroll
        for (int i = 0; i < 4; ++i) { e[i] = expf(lg[i * 256 + tid] - m); sum += e[i]; }
        for (int o = 32; o > 0; o >>= 1) sum += __shfl_xor(sum, o);
        if ((tid & 63) == 0) red[4 + (tid >> 6)] = sum;
        __syncthreads();
        const float inv = 1.f / (red[4] + red[5] + red[6] + red[7]);
#pragma unroll
        for (int i = 0; i < 4; ++i) lg[i * 256 + tid] = e[i] * inv;
        __syncthreads();
        {
            const int d = tid & 127, half = tid >> 7;
            float acc = 0.f;
            for (int s = 0; s < 4; ++s) {
                const int blk = (s < 3) ? selb[s] : own;
                const bool bvalid = (s < 3) ? (blk < own) : true;
                if (!bvalid) continue;
                const bf16* vp = kv + (size_t)(b * SEQ + blk * MOBA_BLOCK + half * 128) * 512 + KV_DIM + g * HEAD_DIM + d;
                const float* pp = lg + s * MOBA_BLOCK + half * 128;
                for (int j = 0; j < 128; ++j) { const float p = pp[j]; if (p != 0.f) acc += p * bf2f(vp[(size_t)j * 512]); }
            }
            part[half][d] = acc;
        }
        __syncthreads();
        if (tid < HEAD_DIM) attn[(size_t)tok * D_MODEL + hh * HEAD_DIM + tid] = (bf16)(cvt_pk_bf16(part[0][tid] + part[1][tid], 0.f) & 0xffffu);
    }
}


#endif
#ifndef DEBUG_ATTN
#define DEBUG_ATTN 0
#endif
#if DEBUG_ATTN
__global__ void dbg_compare(const bf16* __restrict__ a, const bf16* __restrict__ ref, size_t n, float* __restrict__ acc) {
    float d2 = 0.f, r2 = 0.f;
    for (size_t i = (size_t)blockIdx.x * blockDim.x + threadIdx.x; i < n; i += (size_t)gridDim.x * blockDim.x) { const float x = bf2f(a[i]), y = bf2f(ref[i]); d2 += (x - y) * (x - y); r2 += y * y; }
    d2 = wave_sum(d2); r2 = wave_sum(r2);
    if ((threadIdx.x & 63) == 0) { atomicAdd(&acc[0], d2); atomicAdd(&acc[1], r2); }
}
__global__ void dbg_scale(float* __restrict__ out, size_t n, const float* __restrict__ acc) {
    const float rv = acc[0] / fmaxf(acc[1], 1e-30f);
    float e = sqrtf(fminf(rv * 100.f, 4.f)); if (!(rv == rv)) e = 3.f;
    for (size_t i = (size_t)blockIdx.x * blockDim.x + threadIdx.x; i < n; i += (size_t)gridDim.x * blockDim.x) out[i] *= (1.f + e);
}
#endif

extern "C" void kernel_launch(void* const* d_in, const int* in_sizes, int n_in, void* d_out, int out_size, void* d_ws, size_t ws_size, hipStream_t stream) {
    static int grid = 0;
    if (grid == 0) {
        int dev = 0, cus = 0;
        (void)hipGetDevice(&dev); (void)hipDeviceGetAttribute(&cus, hipDeviceAttributeMultiprocessorCount, dev);
        (void)hipFuncSetAttribute((const void*)fwd, hipFuncAttributeMaxDynamicSharedMemorySize, LDS_BYTES);
        grid = cus > 0 ? cus : 256;
    }
    unsigned char* ws = (unsigned char*)d_ws;
    (void)hipMemsetAsync(ws + WS_CTL, 0, CTL_ZERO_BYTES, stream);
    Params P{};
    for (int i = 0; i < 18; ++i) P.in[i] = (const float*)d_in[i];
    P.out = (float*)d_out; P.ws = ws;
    int nlaunch = 0;
    auto run = [&](int lo, int hi) { P.ph_lo = lo; P.ph_hi = hi; P.bar_idx = nlaunch++; hipLaunchKernelGGL(fwd, dim3(grid), dim3(512), LDS_BYTES, stream, P); };
#if DEBUG_ATTN
    const bf16* qkvi = (const bf16*)(ws + WS_QKVI); bf16* attn = (bf16*)(ws + WS_ATTN); int* sel = (int*)(ws + WS_SEL);
    float* scores = (float*)(ws + WS_SCORES); const float* iw = (const float*)(ws + WS_IW); const bf16* kvb = (const bf16*)(ws + WS_KV); float* km = (float*)(ws + WS_KM);
#endif
#if DEBUG_ATTN == 0
    run(0, DEPTH * 16);
#else
    for (int L = 0; L < DEPTH; ++L) {
        const int pb = L * 16;
        if (L < N_A) {
#if DEBUG_ATTN == 4
            if (L == 1) {
                run(pb + 0, pb + 3);
                bf16* attn2 = (bf16*)(ws + WS_PL);
                dsa_attn<<<NTOK, 256, 0, stream>>>(qkvi, sel, attn2);
                run(pb + 3, pb + 4);
                dbg_compare<<<1024, 256, 0, stream>>>(attn, attn2, (size_t)NTOK * D_MODEL, (float*)(ws + WS_CTL) + 1024);
                run(pb + 7, pb + 15);
            } else
#endif
#if DEBUG_ATTN == 3
            if (L == 1) {
                run(pb + 0, pb + 2);
                bf16* attn2 = (bf16*)(ws + WS_PL);
                for (int b = 0; b < BATCH; ++b) {
                    dsa_scores<<<dim3(SEQ / 64, SEQ / 64), 256, 0, stream>>>(qkvi + (size_t)b * SEQ * QLD, iw + (size_t)b * SEQ * 4, scores);
                    dsa_topk<<<SEQ, 256, 0, stream>>>(scores, sel + (size_t)b * SEQ * TOPK);
                }
                dsa_attn<<<NTOK, 256, 0, stream>>>(qkvi, sel, attn2);
                run(pb + 2, pb + 4);
                dbg_compare<<<1024, 256, 0, stream>>>(attn, attn2, (size_t)NTOK * D_MODEL, (float*)(ws + WS_CTL) + 1024);
                run(pb + 7, pb + 15);
            } else
#endif
            { run(pb + 0, pb + 4); run(pb + 7, pb + 15); }
        } else {
            run(pb + 0, pb + 7);
#if DEBUG_ATTN == 1
            if (L == N_A) {
                bf16* attn2 = (bf16*)(ws + WS_PL);
                kmeans_kernel<<<BATCH * N_KV * N_BLOCKS, 128, 0, stream>>>(kvb, km + 65536);
                moba_attn<<<NTOK, 256, 0, stream>>>(qkvi, kvb, km + 65536, attn2);
                dbg_compare<<<1024, 256, 0, stream>>>(attn, attn2, (size_t)NTOK * D_MODEL, (float*)(ws + WS_CTL) + 1024);
            }
#endif
            run(pb + 7, pb + 15);
        }
    }
#endif
#if DEBUG_ATTN
    dbg_scale<<<1024, 256, 0, stream>>>((float*)d_out, (size_t)NTOK * D_MODEL, (const float*)(ws + WS_CTL) + 1024);
#endif
}
```

```cpp
#include <hip/hip_runtime.h>
#include <stdint.h>

#define D_MODEL 1024
#define BATCH 4
#define SEQ 8192
#define NTOK (BATCH * SEQ)
#define DEPTH 4
#define N_A 2
#define N_HEADS 8
#define HEAD_DIM 128
#define N_KV 2
#define HEAD_GROUP 4
#define KV_DIM 256
#define IDX_HEADS 4
#define IDX_DIM 64
#define TOPK 256
#define MOBA_BLOCK 256
#define N_BLOCKS 32
#define N_GROUPS 4
#define EPG 8
#define N_EXPERTS 32
#define D_EXPERT 512
#define PLE_DIM 256
#define A_COLS 1860
#define QLD 2048
#define COL_K 1024
#define COL_V 1280
#define COL_IQ 1536
#define COL_IK 1792
#define COL_IW 1856
#define ALPHA_F 1.6817928305074290f
#define LN_EPS 1e-5f
#define MAX_SLOTS (65536 + 8192)
#define MAX_MTILES (MAX_SLOTS / 256)

#define LAS __attribute__((address_space(3)))
#define GAS __attribute__((address_space(1)))
typedef unsigned short bf16;
typedef short bf16x8 __attribute__((ext_vector_type(8)));
typedef float f32x4 __attribute__((ext_vector_type(4)));
typedef float f32x2 __attribute__((ext_vector_type(2)));
typedef unsigned u32x4 __attribute__((ext_vector_type(4)));
typedef unsigned u32x2 __attribute__((ext_vector_type(2)));
typedef _Float16 f16x4 __attribute__((ext_vector_type(4)));

__device__ __forceinline__ unsigned cvt_pk_bf16(float lo, float hi) { unsigned r; asm("v_cvt_pk_bf16_f32 %0, %1, %2" : "=v"(r) : "v"(lo), "v"(hi)); return r; }
__device__ __forceinline__ float bf2f(bf16 b) { return __uint_as_float(((unsigned)b) << 16); }
__device__ __forceinline__ float bflo(unsigned u) { return __uint_as_float(u << 16); }
__device__ __forceinline__ float bfhi(unsigned u) { return __uint_as_float(u & 0xffff0000u); }
template <int CTRL> __device__ __forceinline__ float dpp_add(float v) { return v + __int_as_float(__builtin_amdgcn_update_dpp(0, __float_as_int(v), CTRL, 0xF, 0xF, false)); }
__device__ __forceinline__ float row16_sum(float v) {
    v = dpp_add<0xB1>(v); v = dpp_add<0x4E>(v); v = dpp_add<0x141>(v); v = dpp_add<0x140>(v); return v;
}
__device__ __forceinline__ float wave_sum(float v) { v = row16_sum(v); v += __shfl_xor(v, 16); v += __shfl_xor(v, 32); return v; }

constexpr size_t MiB = 1u << 20;
constexpr size_t WS_CTL = 0, CTL_ZERO_BYTES = 1 * MiB;
constexpr size_t WS_WMIX = 2 * MiB;
constexpr size_t WS_WPG = 10 * MiB;
constexpr size_t WS_WPLE = 12 * MiB;
constexpr size_t WS_WGU = 16 * MiB;
constexpr size_t WS_WD = 80 * MiB;
constexpr size_t WS_PB = 112 * MiB;
constexpr size_t WS_H = 128 * MiB;
constexpr size_t WS_HB = 256 * MiB;
constexpr size_t WS_T = 320 * MiB;
constexpr size_t WS_KV = 448 * MiB;
constexpr size_t WS_PL = 480 * MiB;
constexpr size_t WS_QKVI = 544 * MiB;
constexpr size_t WS_ATTN = 672 * MiB;
constexpr size_t WS_SEL = 736 * MiB;
constexpr size_t WS_ACT = 544 * MiB;
constexpr size_t WS_Y = 616 * MiB;
constexpr size_t WS_MOE = 768 * MiB;
constexpr size_t WS_IW = 770 * MiB;
constexpr size_t WS_KM = 771 * MiB;
constexpr size_t WS_SCORES = 772 * MiB;
constexpr int MO_TOK_E = 0, MO_TOK_POS = NTOK * 2, MO_TOK_SLOT = NTOK * 4, MO_TOK_W = NTOK * 6, MO_SLOT_TOK = NTOK * 8, MO_TILE_E = MO_SLOT_TOK + MAX_SLOTS, MO_TILE_ROW0 = MO_TILE_E + 512, MO_TILE_NV = MO_TILE_ROW0 + 512;
constexpr int CW_BAR = 65536;
constexpr int CW_CNT = 16384;
constexpr int CW_NTILES = 16384 + 256;

constexpr int LDS_BYTES = 163840;
constexpr int LDS_MISC = 163840 - 256;
constexpr int NWAVES = 8;

#define XB_TMO      128
#define XB_XCNT(j)  (256  + 64 * (j))
#define XB_XSUB(j)  (1280 + 64 * (j))
#define XB_XGEN(j)  (2304 + 64 * (j))
#define XB_TOP      3328
#define XB_TOPGEN   3392
#define XCD_BAR_WORDS 3456
#define XB_SPIN_CAP (1u << 22)
__device__ __forceinline__ unsigned xb_ld(unsigned* p)              { return __hip_atomic_load(p, __ATOMIC_RELAXED, __HIP_MEMORY_SCOPE_AGENT); }
__device__ __forceinline__ unsigned xb_add(unsigned* p, unsigned v) { return __hip_atomic_fetch_add(p, v, __ATOMIC_RELAXED, __HIP_MEMORY_SCOPE_AGENT); }
__device__ __forceinline__ unsigned xb_xcc_id() { return (unsigned)__builtin_amdgcn_s_getreg((3 << 11) | 20) & 0xFu; }
#define XB_SPIN(cond, bar) do { unsigned _sp = 0; while (cond) { __builtin_amdgcn_s_sleep(1); \
    if ((++_sp & 255u) == 0u) { if (xb_ld(&(bar)[XB_TMO])) break; if (_sp > XB_SPIN_CAP) { atomicAdd(&(bar)[XB_TMO], 1u); break; } } } } while (0)
struct XcdBarrier { unsigned* bar; unsigned x; volatile LAS unsigned* st; };
__device__ __forceinline__ XcdBarrier xcd_barrier_post(unsigned* bar, volatile LAS unsigned* st) {
    XcdBarrier b; b.bar = bar; b.x = xb_xcc_id(); b.st = st;
    if (threadIdx.x == 0) (void)xb_add(&bar[XB_XCNT(b.x)], 1u);
    return b;
}
__device__ __forceinline__ void xcd_barrier_complete(unsigned* bar, unsigned x, unsigned& nloc, unsigned& nx) {
    const unsigned G = gridDim.x * gridDim.y * gridDim.z;
    unsigned sum, cnt, mine, sp = 0u;
    for (;;) {
        sum = 0u; cnt = 0u; mine = 0u;
#pragma unroll
        for (unsigned j = 0; j < 16; ++j) { const unsigned c = xb_ld(&bar[XB_XCNT(j)]); sum += c; cnt += (c > 0u) ? 1u : 0u; mine = (j == x) ? c : mine; }
        if (sum == G) break;
        __builtin_amdgcn_s_sleep(1);
        if ((++sp & 255u) == 0u) { if (xb_ld(&bar[XB_TMO])) break; if (sp > XB_SPIN_CAP) { atomicAdd(&bar[XB_TMO], 1u); break; } }
    }
    nloc = mine > 0u ? mine : 1u; nx = cnt > 0u ? cnt : 1u;
}
__device__ __forceinline__ void xcd_barrier(const XcdBarrier& b) {
    asm volatile("s_waitcnt vmcnt(0)" ::: "memory");
    __syncthreads();
    if (threadIdx.x == 0) {
        unsigned* bar = b.bar;
        __builtin_amdgcn_s_waitcnt(0);
        unsigned nloc = b.st[0], nx = b.st[1];
        if (nloc == 0u) { xcd_barrier_complete(bar, b.x, nloc, nx); b.st[0] = nloc; b.st[1] = nx; }
        const unsigned old = xb_add(&bar[XB_XSUB(b.x)], 1u);
        const unsigned gen = old / nloc;
        if (old + 1u == (gen + 1u) * nloc) {
            __builtin_amdgcn_fence(__ATOMIC_RELEASE, "agent");
            asm volatile("s_waitcnt vmcnt(0)" ::: "memory");
            const unsigned og = xb_add(&bar[XB_TOP], 1u);
            const unsigned tg = og / nx;
            if (og + 1u == (tg + 1u) * nx) xb_add(&bar[XB_TOPGEN], 1u);
            else XB_SPIN(xb_ld(&bar[XB_TOPGEN]) == tg, bar);
            __builtin_amdgcn_fence(__ATOMIC_ACQUIRE, "agent");
            xb_add(&bar[XB_XGEN(b.x)], 1u);
            asm volatile("s_waitcnt vmcnt(0)" ::: "memory");
        } else {
            XB_SPIN(xb_ld(&bar[XB_XGEN(b.x)]) == gen, bar);
            __builtin_amdgcn_fence(__ATOMIC_ACQUIRE, "agent");
            asm volatile("s_waitcnt vmcnt(0)" ::: "memory");
        }
    }
    __syncthreads();
}

namespace gm {
constexpr int BM = 256, BK = 64, HALF = 128, HTB = HALF * BK * 2, STAGE_BYTES = 8 * HTB, NXCD = 8, WGM = 8;
__host__ __device__ __forceinline__ int lds_byte(int r, int c) { const int st = (r >> 4) * 2 + (c >> 5), rr = r & 15, cc = c & 31, ob = rr * 64 + cc * 2; return st * 1024 + (ob ^ (((ob >> 9) & 1) << 5)); }
__host__ __device__ __forceinline__ void stage_rc(int b, int& R, int& C) { const int st = b / 1024, sb = b % 1024, swz = sb ^ (((sb >> 9) & 1) << 5); R = (st >> 1) * 16 + swz / 64; C = (st & 1) * 32 + (swz % 64) / 2; }
__host__ __device__ __forceinline__ int perm32(int rho) { const int n = rho >> 4, i = rho & 15; return 8 * (i >> 2) + 4 * n + (i & 3); }

struct Unit { const char* a; const char* b; int row0, col0, aux; };

struct DenseOrder {
    int nM, nN, nwg, G, c; const char* A; const char* B; size_t tA, tB;
    __device__ void init(const void* A_, const void* Bt_, int M, int N, int K, int G_, int c_) { nM = M / BM; nN = N / BM; nwg = nM * nN; G = G_; c = c_; A = (const char*)A_; B = (const char*)Bt_; tA = (size_t)BM * K * 2; tB = tA; }
    __device__ bool next(int i, Unit& u) const {
        const long L = (long)i * G + c; if (L >= nwg) return false;
        int wgid = (int)L; { const int q = nwg / NXCD, r = nwg % NXCD, xcd = wgid % NXCD, off = wgid / NXCD; wgid = (xcd < r ? xcd * (q + 1) : r * (q + 1) + (xcd - r) * q) + off; }
        const int nig = WGM * nN, gid = wgid / nig, fm = gid * WGM, gsz = (nM - fm) < WGM ? (nM - fm) : WGM;
        const int pm = fm + ((wgid % nig) % gsz), pn = (wgid % nig) / gsz;
        u.a = A + (size_t)pm * tA; u.b = B + (size_t)pn * tB; u.row0 = pm * BM; u.col0 = pn * BM; u.aux = 0; return true;
    }
    __device__ __forceinline__ void gather(const Unit&, unsigned (&)[2][2], const int (&)[2], const int (&)[2], int) const {}
};
struct MoeOrder {
    const int* tile_e; const int* tile_row0; const int* tile_nv; const int* slot_tok; int n_units, G, c, K; const char* A; const char* W; size_t wstride, tB; bool gath;
    __device__ bool next(int i, Unit& u) const {
        const int L = i * G + c; if (L >= n_units) return false;
        const int T = L >> 2, pn = L & 3;
        const int e = __builtin_amdgcn_readfirstlane(tile_e[T]), r0 = __builtin_amdgcn_readfirstlane(tile_row0[T]), nv = __builtin_amdgcn_readfirstlane(tile_nv[T]);
        u.a = gath ? A : A + (size_t)r0 * K * 2; u.b = W + (size_t)e * wstride + (size_t)pn * tB; u.row0 = r0; u.col0 = pn; u.aux = nv; return true;
    }
    __device__ __forceinline__ void gather(const Unit& u, unsigned (&vo)[2][2], const int (&sR)[2], const int (&sC)[2], int K_) const {
#pragma unroll
        for (int h = 0; h < 2; ++h)
#pragma unroll
            for (int i = 0; i < 2; ++i) { const int r = h * HALF + sR[i]; const int tok = (r < u.aux) ? slot_tok[u.row0 + r] : 0; vo[h][i] = (unsigned)(tok * K_ + sC[i]) * 2u; }
    }
};

template <class Epi, class Sched, bool GATHER>
__device__ __forceinline__ void gemm_phase(LAS unsigned char* lds, const int K, const Sched& S, const Epi& E) {
    int tz = threadIdx.x; asm volatile("" : "+v"(tz));
    const int tid = tz, wid = __builtin_amdgcn_readfirstlane(tid >> 6), lane = tid & 63, wr = wid >> 2, wc = wid & 3, fr = lane & 15, fq = lane >> 4;
    const int nt = K / BK;
    unsigned voffB[2], vA[2][2], vAn[2][2]; int sR[2], sC[2];
#pragma unroll
    for (int i = 0; i < 2; ++i) { int R, C; stage_rc(tid * 16 + i * 8192, R, C); const int Rb = Epi::PERM ? ((R & ~31) + perm32(R & 31)) : R;
        sR[i] = R; sC[i] = C; voffB[i] = (unsigned)(Rb * K + C) * 2u;
        vA[0][i] = (unsigned)(R * K + C) * 2u; vA[1][i] = (unsigned)((R + HALF) * K + C) * 2u; vAn[0][i] = vA[0][i]; vAn[1][i] = vA[1][i]; }
    const size_t kstep = (size_t)(BK * 2);
    const size_t hstep = (size_t)HALF * K * 2;
    const unsigned ldsw = (unsigned)wid * 1024u;
    const int aoff = lds_byte(wr * 64 + fr, fq * 8), boff = lds_byte(wc * 32 + fr, fq * 8);
#define PG8_SA(b, h) (((b) * 2 + (h)) * HTB)
#define PG8_SB(b, h) ((4 + (b) * 2 + (h)) * HTB)
#define PG8_STAGE(bufoff, gbase, voff) do { _Pragma("unroll") for (int _i = 0; _i < 2; ++_i) \
        __builtin_amdgcn_global_load_lds((const unsigned*)((const char*)(gbase) + (voff)[_i]), (LAS unsigned*)(lds + (bufoff) + ldsw + _i * 8192), 16, 0, 0); } while (0)
#define PG8_LDA(dst, b, h) do { _Pragma("unroll") for (int m = 0; m < 4; ++m) _Pragma("unroll") for (int k = 0; k < 2; ++k) dst[m][k] = *(const LAS bf16x8*)(lds + PG8_SA(b, h) + aoff + m * 2048 + k * 1024); } while (0)
#define PG8_LDB(dst, b, h) do { _Pragma("unroll") for (int n = 0; n < 2; ++n) _Pragma("unroll") for (int k = 0; k < 2; ++k) dst[n][k] = *(const LAS bf16x8*)(lds + PG8_SB(b, h) + boff + n * 2048 + k * 1024); } while (0)
#define PG8_MMA(ai, bj, At, Bt) do { __builtin_amdgcn_s_setprio(1); _Pragma("unroll") for (int m = 0; m < 4; ++m) _Pragma("unroll") for (int n = 0; n < 2; ++n) _Pragma("unroll") for (int k = 0; k < 2; ++k) \
        acc[ai][bj][m][n] = __builtin_amdgcn_mfma_f32_16x16x32_bf16(Bt[n][k], At[m][k], acc[ai][bj][m][n], 0, 0, 0); __builtin_amdgcn_s_setprio(0); } while (0)
#define PG8_WAIT_V(n) asm volatile("s_waitcnt vmcnt(" #n ")" ::: "memory")
#define PG8_WAIT_L(n) asm volatile("s_waitcnt lgkmcnt(" #n ")" ::: "memory")
#define PG8_BAR __builtin_amdgcn_s_barrier()
#define PG8_SCHED __builtin_amdgcn_sched_barrier(0)
    Unit cur, nxt; int ui = 0;
    if (!S.next(0, cur)) return;
    f32x4 acc[2][2][4][2];
#pragma unroll
    for (int a = 0; a < 2; ++a)
#pragma unroll
        for (int b = 0; b < 2; ++b)
#pragma unroll
            for (int m = 0; m < 4; ++m)
#pragma unroll
                for (int n = 0; n < 2; ++n) acc[a][b][m][n] = (f32x4){0.f, 0.f, 0.f, 0.f};
    bf16x8 At[4][2], B0[2][2], B1[2][2];
    const char* cA = cur.a; const char* cB = cur.b;
    if constexpr (GATHER) S.gather(cur, vA, sR, sC, K);
    PG8_STAGE(PG8_SB(0, 0), cB, voffB); PG8_STAGE(PG8_SB(0, 1), cB + hstep, voffB); PG8_STAGE(PG8_SA(0, 0), cA, vA[0]); PG8_STAGE(PG8_SA(0, 1), cA, vA[1]);
    if (wr == 1) PG8_BAR;
    PG8_WAIT_V(2); PG8_BAR;
    PG8_STAGE(PG8_SB(1, 0), cB + kstep, voffB); PG8_STAGE(PG8_SA(1, 0), cA + kstep, vA[0]); PG8_STAGE(PG8_SB(1, 1), cB + hstep + kstep, voffB);
    PG8_WAIT_V(6); PG8_BAR;
    for (;;) {
        const bool has_next = S.next(ui + 1, nxt);
        const char* nA = has_next ? nxt.a : cA; const char* nB = has_next ? nxt.b : cB;
        if constexpr (GATHER) {
            if (has_next) S.gather(nxt, vAn, sR, sC, K);
            else { vAn[0][0] = vA[0][0]; vAn[0][1] = vA[0][1]; vAn[1][0] = vA[1][0]; vAn[1][1] = vA[1][1]; }
        }
        for (int t = 0; t < nt; t += 2) {
            const bool last = (t == nt - 2);
            const char* a1 = cA + (size_t)(t + 1) * kstep;
            const char* a2 = last ? nA : cA + (size_t)(t + 2) * kstep; const char* b2 = last ? nB : cB + (size_t)(t + 2) * kstep;
            const char* a3 = a2 + kstep; const char* b3 = b2 + kstep;
            unsigned w0[2], w1[2];
            if constexpr (GATHER) { w0[0] = last ? vAn[0][0] : vA[0][0]; w0[1] = last ? vAn[0][1] : vA[0][1]; w1[0] = last ? vAn[1][0] : vA[1][0]; w1[1] = last ? vAn[1][1] : vA[1][1]; }
            else { w0[0] = vA[0][0]; w0[1] = vA[0][1]; w1[0] = vA[1][0]; w1[1] = vA[1][1]; }
            PG8_LDB(B0, 0, 0); PG8_LDB(B1, 0, 1); PG8_SCHED; PG8_LDA(At, 0, 0); PG8_STAGE(PG8_SA(1, 1), a1, vA[1]);
            PG8_WAIT_V(8); PG8_WAIT_L(0); PG8_BAR; PG8_MMA(0, 0, At, B0); PG8_MMA(0, 1, At, B1); PG8_BAR; PG8_SCHED;
            PG8_LDA(At, 0, 1); PG8_STAGE(PG8_SB(0, 0), b2, voffB); PG8_STAGE(PG8_SB(0, 1), b2 + hstep, voffB); PG8_STAGE(PG8_SA(0, 0), a2, w0);
            PG8_WAIT_V(8); PG8_WAIT_L(0); PG8_BAR; PG8_MMA(1, 0, At, B0); PG8_MMA(1, 1, At, B1); PG8_BAR; PG8_SCHED;
            PG8_LDB(B0, 1, 0); PG8_LDB(B1, 1, 1); PG8_SCHED; PG8_LDA(At, 1, 0); PG8_STAGE(PG8_SA(0, 1), a2, w1);
            PG8_WAIT_V(8); PG8_WAIT_L(0); PG8_BAR; PG8_MMA(0, 0, At, B0); PG8_MMA(0, 1, At, B1); PG8_BAR; PG8_SCHED;
            PG8_LDA(At, 1, 1); PG8_STAGE(PG8_SB(1, 0), b3, voffB); PG8_STAGE(PG8_SB(1, 1), b3 + hstep, voffB); PG8_STAGE(PG8_SA(1, 0), a3, w0);
            PG8_WAIT_V(8); PG8_WAIT_L(0); PG8_BAR; PG8_MMA(1, 0, At, B0); PG8_MMA(1, 1, At, B1); PG8_BAR; PG8_SCHED;
        }
        if (wr == 0) PG8_BAR;
        E(acc, cur, wr, wc, fr, fq);
        if (!has_next) break;
#pragma unroll
        for (int a = 0; a < 2; ++a)
#pragma unroll
            for (int b = 0; b < 2; ++b)
#pragma unroll
                for (int m = 0; m < 4; ++m)
#pragma unroll
                    for (int n = 0; n < 2; ++n) acc[a][b][m][n] = (f32x4){0.f, 0.f, 0.f, 0.f};
        cur = nxt; cA = nA; cB = nB; ++ui;
        if constexpr (GATHER) { vA[0][0] = vAn[0][0]; vA[0][1] = vAn[0][1]; vA[1][0] = vAn[1][0]; vA[1][1] = vAn[1][1]; }
        if (wr == 1) PG8_BAR;
    }
    PG8_WAIT_V(0);
    PG8_BAR;
#undef PG8_SA
#undef PG8_SB
#undef PG8_STAGE
#undef PG8_LDA
#undef PG8_LDB
#undef PG8_MMA
#undef PG8_WAIT_V
#undef PG8_WAIT_L
#undef PG8_BAR
#undef PG8_SCHED
}

#define EPI_ROWS(u, ai, m) ((u).row0 + (ai) * HALF + wr * 64 + (m) * 16 + fr)
struct EpiBf16 {
    static constexpr bool PERM = true;
    bf16* O; int ldc; float* iw;
    __device__ __forceinline__ void operator()(const f32x4 (&acc)[2][2][4][2], const Unit& u, int wr, int wc, int fr, int fq) const {
#pragma unroll
        for (int ai = 0; ai < 2; ++ai)
#pragma unroll
            for (int m = 0; m < 4; ++m) { const int row = EPI_ROWS(u, ai, m); bf16* rowp = O + (size_t)row * ldc + u.col0 + wc * 32 + 8 * fq;
#pragma unroll
                for (int bj = 0; bj < 2; ++bj) { const f32x4 v0 = acc[ai][bj][m][0], v1 = acc[ai][bj][m][1];
                    u32x4 w; w.x = cvt_pk_bf16(v0[0], v0[1]); w.y = cvt_pk_bf16(v0[2], v0[3]); w.z = cvt_pk_bf16(v1[0], v1[1]); w.w = cvt_pk_bf16(v1[2], v1[3]);
                    *(u32x4*)(rowp + bj * HALF) = w; }
                if (iw != nullptr && u.col0 == 1792 && wc == 2 && fq == 0) *(f32x4*)(iw + (size_t)row * 4) = acc[ai][0][m][0] * 0.0625f; }
    }
};
struct EpiResid {
    static constexpr bool PERM = false;
    const float* h; _Float16* t;
    __device__ __forceinline__ void operator()(const f32x4 (&acc)[2][2][4][2], const Unit& u, int wr, int wc, int fr, int fq) const {
#pragma unroll
        for (int ai = 0; ai < 2; ++ai)
#pragma unroll
            for (int m = 0; m < 4; ++m) { const size_t o = (size_t)EPI_ROWS(u, ai, m) * D_MODEL + u.col0 + wc * 32 + 4 * fq;
#pragma unroll
                for (int bj = 0; bj < 2; ++bj)
#pragma unroll
                    for (int n = 0; n < 2; ++n) { const size_t oo = o + bj * HALF + n * 16; const f32x4 hv = *(const f32x4*)(h + oo); const f32x4 tv = hv * ALPHA_F + acc[ai][bj][m][n]; *(f16x4*)(t + oo) = (f16x4){(_Float16)tv[0], (_Float16)tv[1], (_Float16)tv[2], (_Float16)tv[3]}; } }
    }
};
struct EpiPle {
    static constexpr bool PERM = false;
    const float* h; const bf16* pl; _Float16* t;
    __device__ __forceinline__ void operator()(const f32x4 (&acc)[2][2][4][2], const Unit& u, int wr, int wc, int fr, int fq) const {
#pragma unroll
        for (int ai = 0; ai < 2; ++ai)
#pragma unroll
            for (int m = 0; m < 4; ++m) { const size_t o = (size_t)EPI_ROWS(u, ai, m) * D_MODEL + u.col0 + wc * 32 + 4 * fq;
#pragma unroll
                for (int bj = 0; bj < 2; ++bj)
#pragma unroll
                    for (int n = 0; n < 2; ++n) { const size_t oo = o + bj * HALF + n * 16; const f32x4 hv = *(const f32x4*)(h + oo); const u32x2 pv = *(const u32x2*)(pl + oo);
                        const f32x4 a = acc[ai][bj][m][n]; f32x4 r;
                        r[0] = fmaf(hv[0], ALPHA_F, bflo(pv.x) * __builtin_amdgcn_rcpf(1.f + __builtin_amdgcn_exp2f(a[0] * -1.4426950408889634f))); r[1] = fmaf(hv[1], ALPHA_F, bfhi(pv.x) * __builtin_amdgcn_rcpf(1.f + __builtin_amdgcn_exp2f(a[1] * -1.4426950408889634f)));
                        r[2] = fmaf(hv[2], ALPHA_F, bflo(pv.y) * __builtin_amdgcn_rcpf(1.f + __builtin_amdgcn_exp2f(a[2] * -1.4426950408889634f))); r[3] = fmaf(hv[3], ALPHA_F, bfhi(pv.y) * __builtin_amdgcn_rcpf(1.f + __builtin_amdgcn_exp2f(a[3] * -1.4426950408889634f)));
                        *(f16x4*)(t + oo) = (f16x4){(_Float16)r[0], (_Float16)r[1], (_Float16)r[2], (_Float16)r[3]}; } }
    }
};
struct EpiSwiglu {
    static constexpr bool PERM = true;
    bf16* act;
    __device__ __forceinline__ void operator()(const f32x4 (&acc)[2][2][4][2], const Unit& u, int wr, int wc, int fr, int fq) const {
#pragma unroll
        for (int ai = 0; ai < 2; ++ai)
#pragma unroll
            for (int m = 0; m < 4; ++m) { const int row = EPI_ROWS(u, ai, m); float r[8];
#pragma unroll
                for (int n = 0; n < 2; ++n)
#pragma unroll
                    for (int j = 0; j < 4; ++j) { const float g = acc[ai][0][m][n][j], uu = acc[ai][1][m][n][j]; r[n * 4 + j] = g * __builtin_amdgcn_rcpf(1.f + __builtin_amdgcn_exp2f(g * -1.4426950408889634f)) * uu; }
                u32x4 w; w.x = cvt_pk_bf16(r[0], r[1]); w.y = cvt_pk_bf16(r[2], r[3]); w.z = cvt_pk_bf16(r[4], r[5]); w.w = cvt_pk_bf16(r[6], r[7]);
                *(u32x4*)(act + (size_t)row * D_EXPERT + u.col0 * 128 + wc * 32 + 8 * fq) = w; }
    }
};
struct EpiMoeDown {
    static constexpr bool PERM = true;
    bf16* Y;
    __device__ __forceinline__ void operator()(const f32x4 (&acc)[2][2][4][2], const Unit& u, int wr, int wc, int fr, int fq) const {
#pragma unroll
        for (int ai = 0; ai < 2; ++ai)
#pragma unroll
            for (int m = 0; m < 4; ++m) { const int row = EPI_ROWS(u, ai, m); bf16* rowp = Y + (size_t)row * D_MODEL + u.col0 * 256 + wc * 32 + 8 * fq;
#pragma unroll
                for (int bj = 0; bj < 2; ++bj) { const f32x4 v0 = acc[ai][bj][m][0], v1 = acc[ai][bj][m][1];
                    u32x4 w; w.x = cvt_pk_bf16(v0[0], v0[1]); w.y = cvt_pk_bf16(v0[2], v0[3]); w.z = cvt_pk_bf16(v1[0], v1[1]); w.w = cvt_pk_bf16(v1[2], v1[3]);
                    *(u32x4*)(rowp + bj * HALF) = w; } }
    }
};
}

struct Params { const float* in[18]; float* out; unsigned char* ws; int ph_lo, ph_hi, bar_idx, pad; };
typedef const Params __attribute__((address_space(4)))* KP;
__device__ __forceinline__ KP fresh_params() { KP p = (KP)__builtin_amdgcn_kernarg_segment_ptr(); asm volatile("" : "+s"(p)); return p; }

__device__ __forceinline__ void tr_item(const float* W, int K, int N, bf16* WT, int row_off, LAS float* scr, int kb, int nb, int lane) {
    const int k0 = 64 * kb, n0 = 32 * nb;
    const bool ok = (n0 + (lane & 31)) < N;
    if (n0 + 32 <= N) {
        const int kr = lane >> 3, c4 = (lane & 7) * 4;
#pragma unroll
        for (int i = 0; i < 8; ++i) { const int kk = 8 * i + kr; const f32x4 v = __builtin_nontemporal_load((const f32x4*)(W + (size_t)(k0 + kk) * N + n0 + c4));
            LAS float* d = scr + kk * 33 + c4; d[0] = v[0]; d[1] = v[1]; d[2] = v[2]; d[3] = v[3]; }
    } else {
#pragma unroll 8
        for (int i = 0; i < 32; ++i) { const int kk = 2 * i + (lane >> 5); scr[kk * 33 + (lane & 31)] = ok ? W[(size_t)(k0 + kk) * N + n0 + (lane & 31)] : 0.f; }
    }
    asm volatile("s_waitcnt lgkmcnt(0)" ::: "memory");
    const int c = lane & 7;
#pragma unroll
    for (int j = 0; j < 4; ++j) { const int n = (lane >> 3) + 8 * j; const LAS float* s = scr + (8 * c) * 33 + n;
        u32x4 o; o.x = cvt_pk_bf16(s[0 * 33], s[1 * 33]); o.y = cvt_pk_bf16(s[2 * 33], s[3 * 33]); o.z = cvt_pk_bf16(s[4 * 33], s[5 * 33]); o.w = cvt_pk_bf16(s[6 * 33], s[7 * 33]);
        *(u32x4*)(WT + (size_t)(row_off + n0 + n) * K + k0 + 8 * c) = o; }
    asm volatile("s_waitcnt lgkmcnt(0)" ::: "memory");
}
__device__ __forceinline__ void cvt_rows(const float* src, bf16* dst, size_t n4, int gtid, int gthreads) {
    size_t i = gtid;
    for (; i + 3 * (size_t)gthreads < n4; i += 4 * (size_t)gthreads) {
        f32x4 v[4];
#pragma unroll
        for (int u = 0; u < 4; ++u) v[u] = __builtin_nontemporal_load((const f32x4*)(src + (i + u * (size_t)gthreads) * 4));
#pragma unroll
        for (int u = 0; u < 4; ++u) { u32x2 o; o.x = cvt_pk_bf16(v[u][0], v[u][1]); o.y = cvt_pk_bf16(v[u][2], v[u][3]); *(u32x2*)(dst + (i + u * (size_t)gthreads) * 4) = o; }
    }
    for (; i < n4; i += gthreads) { const f32x4 v = *(const f32x4*)(src + i * 4); u32x2 o; o.x = cvt_pk_bf16(v[0], v[1]); o.y = cvt_pk_bf16(v[2], v[3]); *(u32x2*)(dst + i * 4) = o; }
}
__device__ __forceinline__ void phase_convert(KP P, int L, LAS unsigned char* lds) {
    int tz = threadIdx.x; asm volatile("" : "+v"(tz));
    const int tid = tz, lane = tid & 63, wave = tid >> 6;
    LAS float* scr = (LAS float*)(lds + wave * 17408);
    const int gw = blockIdx.x * NWAVES + wave, NGW = gridDim.x * NWAVES;
    unsigned char* ws = P->ws;
    bf16* wmix = (bf16*)(ws + WS_WMIX); bf16* wo_t = (bf16*)(ws + WS_WMIX + 4 * MiB); bf16* wkv_t = (bf16*)(ws + WS_WMIX + 6 * MiB);
    bf16* wpg_t = (bf16*)(ws + WS_WPG); bf16* wple_t = (bf16*)(ws + WS_WPLE); bf16* wgu_t = (bf16*)(ws + WS_WGU); bf16* wd_t = (bf16*)(ws + WS_WD);
    const bool isA = L < N_A; const int j = L - N_A;
    const float* w_first = isA ? P->in[2] + (size_t)L * D_MODEL * A_COLS : P->in[5] + (size_t)j * D_MODEL * D_MODEL;
    const int n_first = isA ? A_COLS : D_MODEL, nb_first = isA ? 64 : 32;
    const float* w_o = isA ? P->in[3] + (size_t)L * D_MODEL * D_MODEL : P->in[6] + (size_t)j * D_MODEL * D_MODEL;
    const int I_FIRST = 16 * nb_first, I_O = 16 * 32, I_KV = (L == N_A) ? 16 * 16 : 0, I_PG = 16 * 32, I_PLE = 4 * 32, I_G = 32 * 256, I_U = 32 * 256, I_D = 32 * 256;
    const int NITEMS = I_FIRST + I_O + I_KV + I_PG + I_PLE + I_G + I_U + I_D;
    const size_t wsz = (size_t)D_MODEL * D_EXPERT;
#define CV_DECODE(IT, W_, K_, N_, WT_, RO_, KB_, NB_) do { int r = (IT); \
        if (r < I_FIRST) { W_ = w_first; K_ = D_MODEL; N_ = n_first; WT_ = wmix; RO_ = 0; KB_ = r / nb_first; NB_ = r % nb_first; break; } r -= I_FIRST; \
        if (r < I_O) { W_ = w_o; K_ = D_MODEL; N_ = D_MODEL; WT_ = wo_t; RO_ = 0; KB_ = r / 32; NB_ = r % 32; break; } r -= I_O; \
        if (r < I_KV) { W_ = P->in[4]; K_ = D_MODEL; N_ = 512; WT_ = wkv_t; RO_ = 0; KB_ = r / 16; NB_ = r % 16; break; } r -= I_KV; \
        if (r < I_PG) { W_ = P->in[15] + (size_t)L * D_MODEL * D_MODEL; K_ = D_MODEL; N_ = D_MODEL; WT_ = wpg_t; RO_ = 0; KB_ = r / 32; NB_ = r % 32; break; } r -= I_PG; \
        if (r < I_PLE) { W_ = P->in[14] + (size_t)L * PLE_DIM * D_MODEL; K_ = PLE_DIM; N_ = D_MODEL; WT_ = wple_t; RO_ = 0; KB_ = r / 32; NB_ = r % 32; break; } r -= I_PLE; \
        if (r < I_G + I_U) { const bool up = r >= I_G; if (up) r -= I_G; const int e = r >> 8, rem = r & 255, n0 = (rem & 15) * 32; \
            W_ = (up ? P->in[12] : P->in[11]) + ((size_t)L * N_EXPERTS + e) * wsz; K_ = D_MODEL; N_ = D_EXPERT; WT_ = wgu_t + (size_t)e * D_MODEL * D_MODEL; \
            RO_ = (n0 >> 7) * 256 + (up ? 128 : 0) + (n0 & 127) - n0; KB_ = rem >> 4; NB_ = rem & 15; break; } \
        r -= I_G + I_U; { const int e = r >> 8, rem = r & 255; W_ = P->in[13] + ((size_t)L * N_EXPERTS + e) * wsz; K_ = D_EXPERT; N_ = D_MODEL; WT_ = wd_t + (size_t)e * wsz; RO_ = 0; KB_ = rem >> 5; NB_ = rem & 31; } } while (0)
    LAS float* scr2 = scr + 64 * 33;
    for (int it = gw; it < NITEMS; it += 2 * NGW) {
        const float* W0; int K0, N0, RO0, KB0, NB0; bf16* WT0; CV_DECODE(it, W0, K0, N0, WT0, RO0, KB0, NB0);
        const int it1 = it + NGW;
        if (it1 >= NITEMS) { tr_item(W0, K0, N0, WT0, RO0, scr, KB0, NB0, lane); continue; }
        const float* W1; int K1, N1, RO1, KB1, NB1; bf16* WT1; CV_DECODE(it1, W1, K1, N1, WT1, RO1, KB1, NB1);
        if (NB0 * 32 + 32 > N0 || NB1 * 32 + 32 > N1) { tr_item(W0, K0, N0, WT0, RO0, scr, KB0, NB0, lane); tr_item(W1, K1, N1, WT1, RO1, scr, KB1, NB1, lane); continue; }
        const int kr = lane >> 3, c4 = (lane & 7) * 4;
        f32x4 va[8], vb2[8];
#pragma unroll
        for (int i = 0; i < 8; ++i) { va[i] = __builtin_nontemporal_load((const f32x4*)(W0 + (size_t)(64 * KB0 + 8 * i + kr) * N0 + 32 * NB0 + c4)); vb2[i] = __builtin_nontemporal_load((const f32x4*)(W1 + (size_t)(64 * KB1 + 8 * i + kr) * N1 + 32 * NB1 + c4)); }
#pragma unroll
        for (int i = 0; i < 8; ++i) { LAS float* d = scr + (8 * i + kr) * 33 + c4; d[0] = va[i][0]; d[1] = va[i][1]; d[2] = va[i][2]; d[3] = va[i][3];
            LAS float* d2 = scr2 + (8 * i + kr) * 33 + c4; d2[0] = vb2[i][0]; d2[1] = vb2[i][1]; d2[2] = vb2[i][2]; d2[3] = vb2[i][3]; }
        asm volatile("s_waitcnt lgkmcnt(0)" ::: "memory");
        { const int c = lane & 7;
#pragma unroll
          for (int jj = 0; jj < 4; ++jj) { const int n = (lane >> 3) + 8 * jj; const LAS float* s0 = scr + (8 * c) * 33 + n; const LAS float* s1 = scr2 + (8 * c) * 33 + n;
              u32x4 o0, o1; o0.x = cvt_pk_bf16(s0[0 * 33], s0[1 * 33]); o0.y = cvt_pk_bf16(s0[2 * 33], s0[3 * 33]); o0.z = cvt_pk_bf16(s0[4 * 33], s0[5 * 33]); o0.w = cvt_pk_bf16(s0[6 * 33], s0[7 * 33]);
              o1.x = cvt_pk_bf16(s1[0 * 33], s1[1 * 33]); o1.y = cvt_pk_bf16(s1[2 * 33], s1[3 * 33]); o1.z = cvt_pk_bf16(s1[4 * 33], s1[5 * 33]); o1.w = cvt_pk_bf16(s1[6 * 33], s1[7 * 33]);
              *(u32x4*)(WT0 + (size_t)(RO0 + 32 * NB0 + n) * K0 + 64 * KB0 + 8 * c) = o0; *(u32x4*)(WT1 + (size_t)(RO1 + 32 * NB1 + n) * K1 + 64 * KB1 + 8 * c) = o1; } }
        asm volatile("s_waitcnt lgkmcnt(0)" ::: "memory");
    }
#undef CV_DECODE
    const int gtid = blockIdx.x * 512 + tid, gthreads = gridDim.x * 512;
    { const float* wrg = P->in[7] + (size_t)L * D_MODEL * N_GROUPS; const float* wre = P->in[9] + (size_t)L * D_MODEL * N_EXPERTS; float* wrt = (float*)(ws + WS_WPLE + 1 * MiB);
      for (int i = gtid; i < D_MODEL * 36; i += gthreads) { const int c = i >> 10, k = i & 1023; wrt[i] = (c < 4) ? wrg[k * 4 + c] : wre[k * 32 + (c - 4)]; } }
    cvt_rows(P->in[1] + (size_t)L * NTOK * PLE_DIM, (bf16*)(ws + WS_PB), (size_t)NTOK * PLE_DIM / 4, gtid, gthreads);
    if (L == 0) cvt_rows(P->in[0], (bf16*)(ws + WS_HB), (size_t)NTOK * D_MODEL / 4, gtid, gthreads);
}

template <int SRC, bool ROUTER>
__device__ __forceinline__ void phase_ln(KP P, int L, int which, LAS unsigned char* lds, float* dst_f32, bool write_hb, int cidx = -1) {
    int tz = threadIdx.x; asm volatile("" : "+v"(tz)); const int tid = tz, lane = tid & 63, wave = tid >> 6;
    unsigned char* ws = P->ws;
    const _Float16* t = (const _Float16*)(ws + WS_T); const float* h = (const float*)(ws + WS_H); bf16* hb = (bf16*)(ws + WS_HB);
    const bf16* Y = (const bf16*)(ws + WS_Y);
    const int* moe = (const int*)(ws + WS_MOE);
    const float* g = P->in[16] + (size_t)(L * 3 + which) * D_MODEL; const float* bt = P->in[17] + (size_t)(L * 3 + which) * D_MODEL;
    f32x4 gv[4], bv[4];
#pragma unroll
    for (int j = 0; j < 4; ++j) { gv[j] = *(const f32x4*)(g + 4 * lane + 256 * j); bv[j] = *(const f32x4*)(bt + 4 * lane + 256 * j); }
    const int gw = blockIdx.x * NWAVES + wave, NGW = gridDim.x * NWAVES;
    for (int pi = gw; pi < NTOK / 2; pi += NGW) {
        const int row0 = pi * 2;
        f32x4 v[2][4];
        if (SRC == 0) {
            f16x4 tv[2][4];
#pragma unroll
            for (int u = 0; u < 2; ++u)
#pragma unroll
                for (int j = 0; j < 4; ++j) tv[u][j] = __builtin_nontemporal_load((const f16x4*)(t + (size_t)(row0 + u) * D_MODEL + 4 * lane + 256 * j));
#pragma unroll
            for (int u = 0; u < 2; ++u)
#pragma unroll
                for (int j = 0; j < 4; ++j) v[u][j] = (f32x4){(float)tv[u][j][0], (float)tv[u][j][1], (float)tv[u][j][2], (float)tv[u][j][3]};
        } else {
            int sl[2][2]; float wq[2][2]; f32x4 hv[2][4]; u32x2 y0[2][4], y1[2][4];
#pragma unroll
            for (int u = 0; u < 2; ++u) { sl[u][0] = moe[MO_TOK_SLOT + (row0 + u) * 2]; sl[u][1] = moe[MO_TOK_SLOT + (row0 + u) * 2 + 1];
                wq[u][0] = ((const float*)moe)[MO_TOK_W + (row0 + u) * 2]; wq[u][1] = ((const float*)moe)[MO_TOK_W + (row0 + u) * 2 + 1];
#pragma unroll
                for (int j = 0; j < 4; ++j) hv[u][j] = *(const f32x4*)(h + (size_t)(row0 + u) * D_MODEL + 4 * lane + 256 * j); }
#pragma unroll
            for (int u = 0; u < 2; ++u)
#pragma unroll
                for (int j = 0; j < 4; ++j) { y0[u][j] = *(const u32x2*)(Y + (size_t)sl[u][0] * D_MODEL + 4 * lane + 256 * j); y1[u][j] = *(const u32x2*)(Y + (size_t)sl[u][1] * D_MODEL + 4 * lane + 256 * j); }
#pragma unroll
            for (int u = 0; u < 2; ++u)
#pragma unroll
                for (int j = 0; j < 4; ++j) { const float w0 = wq[u][0], w1 = wq[u][1];
                    v[u][j][0] = hv[u][j][0] * ALPHA_F + (w0 * bflo(y0[u][j].x) + w1 * bflo(y1[u][j].x)); v[u][j][1] = hv[u][j][1] * ALPHA_F + (w0 * bfhi(y0[u][j].x) + w1 * bfhi(y1[u][j].x));
                    v[u][j][2] = hv[u][j][2] * ALPHA_F + (w0 * bflo(y0[u][j].y) + w1 * bflo(y1[u][j].y)); v[u][j][3] = hv[u][j][3] * ALPHA_F + (w0 * bfhi(y0[u][j].y) + w1 * bfhi(y1[u][j].y)); }
        }
#pragma unroll
        for (int u = 0; u < 2; ++u) {
            const int row = row0 + u;
            float s = 0.f;
#pragma unroll
            for (int j = 0; j < 4; ++j) s += (v[u][j][0] + v[u][j][1]) + (v[u][j][2] + v[u][j][3]);
            const float mean = wave_sum(s) * (1.f / D_MODEL);
            float q = 0.f;
#pragma unroll
            for (int j = 0; j < 4; ++j) { v[u][j] = v[u][j] - mean; q += (v[u][j][0] * v[u][j][0] + v[u][j][1] * v[u][j][1]) + (v[u][j][2] * v[u][j][2] + v[u][j][3] * v[u][j][3]); }
            const float rstd = rsqrtf(wave_sum(q) * (1.f / D_MODEL) + LN_EPS);
#pragma unroll
            for (int j = 0; j < 4; ++j) { v[u][j] = v[u][j] * rstd * gv[j] + bv[j]; *(f32x4*)(dst_f32 + (size_t)row * D_MODEL + 4 * lane + 256 * j) = v[u][j]; }
            if (write_hb) {
#pragma unroll
                for (int j = 0; j < 4; ++j) { u32x2 o; o.x = cvt_pk_bf16(v[u][j][0], v[u][j][1]); o.y = cvt_pk_bf16(v[u][j][2], v[u][j][3]); *(u32x2*)(hb + (size_t)row * D_MODEL + 4 * lane + 256 * j) = o; }
            }
        }
    }
    (void)lds; (void)cidx;
}

__device__ __forceinline__ void phase_ln_router(KP P, int L, LAS unsigned char* lds, int cidx) {
    int tz = threadIdx.x; asm volatile("" : "+v"(tz)); const int tid = tz, lane = tid & 63, wave = tid >> 6;
    unsigned char* ws = P->ws;
    const _Float16* t = (const _Float16*)(ws + WS_T); float* h = (float*)(ws + WS_H); bf16* hb = (bf16*)(ws + WS_HB);
    int* moe = (int*)(ws + WS_MOE);
    const float* g = P->in[16] + (size_t)(L * 3) * D_MODEL; const float* bt = P->in[17] + (size_t)(L * 3) * D_MODEL;
    LAS float* Wl = (LAS float*)lds;
    LAS float* lgs = (LAS float*)(lds + 147456) + wave * 80;
    LAS int* lcnt = (LAS int*)(lds + 150016);
    LAS int* rinfo = (LAS int*)(lds + 150272);
    { const f32x4* wrt = (const f32x4*)(ws + WS_WPLE + 1 * MiB);
      for (int i = tid; i < D_MODEL * 36 / 4; i += 512) ((LAS f32x4*)Wl)[i] = wrt[i];
      if (tid < 64) lcnt[tid] = 0; }
    __syncthreads();
    f32x4 gv[4], bv[4];
#pragma unroll
    for (int j = 0; j < 4; ++j) { gv[j] = *(const f32x4*)(g + 4 * lane + 256 * j); bv[j] = *(const f32x4*)(bt + 4 * lane + 256 * j); }
    const float* brg = P->in[8] + L * N_GROUPS; const float* bre = P->in[10] + L * N_EXPERTS;
    const int gw = blockIdx.x * NWAVES + wave, NGW = gridDim.x * NWAVES;
    int it = 0;
    for (int pi = gw; pi < NTOK / 2; pi += NGW, ++it) {
        const int row0 = pi * 2;
        f32x4 va[4], vb[4];
#pragma unroll
        for (int j = 0; j < 4; ++j) { const f16x4 ta = __builtin_nontemporal_load((const f16x4*)(t + (size_t)row0 * D_MODEL + 4 * lane + 256 * j)), tb2 = __builtin_nontemporal_load((const f16x4*)(t + (size_t)(row0 + 1) * D_MODEL + 4 * lane + 256 * j));
            va[j] = (f32x4){(float)ta[0], (float)ta[1], (float)ta[2], (float)ta[3]}; vb[j] = (f32x4){(float)tb2[0], (float)tb2[1], (float)tb2[2], (float)tb2[3]}; }
        float sa = 0.f, sb = 0.f;
#pragma unroll
        for (int j = 0; j < 4; ++j) { sa += (va[j][0] + va[j][1]) + (va[j][2] + va[j][3]); sb += (vb[j][0] + vb[j][1]) + (vb[j][2] + vb[j][3]); }
        const float ma = wave_sum(sa) * (1.f / D_MODEL), mb_ = wave_sum(sb) * (1.f / D_MODEL);
        float qa = 0.f, qb = 0.f;
#pragma unroll
        for (int j = 0; j < 4; ++j) { va[j] = va[j] - ma; vb[j] = vb[j] - mb_;
            qa += (va[j][0] * va[j][0] + va[j][1] * va[j][1]) + (va[j][2] * va[j][2] + va[j][3] * va[j][3]);
            qb += (vb[j][0] * vb[j][0] + vb[j][1] * vb[j][1]) + (vb[j][2] * vb[j][2] + vb[j][3] * vb[j][3]); }
        const float ra = rsqrtf(wave_sum(qa) * (1.f / D_MODEL) + LN_EPS), rb = rsqrtf(wave_sum(qb) * (1.f / D_MODEL) + LN_EPS);
#pragma unroll
        for (int j = 0; j < 4; ++j) { va[j] = va[j] * ra * gv[j] + bv[j]; vb[j] = vb[j] * rb * gv[j] + bv[j];
            *(f32x4*)(h + (size_t)row0 * D_MODEL + 4 * lane + 256 * j) = va[j]; *(f32x4*)(h + (size_t)(row0 + 1) * D_MODEL + 4 * lane + 256 * j) = vb[j];
            u32x2 oa, ob; oa.x = cvt_pk_bf16(va[j][0], va[j][1]); oa.y = cvt_pk_bf16(va[j][2], va[j][3]); ob.x = cvt_pk_bf16(vb[j][0], vb[j][1]); ob.y = cvt_pk_bf16(vb[j][2], vb[j][3]);
            *(u32x2*)(hb + (size_t)row0 * D_MODEL + 4 * lane + 256 * j) = oa; *(u32x2*)(hb + (size_t)(row0 + 1) * D_MODEL + 4 * lane + 256 * j) = ob; }
#pragma unroll
        for (int p = 0; p < 18; ++p) {
            f32x2 a0 = {0.f, 0.f}, a1 = {0.f, 0.f};
#pragma unroll
            for (int j = 0; j < 4; ++j) { const f32x4 w0 = *(const LAS f32x4*)(Wl + (2 * p) * D_MODEL + 4 * lane + 256 * j), w1 = *(const LAS f32x4*)(Wl + (2 * p + 1) * D_MODEL + 4 * lane + 256 * j);
#pragma unroll
                for (int i = 0; i < 4; ++i) { const f32x2 y = {va[j][i], vb[j][i]}; a0 = a0 + y * w0[i]; a1 = a1 + y * w1[i]; } }
            float ra2[2];
#pragma unroll
            for (int rr = 0; rr < 2; ++rr) {
                auto sw = __builtin_amdgcn_permlane32_swap(__float_as_uint(rr ? a0.y : a0.x), __float_as_uint(rr ? a1.y : a1.x), false, false);
                float v = __uint_as_float(sw[0]) + __uint_as_float(sw[1]);
                v = row16_sum(v); v += __shfl_xor(v, 16); ra2[rr] = v; }
            if ((lane & 31) == 0) { const int ci = 2 * p + (lane >> 5); lgs[ci] = ra2[0]; lgs[40 + ci] = ra2[1]; }
            __builtin_amdgcn_sched_barrier(0);
        }
        asm volatile("s_waitcnt lgkmcnt(0)" ::: "memory");
        if (lane == 0 || lane == 32) {
            const int rr = lane >> 5; LAS float* lg = lgs + rr * 40;
            float gl[4];
#pragma unroll
            for (int jj = 0; jj < 4; ++jj) gl[jj] = lg[jj] + brg[jj];
            int gs = 0; float gmax = gl[0];
#pragma unroll
            for (int jj = 1; jj < 4; ++jj) if (gl[jj] > gmax) { gmax = gl[jj]; gs = jj; }
            float den = 0.f;
#pragma unroll
            for (int jj = 0; jj < 4; ++jj) den += expf(gl[jj] - gmax);
            const float gwt = 1.f / den;
            float el[8];
#pragma unroll
            for (int jj = 0; jj < 8; ++jj) el[jj] = lg[4 + gs * 8 + jj] + bre[gs * 8 + jj];
            int i0 = 0; float v0 = el[0];
#pragma unroll
            for (int jj = 1; jj < 8; ++jj) if (el[jj] > v0) { v0 = el[jj]; i0 = jj; }
            int i1 = -1; float v1 = 0.f;
#pragma unroll
            for (int jj = 0; jj < 8; ++jj) if (jj != i0 && (i1 < 0 || el[jj] > v1)) { v1 = el[jj]; i1 = jj; }
            const float e1 = expf(v1 - v0);
            const float w0 = gwt / (1.f + e1), w1 = gwt * e1 / (1.f + e1);
            const int ea = gs * 8 + i0, eb = gs * 8 + i1;
            const int pa = __hip_atomic_fetch_add(lcnt + ea, 1, __ATOMIC_RELAXED, __HIP_MEMORY_SCOPE_WORKGROUP), pb2 = __hip_atomic_fetch_add(lcnt + eb, 1, __ATOMIC_RELAXED, __HIP_MEMORY_SCOPE_WORKGROUP);
            LAS int* ri = rinfo + ((it * NWAVES + wave) * 2 + rr) * 5;
            ri[0] = ea | (eb << 8); ri[1] = pa; ri[2] = pb2; ri[3] = __float_as_int(w0); ri[4] = __float_as_int(w1);
        }
    }
    __syncthreads();
    if (tid < 32) { const int n = lcnt[tid]; unsigned* cnt = (unsigned*)(ws + WS_CTL) + CW_CNT + cidx * 32; lcnt[32 + tid] = n ? (int)atomicAdd(&cnt[tid], (unsigned)n) : 0; }
    __syncthreads();
    for (int sl = tid; sl < it * NWAVES * 2; sl += 512) {
        const int i2 = sl / (NWAVES * 2), w2 = (sl >> 1) & (NWAVES - 1), rr = sl & 1;
        const int row = ((blockIdx.x * NWAVES + w2) + i2 * NGW) * 2 + rr;
        if (row < NTOK) { const LAS int* ri = rinfo + sl * 5; const int ea = ri[0] & 255, eb = ri[0] >> 8;
            moe[MO_TOK_E + row * 2] = ea; moe[MO_TOK_E + row * 2 + 1] = eb; moe[MO_TOK_POS + row * 2] = lcnt[32 + ea] + ri[1]; moe[MO_TOK_POS + row * 2 + 1] = lcnt[32 + eb] + ri[2];
            moe[MO_TOK_W + row * 2] = ri[3]; moe[MO_TOK_W + row * 2 + 1] = ri[4]; }
    }
}

__device__ __forceinline__ void phase_moe_prep(KP P, int L, LAS unsigned char* lds) {
    int tz = threadIdx.x; asm volatile("" : "+v"(tz));
    const int tid = tz;
    unsigned char* ws = P->ws; int* moe = (int*)(ws + WS_MOE);
    const unsigned* cnt = (const unsigned*)(ws + WS_CTL) + CW_CNT + L * 32;
    LAS int* sb = (LAS int*)lds;
    LAS int* sc = (LAS int*)lds + 64;
    if (tid < 32) sc[tid] = (int)cnt[tid];
    __syncthreads();
    if (tid == 0) { int s = 0; for (int e = 0; e < N_EXPERTS; ++e) { sb[e] = s; s += (sc[e] + 255) / 256 * 256; } sb[N_EXPERTS] = s; }
    __syncthreads();
    const int ntiles = sb[N_EXPERTS] / 256;
    if (blockIdx.x == 0) {
        if (tid == 0) *((unsigned*)(ws + WS_CTL) + CW_NTILES + L) = (unsigned)ntiles;
        for (int T = tid; T < ntiles; T += 512) {
            const int r = T * 256; int e = 0;
            for (int x = 0; x < N_EXPERTS; ++x) if (r >= sb[x] && r < sb[x + 1]) e = x;
            const int nv = sc[e] - (r - sb[e]);
            moe[MO_TILE_E + T] = e; moe[MO_TILE_ROW0 + T] = r; moe[MO_TILE_NV + T] = nv < 256 ? nv : 256;
        }
    }
    for (int a = blockIdx.x * 512 + tid; a < NTOK * 2; a += gridDim.x * 512) {
        const int slot = sb[moe[MO_TOK_E + a]] + moe[MO_TOK_POS + a];
        moe[MO_SLOT_TOK + slot] = a >> 1; moe[MO_TOK_SLOT + a] = slot;
    }
}


namespace mb {
typedef short s16x4 __attribute__((ext_vector_type(4)));
typedef float f32x16 __attribute__((ext_vector_type(16)));
constexpr int SHM_V = 64 * 128 * 2, SHM_K = 64 * 128 * 2, V_OFF = 0, K_OFF = 2 * SHM_V, PRE_OFF = 65536;
constexpr float SCALE = 0.08838834764831845f, LOG2E = 1.4426950408889634f, CC = SCALE * LOG2E, THRX = 8.f * LOG2E;
#define MB_KSWZ(row, colB) ((row) * 256 + ((colB) ^ (((row) & 7) << 4)))
__device__ __forceinline__ int v_st(int k, int c) { const int kk = (k & ~0xC) | ((k & 4) << 1) | ((k & 8) >> 1); return ((kk >> 3) * 4 + (c >> 5)) * 512 + ((kk & 7) * 32 + (c & 31)) * 2; }
__device__ __forceinline__ int v_rd_base(int lane) { return ((lane & 3) << 3) | (((lane >> 2) & 3) << 6) | (((lane >> 4) & 1) << 5) | (((lane >> 5) & 1) << 8); }
constexpr int v_rd_off(int d0, int ks, int half) { return d0 * 512 + ks * 4096 + half * 2048; }
template <int OFF> __device__ __forceinline__ s16x4 tr_read(int vb) { s16x4 r; asm volatile("ds_read_b64_tr_b16 %0, %1 offset:%2" : "=&v"(r) : "v"(vb), "i"(OFF) : "memory"); return r; }
#define MB_SBAR() __builtin_amdgcn_sched_barrier(0)

__device__ __forceinline__ void qkt(f32x16& p0, f32x16& p1, LAS unsigned char* Ks, const bf16x8 (&qr)[8], int r32, int hi) {
    p0 = f32x16{}; p1 = f32x16{};
#pragma unroll
    for (int d0 = 0; d0 < 8; ++d0) { const int cb = (d0 * 16 + hi * 8) * 2;
        const bf16x8 b0 = *(const LAS bf16x8*)(Ks + MB_KSWZ(r32, cb));
        const bf16x8 b1 = *(const LAS bf16x8*)(Ks + MB_KSWZ(32 + r32, cb));
        p0 = __builtin_amdgcn_mfma_f32_32x32x16_bf16(b0, qr[d0], p0, 0, 0, 0);
        p1 = __builtin_amdgcn_mfma_f32_32x32x16_bf16(b1, qr[d0], p1, 0, 0, 0); }
}
__device__ __forceinline__ void partialSM(f32x16& p0, f32x16& p1, float& m_reg, float& mn, float& alpha, float bias2, float tb4, bool own, int lim) {
#pragma unroll
    for (int r = 0; r < 16; ++r) { const float kc = (float)((r & 3) + 8 * (r >> 2));
        p0[r] = fmaf(p0[r], CC, fmaf(bias2, kc, tb4)); p1[r] = fmaf(p1[r], CC, fmaf(bias2, kc + 32.f, tb4)); }
    if (own) {
#pragma unroll
        for (int r = 0; r < 16; ++r) { const int kc = (r & 3) + 8 * (r >> 2); if (kc > lim) p0[r] = -INFINITY; if (kc + 32 > lim) p1[r] = -INFINITY; }
    }
    float pmax = p0[0];
#pragma unroll
    for (int r = 1; r < 16; ++r) pmax = fmaxf(pmax, p0[r]);
#pragma unroll
    for (int r = 0; r < 16; ++r) pmax = fmaxf(pmax, p1[r]);
    { auto rr = __builtin_amdgcn_permlane32_swap(__float_as_uint(pmax), __float_as_uint(pmax), false, false); pmax = fmaxf(__uint_as_float(rr[0]), __uint_as_float(rr[1])); }
    if (__builtin_expect(__all(pmax - m_reg <= THRX), 1)) { mn = m_reg; alpha = 1.f; }
    else { mn = fmaxf(m_reg, pmax); alpha = __builtin_amdgcn_exp2f(m_reg - mn); m_reg = mn; }
#pragma unroll
    for (int r = 0; r < 16; ++r) { p0[r] = p0[r] - mn; p1[r] = p1[r] - mn; }
#pragma unroll
    for (int r = 0; r < 16; ++r) p0[r] = __builtin_amdgcn_exp2f(p0[r]);
}
__device__ __forceinline__ void finishSM(f32x16& p0, f32x16& p1, float alpha, float& l_reg, bf16x8& pa0, bf16x8& pa1, bf16x8& pa2, bf16x8& pa3) {
#pragma unroll
    for (int r = 0; r < 16; ++r) p1[r] = __builtin_amdgcn_exp2f(p1[r]);
    float ps = 0.f;
#pragma unroll
    for (int r = 0; r < 16; ++r) ps += p0[r];
#pragma unroll
    for (int r = 0; r < 16; ++r) ps += p1[r];
    { auto rr = __builtin_amdgcn_permlane32_swap(__float_as_uint(ps), __float_as_uint(ps), false, false); ps = __uint_as_float(rr[0]) + __uint_as_float(rr[1]); }
    l_reg = l_reg * alpha + ps;
#define MB_PK4(P, BASE, OUT) do { unsigned a0 = cvt_pk_bf16(P[BASE + 0], P[BASE + 1]), a1 = cvt_pk_bf16(P[BASE + 2], P[BASE + 3]); \
    unsigned b0 = cvt_pk_bf16(P[BASE + 4], P[BASE + 5]), b1 = cvt_pk_bf16(P[BASE + 6], P[BASE + 7]); \
    auto r0 = __builtin_amdgcn_permlane32_swap(a0, b0, false, false); auto r1 = __builtin_amdgcn_permlane32_swap(a1, b1, false, false); \
    u32x4 w = {r0[0], r1[0], r0[1], r1[1]}; OUT = *reinterpret_cast<bf16x8*>(&w); } while (0)
    MB_PK4(p0, 0, pa0); MB_PK4(p0, 8, pa1); MB_PK4(p1, 0, pa2); MB_PK4(p1, 8, pa3);
#undef MB_PK4
}
template <int D0> __device__ __forceinline__ void pv_one(f32x16& od, int vb, bf16x8 pa0, bf16x8 pa1, bf16x8 pa2, bf16x8 pa3) {
    const s16x4 l0 = tr_read<v_rd_off(D0, 0, 0)>(vb), h0 = tr_read<v_rd_off(D0, 0, 1)>(vb), l1 = tr_read<v_rd_off(D0, 1, 0)>(vb), h1 = tr_read<v_rd_off(D0, 1, 1)>(vb);
    const s16x4 l2 = tr_read<v_rd_off(D0, 2, 0)>(vb), h2 = tr_read<v_rd_off(D0, 2, 1)>(vb), l3 = tr_read<v_rd_off(D0, 3, 0)>(vb), h3 = tr_read<v_rd_off(D0, 3, 1)>(vb);
    asm volatile("s_waitcnt lgkmcnt(0)" ::: "memory"); MB_SBAR();
#define MB_PK(L, H) (bf16x8){L[0], L[1], L[2], L[3], H[0], H[1], H[2], H[3]}
    od = __builtin_amdgcn_mfma_f32_32x32x16_bf16(MB_PK(l0, h0), pa0, od, 0, 0, 0);
    od = __builtin_amdgcn_mfma_f32_32x32x16_bf16(MB_PK(l1, h1), pa1, od, 0, 0, 0);
    od = __builtin_amdgcn_mfma_f32_32x32x16_bf16(MB_PK(l2, h2), pa2, od, 0, 0, 0);
    od = __builtin_amdgcn_mfma_f32_32x32x16_bf16(MB_PK(l3, h3), pa3, od, 0, 0, 0);
#undef MB_PK
}
__device__ __forceinline__ void pv_d0(f32x16 (&o)[4], int vb, bf16x8 pa0, bf16x8 pa1, bf16x8 pa2, bf16x8 pa3) {
    pv_one<0>(o[0], vb, pa0, pa1, pa2, pa3); pv_one<1>(o[1], vb, pa0, pa1, pa2, pa3); pv_one<2>(o[2], vb, pa0, pa1, pa2, pa3); pv_one<3>(o[3], vb, pa0, pa1, pa2, pa3);
}

__device__ __forceinline__ void item(const bf16* __restrict__ q, const bf16* __restrict__ kv, bf16* __restrict__ part_o, float* __restrict__ part_ml, LAS unsigned char* lds,
                                     int tid, int b, int g, int kblk, int NT, bool own, int t, int rh, int slot, bool valid) {
    const int lane = tid & 63, r32 = lane & 31, hi = lane >> 5;
    const int h = g * 4 + rh;
    const bf16* Kh = kv + (size_t)(b * SEQ + kblk * MOBA_BLOCK) * 512 + g * HEAD_DIM;
    float m_reg = -1e30f, l_reg = 0.f; f32x16 o[4] = {}; bf16x8 qr[8];
    { const bf16* Qw = q + (size_t)(b * SEQ + t) * D_MODEL + h * HEAD_DIM + hi * 8;
#pragma unroll
      for (int d0 = 0; d0 < 8; ++d0) qr[d0] = *(const bf16x8*)(Qw + d0 * 16); }
    const float bias2 = __builtin_amdgcn_exp2f(-(float)(h + 1)) * LOG2E;
    const int trel = t - kblk * MOBA_BLOCK;
    const float tb4 = bias2 * (float)(4 * hi - trel);
    const int lim0 = trel - 4 * hi;
    const int sr = tid >> 4, sc = (tid & 15) * 8, vst0 = v_st(sr, sc), vst1 = v_st(32 + sr, sc);
    const int vb0 = (int)(unsigned)(uintptr_t)(lds + V_OFF) + v_rd_base(lane);
    bf16x8 vsA0, vsA1, ksA0, ksA1, vsB0, vsB1, ksB0, ksB1;
    const unsigned vo0 = (unsigned)(sr * 512 + sc) * 2u, vo1 = vo0 + 32u * 1024u;
    const char* KhB = (const char*)Kh;
#define MB_SLOAD_A(k0) do { const char* kt_ = KhB + (size_t)(k0) * 1024; vsA0 = *(const bf16x8*)(kt_ + 512 + vo0); vsA1 = *(const bf16x8*)(kt_ + 512 + vo1); \
        ksA0 = *(const bf16x8*)(kt_ + vo0); ksA1 = *(const bf16x8*)(kt_ + vo1); } while (0)
#define MB_SLOAD_B(k0) do { const char* kt_ = KhB + (size_t)(k0) * 1024; vsB0 = *(const bf16x8*)(kt_ + 512 + vo0); vsB1 = *(const bf16x8*)(kt_ + 512 + vo1); \
        ksB0 = *(const bf16x8*)(kt_ + vo0); ksB1 = *(const bf16x8*)(kt_ + vo1); } while (0)
#define MB_SWRITE(bb, V0, V1, K0, K1) do { *(LAS bf16x8*)(lds + V_OFF + (bb) * SHM_V + vst0) = V0; *(LAS bf16x8*)(lds + V_OFF + (bb) * SHM_V + vst1) = V1; \
        *(LAS bf16x8*)(lds + K_OFF + (bb) * SHM_K + MB_KSWZ(sr, sc * 2)) = K0; *(LAS bf16x8*)(lds + K_OFF + (bb) * SHM_K + MB_KSWZ(32 + sr, sc * 2)) = K1; } while (0)
#define MB_SWAIT() asm volatile("s_waitcnt vmcnt(4)" ::: "memory")
#define MB_RESC(a) do { if (__any((a) < 1.f)) { _Pragma("unroll") for (int d = 0; d < 4; ++d) _Pragma("unroll") for (int r = 0; r < 16; ++r) o[d][r] *= (a); } } while (0)
#define MB_PSM(P0, P1, MN, AL, tile) partialSM(P0, P1, m_reg, MN, AL, bias2, tb4 + bias2 * (float)((tile) * 64), own, lim0 - (tile) * 64)
    f32x16 pA0, pA1, pB0, pB1; float mnA, mnB, alA, alB; bf16x8 pa0, pa1, pa2, pa3;
    MB_SLOAD_A(0); asm volatile("s_waitcnt vmcnt(0)" ::: "memory"); MB_SWRITE(0, vsA0, vsA1, ksA0, ksA1); __syncthreads();
    qkt(pA0, pA1, lds + K_OFF, qr, r32, hi); MB_PSM(pA0, pA1, mnA, alA, 0);
    MB_SLOAD_B(64); if (2 < NT) MB_SLOAD_A(128);
    MB_SWAIT(); MB_SWRITE(1, vsB0, vsB1, ksB0, ksB1); __syncthreads();
    for (int j = 1; j + 1 < NT; j += 2) {
        MB_SBAR(); qkt(pB0, pB1, lds + K_OFF + SHM_K, qr, r32, hi);
        finishSM(pA0, pA1, alA, l_reg, pa0, pa1, pa2, pa3); MB_SBAR();
        MB_SLOAD_B((j + 2) * 64); MB_SBAR();
        pv_d0(o, vb0, pa0, pa1, pa2, pa3); MB_PSM(pB0, pB1, mnB, alB, j);
        __syncthreads(); MB_SWAIT(); MB_SWRITE(0, vsA0, vsA1, ksA0, ksA1);
        MB_RESC(alB); __syncthreads();
        MB_SBAR(); qkt(pA0, pA1, lds + K_OFF, qr, r32, hi);
        finishSM(pB0, pB1, alB, l_reg, pa0, pa1, pa2, pa3); MB_SBAR();
        if (j + 3 < NT) MB_SLOAD_A((j + 3) * 64); MB_SBAR();
        pv_d0(o, vb0 + SHM_V, pa0, pa1, pa2, pa3); MB_PSM(pA0, pA1, mnA, alA, j + 1);
        __syncthreads(); MB_SWAIT(); MB_SWRITE(1, vsB0, vsB1, ksB0, ksB1);
        MB_RESC(alA); __syncthreads();
    }
    MB_SBAR(); qkt(pB0, pB1, lds + K_OFF + SHM_K, qr, r32, hi);
    finishSM(pA0, pA1, alA, l_reg, pa0, pa1, pa2, pa3); MB_SBAR();
    pv_d0(o, vb0, pa0, pa1, pa2, pa3); MB_PSM(pB0, pB1, mnB, alB, NT - 1);
    __syncthreads(); MB_RESC(alB);
    finishSM(pB0, pB1, alB, l_reg, pa0, pa1, pa2, pa3); MB_SBAR();
    pv_d0(o, vb0 + SHM_V, pa0, pa1, pa2, pa3);
    if (valid) {
        const float inv = 1.f / l_reg;
        const size_t rg = ((size_t)(b * SEQ + t) * N_HEADS + h) * 4 + slot;
        bf16* po = part_o + rg * HEAD_DIM + 4 * hi;
#pragma unroll
        for (int d0 = 0; d0 < 4; ++d0)
#pragma unroll
            for (int rq = 0; rq < 4; ++rq) { u32x2 w; w.x = cvt_pk_bf16(o[d0][rq * 4 + 0] * inv, o[d0][rq * 4 + 1] * inv); w.y = cvt_pk_bf16(o[d0][rq * 4 + 2] * inv, o[d0][rq * 4 + 3] * inv);
                *(u32x2*)(po + d0 * 32 + rq * 8) = w; }
        if (hi == 0) { f32x2 ml; ml.x = m_reg; ml.y = l_reg; *(f32x2*)(part_ml + rg * 2) = ml; }
    }
    __syncthreads();
#undef MB_SLOAD_A
#undef MB_SLOAD_B
#undef MB_SWRITE
#undef MB_SWAIT
#undef MB_RESC
#undef MB_PSM
}
}

constexpr size_t WS_SELB = WS_T;
constexpr size_t WS_PML = WS_T + 2 * MiB;
constexpr size_t WS_LISTS = WS_T + 16 * MiB;
constexpr size_t WS_PARTO = WS_SCORES;
constexpr int CW_LCNT = 16384 + 512;

__device__ __forceinline__ void phase_kmeans(KP P) {
    int tz = threadIdx.x; asm volatile("" : "+v"(tz)); const int tid = tz;
    const bf16* kv = (const bf16*)(P->ws + WS_KV); float* km = (float*)(P->ws + WS_KM);
    for (int it = blockIdx.x; it < BATCH * N_KV * N_BLOCKS; it += gridDim.x) {
        const int blk = it % N_BLOCKS, g = (it / N_BLOCKS) % N_KV, b = it / (N_BLOCKS * N_KV);
        if (tid < HEAD_DIM) { float s = 0.f;
            for (int i = 0; i < MOBA_BLOCK; ++i) s += bf2f(kv[(size_t)(b * SEQ + blk * MOBA_BLOCK + i) * 512 + g * HEAD_DIM + tid]);
            const float mval = s * (1.f / MOBA_BLOCK); km[(size_t)it * HEAD_DIM + tid] = mval;
            const unsigned hi16 = cvt_pk_bf16(mval, 0.f) & 0xffffu; const float rem = mval - bflo(hi16);
            bf16* kmh = (bf16*)(km + 65536); kmh[(size_t)it * HEAD_DIM + tid] = (bf16)hi16; kmh[(size_t)(BATCH * N_KV * N_BLOCKS + it) * HEAD_DIM + tid] = (bf16)(cvt_pk_bf16(rem, 0.f) & 0xffffu); }
    }
}
__device__ __forceinline__ void phase_moba_gate(KP P, LAS unsigned char* lds) {
    int tz = threadIdx.x; asm volatile("" : "+v"(tz)); const int tid = tz, lane = tid & 63, wave = tid >> 6;
    const bf16* q = (const bf16*)(P->ws + WS_QKVI); const float* km = (const float*)(P->ws + WS_KM); unsigned char* selb = (unsigned char*)(P->ws + WS_SELB);
    LAS float* qs = (LAS float*)(lds + wave * 2048);
    const int blk = lane & 31, half = lane >> 5;
    for (int it = blockIdx.x * NWAVES + wave; it < NTOK * 2; it += gridDim.x * NWAVES) {
        const int tok = it >> 1, g = it & 1, b = tok / SEQ, t = tok % SEQ, own = t >> 8;
        unsigned char* sb = selb + ((size_t)tok * 8 + g * 4) * 4;
        if (own < 3) { if (lane < 4) { for (int s2 = own; s2 < 3; ++s2) sb[lane * 4 + s2] = 0xFF; } }
        if (own == 0) continue;
        { const u32x4 w = *(const u32x4*)(q + (size_t)tok * D_MODEL + g * 512 + lane * 8);
          LAS float* d = qs + lane * 8;
          d[0] = bflo(w.x); d[1] = bfhi(w.x); d[2] = bflo(w.y); d[3] = bfhi(w.y); d[4] = bflo(w.z); d[5] = bfhi(w.z); d[6] = bflo(w.w); d[7] = bfhi(w.w); }
        asm volatile("s_waitcnt lgkmcnt(0)" ::: "memory");
        float acc[4] = {0.f, 0.f, 0.f, 0.f};
        const float* kp = km + ((size_t)(b * N_KV + g) * N_BLOCKS + blk) * HEAD_DIM + half * 64;
#pragma unroll 4
        for (int i = 0; i < 16; ++i) { const f32x4 kk = *(const f32x4*)(kp + 4 * i);
#pragma unroll
            for (int r = 0; r < 4; ++r) { const f32x4 qq = *(const LAS f32x4*)(qs + r * 128 + half * 64 + 4 * i); acc[r] += (kk[0] * qq[0] + kk[1] * qq[1]) + (kk[2] * qq[2] + kk[3] * qq[3]); } }
#pragma unroll
        for (int r = 0; r < 4; ++r) { acc[r] += __shfl_xor(acc[r], 32); if (blk >= own) acc[r] = -INFINITY; }
        int rank[4] = {0, 0, 0, 0};
#pragma unroll
        for (int j = 0; j < 32; ++j) {
#pragma unroll
            for (int r = 0; r < 4; ++r) { const float vj = __uint_as_float(__builtin_amdgcn_readlane(__float_as_uint(acc[r]), j)); rank[r] += (vj > acc[r] || (vj == acc[r] && j < blk)) ? 1 : 0; }
        }
        if (half == 0 && blk < own) {
#pragma unroll
            for (int r = 0; r < 4; ++r) if (rank[r] < 3) sb[r * 4 + rank[r]] = (unsigned char)blk;
        }
    }
}

__device__ __forceinline__ void phase_moba_gate2(KP P) {
    typedef float f32x16 __attribute__((ext_vector_type(16)));
    int tz = threadIdx.x; asm volatile("" : "+v"(tz)); const int tid = tz, lane = tid & 63, wave = tid >> 6, r32 = lane & 31, hi = lane >> 5;
    const bf16* q = (const bf16*)(P->ws + WS_QKVI); const bf16* kmh = (const bf16*)((const float*)(P->ws + WS_KM) + 65536); unsigned char* selb = (unsigned char*)(P->ws + WS_SELB);
    const int gw = blockIdx.x * NWAVES + wave, NGW = gridDim.x * NWAVES;
    int cur_bg = -1; bf16x8 ah[8], al[8];
    for (int tile = gw * 4; tile < 8192; tile += NGW * 4) {
#pragma unroll 1
        for (int sub = 0; sub < 4; ++sub) {
            const int tl = tile + sub, bg = tl >> 10, b = bg >> 1, g = bg & 1, rt = tl & 1023;
            if (bg != cur_bg) { cur_bg = bg;
                const bf16* kp = kmh + ((size_t)(b * N_KV + g) * N_BLOCKS + r32) * HEAD_DIM + 8 * hi;
#pragma unroll
                for (int ks = 0; ks < 8; ++ks) { ah[ks] = *(const bf16x8*)(kp + 16 * ks); al[ks] = *(const bf16x8*)(kp + (size_t)BATCH * N_KV * N_BLOCKS * HEAD_DIM + 16 * ks); } }
            const int row = rt * 32 + r32, t = row >> 2, rh = row & 3, own = t >> 8, tok = b * SEQ + t;
            const bf16* qp = q + (size_t)tok * D_MODEL + (g * 4 + rh) * HEAD_DIM + 8 * hi;
            f32x16 acc = {};
#pragma unroll
            for (int ks = 0; ks < 8; ++ks) { const bf16x8 qv = *(const bf16x8*)(qp + 16 * ks);
                acc = __builtin_amdgcn_mfma_f32_32x32x16_bf16(ah[ks], qv, acc, 0, 0, 0); acc = __builtin_amdgcn_mfma_f32_32x32x16_bf16(al[ks], qv, acc, 0, 0, 0); }
            float v[16];
#pragma unroll
            for (int r = 0; r < 16; ++r) { const int blk = (r & 3) + 8 * (r >> 2) + 4 * hi; v[r] = (blk < own) ? acc[r] : -INFINITY; }
            float bv[3]; int bi[3];
#pragma unroll
            for (int p = 0; p < 3; ++p) { float best = -INFINITY; int br = -1;
#pragma unroll
                for (int r = 0; r < 16; ++r) { if (v[r] > best) { best = v[r]; br = r; } }
                bv[p] = best; bi[p] = (br < 0) ? 255 : ((br & 3) + 8 * (br >> 2) + 4 * hi);
#pragma unroll
                for (int r = 0; r < 16; ++r) { if (r == br) v[r] = -INFINITY; } }
            float ov[3]; int oi[3];
#pragma unroll
            for (int p = 0; p < 3; ++p) { ov[p] = __shfl_xor(bv[p], 32); oi[p] = __shfl_xor(bi[p], 32); }
            int ia = 0, ib = 0; int res[3];
#pragma unroll
            for (int p = 0; p < 3; ++p) {
                const float va = (ia == 0) ? bv[0] : (ia == 1) ? bv[1] : (ia == 2) ? bv[2] : -INFINITY; const int xa = (ia == 0) ? bi[0] : (ia == 1) ? bi[1] : (ia == 2) ? bi[2] : 255;
                const float vb = (ib == 0) ? ov[0] : (ib == 1) ? ov[1] : (ib == 2) ? ov[2] : -INFINITY; const int xb = (ib == 0) ? oi[0] : (ib == 1) ? oi[1] : (ib == 2) ? oi[2] : 255;
                const bool takeA = (va > vb) || (va == vb && xa < xb);
                const float vv = takeA ? va : vb; const int xx = takeA ? xa : xb;
                res[p] = (vv > -INFINITY) ? xx : 255; if (takeA) ++ia; else ++ib; }
            if (hi == 0) { const unsigned w = (unsigned)res[0] | ((unsigned)res[1] << 8) | ((unsigned)res[2] << 16) | 0xFF000000u;
                *(unsigned*)(selb + ((size_t)tok * 8 + g * 4 + rh) * 4) = w; }
        }
    }
}

__device__ __forceinline__ void phase_moba_lists(KP P, LAS unsigned char* lds) {
    int tz = threadIdx.x; asm volatile("" : "+v"(tz)); const int tid = tz, lane = tid & 63, wave = tid >> 6;
    const u32x4* selb = (const u32x4*)(P->ws + WS_SELB); unsigned* lists = (unsigned*)(P->ws + WS_LISTS); unsigned* lcnt = (unsigned*)(P->ws + WS_CTL) + CW_LCNT;
    LAS int* wtot = (LAS int*)lds;
    for (int li = blockIdx.x; li < 256; li += gridDim.x) {
        const int j = li & 31, g = (li >> 5) & 1, b = li >> 6, base_t = (j + 1) * MOBA_BLOCK, n_t = SEQ - base_t;
        unsigned* out = lists + (size_t)li * 32768;
        int running = 0;
        for (int i0 = 0; i0 < n_t; i0 += 512) {
            const int ti = i0 + tid; const bool ok = ti < n_t; const int t = base_t + ti;
            u32x4 w = {0xFFFFFFFFu, 0xFFFFFFFFu, 0xFFFFFFFFu, 0xFFFFFFFFu};
            if (ok) w = selb[((size_t)(b * SEQ + t) * 8 + g * 4) / 4];
            int ms[4];
#pragma unroll
            for (int r = 0; r < 4; ++r) { const unsigned x = w[r]; ms[r] = ((x & 0xFFu) == (unsigned)j) ? 0 : (((x >> 8) & 0xFFu) == (unsigned)j) ? 1 : (((x >> 16) & 0xFFu) == (unsigned)j) ? 2 : -1; }
            const int c = (ms[0] >= 0) + (ms[1] >= 0) + (ms[2] >= 0) + (ms[3] >= 0);
            int inc = c;
#pragma unroll
            for (int o = 1; o < 64; o <<= 1) { const int v = __shfl_up(inc, o); if (lane >= o) inc += v; }
            __syncthreads();
            if (lane == 63) wtot[wave] = inc;
            __syncthreads();
            int woff = 0, tot = 0;
#pragma unroll
            for (int x = 0; x < NWAVES; ++x) { const int v = wtot[x]; if (x < wave) woff += v; tot += v; }
            int pos = running + woff + inc - c;
#pragma unroll
            for (int r = 0; r < 4; ++r) if (ms[r] >= 0) out[pos++] = (unsigned)t | ((unsigned)r << 13) | ((unsigned)ms[r] << 15);
            running += tot;
        }
        if (tid == 0) lcnt[li] = (unsigned)running;
        __syncthreads();
    }
}
__device__ __forceinline__ void phase_moba_attn(KP P, LAS unsigned char* lds) {
    int tz = threadIdx.x; asm volatile("" : "+v"(tz)); const int tid = tz, lane = tid & 63, wave = tid >> 6;
    const bf16* q = (const bf16*)(P->ws + WS_QKVI); const bf16* kv = (const bf16*)(P->ws + WS_KV);
    bf16* part_o = (bf16*)(P->ws + WS_PARTO); float* part_ml = (float*)(P->ws + WS_PML);
    const unsigned* lists = (const unsigned*)(P->ws + WS_LISTS); const unsigned* lcnt = (const unsigned*)(P->ws + WS_CTL) + CW_LCNT;
    LAS int* pre = (LAS int*)(lds + mb::PRE_OFF);
    LAS int* cn = pre + 260;
    if (tid < 256) cn[tid] = (int)lcnt[tid];
    __syncthreads();
    if (tid == 0) { int s = 0; for (int i = 0; i < 256; ++i) { pre[i] = s; s += (cn[i] + 255) >> 8; } pre[256] = s; }
    __syncthreads();
    const int npast = pre[256], total = npast + 1024;
    for (int it = blockIdx.x; it < total; it += gridDim.x) {
        int b, g, kblk, NT, t, rh, slot; bool own, valid;
        const int ri = wave * 32 + (lane & 31);
        if (it < npast) {
            int lo = 0, hi = 256;
            while (hi - lo > 1) { const int mid = (lo + hi) >> 1; if (pre[mid] <= it) lo = mid; else hi = mid; }
            const int li = lo, chunk = it - pre[li], n = cn[li];
            kblk = li & 31; g = (li >> 5) & 1; b = li >> 6; NT = 4; own = false;
            int idx = chunk * 256 + ri; valid = idx < n; if (!valid) idx = chunk * 256;
            const unsigned e = lists[(size_t)li * 32768 + idx];
            t = (int)(e & 0x1FFFu); rh = (int)((e >> 13) & 3u); slot = (int)((e >> 15) & 3u);
        } else {
            const int oi = it - npast, chunk = oi & 3, bi = oi >> 2;
            kblk = bi & 31; g = (bi >> 5) & 1; b = bi >> 6; NT = chunk < 2 ? 2 : 4; own = true; valid = true;
            t = kblk * MOBA_BLOCK + chunk * 64 + (ri >> 2); rh = ri & 3; slot = 3;
        }
        mb::item(q, kv, part_o, part_ml, lds, tid, b, g, kblk, NT, own, t, rh, slot, valid);
    }
}

namespace mb {
constexpr int SEG_K = 0, SEG_V = 65536, SEG_PRE = 131072, SEGC = 8;
__device__ __forceinline__ void stage_block(const bf16* __restrict__ kv, LAS unsigned char* lds, int tid, int b, int g, int kblk) {
    const char* KhB = (const char*)(kv + (size_t)(b * SEQ + kblk * MOBA_BLOCK) * 512 + g * HEAD_DIM);
    const int sr = tid >> 4, sc = (tid & 15) * 8, vst0 = v_st(sr, sc), vst1 = v_st(32 + sr, sc);
    const unsigned vo0 = (unsigned)(sr * 512 + sc) * 2u, vo1 = vo0 + 32u * 1024u;
#pragma unroll
    for (int h2 = 0; h2 < 2; ++h2) {
        bf16x8 kx[2][2], vx[2][2];
#pragma unroll
        for (int tt = 0; tt < 2; ++tt) { const char* kt_ = KhB + (size_t)((h2 * 2 + tt) * 64) * 1024;
            kx[tt][0] = *(const bf16x8*)(kt_ + vo0); kx[tt][1] = *(const bf16x8*)(kt_ + vo1); vx[tt][0] = *(const bf16x8*)(kt_ + 512 + vo0); vx[tt][1] = *(const bf16x8*)(kt_ + 512 + vo1); }
#pragma unroll
        for (int tt = 0; tt < 2; ++tt) { const int tile = h2 * 2 + tt;
            *(LAS bf16x8*)(lds + SEG_K + tile * SHM_K + MB_KSWZ(sr, sc * 2)) = kx[tt][0]; *(LAS bf16x8*)(lds + SEG_K + tile * SHM_K + MB_KSWZ(32 + sr, sc * 2)) = kx[tt][1];
            *(LAS bf16x8*)(lds + SEG_V + tile * SHM_V + vst0) = vx[tt][0]; *(LAS bf16x8*)(lds + SEG_V + tile * SHM_V + vst1) = vx[tt][1]; }
    }
}
__device__ __forceinline__ void chunk_rows(const bf16* __restrict__ q, bf16* __restrict__ part_o, float* __restrict__ part_ml, LAS unsigned char* lds, int lane,
                                           int b, int g, int kblk, int NT, bool own, int t, int rh, int slot, bool valid) {
    const int r32 = lane & 31, hi = lane >> 5, h = g * 4 + rh;
    float m_reg = -1e30f, l_reg = 0.f; f32x16 o[4] = {}; bf16x8 qr[8];
    { const bf16* Qw = q + (size_t)(b * SEQ + t) * D_MODEL + h * HEAD_DIM + hi * 8;
#pragma unroll
      for (int d0 = 0; d0 < 8; ++d0) qr[d0] = *(const bf16x8*)(Qw + d0 * 16); }
    const float bias2 = __builtin_amdgcn_exp2f(-(float)(h + 1)) * LOG2E;
    const int trel = t - kblk * MOBA_BLOCK;
    const float tb4 = bias2 * (float)(4 * hi - trel);
    const int lim0 = trel - 4 * hi;
    const int vb0 = (int)(unsigned)(uintptr_t)(lds + SEG_V) + v_rd_base(lane);
    for (int tile = 0; tile < NT; ++tile) {
        f32x16 p0, p1; float mn, al; bf16x8 pa0, pa1, pa2, pa3;
        qkt(p0, p1, lds + SEG_K + tile * SHM_K, qr, r32, hi);
        partialSM(p0, p1, m_reg, mn, al, bias2, tb4 + bias2 * (float)(tile * 64), own, lim0 - tile * 64);
        if (__any(al < 1.f)) {
#pragma unroll
            for (int d = 0; d < 4; ++d)
#pragma unroll
                for (int r = 0; r < 16; ++r) o[d][r] *= al; }
        finishSM(p0, p1, al, l_reg, pa0, pa1, pa2, pa3);
        pv_d0(o, vb0 + tile * SHM_V, pa0, pa1, pa2, pa3);
    }
    if (valid) {
        const float inv = 1.f / l_reg;
        const size_t rg = ((size_t)(b * SEQ + t) * N_HEADS + h) * 4 + slot;
        bf16* po = part_o + rg * HEAD_DIM + 4 * hi;
#pragma unroll
        for (int d0 = 0; d0 < 4; ++d0)
#pragma unroll
            for (int rq = 0; rq < 4; ++rq) { u32x2 w; w.x = cvt_pk_bf16(o[d0][rq * 4 + 0] * inv, o[d0][rq * 4 + 1] * inv); w.y = cvt_pk_bf16(o[d0][rq * 4 + 2] * inv, o[d0][rq * 4 + 3] * inv);
                *(u32x2*)(po + d0 * 32 + rq * 8) = w; }
        if (hi == 0) { f32x2 ml; ml.x = m_reg; ml.y = l_reg; *(f32x2*)(part_ml + rg * 2) = ml; }
    }
}
}
constexpr int CW_MQ = 20480;
__device__ __forceinline__ void phase_moba_attn2(KP P, int Lb, LAS unsigned char* lds) {
    int tz = threadIdx.x; asm volatile("" : "+v"(tz)); const int tid = tz, lane = tid & 63, wave = tid >> 6;
    const bf16* q = (const bf16*)(P->ws + WS_QKVI); const bf16* kv = (const bf16*)(P->ws + WS_KV);
    bf16* part_o = (bf16*)(P->ws + WS_PARTO); float* part_ml = (float*)(P->ws + WS_PML);
    const unsigned* lists = (const unsigned*)(P->ws + WS_LISTS); const unsigned* lcnt = (const unsigned*)(P->ws + WS_CTL) + CW_LCNT;
    unsigned* qhead = (unsigned*)(P->ws + WS_CTL) + CW_MQ + Lb * 64;
    LAS int* pre = (LAS int*)(lds + mb::SEG_PRE);
    LAS int* cn = pre + 260;
    LAS int* cur = pre + 520;
    if (tid < 256) cn[tid] = (int)lcnt[tid];
    __syncthreads();
    if (tid == 0) { int s2 = 0; for (int i = 0; i < 256; ++i) { pre[i] = s2; const int nch = (cn[i] + 255) >> 8; s2 += (nch + mb::SEGC - 1) / mb::SEGC; } pre[256] = s2; }
    __syncthreads();
    const int npast = pre[256], total = npast + 256;
    for (;;) {
        if (tid == 0) cur[0] = (int)__hip_atomic_fetch_add(qhead, 1u, __ATOMIC_RELAXED, __HIP_MEMORY_SCOPE_AGENT);
        __syncthreads();
        const int sg = cur[0];
        if (sg >= total) break;
        int b, g, kblk, li = 0, ch0, nch, n = 0; bool own;
        if (sg < npast) {
            int lo = 0, hi2 = 256;
            while (hi2 - lo > 1) { const int mid = (lo + hi2) >> 1; if (pre[mid] <= sg) lo = mid; else hi2 = mid; }
            li = lo; n = cn[li]; ch0 = (sg - pre[li]) * mb::SEGC; const int ncht = (n + 255) >> 8; nch = ncht - ch0 < mb::SEGC ? ncht - ch0 : mb::SEGC;
            kblk = li & 31; g = (li >> 5) & 1; b = li >> 6; own = false;
        } else { const int bi = sg - npast; kblk = bi & 31; g = (bi >> 5) & 1; b = bi >> 6; own = true; ch0 = 0; nch = 4; }
        mb::stage_block(kv, lds, tid, b, g, kblk);
        __syncthreads();
        const int ri = wave * 32 + (lane & 31);
        for (int c = 0; c < nch; ++c) {
            const int chunk = ch0 + c; int t, rh, slot, NT; bool valid;
            if (!own) { int idx = chunk * 256 + ri; valid = idx < n; if (!valid) idx = chunk * 256;
                const unsigned e = lists[(size_t)li * 32768 + idx];
                t = (int)(e & 0x1FFFu); rh = (int)((e >> 13) & 3u); slot = (int)((e >> 15) & 3u); NT = 4;
            } else { valid = true; t = kblk * MOBA_BLOCK + chunk * 64 + (ri >> 2); rh = ri & 3; slot = 3; NT = chunk + 1; }
            mb::chunk_rows(q, part_o, part_ml, lds, lane, b, g, kblk, NT, own, t, rh, slot, valid);
        }
        __syncthreads();
    }
}

__device__ __forceinline__ void phase_moba_combine(KP P) {
    int tz = threadIdx.x; asm volatile("" : "+v"(tz)); const int tid = tz;
    const bf16* part_o = (const bf16*)(P->ws + WS_PARTO); const float* part_ml = (const float*)(P->ws + WS_PML); bf16* attn = (bf16*)(P->ws + WS_ATTN);
    const int sub = tid & 15;
    const int stride = (gridDim.x * 512) >> 4;
    for (int rg0 = (blockIdx.x * 512 + tid) >> 4; rg0 < NTOK * N_HEADS; rg0 += 2 * stride) {
        f32x4 mlv[2][2]; u32x4 pv[2][4]; bool has[2];
#pragma unroll
        for (int u = 0; u < 2; ++u) { const int rg = rg0 + u * stride; has[u] = rg < NTOK * N_HEADS; const int rgc = has[u] ? rg : rg0;
            mlv[u][0] = *(const f32x4*)(part_ml + (size_t)rgc * 8); mlv[u][1] = *(const f32x4*)(part_ml + (size_t)rgc * 8 + 4);
#pragma unroll
            for (int s2 = 0; s2 < 4; ++s2) pv[u][s2] = __builtin_nontemporal_load((const u32x4*)(part_o + ((size_t)rgc * 4 + s2) * HEAD_DIM + sub * 8)); }
#pragma unroll
        for (int u = 0; u < 2; ++u) { const int rg = rg0 + u * stride;
            if (!has[u]) continue;
            const int tok = rg >> 3, own = (tok % SEQ) >> 8, nv = own < 3 ? own : 3;
            const float mm[4] = {mlv[u][0][0], mlv[u][0][2], mlv[u][1][0], mlv[u][1][2]}, ll[4] = {mlv[u][0][1], mlv[u][0][3], mlv[u][1][1], mlv[u][1][3]};
            float m[4], l[4];
#pragma unroll
            for (int s2 = 0; s2 < 4; ++s2) { const bool ok = (s2 == 3) || (s2 < nv); m[s2] = ok ? mm[s2] : -INFINITY; l[s2] = ok ? ll[s2] : 0.f; }
            const float M = fmaxf(fmaxf(m[0], m[1]), fmaxf(m[2], m[3]));
            float w[4], W = 0.f;
#pragma unroll
            for (int s2 = 0; s2 < 4; ++s2) { w[s2] = l[s2] * __builtin_amdgcn_exp2f(m[s2] - M); W += w[s2]; }
            const float inv = 1.f / W;
            float acc[8] = {0.f, 0.f, 0.f, 0.f, 0.f, 0.f, 0.f, 0.f};
#pragma unroll
            for (int s2 = 0; s2 < 4; ++s2) { const bool ok = (s2 == 3) || (s2 < nv); const u32x4 v = pv[u][s2]; const float ws2 = ok ? w[s2] * inv : 0.f;
                if (ok) { acc[0] += ws2 * bflo(v.x); acc[1] += ws2 * bfhi(v.x); acc[2] += ws2 * bflo(v.y); acc[3] += ws2 * bfhi(v.y);
                          acc[4] += ws2 * bflo(v.z); acc[5] += ws2 * bfhi(v.z); acc[6] += ws2 * bflo(v.w); acc[7] += ws2 * bfhi(v.w); } }
            u32x4 o; o.x = cvt_pk_bf16(acc[0], acc[1]); o.y = cvt_pk_bf16(acc[2], acc[3]); o.z = cvt_pk_bf16(acc[4], acc[5]); o.w = cvt_pk_bf16(acc[6], acc[7]);
            *(u32x4*)(attn + (size_t)rg * HEAD_DIM + sub * 8) = o;
        }
    }
}


#ifndef D1_EXP
#define D1_EXP 0
#endif
constexpr int D1_QS = 4100, D1_SM = 32 * D1_QS, D1_SELIDX = D1_SM + 1024, D1_NT = 992;
__device__ __forceinline__ unsigned fkey2(float f) { const unsigned u = __float_as_uint(f); return (u & 0x80000000u) ? ~u : (u | 0x80000000u); }
template <int PASS, int EXP>
__device__ __forceinline__ void d1_scan(const bf16* __restrict__ ikb, int qt, int kt_end, int wave, int lane, const bf16x8 (&qb)[4][4], const float (&wv)[4], LAS unsigned char* lds, unsigned thr, float flo = 0.f, float finv = 0.f, unsigned bstar = 0) {
    typedef float f32x16 __attribute__((ext_vector_type(16)));
    const int r32 = lane & 31, hi = lane >> 5;
    LAS unsigned* hq = (LAS unsigned*)(lds + r32 * D1_QS);
    LAS unsigned* sm = (LAS unsigned*)(lds + D1_SM);
    bf16x8 ka[4];
    int kt = wave;
    if (kt <= kt_end) { const bf16* kp = ikb + (size_t)(kt * 32 + r32) * QLD + 8 * hi;
#pragma unroll
        for (int ks = 0; ks < 4; ++ks) ka[ks] = *(const bf16x8*)(kp + 16 * ks); }
    for (; kt <= kt_end; kt += 8) {
        bf16x8 kn[4];
#pragma unroll
        for (int ks = 0; ks < 4; ++ks) kn[ks] = ka[ks];
        if (kt + 8 <= kt_end) { const bf16* kp = ikb + (size_t)((kt + 8) * 32 + r32) * QLD + 8 * hi;
#pragma unroll
            for (int ks = 0; ks < 4; ++ks) kn[ks] = *(const bf16x8*)(kp + 16 * ks); }
        float sc[16];
#pragma unroll
        for (int r = 0; r < 16; ++r) sc[r] = 0.f;
#pragma unroll
        for (int h = 0; h < 4; ++h) { f32x16 acc = {};
#pragma unroll
            for (int ks = 0; ks < 4; ++ks) acc = __builtin_amdgcn_mfma_f32_32x32x16_bf16(ka[ks], qb[h][ks], acc, 0, 0, 0);
#pragma unroll
            for (int r = 0; r < 16; ++r) sc[r] = fmaf(wv[h], fmaxf(acc[r], 0.f), sc[r]); }
        int kbase = kt * 32 + 4 * hi; asm volatile("" : "+v"(kbase));
        const int lim = (kt == qt) ? (r32 - 4 * hi) : 64;
#pragma unroll
        for (int r = 0; r < 16; ++r) {
            const int kc = (r & 3) + 8 * (r >> 2);
            const bool valid = kc <= lim;
            const unsigned key = fkey2(sc[r]);
            if (PASS == 1) { if (EXP == 3) { if (key == 12345u) hq[0] = 1u; } else if (valid && EXP != 2) { const unsigned bin = key >> 21; (void)__hip_atomic_fetch_add(hq + (bin >> 1), 1u << (16 * (bin & 1)), __ATOMIC_RELAXED, __HIP_MEMORY_SCOPE_WORKGROUP); } }
            else if (PASS == 2) { if (valid && (key >> 21) == thr) { const unsigned bin = (key >> 10) & 2047u; (void)__hip_atomic_fetch_add(hq + (bin >> 1), 1u << (16 * (bin & 1)), __ATOMIC_RELAXED, __HIP_MEMORY_SCOPE_WORKGROUP); } }
            else if (PASS == 4) { if (valid && sc[r] >= flo) { unsigned bin = (unsigned)((sc[r] - flo) * finv); bin = bin > 2047u ? 2047u : bin; (void)__hip_atomic_fetch_add(hq + (bin >> 1), 1u << (16 * (bin & 1)), __ATOMIC_RELAXED, __HIP_MEMORY_SCOPE_WORKGROUP); } }
            else if (PASS == 5) { if (valid && sc[r] >= flo) { unsigned bin = (unsigned)((sc[r] - flo) * finv); bin = bin > 2047u ? 2047u : bin; const unsigned sidx = (unsigned)(kbase + kc);
                    if (bin > bstar) (void)__hip_atomic_fetch_or(hq + 512 + (sidx >> 5), 1u << (sidx & 31u), __ATOMIC_RELAXED, __HIP_MEMORY_SCOPE_WORKGROUP);
                    else if (bin == bstar) {
                        if (key == 0x80000000u) (void)__hip_atomic_fetch_or(hq + 768 + (sidx >> 5), 1u << (sidx & 31u), __ATOMIC_RELAXED, __HIP_MEMORY_SCOPE_WORKGROUP);
                        else { const unsigned cp = __hip_atomic_fetch_add(sm + 160 + r32, 1u, __ATOMIC_RELAXED, __HIP_MEMORY_SCOPE_WORKGROUP); if (cp < 256u) { hq[cp] = key; ((LAS unsigned short*)(hq + 256))[cp] = (unsigned short)sidx; } } } } }
            else { if (valid) { const unsigned p22 = key >> 10; const unsigned sidx = (unsigned)(kbase + kc);
                    if (p22 > thr) (void)__hip_atomic_fetch_or(hq + 512 + (sidx >> 5), 1u << (sidx & 31u), __ATOMIC_RELAXED, __HIP_MEMORY_SCOPE_WORKGROUP);
                    else if (p22 == thr) {
                        if (key == 0x80000000u) (void)__hip_atomic_fetch_or(hq + 768 + (sidx >> 5), 1u << (sidx & 31u), __ATOMIC_RELAXED, __HIP_MEMORY_SCOPE_WORKGROUP);
                        else { const unsigned cp = __hip_atomic_fetch_add(sm + 160 + r32, 1u, __ATOMIC_RELAXED, __HIP_MEMORY_SCOPE_WORKGROUP); if (cp < 256u) { hq[cp] = key; ((LAS unsigned short*)(hq + 256))[cp] = (unsigned short)sidx; } } } } }
        }
#pragma unroll
        for (int ks = 0; ks < 4; ++ks) ka[ks] = kn[ks];
    }
}
__device__ __forceinline__ bool d1_find(LAS unsigned* H, unsigned need, int lane, unsigned& bin_out, unsigned& above_out) {
    unsigned mine = 0;
#pragma unroll
    for (int i = 0; i < 16; ++i) { const unsigned w = H[lane * 16 + i]; mine += (w & 0xFFFFu) + (w >> 16); }
    unsigned inc = mine;
#pragma unroll
    for (int o = 1; o < 64; o <<= 1) { const unsigned v = __shfl_down(inc, o); if (lane + o < 64) inc += v; }
    const unsigned above = inc - mine; const bool found = (above < need) && (inc >= need);
    const unsigned long long bal = __ballot(found); const int src = bal ? (__ffsll((long long)bal) - 1) : 0;
    const unsigned ab0 = __shfl(above, src);
    unsigned cj = 0;
    if (lane < 32) { const int bidx = src * 32 + 31 - lane; const unsigned w = H[bidx >> 1]; cj = (bidx & 1) ? (w >> 16) : (w & 0xFFFFu); }
    unsigned inc2 = cj;
#pragma unroll
    for (int o = 1; o < 32; o <<= 1) { const unsigned v = __shfl_up(inc2, o); if (lane >= o) inc2 += v; }
    const bool hit = (lane < 32) && (ab0 + inc2 >= need) && (ab0 + inc2 - cj < need);
    const unsigned long long bal2 = __ballot(hit); const int l2 = bal2 ? (__ffsll((long long)bal2) - 1) : 0;
    bin_out = (unsigned)(src * 32 + 31 - l2); above_out = ab0 + __shfl(inc2 - cj, l2);
    return bal != 0ull;
}
template <int EXP>
__device__ __forceinline__ void phase_dsa_topk(KP P, LAS unsigned char* lds, size_t sel_off) {
    int tz = threadIdx.x; asm volatile("" : "+v"(tz)); const int tid = tz, lane = tid & 63, wave = tid >> 6, r32 = lane & 31, hi = lane >> 5;
    const bf16* qkvi = (const bf16*)(P->ws + WS_QKVI); const float* iw = (const float*)(P->ws + WS_IW); int* sel = (int*)(P->ws + sel_off);
    LAS unsigned* sm = (LAS unsigned*)(lds + D1_SM);
    const int G = gridDim.x, nrounds = (D1_NT + G - 1) / G;
    for (int rho = 0; rho < nrounds; ++rho) {
        const int pos = (rho & 1) ? (G - 1 - (int)blockIdx.x) : (int)blockIdx.x, i = rho * G + pos;
        if (i >= D1_NT) continue;
        const int qt = 255 - (i >> 2), b = i & 3, t0 = qt * 32, tok0 = b * SEQ + t0;
        for (int w = tid; w < (D1_SM + 1024) / 4; w += 512) ((LAS unsigned*)lds)[w] = 0u;
        bf16x8 qb[4][4]; float wv[4];
        { const bf16* qp = qkvi + (size_t)(tok0 + r32) * QLD + COL_IQ + 8 * hi;
#pragma unroll
          for (int h = 0; h < 4; ++h)
#pragma unroll
              for (int ks = 0; ks < 4; ++ks) qb[h][ks] = *(const bf16x8*)(qp + h * IDX_DIM + 16 * ks);
          const f32x4 w4 = *(const f32x4*)(iw + (size_t)(tok0 + r32) * 4); wv[0] = w4[0]; wv[1] = w4[1]; wv[2] = w4[2]; wv[3] = w4[3]; }
        const bf16* ikb = qkvi + (size_t)b * SEQ * QLD + COL_IK;
        __syncthreads();
        d1_scan<1, EXP>(ikb, qt, 7, wave, lane, qb, wv, lds, 0u);
        __syncthreads();
#pragma unroll 1
        for (int qq = 0; qq < 4; ++qq) { const int q = wave * 4 + qq; const unsigned n = (unsigned)(t0 + q + 1); unsigned klo = 196608u / n; klo = klo > 256u ? 256u : (klo < 1u ? 1u : klo);
            unsigned bs, ab, bmx, ab2; const bool ok1 = d1_find((LAS unsigned*)(lds + q * D1_QS), klo, lane, bs, ab), ok2 = d1_find((LAS unsigned*)(lds + q * D1_QS), 1u, lane, bmx, ab2);
            if (lane == 0) { const unsigned klo_key = bs << 21, khi_key = (bmx + 1u) << 21;
                const float lo = __uint_as_float((klo_key & 0x80000000u) ? (klo_key & 0x7FFFFFFFu) : ~klo_key), hi2 = __uint_as_float((khi_key & 0x80000000u) ? (khi_key & 0x7FFFFFFFu) : ~khi_key);
                const float span = (hi2 - lo) * 1.5f; const bool good = ok1 && ok2 && bmx < 2046u && span > 0.f && span < 3.0e38f;
                sm[q] = __float_as_uint(lo); sm[32 + q] = __float_as_uint(good ? 2047.f / span : 0.f); if (!good) sm[224] = 1u; } }
        __syncthreads();
        for (int w = tid; w < D1_SM / 4; w += 512) ((LAS unsigned*)lds)[w] = 0u;
        const float f_lo = __uint_as_float(sm[r32]), f_inv = __uint_as_float(sm[32 + r32]);
        __syncthreads();
        d1_scan<4, EXP>(ikb, qt, qt, wave, lane, qb, wv, lds, 0u, f_lo, f_inv);
        __syncthreads();
#pragma unroll 1
        for (int qq = 0; qq < 4; ++qq) { const int q = wave * 4 + qq; unsigned bin, ab; const bool ok = d1_find((LAS unsigned*)(lds + q * D1_QS), 256u, lane, bin, ab);
            if (lane == 0) { sm[64 + q] = bin; sm[96 + q] = 256u - ab; if (!ok || bin == 2047u) sm[224] = 1u; } }
        __syncthreads();
        for (int w = tid; w < D1_SM / 4; w += 512) ((LAS unsigned*)lds)[w] = 0u;
#ifndef D1_FORCE_FB
#define D1_FORCE_FB 0
#endif
        const unsigned f_bs = sm[64 + r32]; bool fast_ok = (sm[224] == 0u) && !D1_FORCE_FB;
        __syncthreads();
        if (fast_ok) {
            d1_scan<5, EXP>(ikb, qt, qt, wave, lane, qb, wv, lds, 0u, f_lo, f_inv, f_bs);
            __syncthreads();
            if (tid < 32 && sm[160 + tid] > 256u) sm[224] = 1u;
            __syncthreads();
            fast_ok = (sm[224] == 0u);
            __syncthreads();
        }
        if (!fast_ok) {
        for (int w = tid; w < (D1_SM + 1024) / 4; w += 512) ((LAS unsigned*)lds)[w] = 0u;
        __syncthreads();
        d1_scan<1, EXP>(ikb, qt, qt, wave, lane, qb, wv, lds, 0u);
        __syncthreads();
#pragma unroll 1
        for (int qq = 0; qq < 4; ++qq) { const int q = wave * 4 + qq; unsigned bin, ab; d1_find((LAS unsigned*)(lds + q * D1_QS), 256u, lane, bin, ab); if (lane == 0) { sm[q] = bin; sm[32 + q] = ab; } }
        __syncthreads();
        for (int w = tid; w < D1_SM / 4; w += 512) ((LAS unsigned*)lds)[w] = 0u;
        const unsigned b1 = sm[r32];
        __syncthreads();
        d1_scan<2, EXP>(ikb, qt, qt, wave, lane, qb, wv, lds, b1);
        __syncthreads();
#pragma unroll 1
        for (int qq = 0; qq < 4; ++qq) { const int q = wave * 4 + qq; const unsigned need2 = 256u - sm[32 + q]; unsigned bin, ab; d1_find((LAS unsigned*)(lds + q * D1_QS), need2, lane, bin, ab);
            if (lane == 0) { sm[64 + q] = (sm[q] << 11) | bin; sm[96 + q] = need2 - ab; } }
        __syncthreads();
        for (int w = tid; w < D1_SM / 4; w += 512) ((LAS unsigned*)lds)[w] = 0u;
        const unsigned T22 = sm[64 + r32];
        __syncthreads();
        d1_scan<3, EXP>(ikb, qt, qt, wave, lane, qb, wv, lds, T22);
        __syncthreads();
        }
#pragma unroll 1
        for (int qq = 0; qq < 4; ++qq) { const int q = wave * 4 + qq;
            const unsigned cc = sm[160 + q] < 256u ? sm[160 + q] : 256u, need3 = sm[96 + q];
            LAS unsigned* cand = (LAS unsigned*)(lds + q * D1_QS); LAS unsigned short* cidx = (LAS unsigned short*)(cand + 256); LAS unsigned* bm = cand + 512; LAS unsigned* tb = cand + 768;
            unsigned tw[4]; int cz = 0;
#pragma unroll
            for (int w = 0; w < 4; ++w) { tw[w] = tb[lane * 4 + w]; cz += __popc(tw[w]); }
            int incz = cz;
#pragma unroll
            for (int o = 1; o < 64; o <<= 1) { const int v = __shfl_up(incz, o); if (lane >= o) incz += v; }
            const int cztot = __shfl(incz, 63);
            int npos = 0;
            for (unsigned ci = lane; ci < ((cc + 63u) & ~63u); ci += 64) { const bool act = ci < cc; const unsigned mine = act ? cand[ci] : 0u; const unsigned mi = act ? (unsigned)cidx[ci] : 0u;
                npos += __popcll(__ballot(act && mine > 0x80000000u));
                unsigned rank = (mine < 0x80000000u) ? (unsigned)cztot : 0u;
                for (unsigned j = 0; j < cc; ++j) { const unsigned kj = cand[j]; const unsigned ij = (unsigned)cidx[j]; rank += (kj > mine || (kj == mine && ij < mi)) ? 1u : 0u; }
                if (act && rank < need3) (void)__hip_atomic_fetch_or(bm + (mi >> 5), 1u << (mi & 31u), __ATOMIC_RELAXED, __HIP_MEMORY_SCOPE_WORKGROUP); }
            { int need_z = (int)need3 - npos; need_z = need_z < 0 ? 0 : (need_z > cztot ? cztot : need_z);
              if (need_z > 0) { int pre = incz - cz;
#pragma unroll
                for (int w = 0; w < 4; ++w) { unsigned bits = tw[w]; const int pc = __popc(bits); int k = need_z - pre; k = k < 0 ? 0 : (k > pc ? pc : k);
                    unsigned keep = 0u; for (int x = 0; x < k; ++x) { const unsigned low = bits & (0u - bits); keep |= low; bits ^= low; }
                    if (keep) (void)__hip_atomic_fetch_or(bm + lane * 4 + w, keep, __ATOMIC_RELAXED, __HIP_MEMORY_SCOPE_WORKGROUP);
                    pre += pc; } } }
            asm volatile("s_waitcnt lgkmcnt(0)" ::: "memory");
            unsigned wds[4]; int c = 0;
#pragma unroll
            for (int w = 0; w < 4; ++w) { wds[w] = bm[lane * 4 + w]; c += __popc(wds[w]); }
            int inc = c;
#pragma unroll
            for (int o = 1; o < 64; o <<= 1) { const int v = __shfl_up(inc, o); if (lane >= o) inc += v; }
            const int total = __shfl(inc, 63); int off = inc - c;
            int* op = sel + (size_t)(tok0 + q) * TOPK;
            if (EXP != 7)
#pragma unroll
            for (int w = 0; w < 4; ++w) { unsigned bits = wds[w]; const int kb = lane * 128 + w * 32;
                while (bits) { const int k = __ffs((int)bits) - 1; if (off < TOPK) op[off] = kb + k; ++off; bits &= bits - 1u; } }
            for (int j = total + lane; j < TOPK; j += 64) op[j] = t0 + q;
        }
        __syncthreads();
    }
}

constexpr int CW_DQ = 16384 + 1024;
__device__ __forceinline__ void phase_dsa_attn(KP P, int L, LAS unsigned char* lds) {
    int tz = threadIdx.x; asm volatile("" : "+v"(tz)); const int tid = tz, lane = tid & 63, wave = tid >> 6;
    const bf16* qkvi = (const bf16*)(P->ws + WS_QKVI); const int* sel = (const int*)(P->ws + WS_SEL); bf16* attn = (bf16*)(P->ws + WS_ATTN);
    unsigned* qh = (unsigned*)(P->ws + WS_CTL) + CW_DQ + L * 8 * 64;
    LAS unsigned* idxs = (LAS unsigned*)(lds + wave * 8192);
    LAS float* pl = (LAS float*)(lds + wave * 8192 + 1024);
    LAS int* wq = (LAS int*)(lds + 65536 + wave * 16);
    const int r = lane & 3, ts_l = (lane & 15) >> 2, kq = lane >> 4, c16 = lane & 15;
    const unsigned myq = xb_xcc_id() & 7u;
    constexpr float CC = 0.08838834764831845f * 1.4426950408889634f;
    for (int qi = 0; qi < 8; ++qi) {
        const int qx = (int)((myq + (unsigned)qi) & 7u), b = qx >> 1, g = qx & 1;
        for (;;) {
            int item = 0;
            if (lane == 0) item = (int)__hip_atomic_fetch_add(qh + qx * 64, 1u, __ATOMIC_RELAXED, __HIP_MEMORY_SCOPE_AGENT);
            item = __builtin_amdgcn_readfirstlane(item);
            if (item >= SEQ) break;
            const int t = SEQ - 1 - item, tok = b * SEQ + t, cnt = (t + 1 < TOPK) ? (t + 1) : TOPK;
#pragma unroll
            for (int i = 0; i < 4; ++i) { const int j = lane + 64 * i; int sidx = 0; if (j < cnt) sidx = (t < TOPK) ? j : sel[(size_t)tok * TOPK + j]; idxs[j] = (unsigned)sidx; }
            asm volatile("s_waitcnt lgkmcnt(0)" ::: "memory");
            bf16x8 qm[4][4];
            { const bf16* qp = qkvi + (size_t)tok * QLD + (g * 4 + r) * HEAD_DIM + 8 * kq;
#pragma unroll
              for (int ks = 0; ks < 4; ++ks) { const bf16x8 v = *(const bf16x8*)(qp + 32 * ks);
#pragma unroll
                  for (int ts = 0; ts < 4; ++ts) qm[ts][ks] = (ts_l == ts) ? v : (bf16x8){0, 0, 0, 0, 0, 0, 0, 0}; } }
            f32x4 C[4];
            const bf16* kbase = qkvi + (size_t)b * SEQ * QLD + COL_K + g * HEAD_DIM + 8 * kq;
#pragma unroll
            for (int c = 0; c < 4; ++c) {
                C[c] = (f32x4){0.f, 0.f, 0.f, 0.f};
                bf16x8 a[4][4];
#pragma unroll
                for (int ts = 0; ts < 4; ++ts) { const unsigned sk = idxs[(4 * c + ts) * 16 + c16]; const bf16* kp = kbase + (size_t)sk * QLD;
#pragma unroll
                    for (int ks = 0; ks < 4; ++ks) a[ts][ks] = *(const bf16x8*)(kp + 32 * ks); }
#pragma unroll
                for (int ts = 0; ts < 4; ++ts)
#pragma unroll
                    for (int ks = 0; ks < 4; ++ks) C[c] = __builtin_amdgcn_mfma_f32_16x16x32_bf16(a[ts][ks], qm[ts][ks], C[c], 0, 0, 0);
            }
            const float bias2 = __builtin_amdgcn_exp2f(-(float)(g * 4 + r + 1)) * 1.4426950408889634f;
            float x[16]; float m = -INFINITY;
#pragma unroll
            for (int c = 0; c < 4; ++c) { const int k0 = (4 * c + ts_l) * 16 + 4 * kq; const u32x4 sp = *(const LAS u32x4*)(idxs + k0);
#pragma unroll
                for (int j = 0; j < 4; ++j) { const float v = (k0 + j < cnt) ? fmaf(C[c][j], CC, bias2 * (float)((int)sp[j] - t)) : -INFINITY; x[c * 4 + j] = v; m = fmaxf(m, v); } }
            m = fmaxf(m, __shfl_xor(m, 4)); m = fmaxf(m, __shfl_xor(m, 8)); m = fmaxf(m, __shfl_xor(m, 16)); m = fmaxf(m, __shfl_xor(m, 32));
            float sum = 0.f;
#pragma unroll
            for (int i = 0; i < 16; ++i) { x[i] = __builtin_amdgcn_exp2f(x[i] - m); sum += x[i]; }
            sum += __shfl_xor(sum, 4); sum += __shfl_xor(sum, 8); sum += __shfl_xor(sum, 16); sum += __shfl_xor(sum, 32);
            const float inv = 1.f / sum;
#pragma unroll
            for (int c = 0; c < 4; ++c) { const int k0 = (4 * c + ts_l) * 16 + 4 * kq;
#pragma unroll
                for (int j = 0; j < 4; ++j) pl[(k0 + j) * 4 + r] = x[c * 4 + j] * inv; }
            asm volatile("s_waitcnt lgkmcnt(0)" ::: "memory");
            float acc[4][8];
#pragma unroll
            for (int rr = 0; rr < 4; ++rr)
#pragma unroll
                for (int i = 0; i < 8; ++i) acc[rr][i] = 0.f;
            const bf16* vbase = qkvi + (size_t)b * SEQ * QLD + COL_V + g * HEAD_DIM + 8 * c16;
            const int nk4 = (cnt + 3) >> 2;
#pragma unroll 4
            for (int j4 = 0; j4 < nk4; ++j4) {
                const int key = 4 * j4 + kq; const unsigned sk = idxs[key];
                const u32x4 vv = *(const u32x4*)(vbase + (size_t)sk * QLD);
                const f32x4 pp = *(const LAS f32x4*)(pl + key * 4);
                const float vf[8] = {bflo(vv.x), bfhi(vv.x), bflo(vv.y), bfhi(vv.y), bflo(vv.z), bfhi(vv.z), bflo(vv.w), bfhi(vv.w)};
#pragma unroll
                for (int rr = 0; rr < 4; ++rr)
#pragma unroll
                    for (int i = 0; i < 8; ++i) acc[rr][i] = fmaf(pp[rr], vf[i], acc[rr][i]);
            }
#pragma unroll
            for (int rr = 0; rr < 4; ++rr)
#pragma unroll
                for (int i = 0; i < 8; ++i) { float v = acc[rr][i]; v += __shfl_xor(v, 16); v += __shfl_xor(v, 32); acc[rr][i] = v; }
            if (kq == 0) {
#pragma unroll
                for (int rr = 0; rr < 4; ++rr) { u32x4 o; o.x = cvt_pk_bf16(acc[rr][0], acc[rr][1]); o.y = cvt_pk_bf16(acc[rr][2], acc[rr][3]); o.z = cvt_pk_bf16(acc[rr][4], acc[rr][5]); o.w = cvt_pk_bf16(acc[rr][6], acc[rr][7]);
                    *(u32x4*)(attn + (size_t)tok * D_MODEL + (g * 4 + rr) * HEAD_DIM + 8 * c16) = o; }
            }
        }
    }
    (void)wq;
}


__device__ __forceinline__ int d2_swz(int i) { return ((i & 3) << 2) | ((i >> 2) & 3); }
__device__ __forceinline__ void phase_dsa_attn2(KP P, int L, LAS unsigned char* lds) {
    typedef short s16x4 __attribute__((ext_vector_type(4)));
    int tz = threadIdx.x; asm volatile("" : "+v"(tz)); const int tid = tz, lane = tid & 63, wave = __builtin_amdgcn_readfirstlane(tid >> 6);
    const bf16* qkvi = (const bf16*)(P->ws + WS_QKVI); const int* sel = (const int*)(P->ws + WS_SEL); bf16* attn = (bf16*)(P->ws + WS_ATTN);
    unsigned* qh = (unsigned*)(P->ws + WS_CTL) + CW_DQ + L * 8 * 64;
    LAS unsigned char* wl = lds + wave * 19456;
    LAS unsigned* idxs = (LAS unsigned*)wl;
    LAS unsigned char* pb = wl + 1024;
    LAS unsigned char* ring = wl + 3072;
    const int n16 = lane & 15, r = lane & 3, ts_l = n16 >> 2, kq = lane >> 4;
    const unsigned myq = xb_xcc_id() & 7u;
    constexpr float CC = 0.08838834764831845f * 1.4426950408889634f;
    unsigned dch[4];
#pragma unroll
    for (int j = 0; j < 4; ++j) dch[j] = (unsigned)((n16 ^ d2_swz(4 * j + kq)) * 16);
    unsigned aoff[4];
#pragma unroll
    for (int ks = 0; ks < 4; ++ks) aoff[ks] = (unsigned)(n16 * 256 + (((4 * ks + kq) ^ d2_swz(n16)) * 16));
    for (int qi = 0; qi < 8; ++qi) {
        const int qx = (int)((myq + (unsigned)qi) & 7u), b = qx >> 1, g = qx & 1;
        const char* kgb = (const char*)(qkvi + (size_t)b * SEQ * QLD + COL_K + g * HEAD_DIM);
        int item = 0;
        if (lane == 0) item = (int)__hip_atomic_fetch_add(qh + qx * 64, 1u, __ATOMIC_RELAXED, __HIP_MEMORY_SCOPE_AGENT);
        item = __builtin_amdgcn_readfirstlane(item);
        bool have_pf = false; int sx[4] = {0, 0, 0, 0}; bf16x8 qv[4] = {};
        while (item < SEQ) {
            const int t = SEQ - 1 - item, tok = b * SEQ + t, cnt = (t + 1 < TOPK) ? (t + 1) : TOPK;
            if (!have_pf) {
#pragma unroll
                for (int i = 0; i < 4; ++i) { const int j = lane + 64 * i; sx[i] = (t < TOPK) ? j : sel[(size_t)tok * TOPK + j]; }
                const bf16* qp = qkvi + (size_t)tok * QLD + (g * 4 + r) * HEAD_DIM + 8 * kq;
#pragma unroll
                for (int ks = 0; ks < 4; ++ks) qv[ks] = *(const bf16x8*)(qp + 32 * ks);
            }
#pragma unroll
            for (int i = 0; i < 4; ++i) { const int j = lane + 64 * i; idxs[j] = (j < cnt) ? (unsigned)sx[i] : 0u; }
            bf16x8 qm[4][4];
#pragma unroll
            for (int ks = 0; ks < 4; ++ks) {
#pragma unroll
                for (int ts = 0; ts < 4; ++ts) qm[ts][ks] = (ts_l == ts) ? qv[ks] : (bf16x8){0, 0, 0, 0, 0, 0, 0, 0}; }
            asm volatile("s_waitcnt vmcnt(0) lgkmcnt(0)" ::: "memory");
#define D2_ISSUE(s) do { const int kb_ = (s) & 15; const char* gb_ = kgb + ((s) >= 16 ? (COL_V - COL_K) * 2 : 0); LAS unsigned char* sl_ = ring + ((s) & 3) * 4096; \
        _Pragma("unroll") for (int j = 0; j < 4; ++j) { const unsigned sk_ = idxs[kb_ * 16 + 4 * j + kq]; \
            __builtin_amdgcn_global_load_lds((const unsigned*)(gb_ + (size_t)sk_ * (QLD * 2) + dch[j]), (LAS unsigned*)(sl_ + j * 1024), 16, 0, 0); } } while (0)
            int nraw = 0;
            if (lane == 0) nraw = (int)__hip_atomic_fetch_add(qh + qx * 64, 1u, __ATOMIC_RELAXED, __HIP_MEMORY_SCOPE_AGENT);
            D2_ISSUE(0); D2_ISSUE(1); D2_ISSUE(2); D2_ISSUE(3);
            f32x4 C[4];
#pragma unroll
            for (int c = 0; c < 4; ++c) C[c] = (f32x4){0.f, 0.f, 0.f, 0.f};
#pragma unroll
            for (int s2 = 0; s2 < 16; ++s2) {
                asm volatile("s_waitcnt vmcnt(12)" ::: "memory");
                LAS unsigned char* sl = ring + (s2 & 3) * 4096;
                bf16x8 a[4];
#pragma unroll
                for (int ks = 0; ks < 4; ++ks) a[ks] = *(const LAS bf16x8*)(sl + aoff[ks]);
#pragma unroll
                for (int ks = 0; ks < 4; ++ks) C[s2 >> 2] = __builtin_amdgcn_mfma_f32_16x16x32_bf16(a[ks], qm[s2 & 3][ks], C[s2 >> 2], 0, 0, 0);
                asm volatile("s_waitcnt lgkmcnt(0)" ::: "memory");
                D2_ISSUE(s2 + 4);
            }
            const float bias2 = __builtin_amdgcn_exp2f(-(float)(g * 4 + r + 1)) * 1.4426950408889634f;
            float x[16]; float m = -INFINITY;
#pragma unroll
            for (int c = 0; c < 4; ++c) { const int k0 = (4 * c + ts_l) * 16 + 4 * kq; const u32x4 sp = *(const LAS u32x4*)(idxs + k0);
#pragma unroll
                for (int j = 0; j < 4; ++j) { const float v = (k0 + j < cnt) ? fmaf(C[c][j], CC, bias2 * (float)((int)sp[j] - t)) : -INFINITY; x[c * 4 + j] = v; m = fmaxf(m, v); } }
            m = fmaxf(m, __shfl_xor(m, 4)); m = fmaxf(m, __shfl_xor(m, 8)); m = fmaxf(m, __shfl_xor(m, 16)); m = fmaxf(m, __shfl_xor(m, 32));
            float sum = 0.f;
#pragma unroll
            for (int i = 0; i < 16; ++i) { x[i] = __builtin_amdgcn_exp2f(x[i] - m); sum += x[i]; }
            sum += __shfl_xor(sum, 4); sum += __shfl_xor(sum, 8); sum += __shfl_xor(sum, 16); sum += __shfl_xor(sum, 32);
            const float inv = 1.f / sum;
#pragma unroll
            for (int c = 0; c < 4; ++c) { const int k0 = (4 * c + ts_l) * 16 + 4 * kq;
                u32x2 w; w.x = cvt_pk_bf16(x[c * 4 + 0] * inv, x[c * 4 + 1] * inv); w.y = cvt_pk_bf16(x[c * 4 + 2] * inv, x[c * 4 + 3] * inv);
                *(LAS u32x2*)(pb + (r * 256 + k0) * 2) = w; }
            asm volatile("s_waitcnt lgkmcnt(0)" ::: "memory");
            f32x4 O[8]; int nitem = SEQ;
#pragma unroll
            for (int db = 0; db < 8; ++db) O[db] = (f32x4){0.f, 0.f, 0.f, 0.f};
            const int q4 = n16 >> 2, p4 = n16 & 3;
#pragma unroll
            for (int u = 0; u < 8; ++u) {
                if (u < 7) asm volatile("s_waitcnt vmcnt(8)" ::: "memory"); else asm volatile("s_waitcnt vmcnt(0)" ::: "memory");
                LAS unsigned char* sl = ring + (((2 * u) & 3) + (kq >> 1)) * 4096;
                const bf16x8 pf = *(const LAS bf16x8*)(pb + (r * 256 + u * 32 + 8 * kq) * 2);
#pragma unroll
                for (int db = 0; db < 8; ++db) {
                    const int i0 = 8 * (kq & 1) + q4, i1 = i0 + 4;
                    const int a0 = (int)(unsigned)(uintptr_t)(sl + i0 * 256 + (((2 * db + (p4 >> 1)) ^ d2_swz(i0)) * 16) + 8 * (p4 & 1));
                    const int a1 = (int)(unsigned)(uintptr_t)(sl + i1 * 256 + (((2 * db + (p4 >> 1)) ^ d2_swz(i1)) * 16) + 8 * (p4 & 1));
                    const s16x4 v0 = mb::tr_read<0>(a0), v1 = mb::tr_read<0>(a1);
                    asm volatile("s_waitcnt lgkmcnt(0)" ::: "memory");
                    const bf16x8 vf = {v0[0], v0[1], v0[2], v0[3], v1[0], v1[1], v1[2], v1[3]};
                    O[db] = __builtin_amdgcn_mfma_f32_16x16x32_bf16(vf, pf, O[db], 0, 0, 0);
                }
                if (u == 0) {
                    nitem = __builtin_amdgcn_readfirstlane(nraw); have_pf = nitem < SEQ;
                    if (have_pf) { const int tn = SEQ - 1 - nitem, tokn = b * SEQ + tn;
#pragma unroll
                        for (int i = 0; i < 4; ++i) { const int j = lane + 64 * i; sx[i] = (tn < TOPK) ? j : sel[(size_t)tokn * TOPK + j]; }
                        const bf16* qpn = qkvi + (size_t)tokn * QLD + (g * 4 + r) * HEAD_DIM + 8 * kq;
#pragma unroll
                        for (int ks = 0; ks < 4; ++ks) qv[ks] = *(const bf16x8*)(qpn + 32 * ks); } }
                if (u < 6) { D2_ISSUE(16 + 2 * u + 4); D2_ISSUE(16 + 2 * u + 5); }
            }
#undef D2_ISSUE
            if (n16 < 4) {
                bf16* op = attn + (size_t)tok * D_MODEL + (g * 4 + n16) * HEAD_DIM + 4 * kq;
#pragma unroll
                for (int db = 0; db < 8; ++db) { u32x2 w; w.x = cvt_pk_bf16(O[db][0], O[db][1]); w.y = cvt_pk_bf16(O[db][2], O[db][3]); *(u32x2*)(op + 16 * db) = w; }
            }
            item = nitem;
        }
    }
}

__device__ __forceinline__ int opq(int x) { asm volatile("" : "+s"(x)); return x; }
__device__ __forceinline__ bool phase_active(int L, int k) {
    if (k >= 2 && k <= 6) { if (L < N_A) return k <= 3; if (k == 2) return L == N_A; }
    return k <= 14;
}
__global__ void __launch_bounds__(512, 2) fwd(Params P) {
    extern __shared__ __attribute__((aligned(16))) unsigned char lds_raw[];
    LAS unsigned char* lds = (LAS unsigned char*)lds_raw;
    const int tid = threadIdx.x;
    unsigned char* ws0 = P.ws;
    if (tid < 16) ((LAS unsigned*)(lds + LDS_MISC))[tid] = 0u;
    __syncthreads();
    const int lo = P.ph_lo, hi = P.ph_hi;
    const bool multi = (hi - lo) > 1;
    unsigned* barw = (unsigned*)(ws0 + WS_CTL) + CW_BAR + P.bar_idx * XCD_BAR_WORDS;
    XcdBarrier bar; bar.bar = barw; bar.x = 0; bar.st = nullptr;
    if (multi) bar = xcd_barrier_post(barw, (volatile LAS unsigned*)(lds + LDS_MISC));
#ifndef PHASE_MASK
#define PHASE_MASK 0xFFFF
#endif
#define IN(k) (((PHASE_MASK >> (k)) & 1) && opq(lo) <= (pb + (k)) && (pb + (k)) < hi && phase_active(L, (k)))
#define SEAM(k) do { if (IN(k) && (pb + (k) + 1) < hi) xcd_barrier(bar); } while (0)
#ifndef PROBE_MASK
#define PROBE_MASK 0
#endif
#define PROBED(k) (((PROBE_MASK) >> (k)) & 1)
    const int G = gridDim.x, c = blockIdx.x;
    for (int L = 0; L < DEPTH; ++L) {
        const int pb = L * 16;
        if (pb + 16 <= lo || pb >= hi) continue;
        const bool isA = L < N_A;
        if (IN(0)) { for (int rep = PROBED(0) ? 0 : 1; rep < 2; ++rep) { phase_convert(fresh_params(), L, lds); if (rep == 0) xcd_barrier(bar); } } SEAM(0);
        if (IN(1)) { for (int rep = PROBED(1) ? 0 : 1; rep < 2; ++rep) {
            KP Q = fresh_params(); unsigned char* ws = Q->ws; bf16* hb = (bf16*)(ws + WS_HB);
            if (isA) {
                gm::DenseOrder S; S.init(hb, ws + WS_WMIX, NTOK, 2048, D_MODEL, G, c);
                gm::EpiBf16 E{(bf16*)(ws + WS_QKVI), QLD, (float*)(ws + WS_IW)};
                gm::gemm_phase<gm::EpiBf16, gm::DenseOrder, false>(lds, D_MODEL, S, E);
            } else {
                if (L == N_A) {
                    gm::DenseOrder S; S.init(hb, ws + WS_WMIX + 6 * MiB, NTOK, 512, D_MODEL, G, c);
                    gm::EpiBf16 E{(bf16*)(ws + WS_KV), 512, nullptr};
                    gm::gemm_phase<gm::EpiBf16, gm::DenseOrder, false>(lds, D_MODEL, S, E);
                }
                gm::DenseOrder S; S.init(hb, ws + WS_WMIX, NTOK, D_MODEL, D_MODEL, G, c);
                gm::EpiBf16 E{(bf16*)(ws + WS_QKVI), D_MODEL, nullptr};
                gm::gemm_phase<gm::EpiBf16, gm::DenseOrder, false>(lds, D_MODEL, S, E);
            }
            if (rep == 0) xcd_barrier(bar);
        } } SEAM(1);
        if (IN(2)) { if (isA) { if (PROBED(2)) { phase_dsa_topk<D1_EXP>(fresh_params(), lds, WS_PL); xcd_barrier(bar); } phase_dsa_topk<0>(fresh_params(), lds, WS_SEL); } else phase_kmeans(fresh_params()); } SEAM(2);
        if (IN(3)) { if (isA) { for (int rep = PROBED(3) ? 0 : 1; rep < 2; ++rep) { phase_dsa_attn2(fresh_params(), rep == 0 ? L + 2 : L, lds); if (rep == 0) xcd_barrier(bar); } } else { for (int rep = PROBED(4) ? 0 : 1; rep < 2; ++rep) { phase_moba_gate2(fresh_params()); if (rep == 0) xcd_barrier(bar); } } } SEAM(3);
        if (IN(4)) { phase_moba_lists(fresh_params(), lds); } SEAM(4);
        if (IN(5)) { for (int rep = PROBED(5) ? 0 : 1; rep < 2; ++rep) { phase_moba_attn2(fresh_params(), (L - N_A) * 2 + rep, lds); if (rep == 0) xcd_barrier(bar); } } SEAM(5);
        if (IN(6)) { for (int rep = PROBED(6) ? 0 : 1; rep < 2; ++rep) { phase_moba_combine(fresh_params()); if (rep == 0) xcd_barrier(bar); } } SEAM(6);
        if (IN(7)) { for (int rep = PROBED(7) ? 0 : 1; rep < 2; ++rep) {
            KP Q = fresh_params(); unsigned char* ws = Q->ws; const float* hres = (L == 0) ? Q->in[0] : (const float*)(ws + WS_H); _Float16* t = (_Float16*)(ws + WS_T);
            { gm::DenseOrder S; S.init(ws + WS_ATTN, ws + WS_WMIX + 4 * MiB, NTOK, D_MODEL, D_MODEL, G, c);
              gm::EpiResid E{hres, t};
              gm::gemm_phase<gm::EpiResid, gm::DenseOrder, false>(lds, D_MODEL, S, E); }
            { gm::DenseOrder S; S.init(ws + WS_PB, ws + WS_WPLE, NTOK, D_MODEL, PLE_DIM, G, c);
              gm::EpiBf16 E{(bf16*)(ws + WS_PL), D_MODEL, nullptr};
              gm::gemm_phase<gm::EpiBf16, gm::DenseOrder, false>(lds, PLE_DIM, S, E); }
            if (rep == 0) xcd_barrier(bar);
        } } SEAM(7);
        if (IN(8)) { for (int rep = PROBED(8) ? 0 : 1; rep < 2; ++rep) { phase_ln_router(fresh_params(), L, lds, rep == 0 ? L + 4 : L); if (rep == 0) xcd_barrier(bar); } } SEAM(8);
        if (IN(9)) { phase_moe_prep(fresh_params(), L, lds); } SEAM(9);
        if (IN(10)) { for (int rep = PROBED(10) ? 0 : 1; rep < 2; ++rep) {
            KP Q = fresh_params(); unsigned char* ws = Q->ws; bf16* hb = (bf16*)(ws + WS_HB);
            const int* moe = (const int*)(ws + WS_MOE);
            gm::MoeOrder S; S.tile_e = moe + MO_TILE_E; S.tile_row0 = moe + MO_TILE_ROW0; S.tile_nv = moe + MO_TILE_NV; S.slot_tok = moe + MO_SLOT_TOK;
            S.n_units = (int)*((const unsigned*)(ws + WS_CTL) + CW_NTILES + L) * 4; S.G = G; S.c = c; S.K = D_MODEL; S.A = (const char*)hb; S.W = (const char*)(ws + WS_WGU);
            S.wstride = (size_t)D_MODEL * D_MODEL * 2; S.tB = (size_t)256 * D_MODEL * 2; S.gath = true;
            gm::EpiSwiglu E{(bf16*)(ws + WS_ACT)};
            gm::gemm_phase<gm::EpiSwiglu, gm::MoeOrder, true>(lds, D_MODEL, S, E);
            if (rep == 0) xcd_barrier(bar);
        } } SEAM(10);
        if (IN(11)) { for (int rep = PROBED(11) ? 0 : 1; rep < 2; ++rep) {
            KP Q = fresh_params(); unsigned char* ws = Q->ws;
            const int* moe = (const int*)(ws + WS_MOE);
            gm::MoeOrder S; S.tile_e = moe + MO_TILE_E; S.tile_row0 = moe + MO_TILE_ROW0; S.tile_nv = moe + MO_TILE_NV; S.slot_tok = moe + MO_SLOT_TOK;
            S.n_units = (int)*((const unsigned*)(ws + WS_CTL) + CW_NTILES + L) * 4; S.G = G; S.c = c; S.K = D_EXPERT; S.A = (const char*)(ws + WS_ACT); S.W = (const char*)(ws + WS_WD);
            S.wstride = (size_t)D_MODEL * D_EXPERT * 2; S.tB = (size_t)256 * D_EXPERT * 2; S.gath = false;
            gm::EpiMoeDown E{(bf16*)(ws + WS_Y)};
            gm::gemm_phase<gm::EpiMoeDown, gm::MoeOrder, false>(lds, D_EXPERT, S, E);
            if (rep == 0) xcd_barrier(bar);
        } } SEAM(11);
        if (IN(12)) { KP Q = fresh_params(); phase_ln<1, false>(Q, L, 1, lds, (float*)(Q->ws + WS_H), true); } SEAM(12);
        if (IN(13)) { for (int rep = PROBED(13) ? 0 : 1; rep < 2; ++rep) {
            KP Q = fresh_params(); unsigned char* ws = Q->ws; bf16* hb = (bf16*)(ws + WS_HB); float* h = (float*)(ws + WS_H); _Float16* t = (_Float16*)(ws + WS_T);
            gm::DenseOrder S; S.init(hb, ws + WS_WPG, NTOK, D_MODEL, D_MODEL, G, c);
            gm::EpiPle E{h, (const bf16*)(ws + WS_PL), t};
            gm::gemm_phase<gm::EpiPle, gm::DenseOrder, false>(lds, D_MODEL, S, E);
            if (rep == 0) xcd_barrier(bar);
        } } SEAM(13);
        if (IN(14)) { for (int rep = PROBED(14) ? 0 : 1; rep < 2; ++rep) { KP Q = fresh_params(); phase_ln<0, false>(Q, L, 2, lds, (L == DEPTH - 1) ? Q->out : (float*)(Q->ws + WS_H), L != DEPTH - 1); if (rep == 0) xcd_barrier(bar); } }
        if (L != DEPTH - 1) SEAM(14);
    }
#undef IN
#undef SEAM
}

#ifndef DEBUG_ATTN
#define DEBUG_ATTN 0
#endif
#if DEBUG_ATTN
__global__ void __launch_bounds__(256) dsa_scores(const bf16* __restrict__ qkvi  , const float* __restrict__ iw  , float* __restrict__ sc) {
    const int s0 = blockIdx.x * 64, t0 = blockIdx.y * 64;
    if (s0 > t0) return;
    __shared__ float Qs[64][68];
    __shared__ float Ks[64][68];
    const int tid = threadIdx.x, r = tid >> 2, kq = (tid & 3) * 16;
    {
        const bf16* kp = qkvi + (size_t)(s0 + r) * QLD + COL_IK + kq;
#pragma unroll
        for (int i = 0; i < 16; ++i) Ks[kq + i][r] = bf2f(kp[i]);
    }
    const int ty = tid >> 4, tx = tid & 15;
    float tot[4][4];
#pragma unroll
    for (int i = 0; i < 4; ++i)
#pragma unroll
        for (int j = 0; j < 4; ++j) tot[i][j] = 0.f;
    for (int hh = 0; hh < IDX_HEADS; ++hh) {
        __syncthreads();
        const bf16* qp = qkvi + (size_t)(t0 + r) * QLD + COL_IQ + hh * IDX_DIM + kq;
#pragma unroll
        for (int i = 0; i < 16; ++i) Qs[kq + i][r] = bf2f(qp[i]);
        __syncthreads();
        float acc[4][4];
#pragma unroll
        for (int i = 0; i < 4; ++i)
#pragma unroll
            for (int j = 0; j < 4; ++j) acc[i][j] = 0.f;
#pragma unroll 8
        for (int k = 0; k < 64; ++k) {
            const float4 a4 = *(const float4*)&Qs[k][ty * 4];
            const float4 b4 = *(const float4*)&Ks[k][tx * 4];
            const float a[4] = {a4.x, a4.y, a4.z, a4.w};
            const float b[4] = {b4.x, b4.y, b4.z, b4.w};
#pragma unroll
            for (int i = 0; i < 4; ++i)
#pragma unroll
                for (int j = 0; j < 4; ++j) acc[i][j] += a[i] * b[j];
        }
#pragma unroll
        for (int i = 0; i < 4; ++i) {
            const float w = iw[(size_t)(t0 + ty * 4 + i) * 4 + hh];
#pragma unroll
            for (int j = 0; j < 4; ++j) tot[i][j] += w * fmaxf(acc[i][j], 0.f);
        }
    }
#pragma unroll
    for (int i = 0; i < 4; ++i)
        *(float4*)(sc + (size_t)(t0 + ty * 4 + i) * SEQ + s0 + tx * 4) = make_float4(tot[i][0], tot[i][1], tot[i][2], tot[i][3]);
}

__device__ __forceinline__ unsigned fkey(float f) { const unsigned u = __float_as_uint(f); return (u & 0x80000000u) ? ~u : (u | 0x80000000u); }
__global__ void __launch_bounds__(256) dsa_topk(const float* __restrict__ sc, int* __restrict__ sel) {
    const int t = blockIdx.x, tid = threadIdx.x, n = t + 1;
    int* out = sel + (size_t)t * TOPK;
    if (n <= TOPK) { out[tid] = tid <= t ? tid : 0; return; }
    const float* row = sc + (size_t)t * SEQ;
    __shared__ unsigned hist[256];
    __shared__ unsigned s_prefix, s_need;
    __shared__ int wsum[2][4];
    unsigned prefix = 0, need = TOPK;
    for (int pass = 3; pass >= 0; --pass) {
        hist[tid] = 0;
        __syncthreads();
        for (int i = tid; i < n; i += 256) {
            const unsigned k = fkey(row[i]);
            const bool match = (pass == 3) ? true : ((k >> (8 * (pass + 1))) == prefix);
            if (match) atomicAdd(&hist[(k >> (8 * pass)) & 255u], 1u);
        }
        __syncthreads();
        if (tid == 0) {
            unsigned c = 0; int d = 255;
            for (; d > 0; --d) { if (c + hist[d] >= need) break; c += hist[d]; }
            s_prefix = (prefix << 8) | (unsigned)d; s_need = need - c;
        }
        __syncthreads();
        prefix = s_prefix; need = s_need;
        __syncthreads();
    }
    const unsigned T = prefix;
    const int n_gt = TOPK - (int)need;
    int run_gt = 0, run_eq = 0;
    const int lane = tid & 63, w = tid >> 6;
    for (int base = 0; base < n; base += 256) {
        const int i = base + tid;
        unsigned k = 0; bool gt = false, eq = false;
        if (i < n) { k = fkey(row[i]); gt = k > T; eq = k == T; }
        const unsigned long long mg = __ballot(gt), me = __ballot(eq);
        const unsigned long long lower = (lane == 0) ? 0ull : (~0ull >> (64 - lane));
        const int pg = __popcll(mg & lower), pe = __popcll(me & lower);
        if (lane == 0) { wsum[0][w] = __popcll(mg); wsum[1][w] = __popcll(me); }
        __syncthreads();
        int og = 0, oe = 0, tg = 0, te = 0;
        for (int x = 0; x < 4; ++x) { if (x < w) { og += wsum[0][x]; oe += wsum[1][x]; } tg += wsum[0][x]; te += wsum[1][x]; }
        if (gt) out[run_gt + og + pg] = i;
        if (eq) { const int rk = run_eq + oe + pe; if (rk < (int)need) out[n_gt + rk] = i; }
        run_gt += tg; run_eq += te;
        __syncthreads();
    }
}

__global__ void __launch_bounds__(256) dsa_attn(const bf16* __restrict__ qkvi, const int* __restrict__ sel, bf16* __restrict__ attn) {
    const int tok = blockIdx.x, b = tok / SEQ, t = tok % SEQ, tid = threadIdx.x;
    __shared__ float qs[D_MODEL];
    __shared__ float lg[N_HEADS][TOPK];
    __shared__ int sidx[TOPK];
    const int cnt = (t + 1 < TOPK) ? (t + 1) : TOPK;
    const bf16* prow = qkvi + (size_t)tok * QLD;
#pragma unroll
    for (int i = 0; i < 4; ++i) qs[tid * 4 + i] = bf2f(prow[tid * 4 + i]);
    int s = 0;
    if (tid < cnt) s = (t < TOPK) ? tid : sel[(size_t)tok * TOPK + tid];
    sidx[tid] = s;
    __syncthreads();
    const float scale = 0.08838834764831845f;
    if (tid < cnt) {
        const bf16* krow = qkvi + (size_t)(b * SEQ + s) * QLD + COL_K;
        for (int g = 0; g < N_KV; ++g) {
            float d[4] = {0.f, 0.f, 0.f, 0.f};
            for (int k = 0; k < HEAD_DIM; ++k) {
                const float kv = bf2f(krow[g * HEAD_DIM + k]);
#pragma unroll
                for (int r = 0; r < 4; ++r) d[r] += qs[(g * 4 + r) * HEAD_DIM + k] * kv;
            }
#pragma unroll
            for (int r = 0; r < 4; ++r) {
                const int hh = g * 4 + r;
                const float slope = exp2f(-(float)(hh + 1));
                lg[hh][tid] = d[r] * scale - slope * (float)(t - s);
            }
        }
    } else {
        for (int hh = 0; hh < N_HEADS; ++hh) lg[hh][tid] = -INFINITY;
    }
    __syncthreads();
    {
        const int lane = tid & 63, w = tid >> 6;
        for (int h2 = 0; h2 < 2; ++h2) {
            const int hh = w * 2 + h2;
            float v[4], m = -INFINITY;
#pragma unroll
            for (int i = 0; i < 4; ++i) { v[i] = lg[hh][lane + 64 * i]; m = fmaxf(m, v[i]); }
            for (int o = 32; o > 0; o >>= 1) m = fmaxf(m, __shfl_xor(m, o));
            float sum = 0.f;
#pragma unroll
            for (int i = 0; i < 4; ++i) { v[i] = expf(v[i] - m); sum += v[i]; }
            for (int o = 32; o > 0; o >>= 1) sum += __shfl_xor(sum, o);
            const float inv = 1.f / sum;
#pragma unroll
            for (int i = 0; i < 4; ++i) lg[hh][lane + 64 * i] = v[i] * inv;
        }
    }
    __syncthreads();
    {
        const int col = tid * 4, hh = col / HEAD_DIM, g = hh / HEAD_GROUP, d = col % HEAD_DIM;
        float acc[4] = {0.f, 0.f, 0.f, 0.f};
        for (int j = 0; j < cnt; ++j) {
            const float p = lg[hh][j];
            const u32x2 vv = *(const u32x2*)(qkvi + (size_t)(b * SEQ + sidx[j]) * QLD + COL_V + g * HEAD_DIM + d);
            acc[0] += p * bflo(vv.x); acc[1] += p * bfhi(vv.x); acc[2] += p * bflo(vv.y); acc[3] += p * bfhi(vv.y);
        }
        u32x2 o; o.x = cvt_pk_bf16(acc[0], acc[1]); o.y = cvt_pk_bf16(acc[2], acc[3]);
        *(u32x2*)(attn + (size_t)tok * D_MODEL + col) = o;
    }
}

__global__ void __launch_bounds__(128) kmeans_kernel(const bf16* __restrict__ kv, float* __restrict__ km) {
    const int blk = blockIdx.x % N_BLOCKS, g = (blockIdx.x / N_BLOCKS) % N_KV, b = blockIdx.x / (N_BLOCKS * N_KV), d = threadIdx.x;
    float s = 0.f;
    for (int i = 0; i < MOBA_BLOCK; ++i) s += bf2f(kv[(size_t)(b * SEQ + blk * MOBA_BLOCK + i) * 512 + g * HEAD_DIM + d]);
    km[((size_t)(b * N_KV + g) * N_BLOCKS + blk) * HEAD_DIM + d] = s * (1.f / MOBA_BLOCK);
}

__global__ void __launch_bounds__(256) moba_attn(const bf16* __restrict__ q, const bf16* __restrict__ kv, const float* __restrict__ km, bf16* __restrict__ attn) {
    const int tok = blockIdx.x, b = tok / SEQ, t = tok % SEQ, tid = threadIdx.x, own = t / MOBA_BLOCK;
    __shared__ float qs[HEAD_DIM];
    __shared__ float gate[N_BLOCKS];
    __shared__ int selb[3];
    __shared__ float lg[4 * MOBA_BLOCK];
    __shared__ float red[8];
    __shared__ float part[2][HEAD_DIM];
    const float scale = 0.08838834764831845f;
    for (int hh = 0; hh < N_HEADS; ++hh) {
        const int g = hh / HEAD_GROUP;
        const float slope = exp2f(-(float)(hh + 1));
        __syncthreads();
        if (tid < HEAD_DIM) qs[tid] = bf2f(q[(size_t)tok * D_MODEL + hh * HEAD_DIM + tid]);
        __syncthreads();
        if (tid < N_BLOCKS) {
            float gval = -INFINITY;
            if (tid < own) {
                const float* kp = km + ((size_t)(b * N_KV + g) * N_BLOCKS + tid) * HEAD_DIM;
                float s = 0.f;
                for (int k = 0; k < HEAD_DIM; ++k) s += qs[k] * kp[k];
                gval = s;
            }
            gate[tid] = gval;
        }
        __syncthreads();
        if (tid == 0) {
            unsigned used = 0u;
            for (int s = 0; s < 3; ++s) {
                int best = -1; float bv = 0.f;
                for (int j = 0; j < N_BLOCKS; ++j) if (!((used >> j) & 1u) && (best < 0 || gate[j] > bv)) { best = j; bv = gate[j]; }
                used |= 1u << best; selb[s] = best;
            }
        }
        __syncthreads();
        for (int s = 0; s < 4; ++s) {
            const int blk = (s < 3) ? selb[s] : own;
            const int kpos = blk * MOBA_BLOCK + tid;
            const bool valid = (s < 3) ? (blk < own) : (kpos <= t);
            float v = -INFINITY;
            if (valid) {
                const bf16* kp = kv + (size_t)(b * SEQ + kpos) * 512 + g * HEAD_DIM;
                float d = 0.f;
                for (int k = 0; k < HEAD_DIM; ++k) d += qs[k] * bf2f(kp[k]);
                v = d * scale - slope * (float)(t - kpos);
            }
            lg[s * MOBA_BLOCK + tid] = v;
        }
        __syncthreads();
        float m = fmaxf(fmaxf(lg[tid], lg[256 + tid]), fmaxf(lg[512 + tid], lg[768 + tid]));
        for (int o = 32; o > 0; o >>= 1) m = fmaxf(m, __shfl_xor(m, o));
        if ((tid & 63) == 0) red[tid >> 6] = m;
        __syncthreads();
        m = fmaxf(fmaxf(red[0], red[1]), fmaxf(red[2], red[3]));
        float e[4], sum = 0.f;
#pragma unroll
        for (int i = 0; i < 4; ++i) { e[i] = expf(lg[i * 256 + tid] - m); sum += e[i]; }
        for (int o = 32; o > 0; o >>= 1) sum += __shfl_xor(sum, o);
        if ((tid & 63) == 0) red[4 + (tid >> 6)] = sum;
        __syncthreads();
        const float inv = 1.f / (red[4] + red[5] + red[6] + red[7]);
#pragma unroll
        for (int i = 0; i < 4; ++i) lg[i * 256 + tid] = e[i] * inv;
        __syncthreads();
        {
            const int d = tid & 127, half = tid >> 7;
            float acc = 0.f;
            for (int s = 0; s < 4; ++s) {
                const int blk = (s < 3) ? selb[s] : own;
                const bool bvalid = (s < 3) ? (blk < own) : true;
                if (!bvalid) continue;
                const bf16* vp = kv + (size_t)(b * SEQ + blk * MOBA_BLOCK + half * 128) * 512 + KV_DIM + g * HEAD_DIM + d;
                const float* pp = lg + s * MOBA_BLOCK + half * 128;
                for (int j = 0; j < 128; ++j) { const float p = pp[j]; if (p != 0.f) acc += p * bf2f(vp[(size_t)j * 512]); }
            }
            part[half][d] = acc;
        }
        __syncthreads();
        if (tid < HEAD_DIM) attn[(size_t)tok * D_MODEL + hh * HEAD_DIM + tid] = (bf16)(cvt_pk_bf16(part[0][tid] + part[1][tid], 0.f) & 0xffffu);
    }
}


#endif
#ifndef DEBUG_ATTN
#define DEBUG_ATTN 0
#endif
#if DEBUG_ATTN
__global__ void dbg_compare(const bf16* __restrict__ a, const bf16* __restrict__ ref, size_t n, float* __restrict__ acc) {
    float d2 = 0.f, r2 = 0.f;
    for (size_t i = (size_t)blockIdx.x * blockDim.x + threadIdx.x; i < n; i += (size_t)gridDim.x * blockDim.x) { const float x = bf2f(a[i]), y = bf2f(ref[i]); d2 += (x - y) * (x - y); r2 += y * y; }
    d2 = wave_sum(d2); r2 = wave_sum(r2);
    if ((threadIdx.x & 63) == 0) { atomicAdd(&acc[0], d2); atomicAdd(&acc[1], r2); }
}
__global__ void dbg_scale(float* __restrict__ out, size_t n, const float* __restrict__ acc) {
    const float rv = acc[0] / fmaxf(acc[1], 1e-30f);
    float e = sqrtf(fminf(rv * 100.f, 4.f)); if (!(rv == rv)) e = 3.f;
    for (size_t i = (size_t)blockIdx.x * blockDim.x + threadIdx.x; i < n; i += (size_t)gridDim.x * blockDim.x) out[i] *= (1.f + e);
}
#endif

extern "C" void kernel_launch(void* const* d_in, const int* in_sizes, int n_in, void* d_out, int out_size, void* d_ws, size_t ws_size, hipStream_t stream) {
    static int grid = 0;
    if (grid == 0) {
        int dev = 0, cus = 0;
        (void)hipGetDevice(&dev); (void)hipDeviceGetAttribute(&cus, hipDeviceAttributeMultiprocessorCount, dev);
        (void)hipFuncSetAttribute((const void*)fwd, hipFuncAttributeMaxDynamicSharedMemorySize, LDS_BYTES);
        grid = cus > 0 ? cus : 256;
    }
    unsigned char* ws = (unsigned char*)d_ws;
    (void)hipMemsetAsync(ws + WS_CTL, 0, CTL_ZERO_BYTES, stream);
    Params P{};
    for (int i = 0; i < 18; ++i) P.in[i] = (const float*)d_in[i];
    P.out = (float*)d_out; P.ws = ws;
    int nlaunch = 0;
    auto run = [&](int lo, int hi) { P.ph_lo = lo; P.ph_hi = hi; P.bar_idx = nlaunch++; hipLaunchKernelGGL(fwd, dim3(grid), dim3(512), LDS_BYTES, stream, P); };
#if DEBUG_ATTN
    const bf16* qkvi = (const bf16*)(ws + WS_QKVI); bf16* attn = (bf16*)(ws + WS_ATTN); int* sel = (int*)(ws + WS_SEL);
    float* scores = (float*)(ws + WS_SCORES); const float* iw = (const float*)(ws + WS_IW); const bf16* kvb = (const bf16*)(ws + WS_KV); float* km = (float*)(ws + WS_KM);
#endif
#if DEBUG_ATTN == 0
    run(0, DEPTH * 16);
#else
    for (int L = 0; L < DEPTH; ++L) {
        const int pb = L * 16;
        if (L < N_A) {
#if DEBUG_ATTN == 4
            if (L == 1) {
                run(pb + 0, pb + 3);
                bf16* attn2 = (bf16*)(ws + WS_PL);
                dsa_attn<<<NTOK, 256, 0, stream>>>(qkvi, sel, attn2);
                run(pb + 3, pb + 4);
                dbg_compare<<<1024, 256, 0, stream>>>(attn, attn2, (size_t)NTOK * D_MODEL, (float*)(ws + WS_CTL) + 1024);
                run(pb + 7, pb + 15);
            } else
#endif
#if DEBUG_ATTN == 3
            if (L == 1) {
                run(pb + 0, pb + 2);
                bf16* attn2 = (bf16*)(ws + WS_PL);
                for (int b = 0; b < BATCH; ++b) {
                    dsa_scores<<<dim3(SEQ / 64, SEQ / 64), 256, 0, stream>>>(qkvi + (size_t)b * SEQ * QLD, iw + (size_t)b * SEQ * 4, scores);
                    dsa_topk<<<SEQ, 256, 0, stream>>>(scores, sel + (size_t)b * SEQ * TOPK);
                }
                dsa_attn<<<NTOK, 256, 0, stream>>>(qkvi, sel, attn2);
                run(pb + 2, pb + 4);
                dbg_compare<<<1024, 256, 0, stream>>>(attn, attn2, (size_t)NTOK * D_MODEL, (float*)(ws + WS_CTL) + 1024);
                run(pb + 7, pb + 15);
            } else
#endif
            { run(pb + 0, pb + 4); run(pb + 7, pb + 15); }
        } else {
            run(pb + 0, pb + 7);
#if DEBUG_ATTN == 1
            if (L == N_A) {
                bf16* attn2 = (bf16*)(ws + WS_PL);
                kmeans_kernel<<<BATCH * N_KV * N_BLOCKS, 128, 0, stream>>>(kvb, km + 65536);
                moba_attn<<<NTOK, 256, 0, stream>>>(qkvi, kvb, km + 65536, attn2);
                dbg_compare<<<1024, 256, 0, stream>>>(attn, attn2, (size_t)NTOK * D_MODEL, (float*)(ws + WS_CTL) + 1024);
            }
#endif
            run(pb + 7, pb + 15);
        }
    }
#endif
#if DEBUG_ATTN
    dbg_scale<<<1024, 256, 0, stream>>>((float*)d_out, (size_t)NTOK * D_MODEL, (const float*)(ws + WS_CTL) + 1024);
#endif
}
```

```cpp
#include <hip/hip_runtime.h>
#include <stdint.h>

#define D_MODEL 1024
#define BATCH 4
#define SEQ 8192
#define NTOK (BATCH * SEQ)
#define DEPTH 4
#define N_A 2
#define N_HEADS 8
#define HEAD_DIM 128
#define N_KV 2
#define HEAD_GROUP 4
#define KV_DIM 256
#define IDX_HEADS 4
#define IDX_DIM 64
#define TOPK 256
#define MOBA_BLOCK 256
#define N_BLOCKS 32
#define N_GROUPS 4
#define EPG 8
#define N_EXPERTS 32
#define D_EXPERT 512
#define PLE_DIM 256
#define A_COLS 1860
#define QLD 2048
#define COL_K 1024
#define COL_V 1280
#define COL_IQ 1536
#define COL_IK 1792
#define COL_IW 1856
#define ALPHA_F 1.6817928305074290f
#define LN_EPS 1e-5f
#define MAX_SLOTS (65536 + 8192)
#define MAX_MTILES (MAX_SLOTS / 256)

#define LAS __attribute__((address_space(3)))
#define GAS __attribute__((address_space(1)))
typedef unsigned short bf16;
typedef short bf16x8 __attribute__((ext_vector_type(8)));
typedef float f32x4 __attribute__((ext_vector_type(4)));
typedef float f32x2 __attribute__((ext_vector_type(2)));
typedef unsigned u32x4 __attribute__((ext_vector_type(4)));
typedef unsigned u32x2 __attribute__((ext_vector_type(2)));
typedef _Float16 f16x4 __attribute__((ext_vector_type(4)));

__device__ __forceinline__ unsigned cvt_pk_bf16(float lo, float hi) { unsigned r; asm("v_cvt_pk_bf16_f32 %0, %1, %2" : "=v"(r) : "v"(lo), "v"(hi)); return r; }
__device__ __forceinline__ float bf2f(bf16 b) { return __uint_as_float(((unsigned)b) << 16); }
__device__ __forceinline__ float bflo(unsigned u) { return __uint_as_float(u << 16); }
__device__ __forceinline__ float bfhi(unsigned u) { return __uint_as_float(u & 0xffff0000u); }
template <int CTRL> __device__ __forceinline__ float dpp_add(float v) { return v + __int_as_float(__builtin_amdgcn_update_dpp(0, __float_as_int(v), CTRL, 0xF, 0xF, false)); }
__device__ __forceinline__ float row16_sum(float v) {
    v = dpp_add<0xB1>(v); v = dpp_add<0x4E>(v); v = dpp_add<0x141>(v); v = dpp_add<0x140>(v); return v;
}
__device__ __forceinline__ float wave_sum(float v) { v = row16_sum(v); v += __shfl_xor(v, 16); v += __shfl_xor(v, 32); return v; }
template <int CTRL, int RMASK> __device__ __forceinline__ unsigned dpp_addu(unsigned v) { return v + (unsigned)__builtin_amdgcn_update_dpp(0, (int)v, CTRL, RMASK, 0xF, false); }
__device__ __forceinline__ unsigned wave_scan_incl(unsigned v) {
    v = dpp_addu<0x111, 0xF>(v); v = dpp_addu<0x112, 0xF>(v); v = dpp_addu<0x114, 0xF>(v); v = dpp_addu<0x118, 0xF>(v);
    v = dpp_addu<0x142, 0xA>(v); v = dpp_addu<0x143, 0xC>(v); return v;
}

constexpr size_t MiB = 1u << 20;
constexpr size_t WS_CTL = 0, CTL_ZERO_BYTES = 1 * MiB;
constexpr size_t WS_WMIX = 2 * MiB;
constexpr size_t WS_WPG = 10 * MiB;
constexpr size_t WS_WPLE = 12 * MiB;
constexpr size_t WS_WGU = 16 * MiB;
constexpr size_t WS_WD = 80 * MiB;
constexpr size_t WS_PB = 112 * MiB;
constexpr size_t WS_H = 128 * MiB;
constexpr size_t WS_HB = 256 * MiB;
constexpr size_t WS_T = 320 * MiB;
constexpr size_t WS_KV = 448 * MiB;
constexpr size_t WS_PL = 480 * MiB;
constexpr size_t WS_QKVI = 544 * MiB;
constexpr size_t WS_ATTN = 672 * MiB;
constexpr size_t WS_SEL = 736 * MiB;
constexpr size_t WS_ACT = 544 * MiB;
constexpr size_t WS_Y = 616 * MiB;
constexpr size_t WS_MOE = 768 * MiB;
constexpr size_t WS_IW = 770 * MiB;
constexpr size_t WS_KM = 771 * MiB;
constexpr size_t WS_SCORES = 772 * MiB;
constexpr int MO_TOK_E = 0, MO_TOK_POS = NTOK * 2, MO_TOK_SLOT = NTOK * 4, MO_TOK_W = NTOK * 6, MO_SLOT_TOK = NTOK * 8, MO_TILE_E = MO_SLOT_TOK + MAX_SLOTS, MO_TILE_ROW0 = MO_TILE_E + 512, MO_TILE_NV = MO_TILE_ROW0 + 512;
constexpr int CW_BAR = 65536;
constexpr int CW_CNT = 16384;
constexpr int CW_NTILES = 16384 + 256;

constexpr int LDS_BYTES = 163840;
constexpr int LDS_MISC = 163840 - 256;
constexpr int NWAVES = 8;

#define XB_TMO      128
#define XB_XCNT(j)  (256  + 64 * (j))
#define XB_XSUB(j)  (1280 + 64 * (j))
#define XB_XGEN(j)  (2304 + 64 * (j))
#define XB_TOP      3328
#define XB_TOPGEN   3392
#define XCD_BAR_WORDS 3456
#define XB_SPIN_CAP (1u << 22)
__device__ __forceinline__ unsigned xb_ld(unsigned* p)              { return __hip_atomic_load(p, __ATOMIC_RELAXED, __HIP_MEMORY_SCOPE_AGENT); }
__device__ __forceinline__ unsigned xb_add(unsigned* p, unsigned v) { return __hip_atomic_fetch_add(p, v, __ATOMIC_RELAXED, __HIP_MEMORY_SCOPE_AGENT); }
__device__ __forceinline__ unsigned xb_xcc_id() { return (unsigned)__builtin_amdgcn_s_getreg((3 << 11) | 20) & 0xFu; }
#define XB_SPIN(cond, bar) do { unsigned _sp = 0; while (cond) { __builtin_amdgcn_s_sleep(1); \
    if ((++_sp & 255u) == 0u) { if (xb_ld(&(bar)[XB_TMO])) break; if (_sp > XB_SPIN_CAP) { atomicAdd(&(bar)[XB_TMO], 1u); break; } } } } while (0)
struct XcdBarrier { unsigned* bar; unsigned x; volatile LAS unsigned* st; };
__device__ __forceinline__ XcdBarrier xcd_barrier_post(unsigned* bar, volatile LAS unsigned* st) {
    XcdBarrier b; b.bar = bar; b.x = xb_xcc_id(); b.st = st;
    if (threadIdx.x == 0) (void)xb_add(&bar[XB_XCNT(b.x)], 1u);
    return b;
}
__device__ __forceinline__ void xcd_barrier_complete(unsigned* bar, unsigned x, unsigned& nloc, unsigned& nx) {
    const unsigned G = gridDim.x * gridDim.y * gridDim.z;
    unsigned sum, cnt, mine, sp = 0u;
    for (;;) {
        sum = 0u; cnt = 0u; mine = 0u;
#pragma unroll
        for (unsigned j = 0; j < 16; ++j) { const unsigned c = xb_ld(&bar[XB_XCNT(j)]); sum += c; cnt += (c > 0u) ? 1u : 0u; mine = (j == x) ? c : mine; }
        if (sum == G) break;
        __builtin_amdgcn_s_sleep(1);
        if ((++sp & 255u) == 0u) { if (xb_ld(&bar[XB_TMO])) break; if (sp > XB_SPIN_CAP) { atomicAdd(&bar[XB_TMO], 1u); break; } }
    }
    nloc = mine > 0u ? mine : 1u; nx = cnt > 0u ? cnt : 1u;
}
__device__ __forceinline__ void xcd_barrier(const XcdBarrier& b) {
    asm volatile("s_waitcnt vmcnt(0)" ::: "memory");
    __syncthreads();
    if (threadIdx.x == 0) {
        unsigned* bar = b.bar;
        __builtin_amdgcn_s_waitcnt(0);
        unsigned nloc = b.st[0], nx = b.st[1];
        if (nloc == 0u) { xcd_barrier_complete(bar, b.x, nloc, nx); b.st[0] = nloc; b.st[1] = nx; }
        const unsigned old = xb_add(&bar[XB_XSUB(b.x)], 1u);
        const unsigned gen = old / nloc;
        if (old + 1u == (gen + 1u) * nloc) {
            __builtin_amdgcn_fence(__ATOMIC_RELEASE, "agent");
            asm volatile("s_waitcnt vmcnt(0)" ::: "memory");
            const unsigned og = xb_add(&bar[XB_TOP], 1u);
            const unsigned tg = og / nx;
            if (og + 1u == (tg + 1u) * nx) xb_add(&bar[XB_TOPGEN], 1u);
            else XB_SPIN(xb_ld(&bar[XB_TOPGEN]) == tg, bar);
            __builtin_amdgcn_fence(__ATOMIC_ACQUIRE, "agent");
            xb_add(&bar[XB_XGEN(b.x)], 1u);
            asm volatile("s_waitcnt vmcnt(0)" ::: "memory");
        } else {
            XB_SPIN(xb_ld(&bar[XB_XGEN(b.x)]) == gen, bar);
            __builtin_amdgcn_fence(__ATOMIC_ACQUIRE, "agent");
            asm volatile("s_waitcnt vmcnt(0)" ::: "memory");
        }
    }
    __syncthreads();
}

namespace gm {
constexpr int BM = 256, BK = 64, HALF = 128, HTB = HALF * BK * 2, STAGE_BYTES = 8 * HTB, NXCD = 8, WGM = 8;
__host__ __device__ __forceinline__ int lds_byte(int r, int c) { const int st = (r >> 4) * 2 + (c >> 5), rr = r & 15, cc = c & 31, ob = rr * 64 + cc * 2; return st * 1024 + (ob ^ (((ob >> 9) & 1) << 5)); }
__host__ __device__ __forceinline__ void stage_rc(int b, int& R, int& C) { const int st = b / 1024, sb = b % 1024, swz = sb ^ (((sb >> 9) & 1) << 5); R = (st >> 1) * 16 + swz / 64; C = (st & 1) * 32 + (swz % 64) / 2; }
__host__ __device__ __forceinline__ int perm32(int rho) { const int n = rho >> 4, i = rho & 15; return 8 * (i >> 2) + 4 * n + (i & 3); }

struct Unit { const char* a; const char* b; int row0, col0, aux; };

struct DenseOrder {
    int nM, nN, nwg, G, c; const char* A; const char* B; size_t tA, tB;
    __device__ void init(const void* A_, const void* Bt_, int M, int N, int K, int G_, int c_) { nM = M / BM; nN = N / BM; nwg = nM * nN; G = G_; c = c_; A = (const char*)A_; B = (const char*)Bt_; tA = (size_t)BM * K * 2; tB = tA; }
    __device__ bool next(int i, Unit& u) const {
        const long L = (long)i * G + c; if (L >= nwg) return false;
        int wgid = (int)L; { const int q = nwg / NXCD, r = nwg % NXCD, xcd = wgid % NXCD, off = wgid / NXCD; wgid = (xcd < r ? xcd * (q + 1) : r * (q + 1) + (xcd - r) * q) + off; }
        const int nig = WGM * nN, gid = wgid / nig, fm = gid * WGM, gsz = (nM - fm) < WGM ? (nM - fm) : WGM;
        const int pm = fm + ((wgid % nig) % gsz), pn = (wgid % nig) / gsz;
        u.a = A + (size_t)pm * tA; u.b = B + (size_t)pn * tB; u.row0 = pm * BM; u.col0 = pn * BM; u.aux = 0; return true;
    }
    __device__ __forceinline__ void gather(const Unit&, unsigned (&)[2][2], const int (&)[2], const int (&)[2], int) const {}
};
struct MoeOrder {
    const int* tile_e; const int* tile_row0; const int* tile_nv; const int* slot_tok; int n_units, G, c, K; const char* A; const char* W; size_t wstride, tB; bool gath;
    __device__ bool next(int i, Unit& u) const {
        const int L = i * G + c; if (L >= n_units) return false;
        const int T = L >> 2, pn = L & 3;
        const int e = __builtin_amdgcn_readfirstlane(tile_e[T]), r0 = __builtin_amdgcn_readfirstlane(tile_row0[T]), nv = __builtin_amdgcn_readfirstlane(tile_nv[T]);
        u.a = gath ? A : A + (size_t)r0 * K * 2; u.b = W + (size_t)e * wstride + (size_t)pn * tB; u.row0 = r0; u.col0 = pn; u.aux = nv; return true;
    }
    __device__ __forceinline__ void gather(const Unit& u, unsigned (&vo)[2][2], const int (&sR)[2], const int (&sC)[2], int K_) const {
#pragma unroll
        for (int h = 0; h < 2; ++h)
#pragma unroll
            for (int i = 0; i < 2; ++i) { const int r = h * HALF + sR[i]; const int tok = (r < u.aux) ? slot_tok[u.row0 + r] : 0; vo[h][i] = (unsigned)(tok * K_ + sC[i]) * 2u; }
    }
};

template <class Epi, class Sched, bool GATHER>
__device__ __forceinline__ void gemm_phase(LAS unsigned char* lds, const int K, const Sched& S, const Epi& E) {
    int tz = threadIdx.x; asm volatile("" : "+v"(tz));
    const int tid = tz, wid = __builtin_amdgcn_readfirstlane(tid >> 6), lane = tid & 63, wr = wid >> 2, wc = wid & 3, fr = lane & 15, fq = lane >> 4;
    const int nt = K / BK;
    unsigned voffB[2], vA[2][2], vAn[2][2]; int sR[2], sC[2];
#pragma unroll
    for (int i = 0; i < 2; ++i) { int R, C; stage_rc(tid * 16 + i * 8192, R, C); const int Rb = Epi::PERM ? ((R & ~31) + perm32(R & 31)) : R;
        sR[i] = R; sC[i] = C; voffB[i] = (unsigned)(Rb * K + C) * 2u;
        vA[0][i] = (unsigned)(R * K + C) * 2u; vA[1][i] = (unsigned)((R + HALF) * K + C) * 2u; vAn[0][i] = vA[0][i]; vAn[1][i] = vA[1][i]; }
    const size_t kstep = (size_t)(BK * 2);
    const size_t hstep = (size_t)HALF * K * 2;
    const unsigned ldsw = (unsigned)wid * 1024u;
    const int aoff = lds_byte(wr * 64 + fr, fq * 8), boff = lds_byte(wc * 32 + fr, fq * 8);
#define PG8_SA(b, h) (((b) * 2 + (h)) * HTB)
#define PG8_SB(b, h) ((4 + (b) * 2 + (h)) * HTB)
#define PG8_STAGE(bufoff, gbase, voff) do { _Pragma("unroll") for (int _i = 0; _i < 2; ++_i) \
        __builtin_amdgcn_global_load_lds((const unsigned*)((const char*)(gbase) + (voff)[_i]), (LAS unsigned*)(lds + (bufoff) + ldsw + _i * 8192), 16, 0, 0); } while (0)
#define PG8_LDA(dst, b, h) do { _Pragma("unroll") for (int m = 0; m < 4; ++m) _Pragma("unroll") for (int k = 0; k < 2; ++k) dst[m][k] = *(const LAS bf16x8*)(lds + PG8_SA(b, h) + aoff + m * 2048 + k * 1024); } while (0)
#define PG8_LDB(dst, b, h) do { _Pragma("unroll") for (int n = 0; n < 2; ++n) _Pragma("unroll") for (int k = 0; k < 2; ++k) dst[n][k] = *(const LAS bf16x8*)(lds + PG8_SB(b, h) + boff + n * 2048 + k * 1024); } while (0)
#define PG8_MMA(ai, bj, At, Bt) do { __builtin_amdgcn_s_setprio(1); _Pragma("unroll") for (int m = 0; m < 4; ++m) _Pragma("unroll") for (int n = 0; n < 2; ++n) _Pragma("unroll") for (int k = 0; k < 2; ++k) \
        acc[ai][bj][m][n] = __builtin_amdgcn_mfma_f32_16x16x32_bf16(Bt[n][k], At[m][k], acc[ai][bj][m][n], 0, 0, 0); __builtin_amdgcn_s_setprio(0); } while (0)
#define PG8_WAIT_V(n) asm volatile("s_waitcnt vmcnt(" #n ")" ::: "memory")
#define PG8_WAIT_L(n) asm volatile("s_waitcnt lgkmcnt(" #n ")" ::: "memory")
#define PG8_BAR __builtin_amdgcn_s_barrier()
#define PG8_SCHED __builtin_amdgcn_sched_barrier(0)
    Unit cur, nxt; int ui = 0;
    if (!S.next(0, cur)) return;
    f32x4 acc[2][2][4][2];
#pragma unroll
    for (int a = 0; a < 2; ++a)
#pragma unroll
        for (int b = 0; b < 2; ++b)
#pragma unroll
            for (int m = 0; m < 4; ++m)
#pragma unroll
                for (int n = 0; n < 2; ++n) acc[a][b][m][n] = (f32x4){0.f, 0.f, 0.f, 0.f};
    bf16x8 At[4][2], B0[2][2], B1[2][2];
    const char* cA = cur.a; const char* cB = cur.b;
    if constexpr (GATHER) S.gather(cur, vA, sR, sC, K);
    PG8_STAGE(PG8_SB(0, 0), cB, voffB); PG8_STAGE(PG8_SB(0, 1), cB + hstep, voffB); PG8_STAGE(PG8_SA(0, 0), cA, vA[0]); PG8_STAGE(PG8_SA(0, 1), cA, vA[1]);
    if (wr == 1) PG8_BAR;
    PG8_WAIT_V(2); PG8_BAR;
    PG8_STAGE(PG8_SB(1, 0), cB + kstep, voffB); PG8_STAGE(PG8_SA(1, 0), cA + kstep, vA[0]); PG8_STAGE(PG8_SB(1, 1), cB + hstep + kstep, voffB);
    PG8_WAIT_V(6); PG8_BAR;
    for (;;) {
        const bool has_next = S.next(ui + 1, nxt);
        const char* nA = has_next ? nxt.a : cA; const char* nB = has_next ? nxt.b : cB;
        if constexpr (GATHER) {
            if (has_next) S.gather(nxt, vAn, sR, sC, K);
            else { vAn[0][0] = vA[0][0]; vAn[0][1] = vA[0][1]; vAn[1][0] = vA[1][0]; vAn[1][1] = vA[1][1]; }
        }
        for (int t = 0; t < nt; t += 2) {
            const bool last = (t == nt - 2);
            const char* a1 = cA + (size_t)(t + 1) * kstep;
            const char* a2 = last ? nA : cA + (size_t)(t + 2) * kstep; const char* b2 = last ? nB : cB + (size_t)(t + 2) * kstep;
            const char* a3 = a2 + kstep; const char* b3 = b2 + kstep;
            unsigned w0[2], w1[2];
            if constexpr (GATHER) { w0[0] = last ? vAn[0][0] : vA[0][0]; w0[1] = last ? vAn[0][1] : vA[0][1]; w1[0] = last ? vAn[1][0] : vA[1][0]; w1[1] = last ? vAn[1][1] : vA[1][1]; }
            else { w0[0] = vA[0][0]; w0[1] = vA[0][1]; w1[0] = vA[1][0]; w1[1] = vA[1][1]; }
            PG8_LDB(B0, 0, 0); PG8_LDB(B1, 0, 1); PG8_SCHED; PG8_LDA(At, 0, 0); PG8_STAGE(PG8_SA(1, 1), a1, vA[1]);
            PG8_WAIT_V(8); PG8_WAIT_L(0); PG8_BAR; PG8_MMA(0, 0, At, B0); PG8_MMA(0, 1, At, B1); PG8_BAR; PG8_SCHED;
            PG8_LDA(At, 0, 1); PG8_STAGE(PG8_SB(0, 0), b2, voffB); PG8_STAGE(PG8_SB(0, 1), b2 + hstep, voffB); PG8_STAGE(PG8_SA(0, 0), a2, w0);
            PG8_WAIT_V(8); PG8_WAIT_L(0); PG8_BAR; PG8_MMA(1, 0, At, B0); PG8_MMA(1, 1, At, B1); PG8_BAR; PG8_SCHED;
            PG8_LDB(B0, 1, 0); PG8_LDB(B1, 1, 1); PG8_SCHED; PG8_LDA(At, 1, 0); PG8_STAGE(PG8_SA(0, 1), a2, w1);
            PG8_WAIT_V(8); PG8_WAIT_L(0); PG8_BAR; PG8_MMA(0, 0, At, B0); PG8_MMA(0, 1, At, B1); PG8_BAR; PG8_SCHED;
            PG8_LDA(At, 1, 1); PG8_STAGE(PG8_SB(1, 0), b3, voffB); PG8_STAGE(PG8_SB(1, 1), b3 + hstep, voffB); PG8_STAGE(PG8_SA(1, 0), a3, w0);
            PG8_WAIT_V(8); PG8_WAIT_L(0); PG8_BAR; PG8_MMA(1, 0, At, B0); PG8_MMA(1, 1, At, B1); PG8_BAR; PG8_SCHED;
        }
        if (wr == 0) PG8_BAR;
        E(acc, cur, wr, wc, fr, fq);
        if (!has_next) break;
#pragma unroll
        for (int a = 0; a < 2; ++a)
#pragma unroll
            for (int b = 0; b < 2; ++b)
#pragma unroll
                for (int m = 0; m < 4; ++m)
#pragma unroll
                    for (int n = 0; n < 2; ++n) acc[a][b][m][n] = (f32x4){0.f, 0.f, 0.f, 0.f};
        cur = nxt; cA = nA; cB = nB; ++ui;
        if constexpr (GATHER) { vA[0][0] = vAn[0][0]; vA[0][1] = vAn[0][1]; vA[1][0] = vAn[1][0]; vA[1][1] = vAn[1][1]; }
        if (wr == 1) PG8_BAR;
    }
    PG8_WAIT_V(0);
    PG8_BAR;
#undef PG8_SA
#undef PG8_SB
#undef PG8_STAGE
#undef PG8_LDA
#undef PG8_LDB
#undef PG8_MMA
#undef PG8_WAIT_V
#undef PG8_WAIT_L
#undef PG8_BAR
#undef PG8_SCHED
}

#define EPI_ROWS(u, ai, m) ((u).row0 + (ai) * HALF + wr * 64 + (m) * 16 + fr)
struct EpiBf16 {
    static constexpr bool PERM = true;
    bf16* O; int ldc; float* iw;
    __device__ __forceinline__ void operator()(const f32x4 (&acc)[2][2][4][2], const Unit& u, int wr, int wc, int fr, int fq) const {
#pragma unroll
        for (int ai = 0; ai < 2; ++ai)
#pragma unroll
            for (int m = 0; m < 4; ++m) { const int row = EPI_ROWS(u, ai, m); bf16* rowp = O + (size_t)row * ldc + u.col0 + wc * 32 + 8 * fq;
#pragma unroll
                for (int bj = 0; bj < 2; ++bj) { const f32x4 v0 = acc[ai][bj][m][0], v1 = acc[ai][bj][m][1];
                    u32x4 w; w.x = cvt_pk_bf16(v0[0], v0[1]); w.y = cvt_pk_bf16(v0[2], v0[3]); w.z = cvt_pk_bf16(v1[0], v1[1]); w.w = cvt_pk_bf16(v1[2], v1[3]);
                    *(u32x4*)(rowp + bj * HALF) = w; }
                if (iw != nullptr && u.col0 == 1792 && wc == 2 && fq == 0) *(f32x4*)(iw + (size_t)row * 4) = acc[ai][0][m][0] * 0.0625f; }
    }
};
struct EpiResid {
    static constexpr bool PERM = false;
    const float* h; _Float16* t;
    __device__ __forceinline__ void operator()(const f32x4 (&acc)[2][2][4][2], const Unit& u, int wr, int wc, int fr, int fq) const {
#pragma unroll
        for (int ai = 0; ai < 2; ++ai)
#pragma unroll
            for (int m = 0; m < 4; ++m) { const size_t o = (size_t)EPI_ROWS(u, ai, m) * D_MODEL + u.col0 + wc * 32 + 4 * fq;
#pragma unroll
                for (int bj = 0; bj < 2; ++bj)
#pragma unroll
                    for (int n = 0; n < 2; ++n) { const size_t oo = o + bj * HALF + n * 16; const f32x4 hv = *(const f32x4*)(h + oo); const f32x4 tv = hv * ALPHA_F + acc[ai][bj][m][n]; *(f16x4*)(t + oo) = (f16x4){(_Float16)tv[0], (_Float16)tv[1], (_Float16)tv[2], (_Float16)tv[3]}; } }
    }
};
struct EpiPle {
    static constexpr bool PERM = false;
    const float* h; const bf16* pl; _Float16* t;
    __device__ __forceinline__ void operator()(const f32x4 (&acc)[2][2][4][2], const Unit& u, int wr, int wc, int fr, int fq) const {
#pragma unroll
        for (int ai = 0; ai < 2; ++ai)
#pragma unroll
            for (int m = 0; m < 4; ++m) { const size_t o = (size_t)EPI_ROWS(u, ai, m) * D_MODEL + u.col0 + wc * 32 + 4 * fq;
#pragma unroll
                for (int bj = 0; bj < 2; ++bj)
#pragma unroll
                    for (int n = 0; n < 2; ++n) { const size_t oo = o + bj * HALF + n * 16; const f32x4 hv = *(const f32x4*)(h + oo); const u32x2 pv = *(const u32x2*)(pl + oo);
                        const f32x4 a = acc[ai][bj][m][n]; f32x4 r;
                        r[0] = fmaf(hv[0], ALPHA_F, bflo(pv.x) * __builtin_amdgcn_rcpf(1.f + __builtin_amdgcn_exp2f(a[0] * -1.4426950408889634f))); r[1] = fmaf(hv[1], ALPHA_F, bfhi(pv.x) * __builtin_amdgcn_rcpf(1.f + __builtin_amdgcn_exp2f(a[1] * -1.4426950408889634f)));
                        r[2] = fmaf(hv[2], ALPHA_F, bflo(pv.y) * __builtin_amdgcn_rcpf(1.f + __builtin_amdgcn_exp2f(a[2] * -1.4426950408889634f))); r[3] = fmaf(hv[3], ALPHA_F, bfhi(pv.y) * __builtin_amdgcn_rcpf(1.f + __builtin_amdgcn_exp2f(a[3] * -1.4426950408889634f)));
                        *(f16x4*)(t + oo) = (f16x4){(_Float16)r[0], (_Float16)r[1], (_Float16)r[2], (_Float16)r[3]}; } }
    }
};
struct EpiSwiglu {
    static constexpr bool PERM = true;
    bf16* act;
    __device__ __forceinline__ void operator()(const f32x4 (&acc)[2][2][4][2], const Unit& u, int wr, int wc, int fr, int fq) const {
#pragma unroll
        for (int ai = 0; ai < 2; ++ai)
#pragma unroll
            for (int m = 0; m < 4; ++m) { const int row = EPI_ROWS(u, ai, m); float r[8];
#pragma unroll
                for (int n = 0; n < 2; ++n)
#pragma unroll
                    for (int j = 0; j < 4; ++j) { const float g = acc[ai][0][m][n][j], uu = acc[ai][1][m][n][j]; r[n * 4 + j] = g * __builtin_amdgcn_rcpf(1.f + __builtin_amdgcn_exp2f(g * -1.4426950408889634f)) * uu; }
                u32x4 w; w.x = cvt_pk_bf16(r[0], r[1]); w.y = cvt_pk_bf16(r[2], r[3]); w.z = cvt_pk_bf16(r[4], r[5]); w.w = cvt_pk_bf16(r[6], r[7]);
                *(u32x4*)(act + (size_t)row * D_EXPERT + u.col0 * 128 + wc * 32 + 8 * fq) = w; }
    }
};
struct EpiMoeDown {
    static constexpr bool PERM = true;
    bf16* Y;
    __device__ __forceinline__ void operator()(const f32x4 (&acc)[2][2][4][2], const Unit& u, int wr, int wc, int fr, int fq) const {
#pragma unroll
        for (int ai = 0; ai < 2; ++ai)
#pragma unroll
            for (int m = 0; m < 4; ++m) { const int row = EPI_ROWS(u, ai, m); bf16* rowp = Y + (size_t)row * D_MODEL + u.col0 * 256 + wc * 32 + 8 * fq;
#pragma unroll
                for (int bj = 0; bj < 2; ++bj) { const f32x4 v0 = acc[ai][bj][m][0], v1 = acc[ai][bj][m][1];
                    u32x4 w; w.x = cvt_pk_bf16(v0[0], v0[1]); w.y = cvt_pk_bf16(v0[2], v0[3]); w.z = cvt_pk_bf16(v1[0], v1[1]); w.w = cvt_pk_bf16(v1[2], v1[3]);
                    *(u32x4*)(rowp + bj * HALF) = w; } }
    }
};
}

struct Params { const float* in[18]; float* out; unsigned char* ws; int ph_lo, ph_hi, bar_idx, pad; };
typedef const Params __attribute__((address_space(4)))* KP;
__device__ __forceinline__ KP fresh_params() { KP p = (KP)__builtin_amdgcn_kernarg_segment_ptr(); asm volatile("" : "+s"(p)); return p; }

__device__ __forceinline__ void tr_item(const float* W, int K, int N, bf16* WT, int row_off, LAS float* scr, int kb, int nb, int lane) {
    const int k0 = 64 * kb, n0 = 32 * nb;
    const bool ok = (n0 + (lane & 31)) < N;
    if (n0 + 32 <= N) {
        const int kr = lane >> 3, c4 = (lane & 7) * 4;
#pragma unroll
        for (int i = 0; i < 8; ++i) { const int kk = 8 * i + kr; const f32x4 v = __builtin_nontemporal_load((const f32x4*)(W + (size_t)(k0 + kk) * N + n0 + c4));
            LAS float* d = scr + kk * 33 + c4; d[0] = v[0]; d[1] = v[1]; d[2] = v[2]; d[3] = v[3]; }
    } else {
#pragma unroll 8
        for (int i = 0; i < 32; ++i) { const int kk = 2 * i + (lane >> 5); scr[kk * 33 + (lane & 31)] = ok ? W[(size_t)(k0 + kk) * N + n0 + (lane & 31)] : 0.f; }
    }
    asm volatile("s_waitcnt lgkmcnt(0)" ::: "memory");
    const int c = lane & 7;
#pragma unroll
    for (int j = 0; j < 4; ++j) { const int n = (lane >> 3) + 8 * j; const LAS float* s = scr + (8 * c) * 33 + n;
        u32x4 o; o.x = cvt_pk_bf16(s[0 * 33], s[1 * 33]); o.y = cvt_pk_bf16(s[2 * 33], s[3 * 33]); o.z = cvt_pk_bf16(s[4 * 33], s[5 * 33]); o.w = cvt_pk_bf16(s[6 * 33], s[7 * 33]);
        *(u32x4*)(WT + (size_t)(row_off + n0 + n) * K + k0 + 8 * c) = o; }
    asm volatile("s_waitcnt lgkmcnt(0)" ::: "memory");
}
__device__ __forceinline__ void cvt_rows(const float* src, bf16* dst, size_t n4, int gtid, int gthreads) {
    size_t i = gtid;
    for (; i + 3 * (size_t)gthreads < n4; i += 4 * (size_t)gthreads) {
        f32x4 v[4];
#pragma unroll
        for (int u = 0; u < 4; ++u) v[u] = __builtin_nontemporal_load((const f32x4*)(src + (i + u * (size_t)gthreads) * 4));
#pragma unroll
        for (int u = 0; u < 4; ++u) { u32x2 o; o.x = cvt_pk_bf16(v[u][0], v[u][1]); o.y = cvt_pk_bf16(v[u][2], v[u][3]); *(u32x2*)(dst + (i + u * (size_t)gthreads) * 4) = o; }
    }
    for (; i < n4; i += gthreads) { const f32x4 v = *(const f32x4*)(src + i * 4); u32x2 o; o.x = cvt_pk_bf16(v[0], v[1]); o.y = cvt_pk_bf16(v[2], v[3]); *(u32x2*)(dst + i * 4) = o; }
}
__device__ __forceinline__ void phase_convert(KP P, int L, LAS unsigned char* lds) {
    int tz = threadIdx.x; asm volatile("" : "+v"(tz));
    const int tid = tz, lane = tid & 63, wave = tid >> 6;
    LAS float* scr = (LAS float*)(lds + wave * 17408);
    const int gw = blockIdx.x * NWAVES + wave, NGW = gridDim.x * NWAVES;
    unsigned char* ws = P->ws;
    bf16* wmix = (bf16*)(ws + WS_WMIX); bf16* wo_t = (bf16*)(ws + WS_WMIX + 4 * MiB); bf16* wkv_t = (bf16*)(ws + WS_WMIX + 6 * MiB);
    bf16* wpg_t = (bf16*)(ws + WS_WPG); bf16* wple_t = (bf16*)(ws + WS_WPLE); bf16* wgu_t = (bf16*)(ws + WS_WGU); bf16* wd_t = (bf16*)(ws + WS_WD);
    const bool isA = L < N_A; const int j = L - N_A;
    const float* w_first = isA ? P->in[2] + (size_t)L * D_MODEL * A_COLS : P->in[5] + (size_t)j * D_MODEL * D_MODEL;
    const int n_first = isA ? A_COLS : D_MODEL, nb_first = isA ? 64 : 32;
    const float* w_o = isA ? P->in[3] + (size_t)L * D_MODEL * D_MODEL : P->in[6] + (size_t)j * D_MODEL * D_MODEL;
    const int I_FIRST = 16 * nb_first, I_O = 16 * 32, I_KV = (L == N_A) ? 16 * 16 : 0, I_PG = 16 * 32, I_PLE = 4 * 32, I_G = 32 * 256, I_U = 32 * 256, I_D = 32 * 256;
    const int NITEMS = I_FIRST + I_O + I_KV + I_PG + I_PLE + I_G + I_U + I_D;
    const size_t wsz = (size_t)D_MODEL * D_EXPERT;
#define CV_DECODE(IT, W_, K_, N_, WT_, RO_, KB_, NB_) do { int r = (IT); \
        if (r < I_FIRST) { W_ = w_first; K_ = D_MODEL; N_ = n_first; WT_ = wmix; RO_ = 0; KB_ = r / nb_first; NB_ = r % nb_first; break; } r -= I_FIRST; \
        if (r < I_O) { W_ = w_o; K_ = D_MODEL; N_ = D_MODEL; WT_ = wo_t; RO_ = 0; KB_ = r / 32; NB_ = r % 32; break; } r -= I_O; \
        if (r < I_KV) { W_ = P->in[4]; K_ = D_MODEL; N_ = 512; WT_ = wkv_t; RO_ = 0; KB_ = r / 16; NB_ = r % 16; break; } r -= I_KV; \
        if (r < I_PG) { W_ = P->in[15] + (size_t)L * D_MODEL * D_MODEL; K_ = D_MODEL; N_ = D_MODEL; WT_ = wpg_t; RO_ = 0; KB_ = r / 32; NB_ = r % 32; break; } r -= I_PG; \
        if (r < I_PLE) { W_ = P->in[14] + (size_t)L * PLE_DIM * D_MODEL; K_ = PLE_DIM; N_ = D_MODEL; WT_ = wple_t; RO_ = 0; KB_ = r / 32; NB_ = r % 32; break; } r -= I_PLE; \
        if (r < I_G + I_U) { const bool up = r >= I_G; if (up) r -= I_G; const int e = r >> 8, rem = r & 255, n0 = (rem & 15) * 32; \
            W_ = (up ? P->in[12] : P->in[11]) + ((size_t)L * N_EXPERTS + e) * wsz; K_ = D_MODEL; N_ = D_EXPERT; WT_ = wgu_t + (size_t)e * D_MODEL * D_MODEL; \
            RO_ = (n0 >> 7) * 256 + (up ? 128 : 0) + (n0 & 127) - n0; KB_ = rem >> 4; NB_ = rem & 15; break; } \
        r -= I_G + I_U; { const int e = r >> 8, rem = r & 255; W_ = P->in[13] + ((size_t)L * N_EXPERTS + e) * wsz; K_ = D_EXPERT; N_ = D_MODEL; WT_ = wd_t + (size_t)e * wsz; RO_ = 0; KB_ = rem >> 5; NB_ = rem & 31; } } while (0)
    LAS float* scr2 = scr + 64 * 33;
    for (int it = gw; it < NITEMS; it += 2 * NGW) {
        const float* W0; int K0, N0, RO0, KB0, NB0; bf16* WT0; CV_DECODE(it, W0, K0, N0, WT0, RO0, KB0, NB0);
        const int it1 = it + NGW;
        if (it1 >= NITEMS) { tr_item(W0, K0, N0, WT0, RO0, scr, KB0, NB0, lane); continue; }
        const float* W1; int K1, N1, RO1, KB1, NB1; bf16* WT1; CV_DECODE(it1, W1, K1, N1, WT1, RO1, KB1, NB1);
        if (NB0 * 32 + 32 > N0 || NB1 * 32 + 32 > N1) { tr_item(W0, K0, N0, WT0, RO0, scr, KB0, NB0, lane); tr_item(W1, K1, N1, WT1, RO1, scr, KB1, NB1, lane); continue; }
        const int kr = lane >> 3, c4 = (lane & 7) * 4;
        f32x4 va[8], vb2[8];
#pragma unroll
        for (int i = 0; i < 8; ++i) { va[i] = __builtin_nontemporal_load((const f32x4*)(W0 + (size_t)(64 * KB0 + 8 * i + kr) * N0 + 32 * NB0 + c4)); vb2[i] = __builtin_nontemporal_load((const f32x4*)(W1 + (size_t)(64 * KB1 + 8 * i + kr) * N1 + 32 * NB1 + c4)); }
#pragma unroll
        for (int i = 0; i < 8; ++i) { LAS float* d = scr + (8 * i + kr) * 33 + c4; d[0] = va[i][0]; d[1] = va[i][1]; d[2] = va[i][2]; d[3] = va[i][3];
            LAS float* d2 = scr2 + (8 * i + kr) * 33 + c4; d2[0] = vb2[i][0]; d2[1] = vb2[i][1]; d2[2] = vb2[i][2]; d2[3] = vb2[i][3]; }
        asm volatile("s_waitcnt lgkmcnt(0)" ::: "memory");
        { const int c = lane & 7;
#pragma unroll
          for (int jj = 0; jj < 4; ++jj) { const int n = (lane >> 3) + 8 * jj; const LAS float* s0 = scr + (8 * c) * 33 + n; const LAS float* s1 = scr2 + (8 * c) * 33 + n;
              u32x4 o0, o1; o0.x = cvt_pk_bf16(s0[0 * 33], s0[1 * 33]); o0.y = cvt_pk_bf16(s0[2 * 33], s0[3 * 33]); o0.z = cvt_pk_bf16(s0[4 * 33], s0[5 * 33]); o0.w = cvt_pk_bf16(s0[6 * 33], s0[7 * 33]);
              o1.x = cvt_pk_bf16(s1[0 * 33], s1[1 * 33]); o1.y = cvt_pk_bf16(s1[2 * 33], s1[3 * 33]); o1.z = cvt_pk_bf16(s1[4 * 33], s1[5 * 33]); o1.w = cvt_pk_bf16(s1[6 * 33], s1[7 * 33]);
              *(u32x4*)(WT0 + (size_t)(RO0 + 32 * NB0 + n) * K0 + 64 * KB0 + 8 * c) = o0; *(u32x4*)(WT1 + (size_t)(RO1 + 32 * NB1 + n) * K1 + 64 * KB1 + 8 * c) = o1; } }
        asm volatile("s_waitcnt lgkmcnt(0)" ::: "memory");
    }
#undef CV_DECODE
    const int gtid = blockIdx.x * 512 + tid, gthreads = gridDim.x * 512;
    { const float* wrg = P->in[7] + (size_t)L * D_MODEL * N_GROUPS; const float* wre = P->in[9] + (size_t)L * D_MODEL * N_EXPERTS; float* wrt = (float*)(ws + WS_WPLE + 1 * MiB);
      for (int i = gtid; i < D_MODEL * 36; i += gthreads) { const int c = i >> 10, k = i & 1023; wrt[i] = (c < 4) ? wrg[k * 4 + c] : wre[k * 32 + (c - 4)]; } }
    cvt_rows(P->in[1] + (size_t)L * NTOK * PLE_DIM, (bf16*)(ws + WS_PB), (size_t)NTOK * PLE_DIM / 4, gtid, gthreads);
    if (L == 0) cvt_rows(P->in[0], (bf16*)(ws + WS_HB), (size_t)NTOK * D_MODEL / 4, gtid, gthreads);
}

template <int SRC, bool ROUTER>
__device__ __forceinline__ void phase_ln(KP P, int L, int which, LAS unsigned char* lds, float* dst_f32, bool write_hb, int cidx = -1) {
    int tz = threadIdx.x; asm volatile("" : "+v"(tz)); const int tid = tz, lane = tid & 63, wave = tid >> 6;
    unsigned char* ws = P->ws;
    const _Float16* t = (const _Float16*)(ws + WS_T); const float* h = (const float*)(ws + WS_H); bf16* hb = (bf16*)(ws + WS_HB);
    const bf16* Y = (const bf16*)(ws + WS_Y);
    const int* moe = (const int*)(ws + WS_MOE);
    const float* g = P->in[16] + (size_t)(L * 3 + which) * D_MODEL; const float* bt = P->in[17] + (size_t)(L * 3 + which) * D_MODEL;
    f32x4 gv[4], bv[4];
#pragma unroll
    for (int j = 0; j < 4; ++j) { gv[j] = *(const f32x4*)(g + 4 * lane + 256 * j); bv[j] = *(const f32x4*)(bt + 4 * lane + 256 * j); }
    const int gw = blockIdx.x * NWAVES + wave, NGW = gridDim.x * NWAVES;
    for (int pi = gw; pi < NTOK / 2; pi += NGW) {
        const int row0 = pi * 2;
        f32x4 v[2][4];
        if (SRC == 0) {
            f16x4 tv[2][4];
#pragma unroll
            for (int u = 0; u < 2; ++u)
#pragma unroll
                for (int j = 0; j < 4; ++j) tv[u][j] = __builtin_nontemporal_load((const f16x4*)(t + (size_t)(row0 + u) * D_MODEL + 4 * lane + 256 * j));
#pragma unroll
            for (int u = 0; u < 2; ++u)
#pragma unroll
                for (int j = 0; j < 4; ++j) v[u][j] = (f32x4){(float)tv[u][j][0], (float)tv[u][j][1], (float)tv[u][j][2], (float)tv[u][j][3]};
        } else {
            int sl[2][2]; float wq[2][2]; f32x4 hv[2][4]; u32x2 y0[2][4], y1[2][4];
#pragma unroll
            for (int u = 0; u < 2; ++u) { sl[u][0] = moe[MO_TOK_SLOT + (row0 + u) * 2]; sl[u][1] = moe[MO_TOK_SLOT + (row0 + u) * 2 + 1];
                wq[u][0] = ((const float*)moe)[MO_TOK_W + (row0 + u) * 2]; wq[u][1] = ((const float*)moe)[MO_TOK_W + (row0 + u) * 2 + 1];
#pragma unroll
                for (int j = 0; j < 4; ++j) hv[u][j] = *(const f32x4*)(h + (size_t)(row0 + u) * D_MODEL + 4 * lane + 256 * j); }
#pragma unroll
            for (int u = 0; u < 2; ++u)
#pragma unroll
                for (int j = 0; j < 4; ++j) { y0[u][j] = *(const u32x2*)(Y + (size_t)sl[u][0] * D_MODEL + 4 * lane + 256 * j); y1[u][j] = *(const u32x2*)(Y + (size_t)sl[u][1] * D_MODEL + 4 * lane + 256 * j); }
#pragma unroll
            for (int u = 0; u < 2; ++u)
#pragma unroll
                for (int j = 0; j < 4; ++j) { const float w0 = wq[u][0], w1 = wq[u][1];
                    v[u][j][0] = hv[u][j][0] * ALPHA_F + (w0 * bflo(y0[u][j].x) + w1 * bflo(y1[u][j].x)); v[u][j][1] = hv[u][j][1] * ALPHA_F + (w0 * bfhi(y0[u][j].x) + w1 * bfhi(y1[u][j].x));
                    v[u][j][2] = hv[u][j][2] * ALPHA_F + (w0 * bflo(y0[u][j].y) + w1 * bflo(y1[u][j].y)); v[u][j][3] = hv[u][j][3] * ALPHA_F + (w0 * bfhi(y0[u][j].y) + w1 * bfhi(y1[u][j].y)); }
        }
#pragma unroll
        for (int u = 0; u < 2; ++u) {
            const int row = row0 + u;
            float s = 0.f;
#pragma unroll
            for (int j = 0; j < 4; ++j) s += (v[u][j][0] + v[u][j][1]) + (v[u][j][2] + v[u][j][3]);
            const float mean = wave_sum(s) * (1.f / D_MODEL);
            float q = 0.f;
#pragma unroll
            for (int j = 0; j < 4; ++j) { v[u][j] = v[u][j] - mean; q += (v[u][j][0] * v[u][j][0] + v[u][j][1] * v[u][j][1]) + (v[u][j][2] * v[u][j][2] + v[u][j][3] * v[u][j][3]); }
            const float rstd = rsqrtf(wave_sum(q) * (1.f / D_MODEL) + LN_EPS);
#pragma unroll
            for (int j = 0; j < 4; ++j) { v[u][j] = v[u][j] * rstd * gv[j] + bv[j]; *(f32x4*)(dst_f32 + (size_t)row * D_MODEL + 4 * lane + 256 * j) = v[u][j]; }
            if (write_hb) {
#pragma unroll
                for (int j = 0; j < 4; ++j) { u32x2 o; o.x = cvt_pk_bf16(v[u][j][0], v[u][j][1]); o.y = cvt_pk_bf16(v[u][j][2], v[u][j][3]); *(u32x2*)(hb + (size_t)row * D_MODEL + 4 * lane + 256 * j) = o; }
            }
        }
    }
    (void)lds; (void)cidx;
}

__device__ __forceinline__ void phase_ln_router(KP P, int L, LAS unsigned char* lds, int cidx) {
    int tz = threadIdx.x; asm volatile("" : "+v"(tz)); const int tid = tz, lane = tid & 63, wave = tid >> 6;
    unsigned char* ws = P->ws;
    const _Float16* t = (const _Float16*)(ws + WS_T); float* h = (float*)(ws + WS_H); bf16* hb = (bf16*)(ws + WS_HB);
    int* moe = (int*)(ws + WS_MOE);
    const float* g = P->in[16] + (size_t)(L * 3) * D_MODEL; const float* bt = P->in[17] + (size_t)(L * 3) * D_MODEL;
    LAS float* Wl = (LAS float*)lds;
    LAS float* lgs = (LAS float*)(lds + 147456) + wave * 80;
    LAS int* lcnt = (LAS int*)(lds + 150016);
    LAS int* rinfo = (LAS int*)(lds + 150272);
    { const f32x4* wrt = (const f32x4*)(ws + WS_WPLE + 1 * MiB);
      for (int i = tid; i < D_MODEL * 36 / 4; i += 512) ((LAS f32x4*)Wl)[i] = wrt[i];
      if (tid < 64) lcnt[tid] = 0; }
    __syncthreads();
    f32x4 gv[4], bv[4];
#pragma unroll
    for (int j = 0; j < 4; ++j) { gv[j] = *(const f32x4*)(g + 4 * lane + 256 * j); bv[j] = *(const f32x4*)(bt + 4 * lane + 256 * j); }
    const float* brg = P->in[8] + L * N_GROUPS; const float* bre = P->in[10] + L * N_EXPERTS;
    const int gw = blockIdx.x * NWAVES + wave, NGW = gridDim.x * NWAVES;
    int it = 0;
    for (int pi = gw; pi < NTOK / 2; pi += NGW, ++it) {
        const int row0 = pi * 2;
        f32x4 va[4], vb[4];
#pragma unroll
        for (int j = 0; j < 4; ++j) { const f16x4 ta = __builtin_nontemporal_load((const f16x4*)(t + (size_t)row0 * D_MODEL + 4 * lane + 256 * j)), tb2 = __builtin_nontemporal_load((const f16x4*)(t + (size_t)(row0 + 1) * D_MODEL + 4 * lane + 256 * j));
            va[j] = (f32x4){(float)ta[0], (float)ta[1], (float)ta[2], (float)ta[3]}; vb[j] = (f32x4){(float)tb2[0], (float)tb2[1], (float)tb2[2], (float)tb2[3]}; }
        float sa = 0.f, sb = 0.f;
#pragma unroll
        for (int j = 0; j < 4; ++j) { sa += (va[j][0] + va[j][1]) + (va[j][2] + va[j][3]); sb += (vb[j][0] + vb[j][1]) + (vb[j][2] + vb[j][3]); }
        const float ma = wave_sum(sa) * (1.f / D_MODEL), mb_ = wave_sum(sb) * (1.f / D_MODEL);
        float qa = 0.f, qb = 0.f;
#pragma unroll
        for (int j = 0; j < 4; ++j) { va[j] = va[j] - ma; vb[j] = vb[j] - mb_;
            qa += (va[j][0] * va[j][0] + va[j][1] * va[j][1]) + (va[j][2] * va[j][2] + va[j][3] * va[j][3]);
            qb += (vb[j][0] * vb[j][0] + vb[j][1] * vb[j][1]) + (vb[j][2] * vb[j][2] + vb[j][3] * vb[j][3]); }
        const float ra = rsqrtf(wave_sum(qa) * (1.f / D_MODEL) + LN_EPS), rb = rsqrtf(wave_sum(qb) * (1.f / D_MODEL) + LN_EPS);
#pragma unroll
        for (int j = 0; j < 4; ++j) { va[j] = va[j] * ra * gv[j] + bv[j]; vb[j] = vb[j] * rb * gv[j] + bv[j];
            *(f32x4*)(h + (size_t)row0 * D_MODEL + 4 * lane + 256 * j) = va[j]; *(f32x4*)(h + (size_t)(row0 + 1) * D_MODEL + 4 * lane + 256 * j) = vb[j];
            u32x2 oa, ob; oa.x = cvt_pk_bf16(va[j][0], va[j][1]); oa.y = cvt_pk_bf16(va[j][2], va[j][3]); ob.x = cvt_pk_bf16(vb[j][0], vb[j][1]); ob.y = cvt_pk_bf16(vb[j][2], vb[j][3]);
            *(u32x2*)(hb + (size_t)row0 * D_MODEL + 4 * lane + 256 * j) = oa; *(u32x2*)(hb + (size_t)(row0 + 1) * D_MODEL + 4 * lane + 256 * j) = ob; }
#pragma unroll
        for (int p = 0; p < 18; ++p) {
            f32x2 a0 = {0.f, 0.f}, a1 = {0.f, 0.f};
#pragma unroll
            for (int j = 0; j < 4; ++j) { const f32x4 w0 = *(const LAS f32x4*)(Wl + (2 * p) * D_MODEL + 4 * lane + 256 * j), w1 = *(const LAS f32x4*)(Wl + (2 * p + 1) * D_MODEL + 4 * lane + 256 * j);
#pragma unroll
                for (int i = 0; i < 4; ++i) { const f32x2 y = {va[j][i], vb[j][i]}; a0 = a0 + y * w0[i]; a1 = a1 + y * w1[i]; } }
            float ra2[2];
#pragma unroll
            for (int rr = 0; rr < 2; ++rr) {
                auto sw = __builtin_amdgcn_permlane32_swap(__float_as_uint(rr ? a0.y : a0.x), __float_as_uint(rr ? a1.y : a1.x), false, false);
                float v = __uint_as_float(sw[0]) + __uint_as_float(sw[1]);
                v = row16_sum(v); v += __shfl_xor(v, 16); ra2[rr] = v; }
            if ((lane & 31) == 0) { const int ci = 2 * p + (lane >> 5); lgs[ci] = ra2[0]; lgs[40 + ci] = ra2[1]; }
            __builtin_amdgcn_sched_barrier(0);
        }
        asm volatile("s_waitcnt lgkmcnt(0)" ::: "memory");
        if (lane == 0 || lane == 32) {
            const int rr = lane >> 5; LAS float* lg = lgs + rr * 40;
            float gl[4];
#pragma unroll
            for (int jj = 0; jj < 4; ++jj) gl[jj] = lg[jj] + brg[jj];
            int gs = 0; float gmax = gl[0];
#pragma unroll
            for (int jj = 1; jj < 4; ++jj) if (gl[jj] > gmax) { gmax = gl[jj]; gs = jj; }
            float den = 0.f;
#pragma unroll
            for (int jj = 0; jj < 4; ++jj) den += expf(gl[jj] - gmax);
            const float gwt = 1.f / den;
            float el[8];
#pragma unroll
            for (int jj = 0; jj < 8; ++jj) el[jj] = lg[4 + gs * 8 + jj] + bre[gs * 8 + jj];
            int i0 = 0; float v0 = el[0];
#pragma unroll
            for (int jj = 1; jj < 8; ++jj) if (el[jj] > v0) { v0 = el[jj]; i0 = jj; }
            int i1 = -1; float v1 = 0.f;
#pragma unroll
            for (int jj = 0; jj < 8; ++jj) if (jj != i0 && (i1 < 0 || el[jj] > v1)) { v1 = el[jj]; i1 = jj; }
            const float e1 = expf(v1 - v0);
            const float w0 = gwt / (1.f + e1), w1 = gwt * e1 / (1.f + e1);
            const int ea = gs * 8 + i0, eb = gs * 8 + i1;
            const int pa = __hip_atomic_fetch_add(lcnt + ea, 1, __ATOMIC_RELAXED, __HIP_MEMORY_SCOPE_WORKGROUP), pb2 = __hip_atomic_fetch_add(lcnt + eb, 1, __ATOMIC_RELAXED, __HIP_MEMORY_SCOPE_WORKGROUP);
            LAS int* ri = rinfo + ((it * NWAVES + wave) * 2 + rr) * 5;
            ri[0] = ea | (eb << 8); ri[1] = pa; ri[2] = pb2; ri[3] = __float_as_int(w0); ri[4] = __float_as_int(w1);
        }
    }
    __syncthreads();
    if (tid < 32) { const int n = lcnt[tid]; unsigned* cnt = (unsigned*)(ws + WS_CTL) + CW_CNT + cidx * 32; lcnt[32 + tid] = n ? (int)atomicAdd(&cnt[tid], (unsigned)n) : 0; }
    __syncthreads();
    for (int sl = tid; sl < it * NWAVES * 2; sl += 512) {
        const int i2 = sl / (NWAVES * 2), w2 = (sl >> 1) & (NWAVES - 1), rr = sl & 1;
        const int row = ((blockIdx.x * NWAVES + w2) + i2 * NGW) * 2 + rr;
        if (row < NTOK) { const LAS int* ri = rinfo + sl * 5; const int ea = ri[0] & 255, eb = ri[0] >> 8;
            moe[MO_TOK_E + row * 2] = ea; moe[MO_TOK_E + row * 2 + 1] = eb; moe[MO_TOK_POS + row * 2] = lcnt[32 + ea] + ri[1]; moe[MO_TOK_POS + row * 2 + 1] = lcnt[32 + eb] + ri[2];
            moe[MO_TOK_W + row * 2] = ri[3]; moe[MO_TOK_W + row * 2 + 1] = ri[4]; }
    }
}

__device__ __forceinline__ void phase_moe_prep(KP P, int L, LAS unsigned char* lds) {
    int tz = threadIdx.x; asm volatile("" : "+v"(tz));
    const int tid = tz;
    unsigned char* ws = P->ws; int* moe = (int*)(ws + WS_MOE);
    const unsigned* cnt = (const unsigned*)(ws + WS_CTL) + CW_CNT + L * 32;
    LAS int* sb = (LAS int*)lds;
    LAS int* sc = (LAS int*)lds + 64;
    if (tid < 32) sc[tid] = (int)cnt[tid];
    __syncthreads();
    if (tid == 0) { int s = 0; for (int e = 0; e < N_EXPERTS; ++e) { sb[e] = s; s += (sc[e] + 255) / 256 * 256; } sb[N_EXPERTS] = s; }
    __syncthreads();
    const int ntiles = sb[N_EXPERTS] / 256;
    if (blockIdx.x == 0) {
        if (tid == 0) *((unsigned*)(ws + WS_CTL) + CW_NTILES + L) = (unsigned)ntiles;
        for (int T = tid; T < ntiles; T += 512) {
            const int r = T * 256; int e = 0;
            for (int x = 0; x < N_EXPERTS; ++x) if (r >= sb[x] && r < sb[x + 1]) e = x;
            const int nv = sc[e] - (r - sb[e]);
            moe[MO_TILE_E + T] = e; moe[MO_TILE_ROW0 + T] = r; moe[MO_TILE_NV + T] = nv < 256 ? nv : 256;
        }
    }
    for (int a = blockIdx.x * 512 + tid; a < NTOK * 2; a += gridDim.x * 512) {
        const int slot = sb[moe[MO_TOK_E + a]] + moe[MO_TOK_POS + a];
        moe[MO_SLOT_TOK + slot] = a >> 1; moe[MO_TOK_SLOT + a] = slot;
    }
}


namespace mb {
typedef short s16x4 __attribute__((ext_vector_type(4)));
typedef float f32x16 __attribute__((ext_vector_type(16)));
constexpr int SHM_V = 64 * 128 * 2, SHM_K = 64 * 128 * 2, V_OFF = 0, K_OFF = 2 * SHM_V, PRE_OFF = 65536;
constexpr float SCALE = 0.08838834764831845f, LOG2E = 1.4426950408889634f, CC = SCALE * LOG2E, THRX = 8.f * LOG2E;
#define MB_KSWZ(row, colB) ((row) * 256 + ((colB) ^ (((row) & 7) << 4)))
__device__ __forceinline__ int v_st(int k, int c) { const int kk = (k & ~0xC) | ((k & 4) << 1) | ((k & 8) >> 1); return ((kk >> 3) * 4 + (c >> 5)) * 512 + ((kk & 7) * 32 + (c & 31)) * 2; }
__device__ __forceinline__ int v_rd_base(int lane) { return ((lane & 3) << 3) | (((lane >> 2) & 3) << 6) | (((lane >> 4) & 1) << 5) | (((lane >> 5) & 1) << 8); }
constexpr int v_rd_off(int d0, int ks, int half) { return d0 * 512 + ks * 4096 + half * 2048; }
template <int OFF> __device__ __forceinline__ s16x4 tr_read(int vb) { s16x4 r; asm volatile("ds_read_b64_tr_b16 %0, %1 offset:%2" : "=&v"(r) : "v"(vb), "i"(OFF) : "memory"); return r; }
#define MB_SBAR() __builtin_amdgcn_sched_barrier(0)

__device__ __forceinline__ void qkt(f32x16& p0, f32x16& p1, LAS unsigned char* Ks, const bf16x8 (&qr)[8], int r32, int hi) {
    p0 = f32x16{}; p1 = f32x16{};
#pragma unroll
    for (int d0 = 0; d0 < 8; ++d0) { const int cb = (d0 * 16 + hi * 8) * 2;
        const bf16x8 b0 = *(const LAS bf16x8*)(Ks + MB_KSWZ(r32, cb));
        const bf16x8 b1 = *(const LAS bf16x8*)(Ks + MB_KSWZ(32 + r32, cb));
        p0 = __builtin_amdgcn_mfma_f32_32x32x16_bf16(b0, qr[d0], p0, 0, 0, 0);
        p1 = __builtin_amdgcn_mfma_f32_32x32x16_bf16(b1, qr[d0], p1, 0, 0, 0); }
}
__device__ __forceinline__ void partialSM(f32x16& p0, f32x16& p1, float& m_reg, float& mn, float& alpha, float bias2, float tb4, bool own, int lim) {
#pragma unroll
    for (int r = 0; r < 16; ++r) { const float kc = (float)((r & 3) + 8 * (r >> 2));
        p0[r] = fmaf(p0[r], CC, fmaf(bias2, kc, tb4)); p1[r] = fmaf(p1[r], CC, fmaf(bias2, kc + 32.f, tb4)); }
    if (own) {
#pragma unroll
        for (int r = 0; r < 16; ++r) { const int kc = (r & 3) + 8 * (r >> 2); if (kc > lim) p0[r] = -INFINITY; if (kc + 32 > lim) p1[r] = -INFINITY; }
    }
    float pmax = p0[0];
#pragma unroll
    for (int r = 1; r < 16; ++r) pmax = fmaxf(pmax, p0[r]);
#pragma unroll
    for (int r = 0; r < 16; ++r) pmax = fmaxf(pmax, p1[r]);
    { auto rr = __builtin_amdgcn_permlane32_swap(__float_as_uint(pmax), __float_as_uint(pmax), false, false); pmax = fmaxf(__uint_as_float(rr[0]), __uint_as_float(rr[1])); }
    if (__builtin_expect(__all(pmax - m_reg <= THRX), 1)) { mn = m_reg; alpha = 1.f; }
    else { mn = fmaxf(m_reg, pmax); alpha = __builtin_amdgcn_exp2f(m_reg - mn); m_reg = mn; }
#pragma unroll
    for (int r = 0; r < 16; ++r) { p0[r] = p0[r] - mn; p1[r] = p1[r] - mn; }
#pragma unroll
    for (int r = 0; r < 16; ++r) p0[r] = __builtin_amdgcn_exp2f(p0[r]);
}
__device__ __forceinline__ void finishSM(f32x16& p0, f32x16& p1, float alpha, float& l_reg, bf16x8& pa0, bf16x8& pa1, bf16x8& pa2, bf16x8& pa3) {
#pragma unroll
    for (int r = 0; r < 16; ++r) p1[r] = __builtin_amdgcn_exp2f(p1[r]);
    float ps = 0.f;
#pragma unroll
    for (int r = 0; r < 16; ++r) ps += p0[r];
#pragma unroll
    for (int r = 0; r < 16; ++r) ps += p1[r];
    { auto rr = __builtin_amdgcn_permlane32_swap(__float_as_uint(ps), __float_as_uint(ps), false, false); ps = __uint_as_float(rr[0]) + __uint_as_float(rr[1]); }
    l_reg = l_reg * alpha + ps;
#define MB_PK4(P, BASE, OUT) do { unsigned a0 = cvt_pk_bf16(P[BASE + 0], P[BASE + 1]), a1 = cvt_pk_bf16(P[BASE + 2], P[BASE + 3]); \
    unsigned b0 = cvt_pk_bf16(P[BASE + 4], P[BASE + 5]), b1 = cvt_pk_bf16(P[BASE + 6], P[BASE + 7]); \
    auto r0 = __builtin_amdgcn_permlane32_swap(a0, b0, false, false); auto r1 = __builtin_amdgcn_permlane32_swap(a1, b1, false, false); \
    u32x4 w = {r0[0], r1[0], r0[1], r1[1]}; OUT = *reinterpret_cast<bf16x8*>(&w); } while (0)
    MB_PK4(p0, 0, pa0); MB_PK4(p0, 8, pa1); MB_PK4(p1, 0, pa2); MB_PK4(p1, 8, pa3);
#undef MB_PK4
}
template <int D0> __device__ __forceinline__ void pv_one(f32x16& od, int vb, bf16x8 pa0, bf16x8 pa1, bf16x8 pa2, bf16x8 pa3) {
    const s16x4 l0 = tr_read<v_rd_off(D0, 0, 0)>(vb), h0 = tr_read<v_rd_off(D0, 0, 1)>(vb), l1 = tr_read<v_rd_off(D0, 1, 0)>(vb), h1 = tr_read<v_rd_off(D0, 1, 1)>(vb);
    const s16x4 l2 = tr_read<v_rd_off(D0, 2, 0)>(vb), h2 = tr_read<v_rd_off(D0, 2, 1)>(vb), l3 = tr_read<v_rd_off(D0, 3, 0)>(vb), h3 = tr_read<v_rd_off(D0, 3, 1)>(vb);
    asm volatile("s_waitcnt lgkmcnt(0)" ::: "memory"); MB_SBAR();
#define MB_PK(L, H) (bf16x8){L[0], L[1], L[2], L[3], H[0], H[1], H[2], H[3]}
    od = __builtin_amdgcn_mfma_f32_32x32x16_bf16(MB_PK(l0, h0), pa0, od, 0, 0, 0);
    od = __builtin_amdgcn_mfma_f32_32x32x16_bf16(MB_PK(l1, h1), pa1, od, 0, 0, 0);
    od = __builtin_amdgcn_mfma_f32_32x32x16_bf16(MB_PK(l2, h2), pa2, od, 0, 0, 0);
    od = __builtin_amdgcn_mfma_f32_32x32x16_bf16(MB_PK(l3, h3), pa3, od, 0, 0, 0);
#undef MB_PK
}
__device__ __forceinline__ void pv_d0(f32x16 (&o)[4], int vb, bf16x8 pa0, bf16x8 pa1, bf16x8 pa2, bf16x8 pa3) {
    pv_one<0>(o[0], vb, pa0, pa1, pa2, pa3); pv_one<1>(o[1], vb, pa0, pa1, pa2, pa3); pv_one<2>(o[2], vb, pa0, pa1, pa2, pa3); pv_one<3>(o[3], vb, pa0, pa1, pa2, pa3);
}

__device__ __forceinline__ void item(const bf16* __restrict__ q, const bf16* __restrict__ kv, bf16* __restrict__ part_o, float* __restrict__ part_ml, LAS unsigned char* lds,
                                     int tid, int b, int g, int kblk, int NT, bool own, int t, int rh, int slot, bool valid) {
    const int lane = tid & 63, r32 = lane & 31, hi = lane >> 5;
    const int h = g * 4 + rh;
    const bf16* Kh = kv + (size_t)(b * SEQ + kblk * MOBA_BLOCK) * 512 + g * HEAD_DIM;
    float m_reg = -1e30f, l_reg = 0.f; f32x16 o[4] = {}; bf16x8 qr[8];
    { const bf16* Qw = q + (size_t)(b * SEQ + t) * D_MODEL + h * HEAD_DIM + hi * 8;
#pragma unroll
      for (int d0 = 0; d0 < 8; ++d0) qr[d0] = *(const bf16x8*)(Qw + d0 * 16); }
    const float bias2 = __builtin_amdgcn_exp2f(-(float)(h + 1)) * LOG2E;
    const int trel = t - kblk * MOBA_BLOCK;
    const float tb4 = bias2 * (float)(4 * hi - trel);
    const int lim0 = trel - 4 * hi;
    const int sr = tid >> 4, sc = (tid & 15) * 8, vst0 = v_st(sr, sc), vst1 = v_st(32 + sr, sc);
    const int vb0 = (int)(unsigned)(uintptr_t)(lds + V_OFF) + v_rd_base(lane);
    bf16x8 vsA0, vsA1, ksA0, ksA1, vsB0, vsB1, ksB0, ksB1;
    const unsigned vo0 = (unsigned)(sr * 512 + sc) * 2u, vo1 = vo0 + 32u * 1024u;
    const char* KhB = (const char*)Kh;
#define MB_SLOAD_A(k0) do { const char* kt_ = KhB + (size_t)(k0) * 1024; vsA0 = *(const bf16x8*)(kt_ + 512 + vo0); vsA1 = *(const bf16x8*)(kt_ + 512 + vo1); \
        ksA0 = *(const bf16x8*)(kt_ + vo0); ksA1 = *(const bf16x8*)(kt_ + vo1); } while (0)
#define MB_SLOAD_B(k0) do { const char* kt_ = KhB + (size_t)(k0) * 1024; vsB0 = *(const bf16x8*)(kt_ + 512 + vo0); vsB1 = *(const bf16x8*)(kt_ + 512 + vo1); \
        ksB0 = *(const bf16x8*)(kt_ + vo0); ksB1 = *(const bf16x8*)(kt_ + vo1); } while (0)
#define MB_SWRITE(bb, V0, V1, K0, K1) do { *(LAS bf16x8*)(lds + V_OFF + (bb) * SHM_V + vst0) = V0; *(LAS bf16x8*)(lds + V_OFF + (bb) * SHM_V + vst1) = V1; \
        *(LAS bf16x8*)(lds + K_OFF + (bb) * SHM_K + MB_KSWZ(sr, sc * 2)) = K0; *(LAS bf16x8*)(lds + K_OFF + (bb) * SHM_K + MB_KSWZ(32 + sr, sc * 2)) = K1; } while (0)
#define MB_SWAIT() asm volatile("s_waitcnt vmcnt(4)" ::: "memory")
#define MB_RESC(a) do { if (__any((a) < 1.f)) { _Pragma("unroll") for (int d = 0; d < 4; ++d) _Pragma("unroll") for (int r = 0; r < 16; ++r) o[d][r] *= (a); } } while (0)
#define MB_PSM(P0, P1, MN, AL, tile) partialSM(P0, P1, m_reg, MN, AL, bias2, tb4 + bias2 * (float)((tile) * 64), own, lim0 - (tile) * 64)
    f32x16 pA0, pA1, pB0, pB1; float mnA, mnB, alA, alB; bf16x8 pa0, pa1, pa2, pa3;
    MB_SLOAD_A(0); asm volatile("s_waitcnt vmcnt(0)" ::: "memory"); MB_SWRITE(0, vsA0, vsA1, ksA0, ksA1); __syncthreads();
    qkt(pA0, pA1, lds + K_OFF, qr, r32, hi); MB_PSM(pA0, pA1, mnA, alA, 0);
    MB_SLOAD_B(64); if (2 < NT) MB_SLOAD_A(128);
    MB_SWAIT(); MB_SWRITE(1, vsB0, vsB1, ksB0, ksB1); __syncthreads();
    for (int j = 1; j + 1 < NT; j += 2) {
        MB_SBAR(); qkt(pB0, pB1, lds + K_OFF + SHM_K, qr, r32, hi);
        finishSM(pA0, pA1, alA, l_reg, pa0, pa1, pa2, pa3); MB_SBAR();
        MB_SLOAD_B((j + 2) * 64); MB_SBAR();
        pv_d0(o, vb0, pa0, pa1, pa2, pa3); MB_PSM(pB0, pB1, mnB, alB, j);
        __syncthreads(); MB_SWAIT(); MB_SWRITE(0, vsA0, vsA1, ksA0, ksA1);
        MB_RESC(alB); __syncthreads();
        MB_SBAR(); qkt(pA0, pA1, lds + K_OFF, qr, r32, hi);
        finishSM(pB0, pB1, alB, l_reg, pa0, pa1, pa2, pa3); MB_SBAR();
        if (j + 3 < NT) MB_SLOAD_A((j + 3) * 64); MB_SBAR();
        pv_d0(o, vb0 + SHM_V, pa0, pa1, pa2, pa3); MB_PSM(pA0, pA1, mnA, alA, j + 1);
        __syncthreads(); MB_SWAIT(); MB_SWRITE(1, vsB0, vsB1, ksB0, ksB1);
        MB_RESC(alA); __syncthreads();
    }
    MB_SBAR(); qkt(pB0, pB1, lds + K_OFF + SHM_K, qr, r32, hi);
    finishSM(pA0, pA1, alA, l_reg, pa0, pa1, pa2, pa3); MB_SBAR();
    pv_d0(o, vb0, pa0, pa1, pa2, pa3); MB_PSM(pB0, pB1, mnB, alB, NT - 1);
    __syncthreads(); MB_RESC(alB);
    finishSM(pB0, pB1, alB, l_reg, pa0, pa1, pa2, pa3); MB_SBAR();
    pv_d0(o, vb0 + SHM_V, pa0, pa1, pa2, pa3);
    if (valid) {
        const float inv = 1.f / l_reg;
        const size_t rg = ((size_t)(b * SEQ + t) * N_HEADS + h) * 4 + slot;
        bf16* po = part_o + rg * HEAD_DIM + 4 * hi;
#pragma unroll
        for (int d0 = 0; d0 < 4; ++d0)
#pragma unroll
            for (int rq = 0; rq < 4; ++rq) { u32x2 w; w.x = cvt_pk_bf16(o[d0][rq * 4 + 0] * inv, o[d0][rq * 4 + 1] * inv); w.y = cvt_pk_bf16(o[d0][rq * 4 + 2] * inv, o[d0][rq * 4 + 3] * inv);
                *(u32x2*)(po + d0 * 32 + rq * 8) = w; }
        if (hi == 0) { f32x2 ml; ml.x = m_reg; ml.y = l_reg; *(f32x2*)(part_ml + rg * 2) = ml; }
    }
    __syncthreads();
#undef MB_SLOAD_A
#undef MB_SLOAD_B
#undef MB_SWRITE
#undef MB_SWAIT
#undef MB_RESC
#undef MB_PSM
}
}

constexpr size_t WS_SELB = WS_T;
constexpr size_t WS_PML = WS_T + 2 * MiB;
constexpr size_t WS_LISTS = WS_T + 16 * MiB;
constexpr size_t WS_PARTO = WS_SCORES;
constexpr int CW_LCNT = 16384 + 512;

__device__ __forceinline__ void phase_kmeans(KP P) {
    int tz = threadIdx.x; asm volatile("" : "+v"(tz)); const int tid = tz;
    const bf16* kv = (const bf16*)(P->ws + WS_KV); float* km = (float*)(P->ws + WS_KM);
    for (int it = blockIdx.x; it < BATCH * N_KV * N_BLOCKS; it += gridDim.x) {
        const int blk = it % N_BLOCKS, g = (it / N_BLOCKS) % N_KV, b = it / (N_BLOCKS * N_KV);
        if (tid < HEAD_DIM) { float s = 0.f;
            for (int i = 0; i < MOBA_BLOCK; ++i) s += bf2f(kv[(size_t)(b * SEQ + blk * MOBA_BLOCK + i) * 512 + g * HEAD_DIM + tid]);
            const float mval = s * (1.f / MOBA_BLOCK); km[(size_t)it * HEAD_DIM + tid] = mval;
            const unsigned hi16 = cvt_pk_bf16(mval, 0.f) & 0xffffu; const float rem = mval - bflo(hi16);
            bf16* kmh = (bf16*)(km + 65536); kmh[(size_t)it * HEAD_DIM + tid] = (bf16)hi16; kmh[(size_t)(BATCH * N_KV * N_BLOCKS + it) * HEAD_DIM + tid] = (bf16)(cvt_pk_bf16(rem, 0.f) & 0xffffu); }
    }
}
__device__ __forceinline__ void phase_moba_gate(KP P, LAS unsigned char* lds) {
    int tz = threadIdx.x; asm volatile("" : "+v"(tz)); const int tid = tz, lane = tid & 63, wave = tid >> 6;
    const bf16* q = (const bf16*)(P->ws + WS_QKVI); const float* km = (const float*)(P->ws + WS_KM); unsigned char* selb = (unsigned char*)(P->ws + WS_SELB);
    LAS float* qs = (LAS float*)(lds + wave * 2048);
    const int blk = lane & 31, half = lane >> 5;
    for (int it = blockIdx.x * NWAVES + wave; it < NTOK * 2; it += gridDim.x * NWAVES) {
        const int tok = it >> 1, g = it & 1, b = tok / SEQ, t = tok % SEQ, own = t >> 8;
        unsigned char* sb = selb + ((size_t)tok * 8 + g * 4) * 4;
        if (own < 3) { if (lane < 4) { for (int s2 = own; s2 < 3; ++s2) sb[lane * 4 + s2] = 0xFF; } }
        if (own == 0) continue;
        { const u32x4 w = *(const u32x4*)(q + (size_t)tok * D_MODEL + g * 512 + lane * 8);
          LAS float* d = qs + lane * 8;
          d[0] = bflo(w.x); d[1] = bfhi(w.x); d[2] = bflo(w.y); d[3] = bfhi(w.y); d[4] = bflo(w.z); d[5] = bfhi(w.z); d[6] = bflo(w.w); d[7] = bfhi(w.w); }
        asm volatile("s_waitcnt lgkmcnt(0)" ::: "memory");
        float acc[4] = {0.f, 0.f, 0.f, 0.f};
        const float* kp = km + ((size_t)(b * N_KV + g) * N_BLOCKS + blk) * HEAD_DIM + half * 64;
#pragma unroll 4
        for (int i = 0; i < 16; ++i) { const f32x4 kk = *(const f32x4*)(kp + 4 * i);
#pragma unroll
            for (int r = 0; r < 4; ++r) { const f32x4 qq = *(const LAS f32x4*)(qs + r * 128 + half * 64 + 4 * i); acc[r] += (kk[0] * qq[0] + kk[1] * qq[1]) + (kk[2] * qq[2] + kk[3] * qq[3]); } }
#pragma unroll
        for (int r = 0; r < 4; ++r) { acc[r] += __shfl_xor(acc[r], 32); if (blk >= own) acc[r] = -INFINITY; }
        int rank[4] = {0, 0, 0, 0};
#pragma unroll
        for (int j = 0; j < 32; ++j) {
#pragma unroll
            for (int r = 0; r < 4; ++r) { const float vj = __uint_as_float(__builtin_amdgcn_readlane(__float_as_uint(acc[r]), j)); rank[r] += (vj > acc[r] || (vj == acc[r] && j < blk)) ? 1 : 0; }
        }
        if (half == 0 && blk < own) {
#pragma unroll
            for (int r = 0; r < 4; ++r) if (rank[r] < 3) sb[r * 4 + rank[r]] = (unsigned char)blk;
        }
    }
}

__device__ __forceinline__ void phase_moba_gate2(KP P) {
    typedef float f32x16 __attribute__((ext_vector_type(16)));
    int tz = threadIdx.x; asm volatile("" : "+v"(tz)); const int tid = tz, lane = tid & 63, wave = tid >> 6, r32 = lane & 31, hi = lane >> 5;
    const bf16* q = (const bf16*)(P->ws + WS_QKVI); const bf16* kmh = (const bf16*)((const float*)(P->ws + WS_KM) + 65536); unsigned char* selb = (unsigned char*)(P->ws + WS_SELB);
    const int gw = blockIdx.x * NWAVES + wave, NGW = gridDim.x * NWAVES;
    int cur_bg = -1; bf16x8 ah[8], al[8];
    for (int tile = gw * 4; tile < 8192; tile += NGW * 4) {
#pragma unroll 1
        for (int sub = 0; sub < 4; ++sub) {
            const int tl = tile + sub, bg = tl >> 10, b = bg >> 1, g = bg & 1, rt = tl & 1023;
            if (bg != cur_bg) { cur_bg = bg;
                const bf16* kp = kmh + ((size_t)(b * N_KV + g) * N_BLOCKS + r32) * HEAD_DIM + 8 * hi;
#pragma unroll
                for (int ks = 0; ks < 8; ++ks) { ah[ks] = *(const bf16x8*)(kp + 16 * ks); al[ks] = *(const bf16x8*)(kp + (size_t)BATCH * N_KV * N_BLOCKS * HEAD_DIM + 16 * ks); } }
            const int row = rt * 32 + r32, t = row >> 2, rh = row & 3, own = t >> 8, tok = b * SEQ + t;
            const bf16* qp = q + (size_t)tok * D_MODEL + (g * 4 + rh) * HEAD_DIM + 8 * hi;
            f32x16 acc = {};
#pragma unroll
            for (int ks = 0; ks < 8; ++ks) { const bf16x8 qv = *(const bf16x8*)(qp + 16 * ks);
                acc = __builtin_amdgcn_mfma_f32_32x32x16_bf16(ah[ks], qv, acc, 0, 0, 0); acc = __builtin_amdgcn_mfma_f32_32x32x16_bf16(al[ks], qv, acc, 0, 0, 0); }
            float v[16];
#pragma unroll
            for (int r = 0; r < 16; ++r) { const int blk = (r & 3) + 8 * (r >> 2) + 4 * hi; v[r] = (blk < own) ? acc[r] : -INFINITY; }
            float bv[3]; int bi[3];
#pragma unroll
            for (int p = 0; p < 3; ++p) { float best = -INFINITY; int br = -1;
#pragma unroll
                for (int r = 0; r < 16; ++r) { if (v[r] > best) { best = v[r]; br = r; } }
                bv[p] = best; bi[p] = (br < 0) ? 255 : ((br & 3) + 8 * (br >> 2) + 4 * hi);
#pragma unroll
                for (int r = 0; r < 16; ++r) { if (r == br) v[r] = -INFINITY; } }
            float ov[3]; int oi[3];
#pragma unroll
            for (int p = 0; p < 3; ++p) { ov[p] = __shfl_xor(bv[p], 32); oi[p] = __shfl_xor(bi[p], 32); }
            int ia = 0, ib = 0; int res[3];
#pragma unroll
            for (int p = 0; p < 3; ++p) {
                const float va = (ia == 0) ? bv[0] : (ia == 1) ? bv[1] : (ia == 2) ? bv[2] : -INFINITY; const int xa = (ia == 0) ? bi[0] : (ia == 1) ? bi[1] : (ia == 2) ? bi[2] : 255;
                const float vb = (ib == 0) ? ov[0] : (ib == 1) ? ov[1] : (ib == 2) ? ov[2] : -INFINITY; const int xb = (ib == 0) ? oi[0] : (ib == 1) ? oi[1] : (ib == 2) ? oi[2] : 255;
                const bool takeA = (va > vb) || (va == vb && xa < xb);
                const float vv = takeA ? va : vb; const int xx = takeA ? xa : xb;
                res[p] = (vv > -INFINITY) ? xx : 255; if (takeA) ++ia; else ++ib; }
            if (hi == 0) { const unsigned w = (unsigned)res[0] | ((unsigned)res[1] << 8) | ((unsigned)res[2] << 16) | 0xFF000000u;
                *(unsigned*)(selb + ((size_t)tok * 8 + g * 4 + rh) * 4) = w; }
        }
    }
}

__device__ __forceinline__ void phase_moba_lists(KP P, LAS unsigned char* lds) {
    int tz = threadIdx.x; asm volatile("" : "+v"(tz)); const int tid = tz, lane = tid & 63, wave = tid >> 6;
    const u32x4* selb = (const u32x4*)(P->ws + WS_SELB); unsigned* lists = (unsigned*)(P->ws + WS_LISTS); unsigned* lcnt = (unsigned*)(P->ws + WS_CTL) + CW_LCNT;
    LAS int* wtot = (LAS int*)lds;
    for (int li = blockIdx.x; li < 256; li += gridDim.x) {
        const int j = li & 31, g = (li >> 5) & 1, b = li >> 6, base_t = (j + 1) * MOBA_BLOCK, n_t = SEQ - base_t;
        unsigned* out = lists + (size_t)li * 32768;
        int running = 0;
        for (int i0 = 0; i0 < n_t; i0 += 512) {
            const int ti = i0 + tid; const bool ok = ti < n_t; const int t = base_t + ti;
            u32x4 w = {0xFFFFFFFFu, 0xFFFFFFFFu, 0xFFFFFFFFu, 0xFFFFFFFFu};
            if (ok) w = selb[((size_t)(b * SEQ + t) * 8 + g * 4) / 4];
            int ms[4];
#pragma unroll
            for (int r = 0; r < 4; ++r) { const unsigned x = w[r]; ms[r] = ((x & 0xFFu) == (unsigned)j) ? 0 : (((x >> 8) & 0xFFu) == (unsigned)j) ? 1 : (((x >> 16) & 0xFFu) == (unsigned)j) ? 2 : -1; }
            const int c = (ms[0] >= 0) + (ms[1] >= 0) + (ms[2] >= 0) + (ms[3] >= 0);
            int inc = c;
#pragma unroll
            for (int o = 1; o < 64; o <<= 1) { const int v = __shfl_up(inc, o); if (lane >= o) inc += v; }
            __syncthreads();
            if (lane == 63) wtot[wave] = inc;
            __syncthreads();
            int woff = 0, tot = 0;
#pragma unroll
            for (int x = 0; x < NWAVES; ++x) { const int v = wtot[x]; if (x < wave) woff += v; tot += v; }
            int pos = running + woff + inc - c;
#pragma unroll
            for (int r = 0; r < 4; ++r) if (ms[r] >= 0) out[pos++] = (unsigned)t | ((unsigned)r << 13) | ((unsigned)ms[r] << 15);
            running += tot;
        }
        if (tid == 0) lcnt[li] = (unsigned)running;
        __syncthreads();
    }
}
__device__ __forceinline__ void phase_moba_attn(KP P, LAS unsigned char* lds) {
    int tz = threadIdx.x; asm volatile("" : "+v"(tz)); const int tid = tz, lane = tid & 63, wave = tid >> 6;
    const bf16* q = (const bf16*)(P->ws + WS_QKVI); const bf16* kv = (const bf16*)(P->ws + WS_KV);
    bf16* part_o = (bf16*)(P->ws + WS_PARTO); float* part_ml = (float*)(P->ws + WS_PML);
    const unsigned* lists = (const unsigned*)(P->ws + WS_LISTS); const unsigned* lcnt = (const unsigned*)(P->ws + WS_CTL) + CW_LCNT;
    LAS int* pre = (LAS int*)(lds + mb::PRE_OFF);
    LAS int* cn = pre + 260;
    if (tid < 256) cn[tid] = (int)lcnt[tid];
    __syncthreads();
    if (tid == 0) { int s = 0; for (int i = 0; i < 256; ++i) { pre[i] = s; s += (cn[i] + 255) >> 8; } pre[256] = s; }
    __syncthreads();
    const int npast = pre[256], total = npast + 1024;
    for (int it = blockIdx.x; it < total; it += gridDim.x) {
        int b, g, kblk, NT, t, rh, slot; bool own, valid;
        const int ri = wave * 32 + (lane & 31);
        if (it < npast) {
            int lo = 0, hi = 256;
            while (hi - lo > 1) { const int mid = (lo + hi) >> 1; if (pre[mid] <= it) lo = mid; else hi = mid; }
            const int li = lo, chunk = it - pre[li], n = cn[li];
            kblk = li & 31; g = (li >> 5) & 1; b = li >> 6; NT = 4; own = false;
            int idx = chunk * 256 + ri; valid = idx < n; if (!valid) idx = chunk * 256;
            const unsigned e = lists[(size_t)li * 32768 + idx];
            t = (int)(e & 0x1FFFu); rh = (int)((e >> 13) & 3u); slot = (int)((e >> 15) & 3u);
        } else {
            const int oi = it - npast, chunk = oi & 3, bi = oi >> 2;
            kblk = bi & 31; g = (bi >> 5) & 1; b = bi >> 6; NT = chunk < 2 ? 2 : 4; own = true; valid = true;
            t = kblk * MOBA_BLOCK + chunk * 64 + (ri >> 2); rh = ri & 3; slot = 3;
        }
        mb::item(q, kv, part_o, part_ml, lds, tid, b, g, kblk, NT, own, t, rh, slot, valid);
    }
}

namespace mb {
constexpr int SEG_K = 0, SEG_V = 65536, SEG_PRE = 131072, SEGC = 8;
__device__ __forceinline__ void stage_block(const bf16* __restrict__ kv, LAS unsigned char* lds, int tid, int b, int g, int kblk) {
    const char* KhB = (const char*)(kv + (size_t)(b * SEQ + kblk * MOBA_BLOCK) * 512 + g * HEAD_DIM);
    const int sr = tid >> 4, sc = (tid & 15) * 8, vst0 = v_st(sr, sc), vst1 = v_st(32 + sr, sc);
    const unsigned vo0 = (unsigned)(sr * 512 + sc) * 2u, vo1 = vo0 + 32u * 1024u;
#pragma unroll
    for (int h2 = 0; h2 < 2; ++h2) {
        bf16x8 kx[2][2], vx[2][2];
#pragma unroll
        for (int tt = 0; tt < 2; ++tt) { const char* kt_ = KhB + (size_t)((h2 * 2 + tt) * 64) * 1024;
            kx[tt][0] = *(const bf16x8*)(kt_ + vo0); kx[tt][1] = *(const bf16x8*)(kt_ + vo1); vx[tt][0] = *(const bf16x8*)(kt_ + 512 + vo0); vx[tt][1] = *(const bf16x8*)(kt_ + 512 + vo1); }
#pragma unroll
        for (int tt = 0; tt < 2; ++tt) { const int tile = h2 * 2 + tt;
            *(LAS bf16x8*)(lds + SEG_K + tile * SHM_K + MB_KSWZ(sr, sc * 2)) = kx[tt][0]; *(LAS bf16x8*)(lds + SEG_K + tile * SHM_K + MB_KSWZ(32 + sr, sc * 2)) = kx[tt][1];
            *(LAS bf16x8*)(lds + SEG_V + tile * SHM_V + vst0) = vx[tt][0]; *(LAS bf16x8*)(lds + SEG_V + tile * SHM_V + vst1) = vx[tt][1]; }
    }
}
__device__ __forceinline__ void chunk_rows(const bf16* __restrict__ q, bf16* __restrict__ part_o, float* __restrict__ part_ml, LAS unsigned char* lds, int lane,
                                           int b, int g, int kblk, int NT, bool own, int t, int rh, int slot, bool valid) {
    const int r32 = lane & 31, hi = lane >> 5, h = g * 4 + rh;
    float m_reg = -1e30f, l_reg = 0.f; f32x16 o[4] = {}; bf16x8 qr[8];
    { const bf16* Qw = q + (size_t)(b * SEQ + t) * D_MODEL + h * HEAD_DIM + hi * 8;
#pragma unroll
      for (int d0 = 0; d0 < 8; ++d0) qr[d0] = *(const bf16x8*)(Qw + d0 * 16); }
    const float bias2 = __builtin_amdgcn_exp2f(-(float)(h + 1)) * LOG2E;
    const int trel = t - kblk * MOBA_BLOCK;
    const float tb4 = bias2 * (float)(4 * hi - trel);
    const int lim0 = trel - 4 * hi;
    const int vb0 = (int)(unsigned)(uintptr_t)(lds + SEG_V) + v_rd_base(lane);
    for (int tile = 0; tile < NT; ++tile) {
        f32x16 p0, p1; float mn, al; bf16x8 pa0, pa1, pa2, pa3;
        qkt(p0, p1, lds + SEG_K + tile * SHM_K, qr, r32, hi);
        partialSM(p0, p1, m_reg, mn, al, bias2, tb4 + bias2 * (float)(tile * 64), own, lim0 - tile * 64);
        if (__any(al < 1.f)) {
#pragma unroll
            for (int d = 0; d < 4; ++d)
#pragma unroll
                for (int r = 0; r < 16; ++r) o[d][r] *= al; }
        finishSM(p0, p1, al, l_reg, pa0, pa1, pa2, pa3);
        pv_d0(o, vb0 + tile * SHM_V, pa0, pa1, pa2, pa3);
    }
    if (valid) {
        const float inv = 1.f / l_reg;
        const size_t rg = ((size_t)(b * SEQ + t) * N_HEADS + h) * 4 + slot;
        bf16* po = part_o + rg * HEAD_DIM + 4 * hi;
#pragma unroll
        for (int d0 = 0; d0 < 4; ++d0)
#pragma unroll
            for (int rq = 0; rq < 4; ++rq) { u32x2 w; w.x = cvt_pk_bf16(o[d0][rq * 4 + 0] * inv, o[d0][rq * 4 + 1] * inv); w.y = cvt_pk_bf16(o[d0][rq * 4 + 2] * inv, o[d0][rq * 4 + 3] * inv);
                *(u32x2*)(po + d0 * 32 + rq * 8) = w; }
        if (hi == 0) { f32x2 ml; ml.x = m_reg; ml.y = l_reg; *(f32x2*)(part_ml + rg * 2) = ml; }
    }
}
}
constexpr int CW_MQ = 20480;
__device__ __forceinline__ void phase_moba_attn2(KP P, int Lb, LAS unsigned char* lds) {
    int tz = threadIdx.x; asm volatile("" : "+v"(tz)); const int tid = tz, lane = tid & 63, wave = tid >> 6;
    const bf16* q = (const bf16*)(P->ws + WS_QKVI); const bf16* kv = (const bf16*)(P->ws + WS_KV);
    bf16* part_o = (bf16*)(P->ws + WS_PARTO); float* part_ml = (float*)(P->ws + WS_PML);
    const unsigned* lists = (const unsigned*)(P->ws + WS_LISTS); const unsigned* lcnt = (const unsigned*)(P->ws + WS_CTL) + CW_LCNT;
    unsigned* qhead = (unsigned*)(P->ws + WS_CTL) + CW_MQ + Lb * 64;
    LAS int* pre = (LAS int*)(lds + mb::SEG_PRE);
    LAS int* cn = pre + 260;
    LAS int* cur = pre + 520;
    if (tid < 256) cn[tid] = (int)lcnt[tid];
    __syncthreads();
    if (tid == 0) { int s2 = 0; for (int i = 0; i < 256; ++i) { pre[i] = s2; const int nch = (cn[i] + 255) >> 8; s2 += (nch + mb::SEGC - 1) / mb::SEGC; } pre[256] = s2; }
    __syncthreads();
    const int npast = pre[256], total = npast + 256;
    for (;;) {
        if (tid == 0) cur[0] = (int)__hip_atomic_fetch_add(qhead, 1u, __ATOMIC_RELAXED, __HIP_MEMORY_SCOPE_AGENT);
        __syncthreads();
        const int sg = cur[0];
        if (sg >= total) break;
        int b, g, kblk, li = 0, ch0, nch, n = 0; bool own;
        if (sg < npast) {
            int lo = 0, hi2 = 256;
            while (hi2 - lo > 1) { const int mid = (lo + hi2) >> 1; if (pre[mid] <= sg) lo = mid; else hi2 = mid; }
            li = lo; n = cn[li]; ch0 = (sg - pre[li]) * mb::SEGC; const int ncht = (n + 255) >> 8; nch = ncht - ch0 < mb::SEGC ? ncht - ch0 : mb::SEGC;
            kblk = li & 31; g = (li >> 5) & 1; b = li >> 6; own = false;
        } else { const int bi = sg - npast; kblk = bi & 31; g = (bi >> 5) & 1; b = bi >> 6; own = true; ch0 = 0; nch = 4; }
        mb::stage_block(kv, lds, tid, b, g, kblk);
        __syncthreads();
        const int ri = wave * 32 + (lane & 31);
        for (int c = 0; c < nch; ++c) {
            const int chunk = ch0 + c; int t, rh, slot, NT; bool valid;
            if (!own) { int idx = chunk * 256 + ri; valid = idx < n; if (!valid) idx = chunk * 256;
                const unsigned e = lists[(size_t)li * 32768 + idx];
                t = (int)(e & 0x1FFFu); rh = (int)((e >> 13) & 3u); slot = (int)((e >> 15) & 3u); NT = 4;
            } else { valid = true; t = kblk * MOBA_BLOCK + chunk * 64 + (ri >> 2); rh = ri & 3; slot = 3; NT = chunk + 1; }
            mb::chunk_rows(q, part_o, part_ml, lds, lane, b, g, kblk, NT, own, t, rh, slot, valid);
        }
        __syncthreads();
    }
}

__device__ __forceinline__ void phase_moba_combine(KP P) {
    int tz = threadIdx.x; asm volatile("" : "+v"(tz)); const int tid = tz;
    const bf16* part_o = (const bf16*)(P->ws + WS_PARTO); const float* part_ml = (const float*)(P->ws + WS_PML); bf16* attn = (bf16*)(P->ws + WS_ATTN);
    const int sub = tid & 15;
    const int stride = (gridDim.x * 512) >> 4;
    for (int rg0 = (blockIdx.x * 512 + tid) >> 4; rg0 < NTOK * N_HEADS; rg0 += 2 * stride) {
        f32x4 mlv[2][2]; u32x4 pv[2][4]; bool has[2];
#pragma unroll
        for (int u = 0; u < 2; ++u) { const int rg = rg0 + u * stride; has[u] = rg < NTOK * N_HEADS; const int rgc = has[u] ? rg : rg0;
            mlv[u][0] = *(const f32x4*)(part_ml + (size_t)rgc * 8); mlv[u][1] = *(const f32x4*)(part_ml + (size_t)rgc * 8 + 4);
#pragma unroll
            for (int s2 = 0; s2 < 4; ++s2) pv[u][s2] = __builtin_nontemporal_load((const u32x4*)(part_o + ((size_t)rgc * 4 + s2) * HEAD_DIM + sub * 8)); }
#pragma unroll
        for (int u = 0; u < 2; ++u) { const int rg = rg0 + u * stride;
            if (!has[u]) continue;
            const int tok = rg >> 3, own = (tok % SEQ) >> 8, nv = own < 3 ? own : 3;
            const float mm[4] = {mlv[u][0][0], mlv[u][0][2], mlv[u][1][0], mlv[u][1][2]}, ll[4] = {mlv[u][0][1], mlv[u][0][3], mlv[u][1][1], mlv[u][1][3]};
            float m[4], l[4];
#pragma unroll
            for (int s2 = 0; s2 < 4; ++s2) { const bool ok = (s2 == 3) || (s2 < nv); m[s2] = ok ? mm[s2] : -INFINITY; l[s2] = ok ? ll[s2] : 0.f; }
            const float M = fmaxf(fmaxf(m[0], m[1]), fmaxf(m[2], m[3]));
            float w[4], W = 0.f;
#pragma unroll
            for (int s2 = 0; s2 < 4; ++s2) { w[s2] = l[s2] * __builtin_amdgcn_exp2f(m[s2] - M); W += w[s2]; }
            const float inv = 1.f / W;
            float acc[8] = {0.f, 0.f, 0.f, 0.f, 0.f, 0.f, 0.f, 0.f};
#pragma unroll
            for (int s2 = 0; s2 < 4; ++s2) { const bool ok = (s2 == 3) || (s2 < nv); const u32x4 v = pv[u][s2]; const float ws2 = ok ? w[s2] * inv : 0.f;
                if (ok) { acc[0] += ws2 * bflo(v.x); acc[1] += ws2 * bfhi(v.x); acc[2] += ws2 * bflo(v.y); acc[3] += ws2 * bfhi(v.y);
                          acc[4] += ws2 * bflo(v.z); acc[5] += ws2 * bfhi(v.z); acc[6] += ws2 * bflo(v.w); acc[7] += ws2 * bfhi(v.w); } }
            u32x4 o; o.x = cvt_pk_bf16(acc[0], acc[1]); o.y = cvt_pk_bf16(acc[2], acc[3]); o.z = cvt_pk_bf16(acc[4], acc[5]); o.w = cvt_pk_bf16(acc[6], acc[7]);
            *(u32x4*)(attn + (size_t)rg * HEAD_DIM + sub * 8) = o;
        }
    }
}


#ifndef D1_EXP
#define D1_EXP 0
#endif
constexpr int D1_QS = 4100, D1_SM = 32 * D1_QS, D1_SELIDX = D1_SM + 1024, D1_NT = 992;
__device__ __forceinline__ unsigned fkey2(float f) { const unsigned u = __float_as_uint(f); return (u & 0x80000000u) ? ~u : (u | 0x80000000u); }
template <int PASS, int EXP>
__device__ __forceinline__ void d1_scan(const bf16* __restrict__ ikb, int qt, int kt_end, int tid_in, const bf16x8 (&qb)[4][4], const float (&wv)[4], LAS unsigned char* lds, unsigned thr, float c0 = 0.f, unsigned bstar = 0) {
    typedef float f32x16 __attribute__((ext_vector_type(16)));
    int t2_ = tid_in; asm volatile("" : "+v"(t2_));
    const int lane = t2_ & 63, wave = __builtin_amdgcn_readfirstlane(t2_ >> 6), r32 = lane & 31, hi = lane >> 5;
    LAS unsigned* hq = (LAS unsigned*)(lds + r32 * D1_QS);
    LAS unsigned* sm = (LAS unsigned*)(lds + D1_SM);
    typedef float f32x2v __attribute__((ext_vector_type(2)));
    f32x2v w2[4];
#pragma unroll
    for (int h = 0; h < 4; ++h) w2[h] = (f32x2v){wv[h], wv[h]};
    bf16x8 ka[4];
    int kt = wave;
    if (kt <= kt_end) { const bf16* kp = ikb + (size_t)(kt * 32 + r32) * QLD + 8 * hi;
#pragma unroll
        for (int ks = 0; ks < 4; ++ks) ka[ks] = *(const bf16x8*)(kp + 16 * ks); }
    for (; kt <= kt_end; kt += 8) {
        bf16x8 kn[4];
#pragma unroll
        for (int ks = 0; ks < 4; ++ks) kn[ks] = ka[ks];
        if (kt + 8 <= kt_end) { const bf16* kp = ikb + (size_t)((kt + 8) * 32 + r32) * QLD + 8 * hi;
#pragma unroll
            for (int ks = 0; ks < 4; ++ks) kn[ks] = *(const bf16x8*)(kp + 16 * ks); }
        f32x2v s2[8];
#pragma unroll
        for (int j = 0; j < 8; ++j) s2[j] = (f32x2v){c0, c0};
#pragma unroll
        for (int h = 0; h < 4; ++h) { f32x16 acc = {};
#pragma unroll
            for (int ks = 0; ks < 4; ++ks) acc = __builtin_amdgcn_mfma_f32_32x32x16_bf16(ka[ks], qb[h][ks], acc, 0, 0, 0);
#pragma unroll
            for (int j = 0; j < 8; ++j) { const int a0 = __float_as_int(acc[2 * j]), a1 = __float_as_int(acc[2 * j + 1]);
                const f32x2v rl = {__int_as_float(a0 > 0 ? a0 : 0), __int_as_float(a1 > 0 ? a1 : 0)};
                asm("v_pk_fma_f32 %0, %1, %2, %0" : "+v"(s2[j]) : "v"(w2[h]), "v"(rl)); } }
        float sc[16];
#pragma unroll
        for (int r = 0; r < 16; ++r) sc[r] = s2[r >> 1][r & 1];
        int kbase = kt * 32 + 4 * hi; asm volatile("" : "+v"(kbase));
        const int lim = (kt == qt) ? (r32 - 4 * hi) : 64;
        if constexpr (PASS == 4 || PASS == 5) {
            if (kt == qt) {
#pragma unroll
                for (int r = 0; r < 16; ++r) { const int kc = (r & 3) + 8 * (r >> 2); if (kc > lim) sc[r] = -INFINITY; } }
        }
        if constexpr (PASS == 4) {
#pragma unroll
            for (int r = 0; r < 16; ++r) { int bi; asm("v_cvt_flr_i32_f32 %0, %1" : "=v"(bi) : "v"(sc[r])); bi = bi < -1 ? -1 : bi; bi = bi > 1023 ? 1023 : bi;
                (void)__hip_atomic_fetch_add(hq + 1 + bi, 1u, __ATOMIC_RELAXED, __HIP_MEMORY_SCOPE_WORKGROUP); }
        } else if constexpr (PASS == 5) {
            unsigned msel = 0u, mcand = 0u; const int bsi = (int)bstar;
#pragma unroll
            for (int r = 15; r >= 0; --r) { int bi; asm("v_cvt_flr_i32_f32 %0, %1" : "=v"(bi) : "v"(sc[r]));
                asm("v_cmp_gt_i32 vcc, %1, %2\n\tv_addc_co_u32 %0, vcc, %0, %0, vcc" : "+v"(msel) : "v"(bi), "v"(bsi) : "vcc");
                asm("v_cmp_eq_i32 vcc, %1, %2\n\tv_addc_co_u32 %0, vcc, %0, %0, vcc" : "+v"(mcand) : "v"(bi), "v"(bsi) : "vcc"); }
            unsigned mzero = 0u;
            if (__any(mcand != 0u)) {
#pragma unroll
                for (int r = 0; r < 16; ++r) { if ((mcand >> r) & 1u) { const int kc = (r & 3) + 8 * (r >> 2); const unsigned key5 = fkey2(sc[r] - c0); const unsigned sidx = (unsigned)(kbase + kc);
                    if (key5 == 0x80000000u) mzero |= 1u << r;
                    else { const unsigned cp = __hip_atomic_fetch_add(sm + 160 + r32, 1u, __ATOMIC_RELAXED, __HIP_MEMORY_SCOPE_WORKGROUP); if (cp < 256u) { hq[cp] = key5; ((LAS unsigned short*)(hq + 256))[cp] = (unsigned short)sidx; } } } }
            }
            unsigned w = ((msel & 0xFu) | ((msel & 0xF0u) << 4) | ((msel & 0xF00u) << 8) | ((msel & 0xF000u) << 12)) << (4 * hi);
            unsigned z = ((mzero & 0xFu) | ((mzero & 0xF0u) << 4) | ((mzero & 0xF00u) << 8) | ((mzero & 0xF000u) << 12)) << (4 * hi);
            w |= (unsigned)__shfl_xor((int)w, 32); z |= (unsigned)__shfl_xor((int)z, 32);
            if (hi == 0) { hq[512 + kt] = w; hq[768 + kt] = z; }
        } else {
#pragma unroll
        for (int r = 0; r < 16; ++r) {
            const int kc = (r & 3) + 8 * (r >> 2);
            const bool valid = kc <= lim;
            const unsigned key = fkey2(sc[r]);
            if (PASS == 1) { if (EXP == 3) { if (key == 12345u) hq[0] = 1u; } else if (valid && EXP != 2) { const unsigned bin = key >> 21; (void)__hip_atomic_fetch_add(hq + (bin >> 1), 1u << (16 * (bin & 1)), __ATOMIC_RELAXED, __HIP_MEMORY_SCOPE_WORKGROUP); } }
            else if (PASS == 2) { if (valid && (key >> 21) == thr) { const unsigned bin = (key >> 10) & 2047u; (void)__hip_atomic_fetch_add(hq + (bin >> 1), 1u << (16 * (bin & 1)), __ATOMIC_RELAXED, __HIP_MEMORY_SCOPE_WORKGROUP); } }
            else { if (valid) { const unsigned p22 = key >> 10; const unsigned sidx = (unsigned)(kbase + kc);
                    if (p22 > thr) (void)__hip_atomic_fetch_or(hq + 512 + (sidx >> 5), 1u << (sidx & 31u), __ATOMIC_RELAXED, __HIP_MEMORY_SCOPE_WORKGROUP);
                    else if (p22 == thr) {
                        if (key == 0x80000000u) (void)__hip_atomic_fetch_or(hq + 768 + (sidx >> 5), 1u << (sidx & 31u), __ATOMIC_RELAXED, __HIP_MEMORY_SCOPE_WORKGROUP);
                        else { const unsigned cp = __hip_atomic_fetch_add(sm + 160 + r32, 1u, __ATOMIC_RELAXED, __HIP_MEMORY_SCOPE_WORKGROUP); if (cp < 256u) { hq[cp] = key; ((LAS unsigned short*)(hq + 256))[cp] = (unsigned short)sidx; } } } } }
        }
        }
#pragma unroll
        for (int ks = 0; ks < 4; ++ks) ka[ks] = kn[ks];
    }
}
__device__ __forceinline__ bool d1_find(LAS unsigned* H, unsigned need, int lane, unsigned& bin_out, unsigned& above_out) {
    unsigned mine = 0;
#pragma unroll
    for (int i = 0; i < 16; ++i) { const unsigned w = H[lane * 16 + i]; mine += (w & 0xFFFFu) + (w >> 16); }
    const unsigned pre = wave_scan_incl(mine);
    const unsigned total = (unsigned)__builtin_amdgcn_readlane((int)pre, 63);
    const unsigned above = total - pre, inc = above + mine;
    const bool found = (above < need) && (inc >= need);
    const unsigned long long bal = __ballot(found); const int src = bal ? (__ffsll((long long)bal) - 1) : 0;
    const unsigned ab0 = (unsigned)__builtin_amdgcn_readlane((int)above, src);
    unsigned cj = 0;
    if (lane < 32) { const int bidx = src * 32 + 31 - lane; const unsigned w = H[bidx >> 1]; cj = (bidx & 1) ? (w >> 16) : (w & 0xFFFFu); }
    const unsigned inc2 = wave_scan_incl(cj);
    const bool hit = (lane < 32) && (ab0 + inc2 >= need) && (ab0 + inc2 - cj < need);
    const unsigned long long bal2 = __ballot(hit); const int l2 = bal2 ? (__ffsll((long long)bal2) - 1) : 0;
    bin_out = (unsigned)(src * 32 + 31 - l2); above_out = ab0 + (unsigned)__builtin_amdgcn_readlane((int)(inc2 - cj), l2);
    return bal != 0ull;
}
__device__ __forceinline__ bool d1_find32(LAS unsigned* H, unsigned need, int lane, unsigned& bin_out, unsigned& above_out) {
    unsigned mine = 0;
#pragma unroll
    for (int i = 0; i < 16; ++i) mine += H[1 + lane * 16 + i];
    const unsigned pre = wave_scan_incl(mine);
    const unsigned total = (unsigned)__builtin_amdgcn_readlane((int)pre, 63);
    const unsigned above = total - pre, inc = above + mine;
    const bool found = (above < need) && (inc >= need);
    const unsigned long long bal = __ballot(found); const int src = bal ? (__ffsll((long long)bal) - 1) : 0;
    const unsigned ab0 = (unsigned)__builtin_amdgcn_readlane((int)above, src);
    unsigned cj = 0;
    if (lane < 16) cj = H[1 + src * 16 + 15 - lane];
    const unsigned inc2 = wave_scan_incl(cj);
    const bool hit = (lane < 16) && (ab0 + inc2 >= need) && (ab0 + inc2 - cj < need);
    const unsigned long long bal2 = __ballot(hit); const int l2 = bal2 ? (__ffsll((long long)bal2) - 1) : 0;
    bin_out = (unsigned)(src * 16 + 15 - l2); above_out = ab0 + (unsigned)__builtin_amdgcn_readlane((int)(inc2 - cj), l2);
    return bal != 0ull;
}
#define D1_FRESH(l, w) int l, w; { int t_ = tid; asm volatile("" : "+v"(t_)); l = t_ & 63; w = __builtin_amdgcn_readfirstlane(t_ >> 6); }
template <int EXP>
__device__ __forceinline__ void phase_dsa_topk(KP P, LAS unsigned char* lds, size_t sel_off) {
    int tz = threadIdx.x; asm volatile("" : "+v"(tz)); int tid = tz, r32 = tid & 31, hi = (tid >> 5) & 1;
#define D1_REFRESH() { asm volatile("" : "+v"(tid)); r32 = tid & 31; hi = (tid >> 5) & 1; }
    const bf16* qkvi = (const bf16*)(P->ws + WS_QKVI); const float* iw = (const float*)(P->ws + WS_IW); int* sel = (int*)(P->ws + sel_off);
    LAS unsigned* sm = (LAS unsigned*)(lds + D1_SM);
    const int G = gridDim.x, nrounds = (D1_NT + G - 1) / G;
    for (int rho = 0; rho < nrounds; ++rho) {
        const int pos = (rho & 1) ? (G - 1 - (int)blockIdx.x) : (int)blockIdx.x, i = rho * G + pos;
        if (i >= D1_NT) continue;
        D1_REFRESH()
        const int qt = 255 - (i >> 2), b = i & 3, t0 = qt * 32, tok0 = b * SEQ + t0;
        for (int w = tid; w < (D1_SM + 1024) / 4; w += 512) ((LAS unsigned*)lds)[w] = 0u;
        bf16x8 qb[4][4]; float wv[4];
        { const bf16* qp = qkvi + (size_t)(tok0 + r32) * QLD + COL_IQ + 8 * hi;
#pragma unroll
          for (int h = 0; h < 4; ++h)
#pragma unroll
              for (int ks = 0; ks < 4; ++ks) qb[h][ks] = *(const bf16x8*)(qp + h * IDX_DIM + 16 * ks);
          const f32x4 w4 = *(const f32x4*)(iw + (size_t)(tok0 + r32) * 4); wv[0] = w4[0]; wv[1] = w4[1]; wv[2] = w4[2]; wv[3] = w4[3]; }
        const bf16* ikb = qkvi + (size_t)b * SEQ * QLD + COL_IK;
        __syncthreads(); D1_REFRESH()
        d1_scan<1, EXP>(ikb, qt, 7, tid, qb, wv, lds, 0u);
        __syncthreads(); D1_REFRESH()
#pragma unroll 1
        for (int qq = 0; qq < 4; ++qq) { D1_FRESH(lane, wave) const int q = wave * 4 + qq; const unsigned n = (unsigned)(t0 + q + 1); unsigned klo = 196608u / n; klo = klo > 256u ? 256u : (klo < 1u ? 1u : klo);
            unsigned bs, ab, bmx, ab2; const bool ok1 = d1_find((LAS unsigned*)(lds + q * D1_QS), klo, lane, bs, ab), ok2 = d1_find((LAS unsigned*)(lds + q * D1_QS), 1u, lane, bmx, ab2);
            if (lane == 0) { const unsigned klo_key = bs << 21, khi_key = (bmx + 1u) << 21;
                const float lo = __uint_as_float((klo_key & 0x80000000u) ? (klo_key & 0x7FFFFFFFu) : ~klo_key), hi2 = __uint_as_float((khi_key & 0x80000000u) ? (khi_key & 0x7FFFFFFFu) : ~khi_key);
                const float span = (hi2 - lo) * 1.5f; const bool good = ok1 && ok2 && bmx < 2046u && span > 0.f && span < 3.0e38f;
                sm[q] = __float_as_uint(lo); sm[32 + q] = __float_as_uint(good ? fminf(1023.f / span, 1.0e30f) : 0.f); if (!good) sm[224] = 1u; } }
        __syncthreads(); D1_REFRESH()
        if constexpr (EXP == 20) continue;
        for (int w = tid; w < D1_SM / 4; w += 512) ((LAS unsigned*)lds)[w] = 0u;
        float c0;
        { const float f_lo = __uint_as_float(sm[r32]), f_inv = __uint_as_float(sm[32 + r32]); c0 = -f_lo * f_inv;
#pragma unroll
          for (int h = 0; h < 4; ++h) wv[h] *= f_inv; }
        __syncthreads(); D1_REFRESH()
        d1_scan<4, EXP>(ikb, qt, qt, tid, qb, wv, lds, 0u, c0);
        __syncthreads(); D1_REFRESH()
        if constexpr (EXP == 21) continue;
#pragma unroll 1
        for (int qq = 0; qq < 4; ++qq) { D1_FRESH(lane, wave) const int q = wave * 4 + qq; unsigned bin, ab; const bool ok = d1_find32((LAS unsigned*)(lds + q * D1_QS), 256u, lane, bin, ab);
            if (lane == 0) { sm[64 + q] = bin; sm[96 + q] = 256u - ab; if (!ok || bin == 1023u) sm[224] = 1u; } }
        __syncthreads(); D1_REFRESH()
        for (int w = tid; w < D1_SM / 4; w += 512) ((LAS unsigned*)lds)[w] = 0u;
#ifndef D1_FORCE_FB
#define D1_FORCE_FB 0
#endif
        const unsigned f_bs = sm[64 + r32]; bool fast_ok = (sm[224] == 0u) && !D1_FORCE_FB;
        __syncthreads(); D1_REFRESH()
        if constexpr (EXP == 22) continue;
        if (fast_ok) {
            d1_scan<5, EXP>(ikb, qt, qt, tid, qb, wv, lds, 0u, c0, f_bs);
            __syncthreads(); D1_REFRESH()
            if (tid < 32 && sm[160 + tid] > 256u) sm[224] = 1u;
            __syncthreads(); D1_REFRESH()
            fast_ok = (sm[224] == 0u);
            __syncthreads(); D1_REFRESH()
        }
        if constexpr (EXP == 23) continue;
        if (!fast_ok) {
        { const f32x4 w4 = *(const f32x4*)(iw + (size_t)(tok0 + r32) * 4); wv[0] = w4[0]; wv[1] = w4[1]; wv[2] = w4[2]; wv[3] = w4[3]; }
        for (int w = tid; w < (D1_SM + 1024) / 4; w += 512) ((LAS unsigned*)lds)[w] = 0u;
        __syncthreads(); D1_REFRESH()
        d1_scan<1, EXP>(ikb, qt, qt, tid, qb, wv, lds, 0u);
        __syncthreads(); D1_REFRESH()
#pragma unroll 1
        for (int qq = 0; qq < 4; ++qq) { D1_FRESH(lane, wave) const int q = wave * 4 + qq; unsigned bin, ab; d1_find((LAS unsigned*)(lds + q * D1_QS), 256u, lane, bin, ab); if (lane == 0) { sm[q] = bin; sm[32 + q] = ab; } }
        __syncthreads(); D1_REFRESH()
        for (int w = tid; w < D1_SM / 4; w += 512) ((LAS unsigned*)lds)[w] = 0u;
        const unsigned b1 = sm[r32];
        __syncthreads(); D1_REFRESH()
        d1_scan<2, EXP>(ikb, qt, qt, tid, qb, wv, lds, b1);
        __syncthreads(); D1_REFRESH()
#pragma unroll 1
        for (int qq = 0; qq < 4; ++qq) { D1_FRESH(lane, wave) const int q = wave * 4 + qq; const unsigned need2 = 256u - sm[32 + q]; unsigned bin, ab; d1_find((LAS unsigned*)(lds + q * D1_QS), need2, lane, bin, ab);
            if (lane == 0) { sm[64 + q] = (sm[q] << 11) | bin; sm[96 + q] = need2 - ab; } }
        __syncthreads(); D1_REFRESH()
        for (int w = tid; w < D1_SM / 4; w += 512) ((LAS unsigned*)lds)[w] = 0u;
        const unsigned T22 = sm[64 + r32];
        __syncthreads(); D1_REFRESH()
        d1_scan<3, EXP>(ikb, qt, qt, tid, qb, wv, lds, T22);
        __syncthreads(); D1_REFRESH()
        }
#pragma unroll 1
        for (int qq = 0; qq < 4; ++qq) { D1_FRESH(lane, wave) const int q = wave * 4 + qq;
            const unsigned cc = sm[160 + q] < 256u ? sm[160 + q] : 256u, need3 = sm[96 + q];
            LAS unsigned* cand = (LAS unsigned*)(lds + q * D1_QS); LAS unsigned short* cidx = (LAS unsigned short*)(cand + 256); LAS unsigned* bm = cand + 512; LAS unsigned* tb = cand + 768;
            unsigned tw[4]; int cz = 0;
#pragma unroll
            for (int w = 0; w < 4; ++w) { tw[w] = tb[lane * 4 + w]; cz += __popc(tw[w]); }
            int incz = cz;
#pragma unroll
            for (int o = 1; o < 64; o <<= 1) { const int v = __shfl_up(incz, o); if (lane >= o) incz += v; }
            const int cztot = __shfl(incz, 63);
            int npos = 0;
            for (unsigned ci = lane; ci < ((cc + 63u) & ~63u); ci += 64) { const bool act = ci < cc; const unsigned mine = act ? cand[ci] : 0u; const unsigned mi = act ? (unsigned)cidx[ci] : 0u;
                npos += __popcll(__ballot(act && mine > 0x80000000u));
                unsigned rank = (mine < 0x80000000u) ? (unsigned)cztot : 0u;
                for (unsigned j = 0; j < cc; ++j) { const unsigned kj = cand[j]; const unsigned ij = (unsigned)cidx[j]; rank += (kj > mine || (kj == mine && ij < mi)) ? 1u : 0u; }
                if (act && rank < need3) (void)__hip_atomic_fetch_or(bm + (mi >> 5), 1u << (mi & 31u), __ATOMIC_RELAXED, __HIP_MEMORY_SCOPE_WORKGROUP); }
            { int need_z = (int)need3 - npos; need_z = need_z < 0 ? 0 : (need_z > cztot ? cztot : need_z);
              if (need_z > 0) { int pre = incz - cz;
#pragma unroll
                for (int w = 0; w < 4; ++w) { unsigned bits = tw[w]; const int pc = __popc(bits); int k = need_z - pre; k = k < 0 ? 0 : (k > pc ? pc : k);
                    unsigned keep = 0u; for (int x = 0; x < k; ++x) { const unsigned low = bits & (0u - bits); keep |= low; bits ^= low; }
                    if (keep) (void)__hip_atomic_fetch_or(bm + lane * 4 + w, keep, __ATOMIC_RELAXED, __HIP_MEMORY_SCOPE_WORKGROUP);
                    pre += pc; } } }
            asm volatile("s_waitcnt lgkmcnt(0)" ::: "memory");
            unsigned wds[4]; int c = 0;
#pragma unroll
            for (int w = 0; w < 4; ++w) { wds[w] = bm[lane * 4 + w]; c += __popc(wds[w]); }
            int inc = c;
#pragma unroll
            for (int o = 1; o < 64; o <<= 1) { const int v = __shfl_up(inc, o); if (lane >= o) inc += v; }
            const int total = __shfl(inc, 63); int off = inc - c;
            int* op = sel + (size_t)(tok0 + q) * TOPK;
            if (EXP != 7)
#pragma unroll
            for (int w = 0; w < 4; ++w) { unsigned bits = wds[w]; const int kb = lane * 128 + w * 32;
                while (bits) { const int k = __ffs((int)bits) - 1; if (off < TOPK) op[off] = kb + k; ++off; bits &= bits - 1u; } }
            for (int j = total + lane; j < TOPK; j += 64) op[j] = t0 + q;
        }
        __syncthreads(); D1_REFRESH()
    }
}

constexpr int CW_DQ = 16384 + 1024;
__device__ __forceinline__ void phase_dsa_attn(KP P, int L, LAS unsigned char* lds) {
    int tz = threadIdx.x; asm volatile("" : "+v"(tz)); const int tid = tz, lane = tid & 63, wave = tid >> 6;
    const bf16* qkvi = (const bf16*)(P->ws + WS_QKVI); const int* sel = (const int*)(P->ws + WS_SEL); bf16* attn = (bf16*)(P->ws + WS_ATTN);
    unsigned* qh = (unsigned*)(P->ws + WS_CTL) + CW_DQ + L * 8 * 64;
    LAS unsigned* idxs = (LAS unsigned*)(lds + wave * 8192);
    LAS float* pl = (LAS float*)(lds + wave * 8192 + 1024);
    LAS int* wq = (LAS int*)(lds + 65536 + wave * 16);
    const int r = lane & 3, ts_l = (lane & 15) >> 2, kq = lane >> 4, c16 = lane & 15;
    const unsigned myq = xb_xcc_id() & 7u;
    constexpr float CC = 0.08838834764831845f * 1.4426950408889634f;
    for (int qi = 0; qi < 8; ++qi) {
        const int qx = (int)((myq + (unsigned)qi) & 7u), b = qx >> 1, g = qx & 1;
        for (;;) {
            int item = 0;
            if (lane == 0) item = (int)__hip_atomic_fetch_add(qh + qx * 64, 1u, __ATOMIC_RELAXED, __HIP_MEMORY_SCOPE_AGENT);
            item = __builtin_amdgcn_readfirstlane(item);
            if (item >= SEQ) break;
            const int t = SEQ - 1 - item, tok = b * SEQ + t, cnt = (t + 1 < TOPK) ? (t + 1) : TOPK;
#pragma unroll
            for (int i = 0; i < 4; ++i) { const int j = lane + 64 * i; int sidx = 0; if (j < cnt) sidx = (t < TOPK) ? j : sel[(size_t)tok * TOPK + j]; idxs[j] = (unsigned)sidx; }
            asm volatile("s_waitcnt lgkmcnt(0)" ::: "memory");
            bf16x8 qm[4][4];
            { const bf16* qp = qkvi + (size_t)tok * QLD + (g * 4 + r) * HEAD_DIM + 8 * kq;
#pragma unroll
              for (int ks = 0; ks < 4; ++ks) { const bf16x8 v = *(const bf16x8*)(qp + 32 * ks);
#pragma unroll
                  for (int ts = 0; ts < 4; ++ts) qm[ts][ks] = (ts_l == ts) ? v : (bf16x8){0, 0, 0, 0, 0, 0, 0, 0}; } }
            f32x4 C[4];
            const bf16* kbase = qkvi + (size_t)b * SEQ * QLD + COL_K + g * HEAD_DIM + 8 * kq;
#pragma unroll
            for (int c = 0; c < 4; ++c) {
                C[c] = (f32x4){0.f, 0.f, 0.f, 0.f};
                bf16x8 a[4][4];
#pragma unroll
                for (int ts = 0; ts < 4; ++ts) { const unsigned sk = idxs[(4 * c + ts) * 16 + c16]; const bf16* kp = kbase + (size_t)sk * QLD;
#pragma unroll
                    for (int ks = 0; ks < 4; ++ks) a[ts][ks] = *(const bf16x8*)(kp + 32 * ks); }
#pragma unroll
                for (int ts = 0; ts < 4; ++ts)
#pragma unroll
                    for (int ks = 0; ks < 4; ++ks) C[c] = __builtin_amdgcn_mfma_f32_16x16x32_bf16(a[ts][ks], qm[ts][ks], C[c], 0, 0, 0);
            }
            const float bias2 = __builtin_amdgcn_exp2f(-(float)(g * 4 + r + 1)) * 1.4426950408889634f;
            float x[16]; float m = -INFINITY;
#pragma unroll
            for (int c = 0; c < 4; ++c) { const int k0 = (4 * c + ts_l) * 16 + 4 * kq; const u32x4 sp = *(const LAS u32x4*)(idxs + k0);
#pragma unroll
                for (int j = 0; j < 4; ++j) { const float v = (k0 + j < cnt) ? fmaf(C[c][j], CC, bias2 * (float)((int)sp[j] - t)) : -INFINITY; x[c * 4 + j] = v; m = fmaxf(m, v); } }
            m = fmaxf(m, __shfl_xor(m, 4)); m = fmaxf(m, __shfl_xor(m, 8)); m = fmaxf(m, __shfl_xor(m, 16)); m = fmaxf(m, __shfl_xor(m, 32));
            float sum = 0.f;
#pragma unroll
            for (int i = 0; i < 16; ++i) { x[i] = __builtin_amdgcn_exp2f(x[i] - m); sum += x[i]; }
            sum += __shfl_xor(sum, 4); sum += __shfl_xor(sum, 8); sum += __shfl_xor(sum, 16); sum += __shfl_xor(sum, 32);
            const float inv = 1.f / sum;
#pragma unroll
            for (int c = 0; c < 4; ++c) { const int k0 = (4 * c + ts_l) * 16 + 4 * kq;
#pragma unroll
                for (int j = 0; j < 4; ++j) pl[(k0 + j) * 4 + r] = x[c * 4 + j] * inv; }
            asm volatile("s_waitcnt lgkmcnt(0)" ::: "memory");
            float acc[4][8];
#pragma unroll
            for (int rr = 0; rr < 4; ++rr)
#pragma unroll
                for (int i = 0; i < 8; ++i) acc[rr][i] = 0.f;
            const bf16* vbase = qkvi + (size_t)b * SEQ * QLD + COL_V + g * HEAD_DIM + 8 * c16;
            const int nk4 = (cnt + 3) >> 2;
#pragma unroll 4
            for (int j4 = 0; j4 < nk4; ++j4) {
                const int key = 4 * j4 + kq; const unsigned sk = idxs[key];
                const u32x4 vv = *(const u32x4*)(vbase + (size_t)sk * QLD);
                const f32x4 pp = *(const LAS f32x4*)(pl + key * 4);
                const float vf[8] = {bflo(vv.x), bfhi(vv.x), bflo(vv.y), bfhi(vv.y), bflo(vv.z), bfhi(vv.z), bflo(vv.w), bfhi(vv.w)};
#pragma unroll
                for (int rr = 0; rr < 4; ++rr)
#pragma unroll
                    for (int i = 0; i < 8; ++i) acc[rr][i] = fmaf(pp[rr], vf[i], acc[rr][i]);
            }
#pragma unroll
            for (int rr = 0; rr < 4; ++rr)
#pragma unroll
                for (int i = 0; i < 8; ++i) { float v = acc[rr][i]; v += __shfl_xor(v, 16); v += __shfl_xor(v, 32); acc[rr][i] = v; }
            if (kq == 0) {
#pragma unroll
                for (int rr = 0; rr < 4; ++rr) { u32x4 o; o.x = cvt_pk_bf16(acc[rr][0], acc[rr][1]); o.y = cvt_pk_bf16(acc[rr][2], acc[rr][3]); o.z = cvt_pk_bf16(acc[rr][4], acc[rr][5]); o.w = cvt_pk_bf16(acc[rr][6], acc[rr][7]);
                    *(u32x4*)(attn + (size_t)tok * D_MODEL + (g * 4 + rr) * HEAD_DIM + 8 * c16) = o; }
            }
        }
    }
    (void)wq;
}


__device__ __forceinline__ int d2_swz(int i) { return ((i & 3) << 2) | ((i >> 2) & 3); }
__device__ __forceinline__ void phase_dsa_attn2(KP P, int L, LAS unsigned char* lds) {
    typedef short s16x4 __attribute__((ext_vector_type(4)));
    int tz = threadIdx.x; asm volatile("" : "+v"(tz)); const int tid = tz, lane = tid & 63, wave = __builtin_amdgcn_readfirstlane(tid >> 6);
    const bf16* qkvi = (const bf16*)(P->ws + WS_QKVI); const int* sel = (const int*)(P->ws + WS_SEL); bf16* attn = (bf16*)(P->ws + WS_ATTN);
    unsigned* qh = (unsigned*)(P->ws + WS_CTL) + CW_DQ + L * 8 * 64;
    LAS unsigned char* wl = lds + wave * 19456;
    LAS unsigned* idxs = (LAS unsigned*)wl;
    LAS unsigned char* pb = wl + 1024;
    LAS unsigned char* ring = wl + 3072;
    const int n16 = lane & 15, r = lane & 3, ts_l = n16 >> 2, kq = lane >> 4;
    const unsigned myq = xb_xcc_id() & 7u;
    constexpr float CC = 0.08838834764831845f * 1.4426950408889634f;
    unsigned dch[4];
#pragma unroll
    for (int j = 0; j < 4; ++j) dch[j] = (unsigned)((n16 ^ d2_swz(4 * j + kq)) * 16);
    unsigned aoff[4];
#pragma unroll
    for (int ks = 0; ks < 4; ++ks) aoff[ks] = (unsigned)(n16 * 256 + (((4 * ks + kq) ^ d2_swz(n16)) * 16));
    for (int qi = 0; qi < 8; ++qi) {
        const int qx = (int)((myq + (unsigned)qi) & 7u), b = qx >> 1, g = qx & 1;
        const char* kgb = (const char*)(qkvi + (size_t)b * SEQ * QLD + COL_K + g * HEAD_DIM);
        int item = 0;
        if (lane == 0) item = (int)__hip_atomic_fetch_add(qh + qx * 64, 1u, __ATOMIC_RELAXED, __HIP_MEMORY_SCOPE_AGENT);
        item = __builtin_amdgcn_readfirstlane(item);
        bool have_pf = false; int sx[4] = {0, 0, 0, 0}; bf16x8 qv[4] = {};
        while (item < SEQ) {
            const int t = SEQ - 1 - item, tok = b * SEQ + t, cnt = (t + 1 < TOPK) ? (t + 1) : TOPK;
            if (!have_pf) {
#pragma unroll
                for (int i = 0; i < 4; ++i) { const int j = lane + 64 * i; sx[i] = (t < TOPK) ? j : sel[(size_t)tok * TOPK + j]; }
                const bf16* qp = qkvi + (size_t)tok * QLD + (g * 4 + r) * HEAD_DIM + 8 * kq;
#pragma unroll
                for (int ks = 0; ks < 4; ++ks) qv[ks] = *(const bf16x8*)(qp + 32 * ks);
            }
#pragma unroll
            for (int i = 0; i < 4; ++i) { const int j = lane + 64 * i; idxs[j] = (j < cnt) ? (unsigned)sx[i] : 0u; }
            bf16x8 qm[4][4];
#pragma unroll
            for (int ks = 0; ks < 4; ++ks) {
#pragma unroll
                for (int ts = 0; ts < 4; ++ts) qm[ts][ks] = (ts_l == ts) ? qv[ks] : (bf16x8){0, 0, 0, 0, 0, 0, 0, 0}; }
            asm volatile("s_waitcnt vmcnt(0) lgkmcnt(0)" ::: "memory");
#define D2_ISSUE(s) do { const int kb_ = (s) & 15; const char* gb_ = kgb + ((s) >= 16 ? (COL_V - COL_K) * 2 : 0); LAS unsigned char* sl_ = ring + ((s) & 3) * 4096; \
        _Pragma("unroll") for (int j = 0; j < 4; ++j) { const unsigned sk_ = idxs[kb_ * 16 + 4 * j + kq]; \
            __builtin_amdgcn_global_load_lds((const unsigned*)(gb_ + (size_t)sk_ * (QLD * 2) + dch[j]), (LAS unsigned*)(sl_ + j * 1024), 16, 0, 0); } } while (0)
            int nraw = 0;
            if (lane == 0) nraw = (int)__hip_atomic_fetch_add(qh + qx * 64, 1u, __ATOMIC_RELAXED, __HIP_MEMORY_SCOPE_AGENT);
            D2_ISSUE(0); D2_ISSUE(1); D2_ISSUE(2); D2_ISSUE(3);
            f32x4 C[4];
#pragma unroll
            for (int c = 0; c < 4; ++c) C[c] = (f32x4){0.f, 0.f, 0.f, 0.f};
#pragma unroll
            for (int s2 = 0; s2 < 16; ++s2) {
                asm volatile("s_waitcnt vmcnt(12)" ::: "memory");
                LAS unsigned char* sl = ring + (s2 & 3) * 4096;
                bf16x8 a[4];
#pragma unroll
                for (int ks = 0; ks < 4; ++ks) a[ks] = *(const LAS bf16x8*)(sl + aoff[ks]);
#pragma unroll
                for (int ks = 0; ks < 4; ++ks) C[s2 >> 2] = __builtin_amdgcn_mfma_f32_16x16x32_bf16(a[ks], qm[s2 & 3][ks], C[s2 >> 2], 0, 0, 0);
                asm volatile("s_waitcnt lgkmcnt(0)" ::: "memory");
                D2_ISSUE(s2 + 4);
            }
            const float bias2 = __builtin_amdgcn_exp2f(-(float)(g * 4 + r + 1)) * 1.4426950408889634f;
            float x[16]; float m = -INFINITY;
#pragma unroll
            for (int c = 0; c < 4; ++c) { const int k0 = (4 * c + ts_l) * 16 + 4 * kq; const u32x4 sp = *(const LAS u32x4*)(idxs + k0);
#pragma unroll
                for (int j = 0; j < 4; ++j) { const float v = (k0 + j < cnt) ? fmaf(C[c][j], CC, bias2 * (float)((int)sp[j] - t)) : -INFINITY; x[c * 4 + j] = v; m = fmaxf(m, v); } }
            m = fmaxf(m, __shfl_xor(m, 4)); m = fmaxf(m, __shfl_xor(m, 8)); m = fmaxf(m, __shfl_xor(m, 16)); m = fmaxf(m, __shfl_xor(m, 32));
            float sum = 0.f;
#pragma unroll
            for (int i = 0; i < 16; ++i) { x[i] = __builtin_amdgcn_exp2f(x[i] - m); sum += x[i]; }
            sum += __shfl_xor(sum, 4); sum += __shfl_xor(sum, 8); sum += __shfl_xor(sum, 16); sum += __shfl_xor(sum, 32);
            const float inv = 1.f / sum;
#pragma unroll
            for (int c = 0; c < 4; ++c) { const int k0 = (4 * c + ts_l) * 16 + 4 * kq;
                u32x2 w; w.x = cvt_pk_bf16(x[c * 4 + 0] * inv, x[c * 4 + 1] * inv); w.y = cvt_pk_bf16(x[c * 4 + 2] * inv, x[c * 4 + 3] * inv);
                *(LAS u32x2*)(pb + (r * 256 + k0) * 2) = w; }
            asm volatile("s_waitcnt lgkmcnt(0)" ::: "memory");
            f32x4 O[8]; int nitem = SEQ;
#pragma unroll
            for (int db = 0; db < 8; ++db) O[db] = (f32x4){0.f, 0.f, 0.f, 0.f};
            const int q4 = n16 >> 2, p4 = n16 & 3;
#pragma unroll
            for (int u = 0; u < 8; ++u) {
                if (u < 7) asm volatile("s_waitcnt vmcnt(8)" ::: "memory"); else asm volatile("s_waitcnt vmcnt(0)" ::: "memory");
                LAS unsigned char* sl = ring + (((2 * u) & 3) + (kq >> 1)) * 4096;
                const bf16x8 pf = *(const LAS bf16x8*)(pb + (r * 256 + u * 32 + 8 * kq) * 2);
#pragma unroll
                for (int db = 0; db < 8; ++db) {
                    const int i0 = 8 * (kq & 1) + q4, i1 = i0 + 4;
                    const int a0 = (int)(unsigned)(uintptr_t)(sl + i0 * 256 + (((2 * db + (p4 >> 1)) ^ d2_swz(i0)) * 16) + 8 * (p4 & 1));
                    const int a1 = (int)(unsigned)(uintptr_t)(sl + i1 * 256 + (((2 * db + (p4 >> 1)) ^ d2_swz(i1)) * 16) + 8 * (p4 & 1));
                    const s16x4 v0 = mb::tr_read<0>(a0), v1 = mb::tr_read<0>(a1);
                    asm volatile("s_waitcnt lgkmcnt(0)" ::: "memory");
                    const bf16x8 vf = {v0[0], v0[1], v0[2], v0[3], v1[0], v1[1], v1[2], v1[3]};
                    O[db] = __builtin_amdgcn_mfma_f32_16x16x32_bf16(vf, pf, O[db], 0, 0, 0);
                }
                if (u == 0) {
                    nitem = __builtin_amdgcn_readfirstlane(nraw); have_pf = nitem < SEQ;
                    if (have_pf) { const int tn = SEQ - 1 - nitem, tokn = b * SEQ + tn;
#pragma unroll
                        for (int i = 0; i < 4; ++i) { const int j = lane + 64 * i; sx[i] = (tn < TOPK) ? j : sel[(size_t)tokn * TOPK + j]; }
                        const bf16* qpn = qkvi + (size_t)tokn * QLD + (g * 4 + r) * HEAD_DIM + 8 * kq;
#pragma unroll
                        for (int ks = 0; ks < 4; ++ks) qv[ks] = *(const bf16x8*)(qpn + 32 * ks); } }
                if (u < 6) { D2_ISSUE(16 + 2 * u + 4); D2_ISSUE(16 + 2 * u + 5); }
            }
#undef D2_ISSUE
            if (n16 < 4) {
                bf16* op = attn + (size_t)tok * D_MODEL + (g * 4 + n16) * HEAD_DIM + 4 * kq;
#pragma unroll
                for (int db = 0; db < 8; ++db) { u32x2 w; w.x = cvt_pk_bf16(O[db][0], O[db][1]); w.y = cvt_pk_bf16(O[db][2], O[db][3]); *(u32x2*)(op + 16 * db) = w; }
            }
            item = nitem;
        }
    }
}

__device__ __forceinline__ int opq(int x) { asm volatile("" : "+s"(x)); return x; }
__device__ __forceinline__ bool phase_active(int L, int k) {
    if (k >= 2 && k <= 6) { if (L < N_A) return k <= 3; if (k == 2) return L == N_A; }
    return k <= 14;
}
__global__ void __launch_bounds__(512, 2) fwd(Params P) {
    extern __shared__ __attribute__((aligned(16))) unsigned char lds_raw[];
    LAS unsigned char* lds = (LAS unsigned char*)lds_raw;
    const int tid = threadIdx.x;
    unsigned char* ws0 = P.ws;
    if (tid < 16) ((LAS unsigned*)(lds + LDS_MISC))[tid] = 0u;
    __syncthreads();
    const int lo = P.ph_lo, hi = P.ph_hi;
    const bool multi = (hi - lo) > 1;
    unsigned* barw = (unsigned*)(ws0 + WS_CTL) + CW_BAR + P.bar_idx * XCD_BAR_WORDS;
    XcdBarrier bar; bar.bar = barw; bar.x = 0; bar.st = nullptr;
    if (multi) bar = xcd_barrier_post(barw, (volatile LAS unsigned*)(lds + LDS_MISC));
#ifndef PHASE_MASK
#define PHASE_MASK 0xFFFF
#endif
#define IN(k) (((PHASE_MASK >> (k)) & 1) && opq(lo) <= (pb + (k)) && (pb + (k)) < hi && phase_active(L, (k)))
#define SEAM(k) do { if (IN(k) && (pb + (k) + 1) < hi) xcd_barrier(bar); } while (0)
#ifndef PROBE_MASK
#define PROBE_MASK 0
#endif
#define PROBED(k) (((PROBE_MASK) >> (k)) & 1)
    const int G = gridDim.x, c = blockIdx.x;
    for (int L = 0; L < DEPTH; ++L) {
        const int pb = L * 16;
        if (pb + 16 <= lo || pb >= hi) continue;
        const bool isA = L < N_A;
        if (IN(0)) { for (int rep = PROBED(0) ? 0 : 1; rep < 2; ++rep) { phase_convert(fresh_params(), L, lds); if (rep == 0) xcd_barrier(bar); } } SEAM(0);
        if (IN(1)) { for (int rep = PROBED(1) ? 0 : 1; rep < 2; ++rep) {
            KP Q = fresh_params(); unsigned char* ws = Q->ws; bf16* hb = (bf16*)(ws + WS_HB);
            if (isA) {
                gm::DenseOrder S; S.init(hb, ws + WS_WMIX, NTOK, 2048, D_MODEL, G, c);
                gm::EpiBf16 E{(bf16*)(ws + WS_QKVI), QLD, (float*)(ws + WS_IW)};
                gm::gemm_phase<gm::EpiBf16, gm::DenseOrder, false>(lds, D_MODEL, S, E);
            } else {
                if (L == N_A) {
                    gm::DenseOrder S; S.init(hb, ws + WS_WMIX + 6 * MiB, NTOK, 512, D_MODEL, G, c);
                    gm::EpiBf16 E{(bf16*)(ws + WS_KV), 512, nullptr};
                    gm::gemm_phase<gm::EpiBf16, gm::DenseOrder, false>(lds, D_MODEL, S, E);
                }
                gm::DenseOrder S; S.init(hb, ws + WS_WMIX, NTOK, D_MODEL, D_MODEL, G, c);
                gm::EpiBf16 E{(bf16*)(ws + WS_QKVI), D_MODEL, nullptr};
                gm::gemm_phase<gm::EpiBf16, gm::DenseOrder, false>(lds, D_MODEL, S, E);
            }
            if (rep == 0) xcd_barrier(bar);
        } } SEAM(1);
        if (IN(2)) { if (isA) { if (PROBED(2)) { phase_dsa_topk<D1_EXP>(fresh_params(), lds, WS_PL); xcd_barrier(bar); } phase_dsa_topk<0>(fresh_params(), lds, WS_SEL); } else phase_kmeans(fresh_params()); } SEAM(2);
        if (IN(3)) { if (isA) { for (int rep = PROBED(3) ? 0 : 1; rep < 2; ++rep) { phase_dsa_attn2(fresh_params(), rep == 0 ? L + 2 : L, lds); if (rep == 0) xcd_barrier(bar); } } else { for (int rep = PROBED(4) ? 0 : 1; rep < 2; ++rep) { phase_moba_gate2(fresh_params()); if (rep == 0) xcd_barrier(bar); } } } SEAM(3);
        if (IN(4)) { phase_moba_lists(fresh_params(), lds); } SEAM(4);
        if (IN(5)) { for (int rep = PROBED(5) ? 0 : 1; rep < 2; ++rep) { phase_moba_attn2(fresh_params(), (L - N_A) * 2 + rep, lds); if (rep == 0) xcd_barrier(bar); } } SEAM(5);
        if (IN(6)) { for (int rep = PROBED(6) ? 0 : 1; rep < 2; ++rep) { phase_moba_combine(fresh_params()); if (rep == 0) xcd_barrier(bar); } } SEAM(6);
        if (IN(7)) { for (int rep = PROBED(7) ? 0 : 1; rep < 2; ++rep) {
            KP Q = fresh_params(); unsigned char* ws = Q->ws; const float* hres = (L == 0) ? Q->in[0] : (const float*)(ws + WS_H); _Float16* t = (_Float16*)(ws + WS_T);
            { gm::DenseOrder S; S.init(ws + WS_ATTN, ws + WS_WMIX + 4 * MiB, NTOK, D_MODEL, D_MODEL, G, c);
              gm::EpiResid E{hres, t};
              gm::gemm_phase<gm::EpiResid, gm::DenseOrder, false>(lds, D_MODEL, S, E); }
            { gm::DenseOrder S; S.init(ws + WS_PB, ws + WS_WPLE, NTOK, D_MODEL, PLE_DIM, G, c);
              gm::EpiBf16 E{(bf16*)(ws + WS_PL), D_MODEL, nullptr};
              gm::gemm_phase<gm::EpiBf16, gm::DenseOrder, false>(lds, PLE_DIM, S, E); }
            if (rep == 0) xcd_barrier(bar);
        } } SEAM(7);
        if (IN(8)) { for (int rep = PROBED(8) ? 0 : 1; rep < 2; ++rep) { phase_ln_router(fresh_params(), L, lds, rep == 0 ? L + 4 : L); if (rep == 0) xcd_barrier(bar); } } SEAM(8);
        if (IN(9)) { phase_moe_prep(fresh_params(), L, lds); } SEAM(9);
        if (IN(10)) { for (int rep = PROBED(10) ? 0 : 1; rep < 2; ++rep) {
            KP Q = fresh_params(); unsigned char* ws = Q->ws; bf16* hb = (bf16*)(ws + WS_HB);
            const int* moe = (const int*)(ws + WS_MOE);
            gm::MoeOrder S; S.tile_e = moe + MO_TILE_E; S.tile_row0 = moe + MO_TILE_ROW0; S.tile_nv = moe + MO_TILE_NV; S.slot_tok = moe + MO_SLOT_TOK;
            S.n_units = (int)*((const unsigned*)(ws + WS_CTL) + CW_NTILES + L) * 4; S.G = G; S.c = c; S.K = D_MODEL; S.A = (const char*)hb; S.W = (const char*)(ws + WS_WGU);
            S.wstride = (size_t)D_MODEL * D_MODEL * 2; S.tB = (size_t)256 * D_MODEL * 2; S.gath = true;
            gm::EpiSwiglu E{(bf16*)(ws + WS_ACT)};
            gm::gemm_phase<gm::EpiSwiglu, gm::MoeOrder, true>(lds, D_MODEL, S, E);
            if (rep == 0) xcd_barrier(bar);
        } } SEAM(10);
        if (IN(11)) { for (int rep = PROBED(11) ? 0 : 1; rep < 2; ++rep) {
            KP Q = fresh_params(); unsigned char* ws = Q->ws;
            const int* moe = (const int*)(ws + WS_MOE);
            gm::MoeOrder S; S.tile_e = moe + MO_TILE_E; S.tile_row0 = moe + MO_TILE_ROW0; S.tile_nv = moe + MO_TILE_NV; S.slot_tok = moe + MO_SLOT_TOK;
            S.n_units = (int)*((const unsigned*)(ws + WS_CTL) + CW_NTILES + L) * 4; S.G = G; S.c = c; S.K = D_EXPERT; S.A = (const char*)(ws + WS_ACT); S.W = (const char*)(ws + WS_WD);
            S.wstride = (size_t)D_MODEL * D_EXPERT * 2; S.tB = (size_t)256 * D_EXPERT * 2; S.gath = false;
            gm::EpiMoeDown E{(bf16*)(ws + WS_Y)};
            gm::gemm_phase<gm::EpiMoeDown, gm::MoeOrder, false>(lds, D_EXPERT, S, E);
            if (rep == 0) xcd_barrier(bar);
        } } SEAM(11);
        if (IN(12)) { KP Q = fresh_params(); phase_ln<1, false>(Q, L, 1, lds, (float*)(Q->ws + WS_H), true); } SEAM(12);
        if (IN(13)) { for (int rep = PROBED(13) ? 0 : 1; rep < 2; ++rep) {
            KP Q = fresh_params(); unsigned char* ws = Q->ws; bf16* hb = (bf16*)(ws + WS_HB); float* h = (float*)(ws + WS_H); _Float16* t = (_Float16*)(ws + WS_T);
            gm::DenseOrder S; S.init(hb, ws + WS_WPG, NTOK, D_MODEL, D_MODEL, G, c);
            gm::EpiPle E{h, (const bf16*)(ws + WS_PL), t};
            gm::gemm_phase<gm::EpiPle, gm::DenseOrder, false>(lds, D_MODEL, S, E);
            if (rep == 0) xcd_barrier(bar);
        } } SEAM(13);
        if (IN(14)) { for (int rep = PROBED(14) ? 0 : 1; rep < 2; ++rep) { KP Q = fresh_params(); phase_ln<0, false>(Q, L, 2, lds, (L == DEPTH - 1) ? Q->out : (float*)(Q->ws + WS_H), L != DEPTH - 1); if (rep == 0) xcd_barrier(bar); } }
        if (L != DEPTH - 1) SEAM(14);
    }
#undef IN
#undef SEAM
}

#ifndef DEBUG_ATTN
#define DEBUG_ATTN 0
#endif
#if DEBUG_ATTN
__global__ void __launch_bounds__(256) dsa_scores(const bf16* __restrict__ qkvi  , const float* __restrict__ iw  , float* __restrict__ sc) {
    const int s0 = blockIdx.x * 64, t0 = blockIdx.y * 64;
    if (s0 > t0) return;
    __shared__ float Qs[64][68];
    __shared__ float Ks[64][68];
    const int tid = threadIdx.x, r = tid >> 2, kq = (tid & 3) * 16;
    {
        const bf16* kp = qkvi + (size_t)(s0 + r) * QLD + COL_IK + kq;
#pragma unroll
        for (int i = 0; i < 16; ++i) Ks[kq + i][r] = bf2f(kp[i]);
    }
    const int ty = tid >> 4, tx = tid & 15;
    float tot[4][4];
#pragma unroll
    for (int i = 0; i < 4; ++i)
#pragma unroll
        for (int j = 0; j < 4; ++j) tot[i][j] = 0.f;
    for (int hh = 0; hh < IDX_HEADS; ++hh) {
        __syncthreads();
        const bf16* qp = qkvi + (size_t)(t0 + r) * QLD + COL_IQ + hh * IDX_DIM + kq;
#pragma unroll
        for (int i = 0; i < 16; ++i) Qs[kq + i][r] = bf2f(qp[i]);
        __syncthreads();
        float acc[4][4];
#pragma unroll
        for (int i = 0; i < 4; ++i)
#pragma unroll
            for (int j = 0; j < 4; ++j) acc[i][j] = 0.f;
#pragma unroll 8
        for (int k = 0; k < 64; ++k) {
            const float4 a4 = *(const float4*)&Qs[k][ty * 4];
            const float4 b4 = *(const float4*)&Ks[k][tx * 4];
            const float a[4] = {a4.x, a4.y, a4.z, a4.w};
            const float b[4] = {b4.x, b4.y, b4.z, b4.w};
#pragma unroll
            for (int i = 0; i < 4; ++i)
#pragma unroll
                for (int j = 0; j < 4; ++j) acc[i][j] += a[i] * b[j];
        }
#pragma unroll
        for (int i = 0; i < 4; ++i) {
            const float w = iw[(size_t)(t0 + ty * 4 + i) * 4 + hh];
#pragma unroll
            for (int j = 0; j < 4; ++j) tot[i][j] += w * fmaxf(acc[i][j], 0.f);
        }
    }
#pragma unroll
    for (int i = 0; i < 4; ++i)
        *(float4*)(sc + (size_t)(t0 + ty * 4 + i) * SEQ + s0 + tx * 4) = make_float4(tot[i][0], tot[i][1], tot[i][2], tot[i][3]);
}

__device__ __forceinline__ unsigned fkey(float f) { const unsigned u = __float_as_uint(f); return (u & 0x80000000u) ? ~u : (u | 0x80000000u); }
__global__ void __launch_bounds__(256) dsa_topk(const float* __restrict__ sc, int* __restrict__ sel) {
    const int t = blockIdx.x, tid = threadIdx.x, n = t + 1;
    int* out = sel + (size_t)t * TOPK;
    if (n <= TOPK) { out[tid] = tid <= t ? tid : 0; return; }
    const float* row = sc + (size_t)t * SEQ;
    __shared__ unsigned hist[256];
    __shared__ unsigned s_prefix, s_need;
    __shared__ int wsum[2][4];
    unsigned prefix = 0, need = TOPK;
    for (int pass = 3; pass >= 0; --pass) {
        hist[tid] = 0;
        __syncthreads();
        for (int i = tid; i < n; i += 256) {
            const unsigned k = fkey(row[i]);
            const bool match = (pass == 3) ? true : ((k >> (8 * (pass + 1))) == prefix);
            if (match) atomicAdd(&hist[(k >> (8 * pass)) & 255u], 1u);
        }
        __syncthreads();
        if (tid == 0) {
            unsigned c = 0; int d = 255;
            for (; d > 0; --d) { if (c + hist[d] >= need) break; c += hist[d]; }
            s_prefix = (prefix << 8) | (unsigned)d; s_need = need - c;
        }
        __syncthreads();
        prefix = s_prefix; need = s_need;
        __syncthreads();
    }
    const unsigned T = prefix;
    const int n_gt = TOPK - (int)need;
    int run_gt = 0, run_eq = 0;
    const int lane = tid & 63, w = tid >> 6;
    for (int base = 0; base < n; base += 256) {
        const int i = base + tid;
        unsigned k = 0; bool gt = false, eq = false;
        if (i < n) { k = fkey(row[i]); gt = k > T; eq = k == T; }
        const unsigned long long mg = __ballot(gt), me = __ballot(eq);
        const unsigned long long lower = (lane == 0) ? 0ull : (~0ull >> (64 - lane));
        const int pg = __popcll(mg & lower), pe = __popcll(me & lower);
        if (lane == 0) { wsum[0][w] = __popcll(mg); wsum[1][w] = __popcll(me); }
        __syncthreads();
        int og = 0, oe = 0, tg = 0, te = 0;
        for (int x = 0; x < 4; ++x) { if (x < w) { og += wsum[0][x]; oe += wsum[1][x]; } tg += wsum[0][x]; te += wsum[1][x]; }
        if (gt) out[run_gt + og + pg] = i;
        if (eq) { const int rk = run_eq + oe + pe; if (rk < (int)need) out[n_gt + rk] = i; }
        run_gt += tg; run_eq += te;
        __syncthreads();
    }
}

__global__ void __launch_bounds__(256) dsa_attn(const bf16* __restrict__ qkvi, const int* __restrict__ sel, bf16* __restrict__ attn) {
    const int tok = blockIdx.x, b = tok / SEQ, t = tok % SEQ, tid = threadIdx.x;
    __shared__ float qs[D_MODEL];
    __shared__ float lg[N_HEADS][TOPK];
    __shared__ int sidx[TOPK];
    const int cnt = (t + 1 < TOPK) ? (t + 1) : TOPK;
    const bf16* prow = qkvi + (size_t)tok * QLD;
#pragma unroll
    for (int i = 0; i < 4; ++i) qs[tid * 4 + i] = bf2f(prow[tid * 4 + i]);
    int s = 0;
    if (tid < cnt) s = (t < TOPK) ? tid : sel[(size_t)tok * TOPK + tid];
    sidx[tid] = s;
    __syncthreads();
    const float scale = 0.08838834764831845f;
    if (tid < cnt) {
        const bf16* krow = qkvi + (size_t)(b * SEQ + s) * QLD + COL_K;
        for (int g = 0; g < N_KV; ++g) {
            float d[4] = {0.f, 0.f, 0.f, 0.f};
            for (int k = 0; k < HEAD_DIM; ++k) {
                const float kv = bf2f(krow[g * HEAD_DIM + k]);
#pragma unroll
                for (int r = 0; r < 4; ++r) d[r] += qs[(g * 4 + r) * HEAD_DIM + k] * kv;
            }
#pragma unroll
            for (int r = 0; r < 4; ++r) {
                const int hh = g * 4 + r;
                const float slope = exp2f(-(float)(hh + 1));
                lg[hh][tid] = d[r] * scale - slope * (float)(t - s);
            }
        }
    } else {
        for (int hh = 0; hh < N_HEADS; ++hh) lg[hh][tid] = -INFINITY;
    }
    __syncthreads();
    {
        const int lane = tid & 63, w = tid >> 6;
        for (int h2 = 0; h2 < 2; ++h2) {
            const int hh = w * 2 + h2;
            float v[4], m = -INFINITY;
#pragma unroll
            for (int i = 0; i < 4; ++i) { v[i] = lg[hh][lane + 64 * i]; m = fmaxf(m, v[i]); }
            for (int o = 32; o > 0; o >>= 1) m = fmaxf(m, __shfl_xor(m, o));
            float sum = 0.f;
#pragma unroll
            for (int i = 0; i < 4; ++i) { v[i] = expf(v[i] - m); sum += v[i]; }
            for (int o = 32; o > 0; o >>= 1) sum += __shfl_xor(sum, o);
            const float inv = 1.f / sum;
#pragma unroll
            for (int i = 0; i < 4; ++i) lg[hh][lane + 64 * i] = v[i] * inv;
        }
    }
    __syncthreads();
    {
        const int col = tid * 4, hh = col / HEAD_DIM, g = hh / HEAD_GROUP, d = col % HEAD_DIM;
        float acc[4] = {0.f, 0.f, 0.f, 0.f};
        for (int j = 0; j < cnt; ++j) {
            const float p = lg[hh][j];
            const u32x2 vv = *(const u32x2*)(qkvi + (size_t)(b * SEQ + sidx[j]) * QLD + COL_V + g * HEAD_DIM + d);
            acc[0] += p * bflo(vv.x); acc[1] += p * bfhi(vv.x); acc[2] += p * bflo(vv.y); acc[3] += p * bfhi(vv.y);
        }
        u32x2 o; o.x = cvt_pk_bf16(acc[0], acc[1]); o.y = cvt_pk_bf16(acc[2], acc[3]);
        *(u32x2*)(attn + (size_t)tok * D_MODEL + col) = o;
    }
}

__global__ void __launch_bounds__(128) kmeans_kernel(const bf16* __restrict__ kv, float* __restrict__ km) {
    const int blk = blockIdx.x % N_BLOCKS, g = (blockIdx.x / N_BLOCKS) % N_KV, b = blockIdx.x / (N_BLOCKS * N_KV), d = threadIdx.x;
    float s = 0.f;
    for (int i = 0; i < MOBA_BLOCK; ++i) s += bf2f(kv[(size_t)(b * SEQ + blk * MOBA_BLOCK + i) * 512 + g * HEAD_DIM + d]);
    km[((size_t)(b * N_KV + g) * N_BLOCKS + blk) * HEAD_DIM + d] = s * (1.f / MOBA_BLOCK);
}

__global__ void __launch_bounds__(256) moba_attn(const bf16* __restrict__ q, const bf16* __restrict__ kv, const float* __restrict__ km, bf16* __restrict__ attn) {
    const int tok = blockIdx.x, b = tok / SEQ, t = tok % SEQ, tid = threadIdx.x, own = t / MOBA_BLOCK;
    __shared__ float qs[HEAD_DIM];
    __shared__ float gate[N_BLOCKS];
    __shared__ int selb[3];
    __shared__ float lg[4 * MOBA_BLOCK];
    __shared__ float red[8];
    __shared__ float part[2][HEAD_DIM];
    const float scale = 0.08838834764831845f;
    for (int hh = 0; hh < N_HEADS; ++hh) {
        const int g = hh / HEAD_GROUP;
        const float slope = exp2f(-(float)(hh + 1));
        __syncthreads();
        if (tid < HEAD_DIM) qs[tid] = bf2f(q[(size_t)tok * D_MODEL + hh * HEAD_DIM + tid]);
        __syncthreads();
        if (tid < N_BLOCKS) {
            float gval = -INFINITY;
            if (tid < own) {
                const float* kp = km + ((size_t)(b * N_KV + g) * N_BLOCKS + tid) * HEAD_DIM;
                float s = 0.f;
                for (int k = 0; k < HEAD_DIM; ++k) s += qs[k] * kp[k];
                gval = s;
            }
            gate[tid] = gval;
        }
        __syncthreads();
        if (tid == 0) {
            unsigned used = 0u;
            for (int s = 0; s < 3; ++s) {
                int best = -1; float bv = 0.f;
                for (int j = 0; j < N_BLOCKS; ++j) if (!((used >> j) & 1u) && (best < 0 || gate[j] > bv)) { best = j; bv = gate[j]; }
                used |= 1u << best; selb[s] = best;
            }
        }
        __syncthreads();
        for (int s = 0; s < 4; ++s) {
            const int blk = (s < 3) ? selb[s] : own;
            const int kpos = blk * MOBA_BLOCK + tid;
            const bool valid = (s < 3) ? (blk < own) : (kpos <= t);
            float v = -INFINITY;
            if (valid) {
                const bf16* kp = kv + (size_t)(b * SEQ + kpos) * 512 + g * HEAD_DIM;
                float d = 0.f;
                for (int k = 0; k < HEAD_DIM; ++k) d += qs[k] * bf2f(kp[k]);
                v = d * scale - slope * (float)(t - kpos);
            }
            lg[s * MOBA_BLOCK + tid] = v;
        }
        __syncthreads();
        float m = fmaxf(fmaxf(lg[tid], lg[256 + tid]), fmaxf(lg[512 + tid], lg[768 + tid]));
        for (int o = 32; o > 0; o >>= 1) m = fmaxf(m, __shfl_xor(m, o));
        if ((tid & 63) == 0) red[tid >> 6] = m;
        __syncthreads();
        m = fmaxf(fmaxf(red[0], red[1]), fmaxf(red[2], red[3]));
        float e[4], sum = 0.f;
#pragma unroll
        for (int i = 0; i < 4; ++i) { e[i] = expf(lg[i * 256 + tid] - m); sum += e[i]; }
        for (int o = 32; o > 0; o >>= 1) sum += __shfl_xor(sum, o);
        if ((tid & 63) == 0) red[4 + (tid >> 6)] = sum;
        __syncthreads();
        const float inv = 1.f / (red[4] + red[5] + red[6] + red[7]);
#pragma unroll
        for (int i = 0; i < 4; ++i) lg[i * 256 + tid] = e[i] * inv;
        __syncthreads();
        {
            const int d = tid & 127, half = tid >> 7;
            float acc = 0.f;
            for (int s = 0; s < 4; ++s) {
                const int blk = (s < 3) ? selb[s] : own;
                const bool bvalid = (s < 3) ? (blk < own) : true;
                if (!bvalid) continue;
                const bf16* vp = kv + (size_t)(b * SEQ + blk * MOBA_BLOCK + half * 128) * 512 + KV_DIM + g * HEAD_DIM + d;
                const float* pp = lg + s * MOBA_BLOCK + half * 128;
                for (int j = 0; j < 128; ++j) { const float p = pp[j]; if (p != 0.f) acc += p * bf2f(vp[(size_t)j * 512]); }
            }
            part[half][d] = acc;
        }
        __syncthreads();
        if (tid < HEAD_DIM) attn[(size_t)tok * D_MODEL + hh * HEAD_DIM + tid] = (bf16)(cvt_pk_bf16(part[0][tid] + part[1][tid], 0.f) & 0xffffu);
    }
}


#endif
#ifndef DEBUG_ATTN
#define DEBUG_ATTN 0
#endif
#if DEBUG_ATTN
__global__ void dbg_compare(const bf16* __restrict__ a, const bf16* __restrict__ ref, size_t n, float* __restrict__ acc) {
    float d2 = 0.f, r2 = 0.f;
    for (size_t i = (size_t)blockIdx.x * blockDim.x + threadIdx.x; i < n; i += (size_t)gridDim.x * blockDim.x) { const float x = bf2f(a[i]), y = bf2f(ref[i]); d2 += (x - y) * (x - y); r2 += y * y; }
    d2 = wave_sum(d2); r2 = wave_sum(r2);
    if ((threadIdx.x & 63) == 0) { atomicAdd(&acc[0], d2); atomicAdd(&acc[1], r2); }
}
__global__ void dbg_scale(float* __restrict__ out, size_t n, const float* __restrict__ acc) {
    const float rv = acc[0] / fmaxf(acc[1], 1e-30f);
    float e = sqrtf(fminf(rv * 100.f, 4.f)); if (!(rv == rv)) e = 3.f;
    for (size_t i = (size_t)blockIdx.x * blockDim.x + threadIdx.x; i < n; i += (size_t)gridDim.x * blockDim.x) out[i] *= (1.f + e);
}
#endif

extern "C" void kernel_launch(void* const* d_in, const int* in_sizes, int n_in, void* d_out, int out_size, void* d_ws, size_t ws_size, hipStream_t stream) {
    static int grid = 0;
    if (grid == 0) {
        int dev = 0, cus = 0;
        (void)hipGetDevice(&dev); (void)hipDeviceGetAttribute(&cus, hipDeviceAttributeMultiprocessorCount, dev);
        (void)hipFuncSetAttribute((const void*)fwd, hipFuncAttributeMaxDynamicSharedMemorySize, LDS_BYTES);
        grid = cus > 0 ? cus : 256;
    }
    unsigned char* ws = (unsigned char*)d_ws;
    (void)hipMemsetAsync(ws + WS_CTL, 0, CTL_ZERO_BYTES, stream);
    Params P{};
    for (int i = 0; i < 18; ++i) P.in[i] = (const float*)d_in[i];
    P.out = (float*)d_out; P.ws = ws;
    int nlaunch = 0;
    auto run = [&](int lo, int hi) { P.ph_lo = lo; P.ph_hi = hi; P.bar_idx = nlaunch++; hipLaunchKernelGGL(fwd, dim3(grid), dim3(512), LDS_BYTES, stream, P); };
#if DEBUG_ATTN
    const bf16* qkvi = (const bf16*)(ws + WS_QKVI); bf16* attn = (bf16*)(ws + WS_ATTN); int* sel = (int*)(ws + WS_SEL);
    float* scores = (float*)(ws + WS_SCORES); const float* iw = (const float*)(ws + WS_IW); const bf16* kvb = (const bf16*)(ws + WS_KV); float* km = (float*)(ws + WS_KM);
#endif
#if DEBUG_ATTN == 0
    run(0, DEPTH * 16);
#else
    for (int L = 0; L < DEPTH; ++L) {
        const int pb = L * 16;
        if (L < N_A) {
#if DEBUG_ATTN == 4
            if (L == 1) {
                run(pb + 0, pb + 3);
                bf16* attn2 = (bf16*)(ws + WS_PL);
                dsa_attn<<<NTOK, 256, 0, stream>>>(qkvi, sel, attn2);
                run(pb + 3, pb + 4);
                dbg_compare<<<1024, 256, 0, stream>>>(attn, attn2, (size_t)NTOK * D_MODEL, (float*)(ws + WS_CTL) + 1024);
                run(pb + 7, pb + 15);
            } else
#endif
#if DEBUG_ATTN == 3
            if (L == 1) {
                run(pb + 0, pb + 2);
                bf16* attn2 = (bf16*)(ws + WS_PL);
                for (int b = 0; b < BATCH; ++b) {
                    dsa_scores<<<dim3(SEQ / 64, SEQ / 64), 256, 0, stream>>>(qkvi + (size_t)b * SEQ * QLD, iw + (size_t)b * SEQ * 4, scores);
                    dsa_topk<<<SEQ, 256, 0, stream>>>(scores, sel + (size_t)b * SEQ * TOPK);
                }
                dsa_attn<<<NTOK, 256, 0, stream>>>(qkvi, sel, attn2);
                run(pb + 2, pb + 4);
                dbg_compare<<<1024, 256, 0, stream>>>(attn, attn2, (size_t)NTOK * D_MODEL, (float*)(ws + WS_CTL) + 1024);
                run(pb + 7, pb + 15);
            } else
#endif
            { run(pb + 0, pb + 4); run(pb + 7, pb + 15); }
        } else {
            run(pb + 0, pb + 7);
#if DEBUG_ATTN == 1
            if (L == N_A) {
                bf16* attn2 = (bf16*)(ws + WS_PL);
                kmeans_kernel<<<BATCH * N_KV * N_BLOCKS, 128, 0, stream>>>(kvb, km + 65536);
                moba_attn<<<NTOK, 256, 0, stream>>>(qkvi, kvb, km + 65536, attn2);
                dbg_compare<<<1024, 256, 0, stream>>>(attn, attn2, (size_t)NTOK * D_MODEL, (float*)(ws + WS_CTL) + 1024);
            }
#endif
            run(pb + 7, pb + 15);
        }
    }
#endif
#if DEBUG_ATTN
    dbg_scale<<<1024, 256, 0, stream>>>((float*)d_out, (size_t)NTOK * D_MODEL, (const float*)(ws + WS_CTL) + 1024);
#endif
}
```

```cpp
#include <hip/hip_runtime.h>
#include <stdint.h>

#define D_MODEL 1024
#define BATCH 4
#define SEQ 8192
#define NTOK (BATCH * SEQ)
#define DEPTH 4
#define N_A 2
#define N_HEADS 8
#define HEAD_DIM 128
#define N_KV 2
#define HEAD_GROUP 4
#define KV_DIM 256
#define IDX_HEADS 4
#define IDX_DIM 64
#define TOPK 256
#define MOBA_BLOCK 256
#define N_BLOCKS 32
#define N_GROUPS 4
#define EPG 8
#define N_EXPERTS 32
#define D_EXPERT 512
#define PLE_DIM 256
#define A_COLS 1860
#define QLD 2048
#define COL_K 1024
#define COL_V 1280
#define COL_IQ 1536
#define COL_IK 1792
#define COL_IW 1856
#define ALPHA_F 1.6817928305074290f
#define LN_EPS 1e-5f
#define MAX_SLOTS (65536 + 8192)
#define MAX_MTILES (MAX_SLOTS / 256)

#define LAS __attribute__((address_space(3)))
#define GAS __attribute__((address_space(1)))
typedef unsigned short bf16;
typedef short bf16x8 __attribute__((ext_vector_type(8)));
typedef float f32x4 __attribute__((ext_vector_type(4)));
typedef float f32x2 __attribute__((ext_vector_type(2)));
typedef unsigned u32x4 __attribute__((ext_vector_type(4)));
typedef unsigned u32x2 __attribute__((ext_vector_type(2)));
typedef _Float16 f16x4 __attribute__((ext_vector_type(4)));

__device__ __forceinline__ unsigned cvt_pk_bf16(float lo, float hi) { unsigned r; asm("v_cvt_pk_bf16_f32 %0, %1, %2" : "=v"(r) : "v"(lo), "v"(hi)); return r; }
__device__ __forceinline__ float bf2f(bf16 b) { return __uint_as_float(((unsigned)b) << 16); }
__device__ __forceinline__ float bflo(unsigned u) { return __uint_as_float(u << 16); }
__device__ __forceinline__ float bfhi(unsigned u) { return __uint_as_float(u & 0xffff0000u); }
template <int CTRL> __device__ __forceinline__ float dpp_add(float v) { return v + __int_as_float(__builtin_amdgcn_update_dpp(0, __float_as_int(v), CTRL, 0xF, 0xF, false)); }
__device__ __forceinline__ float row16_sum(float v) {
    v = dpp_add<0xB1>(v); v = dpp_add<0x4E>(v); v = dpp_add<0x141>(v); v = dpp_add<0x140>(v); return v;
}
__device__ __forceinline__ float wave_sum(float v) { v = row16_sum(v); v += __shfl_xor(v, 16); v += __shfl_xor(v, 32); return v; }
template <int CTRL, int RMASK> __device__ __forceinline__ unsigned dpp_addu(unsigned v) { return v + (unsigned)__builtin_amdgcn_update_dpp(0, (int)v, CTRL, RMASK, 0xF, false); }
__device__ __forceinline__ unsigned wave_scan_incl(unsigned v) {
    v = dpp_addu<0x111, 0xF>(v); v = dpp_addu<0x112, 0xF>(v); v = dpp_addu<0x114, 0xF>(v); v = dpp_addu<0x118, 0xF>(v);
    v = dpp_addu<0x142, 0xA>(v); v = dpp_addu<0x143, 0xC>(v); return v;
}

constexpr size_t MiB = 1u << 20;
constexpr size_t WS_CTL = 0, CTL_ZERO_BYTES = 1 * MiB;
constexpr size_t WS_WMIX = 2 * MiB;
constexpr size_t WS_WPG = 10 * MiB;
constexpr size_t WS_WPLE = 12 * MiB;
constexpr size_t WS_WGU = 16 * MiB;
constexpr size_t WS_WD = 80 * MiB;
constexpr size_t WS_PB = 112 * MiB;
constexpr size_t WS_H = 128 * MiB;
constexpr size_t WS_HB = 256 * MiB;
constexpr size_t WS_T = 320 * MiB;
constexpr size_t WS_KV = 448 * MiB;
constexpr size_t WS_PL = 480 * MiB;
constexpr size_t WS_QKVI = 544 * MiB;
constexpr size_t WS_ATTN = 672 * MiB;
constexpr size_t WS_SEL = 736 * MiB;
constexpr size_t WS_ACT = 544 * MiB;
constexpr size_t WS_Y = 616 * MiB;
constexpr size_t WS_MOE = 768 * MiB;
constexpr size_t WS_IW = 770 * MiB;
constexpr size_t WS_KM = 771 * MiB;
constexpr size_t WS_SCORES = 772 * MiB;
constexpr int MO_TOK_E = 0, MO_TOK_POS = NTOK * 2, MO_TOK_SLOT = NTOK * 4, MO_TOK_W = NTOK * 6, MO_SLOT_TOK = NTOK * 8, MO_TILE_E = MO_SLOT_TOK + MAX_SLOTS, MO_TILE_ROW0 = MO_TILE_E + 512, MO_TILE_NV = MO_TILE_ROW0 + 512;
constexpr int CW_BAR = 65536;
constexpr int CW_CNT = 16384;
constexpr int CW_NTILES = 16384 + 256;

constexpr int LDS_BYTES = 163840;
constexpr int LDS_MISC = 163840 - 256;
constexpr int NWAVES = 8;

#define XB_TMO      128
#define XB_XCNT(j)  (256  + 64 * (j))
#define XB_XSUB(j)  (1280 + 64 * (j))
#define XB_XGEN(j)  (2304 + 64 * (j))
#define XB_TOP      3328
#define XB_TOPGEN   3392
#define XCD_BAR_WORDS 3456
#define XB_SPIN_CAP (1u << 22)
__device__ __forceinline__ unsigned xb_ld(unsigned* p)              { return __hip_atomic_load(p, __ATOMIC_RELAXED, __HIP_MEMORY_SCOPE_AGENT); }
__device__ __forceinline__ unsigned xb_add(unsigned* p, unsigned v) { return __hip_atomic_fetch_add(p, v, __ATOMIC_RELAXED, __HIP_MEMORY_SCOPE_AGENT); }
__device__ __forceinline__ unsigned xb_xcc_id() { return (unsigned)__builtin_amdgcn_s_getreg((3 << 11) | 20) & 0xFu; }
#define XB_SPIN(cond, bar) do { unsigned _sp = 0; while (cond) { __builtin_amdgcn_s_sleep(1); \
    if ((++_sp & 255u) == 0u) { if (xb_ld(&(bar)[XB_TMO])) break; if (_sp > XB_SPIN_CAP) { atomicAdd(&(bar)[XB_TMO], 1u); break; } } } } while (0)
struct XcdBarrier { unsigned* bar; unsigned x; volatile LAS unsigned* st; };
__device__ __forceinline__ XcdBarrier xcd_barrier_post(unsigned* bar, volatile LAS unsigned* st) {
    XcdBarrier b; b.bar = bar; b.x = xb_xcc_id(); b.st = st;
    if (threadIdx.x == 0) (void)xb_add(&bar[XB_XCNT(b.x)], 1u);
    return b;
}
__device__ __forceinline__ void xcd_barrier_complete(unsigned* bar, unsigned x, unsigned& nloc, unsigned& nx) {
    const unsigned G = gridDim.x * gridDim.y * gridDim.z;
    unsigned sum, cnt, mine, sp = 0u;
    for (;;) {
        sum = 0u; cnt = 0u; mine = 0u;
#pragma unroll
        for (unsigned j = 0; j < 16; ++j) { const unsigned c = xb_ld(&bar[XB_XCNT(j)]); sum += c; cnt += (c > 0u) ? 1u : 0u; mine = (j == x) ? c : mine; }
        if (sum == G) break;
        __builtin_amdgcn_s_sleep(1);
        if ((++sp & 255u) == 0u) { if (xb_ld(&bar[XB_TMO])) break; if (sp > XB_SPIN_CAP) { atomicAdd(&bar[XB_TMO], 1u); break; } }
    }
    nloc = mine > 0u ? mine : 1u; nx = cnt > 0u ? cnt : 1u;
}
__device__ __forceinline__ void xcd_barrier(const XcdBarrier& b) {
    asm volatile("s_waitcnt vmcnt(0)" ::: "memory");
    __syncthreads();
    if (threadIdx.x == 0) {
        unsigned* bar = b.bar;
        __builtin_amdgcn_s_waitcnt(0);
        unsigned nloc = b.st[0], nx = b.st[1];
        if (nloc == 0u) { xcd_barrier_complete(bar, b.x, nloc, nx); b.st[0] = nloc; b.st[1] = nx; }
        const unsigned old = xb_add(&bar[XB_XSUB(b.x)], 1u);
        const unsigned gen = old / nloc;
        if (old + 1u == (gen + 1u) * nloc) {
            __builtin_amdgcn_fence(__ATOMIC_RELEASE, "agent");
            asm volatile("s_waitcnt vmcnt(0)" ::: "memory");
            const unsigned og = xb_add(&bar[XB_TOP], 1u);
            const unsigned tg = og / nx;
            if (og + 1u == (tg + 1u) * nx) xb_add(&bar[XB_TOPGEN], 1u);
            else XB_SPIN(xb_ld(&bar[XB_TOPGEN]) == tg, bar);
            __builtin_amdgcn_fence(__ATOMIC_ACQUIRE, "agent");
            xb_add(&bar[XB_XGEN(b.x)], 1u);
            asm volatile("s_waitcnt vmcnt(0)" ::: "memory");
        } else {
            XB_SPIN(xb_ld(&bar[XB_XGEN(b.x)]) == gen, bar);
            __builtin_amdgcn_fence(__ATOMIC_ACQUIRE, "agent");
            asm volatile("s_waitcnt vmcnt(0)" ::: "memory");
        }
    }
    __syncthreads();
}

namespace gm {
constexpr int BM = 256, BK = 64, HALF = 128, HTB = HALF * BK * 2, STAGE_BYTES = 8 * HTB, NXCD = 8, WGM = 8;
__host__ __device__ __forceinline__ int lds_byte(int r, int c) { const int st = (r >> 4) * 2 + (c >> 5), rr = r & 15, cc = c & 31, ob = rr * 64 + cc * 2; return st * 1024 + (ob ^ (((ob >> 9) & 1) << 5)); }
__host__ __device__ __forceinline__ void stage_rc(int b, int& R, int& C) { const int st = b / 1024, sb = b % 1024, swz = sb ^ (((sb >> 9) & 1) << 5); R = (st >> 1) * 16 + swz / 64; C = (st & 1) * 32 + (swz % 64) / 2; }
__host__ __device__ __forceinline__ int perm32(int rho) { const int n = rho >> 4, i = rho & 15; return 8 * (i >> 2) + 4 * n + (i & 3); }

struct Unit { const char* a; const char* b; int row0, col0, aux; };

struct DenseOrder {
    int nM, nN, nwg, G, c; const char* A; const char* B; size_t tA, tB;
    __device__ void init(const void* A_, const void* Bt_, int M, int N, int K, int G_, int c_) { nM = M / BM; nN = N / BM; nwg = nM * nN; G = G_; c = c_; A = (const char*)A_; B = (const char*)Bt_; tA = (size_t)BM * K * 2; tB = tA; }
    __device__ bool next(int i, Unit& u) const {
        const long L = (long)i * G + c; if (L >= nwg) return false;
        int wgid = (int)L; { const int q = nwg / NXCD, r = nwg % NXCD, xcd = wgid % NXCD, off = wgid / NXCD; wgid = (xcd < r ? xcd * (q + 1) : r * (q + 1) + (xcd - r) * q) + off; }
        const int nig = WGM * nN, gid = wgid / nig, fm = gid * WGM, gsz = (nM - fm) < WGM ? (nM - fm) : WGM;
        const int pm = fm + ((wgid % nig) % gsz), pn = (wgid % nig) / gsz;
        u.a = A + (size_t)pm * tA; u.b = B + (size_t)pn * tB; u.row0 = pm * BM; u.col0 = pn * BM; u.aux = 0; return true;
    }
    __device__ __forceinline__ void gather(const Unit&, unsigned (&)[2][2], const int (&)[2], const int (&)[2], int) const {}
};
struct MoeOrder {
    const int* tile_e; const int* tile_row0; const int* tile_nv; const int* slot_tok; int n_units, G, c, K; const char* A; const char* W; size_t wstride, tB; bool gath;
    __device__ bool next(int i, Unit& u) const {
        const int L = i * G + c; if (L >= n_units) return false;
        const int T = L >> 2, pn = L & 3;
        const int e = __builtin_amdgcn_readfirstlane(tile_e[T]), r0 = __builtin_amdgcn_readfirstlane(tile_row0[T]), nv = __builtin_amdgcn_readfirstlane(tile_nv[T]);
        u.a = gath ? A : A + (size_t)r0 * K * 2; u.b = W + (size_t)e * wstride + (size_t)pn * tB; u.row0 = r0; u.col0 = pn; u.aux = nv; return true;
    }
    __device__ __forceinline__ void gather(const Unit& u, unsigned (&vo)[2][2], const int (&sR)[2], const int (&sC)[2], int K_) const {
#pragma unroll
        for (int h = 0; h < 2; ++h)
#pragma unroll
            for (int i = 0; i < 2; ++i) { const int r = h * HALF + sR[i]; const int tok = (r < u.aux) ? slot_tok[u.row0 + r] : 0; vo[h][i] = (unsigned)(tok * K_ + sC[i]) * 2u; }
    }
};

template <class Epi, class Sched, bool GATHER>
__device__ __forceinline__ void gemm_phase(LAS unsigned char* lds, const int K, const Sched& S, const Epi& E) {
    int tz = threadIdx.x; asm volatile("" : "+v"(tz));
    const int tid = tz, wid = __builtin_amdgcn_readfirstlane(tid >> 6), lane = tid & 63, wr = wid >> 2, wc = wid & 3, fr = lane & 15, fq = lane >> 4;
    const int nt = K / BK;
    unsigned voffB[2], vA[2][2], vAn[2][2]; int sR[2], sC[2];
#pragma unroll
    for (int i = 0; i < 2; ++i) { int R, C; stage_rc(tid * 16 + i * 8192, R, C); const int Rb = Epi::PERM ? ((R & ~31) + perm32(R & 31)) : R;
        sR[i] = R; sC[i] = C; voffB[i] = (unsigned)(Rb * K + C) * 2u;
        vA[0][i] = (unsigned)(R * K + C) * 2u; vA[1][i] = (unsigned)((R + HALF) * K + C) * 2u; vAn[0][i] = vA[0][i]; vAn[1][i] = vA[1][i]; }
    const size_t kstep = (size_t)(BK * 2);
    const size_t hstep = (size_t)HALF * K * 2;
    const unsigned ldsw = (unsigned)wid * 1024u;
    const int aoff = lds_byte(wr * 64 + fr, fq * 8), boff = lds_byte(wc * 32 + fr, fq * 8);
#define PG8_SA(b, h) (((b) * 2 + (h)) * HTB)
#define PG8_SB(b, h) ((4 + (b) * 2 + (h)) * HTB)
#define PG8_STAGE(bufoff, gbase, voff) do { _Pragma("unroll") for (int _i = 0; _i < 2; ++_i) \
        __builtin_amdgcn_global_load_lds((const unsigned*)((const char*)(gbase) + (voff)[_i]), (LAS unsigned*)(lds + (bufoff) + ldsw + _i * 8192), 16, 0, 0); } while (0)
#define PG8_LDA(dst, b, h) do { _Pragma("unroll") for (int m = 0; m < 4; ++m) _Pragma("unroll") for (int k = 0; k < 2; ++k) dst[m][k] = *(const LAS bf16x8*)(lds + PG8_SA(b, h) + aoff + m * 2048 + k * 1024); } while (0)
#define PG8_LDB(dst, b, h) do { _Pragma("unroll") for (int n = 0; n < 2; ++n) _Pragma("unroll") for (int k = 0; k < 2; ++k) dst[n][k] = *(const LAS bf16x8*)(lds + PG8_SB(b, h) + boff + n * 2048 + k * 1024); } while (0)
#define PG8_MMA(ai, bj, At, Bt) do { __builtin_amdgcn_s_setprio(1); _Pragma("unroll") for (int m = 0; m < 4; ++m) _Pragma("unroll") for (int n = 0; n < 2; ++n) _Pragma("unroll") for (int k = 0; k < 2; ++k) \
        acc[ai][bj][m][n] = __builtin_amdgcn_mfma_f32_16x16x32_bf16(Bt[n][k], At[m][k], acc[ai][bj][m][n], 0, 0, 0); __builtin_amdgcn_s_setprio(0); } while (0)
#define PG8_WAIT_V(n) asm volatile("s_waitcnt vmcnt(" #n ")" ::: "memory")
#define PG8_WAIT_L(n) asm volatile("s_waitcnt lgkmcnt(" #n ")" ::: "memory")
#define PG8_BAR __builtin_amdgcn_s_barrier()
#define PG8_SCHED __builtin_amdgcn_sched_barrier(0)
    Unit cur, nxt; int ui = 0;
    if (!S.next(0, cur)) return;
    f32x4 acc[2][2][4][2];
#pragma unroll
    for (int a = 0; a < 2; ++a)
#pragma unroll
        for (int b = 0; b < 2; ++b)
#pragma unroll
            for (int m = 0; m < 4; ++m)
#pragma unroll
                for (int n = 0; n < 2; ++n) acc[a][b][m][n] = (f32x4){0.f, 0.f, 0.f, 0.f};
    bf16x8 At[4][2], B0[2][2], B1[2][2];
    const char* cA = cur.a; const char* cB = cur.b;
    if constexpr (GATHER) S.gather(cur, vA, sR, sC, K);
    PG8_STAGE(PG8_SB(0, 0), cB, voffB); PG8_STAGE(PG8_SB(0, 1), cB + hstep, voffB); PG8_STAGE(PG8_SA(0, 0), cA, vA[0]); PG8_STAGE(PG8_SA(0, 1), cA, vA[1]);
    if (wr == 1) PG8_BAR;
    PG8_WAIT_V(2); PG8_BAR;
    PG8_STAGE(PG8_SB(1, 0), cB + kstep, voffB); PG8_STAGE(PG8_SA(1, 0), cA + kstep, vA[0]); PG8_STAGE(PG8_SB(1, 1), cB + hstep + kstep, voffB);
    PG8_WAIT_V(6); PG8_BAR;
    for (;;) {
        const bool has_next = S.next(ui + 1, nxt);
        const char* nA = has_next ? nxt.a : cA; const char* nB = has_next ? nxt.b : cB;
        if constexpr (GATHER) {
            if (has_next) S.gather(nxt, vAn, sR, sC, K);
            else { vAn[0][0] = vA[0][0]; vAn[0][1] = vA[0][1]; vAn[1][0] = vA[1][0]; vAn[1][1] = vA[1][1]; }
        }
        for (int t = 0; t < nt; t += 2) {
            const bool last = (t == nt - 2);
            const char* a1 = cA + (size_t)(t + 1) * kstep;
            const char* a2 = last ? nA : cA + (size_t)(t + 2) * kstep; const char* b2 = last ? nB : cB + (size_t)(t + 2) * kstep;
            const char* a3 = a2 + kstep; const char* b3 = b2 + kstep;
            unsigned w0[2], w1[2];
            if constexpr (GATHER) { w0[0] = last ? vAn[0][0] : vA[0][0]; w0[1] = last ? vAn[0][1] : vA[0][1]; w1[0] = last ? vAn[1][0] : vA[1][0]; w1[1] = last ? vAn[1][1] : vA[1][1]; }
            else { w0[0] = vA[0][0]; w0[1] = vA[0][1]; w1[0] = vA[1][0]; w1[1] = vA[1][1]; }
            PG8_LDB(B0, 0, 0); PG8_LDB(B1, 0, 1); PG8_SCHED; PG8_LDA(At, 0, 0); PG8_STAGE(PG8_SA(1, 1), a1, vA[1]);
            PG8_WAIT_V(8); PG8_WAIT_L(0); PG8_BAR; PG8_MMA(0, 0, At, B0); PG8_MMA(0, 1, At, B1); PG8_BAR; PG8_SCHED;
            PG8_LDA(At, 0, 1); PG8_STAGE(PG8_SB(0, 0), b2, voffB); PG8_STAGE(PG8_SB(0, 1), b2 + hstep, voffB); PG8_STAGE(PG8_SA(0, 0), a2, w0);
            PG8_WAIT_V(8); PG8_WAIT_L(0); PG8_BAR; PG8_MMA(1, 0, At, B0); PG8_MMA(1, 1, At, B1); PG8_BAR; PG8_SCHED;
            PG8_LDB(B0, 1, 0); PG8_LDB(B1, 1, 1); PG8_SCHED; PG8_LDA(At, 1, 0); PG8_STAGE(PG8_SA(0, 1), a2, w1);
            PG8_WAIT_V(8); PG8_WAIT_L(0); PG8_BAR; PG8_MMA(0, 0, At, B0); PG8_MMA(0, 1, At, B1); PG8_BAR; PG8_SCHED;
            PG8_LDA(At, 1, 1); PG8_STAGE(PG8_SB(1, 0), b3, voffB); PG8_STAGE(PG8_SB(1, 1), b3 + hstep, voffB); PG8_STAGE(PG8_SA(1, 0), a3, w0);
            PG8_WAIT_V(8); PG8_WAIT_L(0); PG8_BAR; PG8_MMA(1, 0, At, B0); PG8_MMA(1, 1, At, B1); PG8_BAR; PG8_SCHED;
        }
        if (wr == 0) PG8_BAR;
        E(acc, cur, wr, wc, fr, fq);
        if (!has_next) break;
#pragma unroll
        for (int a = 0; a < 2; ++a)
#pragma unroll
            for (int b = 0; b < 2; ++b)
#pragma unroll
                for (int m = 0; m < 4; ++m)
#pragma unroll
                    for (int n = 0; n < 2; ++n) acc[a][b][m][n] = (f32x4){0.f, 0.f, 0.f, 0.f};
        cur = nxt; cA = nA; cB = nB; ++ui;
        if constexpr (GATHER) { vA[0][0] = vAn[0][0]; vA[0][1] = vAn[0][1]; vA[1][0] = vAn[1][0]; vA[1][1] = vAn[1][1]; }
        if (wr == 1) PG8_BAR;
    }
    PG8_WAIT_V(0);
    PG8_BAR;
#undef PG8_SA
#undef PG8_SB
#undef PG8_STAGE
#undef PG8_LDA
#undef PG8_LDB
#undef PG8_MMA
#undef PG8_WAIT_V
#undef PG8_WAIT_L
#undef PG8_BAR
#undef PG8_SCHED
}

#define EPI_ROWS(u, ai, m) ((u).row0 + (ai) * HALF + wr * 64 + (m) * 16 + fr)
struct EpiBf16 {
    static constexpr bool PERM = true;
    bf16* O; int ldc; float* iw;
    __device__ __forceinline__ void operator()(const f32x4 (&acc)[2][2][4][2], const Unit& u, int wr, int wc, int fr, int fq) const {
#pragma unroll
        for (int ai = 0; ai < 2; ++ai)
#pragma unroll
            for (int m = 0; m < 4; ++m) { const int row = EPI_ROWS(u, ai, m); bf16* rowp = O + (size_t)row * ldc + u.col0 + wc * 32 + 8 * fq;
#pragma unroll
                for (int bj = 0; bj < 2; ++bj) { const f32x4 v0 = acc[ai][bj][m][0], v1 = acc[ai][bj][m][1];
                    u32x4 w; w.x = cvt_pk_bf16(v0[0], v0[1]); w.y = cvt_pk_bf16(v0[2], v0[3]); w.z = cvt_pk_bf16(v1[0], v1[1]); w.w = cvt_pk_bf16(v1[2], v1[3]);
                    *(u32x4*)(rowp + bj * HALF) = w; }
                if (iw != nullptr && u.col0 == 1792 && wc == 2 && fq == 0) *(f32x4*)(iw + (size_t)row * 4) = acc[ai][0][m][0] * 0.0625f; }
    }
};
struct EpiResid {
    static constexpr bool PERM = false;
    const bf16* h; _Float16* t;
    __device__ __forceinline__ void operator()(const f32x4 (&acc)[2][2][4][2], const Unit& u, int wr, int wc, int fr, int fq) const {
#pragma unroll
        for (int ai = 0; ai < 2; ++ai)
#pragma unroll
            for (int m = 0; m < 4; ++m) { const size_t o = (size_t)EPI_ROWS(u, ai, m) * D_MODEL + u.col0 + wc * 32 + 4 * fq;
#pragma unroll
                for (int bj = 0; bj < 2; ++bj)
#pragma unroll
                    for (int n = 0; n < 2; ++n) { const size_t oo = o + bj * HALF + n * 16; const u32x2 hq = *(const u32x2*)(h + oo); const f32x4 hv = {bflo(hq.x), bfhi(hq.x), bflo(hq.y), bfhi(hq.y)}; const f32x4 tv = hv * ALPHA_F + acc[ai][bj][m][n]; *(f16x4*)(t + oo) = (f16x4){(_Float16)tv[0], (_Float16)tv[1], (_Float16)tv[2], (_Float16)tv[3]}; } }
    }
};
struct EpiPle {
    static constexpr bool PERM = false;
    const bf16* h; const bf16* pl; _Float16* t;
    __device__ __forceinline__ void operator()(const f32x4 (&acc)[2][2][4][2], const Unit& u, int wr, int wc, int fr, int fq) const {
#pragma unroll
        for (int ai = 0; ai < 2; ++ai)
#pragma unroll
            for (int m = 0; m < 4; ++m) { const size_t o = (size_t)EPI_ROWS(u, ai, m) * D_MODEL + u.col0 + wc * 32 + 4 * fq;
#pragma unroll
                for (int bj = 0; bj < 2; ++bj)
#pragma unroll
                    for (int n = 0; n < 2; ++n) { const size_t oo = o + bj * HALF + n * 16; const u32x2 hq = *(const u32x2*)(h + oo); const f32x4 hv = {bflo(hq.x), bfhi(hq.x), bflo(hq.y), bfhi(hq.y)}; const u32x2 pv = *(const u32x2*)(pl + oo);
                        const f32x4 a = acc[ai][bj][m][n]; f32x4 r;
                        r[0] = fmaf(hv[0], ALPHA_F, bflo(pv.x) * __builtin_amdgcn_rcpf(1.f + __builtin_amdgcn_exp2f(a[0] * -1.4426950408889634f))); r[1] = fmaf(hv[1], ALPHA_F, bfhi(pv.x) * __builtin_amdgcn_rcpf(1.f + __builtin_amdgcn_exp2f(a[1] * -1.4426950408889634f)));
                        r[2] = fmaf(hv[2], ALPHA_F, bflo(pv.y) * __builtin_amdgcn_rcpf(1.f + __builtin_amdgcn_exp2f(a[2] * -1.4426950408889634f))); r[3] = fmaf(hv[3], ALPHA_F, bfhi(pv.y) * __builtin_amdgcn_rcpf(1.f + __builtin_amdgcn_exp2f(a[3] * -1.4426950408889634f)));
                        *(f16x4*)(t + oo) = (f16x4){(_Float16)r[0], (_Float16)r[1], (_Float16)r[2], (_Float16)r[3]}; } }
    }
};
struct EpiSwiglu {
    static constexpr bool PERM = true;
    bf16* act;
    __device__ __forceinline__ void operator()(const f32x4 (&acc)[2][2][4][2], const Unit& u, int wr, int wc, int fr, int fq) const {
#pragma unroll
        for (int ai = 0; ai < 2; ++ai)
#pragma unroll
            for (int m = 0; m < 4; ++m) { const int row = EPI_ROWS(u, ai, m); float r[8];
#pragma unroll
                for (int n = 0; n < 2; ++n)
#pragma unroll
                    for (int j = 0; j < 4; ++j) { const float g = acc[ai][0][m][n][j], uu = acc[ai][1][m][n][j]; r[n * 4 + j] = g * __builtin_amdgcn_rcpf(1.f + __builtin_amdgcn_exp2f(g * -1.4426950408889634f)) * uu; }
                u32x4 w; w.x = cvt_pk_bf16(r[0], r[1]); w.y = cvt_pk_bf16(r[2], r[3]); w.z = cvt_pk_bf16(r[4], r[5]); w.w = cvt_pk_bf16(r[6], r[7]);
                *(u32x4*)(act + (size_t)row * D_EXPERT + u.col0 * 128 + wc * 32 + 8 * fq) = w; }
    }
};
struct EpiMoeDown {
    static constexpr bool PERM = true;
    bf16* Y;
    __device__ __forceinline__ void operator()(const f32x4 (&acc)[2][2][4][2], const Unit& u, int wr, int wc, int fr, int fq) const {
#pragma unroll
        for (int ai = 0; ai < 2; ++ai)
#pragma unroll
            for (int m = 0; m < 4; ++m) { const int row = EPI_ROWS(u, ai, m); bf16* rowp = Y + (size_t)row * D_MODEL + u.col0 * 256 + wc * 32 + 8 * fq;
#pragma unroll
                for (int bj = 0; bj < 2; ++bj) { const f32x4 v0 = acc[ai][bj][m][0], v1 = acc[ai][bj][m][1];
                    u32x4 w; w.x = cvt_pk_bf16(v0[0], v0[1]); w.y = cvt_pk_bf16(v0[2], v0[3]); w.z = cvt_pk_bf16(v1[0], v1[1]); w.w = cvt_pk_bf16(v1[2], v1[3]);
                    *(u32x4*)(rowp + bj * HALF) = w; } }
    }
};
}

struct Params { const float* in[18]; float* out; unsigned char* ws; int ph_lo, ph_hi, bar_idx, pad; };
typedef const Params __attribute__((address_space(4)))* KP;
__device__ __forceinline__ KP fresh_params() { KP p = (KP)__builtin_amdgcn_kernarg_segment_ptr(); asm volatile("" : "+s"(p)); return p; }

__device__ __forceinline__ void tr_item(const float* W, int K, int N, bf16* WT, int row_off, LAS float* scr, int kb, int nb, int lane) {
    const int k0 = 64 * kb, n0 = 32 * nb;
    const bool ok = (n0 + (lane & 31)) < N;
    if (n0 + 32 <= N) {
        const int kr = lane >> 3, c4 = (lane & 7) * 4;
#pragma unroll
        for (int i = 0; i < 8; ++i) { const int kk = 8 * i + kr; const f32x4 v = __builtin_nontemporal_load((const f32x4*)(W + (size_t)(k0 + kk) * N + n0 + c4));
            LAS float* d = scr + kk * 33 + c4; d[0] = v[0]; d[1] = v[1]; d[2] = v[2]; d[3] = v[3]; }
    } else {
#pragma unroll 8
        for (int i = 0; i < 32; ++i) { const int kk = 2 * i + (lane >> 5); scr[kk * 33 + (lane & 31)] = ok ? W[(size_t)(k0 + kk) * N + n0 + (lane & 31)] : 0.f; }
    }
    asm volatile("s_waitcnt lgkmcnt(0)" ::: "memory");
    const int c = lane & 7;
#pragma unroll
    for (int j = 0; j < 4; ++j) { const int n = (lane >> 3) + 8 * j; const LAS float* s = scr + (8 * c) * 33 + n;
        u32x4 o; o.x = cvt_pk_bf16(s[0 * 33], s[1 * 33]); o.y = cvt_pk_bf16(s[2 * 33], s[3 * 33]); o.z = cvt_pk_bf16(s[4 * 33], s[5 * 33]); o.w = cvt_pk_bf16(s[6 * 33], s[7 * 33]);
        *(u32x4*)(WT + (size_t)(row_off + n0 + n) * K + k0 + 8 * c) = o; }
    asm volatile("s_waitcnt lgkmcnt(0)" ::: "memory");
}
__device__ __forceinline__ void cvt_rows(const float* src, bf16* dst, size_t n4, int gtid, int gthreads) {
    size_t i = gtid;
    for (; i + 3 * (size_t)gthreads < n4; i += 4 * (size_t)gthreads) {
        f32x4 v[4];
#pragma unroll
        for (int u = 0; u < 4; ++u) v[u] = __builtin_nontemporal_load((const f32x4*)(src + (i + u * (size_t)gthreads) * 4));
#pragma unroll
        for (int u = 0; u < 4; ++u) { u32x2 o; o.x = cvt_pk_bf16(v[u][0], v[u][1]); o.y = cvt_pk_bf16(v[u][2], v[u][3]); *(u32x2*)(dst + (i + u * (size_t)gthreads) * 4) = o; }
    }
    for (; i < n4; i += gthreads) { const f32x4 v = *(const f32x4*)(src + i * 4); u32x2 o; o.x = cvt_pk_bf16(v[0], v[1]); o.y = cvt_pk_bf16(v[2], v[3]); *(u32x2*)(dst + i * 4) = o; }
}
__device__ __forceinline__ void phase_convert(KP P, int L, LAS unsigned char* lds) {
    int tz = threadIdx.x; asm volatile("" : "+v"(tz));
    const int tid = tz, lane = tid & 63, wave = tid >> 6;
    LAS float* scr = (LAS float*)(lds + wave * 17408);
    const int gw = blockIdx.x * NWAVES + wave, NGW = gridDim.x * NWAVES;
    unsigned char* ws = P->ws;
    bf16* wmix = (bf16*)(ws + WS_WMIX); bf16* wo_t = (bf16*)(ws + WS_WMIX + 4 * MiB); bf16* wkv_t = (bf16*)(ws + WS_WMIX + 6 * MiB);
    bf16* wpg_t = (bf16*)(ws + WS_WPG); bf16* wple_t = (bf16*)(ws + WS_WPLE); bf16* wgu_t = (bf16*)(ws + WS_WGU); bf16* wd_t = (bf16*)(ws + WS_WD);
    const bool isA = L < N_A; const int j = L - N_A;
    const float* w_first = isA ? P->in[2] + (size_t)L * D_MODEL * A_COLS : P->in[5] + (size_t)j * D_MODEL * D_MODEL;
    const int n_first = isA ? A_COLS : D_MODEL, nb_first = isA ? 64 : 32;
    const float* w_o = isA ? P->in[3] + (size_t)L * D_MODEL * D_MODEL : P->in[6] + (size_t)j * D_MODEL * D_MODEL;
    const int I_FIRST = 16 * nb_first, I_O = 16 * 32, I_KV = (L == N_A) ? 16 * 16 : 0, I_PG = 16 * 32, I_PLE = 4 * 32, I_G = 32 * 256, I_U = 32 * 256, I_D = 32 * 256;
    const int NITEMS = I_FIRST + I_O + I_KV + I_PG + I_PLE + I_G + I_U + I_D;
    const size_t wsz = (size_t)D_MODEL * D_EXPERT;
#define CV_DECODE(IT, W_, K_, N_, WT_, RO_, KB_, NB_) do { int r = (IT); \
        if (r < I_FIRST) { W_ = w_first; K_ = D_MODEL; N_ = n_first; WT_ = wmix; RO_ = 0; KB_ = r / nb_first; NB_ = r % nb_first; break; } r -= I_FIRST; \
        if (r < I_O) { W_ = w_o; K_ = D_MODEL; N_ = D_MODEL; WT_ = wo_t; RO_ = 0; KB_ = r / 32; NB_ = r % 32; break; } r -= I_O; \
        if (r < I_KV) { W_ = P->in[4]; K_ = D_MODEL; N_ = 512; WT_ = wkv_t; RO_ = 0; KB_ = r / 16; NB_ = r % 16; break; } r -= I_KV; \
        if (r < I_PG) { W_ = P->in[15] + (size_t)L * D_MODEL * D_MODEL; K_ = D_MODEL; N_ = D_MODEL; WT_ = wpg_t; RO_ = 0; KB_ = r / 32; NB_ = r % 32; break; } r -= I_PG; \
        if (r < I_PLE) { W_ = P->in[14] + (size_t)L * PLE_DIM * D_MODEL; K_ = PLE_DIM; N_ = D_MODEL; WT_ = wple_t; RO_ = 0; KB_ = r / 32; NB_ = r % 32; break; } r -= I_PLE; \
        if (r < I_G + I_U) { const bool up = r >= I_G; if (up) r -= I_G; const int e = r >> 8, rem = r & 255, n0 = (rem & 15) * 32; \
            W_ = (up ? P->in[12] : P->in[11]) + ((size_t)L * N_EXPERTS + e) * wsz; K_ = D_MODEL; N_ = D_EXPERT; WT_ = wgu_t + (size_t)e * D_MODEL * D_MODEL; \
            RO_ = (n0 >> 7) * 256 + (up ? 128 : 0) + (n0 & 127) - n0; KB_ = rem >> 4; NB_ = rem & 15; break; } \
        r -= I_G + I_U; { const int e = r >> 8, rem = r & 255; W_ = P->in[13] + ((size_t)L * N_EXPERTS + e) * wsz; K_ = D_EXPERT; N_ = D_MODEL; WT_ = wd_t + (size_t)e * wsz; RO_ = 0; KB_ = rem >> 5; NB_ = rem & 31; } } while (0)
    LAS float* scr2 = scr + 64 * 33;
    for (int it = gw; it < NITEMS; it += 2 * NGW) {
        const float* W0; int K0, N0, RO0, KB0, NB0; bf16* WT0; CV_DECODE(it, W0, K0, N0, WT0, RO0, KB0, NB0);
        const int it1 = it + NGW;
        if (it1 >= NITEMS) { tr_item(W0, K0, N0, WT0, RO0, scr, KB0, NB0, lane); continue; }
        const float* W1; int K1, N1, RO1, KB1, NB1; bf16* WT1; CV_DECODE(it1, W1, K1, N1, WT1, RO1, KB1, NB1);
        if (NB0 * 32 + 32 > N0 || NB1 * 32 + 32 > N1) { tr_item(W0, K0, N0, WT0, RO0, scr, KB0, NB0, lane); tr_item(W1, K1, N1, WT1, RO1, scr, KB1, NB1, lane); continue; }
        const int kr = lane >> 3, c4 = (lane & 7) * 4;
        f32x4 va[8], vb2[8];
#pragma unroll
        for (int i = 0; i < 8; ++i) { va[i] = __builtin_nontemporal_load((const f32x4*)(W0 + (size_t)(64 * KB0 + 8 * i + kr) * N0 + 32 * NB0 + c4)); vb2[i] = __builtin_nontemporal_load((const f32x4*)(W1 + (size_t)(64 * KB1 + 8 * i + kr) * N1 + 32 * NB1 + c4)); }
#pragma unroll
        for (int i = 0; i < 8; ++i) { LAS float* d = scr + (8 * i + kr) * 33 + c4; d[0] = va[i][0]; d[1] = va[i][1]; d[2] = va[i][2]; d[3] = va[i][3];
            LAS float* d2 = scr2 + (8 * i + kr) * 33 + c4; d2[0] = vb2[i][0]; d2[1] = vb2[i][1]; d2[2] = vb2[i][2]; d2[3] = vb2[i][3]; }
        asm volatile("s_waitcnt lgkmcnt(0)" ::: "memory");
        { const int c = lane & 7;
#pragma unroll
          for (int jj = 0; jj < 4; ++jj) { const int n = (lane >> 3) + 8 * jj; const LAS float* s0 = scr + (8 * c) * 33 + n; const LAS float* s1 = scr2 + (8 * c) * 33 + n;
              u32x4 o0, o1; o0.x = cvt_pk_bf16(s0[0 * 33], s0[1 * 33]); o0.y = cvt_pk_bf16(s0[2 * 33], s0[3 * 33]); o0.z = cvt_pk_bf16(s0[4 * 33], s0[5 * 33]); o0.w = cvt_pk_bf16(s0[6 * 33], s0[7 * 33]);
              o1.x = cvt_pk_bf16(s1[0 * 33], s1[1 * 33]); o1.y = cvt_pk_bf16(s1[2 * 33], s1[3 * 33]); o1.z = cvt_pk_bf16(s1[4 * 33], s1[5 * 33]); o1.w = cvt_pk_bf16(s1[6 * 33], s1[7 * 33]);
              *(u32x4*)(WT0 + (size_t)(RO0 + 32 * NB0 + n) * K0 + 64 * KB0 + 8 * c) = o0; *(u32x4*)(WT1 + (size_t)(RO1 + 32 * NB1 + n) * K1 + 64 * KB1 + 8 * c) = o1; } }
        asm volatile("s_waitcnt lgkmcnt(0)" ::: "memory");
    }
#undef CV_DECODE
    const int gtid = blockIdx.x * 512 + tid, gthreads = gridDim.x * 512;
    { const float* wrg = P->in[7] + (size_t)L * D_MODEL * N_GROUPS; const float* wre = P->in[9] + (size_t)L * D_MODEL * N_EXPERTS; float* wrt = (float*)(ws + WS_WPLE + 1 * MiB);
      for (int i = gtid; i < D_MODEL * 36; i += gthreads) { const int c = i >> 10, k = i & 1023; wrt[i] = (c < 4) ? wrg[k * 4 + c] : wre[k * 32 + (c - 4)]; } }
    cvt_rows(P->in[1] + (size_t)L * NTOK * PLE_DIM, (bf16*)(ws + WS_PB), (size_t)NTOK * PLE_DIM / 4, gtid, gthreads);
    if (L == 0) cvt_rows(P->in[0], (bf16*)(ws + WS_HB), (size_t)NTOK * D_MODEL / 4, gtid, gthreads);
}

template <int SRC, bool ROUTER>
__device__ __forceinline__ void phase_ln(KP P, int L, int which, LAS unsigned char* lds, float* dst_f32, bool write_hb, int cidx = -1) {
    int tz = threadIdx.x; asm volatile("" : "+v"(tz)); const int tid = tz, lane = tid & 63, wave = tid >> 6;
    unsigned char* ws = P->ws;
    const _Float16* t = (const _Float16*)(ws + WS_T); bf16* hb = (bf16*)(ws + WS_HB);
    const bf16* Y = (const bf16*)(ws + WS_Y);
    const int* moe = (const int*)(ws + WS_MOE);
    const float* g = P->in[16] + (size_t)(L * 3 + which) * D_MODEL; const float* bt = P->in[17] + (size_t)(L * 3 + which) * D_MODEL;
    f32x4 gv[4], bv[4];
#pragma unroll
    for (int j = 0; j < 4; ++j) { gv[j] = *(const f32x4*)(g + 4 * lane + 256 * j); bv[j] = *(const f32x4*)(bt + 4 * lane + 256 * j); }
    const int gw = blockIdx.x * NWAVES + wave, NGW = gridDim.x * NWAVES;
    for (int pi = gw; pi < NTOK / 2; pi += NGW) {
        const int row0 = pi * 2;
        f32x4 v[2][4];
        if (SRC == 0) {
            f16x4 tv[2][4];
#pragma unroll
            for (int u = 0; u < 2; ++u)
#pragma unroll
                for (int j = 0; j < 4; ++j) tv[u][j] = __builtin_nontemporal_load((const f16x4*)(t + (size_t)(row0 + u) * D_MODEL + 4 * lane + 256 * j));
#pragma unroll
            for (int u = 0; u < 2; ++u)
#pragma unroll
                for (int j = 0; j < 4; ++j) v[u][j] = (f32x4){(float)tv[u][j][0], (float)tv[u][j][1], (float)tv[u][j][2], (float)tv[u][j][3]};
        } else {
            int sl[2][2]; float wq[2][2]; u32x2 hv[2][4]; u32x2 y0[2][4], y1[2][4];
#pragma unroll
            for (int u = 0; u < 2; ++u) { sl[u][0] = moe[MO_TOK_SLOT + (row0 + u) * 2]; sl[u][1] = moe[MO_TOK_SLOT + (row0 + u) * 2 + 1];
                wq[u][0] = ((const float*)moe)[MO_TOK_W + (row0 + u) * 2]; wq[u][1] = ((const float*)moe)[MO_TOK_W + (row0 + u) * 2 + 1];
#pragma unroll
                for (int j = 0; j < 4; ++j) hv[u][j] = *(const u32x2*)(hb + (size_t)(row0 + u) * D_MODEL + 4 * lane + 256 * j); }
#pragma unroll
            for (int u = 0; u < 2; ++u)
#pragma unroll
                for (int j = 0; j < 4; ++j) { y0[u][j] = *(const u32x2*)(Y + (size_t)sl[u][0] * D_MODEL + 4 * lane + 256 * j); y1[u][j] = *(const u32x2*)(Y + (size_t)sl[u][1] * D_MODEL + 4 * lane + 256 * j); }
#pragma unroll
            for (int u = 0; u < 2; ++u)
#pragma unroll
                for (int j = 0; j < 4; ++j) { const float w0 = wq[u][0], w1 = wq[u][1];
                    v[u][j][0] = bflo(hv[u][j].x) * ALPHA_F + (w0 * bflo(y0[u][j].x) + w1 * bflo(y1[u][j].x)); v[u][j][1] = bfhi(hv[u][j].x) * ALPHA_F + (w0 * bfhi(y0[u][j].x) + w1 * bfhi(y1[u][j].x));
                    v[u][j][2] = bflo(hv[u][j].y) * ALPHA_F + (w0 * bflo(y0[u][j].y) + w1 * bflo(y1[u][j].y)); v[u][j][3] = bfhi(hv[u][j].y) * ALPHA_F + (w0 * bfhi(y0[u][j].y) + w1 * bfhi(y1[u][j].y)); }
        }
#pragma unroll
        for (int u = 0; u < 2; ++u) {
            const int row = row0 + u;
            float s = 0.f;
#pragma unroll
            for (int j = 0; j < 4; ++j) s += (v[u][j][0] + v[u][j][1]) + (v[u][j][2] + v[u][j][3]);
            const float mean = wave_sum(s) * (1.f / D_MODEL);
            float q = 0.f;
#pragma unroll
            for (int j = 0; j < 4; ++j) { v[u][j] = v[u][j] - mean; q += (v[u][j][0] * v[u][j][0] + v[u][j][1] * v[u][j][1]) + (v[u][j][2] * v[u][j][2] + v[u][j][3] * v[u][j][3]); }
            const float rstd = rsqrtf(wave_sum(q) * (1.f / D_MODEL) + LN_EPS);
#pragma unroll
            for (int j = 0; j < 4; ++j) { v[u][j] = v[u][j] * rstd * gv[j] + bv[j]; if (dst_f32 != nullptr) *(f32x4*)(dst_f32 + (size_t)row * D_MODEL + 4 * lane + 256 * j) = v[u][j]; }
            if (write_hb) {
#pragma unroll
                for (int j = 0; j < 4; ++j) { u32x2 o; o.x = cvt_pk_bf16(v[u][j][0], v[u][j][1]); o.y = cvt_pk_bf16(v[u][j][2], v[u][j][3]); *(u32x2*)(hb + (size_t)row * D_MODEL + 4 * lane + 256 * j) = o; }
            }
        }
    }
    (void)lds; (void)cidx;
}

__device__ __forceinline__ void phase_ln_router(KP P, int L, LAS unsigned char* lds, int cidx) {
    int tz = threadIdx.x; asm volatile("" : "+v"(tz)); const int tid = tz, lane = tid & 63, wave = tid >> 6;
    unsigned char* ws = P->ws;
    const _Float16* t = (const _Float16*)(ws + WS_T); bf16* hb = (bf16*)(ws + WS_HB);
    int* moe = (int*)(ws + WS_MOE);
    const float* g = P->in[16] + (size_t)(L * 3) * D_MODEL; const float* bt = P->in[17] + (size_t)(L * 3) * D_MODEL;
    LAS float* Wl = (LAS float*)lds;
    LAS float* lgs = (LAS float*)(lds + 147456) + wave * 80;
    LAS int* lcnt = (LAS int*)(lds + 150016);
    LAS int* rinfo = (LAS int*)(lds + 150272);
    { const f32x4* wrt = (const f32x4*)(ws + WS_WPLE + 1 * MiB);
      for (int i = tid; i < D_MODEL * 36 / 4; i += 512) ((LAS f32x4*)Wl)[i] = wrt[i];
      if (tid < 64) lcnt[tid] = 0; }
    __syncthreads();
    f32x4 gv[4], bv[4];
#pragma unroll
    for (int j = 0; j < 4; ++j) { gv[j] = *(const f32x4*)(g + 4 * lane + 256 * j); bv[j] = *(const f32x4*)(bt + 4 * lane + 256 * j); }
    const float* brg = P->in[8] + L * N_GROUPS; const float* bre = P->in[10] + L * N_EXPERTS;
    const int gw = blockIdx.x * NWAVES + wave, NGW = gridDim.x * NWAVES;
    int it = 0;
    for (int pi = gw; pi < NTOK / 2; pi += NGW, ++it) {
        const int row0 = pi * 2;
        f32x4 va[4], vb[4];
#pragma unroll
        for (int j = 0; j < 4; ++j) { const f16x4 ta = __builtin_nontemporal_load((const f16x4*)(t + (size_t)row0 * D_MODEL + 4 * lane + 256 * j)), tb2 = __builtin_nontemporal_load((const f16x4*)(t + (size_t)(row0 + 1) * D_MODEL + 4 * lane + 256 * j));
            va[j] = (f32x4){(float)ta[0], (float)ta[1], (float)ta[2], (float)ta[3]}; vb[j] = (f32x4){(float)tb2[0], (float)tb2[1], (float)tb2[2], (float)tb2[3]}; }
        float sa = 0.f, sb = 0.f;
#pragma unroll
        for (int j = 0; j < 4; ++j) { sa += (va[j][0] + va[j][1]) + (va[j][2] + va[j][3]); sb += (vb[j][0] + vb[j][1]) + (vb[j][2] + vb[j][3]); }
        const float ma = wave_sum(sa) * (1.f / D_MODEL), mb_ = wave_sum(sb) * (1.f / D_MODEL);
        float qa = 0.f, qb = 0.f;
#pragma unroll
        for (int j = 0; j < 4; ++j) { va[j] = va[j] - ma; vb[j] = vb[j] - mb_;
            qa += (va[j][0] * va[j][0] + va[j][1] * va[j][1]) + (va[j][2] * va[j][2] + va[j][3] * va[j][3]);
            qb += (vb[j][0] * vb[j][0] + vb[j][1] * vb[j][1]) + (vb[j][2] * vb[j][2] + vb[j][3] * vb[j][3]); }
        const float ra = rsqrtf(wave_sum(qa) * (1.f / D_MODEL) + LN_EPS), rb = rsqrtf(wave_sum(qb) * (1.f / D_MODEL) + LN_EPS);
#pragma unroll
        for (int j = 0; j < 4; ++j) { va[j] = va[j] * ra * gv[j] + bv[j]; vb[j] = vb[j] * rb * gv[j] + bv[j];
            u32x2 oa, ob; oa.x = cvt_pk_bf16(va[j][0], va[j][1]); oa.y = cvt_pk_bf16(va[j][2], va[j][3]); ob.x = cvt_pk_bf16(vb[j][0], vb[j][1]); ob.y = cvt_pk_bf16(vb[j][2], vb[j][3]);
            *(u32x2*)(hb + (size_t)row0 * D_MODEL + 4 * lane + 256 * j) = oa; *(u32x2*)(hb + (size_t)(row0 + 1) * D_MODEL + 4 * lane + 256 * j) = ob; }
#pragma unroll
        for (int p = 0; p < 18; ++p) {
            f32x2 a0 = {0.f, 0.f}, a1 = {0.f, 0.f};
#pragma unroll
            for (int j = 0; j < 4; ++j) { const f32x4 w0 = *(const LAS f32x4*)(Wl + (2 * p) * D_MODEL + 4 * lane + 256 * j), w1 = *(const LAS f32x4*)(Wl + (2 * p + 1) * D_MODEL + 4 * lane + 256 * j);
#pragma unroll
                for (int i = 0; i < 4; ++i) { const f32x2 y = {va[j][i], vb[j][i]}; a0 = a0 + y * w0[i]; a1 = a1 + y * w1[i]; } }
            float ra2[2];
#pragma unroll
            for (int rr = 0; rr < 2; ++rr) {
                auto sw = __builtin_amdgcn_permlane32_swap(__float_as_uint(rr ? a0.y : a0.x), __float_as_uint(rr ? a1.y : a1.x), false, false);
                float v = __uint_as_float(sw[0]) + __uint_as_float(sw[1]);
                v = row16_sum(v); v += __shfl_xor(v, 16); ra2[rr] = v; }
            if ((lane & 31) == 0) { const int ci = 2 * p + (lane >> 5); lgs[ci] = ra2[0]; lgs[40 + ci] = ra2[1]; }
            __builtin_amdgcn_sched_barrier(0);
        }
        asm volatile("s_waitcnt lgkmcnt(0)" ::: "memory");
        if (lane == 0 || lane == 32) {
            const int rr = lane >> 5; LAS float* lg = lgs + rr * 40;
            float gl[4];
#pragma unroll
            for (int jj = 0; jj < 4; ++jj) gl[jj] = lg[jj] + brg[jj];
            int gs = 0; float gmax = gl[0];
#pragma unroll
            for (int jj = 1; jj < 4; ++jj) if (gl[jj] > gmax) { gmax = gl[jj]; gs = jj; }
            float den = 0.f;
#pragma unroll
            for (int jj = 0; jj < 4; ++jj) den += expf(gl[jj] - gmax);
            const float gwt = 1.f / den;
            float el[8];
#pragma unroll
            for (int jj = 0; jj < 8; ++jj) el[jj] = lg[4 + gs * 8 + jj] + bre[gs * 8 + jj];
            int i0 = 0; float v0 = el[0];
#pragma unroll
            for (int jj = 1; jj < 8; ++jj) if (el[jj] > v0) { v0 = el[jj]; i0 = jj; }
            int i1 = -1; float v1 = 0.f;
#pragma unroll
            for (int jj = 0; jj < 8; ++jj) if (jj != i0 && (i1 < 0 || el[jj] > v1)) { v1 = el[jj]; i1 = jj; }
            const float e1 = expf(v1 - v0);
            const float w0 = gwt / (1.f + e1), w1 = gwt * e1 / (1.f + e1);
            const int ea = gs * 8 + i0, eb = gs * 8 + i1;
            const int pa = __hip_atomic_fetch_add(lcnt + ea, 1, __ATOMIC_RELAXED, __HIP_MEMORY_SCOPE_WORKGROUP), pb2 = __hip_atomic_fetch_add(lcnt + eb, 1, __ATOMIC_RELAXED, __HIP_MEMORY_SCOPE_WORKGROUP);
            LAS int* ri = rinfo + ((it * NWAVES + wave) * 2 + rr) * 5;
            ri[0] = ea | (eb << 8); ri[1] = pa; ri[2] = pb2; ri[3] = __float_as_int(w0); ri[4] = __float_as_int(w1);
        }
    }
    __syncthreads();
    if (tid < 32) { const int n = lcnt[tid]; unsigned* cnt = (unsigned*)(ws + WS_CTL) + CW_CNT + cidx * 32; lcnt[32 + tid] = n ? (int)atomicAdd(&cnt[tid], (unsigned)n) : 0; }
    __syncthreads();
    for (int sl = tid; sl < it * NWAVES * 2; sl += 512) {
        const int i2 = sl / (NWAVES * 2), w2 = (sl >> 1) & (NWAVES - 1), rr = sl & 1;
        const int row = ((blockIdx.x * NWAVES + w2) + i2 * NGW) * 2 + rr;
        if (row < NTOK) { const LAS int* ri = rinfo + sl * 5; const int ea = ri[0] & 255, eb = ri[0] >> 8;
            moe[MO_TOK_E + row * 2] = ea; moe[MO_TOK_E + row * 2 + 1] = eb; moe[MO_TOK_POS + row * 2] = lcnt[32 + ea] + ri[1]; moe[MO_TOK_POS + row * 2 + 1] = lcnt[32 + eb] + ri[2];
            moe[MO_TOK_W + row * 2] = ri[3]; moe[MO_TOK_W + row * 2 + 1] = ri[4]; }
    }
}

__device__ __forceinline__ void phase_moe_prep(KP P, int L, LAS unsigned char* lds) {
    int tz = threadIdx.x; asm volatile("" : "+v"(tz));
    const int tid = tz;
    unsigned char* ws = P->ws; int* moe = (int*)(ws + WS_MOE);
    const unsigned* cnt = (const unsigned*)(ws + WS_CTL) + CW_CNT + L * 32;
    LAS int* sb = (LAS int*)lds;
    LAS int* sc = (LAS int*)lds + 64;
    if (tid < 32) sc[tid] = (int)cnt[tid];
    __syncthreads();
    if (tid == 0) { int s = 0; for (int e = 0; e < N_EXPERTS; ++e) { sb[e] = s; s += (sc[e] + 255) / 256 * 256; } sb[N_EXPERTS] = s; }
    __syncthreads();
    const int ntiles = sb[N_EXPERTS] / 256;
    if (blockIdx.x == 0) {
        if (tid == 0) *((unsigned*)(ws + WS_CTL) + CW_NTILES + L) = (unsigned)ntiles;
        for (int T = tid; T < ntiles; T += 512) {
            const int r = T * 256; int e = 0;
            for (int x = 0; x < N_EXPERTS; ++x) if (r >= sb[x] && r < sb[x + 1]) e = x;
            const int nv = sc[e] - (r - sb[e]);
            moe[MO_TILE_E + T] = e; moe[MO_TILE_ROW0 + T] = r; moe[MO_TILE_NV + T] = nv < 256 ? nv : 256;
        }
    }
    for (int a = blockIdx.x * 512 + tid; a < NTOK * 2; a += gridDim.x * 512) {
        const int slot = sb[moe[MO_TOK_E + a]] + moe[MO_TOK_POS + a];
        moe[MO_SLOT_TOK + slot] = a >> 1; moe[MO_TOK_SLOT + a] = slot;
    }
}


namespace mb {
typedef short s16x4 __attribute__((ext_vector_type(4)));
typedef float f32x16 __attribute__((ext_vector_type(16)));
constexpr int SHM_V = 64 * 128 * 2, SHM_K = 64 * 128 * 2, V_OFF = 0, K_OFF = 2 * SHM_V, PRE_OFF = 65536;
constexpr float SCALE = 0.08838834764831845f, LOG2E = 1.4426950408889634f, CC = SCALE * LOG2E, THRX = 8.f * LOG2E;
#define MB_KSWZ(row, colB) ((row) * 256 + ((colB) ^ (((row) & 7) << 4)))
__device__ __forceinline__ int v_st(int k, int c) { const int kk = (k & ~0xC) | ((k & 4) << 1) | ((k & 8) >> 1); return ((kk >> 3) * 4 + (c >> 5)) * 512 + ((kk & 7) * 32 + (c & 31)) * 2; }
__device__ __forceinline__ int v_rd_base(int lane) { return ((lane & 3) << 3) | (((lane >> 2) & 3) << 6) | (((lane >> 4) & 1) << 5) | (((lane >> 5) & 1) << 8); }
constexpr int v_rd_off(int d0, int ks, int half) { return d0 * 512 + ks * 4096 + half * 2048; }
template <int OFF> __device__ __forceinline__ s16x4 tr_read(int vb) { s16x4 r; asm volatile("ds_read_b64_tr_b16 %0, %1 offset:%2" : "=&v"(r) : "v"(vb), "i"(OFF) : "memory"); return r; }
#define MB_SBAR() __builtin_amdgcn_sched_barrier(0)

__device__ __forceinline__ void qkt(f32x16& p0, f32x16& p1, LAS unsigned char* Ks, const bf16x8 (&qr)[8], int r32, int hi) {
    p0 = f32x16{}; p1 = f32x16{};
#pragma unroll
    for (int d0 = 0; d0 < 8; ++d0) { const int cb = (d0 * 16 + hi * 8) * 2;
        const bf16x8 b0 = *(const LAS bf16x8*)(Ks + MB_KSWZ(r32, cb));
        const bf16x8 b1 = *(const LAS bf16x8*)(Ks + MB_KSWZ(32 + r32, cb));
        p0 = __builtin_amdgcn_mfma_f32_32x32x16_bf16(b0, qr[d0], p0, 0, 0, 0);
        p1 = __builtin_amdgcn_mfma_f32_32x32x16_bf16(b1, qr[d0], p1, 0, 0, 0); }
}
__device__ __forceinline__ void partialSM(f32x16& p0, f32x16& p1, float& m_reg, float& mn, float& alpha, float bias2, float tb4, bool own, int lim) {
#pragma unroll
    for (int r = 0; r < 16; ++r) { const float kc = (float)((r & 3) + 8 * (r >> 2));
        p0[r] = fmaf(p0[r], CC, fmaf(bias2, kc, tb4)); p1[r] = fmaf(p1[r], CC, fmaf(bias2, kc + 32.f, tb4)); }
    if (own) {
#pragma unroll
        for (int r = 0; r < 16; ++r) { const int kc = (r & 3) + 8 * (r >> 2); if (kc > lim) p0[r] = -INFINITY; if (kc + 32 > lim) p1[r] = -INFINITY; }
    }
    float pmax = p0[0];
#pragma unroll
    for (int r = 1; r < 16; ++r) pmax = fmaxf(pmax, p0[r]);
#pragma unroll
    for (int r = 0; r < 16; ++r) pmax = fmaxf(pmax, p1[r]);
    { auto rr = __builtin_amdgcn_permlane32_swap(__float_as_uint(pmax), __float_as_uint(pmax), false, false); pmax = fmaxf(__uint_as_float(rr[0]), __uint_as_float(rr[1])); }
    if (__builtin_expect(__all(pmax - m_reg <= THRX), 1)) { mn = m_reg; alpha = 1.f; }
    else { mn = fmaxf(m_reg, pmax); alpha = __builtin_amdgcn_exp2f(m_reg - mn); m_reg = mn; }
#pragma unroll
    for (int r = 0; r < 16; ++r) { p0[r] = p0[r] - mn; p1[r] = p1[r] - mn; }
#pragma unroll
    for (int r = 0; r < 16; ++r) p0[r] = __builtin_amdgcn_exp2f(p0[r]);
}
__device__ __forceinline__ void finishSM(f32x16& p0, f32x16& p1, float alpha, float& l_reg, bf16x8& pa0, bf16x8& pa1, bf16x8& pa2, bf16x8& pa3) {
#pragma unroll
    for (int r = 0; r < 16; ++r) p1[r] = __builtin_amdgcn_exp2f(p1[r]);
    float ps = 0.f;
#pragma unroll
    for (int r = 0; r < 16; ++r) ps += p0[r];
#pragma unroll
    for (int r = 0; r < 16; ++r) ps += p1[r];
    { auto rr = __builtin_amdgcn_permlane32_swap(__float_as_uint(ps), __float_as_uint(ps), false, false); ps = __uint_as_float(rr[0]) + __uint_as_float(rr[1]); }
    l_reg = l_reg * alpha + ps;
#define MB_PK4(P, BASE, OUT) do { unsigned a0 = cvt_pk_bf16(P[BASE + 0], P[BASE + 1]), a1 = cvt_pk_bf16(P[BASE + 2], P[BASE + 3]); \
    unsigned b0 = cvt_pk_bf16(P[BASE + 4], P[BASE + 5]), b1 = cvt_pk_bf16(P[BASE + 6], P[BASE + 7]); \
    auto r0 = __builtin_amdgcn_permlane32_swap(a0, b0, false, false); auto r1 = __builtin_amdgcn_permlane32_swap(a1, b1, false, false); \
    u32x4 w = {r0[0], r1[0], r0[1], r1[1]}; OUT = *reinterpret_cast<bf16x8*>(&w); } while (0)
    MB_PK4(p0, 0, pa0); MB_PK4(p0, 8, pa1); MB_PK4(p1, 0, pa2); MB_PK4(p1, 8, pa3);
#undef MB_PK4
}
template <int D0> __device__ __forceinline__ void pv_one(f32x16& od, int vb, bf16x8 pa0, bf16x8 pa1, bf16x8 pa2, bf16x8 pa3) {
    const s16x4 l0 = tr_read<v_rd_off(D0, 0, 0)>(vb), h0 = tr_read<v_rd_off(D0, 0, 1)>(vb), l1 = tr_read<v_rd_off(D0, 1, 0)>(vb), h1 = tr_read<v_rd_off(D0, 1, 1)>(vb);
    const s16x4 l2 = tr_read<v_rd_off(D0, 2, 0)>(vb), h2 = tr_read<v_rd_off(D0, 2, 1)>(vb), l3 = tr_read<v_rd_off(D0, 3, 0)>(vb), h3 = tr_read<v_rd_off(D0, 3, 1)>(vb);
    asm volatile("s_waitcnt lgkmcnt(0)" ::: "memory"); MB_SBAR();
#define MB_PK(L, H) (bf16x8){L[0], L[1], L[2], L[3], H[0], H[1], H[2], H[3]}
    od = __builtin_amdgcn_mfma_f32_32x32x16_bf16(MB_PK(l0, h0), pa0, od, 0, 0, 0);
    od = __builtin_amdgcn_mfma_f32_32x32x16_bf16(MB_PK(l1, h1), pa1, od, 0, 0, 0);
    od = __builtin_amdgcn_mfma_f32_32x32x16_bf16(MB_PK(l2, h2), pa2, od, 0, 0, 0);
    od = __builtin_amdgcn_mfma_f32_32x32x16_bf16(MB_PK(l3, h3), pa3, od, 0, 0, 0);
#undef MB_PK
}
__device__ __forceinline__ void pv_d0(f32x16 (&o)[4], int vb, bf16x8 pa0, bf16x8 pa1, bf16x8 pa2, bf16x8 pa3) {
    pv_one<0>(o[0], vb, pa0, pa1, pa2, pa3); pv_one<1>(o[1], vb, pa0, pa1, pa2, pa3); pv_one<2>(o[2], vb, pa0, pa1, pa2, pa3); pv_one<3>(o[3], vb, pa0, pa1, pa2, pa3);
}

__device__ __forceinline__ void item(const bf16* __restrict__ q, const bf16* __restrict__ kv, bf16* __restrict__ part_o, float* __restrict__ part_ml, LAS unsigned char* lds,
                                     int tid, int b, int g, int kblk, int NT, bool own, int t, int rh, int slot, bool valid) {
    const int lane = tid & 63, r32 = lane & 31, hi = lane >> 5;
    const int h = g * 4 + rh;
    const bf16* Kh = kv + (size_t)(b * SEQ + kblk * MOBA_BLOCK) * 512 + g * HEAD_DIM;
    float m_reg = -1e30f, l_reg = 0.f; f32x16 o[4] = {}; bf16x8 qr[8];
    { const bf16* Qw = q + (size_t)(b * SEQ + t) * D_MODEL + h * HEAD_DIM + hi * 8;
#pragma unroll
      for (int d0 = 0; d0 < 8; ++d0) qr[d0] = *(const bf16x8*)(Qw + d0 * 16); }
    const float bias2 = __builtin_amdgcn_exp2f(-(float)(h + 1)) * LOG2E;
    const int trel = t - kblk * MOBA_BLOCK;
    const float tb4 = bias2 * (float)(4 * hi - trel);
    const int lim0 = trel - 4 * hi;
    const int sr = tid >> 4, sc = (tid & 15) * 8, vst0 = v_st(sr, sc), vst1 = v_st(32 + sr, sc);
    const int vb0 = (int)(unsigned)(uintptr_t)(lds + V_OFF) + v_rd_base(lane);
    bf16x8 vsA0, vsA1, ksA0, ksA1, vsB0, vsB1, ksB0, ksB1;
    const unsigned vo0 = (unsigned)(sr * 512 + sc) * 2u, vo1 = vo0 + 32u * 1024u;
    const char* KhB = (const char*)Kh;
#define MB_SLOAD_A(k0) do { const char* kt_ = KhB + (size_t)(k0) * 1024; vsA0 = *(const bf16x8*)(kt_ + 512 + vo0); vsA1 = *(const bf16x8*)(kt_ + 512 + vo1); \
        ksA0 = *(const bf16x8*)(kt_ + vo0); ksA1 = *(const bf16x8*)(kt_ + vo1); } while (0)
#define MB_SLOAD_B(k0) do { const char* kt_ = KhB + (size_t)(k0) * 1024; vsB0 = *(const bf16x8*)(kt_ + 512 + vo0); vsB1 = *(const bf16x8*)(kt_ + 512 + vo1); \
        ksB0 = *(const bf16x8*)(kt_ + vo0); ksB1 = *(const bf16x8*)(kt_ + vo1); } while (0)
#define MB_SWRITE(bb, V0, V1, K0, K1) do { *(LAS bf16x8*)(lds + V_OFF + (bb) * SHM_V + vst0) = V0; *(LAS bf16x8*)(lds + V_OFF + (bb) * SHM_V + vst1) = V1; \
        *(LAS bf16x8*)(lds + K_OFF + (bb) * SHM_K + MB_KSWZ(sr, sc * 2)) = K0; *(LAS bf16x8*)(lds + K_OFF + (bb) * SHM_K + MB_KSWZ(32 + sr, sc * 2)) = K1; } while (0)
#define MB_SWAIT() asm volatile("s_waitcnt vmcnt(4)" ::: "memory")
#define MB_RESC(a) do { if (__any((a) < 1.f)) { _Pragma("unroll") for (int d = 0; d < 4; ++d) _Pragma("unroll") for (int r = 0; r < 16; ++r) o[d][r] *= (a); } } while (0)
#define MB_PSM(P0, P1, MN, AL, tile) partialSM(P0, P1, m_reg, MN, AL, bias2, tb4 + bias2 * (float)((tile) * 64), own, lim0 - (tile) * 64)
    f32x16 pA0, pA1, pB0, pB1; float mnA, mnB, alA, alB; bf16x8 pa0, pa1, pa2, pa3;
    MB_SLOAD_A(0); asm volatile("s_waitcnt vmcnt(0)" ::: "memory"); MB_SWRITE(0, vsA0, vsA1, ksA0, ksA1); __syncthreads();
    qkt(pA0, pA1, lds + K_OFF, qr, r32, hi); MB_PSM(pA0, pA1, mnA, alA, 0);
    MB_SLOAD_B(64); if (2 < NT) MB_SLOAD_A(128);
    MB_SWAIT(); MB_SWRITE(1, vsB0, vsB1, ksB0, ksB1); __syncthreads();
    for (int j = 1; j + 1 < NT; j += 2) {
        MB_SBAR(); qkt(pB0, pB1, lds + K_OFF + SHM_K, qr, r32, hi);
        finishSM(pA0, pA1, alA, l_reg, pa0, pa1, pa2, pa3); MB_SBAR();
        MB_SLOAD_B((j + 2) * 64); MB_SBAR();
        pv_d0(o, vb0, pa0, pa1, pa2, pa3); MB_PSM(pB0, pB1, mnB, alB, j);
        __syncthreads(); MB_SWAIT(); MB_SWRITE(0, vsA0, vsA1, ksA0, ksA1);
        MB_RESC(alB); __syncthreads();
        MB_SBAR(); qkt(pA0, pA1, lds + K_OFF, qr, r32, hi);
        finishSM(pB0, pB1, alB, l_reg, pa0, pa1, pa2, pa3); MB_SBAR();
        if (j + 3 < NT) MB_SLOAD_A((j + 3) * 64); MB_SBAR();
        pv_d0(o, vb0 + SHM_V, pa0, pa1, pa2, pa3); MB_PSM(pA0, pA1, mnA, alA, j + 1);
        __syncthreads(); MB_SWAIT(); MB_SWRITE(1, vsB0, vsB1, ksB0, ksB1);
        MB_RESC(alA); __syncthreads();
    }
    MB_SBAR(); qkt(pB0, pB1, lds + K_OFF + SHM_K, qr, r32, hi);
    finishSM(pA0, pA1, alA, l_reg, pa0, pa1, pa2, pa3); MB_SBAR();
    pv_d0(o, vb0, pa0, pa1, pa2, pa3); MB_PSM(pB0, pB1, mnB, alB, NT - 1);
    __syncthreads(); MB_RESC(alB);
    finishSM(pB0, pB1, alB, l_reg, pa0, pa1, pa2, pa3); MB_SBAR();
    pv_d0(o, vb0 + SHM_V, pa0, pa1, pa2, pa3);
    if (valid) {
        const float inv = 1.f / l_reg;
        const size_t rg = ((size_t)(b * SEQ + t) * N_HEADS + h) * 4 + slot;
        bf16* po = part_o + rg * HEAD_DIM + 4 * hi;
#pragma unroll
        for (int d0 = 0; d0 < 4; ++d0)
#pragma unroll
            for (int rq = 0; rq < 4; ++rq) { u32x2 w; w.x = cvt_pk_bf16(o[d0][rq * 4 + 0] * inv, o[d0][rq * 4 + 1] * inv); w.y = cvt_pk_bf16(o[d0][rq * 4 + 2] * inv, o[d0][rq * 4 + 3] * inv);
                *(u32x2*)(po + d0 * 32 + rq * 8) = w; }
        if (hi == 0) { f32x2 ml; ml.x = m_reg; ml.y = l_reg; *(f32x2*)(part_ml + rg * 2) = ml; }
    }
    __syncthreads();
#undef MB_SLOAD_A
#undef MB_SLOAD_B
#undef MB_SWRITE
#undef MB_SWAIT
#undef MB_RESC
#undef MB_PSM
}
}

constexpr size_t WS_SELB = WS_T;
constexpr size_t WS_PML = WS_T + 2 * MiB;
constexpr size_t WS_LISTS = WS_T + 16 * MiB;
constexpr size_t WS_PARTO = WS_SCORES;
constexpr int CW_LCNT = 16384 + 512;

__device__ __forceinline__ void phase_kmeans(KP P) {
    int tz = threadIdx.x; asm volatile("" : "+v"(tz)); const int tid = tz;
    const bf16* kv = (const bf16*)(P->ws + WS_KV); float* km = (float*)(P->ws + WS_KM);
    for (int it = blockIdx.x; it < BATCH * N_KV * N_BLOCKS; it += gridDim.x) {
        const int blk = it % N_BLOCKS, g = (it / N_BLOCKS) % N_KV, b = it / (N_BLOCKS * N_KV);
        if (tid < HEAD_DIM) { float s = 0.f;
            for (int i = 0; i < MOBA_BLOCK; ++i) s += bf2f(kv[(size_t)(b * SEQ + blk * MOBA_BLOCK + i) * 512 + g * HEAD_DIM + tid]);
            const float mval = s * (1.f / MOBA_BLOCK); km[(size_t)it * HEAD_DIM + tid] = mval;
            const unsigned hi16 = cvt_pk_bf16(mval, 0.f) & 0xffffu; const float rem = mval - bflo(hi16);
            bf16* kmh = (bf16*)(km + 65536); kmh[(size_t)it * HEAD_DIM + tid] = (bf16)hi16; kmh[(size_t)(BATCH * N_KV * N_BLOCKS + it) * HEAD_DIM + tid] = (bf16)(cvt_pk_bf16(rem, 0.f) & 0xffffu); }
    }
}
__device__ __forceinline__ void phase_moba_gate(KP P, LAS unsigned char* lds) {
    int tz = threadIdx.x; asm volatile("" : "+v"(tz)); const int tid = tz, lane = tid & 63, wave = tid >> 6;
    const bf16* q = (const bf16*)(P->ws + WS_QKVI); const float* km = (const float*)(P->ws + WS_KM); unsigned char* selb = (unsigned char*)(P->ws + WS_SELB);
    LAS float* qs = (LAS float*)(lds + wave * 2048);
    const int blk = lane & 31, half = lane >> 5;
    for (int it = blockIdx.x * NWAVES + wave; it < NTOK * 2; it += gridDim.x * NWAVES) {
        const int tok = it >> 1, g = it & 1, b = tok / SEQ, t = tok % SEQ, own = t >> 8;
        unsigned char* sb = selb + ((size_t)tok * 8 + g * 4) * 4;
        if (own < 3) { if (lane < 4) { for (int s2 = own; s2 < 3; ++s2) sb[lane * 4 + s2] = 0xFF; } }
        if (own == 0) continue;
        { const u32x4 w = *(const u32x4*)(q + (size_t)tok * D_MODEL + g * 512 + lane * 8);
          LAS float* d = qs + lane * 8;
          d[0] = bflo(w.x); d[1] = bfhi(w.x); d[2] = bflo(w.y); d[3] = bfhi(w.y); d[4] = bflo(w.z); d[5] = bfhi(w.z); d[6] = bflo(w.w); d[7] = bfhi(w.w); }
        asm volatile("s_waitcnt lgkmcnt(0)" ::: "memory");
        float acc[4] = {0.f, 0.f, 0.f, 0.f};
        const float* kp = km + ((size_t)(b * N_KV + g) * N_BLOCKS + blk) * HEAD_DIM + half * 64;
#pragma unroll 4
        for (int i = 0; i < 16; ++i) { const f32x4 kk = *(const f32x4*)(kp + 4 * i);
#pragma unroll
            for (int r = 0; r < 4; ++r) { const f32x4 qq = *(const LAS f32x4*)(qs + r * 128 + half * 64 + 4 * i); acc[r] += (kk[0] * qq[0] + kk[1] * qq[1]) + (kk[2] * qq[2] + kk[3] * qq[3]); } }
#pragma unroll
        for (int r = 0; r < 4; ++r) { acc[r] += __shfl_xor(acc[r], 32); if (blk >= own) acc[r] = -INFINITY; }
        int rank[4] = {0, 0, 0, 0};
#pragma unroll
        for (int j = 0; j < 32; ++j) {
#pragma unroll
            for (int r = 0; r < 4; ++r) { const float vj = __uint_as_float(__builtin_amdgcn_readlane(__float_as_uint(acc[r]), j)); rank[r] += (vj > acc[r] || (vj == acc[r] && j < blk)) ? 1 : 0; }
        }
        if (half == 0 && blk < own) {
#pragma unroll
            for (int r = 0; r < 4; ++r) if (rank[r] < 3) sb[r * 4 + rank[r]] = (unsigned char)blk;
        }
    }
}

__device__ __forceinline__ void phase_moba_gate2(KP P) {
    typedef float f32x16 __attribute__((ext_vector_type(16)));
    int tz = threadIdx.x; asm volatile("" : "+v"(tz)); const int tid = tz, lane = tid & 63, wave = tid >> 6, r32 = lane & 31, hi = lane >> 5;
    const bf16* q = (const bf16*)(P->ws + WS_QKVI); const bf16* kmh = (const bf16*)((const float*)(P->ws + WS_KM) + 65536); unsigned char* selb = (unsigned char*)(P->ws + WS_SELB);
    const int gw = blockIdx.x * NWAVES + wave, NGW = gridDim.x * NWAVES;
    int cur_bg = -1; bf16x8 ah[8], al[8];
    for (int tile = gw * 4; tile < 8192; tile += NGW * 4) {
#pragma unroll 1
        for (int sub = 0; sub < 4; ++sub) {
            const int tl = tile + sub, bg = tl >> 10, b = bg >> 1, g = bg & 1, rt = tl & 1023;
            if (bg != cur_bg) { cur_bg = bg;
                const bf16* kp = kmh + ((size_t)(b * N_KV + g) * N_BLOCKS + r32) * HEAD_DIM + 8 * hi;
#pragma unroll
                for (int ks = 0; ks < 8; ++ks) { ah[ks] = *(const bf16x8*)(kp + 16 * ks); al[ks] = *(const bf16x8*)(kp + (size_t)BATCH * N_KV * N_BLOCKS * HEAD_DIM + 16 * ks); } }
            const int row = rt * 32 + r32, t = row >> 2, rh = row & 3, own = t >> 8, tok = b * SEQ + t;
            const bf16* qp = q + (size_t)tok * D_MODEL + (g * 4 + rh) * HEAD_DIM + 8 * hi;
            f32x16 acc = {};
#pragma unroll
            for (int ks = 0; ks < 8; ++ks) { const bf16x8 qv = *(const bf16x8*)(qp + 16 * ks);
                acc = __builtin_amdgcn_mfma_f32_32x32x16_bf16(ah[ks], qv, acc, 0, 0, 0); acc = __builtin_amdgcn_mfma_f32_32x32x16_bf16(al[ks], qv, acc, 0, 0, 0); }
            float v[16];
#pragma unroll
            for (int r = 0; r < 16; ++r) { const int blk = (r & 3) + 8 * (r >> 2) + 4 * hi; v[r] = (blk < own) ? acc[r] : -INFINITY; }
            float bv[3]; int bi[3];
#pragma unroll
            for (int p = 0; p < 3; ++p) { float best = -INFINITY; int br = -1;
#pragma unroll
                for (int r = 0; r < 16; ++r) { if (v[r] > best) { best = v[r]; br = r; } }
                bv[p] = best; bi[p] = (br < 0) ? 255 : ((br & 3) + 8 * (br >> 2) + 4 * hi);
#pragma unroll
                for (int r = 0; r < 16; ++r) { if (r == br) v[r] = -INFINITY; } }
            float ov[3]; int oi[3];
#pragma unroll
            for (int p = 0; p < 3; ++p) { ov[p] = __shfl_xor(bv[p], 32); oi[p] = __shfl_xor(bi[p], 32); }
            int ia = 0, ib = 0; int res[3];
#pragma unroll
            for (int p = 0; p < 3; ++p) {
                const float va = (ia == 0) ? bv[0] : (ia == 1) ? bv[1] : (ia == 2) ? bv[2] : -INFINITY; const int xa = (ia == 0) ? bi[0] : (ia == 1) ? bi[1] : (ia == 2) ? bi[2] : 255;
                const float vb = (ib == 0) ? ov[0] : (ib == 1) ? ov[1] : (ib == 2) ? ov[2] : -INFINITY; const int xb = (ib == 0) ? oi[0] : (ib == 1) ? oi[1] : (ib == 2) ? oi[2] : 255;
                const bool takeA = (va > vb) || (va == vb && xa < xb);
                const float vv = takeA ? va : vb; const int xx = takeA ? xa : xb;
                res[p] = (vv > -INFINITY) ? xx : 255; if (takeA) ++ia; else ++ib; }
            if (hi == 0) { const unsigned w = (unsigned)res[0] | ((unsigned)res[1] << 8) | ((unsigned)res[2] << 16) | 0xFF000000u;
                *(unsigned*)(selb + ((size_t)tok * 8 + g * 4 + rh) * 4) = w; }
        }
    }
}

__device__ __forceinline__ void phase_moba_lists(KP P, LAS unsigned char* lds) {
    int tz = threadIdx.x; asm volatile("" : "+v"(tz)); const int tid = tz, lane = tid & 63, wave = tid >> 6;
    const u32x4* selb = (const u32x4*)(P->ws + WS_SELB); unsigned* lists = (unsigned*)(P->ws + WS_LISTS); unsigned* lcnt = (unsigned*)(P->ws + WS_CTL) + CW_LCNT;
    LAS int* wtot = (LAS int*)lds;
    for (int li = blockIdx.x; li < 256; li += gridDim.x) {
        const int j = li & 31, g = (li >> 5) & 1, b = li >> 6, base_t = (j + 1) * MOBA_BLOCK, n_t = SEQ - base_t;
        unsigned* out = lists + (size_t)li * 32768;
        int running = 0;
        for (int i0 = 0; i0 < n_t; i0 += 512) {
            const int ti = i0 + tid; const bool ok = ti < n_t; const int t = base_t + ti;
            u32x4 w = {0xFFFFFFFFu, 0xFFFFFFFFu, 0xFFFFFFFFu, 0xFFFFFFFFu};
            if (ok) w = selb[((size_t)(b * SEQ + t) * 8 + g * 4) / 4];
            int ms[4];
#pragma unroll
            for (int r = 0; r < 4; ++r) { const unsigned x = w[r]; ms[r] = ((x & 0xFFu) == (unsigned)j) ? 0 : (((x >> 8) & 0xFFu) == (unsigned)j) ? 1 : (((x >> 16) & 0xFFu) == (unsigned)j) ? 2 : -1; }
            const int c = (ms[0] >= 0) + (ms[1] >= 0) + (ms[2] >= 0) + (ms[3] >= 0);
            int inc = c;
#pragma unroll
            for (int o = 1; o < 64; o <<= 1) { const int v = __shfl_up(inc, o); if (lane >= o) inc += v; }
            __syncthreads();
            if (lane == 63) wtot[wave] = inc;
            __syncthreads();
            int woff = 0, tot = 0;
#pragma unroll
            for (int x = 0; x < NWAVES; ++x) { const int v = wtot[x]; if (x < wave) woff += v; tot += v; }
            int pos = running + woff + inc - c;
#pragma unroll
            for (int r = 0; r < 4; ++r) if (ms[r] >= 0) out[pos++] = (unsigned)t | ((unsigned)r << 13) | ((unsigned)ms[r] << 15);
            running += tot;
        }
        if (tid == 0) lcnt[li] = (unsigned)running;
        __syncthreads();
    }
}
__device__ __forceinline__ void phase_moba_attn(KP P, LAS unsigned char* lds) {
    int tz = threadIdx.x; asm volatile("" : "+v"(tz)); const int tid = tz, lane = tid & 63, wave = tid >> 6;
    const bf16* q = (const bf16*)(P->ws + WS_QKVI); const bf16* kv = (const bf16*)(P->ws + WS_KV);
    bf16* part_o = (bf16*)(P->ws + WS_PARTO); float* part_ml = (float*)(P->ws + WS_PML);
    const unsigned* lists = (const unsigned*)(P->ws + WS_LISTS); const unsigned* lcnt = (const unsigned*)(P->ws + WS_CTL) + CW_LCNT;
    LAS int* pre = (LAS int*)(lds + mb::PRE_OFF);
    LAS int* cn = pre + 260;
    if (tid < 256) cn[tid] = (int)lcnt[tid];
    __syncthreads();
    if (tid == 0) { int s = 0; for (int i = 0; i < 256; ++i) { pre[i] = s; s += (cn[i] + 255) >> 8; } pre[256] = s; }
    __syncthreads();
    const int npast = pre[256], total = npast + 1024;
    for (int it = blockIdx.x; it < total; it += gridDim.x) {
        int b, g, kblk, NT, t, rh, slot; bool own, valid;
        const int ri = wave * 32 + (lane & 31);
        if (it < npast) {
            int lo = 0, hi = 256;
            while (hi - lo > 1) { const int mid = (lo + hi) >> 1; if (pre[mid] <= it) lo = mid; else hi = mid; }
            const int li = lo, chunk = it - pre[li], n = cn[li];
            kblk = li & 31; g = (li >> 5) & 1; b = li >> 6; NT = 4; own = false;
            int idx = chunk * 256 + ri; valid = idx < n; if (!valid) idx = chunk * 256;
            const unsigned e = lists[(size_t)li * 32768 + idx];
            t = (int)(e & 0x1FFFu); rh = (int)((e >> 13) & 3u); slot = (int)((e >> 15) & 3u);
        } else {
            const int oi = it - npast, chunk = oi & 3, bi = oi >> 2;
            kblk = bi & 31; g = (bi >> 5) & 1; b = bi >> 6; NT = chunk < 2 ? 2 : 4; own = true; valid = true;
            t = kblk * MOBA_BLOCK + chunk * 64 + (ri >> 2); rh = ri & 3; slot = 3;
        }
        mb::item(q, kv, part_o, part_ml, lds, tid, b, g, kblk, NT, own, t, rh, slot, valid);
    }
}

namespace mb {
constexpr int SEG_K = 0, SEG_V = 65536, SEG_PRE = 131072, SEGC = 8;
__device__ __forceinline__ void stage_block(const bf16* __restrict__ kv, LAS unsigned char* lds, int tid, int b, int g, int kblk) {
    const char* KhB = (const char*)(kv + (size_t)(b * SEQ + kblk * MOBA_BLOCK) * 512 + g * HEAD_DIM);
    const int sr = tid >> 4, sc = (tid & 15) * 8, vst0 = v_st(sr, sc), vst1 = v_st(32 + sr, sc);
    const unsigned vo0 = (unsigned)(sr * 512 + sc) * 2u, vo1 = vo0 + 32u * 1024u;
#pragma unroll
    for (int h2 = 0; h2 < 2; ++h2) {
        bf16x8 kx[2][2], vx[2][2];
#pragma unroll
        for (int tt = 0; tt < 2; ++tt) { const char* kt_ = KhB + (size_t)((h2 * 2 + tt) * 64) * 1024;
            kx[tt][0] = *(const bf16x8*)(kt_ + vo0); kx[tt][1] = *(const bf16x8*)(kt_ + vo1); vx[tt][0] = *(const bf16x8*)(kt_ + 512 + vo0); vx[tt][1] = *(const bf16x8*)(kt_ + 512 + vo1); }
#pragma unroll
        for (int tt = 0; tt < 2; ++tt) { const int tile = h2 * 2 + tt;
            *(LAS bf16x8*)(lds + SEG_K + tile * SHM_K + MB_KSWZ(sr, sc * 2)) = kx[tt][0]; *(LAS bf16x8*)(lds + SEG_K + tile * SHM_K + MB_KSWZ(32 + sr, sc * 2)) = kx[tt][1];
            *(LAS bf16x8*)(lds + SEG_V + tile * SHM_V + vst0) = vx[tt][0]; *(LAS bf16x8*)(lds + SEG_V + tile * SHM_V + vst1) = vx[tt][1]; }
    }
}
__device__ __forceinline__ void chunk_rows(const bf16* __restrict__ q, bf16* __restrict__ part_o, float* __restrict__ part_ml, LAS unsigned char* lds, int lane,
                                           int b, int g, int kblk, int NT, bool own, int t, int rh, int slot, bool valid) {
    const int r32 = lane & 31, hi = lane >> 5, h = g * 4 + rh;
    float m_reg = -1e30f, l_reg = 0.f; f32x16 o[4] = {}; bf16x8 qr[8];
    { const bf16* Qw = q + (size_t)(b * SEQ + t) * D_MODEL + h * HEAD_DIM + hi * 8;
#pragma unroll
      for (int d0 = 0; d0 < 8; ++d0) qr[d0] = *(const bf16x8*)(Qw + d0 * 16); }
    const float bias2 = __builtin_amdgcn_exp2f(-(float)(h + 1)) * LOG2E;
    const int trel = t - kblk * MOBA_BLOCK;
    const float tb4 = bias2 * (float)(4 * hi - trel);
    const int lim0 = trel - 4 * hi;
    const int vb0 = (int)(unsigned)(uintptr_t)(lds + SEG_V) + v_rd_base(lane);
    for (int tile = 0; tile < NT; ++tile) {
        f32x16 p0, p1; float mn, al; bf16x8 pa0, pa1, pa2, pa3;
        qkt(p0, p1, lds + SEG_K + tile * SHM_K, qr, r32, hi);
        partialSM(p0, p1, m_reg, mn, al, bias2, tb4 + bias2 * (float)(tile * 64), own, lim0 - tile * 64);
        if (__any(al < 1.f)) {
#pragma unroll
            for (int d = 0; d < 4; ++d)
#pragma unroll
                for (int r = 0; r < 16; ++r) o[d][r] *= al; }
        finishSM(p0, p1, al, l_reg, pa0, pa1, pa2, pa3);
        pv_d0(o, vb0 + tile * SHM_V, pa0, pa1, pa2, pa3);
    }
    if (valid) {
        const float inv = 1.f / l_reg;
        const size_t rg = ((size_t)(b * SEQ + t) * N_HEADS + h) * 4 + slot;
        bf16* po = part_o + rg * HEAD_DIM + 4 * hi;
#pragma unroll
        for (int d0 = 0; d0 < 4; ++d0)
#pragma unroll
            for (int rq = 0; rq < 4; ++rq) { u32x2 w; w.x = cvt_pk_bf16(o[d0][rq * 4 + 0] * inv, o[d0][rq * 4 + 1] * inv); w.y = cvt_pk_bf16(o[d0][rq * 4 + 2] * inv, o[d0][rq * 4 + 3] * inv);
                *(u32x2*)(po + d0 * 32 + rq * 8) = w; }
        if (hi == 0) { f32x2 ml; ml.x = m_reg; ml.y = l_reg; *(f32x2*)(part_ml + rg * 2) = ml; }
    }
}
}
constexpr int CW_MQ = 20480;
__device__ __forceinline__ void phase_moba_attn2(KP P, int Lb, LAS unsigned char* lds) {
    int tz = threadIdx.x; asm volatile("" : "+v"(tz)); const int tid = tz, lane = tid & 63, wave = tid >> 6;
    const bf16* q = (const bf16*)(P->ws + WS_QKVI); const bf16* kv = (const bf16*)(P->ws + WS_KV);
    bf16* part_o = (bf16*)(P->ws + WS_PARTO); float* part_ml = (float*)(P->ws + WS_PML);
    const unsigned* lists = (const unsigned*)(P->ws + WS_LISTS); const unsigned* lcnt = (const unsigned*)(P->ws + WS_CTL) + CW_LCNT;
    unsigned* qhead = (unsigned*)(P->ws + WS_CTL) + CW_MQ + Lb * 64;
    LAS int* pre = (LAS int*)(lds + mb::SEG_PRE);
    LAS int* cn = pre + 260;
    LAS int* cur = pre + 520;
    if (tid < 256) cn[tid] = (int)lcnt[tid];
    __syncthreads();
    if (tid == 0) { int s2 = 0; for (int i = 0; i < 256; ++i) { pre[i] = s2; const int nch = (cn[i] + 255) >> 8; s2 += (nch + mb::SEGC - 1) / mb::SEGC; } pre[256] = s2; }
    __syncthreads();
    const int npast = pre[256], total = npast + 256;
    for (;;) {
        if (tid == 0) cur[0] = (int)__hip_atomic_fetch_add(qhead, 1u, __ATOMIC_RELAXED, __HIP_MEMORY_SCOPE_AGENT);
        __syncthreads();
        const int sg = cur[0];
        if (sg >= total) break;
        int b, g, kblk, li = 0, ch0, nch, n = 0; bool own;
        if (sg < npast) {
            int lo = 0, hi2 = 256;
            while (hi2 - lo > 1) { const int mid = (lo + hi2) >> 1; if (pre[mid] <= sg) lo = mid; else hi2 = mid; }
            li = lo; n = cn[li]; ch0 = (sg - pre[li]) * mb::SEGC; const int ncht = (n + 255) >> 8; nch = ncht - ch0 < mb::SEGC ? ncht - ch0 : mb::SEGC;
            kblk = li & 31; g = (li >> 5) & 1; b = li >> 6; own = false;
        } else { const int bi = sg - npast; kblk = bi & 31; g = (bi >> 5) & 1; b = bi >> 6; own = true; ch0 = 0; nch = 4; }
        mb::stage_block(kv, lds, tid, b, g, kblk);
        __syncthreads();
        const int ri = wave * 32 + (lane & 31);
        for (int c = 0; c < nch; ++c) {
            const int chunk = ch0 + c; int t, rh, slot, NT; bool valid;
            if (!own) { int idx = chunk * 256 + ri; valid = idx < n; if (!valid) idx = chunk * 256;
                const unsigned e = lists[(size_t)li * 32768 + idx];
                t = (int)(e & 0x1FFFu); rh = (int)((e >> 13) & 3u); slot = (int)((e >> 15) & 3u); NT = 4;
            } else { valid = true; t = kblk * MOBA_BLOCK + chunk * 64 + (ri >> 2); rh = ri & 3; slot = 3; NT = chunk + 1; }
            mb::chunk_rows(q, part_o, part_ml, lds, lane, b, g, kblk, NT, own, t, rh, slot, valid);
        }
        __syncthreads();
    }
}

__device__ __forceinline__ void phase_moba_combine(KP P) {
    int tz = threadIdx.x; asm volatile("" : "+v"(tz)); const int tid = tz;
    const bf16* part_o = (const bf16*)(P->ws + WS_PARTO); const float* part_ml = (const float*)(P->ws + WS_PML); bf16* attn = (bf16*)(P->ws + WS_ATTN);
    const int sub = tid & 15;
    const int stride = (gridDim.x * 512) >> 4;
    for (int rg0 = (blockIdx.x * 512 + tid) >> 4; rg0 < NTOK * N_HEADS; rg0 += 2 * stride) {
        f32x4 mlv[2][2]; u32x4 pv[2][4]; bool has[2];
#pragma unroll
        for (int u = 0; u < 2; ++u) { const int rg = rg0 + u * stride; has[u] = rg < NTOK * N_HEADS; const int rgc = has[u] ? rg : rg0;
            mlv[u][0] = *(const f32x4*)(part_ml + (size_t)rgc * 8); mlv[u][1] = *(const f32x4*)(part_ml + (size_t)rgc * 8 + 4);
#pragma unroll
            for (int s2 = 0; s2 < 4; ++s2) pv[u][s2] = __builtin_nontemporal_load((const u32x4*)(part_o + ((size_t)rgc * 4 + s2) * HEAD_DIM + sub * 8)); }
#pragma unroll
        for (int u = 0; u < 2; ++u) { const int rg = rg0 + u * stride;
            if (!has[u]) continue;
            const int tok = rg >> 3, own = (tok % SEQ) >> 8, nv = own < 3 ? own : 3;
            const float mm[4] = {mlv[u][0][0], mlv[u][0][2], mlv[u][1][0], mlv[u][1][2]}, ll[4] = {mlv[u][0][1], mlv[u][0][3], mlv[u][1][1], mlv[u][1][3]};
            float m[4], l[4];
#pragma unroll
            for (int s2 = 0; s2 < 4; ++s2) { const bool ok = (s2 == 3) || (s2 < nv); m[s2] = ok ? mm[s2] : -INFINITY; l[s2] = ok ? ll[s2] : 0.f; }
            const float M = fmaxf(fmaxf(m[0], m[1]), fmaxf(m[2], m[3]));
            float w[4], W = 0.f;
#pragma unroll
            for (int s2 = 0; s2 < 4; ++s2) { w[s2] = l[s2] * __builtin_amdgcn_exp2f(m[s2] - M); W += w[s2]; }
            const float inv = 1.f / W;
            float acc[8] = {0.f, 0.f, 0.f, 0.f, 0.f, 0.f, 0.f, 0.f};
#pragma unroll
            for (int s2 = 0; s2 < 4; ++s2) { const bool ok = (s2 == 3) || (s2 < nv); const u32x4 v = pv[u][s2]; const float ws2 = ok ? w[s2] * inv : 0.f;
                if (ok) { acc[0] += ws2 * bflo(v.x); acc[1] += ws2 * bfhi(v.x); acc[2] += ws2 * bflo(v.y); acc[3] += ws2 * bfhi(v.y);
                          acc[4] += ws2 * bflo(v.z); acc[5] += ws2 * bfhi(v.z); acc[6] += ws2 * bflo(v.w); acc[7] += ws2 * bfhi(v.w); } }
            u32x4 o; o.x = cvt_pk_bf16(acc[0], acc[1]); o.y = cvt_pk_bf16(acc[2], acc[3]); o.z = cvt_pk_bf16(acc[4], acc[5]); o.w = cvt_pk_bf16(acc[6], acc[7]);
            *(u32x4*)(attn + (size_t)rg * HEAD_DIM + sub * 8) = o;
        }
    }
}


#ifndef D1_EXP
#define D1_EXP 0
#endif
constexpr int D1_QS = 4100, D1_SM = 32 * D1_QS, D1_SELIDX = D1_SM + 1024, D1_NT = 992;
__device__ __forceinline__ unsigned fkey2(float f) { const unsigned u = __float_as_uint(f); return (u & 0x80000000u) ? ~u : (u | 0x80000000u); }
template <int PASS, int EXP>
__device__ __forceinline__ void d1_scan(const bf16* __restrict__ ikb, int qt, int kt_end, int tid_in, const bf16x8 (&qb)[4][4], const float (&wv)[4], LAS unsigned char* lds, unsigned thr, float c0 = 0.f, unsigned bstar = 0) {
    typedef float f32x16 __attribute__((ext_vector_type(16)));
    int t2_ = tid_in; asm volatile("" : "+v"(t2_));
    const int lane = t2_ & 63, wave = __builtin_amdgcn_readfirstlane(t2_ >> 6), r32 = lane & 31, hi = lane >> 5;
    LAS unsigned* hq = (LAS unsigned*)(lds + r32 * D1_QS);
    LAS unsigned* sm = (LAS unsigned*)(lds + D1_SM);
    typedef float f32x2v __attribute__((ext_vector_type(2)));
    f32x2v w2[4];
#pragma unroll
    for (int h = 0; h < 4; ++h) w2[h] = (f32x2v){wv[h], wv[h]};
    bf16x8 ka[4];
    int kt = wave;
    if (kt <= kt_end) { const bf16* kp = ikb + (size_t)(kt * 32 + r32) * QLD + 8 * hi;
#pragma unroll
        for (int ks = 0; ks < 4; ++ks) ka[ks] = *(const bf16x8*)(kp + 16 * ks); }
    for (; kt <= kt_end; kt += 8) {
        bf16x8 kn[4];
#pragma unroll
        for (int ks = 0; ks < 4; ++ks) kn[ks] = ka[ks];
        if (kt + 8 <= kt_end) { const bf16* kp = ikb + (size_t)((kt + 8) * 32 + r32) * QLD + 8 * hi;
#pragma unroll
            for (int ks = 0; ks < 4; ++ks) kn[ks] = *(const bf16x8*)(kp + 16 * ks); }
        f32x2v s2[8];
#pragma unroll
        for (int j = 0; j < 8; ++j) s2[j] = (f32x2v){c0, c0};
#pragma unroll
        for (int h = 0; h < 4; ++h) { f32x16 acc = {};
#pragma unroll
            for (int ks = 0; ks < 4; ++ks) acc = __builtin_amdgcn_mfma_f32_32x32x16_bf16(ka[ks], qb[h][ks], acc, 0, 0, 0);
#pragma unroll
            for (int j = 0; j < 8; ++j) { const int a0 = __float_as_int(acc[2 * j]), a1 = __float_as_int(acc[2 * j + 1]);
                const f32x2v rl = {__int_as_float(a0 > 0 ? a0 : 0), __int_as_float(a1 > 0 ? a1 : 0)};
                asm("v_pk_fma_f32 %0, %1, %2, %0" : "+v"(s2[j]) : "v"(w2[h]), "v"(rl)); } }
        float sc[16];
#pragma unroll
        for (int r = 0; r < 16; ++r) sc[r] = s2[r >> 1][r & 1];
        int kbase = kt * 32 + 4 * hi; asm volatile("" : "+v"(kbase));
        const int lim = (kt == qt) ? (r32 - 4 * hi) : 64;
        if constexpr (PASS == 4 || PASS == 5) {
            if (kt == qt) {
#pragma unroll
                for (int r = 0; r < 16; ++r) { const int kc = (r & 3) + 8 * (r >> 2); if (kc > lim) sc[r] = -INFINITY; } }
        }
        if constexpr (PASS == 4) {
#pragma unroll
            for (int r = 0; r < 16; ++r) { int bi; asm("v_cvt_flr_i32_f32 %0, %1" : "=v"(bi) : "v"(sc[r])); bi = bi < -1 ? -1 : bi; bi = bi > 1023 ? 1023 : bi;
                (void)__hip_atomic_fetch_add(hq + 1 + bi, 1u, __ATOMIC_RELAXED, __HIP_MEMORY_SCOPE_WORKGROUP); }
        } else if constexpr (PASS == 5) {
            unsigned msel = 0u, mcand = 0u; const int bsi = (int)bstar;
#pragma unroll
            for (int r = 15; r >= 0; --r) { int bi; asm("v_cvt_flr_i32_f32 %0, %1" : "=v"(bi) : "v"(sc[r]));
                asm("v_cmp_gt_i32 vcc, %1, %2\n\tv_addc_co_u32 %0, vcc, %0, %0, vcc" : "+v"(msel) : "v"(bi), "v"(bsi) : "vcc");
                asm("v_cmp_eq_i32 vcc, %1, %2\n\tv_addc_co_u32 %0, vcc, %0, %0, vcc" : "+v"(mcand) : "v"(bi), "v"(bsi) : "vcc"); }
            unsigned mzero = 0u;
            if (__any(mcand != 0u)) {
#pragma unroll
                for (int r = 0; r < 16; ++r) { if ((mcand >> r) & 1u) { const int kc = (r & 3) + 8 * (r >> 2); const unsigned key5 = fkey2(sc[r] - c0); const unsigned sidx = (unsigned)(kbase + kc);
                    if (key5 == 0x80000000u) mzero |= 1u << r;
                    else { const unsigned cp = __hip_atomic_fetch_add(sm + 160 + r32, 1u, __ATOMIC_RELAXED, __HIP_MEMORY_SCOPE_WORKGROUP); if (cp < 256u) { hq[cp] = key5; ((LAS unsigned short*)(hq + 256))[cp] = (unsigned short)sidx; } } } }
            }
            unsigned w = ((msel & 0xFu) | ((msel & 0xF0u) << 4) | ((msel & 0xF00u) << 8) | ((msel & 0xF000u) << 12)) << (4 * hi);
            unsigned z = ((mzero & 0xFu) | ((mzero & 0xF0u) << 4) | ((mzero & 0xF00u) << 8) | ((mzero & 0xF000u) << 12)) << (4 * hi);
            w |= (unsigned)__shfl_xor((int)w, 32); z |= (unsigned)__shfl_xor((int)z, 32);
            if (hi == 0) { hq[512 + kt] = w; hq[768 + kt] = z; }
        } else {
#pragma unroll
        for (int r = 0; r < 16; ++r) {
            const int kc = (r & 3) + 8 * (r >> 2);
            const bool valid = kc <= lim;
            const unsigned key = fkey2(sc[r]);
            if (PASS == 1) { if (EXP == 3) { if (key == 12345u) hq[0] = 1u; } else if (valid && EXP != 2) { const unsigned bin = key >> 21; (void)__hip_atomic_fetch_add(hq + (bin >> 1), 1u << (16 * (bin & 1)), __ATOMIC_RELAXED, __HIP_MEMORY_SCOPE_WORKGROUP); } }
            else if (PASS == 2) { if (valid && (key >> 21) == thr) { const unsigned bin = (key >> 10) & 2047u; (void)__hip_atomic_fetch_add(hq + (bin >> 1), 1u << (16 * (bin & 1)), __ATOMIC_RELAXED, __HIP_MEMORY_SCOPE_WORKGROUP); } }
            else { if (valid) { const unsigned p22 = key >> 10; const unsigned sidx = (unsigned)(kbase + kc);
                    if (p22 > thr) (void)__hip_atomic_fetch_or(hq + 512 + (sidx >> 5), 1u << (sidx & 31u), __ATOMIC_RELAXED, __HIP_MEMORY_SCOPE_WORKGROUP);
                    else if (p22 == thr) {
                        if (key == 0x80000000u) (void)__hip_atomic_fetch_or(hq + 768 + (sidx >> 5), 1u << (sidx & 31u), __ATOMIC_RELAXED, __HIP_MEMORY_SCOPE_WORKGROUP);
                        else { const unsigned cp = __hip_atomic_fetch_add(sm + 160 + r32, 1u, __ATOMIC_RELAXED, __HIP_MEMORY_SCOPE_WORKGROUP); if (cp < 256u) { hq[cp] = key; ((LAS unsigned short*)(hq + 256))[cp] = (unsigned short)sidx; } } } } }
        }
        }
#pragma unroll
        for (int ks = 0; ks < 4; ++ks) ka[ks] = kn[ks];
    }
}
__device__ __forceinline__ bool d1_find(LAS unsigned* H, unsigned need, int lane, unsigned& bin_out, unsigned& above_out) {
    unsigned mine = 0;
#pragma unroll
    for (int i = 0; i < 16; ++i) { const unsigned w = H[lane * 16 + ((i + (lane >> 2)) & 15)]; mine += (w & 0xFFFFu) + (w >> 16); }
    const unsigned pre = wave_scan_incl(mine);
    const unsigned total = (unsigned)__builtin_amdgcn_readlane((int)pre, 63);
    const unsigned above = total - pre, inc = above + mine;
    const bool found = (above < need) && (inc >= need);
    const unsigned long long bal = __ballot(found); const int src = bal ? (__ffsll((long long)bal) - 1) : 0;
    const unsigned ab0 = (unsigned)__builtin_amdgcn_readlane((int)above, src);
    unsigned cj = 0;
    if (lane < 32) { const int bidx = src * 32 + 31 - lane; const unsigned w = H[bidx >> 1]; cj = (bidx & 1) ? (w >> 16) : (w & 0xFFFFu); }
    const unsigned inc2 = wave_scan_incl(cj);
    const bool hit = (lane < 32) && (ab0 + inc2 >= need) && (ab0 + inc2 - cj < need);
    const unsigned long long bal2 = __ballot(hit); const int l2 = bal2 ? (__ffsll((long long)bal2) - 1) : 0;
    bin_out = (unsigned)(src * 32 + 31 - l2); above_out = ab0 + (unsigned)__builtin_amdgcn_readlane((int)(inc2 - cj), l2);
    return bal != 0ull;
}
__device__ __forceinline__ bool d1_find32(LAS unsigned* H, unsigned need, int lane, unsigned& bin_out, unsigned& above_out) {
    unsigned mine = 0;
#pragma unroll
    for (int i = 0; i < 16; ++i) mine += H[1 + lane * 16 + ((i + (lane >> 2)) & 15)];
    const unsigned pre = wave_scan_incl(mine);
    const unsigned total = (unsigned)__builtin_amdgcn_readlane((int)pre, 63);
    const unsigned above = total - pre, inc = above + mine;
    const bool found = (above < need) && (inc >= need);
    const unsigned long long bal = __ballot(found); const int src = bal ? (__ffsll((long long)bal) - 1) : 0;
    const unsigned ab0 = (unsigned)__builtin_amdgcn_readlane((int)above, src);
    unsigned cj = 0;
    if (lane < 16) cj = H[1 + src * 16 + 15 - lane];
    const unsigned inc2 = wave_scan_incl(cj);
    const bool hit = (lane < 16) && (ab0 + inc2 >= need) && (ab0 + inc2 - cj < need);
    const unsigned long long bal2 = __ballot(hit); const int l2 = bal2 ? (__ffsll((long long)bal2) - 1) : 0;
    bin_out = (unsigned)(src * 16 + 15 - l2); above_out = ab0 + (unsigned)__builtin_amdgcn_readlane((int)(inc2 - cj), l2);
    return bal != 0ull;
}
#define D1_FRESH(l, w) int l, w; { int t_ = tid; asm volatile("" : "+v"(t_)); l = t_ & 63; w = __builtin_amdgcn_readfirstlane(t_ >> 6); }
typedef int i32x4v __attribute__((ext_vector_type(4)));
template <int EXP>
__device__ __forceinline__ void phase_dsa_topk(KP P, LAS unsigned char* lds, size_t sel_off) {
    int tz = threadIdx.x; asm volatile("" : "+v"(tz)); int tid = tz, r32 = tid & 31, hi = (tid >> 5) & 1;
#define D1_REFRESH() { asm volatile("" : "+v"(tid)); r32 = tid & 31; hi = (tid >> 5) & 1; }
    const bf16* qkvi = (const bf16*)(P->ws + WS_QKVI); const float* iw = (const float*)(P->ws + WS_IW); int* sel = (int*)(P->ws + sel_off);
    LAS unsigned* sm = (LAS unsigned*)(lds + D1_SM);
    const int G = gridDim.x, nrounds = (D1_NT + G - 1) / G;
    for (int rho = 0; rho < nrounds; ++rho) {
        const int pos = (rho & 1) ? (G - 1 - (int)blockIdx.x) : (int)blockIdx.x, i = rho * G + pos;
        if (i >= D1_NT) continue;
        D1_REFRESH()
        const int qt = 255 - (i >> 2), b = i & 3, t0 = qt * 32, tok0 = b * SEQ + t0;
        for (int w = tid; w < (D1_SM + 1024) / 4; w += 512) ((LAS unsigned*)lds)[w] = 0u;
        bf16x8 qb[4][4]; float wv[4];
        { const bf16* qp = qkvi + (size_t)(tok0 + r32) * QLD + COL_IQ + 8 * hi;
#pragma unroll
          for (int h = 0; h < 4; ++h)
#pragma unroll
              for (int ks = 0; ks < 4; ++ks) qb[h][ks] = *(const bf16x8*)(qp + h * IDX_DIM + 16 * ks);
          const f32x4 w4 = *(const f32x4*)(iw + (size_t)(tok0 + r32) * 4); wv[0] = w4[0]; wv[1] = w4[1]; wv[2] = w4[2]; wv[3] = w4[3]; }
        const bf16* ikb = qkvi + (size_t)b * SEQ * QLD + COL_IK;
        __syncthreads(); D1_REFRESH()
        d1_scan<1, EXP>(ikb, qt, 7, tid, qb, wv, lds, 0u);
        __syncthreads(); D1_REFRESH()
#pragma unroll 1
        for (int qq = 0; qq < 4; ++qq) { D1_FRESH(lane, wave) const int q = wave * 4 + qq; const unsigned n = (unsigned)(t0 + q + 1); unsigned klo = 196608u / n; klo = klo > 256u ? 256u : (klo < 1u ? 1u : klo);
            unsigned bs, ab, bmx, ab2; const bool ok1 = d1_find((LAS unsigned*)(lds + q * D1_QS), klo, lane, bs, ab), ok2 = d1_find((LAS unsigned*)(lds + q * D1_QS), 1u, lane, bmx, ab2);
            if (lane == 0) { const unsigned klo_key = bs << 21, khi_key = (bmx + 1u) << 21;
                const float lo = __uint_as_float((klo_key & 0x80000000u) ? (klo_key & 0x7FFFFFFFu) : ~klo_key), hi2 = __uint_as_float((khi_key & 0x80000000u) ? (khi_key & 0x7FFFFFFFu) : ~khi_key);
                const float span = (hi2 - lo) * 1.5f; const bool good = ok1 && ok2 && bmx < 2046u && span > 0.f && span < 3.0e38f;
                sm[q] = __float_as_uint(lo); sm[32 + q] = __float_as_uint(good ? fminf(1023.f / span, 1.0e30f) : 0.f); if (!good) sm[224] = 1u; } }
        __syncthreads(); D1_REFRESH()
        if constexpr (EXP == 20) continue;
        for (int w = tid; w < D1_SM / 4; w += 512) ((LAS unsigned*)lds)[w] = 0u;
        float c0;
        { const float f_lo = __uint_as_float(sm[r32]), f_inv = __uint_as_float(sm[32 + r32]); c0 = -f_lo * f_inv;
#pragma unroll
          for (int h = 0; h < 4; ++h) wv[h] *= f_inv; }
        __syncthreads(); D1_REFRESH()
        d1_scan<4, EXP>(ikb, qt, qt, tid, qb, wv, lds, 0u, c0);
        __syncthreads(); D1_REFRESH()
        if constexpr (EXP == 21) continue;
#pragma unroll 1
        for (int qq = 0; qq < 4; ++qq) { D1_FRESH(lane, wave) const int q = wave * 4 + qq; unsigned bin, ab; const bool ok = d1_find32((LAS unsigned*)(lds + q * D1_QS), 256u, lane, bin, ab);
            if (lane == 0) { sm[64 + q] = bin; sm[96 + q] = 256u - ab; if (!ok || bin == 1023u) sm[224] = 1u; } }
        __syncthreads(); D1_REFRESH()
        for (int w = tid; w < D1_SM / 4; w += 512) ((LAS unsigned*)lds)[w] = 0u;
#ifndef D1_FORCE_FB
#define D1_FORCE_FB 0
#endif
        const unsigned f_bs = sm[64 + r32]; bool fast_ok = (sm[224] == 0u) && !D1_FORCE_FB;
        __syncthreads(); D1_REFRESH()
        if constexpr (EXP == 22) continue;
        if (fast_ok) {
            d1_scan<5, EXP>(ikb, qt, qt, tid, qb, wv, lds, 0u, c0, f_bs);
            __syncthreads(); D1_REFRESH()
            if (tid < 32 && sm[160 + tid] > 256u) sm[224] = 1u;
            __syncthreads(); D1_REFRESH()
            fast_ok = (sm[224] == 0u);
            __syncthreads(); D1_REFRESH()
        }
        if constexpr (EXP == 23) continue;
#ifndef D1_NO_FB
#define D1_NO_FB 0
#endif
        if (!fast_ok && !D1_NO_FB) {
        { const f32x4 w4 = *(const f32x4*)(iw + (size_t)(tok0 + r32) * 4); wv[0] = w4[0]; wv[1] = w4[1]; wv[2] = w4[2]; wv[3] = w4[3]; }
        for (int w = tid; w < (D1_SM + 1024) / 4; w += 512) ((LAS unsigned*)lds)[w] = 0u;
        __syncthreads(); D1_REFRESH()
        d1_scan<1, EXP>(ikb, qt, qt, tid, qb, wv, lds, 0u);
        __syncthreads(); D1_REFRESH()
#pragma unroll 1
        for (int qq = 0; qq < 4; ++qq) { D1_FRESH(lane, wave) const int q = wave * 4 + qq; unsigned bin, ab; d1_find((LAS unsigned*)(lds + q * D1_QS), 256u, lane, bin, ab); if (lane == 0) { sm[q] = bin; sm[32 + q] = ab; } }
        __syncthreads(); D1_REFRESH()
        for (int w = tid; w < D1_SM / 4; w += 512) ((LAS unsigned*)lds)[w] = 0u;
        const unsigned b1 = sm[r32];
        __syncthreads(); D1_REFRESH()
        d1_scan<2, EXP>(ikb, qt, qt, tid, qb, wv, lds, b1);
        __syncthreads(); D1_REFRESH()
#pragma unroll 1
        for (int qq = 0; qq < 4; ++qq) { D1_FRESH(lane, wave) const int q = wave * 4 + qq; const unsigned need2 = 256u - sm[32 + q]; unsigned bin, ab; d1_find((LAS unsigned*)(lds + q * D1_QS), need2, lane, bin, ab);
            if (lane == 0) { sm[64 + q] = (sm[q] << 11) | bin; sm[96 + q] = need2 - ab; } }
        __syncthreads(); D1_REFRESH()
        for (int w = tid; w < D1_SM / 4; w += 512) ((LAS unsigned*)lds)[w] = 0u;
        const unsigned T22 = sm[64 + r32];
        __syncthreads(); D1_REFRESH()
        d1_scan<3, EXP>(ikb, qt, qt, tid, qb, wv, lds, T22);
        __syncthreads(); D1_REFRESH()
        }
#pragma unroll 1
        for (int qq = 0; qq < 4; ++qq) { D1_FRESH(lane, wave) const int q = wave * 4 + qq;
            const unsigned cc = sm[160 + q] < 256u ? sm[160 + q] : 256u, need3 = sm[96 + q];
            LAS unsigned* cand = (LAS unsigned*)(lds + q * D1_QS); LAS unsigned short* cidx = (LAS unsigned short*)(cand + 256); LAS unsigned* bm = cand + 512; LAS unsigned* tb = cand + 768;
            unsigned tw[4]; int cz = 0;
#pragma unroll
            for (int w = 0; w < 4; ++w) { tw[w] = tb[lane * 4 + w]; cz += __popc(tw[w]); }
            const int incz = (int)wave_scan_incl((unsigned)cz);
            const int cztot = __builtin_amdgcn_readlane(incz, 63);
            int npos = 0;
            for (unsigned ci = lane; ci < ((cc + 63u) & ~63u); ci += 64) { const bool act = ci < cc; const unsigned mine = act ? cand[ci] : 0u; const unsigned mi = act ? (unsigned)cidx[ci] : 0u;
                npos += __popcll(__ballot(act && mine > 0x80000000u));
                unsigned rank = (mine < 0x80000000u) ? (unsigned)cztot : 0u;
                for (unsigned j = 0; j < cc; ++j) { const unsigned kj = cand[j]; const unsigned ij = (unsigned)cidx[j]; rank += (kj > mine || (kj == mine && ij < mi)) ? 1u : 0u; }
                if (act && rank < need3) (void)__hip_atomic_fetch_or(bm + (mi >> 5), 1u << (mi & 31u), __ATOMIC_RELAXED, __HIP_MEMORY_SCOPE_WORKGROUP); }
            { int need_z = (int)need3 - npos; need_z = need_z < 0 ? 0 : (need_z > cztot ? cztot : need_z);
              if (need_z > 0) { int pre = incz - cz;
#pragma unroll
                for (int w = 0; w < 4; ++w) { unsigned bits = tw[w]; const int pc = __popc(bits); int k = need_z - pre; k = k < 0 ? 0 : (k > pc ? pc : k);
                    unsigned keep = 0u; for (int x = 0; x < k; ++x) { const unsigned low = bits & (0u - bits); keep |= low; bits ^= low; }
                    if (keep) (void)__hip_atomic_fetch_or(bm + lane * 4 + w, keep, __ATOMIC_RELAXED, __HIP_MEMORY_SCOPE_WORKGROUP);
                    pre += pc; } } }
            asm volatile("s_waitcnt lgkmcnt(0)" ::: "memory");
            unsigned wds[4]; int c = 0;
#pragma unroll
            for (int w = 0; w < 4; ++w) { wds[w] = bm[lane * 4 + w]; c += __popc(wds[w]); }
            const int inc = (int)wave_scan_incl((unsigned)c);
            const int total = __builtin_amdgcn_readlane(inc, 63); int off = inc - c;
            LAS unsigned short* ol = (LAS unsigned short*)(lds + D1_SELIDX + q * 512);
#pragma unroll
            for (int w = 0; w < 4; ++w) { unsigned bits = wds[w]; const int kb = lane * 128 + w * 32;
                while (bits) { const int k = __ffs((int)bits) - 1; if (off < TOPK) ol[off] = (unsigned short)(kb + k); ++off; bits &= bits - 1u; } }
            for (int j = total + lane; j < TOPK; j += 64) ol[j] = (unsigned short)(t0 + q);
            asm volatile("s_waitcnt lgkmcnt(0)" ::: "memory");
            { const unsigned lo2 = ((LAS unsigned*)ol)[lane * 2], hi2 = ((LAS unsigned*)ol)[lane * 2 + 1];
              i32x4v ov; ov.x = (int)(lo2 & 0xFFFFu); ov.y = (int)(lo2 >> 16); ov.z = (int)(hi2 & 0xFFFFu); ov.w = (int)(hi2 >> 16);
              if (EXP != 7) *(i32x4v*)(sel + (size_t)(tok0 + q) * TOPK + lane * 4) = ov; }
        }
        __syncthreads(); D1_REFRESH()
    }
}

constexpr int CW_DQ = 16384 + 1024;
__device__ __forceinline__ void phase_dsa_attn(KP P, int L, LAS unsigned char* lds) {
    int tz = threadIdx.x; asm volatile("" : "+v"(tz)); const int tid = tz, lane = tid & 63, wave = tid >> 6;
    const bf16* qkvi = (const bf16*)(P->ws + WS_QKVI); const int* sel = (const int*)(P->ws + WS_SEL); bf16* attn = (bf16*)(P->ws + WS_ATTN);
    unsigned* qh = (unsigned*)(P->ws + WS_CTL) + CW_DQ + L * 8 * 64;
    LAS unsigned* idxs = (LAS unsigned*)(lds + wave * 8192);
    LAS float* pl = (LAS float*)(lds + wave * 8192 + 1024);
    LAS int* wq = (LAS int*)(lds + 65536 + wave * 16);
    const int r = lane & 3, ts_l = (lane & 15) >> 2, kq = lane >> 4, c16 = lane & 15;
    const unsigned myq = xb_xcc_id() & 7u;
    constexpr float CC = 0.08838834764831845f * 1.4426950408889634f;
    for (int qi = 0; qi < 8; ++qi) {
        const int qx = (int)((myq + (unsigned)qi) & 7u), b = qx >> 1, g = qx & 1;
        for (;;) {
            int item = 0;
            if (lane == 0) item = (int)__hip_atomic_fetch_add(qh + qx * 64, 1u, __ATOMIC_RELAXED, __HIP_MEMORY_SCOPE_AGENT);
            item = __builtin_amdgcn_readfirstlane(item);
            if (item >= SEQ) break;
            const int t = SEQ - 1 - item, tok = b * SEQ + t, cnt = (t + 1 < TOPK) ? (t + 1) : TOPK;
#pragma unroll
            for (int i = 0; i < 4; ++i) { const int j = lane + 64 * i; int sidx = 0; if (j < cnt) sidx = (t < TOPK) ? j : sel[(size_t)tok * TOPK + j]; idxs[j] = (unsigned)sidx; }
            asm volatile("s_waitcnt lgkmcnt(0)" ::: "memory");
            bf16x8 qm[4][4];
            { const bf16* qp = qkvi + (size_t)tok * QLD + (g * 4 + r) * HEAD_DIM + 8 * kq;
#pragma unroll
              for (int ks = 0; ks < 4; ++ks) { const bf16x8 v = *(const bf16x8*)(qp + 32 * ks);
#pragma unroll
                  for (int ts = 0; ts < 4; ++ts) qm[ts][ks] = (ts_l == ts) ? v : (bf16x8){0, 0, 0, 0, 0, 0, 0, 0}; } }
            f32x4 C[4];
            const bf16* kbase = qkvi + (size_t)b * SEQ * QLD + COL_K + g * HEAD_DIM + 8 * kq;
#pragma unroll
            for (int c = 0; c < 4; ++c) {
                C[c] = (f32x4){0.f, 0.f, 0.f, 0.f};
                bf16x8 a[4][4];
#pragma unroll
                for (int ts = 0; ts < 4; ++ts) { const unsigned sk = idxs[(4 * c + ts) * 16 + c16]; const bf16* kp = kbase + (size_t)sk * QLD;
#pragma unroll
                    for (int ks = 0; ks < 4; ++ks) a[ts][ks] = *(const bf16x8*)(kp + 32 * ks); }
#pragma unroll
                for (int ts = 0; ts < 4; ++ts)
#pragma unroll
                    for (int ks = 0; ks < 4; ++ks) C[c] = __builtin_amdgcn_mfma_f32_16x16x32_bf16(a[ts][ks], qm[ts][ks], C[c], 0, 0, 0);
            }
            const float bias2 = __builtin_amdgcn_exp2f(-(float)(g * 4 + r + 1)) * 1.4426950408889634f;
            float x[16]; float m = -INFINITY;
#pragma unroll
            for (int c = 0; c < 4; ++c) { const int k0 = (4 * c + ts_l) * 16 + 4 * kq; const u32x4 sp = *(const LAS u32x4*)(idxs + k0);
#pragma unroll
                for (int j = 0; j < 4; ++j) { const float v = (k0 + j < cnt) ? fmaf(C[c][j], CC, bias2 * (float)((int)sp[j] - t)) : -INFINITY; x[c * 4 + j] = v; m = fmaxf(m, v); } }
            m = fmaxf(m, __shfl_xor(m, 4)); m = fmaxf(m, __shfl_xor(m, 8)); m = fmaxf(m, __shfl_xor(m, 16)); m = fmaxf(m, __shfl_xor(m, 32));
            float sum = 0.f;
#pragma unroll
            for (int i = 0; i < 16; ++i) { x[i] = __builtin_amdgcn_exp2f(x[i] - m); sum += x[i]; }
            sum += __shfl_xor(sum, 4); sum += __shfl_xor(sum, 8); sum += __shfl_xor(sum, 16); sum += __shfl_xor(sum, 32);
            const float inv = 1.f / sum;
#pragma unroll
            for (int c = 0; c < 4; ++c) { const int k0 = (4 * c + ts_l) * 16 + 4 * kq;
#pragma unroll
                for (int j = 0; j < 4; ++j) pl[(k0 + j) * 4 + r] = x[c * 4 + j] * inv; }
            asm volatile("s_waitcnt lgkmcnt(0)" ::: "memory");
            float acc[4][8];
#pragma unroll
            for (int rr = 0; rr < 4; ++rr)
#pragma unroll
                for (int i = 0; i < 8; ++i) acc[rr][i] = 0.f;
            const bf16* vbase = qkvi + (size_t)b * SEQ * QLD + COL_V + g * HEAD_DIM + 8 * c16;
            const int nk4 = (cnt + 3) >> 2;
#pragma unroll 4
            for (int j4 = 0; j4 < nk4; ++j4) {
                const int key = 4 * j4 + kq; const unsigned sk = idxs[key];
                const u32x4 vv = *(const u32x4*)(vbase + (size_t)sk * QLD);
                const f32x4 pp = *(const LAS f32x4*)(pl + key * 4);
                const float vf[8] = {bflo(vv.x), bfhi(vv.x), bflo(vv.y), bfhi(vv.y), bflo(vv.z), bfhi(vv.z), bflo(vv.w), bfhi(vv.w)};
#pragma unroll
                for (int rr = 0; rr < 4; ++rr)
#pragma unroll
                    for (int i = 0; i < 8; ++i) acc[rr][i] = fmaf(pp[rr], vf[i], acc[rr][i]);
            }
#pragma unroll
            for (int rr = 0; rr < 4; ++rr)
#pragma unroll
                for (int i = 0; i < 8; ++i) { float v = acc[rr][i]; v += __shfl_xor(v, 16); v += __shfl_xor(v, 32); acc[rr][i] = v; }
            if (kq == 0) {
#pragma unroll
                for (int rr = 0; rr < 4; ++rr) { u32x4 o; o.x = cvt_pk_bf16(acc[rr][0], acc[rr][1]); o.y = cvt_pk_bf16(acc[rr][2], acc[rr][3]); o.z = cvt_pk_bf16(acc[rr][4], acc[rr][5]); o.w = cvt_pk_bf16(acc[rr][6], acc[rr][7]);
                    *(u32x4*)(attn + (size_t)tok * D_MODEL + (g * 4 + rr) * HEAD_DIM + 8 * c16) = o; }
            }
        }
    }
    (void)wq;
}


__device__ __forceinline__ int d2_swz(int i) { return ((i & 3) << 2) | ((i >> 2) & 3); }
__device__ __forceinline__ void phase_dsa_attn2(KP P, int L, LAS unsigned char* lds) {
    typedef short s16x4 __attribute__((ext_vector_type(4)));
    int tz = threadIdx.x; asm volatile("" : "+v"(tz)); const int tid = tz, lane = tid & 63, wave = __builtin_amdgcn_readfirstlane(tid >> 6);
    const bf16* qkvi = (const bf16*)(P->ws + WS_QKVI); const int* sel = (const int*)(P->ws + WS_SEL); bf16* attn = (bf16*)(P->ws + WS_ATTN);
    unsigned* qh = (unsigned*)(P->ws + WS_CTL) + CW_DQ + L * 8 * 64;
    LAS unsigned char* wl = lds + wave * 19456;
    LAS unsigned* idxs = (LAS unsigned*)wl;
    LAS unsigned char* pb = wl + 1024;
    LAS unsigned char* ring = wl + 3072;
    const int n16 = lane & 15, r = lane & 3, ts_l = n16 >> 2, kq = lane >> 4;
    const unsigned myq = xb_xcc_id() & 7u;
    constexpr float CC = 0.08838834764831845f * 1.4426950408889634f;
    unsigned dch[4];
#pragma unroll
    for (int j = 0; j < 4; ++j) dch[j] = (unsigned)((n16 ^ d2_swz(4 * j + kq)) * 16);
    unsigned aoff[4];
#pragma unroll
    for (int ks = 0; ks < 4; ++ks) aoff[ks] = (unsigned)(n16 * 256 + (((4 * ks + kq) ^ d2_swz(n16)) * 16));
    for (int qi = 0; qi < 8; ++qi) {
        const int qx = (int)((myq + (unsigned)qi) & 7u), b = qx >> 1, g = qx & 1;
        const char* kgb = (const char*)(qkvi + (size_t)b * SEQ * QLD + COL_K + g * HEAD_DIM);
        int item = 0;
        if (lane == 0) item = (int)__hip_atomic_fetch_add(qh + qx * 64, 1u, __ATOMIC_RELAXED, __HIP_MEMORY_SCOPE_AGENT);
        item = __builtin_amdgcn_readfirstlane(item);
        bool have_pf = false; int sx[4] = {0, 0, 0, 0}; bf16x8 qv[4] = {};
        while (item < SEQ) {
            const int t = SEQ - 1 - item, tok = b * SEQ + t, cnt = (t + 1 < TOPK) ? (t + 1) : TOPK;
            if (!have_pf) {
#pragma unroll
                for (int i = 0; i < 4; ++i) { const int j = lane + 64 * i; sx[i] = (t < TOPK) ? j : sel[(size_t)tok * TOPK + j]; }
                const bf16* qp = qkvi + (size_t)tok * QLD + (g * 4 + r) * HEAD_DIM + 8 * kq;
#pragma unroll
                for (int ks = 0; ks < 4; ++ks) qv[ks] = *(const bf16x8*)(qp + 32 * ks);
            }
#pragma unroll
            for (int i = 0; i < 4; ++i) { const int j = lane + 64 * i; idxs[j] = (j < cnt) ? (unsigned)sx[i] : 0u; }
            bf16x8 qm[4][4];
#pragma unroll
            for (int ks = 0; ks < 4; ++ks) {
#pragma unroll
                for (int ts = 0; ts < 4; ++ts) qm[ts][ks] = (ts_l == ts) ? qv[ks] : (bf16x8){0, 0, 0, 0, 0, 0, 0, 0}; }
            asm volatile("s_waitcnt vmcnt(0) lgkmcnt(0)" ::: "memory");
#define D2_ISSUE(s) do { const int kb_ = (s) & 15; const char* gb_ = kgb + ((s) >= 16 ? (COL_V - COL_K) * 2 : 0); LAS unsigned char* sl_ = ring + ((s) & 3) * 4096; \
        _Pragma("unroll") for (int j = 0; j < 4; ++j) { const unsigned sk_ = idxs[kb_ * 16 + 4 * j + kq]; \
            __builtin_amdgcn_global_load_lds((const unsigned*)(gb_ + (size_t)sk_ * (QLD * 2) + dch[j]), (LAS unsigned*)(sl_ + j * 1024), 16, 0, 0); } } while (0)
            int nraw = 0;
            if (lane == 0) nraw = (int)__hip_atomic_fetch_add(qh + qx * 64, 1u, __ATOMIC_RELAXED, __HIP_MEMORY_SCOPE_AGENT);
            D2_ISSUE(0); D2_ISSUE(1); D2_ISSUE(2); D2_ISSUE(3);
            f32x4 C[4];
#pragma unroll
            for (int c = 0; c < 4; ++c) C[c] = (f32x4){0.f, 0.f, 0.f, 0.f};
#pragma unroll
            for (int s2 = 0; s2 < 16; ++s2) {
                asm volatile("s_waitcnt vmcnt(12)" ::: "memory");
                LAS unsigned char* sl = ring + (s2 & 3) * 4096;
                bf16x8 a[4];
#pragma unroll
                for (int ks = 0; ks < 4; ++ks) a[ks] = *(const LAS bf16x8*)(sl + aoff[ks]);
#pragma unroll
                for (int ks = 0; ks < 4; ++ks) C[s2 >> 2] = __builtin_amdgcn_mfma_f32_16x16x32_bf16(a[ks], qm[s2 & 3][ks], C[s2 >> 2], 0, 0, 0);
                asm volatile("s_waitcnt lgkmcnt(0)" ::: "memory");
                D2_ISSUE(s2 + 4);
            }
            const float bias2 = __builtin_amdgcn_exp2f(-(float)(g * 4 + r + 1)) * 1.4426950408889634f;
            float x[16]; float m = -INFINITY;
#pragma unroll
            for (int c = 0; c < 4; ++c) { const int k0 = (4 * c + ts_l) * 16 + 4 * kq; const u32x4 sp = *(const LAS u32x4*)(idxs + k0);
#pragma unroll
                for (int j = 0; j < 4; ++j) { const float v = (k0 + j < cnt) ? fmaf(C[c][j], CC, bias2 * (float)((int)sp[j] - t)) : -INFINITY; x[c * 4 + j] = v; m = fmaxf(m, v); } }
            m = fmaxf(m, __shfl_xor(m, 4)); m = fmaxf(m, __shfl_xor(m, 8)); m = fmaxf(m, __shfl_xor(m, 16)); m = fmaxf(m, __shfl_xor(m, 32));
            float sum = 0.f;
#pragma unroll
            for (int i = 0; i < 16; ++i) { x[i] = __builtin_amdgcn_exp2f(x[i] - m); sum += x[i]; }
            sum += __shfl_xor(sum, 4); sum += __shfl_xor(sum, 8); sum += __shfl_xor(sum, 16); sum += __shfl_xor(sum, 32);
            const float inv = 1.f / sum;
#pragma unroll
            for (int c = 0; c < 4; ++c) { const int k0 = (4 * c + ts_l) * 16 + 4 * kq;
                u32x2 w; w.x = cvt_pk_bf16(x[c * 4 + 0] * inv, x[c * 4 + 1] * inv); w.y = cvt_pk_bf16(x[c * 4 + 2] * inv, x[c * 4 + 3] * inv);
                *(LAS u32x2*)(pb + (r * 256 + k0) * 2) = w; }
            asm volatile("s_waitcnt lgkmcnt(0)" ::: "memory");
            f32x4 O[8]; int nitem = SEQ;
#pragma unroll
            for (int db = 0; db < 8; ++db) O[db] = (f32x4){0.f, 0.f, 0.f, 0.f};
            const int q4 = n16 >> 2, p4 = n16 & 3;
#pragma unroll
            for (int u = 0; u < 8; ++u) {
                if (u < 7) asm volatile("s_waitcnt vmcnt(8)" ::: "memory"); else asm volatile("s_waitcnt vmcnt(0)" ::: "memory");
                LAS unsigned char* sl = ring + (((2 * u) & 3) + (kq >> 1)) * 4096;
                const bf16x8 pf = *(const LAS bf16x8*)(pb + (r * 256 + u * 32 + 8 * kq) * 2);
#pragma unroll
                for (int db = 0; db < 8; ++db) {
                    const int i0 = 8 * (kq & 1) + q4, i1 = i0 + 4;
                    const int a0 = (int)(unsigned)(uintptr_t)(sl + i0 * 256 + (((2 * db + (p4 >> 1)) ^ d2_swz(i0)) * 16) + 8 * (p4 & 1));
                    const int a1 = (int)(unsigned)(uintptr_t)(sl + i1 * 256 + (((2 * db + (p4 >> 1)) ^ d2_swz(i1)) * 16) + 8 * (p4 & 1));
                    const s16x4 v0 = mb::tr_read<0>(a0), v1 = mb::tr_read<0>(a1);
                    asm volatile("s_waitcnt lgkmcnt(0)" ::: "memory");
                    const bf16x8 vf = {v0[0], v0[1], v0[2], v0[3], v1[0], v1[1], v1[2], v1[3]};
                    O[db] = __builtin_amdgcn_mfma_f32_16x16x32_bf16(vf, pf, O[db], 0, 0, 0);
                }
                if (u == 0) {
                    nitem = __builtin_amdgcn_readfirstlane(nraw); have_pf = nitem < SEQ;
                    if (have_pf) { const int tn = SEQ - 1 - nitem, tokn = b * SEQ + tn;
#pragma unroll
                        for (int i = 0; i < 4; ++i) { const int j = lane + 64 * i; sx[i] = (tn < TOPK) ? j : sel[(size_t)tokn * TOPK + j]; }
                        const bf16* qpn = qkvi + (size_t)tokn * QLD + (g * 4 + r) * HEAD_DIM + 8 * kq;
#pragma unroll
                        for (int ks = 0; ks < 4; ++ks) qv[ks] = *(const bf16x8*)(qpn + 32 * ks); } }
                if (u < 6) { D2_ISSUE(16 + 2 * u + 4); D2_ISSUE(16 + 2 * u + 5); }
            }
#undef D2_ISSUE
            if (n16 < 4) {
                bf16* op = attn + (size_t)tok * D_MODEL + (g * 4 + n16) * HEAD_DIM + 4 * kq;
#pragma unroll
                for (int db = 0; db < 8; ++db) { u32x2 w; w.x = cvt_pk_bf16(O[db][0], O[db][1]); w.y = cvt_pk_bf16(O[db][2], O[db][3]); *(u32x2*)(op + 16 * db) = w; }
            }
            item = nitem;
        }
    }
}

__device__ __forceinline__ int opq(int x) { asm volatile("" : "+s"(x)); return x; }
__device__ __forceinline__ bool phase_active(int L, int k) {
    if (k >= 2 && k <= 6) { if (L < N_A) return k <= 3; if (k == 2) return L == N_A; }
    return k <= 14;
}
__global__ void __launch_bounds__(512, 2) fwd(Params P) {
    extern __shared__ __attribute__((aligned(16))) unsigned char lds_raw[];
    LAS unsigned char* lds = (LAS unsigned char*)lds_raw;
    const int tid = threadIdx.x;
    unsigned char* ws0 = P.ws;
    if (tid < 16) ((LAS unsigned*)(lds + LDS_MISC))[tid] = 0u;
    __syncthreads();
    const int lo = P.ph_lo, hi = P.ph_hi;
    const bool multi = (hi - lo) > 1;
    unsigned* barw = (unsigned*)(ws0 + WS_CTL) + CW_BAR + P.bar_idx * XCD_BAR_WORDS;
    XcdBarrier bar; bar.bar = barw; bar.x = 0; bar.st = nullptr;
    if (multi) bar = xcd_barrier_post(barw, (volatile LAS unsigned*)(lds + LDS_MISC));
#ifndef PHASE_MASK
#define PHASE_MASK 0xFFFF
#endif
#define IN(k) (((PHASE_MASK >> (k)) & 1) && opq(lo) <= (pb + (k)) && (pb + (k)) < hi && phase_active(L, (k)))
#define SEAM(k) do { if (IN(k) && (pb + (k) + 1) < hi) xcd_barrier(bar); } while (0)
#ifndef PROBE_MASK
#define PROBE_MASK 0
#endif
#define PROBED(k) (((PROBE_MASK) >> (k)) & 1)
    const int G = gridDim.x, c = blockIdx.x;
    for (int L = 0; L < DEPTH; ++L) {
        const int pb = L * 16;
        if (pb + 16 <= lo || pb >= hi) continue;
        const bool isA = L < N_A;
        if (IN(0)) { for (int rep = PROBED(0) ? 0 : 1; rep < 2; ++rep) { phase_convert(fresh_params(), L, lds); if (rep == 0) xcd_barrier(bar); } } SEAM(0);
        if (IN(1)) { for (int rep = PROBED(1) ? 0 : 1; rep < 2; ++rep) {
            KP Q = fresh_params(); unsigned char* ws = Q->ws; bf16* hb = (bf16*)(ws + WS_HB);
            if (isA) {
                gm::DenseOrder S; S.init(hb, ws + WS_WMIX, NTOK, 2048, D_MODEL, G, c);
                gm::EpiBf16 E{(bf16*)(ws + WS_QKVI), QLD, (float*)(ws + WS_IW)};
                gm::gemm_phase<gm::EpiBf16, gm::DenseOrder, false>(lds, D_MODEL, S, E);
            } else {
                if (L == N_A) {
                    gm::DenseOrder S; S.init(hb, ws + WS_WMIX + 6 * MiB, NTOK, 512, D_MODEL, G, c);
                    gm::EpiBf16 E{(bf16*)(ws + WS_KV), 512, nullptr};
                    gm::gemm_phase<gm::EpiBf16, gm::DenseOrder, false>(lds, D_MODEL, S, E);
                }
                gm::DenseOrder S; S.init(hb, ws + WS_WMIX, NTOK, D_MODEL, D_MODEL, G, c);
                gm::EpiBf16 E{(bf16*)(ws + WS_QKVI), D_MODEL, nullptr};
                gm::gemm_phase<gm::EpiBf16, gm::DenseOrder, false>(lds, D_MODEL, S, E);
            }
            if (rep == 0) xcd_barrier(bar);
        } } SEAM(1);
        if (IN(2)) { if (isA) { if (PROBED(2)) { phase_dsa_topk<D1_EXP>(fresh_params(), lds, WS_PL); xcd_barrier(bar); } phase_dsa_topk<0>(fresh_params(), lds, WS_SEL); } else phase_kmeans(fresh_params()); } SEAM(2);
        if (IN(3)) { if (isA) { for (int rep = PROBED(3) ? 0 : 1; rep < 2; ++rep) { phase_dsa_attn2(fresh_params(), rep == 0 ? L + 2 : L, lds); if (rep == 0) xcd_barrier(bar); } } else { for (int rep = PROBED(4) ? 0 : 1; rep < 2; ++rep) { phase_moba_gate2(fresh_params()); if (rep == 0) xcd_barrier(bar); } } } SEAM(3);
        if (IN(4)) { phase_moba_lists(fresh_params(), lds); } SEAM(4);
        if (IN(5)) { for (int rep = PROBED(5) ? 0 : 1; rep < 2; ++rep) { phase_moba_attn2(fresh_params(), (L - N_A) * 2 + rep, lds); if (rep == 0) xcd_barrier(bar); } } SEAM(5);
        if (IN(6)) { for (int rep = PROBED(6) ? 0 : 1; rep < 2; ++rep) { phase_moba_combine(fresh_params()); if (rep == 0) xcd_barrier(bar); } } SEAM(6);
        if (IN(7)) { for (int rep = PROBED(7) ? 0 : 1; rep < 2; ++rep) {
            KP Q = fresh_params(); unsigned char* ws = Q->ws; const bf16* hres = (const bf16*)(ws + WS_HB); _Float16* t = (_Float16*)(ws + WS_T);
            { gm::DenseOrder S; S.init(ws + WS_ATTN, ws + WS_WMIX + 4 * MiB, NTOK, D_MODEL, D_MODEL, G, c);
              gm::EpiResid E{hres, t};
              gm::gemm_phase<gm::EpiResid, gm::DenseOrder, false>(lds, D_MODEL, S, E); }
            { gm::DenseOrder S; S.init(ws + WS_PB, ws + WS_WPLE, NTOK, D_MODEL, PLE_DIM, G, c);
              gm::EpiBf16 E{(bf16*)(ws + WS_PL), D_MODEL, nullptr};
              gm::gemm_phase<gm::EpiBf16, gm::DenseOrder, false>(lds, PLE_DIM, S, E); }
            if (rep == 0) xcd_barrier(bar);
        } } SEAM(7);
        if (IN(8)) { for (int rep = PROBED(8) ? 0 : 1; rep < 2; ++rep) { phase_ln_router(fresh_params(), L, lds, rep == 0 ? L + 4 : L); if (rep == 0) xcd_barrier(bar); } } SEAM(8);
        if (IN(9)) { phase_moe_prep(fresh_params(), L, lds); } SEAM(9);
        if (IN(10)) { for (int rep = PROBED(10) ? 0 : 1; rep < 2; ++rep) {
            KP Q = fresh_params(); unsigned char* ws = Q->ws; bf16* hb = (bf16*)(ws + WS_HB);
            const int* moe = (const int*)(ws + WS_MOE);
            gm::MoeOrder S; S.tile_e = moe + MO_TILE_E; S.tile_row0 = moe + MO_TILE_ROW0; S.tile_nv = moe + MO_TILE_NV; S.slot_tok = moe + MO_SLOT_TOK;
            S.n_units = (int)*((const unsigned*)(ws + WS_CTL) + CW_NTILES + L) * 4; S.G = G; S.c = c; S.K = D_MODEL; S.A = (const char*)hb; S.W = (const char*)(ws + WS_WGU);
            S.wstride = (size_t)D_MODEL * D_MODEL * 2; S.tB = (size_t)256 * D_MODEL * 2; S.gath = true;
            gm::EpiSwiglu E{(bf16*)(ws + WS_ACT)};
            gm::gemm_phase<gm::EpiSwiglu, gm::MoeOrder, true>(lds, D_MODEL, S, E);
            if (rep == 0) xcd_barrier(bar);
        } } SEAM(10);
        if (IN(11)) { for (int rep = PROBED(11) ? 0 : 1; rep < 2; ++rep) {
            KP Q = fresh_params(); unsigned char* ws = Q->ws;
            const int* moe = (const int*)(ws + WS_MOE);
            gm::MoeOrder S; S.tile_e = moe + MO_TILE_E; S.tile_row0 = moe + MO_TILE_ROW0; S.tile_nv = moe + MO_TILE_NV; S.slot_tok = moe + MO_SLOT_TOK;
            S.n_units = (int)*((const unsigned*)(ws + WS_CTL) + CW_NTILES + L) * 4; S.G = G; S.c = c; S.K = D_EXPERT; S.A = (const char*)(ws + WS_ACT); S.W = (const char*)(ws + WS_WD);
            S.wstride = (size_t)D_MODEL * D_EXPERT * 2; S.tB = (size_t)256 * D_EXPERT * 2; S.gath = false;
            gm::EpiMoeDown E{(bf16*)(ws + WS_Y)};
            gm::gemm_phase<gm::EpiMoeDown, gm::MoeOrder, false>(lds, D_EXPERT, S, E);
            if (rep == 0) xcd_barrier(bar);
        } } SEAM(11);
        if (IN(12)) { KP Q = fresh_params(); phase_ln<1, false>(Q, L, 1, lds, nullptr, true); } SEAM(12);
        if (IN(13)) { for (int rep = PROBED(13) ? 0 : 1; rep < 2; ++rep) {
            KP Q = fresh_params(); unsigned char* ws = Q->ws; bf16* hb = (bf16*)(ws + WS_HB); _Float16* t = (_Float16*)(ws + WS_T);
            gm::DenseOrder S; S.init(hb, ws + WS_WPG, NTOK, D_MODEL, D_MODEL, G, c);
            gm::EpiPle E{hb, (const bf16*)(ws + WS_PL), t};
            gm::gemm_phase<gm::EpiPle, gm::DenseOrder, false>(lds, D_MODEL, S, E);
            if (rep == 0) xcd_barrier(bar);
        } } SEAM(13);
        if (IN(14)) { for (int rep = PROBED(14) ? 0 : 1; rep < 2; ++rep) { KP Q = fresh_params(); phase_ln<0, false>(Q, L, 2, lds, (L == DEPTH - 1) ? Q->out : nullptr, L != DEPTH - 1); if (rep == 0) xcd_barrier(bar); } }
        if (L != DEPTH - 1) SEAM(14);
    }
#undef IN
#undef SEAM
}

#ifndef DEBUG_ATTN
#define DEBUG_ATTN 0
#endif
#if DEBUG_ATTN
__global__ void __launch_bounds__(256) dsa_scores(const bf16* __restrict__ qkvi  , const float* __restrict__ iw  , float* __restrict__ sc) {
    const int s0 = blockIdx.x * 64, t0 = blockIdx.y * 64;
    if (s0 > t0) return;
    __shared__ float Qs[64][68];
    __shared__ float Ks[64][68];
    const int tid = threadIdx.x, r = tid >> 2, kq = (tid & 3) * 16;
    {
        const bf16* kp = qkvi + (size_t)(s0 + r) * QLD + COL_IK + kq;
#pragma unroll
        for (int i = 0; i < 16; ++i) Ks[kq + i][r] = bf2f(kp[i]);
    }
    const int ty = tid >> 4, tx = tid & 15;
    float tot[4][4];
#pragma unroll
    for (int i = 0; i < 4; ++i)
#pragma unroll
        for (int j = 0; j < 4; ++j) tot[i][j] = 0.f;
    for (int hh = 0; hh < IDX_HEADS; ++hh) {
        __syncthreads();
        const bf16* qp = qkvi + (size_t)(t0 + r) * QLD + COL_IQ + hh * IDX_DIM + kq;
#pragma unroll
        for (int i = 0; i < 16; ++i) Qs[kq + i][r] = bf2f(qp[i]);
        __syncthreads();
        float acc[4][4];
#pragma unroll
        for (int i = 0; i < 4; ++i)
#pragma unroll
            for (int j = 0; j < 4; ++j) acc[i][j] = 0.f;
#pragma unroll 8
        for (int k = 0; k < 64; ++k) {
            const float4 a4 = *(const float4*)&Qs[k][ty * 4];
            const float4 b4 = *(const float4*)&Ks[k][tx * 4];
            const float a[4] = {a4.x, a4.y, a4.z, a4.w};
            const float b[4] = {b4.x, b4.y, b4.z, b4.w};
#pragma unroll
            for (int i = 0; i < 4; ++i)
#pragma unroll
                for (int j = 0; j < 4; ++j) acc[i][j] += a[i] * b[j];
        }
#pragma unroll
        for (int i = 0; i < 4; ++i) {
            const float w = iw[(size_t)(t0 + ty * 4 + i) * 4 + hh];
#pragma unroll
            for (int j = 0; j < 4; ++j) tot[i][j] += w * fmaxf(acc[i][j], 0.f);
        }
    }
#pragma unroll
    for (int i = 0; i < 4; ++i)
        *(float4*)(sc + (size_t)(t0 + ty * 4 + i) * SEQ + s0 + tx * 4) = make_float4(tot[i][0], tot[i][1], tot[i][2], tot[i][3]);
}

__device__ __forceinline__ unsigned fkey(float f) { const unsigned u = __float_as_uint(f); return (u & 0x80000000u) ? ~u : (u | 0x80000000u); }
__global__ void __launch_bounds__(256) dsa_topk(const float* __restrict__ sc, int* __restrict__ sel) {
    const int t = blockIdx.x, tid = threadIdx.x, n = t + 1;
    int* out = sel + (size_t)t * TOPK;
    if (n <= TOPK) { out[tid] = tid <= t ? tid : 0; return; }
    const float* row = sc + (size_t)t * SEQ;
    __shared__ unsigned hist[256];
    __shared__ unsigned s_prefix, s_need;
    __shared__ int wsum[2][4];
    unsigned prefix = 0, need = TOPK;
    for (int pass = 3; pass >= 0; --pass) {
        hist[tid] = 0;
        __syncthreads();
        for (int i = tid; i < n; i += 256) {
            const unsigned k = fkey(row[i]);
            const bool match = (pass == 3) ? true : ((k >> (8 * (pass + 1))) == prefix);
            if (match) atomicAdd(&hist[(k >> (8 * pass)) & 255u], 1u);
        }
        __syncthreads();
        if (tid == 0) {
            unsigned c = 0; int d = 255;
            for (; d > 0; --d) { if (c + hist[d] >= need) break; c += hist[d]; }
            s_prefix = (prefix << 8) | (unsigned)d; s_need = need - c;
        }
        __syncthreads();
        prefix = s_prefix; need = s_need;
        __syncthreads();
    }
    const unsigned T = prefix;
    const int n_gt = TOPK - (int)need;
    int run_gt = 0, run_eq = 0;
    const int lane = tid & 63, w = tid >> 6;
    for (int base = 0; base < n; base += 256) {
        const int i = base + tid;
        unsigned k = 0; bool gt = false, eq = false;
        if (i < n) { k = fkey(row[i]); gt = k > T; eq = k == T; }
        const unsigned long long mg = __ballot(gt), me = __ballot(eq);
        const unsigned long long lower = (lane == 0) ? 0ull : (~0ull >> (64 - lane));
        const int pg = __popcll(mg & lower), pe = __popcll(me & lower);
        if (lane == 0) { wsum[0][w] = __popcll(mg); wsum[1][w] = __popcll(me); }
        __syncthreads();
        int og = 0, oe = 0, tg = 0, te = 0;
        for (int x = 0; x < 4; ++x) { if (x < w) { og += wsum[0][x]; oe += wsum[1][x]; } tg += wsum[0][x]; te += wsum[1][x]; }
        if (gt) out[run_gt + og + pg] = i;
        if (eq) { const int rk = run_eq + oe + pe; if (rk < (int)need) out[n_gt + rk] = i; }
        run_gt += tg; run_eq += te;
        __syncthreads();
    }
}

__global__ void __launch_bounds__(256) dsa_attn(const bf16* __restrict__ qkvi, const int* __restrict__ sel, bf16* __restrict__ attn) {
    const int tok = blockIdx.x, b = tok / SEQ, t = tok % SEQ, tid = threadIdx.x;
    __shared__ float qs[D_MODEL];
    __shared__ float lg[N_HEADS][TOPK];
    __shared__ int sidx[TOPK];
    const int cnt = (t + 1 < TOPK) ? (t + 1) : TOPK;
    const bf16* prow = qkvi + (size_t)tok * QLD;
#pragma unroll
    for (int i = 0; i < 4; ++i) qs[tid * 4 + i] = bf2f(prow[tid * 4 + i]);
    int s = 0;
    if (tid < cnt) s = (t < TOPK) ? tid : sel[(size_t)tok * TOPK + tid];
    sidx[tid] = s;
    __syncthreads();
    const float scale = 0.08838834764831845f;
    if (tid < cnt) {
        const bf16* krow = qkvi + (size_t)(b * SEQ + s) * QLD + COL_K;
        for (int g = 0; g < N_KV; ++g) {
            float d[4] = {0.f, 0.f, 0.f, 0.f};
            for (int k = 0; k < HEAD_DIM; ++k) {
                const float kv = bf2f(krow[g * HEAD_DIM + k]);
#pragma unroll
                for (int r = 0; r < 4; ++r) d[r] += qs[(g * 4 + r) * HEAD_DIM + k] * kv;
            }
#pragma unroll
            for (int r = 0; r < 4; ++r) {
                const int hh = g * 4 + r;
                const float slope = exp2f(-(float)(hh + 1));
                lg[hh][tid] = d[r] * scale - slope * (float)(t - s);
            }
        }
    } else {
        for (int hh = 0; hh < N_HEADS; ++hh) lg[hh][tid] = -INFINITY;
    }
    __syncthreads();
    {
        const int lane = tid & 63, w = tid >> 6;
        for (int h2 = 0; h2 < 2; ++h2) {
            const int hh = w * 2 + h2;
            float v[4], m = -INFINITY;
#pragma unroll
            for (int i = 0; i < 4; ++i) { v[i] = lg[hh][lane + 64 * i]; m = fmaxf(m, v[i]); }
            for (int o = 32; o > 0; o >>= 1) m = fmaxf(m, __shfl_xor(m, o));
            float sum = 0.f;
#pragma unroll
            for (int i = 0; i < 4; ++i) { v[i] = expf(v[i] - m); sum += v[i]; }
            for (int o = 32; o > 0; o >>= 1) sum += __shfl_xor(sum, o);
            const float inv = 1.f / sum;
#pragma unroll
            for (int i = 0; i < 4; ++i) lg[hh][lane + 64 * i] = v[i] * inv;
        }
    }
    __syncthreads();
    {
        const int col = tid * 4, hh = col / HEAD_DIM, g = hh / HEAD_GROUP, d = col % HEAD_DIM;
        float acc[4] = {0.f, 0.f, 0.f, 0.f};
        for (int j = 0; j < cnt; ++j) {
            const float p = lg[hh][j];
            const u32x2 vv = *(const u32x2*)(qkvi + (size_t)(b * SEQ + sidx[j]) * QLD + COL_V + g * HEAD_DIM + d);
            acc[0] += p * bflo(vv.x); acc[1] += p * bfhi(vv.x); acc[2] += p * bflo(vv.y); acc[3] += p * bfhi(vv.y);
        }
        u32x2 o; o.x = cvt_pk_bf16(acc[0], acc[1]); o.y = cvt_pk_bf16(acc[2], acc[3]);
        *(u32x2*)(attn + (size_t)tok * D_MODEL + col) = o;
    }
}

__global__ void __launch_bounds__(128) kmeans_kernel(const bf16* __restrict__ kv, float* __restrict__ km) {
    const int blk = blockIdx.x % N_BLOCKS, g = (blockIdx.x / N_BLOCKS) % N_KV, b = blockIdx.x / (N_BLOCKS * N_KV), d = threadIdx.x;
    float s = 0.f;
    for (int i = 0; i < MOBA_BLOCK; ++i) s += bf2f(kv[(size_t)(b * SEQ + blk * MOBA_BLOCK + i) * 512 + g * HEAD_DIM + d]);
    km[((size_t)(b * N_KV + g) * N_BLOCKS + blk) * HEAD_DIM + d] = s * (1.f / MOBA_BLOCK);
}

__global__ void __launch_bounds__(256) moba_attn(const bf16* __restrict__ q, const bf16* __restrict__ kv, const float* __restrict__ km, bf16* __restrict__ attn) {
    const int tok = blockIdx.x, b = tok / SEQ, t = tok % SEQ, tid = threadIdx.x, own = t / MOBA_BLOCK;
    __shared__ float qs[HEAD_DIM];
    __shared__ float gate[N_BLOCKS];
    __shared__ int selb[3];
    __shared__ float lg[4 * MOBA_BLOCK];
    __shared__ float red[8];
    __shared__ float part[2][HEAD_DIM];
    const float scale = 0.08838834764831845f;
    for (int hh = 0; hh < N_HEADS; ++hh) {
        const int g = hh / HEAD_GROUP;
        const float slope = exp2f(-(float)(hh + 1));
        __syncthreads();
        if (tid < HEAD_DIM) qs[tid] = bf2f(q[(size_t)tok * D_MODEL + hh * HEAD_DIM + tid]);
        __syncthreads();
        if (tid < N_BLOCKS) {
            float gval = -INFINITY;
            if (tid < own) {
                const float* kp = km + ((size_t)(b * N_KV + g) * N_BLOCKS + tid) * HEAD_DIM;
                float s = 0.f;
                for (int k = 0; k < HEAD_DIM; ++k) s += qs[k] * kp[k];
                gval = s;
            }
            gate[tid] = gval;
        }
        __syncthreads();
        if (tid == 0) {
            unsigned used = 0u;
            for (int s = 0; s < 3; ++s) {
                int best = -1; float bv = 0.f;
                for (int j = 0; j < N_BLOCKS; ++j) if (!((used >> j) & 1u) && (best < 0 || gate[j] > bv)) { best = j; bv = gate[j]; }
                used |= 1u << best; selb[s] = best;
            }
        }
        __syncthreads();
        for (int s = 0; s < 4; ++s) {
            const int blk = (s < 3) ? selb[s] : own;
            const int kpos = blk * MOBA_BLOCK + tid;
            const bool valid = (s < 3) ? (blk < own) : (kpos <= t);
            float v = -INFINITY;
            if (valid) {
                const bf16* kp = kv + (size_t)(b * SEQ + kpos) * 512 + g * HEAD_DIM;
                float d = 0.f;
                for (int k = 0; k < HEAD_DIM; ++k) d += qs[k] * bf2f(kp[k]);
                v = d * scale - slope * (float)(t - kpos);
            }
            lg[s * MOBA_BLOCK + tid] = v;
        }
        __syncthreads();
        float m = fmaxf(fmaxf(lg[tid], lg[256 + tid]), fmaxf(lg[512 + tid], lg[768 + tid]));
        for (int o = 32; o > 0; o >>= 1) m = fmaxf(m, __shfl_xor(m, o));
        if ((tid & 63) == 0) red[tid >> 6] = m;
        __syncthreads();
        m = fmaxf(fmaxf(red[0], red[1]), fmaxf(red[2], red[3]));
        float e[4], sum = 0.f;
#pragma unroll
        for (int i = 0; i < 4; ++i) { e[i] = expf(lg[i * 256 + tid] - m); sum += e[i]; }
        for (int o = 32; o > 0; o >>= 1) sum += __shfl_xor(sum, o);
        if ((tid & 63) == 0) red[4 + (tid >> 6)] = sum;
        __syncthreads();
        const float inv = 1.f / (red[4] + red[5] + red[6] + red[7]);
#pragma unroll
        for (int i = 0; i < 4; ++i) lg[i * 256 + tid] = e[i] * inv;
        __syncthreads();
        {
            const int d = tid & 127, half = tid >> 7;
            float acc = 0.f;
            for (int s = 0; s < 4; ++s) {
                const int blk = (s < 3) ? selb[s] : own;
                const bool bvalid = (s < 3) ? (blk < own) : true;
                if (!bvalid) continue;
                const bf16* vp = kv + (size_t)(b * SEQ + blk * MOBA_BLOCK + half * 128) * 512 + KV_DIM + g * HEAD_DIM + d;
                const float* pp = lg + s * MOBA_BLOCK + half * 128;
                for (int j = 0; j < 128; ++j) { const float p = pp[j]; if (p != 0.f) acc += p * bf2f(vp[(size_t)j * 512]); }
            }
            part[half][d] = acc;
        }
        __syncthreads();
        if (tid < HEAD_DIM) attn[(size_t)tok * D_MODEL + hh * HEAD_DIM + tid] = (bf16)(cvt_pk_bf16(part[0][tid] + part[1][tid], 0.f) & 0xffffu);
    }
}


#endif
#ifndef DEBUG_ATTN
#define DEBUG_ATTN 0
#endif
#if DEBUG_ATTN
__global__ void dbg_compare(const bf16* __restrict__ a, const bf16* __restrict__ ref, size_t n, float* __restrict__ acc) {
    float d2 = 0.f, r2 = 0.f;
    for (size_t i = (size_t)blockIdx.x * blockDim.x + threadIdx.x; i < n; i += (size_t)gridDim.x * blockDim.x) { const float x = bf2f(a[i]), y = bf2f(ref[i]); d2 += (x - y) * (x - y); r2 += y * y; }
    d2 = wave_sum(d2); r2 = wave_sum(r2);
    if ((threadIdx.x & 63) == 0) { atomicAdd(&acc[0], d2); atomicAdd(&acc[1], r2); }
}
__global__ void dbg_scale(float* __restrict__ out, size_t n, const float* __restrict__ acc) {
    const float rv = acc[0] / fmaxf(acc[1], 1e-30f);
    float e = sqrtf(fminf(rv * 100.f, 4.f)); if (!(rv == rv)) e = 3.f;
    for (size_t i = (size_t)blockIdx.x * blockDim.x + threadIdx.x; i < n; i += (size_t)gridDim.x * blockDim.x) out[i] *= (1.f + e);
}
#endif

extern "C" void kernel_launch(void* const* d_in, const int* in_sizes, int n_in, void* d_out, int out_size, void* d_ws, size_t ws_size, hipStream_t stream) {
    static int grid = 0;
    if (grid == 0) {
        int dev = 0, cus = 0;
        (void)hipGetDevice(&dev); (void)hipDeviceGetAttribute(&cus, hipDeviceAttributeMultiprocessorCount, dev);
        (void)hipFuncSetAttribute((const void*)fwd, hipFuncAttributeMaxDynamicSharedMemorySize, LDS_BYTES);
        grid = cus > 0 ? cus : 256;
    }
    unsigned char* ws = (unsigned char*)d_ws;
    (void)hipMemsetAsync(ws + WS_CTL, 0, CTL_ZERO_BYTES, stream);
    Params P{};
    for (int i = 0; i < 18; ++i) P.in[i] = (const float*)d_in[i];
    P.out = (float*)d_out; P.ws = ws;
    int nlaunch = 0;
    auto run = [&](int lo, int hi) { P.ph_lo = lo; P.ph_hi = hi; P.bar_idx = nlaunch++; hipLaunchKernelGGL(fwd, dim3(grid), dim3(512), LDS_BYTES, stream, P); };
#if DEBUG_ATTN
    const bf16* qkvi = (const bf16*)(ws + WS_QKVI); bf16* attn = (bf16*)(ws + WS_ATTN); int* sel = (int*)(ws + WS_SEL);
    float* scores = (float*)(ws + WS_SCORES); const float* iw = (const float*)(ws + WS_IW); const bf16* kvb = (const bf16*)(ws + WS_KV); float* km = (float*)(ws + WS_KM);
#endif
#if DEBUG_ATTN == 0
    run(0, DEPTH * 16);
#else
    for (int L = 0; L < DEPTH; ++L) {
        const int pb = L * 16;
        if (L < N_A) {
#if DEBUG_ATTN == 4
            if (L == 1) {
                run(pb + 0, pb + 3);
                bf16* attn2 = (bf16*)(ws + WS_PL);
                dsa_attn<<<NTOK, 256, 0, stream>>>(qkvi, sel, attn2);
                run(pb + 3, pb + 4);
                dbg_compare<<<1024, 256, 0, stream>>>(attn, attn2, (size_t)NTOK * D_MODEL, (float*)(ws + WS_CTL) + 1024);
                run(pb + 7, pb + 15);
            } else
#endif
#if DEBUG_ATTN == 3
            if (L == 1) {
                run(pb + 0, pb + 2);
                bf16* attn2 = (bf16*)(ws + WS_PL);
                for (int b = 0; b < BATCH; ++b) {
                    dsa_scores<<<dim3(SEQ / 64, SEQ / 64), 256, 0, stream>>>(qkvi + (size_t)b * SEQ * QLD, iw + (size_t)b * SEQ * 4, scores);
                    dsa_topk<<<SEQ, 256, 0, stream>>>(scores, sel + (size_t)b * SEQ * TOPK);
                }
                dsa_attn<<<NTOK, 256, 0, stream>>>(qkvi, sel, attn2);
                run(pb + 2, pb + 4);
                dbg_compare<<<1024, 256, 0, stream>>>(attn, attn2, (size_t)NTOK * D_MODEL, (float*)(ws + WS_CTL) + 1024);
                run(pb + 7, pb + 15);
            } else
#endif
            { run(pb + 0, pb + 4); run(pb + 7, pb + 15); }
        } else {
            run(pb + 0, pb + 7);
#if DEBUG_ATTN == 1
            if (L == N_A) {
                bf16* attn2 = (bf16*)(ws + WS_PL);
                kmeans_kernel<<<BATCH * N_KV * N_BLOCKS, 128, 0, stream>>>(kvb, km + 65536);
                moba_attn<<<NTOK, 256, 0, stream>>>(qkvi, kvb, km + 65536, attn2);
                dbg_compare<<<1024, 256, 0, stream>>>(attn, attn2, (size_t)NTOK * D_MODEL, (float*)(ws + WS_CTL) + 1024);
            }
#endif
            run(pb + 7, pb + 15);
        }
    }
#endif
#if DEBUG_ATTN
    dbg_scale<<<1024, 256, 0, stream>>>((float*)d_out, (size_t)NTOK * D_MODEL, (const float*)(ws + WS_CTL) + 1024);
#endif
}
```
